# Optimizing an MI355X kernel written in HIP

```python
import math
import jax, jax.numpy as jnp
from jax import lax
import numpy as np

D_MODEL = 1024
BATCH = 16
SEQ = 2048
DEPTH = 4

ROPE_THETA = 10000.0
QBLOCK = 128
NORM_EPS = 1e-6
NEG_INF = -1e30

MLA_HEADS = 8
MLA_Q_LORA = 384
MLA_KV_LORA = 256
MLA_NOPE = 64
MLA_ROPE = 32
MLA_V = 64
SWA_HEADS = 8
SWA_KV_HEADS = 2
SWA_HD = 64
SWA_WINDOW = 128
DIFF_HEADS = 4
DIFF_HD = 64
FOX_HEADS = 8
FOX_HD = 64
FORGET_BIAS_MEAN = 3.0

EVEN_WIDTH = MLA_HEADS * MLA_V + SWA_HEADS * SWA_HD
ODD_WIDTH = DIFF_HEADS * 2 * DIFF_HD + FOX_HEADS * FOX_HD
EVEN_SPLITS = [MLA_Q_LORA, MLA_KV_LORA, MLA_ROPE, SWA_HEADS * SWA_HD,
               SWA_KV_HEADS * SWA_HD, SWA_KV_HEADS * SWA_HD, EVEN_WIDTH]
ODD_SPLITS = [DIFF_HEADS * 2 * DIFF_HD, DIFF_HEADS * 2 * DIFF_HD, DIFF_HEADS * 2 * DIFF_HD,
              FOX_HEADS * FOX_HD, FOX_HEADS * FOX_HD, FOX_HEADS * FOX_HD, FOX_HEADS, ODD_WIDTH]
EVEN_IN = sum(EVEN_SPLITS)
ODD_IN = sum(ODD_SPLITS)

kernel_name = 'hybrid_mla_swa_diff_fox_block'


def rmsnorm(x, g):
    xf = x.astype(jnp.float32)
    y = xf * lax.rsqrt(jnp.mean(xf * xf, axis=-1, keepdims=True) + NORM_EPS)
    return (y * g.astype(jnp.float32)).astype(x.dtype)


def split_cols(z, sizes):
    offs = [int(o) for o in np.cumsum(sizes)[:-1]]
    return jnp.split(z, offs, axis=-1)


def rope_tables(seq, dim):
    inv = 1.0 / (ROPE_THETA ** (jnp.arange(0, dim, 2, dtype=jnp.float32) / dim))
    ang = jnp.arange(seq, dtype=jnp.float32)[:, None] * inv[None, :]
    return jnp.cos(ang), jnp.sin(ang)


def apply_rope(x, cos, sin):
    half = x.shape[-1] // 2
    x1, x2 = x[..., :half], x[..., half:]
    c = cos[None, :, None, :].astype(x.dtype)
    s = sin[None, :, None, :].astype(x.dtype)
    return jnp.concatenate([x1 * c - x2 * s, x2 * c + x1 * s], axis=-1)


def causal_block_mask(blk, seq):
    t = blk * QBLOCK + jnp.arange(QBLOCK)
    return jnp.arange(seq)[None, :] <= t[:, None]


def sweep_query_blocks(block_fn, q_arrays):
    b, s = q_arrays[0].shape[0], q_arrays[0].shape[1]
    nblk = s // QBLOCK

    def to_blocks(a):
        return jnp.moveaxis(a.reshape(b, nblk, QBLOCK, *a.shape[2:]), 1, 0)

    xs = (jnp.arange(nblk), tuple(to_blocks(a) for a in q_arrays))
    out = lax.map(lambda args: block_fn(args[0], *args[1]), xs)
    out = jnp.moveaxis(out, 0, 1)
    return out.reshape(b, s, *out.shape[3:])


def mla_attention(q_nope, q_rope, k_nope, k_rope, v):
    seq = k_nope.shape[1]
    scale = (MLA_NOPE + MLA_ROPE) ** -0.5

    def block(blk, qn, qr):
        s = jnp.einsum('bqhd,bkhd->bhqk', qn, k_nope) + jnp.einsum('bqhr,bkr->bhqk', qr, k_rope)
        s = jnp.where(causal_block_mask(blk, seq), s.astype(jnp.float32) * scale, NEG_INF)
        p = jax.nn.softmax(s, axis=-1).astype(v.dtype)
        return jnp.einsum('bhqk,bkhd->bqhd', p, v)

    return sweep_query_blocks(block, (q_nope, q_rope))


def swa_sink_attention(q, k, v, sinks):
    b, s, h, d = q.shape
    kvh = k.shape[2]
    g = h // kvh
    w = SWA_WINDOW
    n = s // w
    qb = q.reshape(b, n, w, kvh, g, d)

    def band(a):
        ap = jnp.pad(a, ((0, 0), (w, 0), (0, 0), (0, 0))).reshape(b, n + 1, w, kvh, d)
        return jnp.concatenate([ap[:, :-1], ap[:, 1:]], axis=2)

    kb, vb = band(k), band(v)
    sc = jnp.einsum('bnqkgd,bnjkd->bnkgqj', qb, kb).astype(jnp.float32) * (d ** -0.5)
    qpos = (jnp.arange(n) * w)[:, None, None] + jnp.arange(w)[None, :, None]
    kpos = (jnp.arange(n) * w - w)[:, None, None] + jnp.arange(2 * w)[None, None, :]
    mask = (kpos <= qpos) & (qpos - kpos < w) & (kpos >= 0)
    sc = jnp.where(mask[None, :, None, None], sc, NEG_INF)
    sink = jnp.broadcast_to(sinks.astype(jnp.float32).reshape(1, 1, kvh, g, 1, 1), sc.shape[:-1] + (1,))
    p = jax.nn.softmax(jnp.concatenate([sc, sink], axis=-1), axis=-1)[..., :-1].astype(v.dtype)
    o = jnp.einsum('bnkgqj,bnjkd->bnqkgd', p, vb)
    return o.reshape(b, s, h, d)


def diff_attention(q1, q2, k1, k2, v, lam):
    seq = k1.shape[1]
    scale = DIFF_HD ** -0.5

    def block(blk, a, c):
        mask = causal_block_mask(blk, seq)
        s1 = jnp.where(mask, jnp.einsum('bqhd,bkhd->bhqk', a, k1).astype(jnp.float32) * scale, NEG_INF)
        s2 = jnp.where(mask, jnp.einsum('bqhd,bkhd->bhqk', c, k2).astype(jnp.float32) * scale, NEG_INF)
        p = (jax.nn.softmax(s1, axis=-1) - lam * jax.nn.softmax(s2, axis=-1)).astype(v.dtype)
        return jnp.einsum('bhqk,bkhe->bqhe', p, v)

    return sweep_query_blocks(block, (q1, q2))


def forgetting_attention(q, k, v, fcum):
    seq = k.shape[1]
    scale = FOX_HD ** -0.5
    f_key = jnp.transpose(fcum, (0, 2, 1))

    def block(blk, qb, fq):
        s = jnp.einsum('bqhd,bkhd->bhqk', qb, k).astype(jnp.float32) * scale
        s = s + jnp.transpose(fq, (0, 2, 1))[..., None] - f_key[:, :, None, :]
        s = jnp.where(causal_block_mask(blk, seq), s, NEG_INF)
        p = jax.nn.softmax(s, axis=-1).astype(v.dtype)
        return jnp.einsum('bhqk,bkhd->bqhd', p, v)

    return sweep_query_blocks(block, (q, fcum))


def even_mixer(h, w_in, q_norm, kv_norm, w_uq, w_ukv, sinks, w_out, rope_lat, rope_head):
    b, s, _ = h.shape
    z = h @ w_in
    z_cq, z_ckv, z_kr, z_sq, z_sk, z_sv, z_gate = split_cols(z, EVEN_SPLITS)
    cos_r, sin_r = rope_lat
    cos_h, sin_h = rope_head
    q = (rmsnorm(z_cq, q_norm) @ w_uq).reshape(b, s, MLA_HEADS, MLA_NOPE + MLA_ROPE)
    q_nope = q[..., :MLA_NOPE]
    q_rope = apply_rope(q[..., MLA_NOPE:], cos_r, sin_r)
    kv = (rmsnorm(z_ckv, kv_norm) @ w_ukv).reshape(b, s, MLA_HEADS, MLA_NOPE + MLA_V)
    k_nope = kv[..., :MLA_NOPE]
    v_mla = kv[..., MLA_NOPE:]
    k_rope = apply_rope(z_kr[:, :, None, :], cos_r, sin_r)[:, :, 0, :]
    o_mla = mla_attention(q_nope, q_rope, k_nope, k_rope, v_mla).reshape(b, s, MLA_HEADS * MLA_V)
    q_s = apply_rope(z_sq.reshape(b, s, SWA_HEADS, SWA_HD), cos_h, sin_h)
    k_s = apply_rope(z_sk.reshape(b, s, SWA_KV_HEADS, SWA_HD), cos_h, sin_h)
    v_s = z_sv.reshape(b, s, SWA_KV_HEADS, SWA_HD)
    o_swa = swa_sink_attention(q_s, k_s, v_s, sinks).reshape(b, s, SWA_HEADS * SWA_HD)
    o = jnp.concatenate([o_mla, o_swa], axis=-1) * jax.nn.silu(z_gate)
    return o @ w_out


def odd_mixer(h, w_in, forget_bias, lam_p, subln, w_out, rope_head, layer):
    b, s, _ = h.shape
    z = h @ w_in
    z_dq, z_dk, z_dv, z_fq, z_fk, z_fv, z_ff, z_gate = split_cols(z, ODD_SPLITS)
    cos_h, sin_h = rope_head
    q = apply_rope(z_dq.reshape(b, s, 2 * DIFF_HEADS, DIFF_HD), cos_h, sin_h).reshape(b, s, DIFF_HEADS, 2, DIFF_HD)
    k = apply_rope(z_dk.reshape(b, s, 2 * DIFF_HEADS, DIFF_HD), cos_h, sin_h).reshape(b, s, DIFF_HEADS, 2, DIFF_HD)
    v_d = z_dv.reshape(b, s, DIFF_HEADS, 2 * DIFF_HD)
    lam_init = 0.8 - 0.6 * math.exp(-0.3 * layer)
    lp = lam_p.astype(jnp.float32)
    lam = jnp.exp(jnp.sum(lp[0] * lp[1])) - jnp.exp(jnp.sum(lp[2] * lp[3])) + lam_init
    o_d = diff_attention(q[:, :, :, 0], q[:, :, :, 1], k[:, :, :, 0], k[:, :, :, 1], v_d, lam)
    o_d = (rmsnorm(o_d, subln) * (1.0 - lam_init)).reshape(b, s, DIFF_HEADS * 2 * DIFF_HD)
    fq = z_fq.reshape(b, s, FOX_HEADS, FOX_HD)
    fk = z_fk.reshape(b, s, FOX_HEADS, FOX_HD)
    fv = z_fv.reshape(b, s, FOX_HEADS, FOX_HD)
    logf = jax.nn.log_sigmoid(z_ff.astype(jnp.float32) + forget_bias.astype(jnp.float32))
    fcum = jnp.cumsum(logf, axis=1)
    o_f = forgetting_attention(fq, fk, fv, fcum).reshape(b, s, FOX_HEADS * FOX_HD)
    o = jnp.concatenate([o_d, o_f], axis=-1) * jax.nn.silu(z_gate)
    return o @ w_out


def setup_inputs(seed: int = 0) -> dict:
    key = jax.random.key(seed)
    ks = jax.random.split(key, 20)
    n_even = (DEPTH + 1) // 2
    n_odd = DEPTH // 2

    def nrm(k, shape, std):
        return std * jax.random.normal(k, shape, jnp.float32)

    return {
        'x': nrm(ks[0], (BATCH, SEQ, D_MODEL), 1.0),
        'c': nrm(ks[1], (BATCH, D_MODEL), 1.0),
        'w_ada': nrm(ks[2], (DEPTH, D_MODEL, 3 * D_MODEL), 0.5 * D_MODEL ** -0.5),
        'b_ada': nrm(ks[3], (DEPTH, 3 * D_MODEL), 0.01),
        'g_pre': 1.0 + nrm(ks[4], (DEPTH, D_MODEL), 0.02),
        'g_post': 1.0 + nrm(ks[5], (DEPTH, D_MODEL), 0.02),
        'ev_w_in': nrm(ks[6], (n_even, D_MODEL, EVEN_IN), D_MODEL ** -0.5),
        'ev_q_norm': 1.0 + nrm(ks[7], (n_even, MLA_Q_LORA), 0.02),
        'ev_kv_norm': 1.0 + nrm(ks[8], (n_even, MLA_KV_LORA), 0.02),
        'ev_w_uq': nrm(ks[9], (n_even, MLA_Q_LORA, MLA_HEADS * (MLA_NOPE + MLA_ROPE)), MLA_Q_LORA ** -0.5),
        'ev_w_ukv': nrm(ks[10], (n_even, MLA_KV_LORA, MLA_HEADS * (MLA_NOPE + MLA_V)), MLA_KV_LORA ** -0.5),
        'ev_sinks': nrm(ks[11], (n_even, SWA_HEADS), 0.5),
        'ev_w_out': nrm(ks[12], (n_even, EVEN_WIDTH, D_MODEL), EVEN_WIDTH ** -0.5),
        'od_w_in': nrm(ks[13], (n_odd, D_MODEL, ODD_IN), D_MODEL ** -0.5),
        'od_forget_bias': FORGET_BIAS_MEAN + nrm(ks[14], (n_odd, FOX_HEADS), 0.5),
        'od_lambda': nrm(ks[15], (n_odd, 4, DIFF_HD), 0.1),
        'od_subln': 1.0 + nrm(ks[16], (n_odd, 2 * DIFF_HD), 0.02),
        'od_w_out': nrm(ks[17], (n_odd, ODD_WIDTH, D_MODEL), ODD_WIDTH ** -0.5),
    }


def reference(x, c, w_ada, b_ada, g_pre, g_post, ev_w_in, ev_q_norm, ev_kv_norm, ev_w_uq, ev_w_ukv,
              ev_sinks, ev_w_out, od_w_in, od_forget_bias, od_lambda, od_subln, od_w_out):
    seq = x.shape[1]
    rope_head = rope_tables(seq, SWA_HD)
    rope_lat = rope_tables(seq, MLA_ROPE)
    cond = jax.nn.silu(c)
    for layer in range(DEPTH):
        mod = cond @ w_ada[layer] + b_ada[layer]
        shift, scale, gate = jnp.split(mod, 3, axis=-1)
        h = rmsnorm(x, g_pre[layer]) * (1.0 + scale[:, None, :]) + shift[:, None, :]
        i = layer // 2
        if layer % 2 == 0:
            y = even_mixer(h, ev_w_in[i], ev_q_norm[i], ev_kv_norm[i], ev_w_uq[i], ev_w_ukv[i],
                           ev_sinks[i], ev_w_out[i], rope_lat, rope_head)
        else:
            y = odd_mixer(h, od_w_in[i], od_forget_bias[i], od_lambda[i], od_subln[i], od_w_out[i],
                          rope_head, layer)
        x = x + gate[:, None, :] * rmsnorm(y, g_post[layer])
    return x
```

```cpp
#include <hip/hip_runtime.h>
#include <hip/hip_cooperative_groups.h>
#include <cstdio>
namespace cg = cooperative_groups;

#define DI __device__ __forceinline__
#define LAS __attribute__((address_space(3)))
typedef unsigned short bf16_t;
typedef short bf16x8 __attribute__((ext_vector_type(8)));
typedef short s16x4 __attribute__((ext_vector_type(4)));
typedef float f32x2 __attribute__((ext_vector_type(2)));
typedef float f32x4 __attribute__((ext_vector_type(4)));
typedef float f32x16 __attribute__((ext_vector_type(16)));
typedef unsigned u32x2 __attribute__((ext_vector_type(2)));
typedef unsigned u32x4 __attribute__((ext_vector_type(4)));
typedef __bf16 bf16x2_t __attribute__((ext_vector_type(2)));

constexpr int T = 32768, DM = 1024, NB = 16, SEQ = 2048;
constexpr float LOG2E = 1.4426950408889634f;
constexpr float EPS = 1e-6f;

constexpr size_t SZ_WEVIN = 2560ull * 1024 * 2, SZ_WODIN = 4096ull * 1024 * 2, SZ_WUQ = 768ull * 384 * 2, SZ_WUKV = 1024ull * 256 * 2, SZ_WOUT = 1024ull * 1024 * 2;
constexpr size_t WS_WEVIN = 0;
constexpr size_t WS_WODIN = WS_WEVIN + 2 * SZ_WEVIN;
constexpr size_t WS_WUQ = WS_WODIN + 2 * SZ_WODIN;
constexpr size_t WS_WUKV = WS_WUQ + 2 * SZ_WUQ;
constexpr size_t WS_WEVOUT = WS_WUKV + 2 * SZ_WUKV;
constexpr size_t WS_WODOUT = WS_WEVOUT + 2 * SZ_WOUT;
constexpr size_t WS_MOD = WS_WODOUT + 2 * SZ_WOUT;
constexpr size_t WS_COSH = WS_MOD + 4ull * 16 * 3072 * 4;
constexpr size_t WS_SINH = WS_COSH + 2048ull * 32 * 4;
constexpr size_t WS_COSR = WS_SINH + 2048ull * 32 * 4;
constexpr size_t WS_SINR = WS_COSR + 2048ull * 16 * 4;
constexpr size_t WS_LOGF = WS_SINR + 2048ull * 16 * 4;
constexpr size_t WS_FCUM = WS_LOGF + (size_t)T * 8 * 4;
constexpr size_t WS_HBUF = (WS_FCUM + (size_t)T * 8 * 4 + 4095) & ~(size_t)4095;
constexpr size_t WS_OBUF = WS_HBUF + (size_t)T * 1024 * 2;
constexpr size_t WS_ZBUF = WS_OBUF + (size_t)T * 1024 * 2;
constexpr size_t WS_QBUF = WS_ZBUF + (size_t)T * 2560 * 2;
constexpr size_t WS_END = WS_ZBUF + (size_t)T * 4096 * 2;

struct Params {
  const float *x, *c, *w_ada, *b_ada, *g_pre, *g_post, *ev_w_in, *ev_q_norm, *ev_kv_norm, *ev_w_uq, *ev_w_ukv, *ev_sinks, *ev_w_out,
      *od_w_in, *od_forget_bias, *od_lambda, *od_subln, *od_w_out;
  float* out;
  unsigned char* ws;
};

DI int opaque_tid() { int t = threadIdx.x; asm volatile("" : "+v"(t)); return t; }
DI float bflo(unsigned u) { return __uint_as_float(u << 16); }
DI float bfhi(unsigned u) { return __uint_as_float(u & 0xffff0000u); }
DI unsigned pk2(float lo, float hi) { f32x2 f = {lo, hi}; bf16x2_t b = __builtin_convertvector(f, bf16x2_t); return __builtin_bit_cast(unsigned, b); }
DI bf16_t f2bf(float f) { return (bf16_t)(pk2(f, 0.f) & 0xffffu); }
DI float fast_exp2(float x) { return __builtin_amdgcn_exp2f(x); }
DI float silu_f(float x) { return x * __builtin_amdgcn_rcpf(1.f + fast_exp2(-x * LOG2E)); }
DI float wave_sum(float v) {
#pragma unroll
  for (int o = 32; o >= 1; o >>= 1) v += __shfl_xor(v, o);
  return v;
}

namespace pg8 {
constexpr int BM = 256, BK = 64, HALF = 128, HTB = HALF * BK * 2, STAGE_BYTES = 8 * HTB, NXCD = 8, WGM = 8;
DI int lds_byte(int r, int c) { const int st = (r >> 4) * 2 + (c >> 5), rr = r & 15, cc = c & 31, ob = rr * 64 + cc * 2; return st * 1024 + (ob ^ (((ob >> 9) & 1) << 5)); }
DI void stage_rc(int b, int& R, int& C) { const int st = b / 1024, sb = b % 1024, swz = sb ^ (((sb >> 9) & 1) << 5); R = (st >> 1) * 16 + swz / 64; C = (st & 1) * 32 + (swz % 64) / 2; }
DI int perm32(int rho) { const int n = rho >> 4, i = rho & 15; return 8 * (i >> 2) + 4 * n + (i & 3); }
struct Unit { int pm, pn; };
struct Gemm { const bf16_t* A; const bf16_t* Bt; int M, N, K, lda; };
struct StaticOrder {
  int nM, nN, nwg, G, c;
  DI void init(int M, int N, int G_, int c_) { nM = M / BM; nN = N / BM; nwg = nM * nN; G = G_; c = c_; }
  DI bool next(int i, Unit& u) const {
    const long L = (long)i * G + c; if (L >= nwg) return false;
    int wgid = (int)L; { const int q = nwg / NXCD, r = nwg % NXCD, xcd = wgid % NXCD, off = wgid / NXCD; wgid = (xcd < r ? xcd * (q + 1) : r * (q + 1) + (xcd - r) * q) + off; }
    const int nig = WGM * nN, gid = wgid / nig, fm = gid * WGM, gsz = (nM - fm) < WGM ? (nM - fm) : WGM;
    u.pm = fm + ((wgid % nig) % gsz); u.pn = (wgid % nig) / gsz; return true;
  }
};

template <class Epi>
DI void gemm_phase(LAS unsigned char* lds, const Gemm g, const StaticOrder& S, const Epi& E) {
  const int tid = opaque_tid(), wid = __builtin_amdgcn_readfirstlane(tid >> 6), lane = tid & 63, wr = wid >> 2, wc = wid & 3, fr = lane & 15, fq = lane >> 4;
  const int K = g.K, nt = K / BK, lda = g.lda;
  unsigned voffA[2], voffB[2];
#pragma unroll
  for (int i = 0; i < 2; ++i) { int R, C; stage_rc(tid * 16 + i * 8192, R, C); const int Rb = (R & ~31) + perm32(R & 31);
    voffA[i] = (unsigned)(R * lda + C) * 2u; voffB[i] = (unsigned)(Rb * K + C) * 2u; }
  const size_t kstep = (size_t)(BK * 2);
  const size_t hstepA = (size_t)HALF * lda * 2, hstepB = (size_t)HALF * K * 2;
  const size_t tstepA = 2 * hstepA, tstepB = 2 * hstepB;
  const unsigned ldsw = (unsigned)wid * 1024u;
  const int aoff = lds_byte(wr * 64 + fr, fq * 8), boff = lds_byte(wc * 32 + fr, fq * 8);
#define PG8_SA(b, h) (((b) * 2 + (h)) * HTB)
#define PG8_SB(b, h) ((4 + (b) * 2 + (h)) * HTB)
#define PG8_STAGE(bufoff, gbase, voff) do { _Pragma("unroll") for (int _i = 0; _i < 2; ++_i) \
    __builtin_amdgcn_global_load_lds((const unsigned*)((const char*)(gbase) + (voff)[_i]), (LAS unsigned*)(lds + (bufoff) + ldsw + _i * 8192), 16, 0, 0); } while (0)
#define PG8_LDA(dst, b, h) do { _Pragma("unroll") for (int m = 0; m < 4; ++m) _Pragma("unroll") for (int k = 0; k < 2; ++k) dst[m][k] = *(const LAS bf16x8*)(lds + PG8_SA(b, h) + aoff + m * 2048 + k * 1024); } while (0)
#define PG8_LDB(dst, b, h) do { _Pragma("unroll") for (int n = 0; n < 2; ++n) _Pragma("unroll") for (int k = 0; k < 2; ++k) dst[n][k] = *(const LAS bf16x8*)(lds + PG8_SB(b, h) + boff + n * 2048 + k * 1024); } while (0)
#define PG8_MMA(ai, bj, At, Bt) do { __builtin_amdgcn_s_setprio(1); _Pragma("unroll") for (int m = 0; m < 4; ++m) _Pragma("unroll") for (int n = 0; n < 2; ++n) _Pragma("unroll") for (int k = 0; k < 2; ++k) \
    acc[ai][bj][m][n] = __builtin_amdgcn_mfma_f32_16x16x32_bf16(Bt[n][k], At[m][k], acc[ai][bj][m][n], 0, 0, 0); __builtin_amdgcn_s_setprio(0); } while (0)
#define PG8_WAIT_V(n) asm volatile("s_waitcnt vmcnt(" #n ")" ::: "memory")
#define PG8_WAIT_L(n) asm volatile("s_waitcnt lgkmcnt(" #n ")" ::: "memory")
#define PG8_BAR __builtin_amdgcn_s_barrier()
#define PG8_SCHED __builtin_amdgcn_sched_barrier(0)
  Unit cur, nxt; int ui = 0;
  if (!S.next(0, cur)) return;
  f32x4 acc[2][2][4][2];
#pragma unroll
  for (int a = 0; a < 2; ++a)
#pragma unroll
    for (int b = 0; b < 2; ++b)
#pragma unroll
      for (int m = 0; m < 4; ++m)
#pragma unroll
        for (int n = 0; n < 2; ++n) acc[a][b][m][n] = (f32x4){0.f, 0.f, 0.f, 0.f};
  bf16x8 At[4][2], B0[2][2], B1[2][2];
  const char* cA = (const char*)g.A + (size_t)cur.pm * tstepA; const char* cB = (const char*)g.Bt + (size_t)cur.pn * tstepB;
  PG8_STAGE(PG8_SB(0, 0), cB, voffB); PG8_STAGE(PG8_SA(0, 0), cA, voffA); PG8_STAGE(PG8_SB(0, 1), cB + hstepB, voffB); PG8_STAGE(PG8_SA(0, 1), cA + hstepA, voffA);
  if (wr == 1) PG8_BAR;
  PG8_WAIT_V(4); PG8_BAR;
  PG8_STAGE(PG8_SB(1, 0), cB + kstep, voffB); PG8_STAGE(PG8_SA(1, 0), cA + kstep, voffA); PG8_STAGE(PG8_SB(1, 1), cB + hstepB + kstep, voffB);
  PG8_WAIT_V(6); PG8_BAR;
  for (;;) {
    const bool has_next = S.next(ui + 1, nxt);
    const char* nA = has_next ? (const char*)g.A + (size_t)nxt.pm * tstepA : cA; const char* nB = has_next ? (const char*)g.Bt + (size_t)nxt.pn * tstepB : cB;
    for (int t = 0; t < nt; t += 2) {
      const bool last = (t == nt - 2);
      const char* a1 = cA + (size_t)(t + 1) * kstep;
      const char* a2 = last ? nA : cA + (size_t)(t + 2) * kstep; const char* b2 = last ? nB : cB + (size_t)(t + 2) * kstep;
      const char* a3 = a2 + kstep; const char* b3 = b2 + kstep;
      PG8_LDB(B0, 0, 0); PG8_SCHED; PG8_LDA(At, 0, 0); PG8_STAGE(PG8_SA(1, 1), a1 + hstepA, voffA);
      PG8_WAIT_L(8); PG8_BAR; PG8_WAIT_L(0); PG8_MMA(0, 0, At, B0); PG8_BAR; PG8_SCHED;
      PG8_LDB(B1, 0, 1); PG8_STAGE(PG8_SB(0, 0), b2, voffB);
      PG8_BAR; PG8_WAIT_L(0); PG8_MMA(0, 1, At, B1); PG8_BAR;
      PG8_LDA(At, 0, 1); PG8_STAGE(PG8_SA(0, 0), a2, voffA);
      PG8_BAR; PG8_WAIT_L(0); PG8_MMA(1, 0, At, B0); PG8_BAR; PG8_SCHED;
      PG8_STAGE(PG8_SB(0, 1), b2 + hstepB, voffB);
      PG8_WAIT_V(6); PG8_BAR; PG8_MMA(1, 1, At, B1); PG8_BAR;
      PG8_LDB(B0, 1, 0); PG8_SCHED; PG8_LDA(At, 1, 0); PG8_STAGE(PG8_SA(0, 1), a2 + hstepA, voffA);
      PG8_WAIT_L(8); PG8_BAR; PG8_WAIT_L(0); PG8_MMA(0, 0, At, B0); PG8_BAR; PG8_SCHED;
      PG8_LDB(B1, 1, 1); PG8_STAGE(PG8_SB(1, 0), b3, voffB);
      PG8_BAR; PG8_WAIT_L(0); PG8_MMA(0, 1, At, B1); PG8_BAR;
      PG8_LDA(At, 1, 1); PG8_STAGE(PG8_SA(1, 0), a3, voffA);
      PG8_BAR; PG8_WAIT_L(0); PG8_MMA(1, 0, At, B0); PG8_BAR; PG8_SCHED;
      PG8_STAGE(PG8_SB(1, 1), b3 + hstepB, voffB);
      PG8_WAIT_V(6); PG8_BAR; PG8_MMA(1, 1, At, B1); PG8_BAR;
    }
    E(acc, cur, wr, wc, fr, fq);
    if (!has_next) break;
#pragma unroll
    for (int a = 0; a < 2; ++a)
#pragma unroll
      for (int b = 0; b < 2; ++b)
#pragma unroll
        for (int m = 0; m < 4; ++m)
#pragma unroll
          for (int n = 0; n < 2; ++n) acc[a][b][m][n] = (f32x4){0.f, 0.f, 0.f, 0.f};
    cur = nxt; cA = nA; cB = nB; ++ui;
  }
  PG8_WAIT_V(0);
  if (wr == 0) PG8_BAR;
  PG8_BAR;
#undef PG8_SA
#undef PG8_SB
#undef PG8_STAGE
#undef PG8_LDA
#undef PG8_LDB
#undef PG8_MMA
#undef PG8_WAIT_V
#undef PG8_WAIT_L
#undef PG8_BAR
#undef PG8_SCHED
}
}

struct Epi {
  bf16_t* out; int ldc;
  int rope64_end;
  int rope32_lo, rope32_hi;
  int qmode;
  const bf16_t* nsrc; int nld, nK;
  const float *cosH, *sinH, *cosR, *sinR;
  DI void operator()(const f32x4 (&acc)[2][2][4][2], const pg8::Unit& u, int wr, int wc, int fr, int fq) const {
    const int row0 = u.pm * 256 + wr * 64 + fr;
#pragma unroll
    for (int ai = 0; ai < 2; ++ai)
#pragma unroll
      for (int m = 0; m < 4; ++m) {
        const int row = row0 + ai * 128 + m * 16;
        const int pos = row & (SEQ - 1);
        float rs = 1.f;
        if (nsrc) {
          const int per = nK >> 2;
          const bf16_t* src = nsrc + (size_t)row * nld + fq * per;
          float ss = 0.f;
          for (int k = 0; k < per; k += 8) {
            const u32x4 v = *(const u32x4*)(src + k);
#pragma unroll
            for (int j = 0; j < 4; ++j) { const float a = bflo(v[j]), b = bfhi(v[j]); ss += a * a + b * b; }
          }
          ss += __shfl_xor(ss, 16); ss += __shfl_xor(ss, 32);
          rs = rsqrtf(ss / (float)nK + EPS);
        }
#pragma unroll
        for (int bj = 0; bj < 2; ++bj) {
          const int c0 = u.pn * 256 + bj * 128 + wc * 32 + 8 * fq;
          f32x4 v0 = acc[ai][bj][m][0] * rs, v1 = acc[ai][bj][m][1] * rs;
          const float* ct = nullptr; const float* st = nullptr;
          if (c0 < rope64_end) { const int i0 = ((c0 & 63) >> 3) * 4; ct = cosH + pos * 32 + i0; st = sinH + pos * 32 + i0; }
          else if (c0 >= rope32_lo && c0 < rope32_hi) { const int i0 = (((c0 - rope32_lo) & 31) >> 3) * 4; ct = cosR + pos * 16 + i0; st = sinR + pos * 16 + i0; }
          else if (qmode) { const int p = c0 % 96; if (p >= 64) { const int i0 = ((p - 64) >> 3) * 4; ct = cosR + pos * 16 + i0; st = sinR + pos * 16 + i0; } }
          if (ct) {
            const f32x4 cv = *(const f32x4*)ct, sv = *(const f32x4*)st;
            const f32x4 o1 = v0 * cv - v1 * sv, o2 = v1 * cv + v0 * sv;
            v0 = o1; v1 = o2;
          }
          u32x4 w; w.x = pk2(v0[0], v0[1]); w.y = pk2(v0[2], v0[3]); w.z = pk2(v1[0], v1[1]); w.w = pk2(v1[2], v1[3]);
          *(u32x4*)(out + (size_t)row * ldc + c0) = w;
        }
      }
  }
};

DI int ropeperm64(int p) { const int g = p >> 3, r = p & 7; return r < 4 ? 4 * g + r : 32 + 4 * g + (r - 4); }
DI int ropeperm32(int p) { const int g = p >> 3, r = p & 7; return r < 4 ? 4 * g + r : 16 + 4 * g + (r - 4); }
DI int srccol(int kind, int n) {
  if (kind == 0) {
    if (n < 512) return 672 + (n & ~63) + ropeperm64(n & 63);
    if (n < 640) return 1184 + ((n - 512) & ~63) + ropeperm64(n & 63);
    if (n < 768) return 1312 + (n - 640);
    if (n < 1792) return 1440 + (n - 768);
    if (n < 2176) return n - 1792;
    if (n < 2432) return 384 + (n - 2176);
    if (n < 2464) return 640 + ropeperm32(n - 2432);
    return -1;
  }
  if (kind == 1) {
    if (n < 1024) return (n & ~63) + ropeperm64(n & 63);
    if (n < 3072) return n;
    return 3080 + (n - 3072);
  }
  if (kind == 2) { const int hd = n / 96, p = n - hd * 96; return hd * 96 + (p < 64 ? p : 64 + ropeperm32(p - 64)); }
  return n;
}
DI void convert_tile(LAS unsigned char* lds, const float* W, int Nsrc, int K, bf16_t* Wt, int kind, const float* g, int tn, int tk) {
  const int tid = opaque_tid();
  LAS bf16_t* tile = (LAS bf16_t*)lds;
  const int nl = tid & 63, ks = tid >> 6;
  const int sc = srccol(kind, tn * 64 + nl);
#pragma unroll
  for (int kk = ks; kk < 64; kk += 8) {
    const int k = tk * 64 + kk;
    float v = 0.f;
    if (sc >= 0) { v = W[(size_t)k * Nsrc + sc]; if (g) v *= g[k]; }
    tile[nl * 72 + kk] = f2bf(v);
  }
  __syncthreads();
  { const int n2 = tid >> 3, ch = tid & 7;
    const u32x4 v = *(const LAS u32x4*)(tile + n2 * 72 + ch * 8);
    *(u32x4*)(Wt + (size_t)(tn * 64 + n2) * K + tk * 64 + ch * 8) = v; }
  __syncthreads();
}

DI void prologue(const Params& p, LAS unsigned char* lds) {
  const int tid = opaque_tid(), G = gridDim.x, bid = blockIdx.x;
  unsigned char* ws = p.ws;
  for (int idx = bid * 512 + tid; idx < 2048 * 48; idx += G * 512) {
    if (idx < 2048 * 32) {
      const int pos = idx >> 5, i = idx & 31;
      const float inv = 1.0f / powf(10000.f, (float)(2 * i) / 64.f);
      const float ang = (float)pos * inv;
      ((float*)(ws + WS_COSH))[idx] = (float)cos((double)ang); ((float*)(ws + WS_SINH))[idx] = (float)sin((double)ang);
    } else {
      const int j = idx - 2048 * 32; const int pos = j >> 4, i = j & 15;
      const float inv = 1.0f / powf(10000.f, (float)(2 * i) / 32.f);
      const float ang = (float)pos * inv;
      ((float*)(ws + WS_COSR))[j] = (float)cos((double)ang); ((float*)(ws + WS_SINR))[j] = (float)sin((double)ang);
    }
  }
  constexpr int NT0 = 40 * 16, NT1 = 64 * 16, NT2 = 12 * 6, NT3 = 16 * 4, NT4 = 16 * 16;
  constexpr int PER_I = NT0 + NT1 + NT2 + NT3 + 2 * NT4;
  for (int job = bid; job < 2 * PER_I; job += G) {
    const int i = job / PER_I; int j = job - i * PER_I;
    if (j < NT0) { convert_tile(lds, p.ev_w_in + (size_t)i * 1024 * 2464, 2464, 1024, (bf16_t*)(ws + WS_WEVIN + i * SZ_WEVIN), 0, nullptr, j / 16, j % 16); continue; }
    j -= NT0;
    if (j < NT1) { convert_tile(lds, p.od_w_in + (size_t)i * 1024 * 4104, 4104, 1024, (bf16_t*)(ws + WS_WODIN + i * SZ_WODIN), 1, nullptr, j / 16, j % 16); continue; }
    j -= NT1;
    if (j < NT2) { convert_tile(lds, p.ev_w_uq + (size_t)i * 384 * 768, 768, 384, (bf16_t*)(ws + WS_WUQ + i * SZ_WUQ), 2, p.ev_q_norm + i * 384, j / 6, j % 6); continue; }
    j -= NT2;
    if (j < NT3) { convert_tile(lds, p.ev_w_ukv + (size_t)i * 256 * 1024, 1024, 256, (bf16_t*)(ws + WS_WUKV + i * SZ_WUKV), 3, p.ev_kv_norm + i * 256, j / 4, j % 4); continue; }
    j -= NT3;
    if (j < NT4) { convert_tile(lds, p.ev_w_out + (size_t)i * 1024 * 1024, 1024, 1024, (bf16_t*)(ws + WS_WEVOUT + i * SZ_WOUT), 4, nullptr, j / 16, j % 16); continue; }
    j -= NT4;
    convert_tile(lds, p.od_w_out + (size_t)i * 1024 * 1024, 1024, 1024, (bf16_t*)(ws + WS_WODOUT + i * SZ_WOUT), 4, nullptr, j / 16, j % 16);
  }
  const int item0 = G - 1 - bid;
  if (item0 < 192) {
    LAS float* cond = (LAS float*)lds;
    LAS float* red = (LAS float*)(lds + 65536);
    for (int e = tid; e < 16 * 1024; e += 512) { const int b = e >> 10, k = e & 1023; cond[k * 16 + b] = silu_f(p.c[e]); }
    __syncthreads();
    for (int item = item0; item < 192; item += G) {
      const int l = item / 48, n0 = (item % 48) * 64;
      const int col = tid & 63, kg = tid >> 6;
      float a[16];
#pragma unroll
      for (int b = 0; b < 16; ++b) a[b] = 0.f;
      const float* wp = p.w_ada + (size_t)l * 1024 * 3072 + n0 + col;
      for (int k = kg * 128; k < kg * 128 + 128; ++k) {
        const float w = wp[(size_t)k * 3072];
#pragma unroll
        for (int b4 = 0; b4 < 4; ++b4) { const f32x4 cv = *(const LAS f32x4*)(cond + k * 16 + b4 * 4);
          a[b4 * 4 + 0] += cv[0] * w; a[b4 * 4 + 1] += cv[1] * w; a[b4 * 4 + 2] += cv[2] * w; a[b4 * 4 + 3] += cv[3] * w; }
      }
#pragma unroll
      for (int b = 0; b < 16; ++b) red[(kg * 16 + b) * 64 + col] = a[b];
      __syncthreads();
      for (int e = tid; e < 1024; e += 512) { const int b = e >> 6, cc = e & 63; float s = 0.f;
#pragma unroll
        for (int k8 = 0; k8 < 8; ++k8) s += red[(k8 * 16 + b) * 64 + cc];
        ((float*)(ws + WS_MOD))[((size_t)l * 16 + b) * 3072 + n0 + cc] = s + p.b_ada[l * 3072 + n0 + cc]; }
      __syncthreads();
    }
  }
}

DI void rowwise_phase(const Params& p, int lp, int ln) {
  const int tid = opaque_tid(), lane = tid & 63, wid = tid >> 6;
  const int gw = blockIdx.x * 8 + wid, nw = gridDim.x * 8;
  unsigned char* ws = p.ws;
  const float* mod = (const float*)(ws + WS_MOD);
  const bf16_t* ybuf = (const bf16_t*)(ws + WS_HBUF);
  bf16_t* hbuf = (bf16_t*)(ws + WS_HBUF);
  const bool ff = (ln < 4) && (ln & 1);
  float wff[16][8];
  float fbias[8];
#pragma unroll
  for (int a = 0; a < 16; ++a)
#pragma unroll
    for (int h = 0; h < 8; ++h) wff[a][h] = 0.f;
#pragma unroll
  for (int h = 0; h < 8; ++h) fbias[h] = 0.f;
  if (ff) {
    const float* w = p.od_w_in + (size_t)(ln >> 1) * 1024 * 4104 + 3072;
#pragma unroll
    for (int j = 0; j < 4; ++j)
#pragma unroll
      for (int e = 0; e < 4; ++e) {
        const int c = 4 * lane + 256 * j + e;
        const f32x4 w0 = *(const f32x4*)(w + (size_t)c * 4104), w1 = *(const f32x4*)(w + (size_t)c * 4104 + 4);
        wff[j * 4 + e][0] = w0[0]; wff[j * 4 + e][1] = w0[1]; wff[j * 4 + e][2] = w0[2]; wff[j * 4 + e][3] = w0[3];
        wff[j * 4 + e][4] = w1[0]; wff[j * 4 + e][5] = w1[1]; wff[j * 4 + e][6] = w1[2]; wff[j * 4 + e][7] = w1[3];
      }
#pragma unroll
    for (int h = 0; h < 8; ++h) fbias[h] = p.od_forget_bias[(ln >> 1) * 8 + h];
  }
  for (int row = gw; row < T; row += nw) {
    const int b = row >> 11;
    f32x4 xv[4];
    const float* xin = (lp <= 0 ? p.x : p.out) + (size_t)row * DM;
#pragma unroll
    for (int j = 0; j < 4; ++j) xv[j] = *(const f32x4*)(xin + 4 * lane + 256 * j);
    if (lp >= 0) {
      f32x4 yv[4]; float ss = 0.f;
#pragma unroll
      for (int j = 0; j < 4; ++j) { const u32x2 u = *(const u32x2*)(ybuf + (size_t)row * DM + 4 * lane + 256 * j);
        yv[j] = (f32x4){bflo(u.x), bfhi(u.x), bflo(u.y), bfhi(u.y)}; ss += yv[j][0] * yv[j][0] + yv[j][1] * yv[j][1] + yv[j][2] * yv[j][2] + yv[j][3] * yv[j][3]; }
      ss = wave_sum(ss);
      const float rs = rsqrtf(ss * (1.f / DM) + EPS);
#pragma unroll
      for (int j = 0; j < 4; ++j) {
        const int c = 4 * lane + 256 * j;
        const f32x4 gt = *(const f32x4*)(mod + ((size_t)lp * 16 + b) * 3072 + 2048 + c);
        const f32x4 gp = *(const f32x4*)(p.g_post + lp * DM + c);
        xv[j] = xv[j] + gt * (yv[j] * rs * gp);
        *(f32x4*)(p.out + (size_t)row * DM + c) = xv[j];
      }
    }
    if (ln < 4) {
      float ss = 0.f;
#pragma unroll
      for (int j = 0; j < 4; ++j) ss += xv[j][0] * xv[j][0] + xv[j][1] * xv[j][1] + xv[j][2] * xv[j][2] + xv[j][3] * xv[j][3];
      ss = wave_sum(ss);
      const float rs = rsqrtf(ss * (1.f / DM) + EPS);
      float zf[8];
#pragma unroll
      for (int h = 0; h < 8; ++h) zf[h] = 0.f;
#pragma unroll
      for (int j = 0; j < 4; ++j) {
        const int c = 4 * lane + 256 * j;
        const f32x4 sh = *(const f32x4*)(mod + ((size_t)ln * 16 + b) * 3072 + c);
        const f32x4 sc = *(const f32x4*)(mod + ((size_t)ln * 16 + b) * 3072 + 1024 + c);
        const f32x4 gp = *(const f32x4*)(p.g_pre + ln * DM + c);
        const f32x4 hv = (xv[j] * rs * gp) * (sc + 1.f) + sh;
        u32x2 w; w.x = pk2(hv[0], hv[1]); w.y = pk2(hv[2], hv[3]);
        *(u32x2*)(hbuf + (size_t)row * DM + c) = w;
        if (ff) {
#pragma unroll
          for (int e = 0; e < 4; ++e)
#pragma unroll
            for (int h = 0; h < 8; ++h) zf[h] += hv[e] * wff[j * 4 + e][h];
        }
      }
      if (ff) {
#pragma unroll
        for (int h = 0; h < 8; ++h) zf[h] = wave_sum(zf[h]);
        if (lane < 8) {
          float z = 0.f;
#pragma unroll
          for (int h = 0; h < 8; ++h) z = (lane == h) ? zf[h] + fbias[h] : z;
          const float ls = fminf(z, 0.f) - log1pf(expf(-fabsf(z)));
          ((float*)(ws + WS_LOGF))[(size_t)row * 8 + lane] = ls;
        }
      }
    }
  }
}

DI void fox_scan(const Params& p, LAS unsigned char* lds, int bh) {
  const int tid = opaque_tid();
  const int b = bh >> 3, h = bh & 7;
  const float* logf_ = (const float*)(p.ws + WS_LOGF);
  float* fcum = (float*)(p.ws + WS_FCUM) + (size_t)bh * SEQ;
  LAS float* s = (LAS float*)lds;
  float v[4];
#pragma unroll
  for (int j = 0; j < 4; ++j) v[j] = logf_[((size_t)b * SEQ + 4 * tid + j) * 8 + h];
  v[1] += v[0]; v[2] += v[1]; v[3] += v[2];
  s[tid] = v[3];
  __syncthreads();
  for (int off = 1; off < 512; off <<= 1) {
    float t = 0.f;
    if (tid >= off) t = s[tid - off];
    __syncthreads();
    s[tid] += t;
    __syncthreads();
  }
  const float excl = s[tid] - v[3];
#pragma unroll
  for (int j = 0; j < 4; ++j) fcum[4 * tid + j] = excl + v[j];
  __syncthreads();
}

struct AttnArgs { const bf16_t *q, *k, *k2, *v, *gate; bf16_t* out; const float* fcum; int ldq, ldk, ldk2, ldv, ldo, ldg; float sl2, sink; };

template <int DQK, int DV, int MODE>
DI void attn_item(LAS unsigned char* lds, const AttnArgs& a, int qb) {
  constexpr int KSTR = DQK * 2 + 16, VSTR = DV * 2 + 16;
  constexpr int KBYTES = 64 * KSTR, VBYTES = 64 * VSTR, FBYTES = 256;
  constexpr int BUF = KBYTES + VBYTES + FBYTES;
  constexpr int NKS = DQK / 16, NBLK = DV / 32, NVR = DV / 64;
  const int tid = opaque_tid(), wid = __builtin_amdgcn_readfirstlane(tid >> 6), lane = tid & 63, r = lane & 31, hh = lane >> 5;
  const int q0 = qb * 256, qw = q0 + 32 * wid, myq = qw + r;
  bf16x8 qf[NKS];
#pragma unroll
  for (int ks = 0; ks < NKS; ++ks) qf[ks] = *(const bf16x8*)(a.q + (size_t)myq * a.ldq + 16 * ks + 8 * hh);
  int kt_lo = 0; const int kt_hi = 4 * (qb + 1);
  if (MODE == 1) { kt_lo = 4 * qb - 2; if (kt_lo < 0) kt_lo = 0; }
  f32x16 O[NBLK];
#pragma unroll
  for (int bl = 0; bl < NBLK; ++bl)
#pragma unroll
    for (int i = 0; i < 16; ++i) O[bl][i] = 0.f;
  float m = (MODE == 1) ? a.sink : -1e30f;
  float l = (MODE == 1 && hh == 0) ? 1.f : 0.f;
  u32x4 kreg0, kreg1 = {0, 0, 0, 0}, vreg[NVR]; float freg = 0.f;
  const int krow = tid >> 3, kch = tid & 7, krow2 = tid >> 2, kch2 = tid & 3;
  auto gload = [&](int kt) {
    const int key0 = kt * 64;
    kreg0 = *(const u32x4*)(a.k + (size_t)(key0 + krow) * a.ldk + 8 * kch);
    if (DQK == 96) { if (tid < 256) kreg1 = *(const u32x4*)(a.k2 + (size_t)(key0 + krow2) * a.ldk2 + 8 * kch2); }
#pragma unroll
    for (int j = 0; j < NVR; ++j) { const int idx = tid + 512 * j; const int vrow = idx / (DV / 8), vch = idx % (DV / 8);
      vreg[j] = *(const u32x4*)(a.v + (size_t)(key0 + vrow) * a.ldv + 8 * vch); }
    if (MODE == 2) { if (tid < 64) freg = a.fcum[key0 + tid] * (-LOG2E); }
  };
  auto lstore = [&](int buf) {
    LAS unsigned char* base = lds + buf * BUF;
    *(LAS u32x4*)(base + krow * KSTR + kch * 16) = kreg0;
    if (DQK == 96) { if (tid < 256) *(LAS u32x4*)(base + krow2 * KSTR + 128 + kch2 * 16) = kreg1; }
#pragma unroll
    for (int j = 0; j < NVR; ++j) { const int idx = tid + 512 * j; const int vrow = idx / (DV / 8), vch = idx % (DV / 8);
      *(LAS u32x4*)(base + KBYTES + vrow * VSTR + vch * 16) = vreg[j]; }
    if (MODE == 2) { if (tid < 64) *(LAS float*)(base + KBYTES + VBYTES + tid * 4) = freg; }
  };
  const int i16 = lane & 15, q4 = i16 >> 2, p4 = i16 & 3, grp = (lane >> 4) & 1;
  gload(kt_lo); lstore(0); __syncthreads();
  int cur = 0;
  for (int kt = kt_lo; kt < kt_hi; ++kt) {
    const bool more = (kt + 1 < kt_hi);
    if (more) gload(kt + 1);
    const int key0 = kt * 64;
    bool active = (key0 <= qw + 31);
    if (MODE == 1) active = active && (key0 + 63 > qw - 128);
    if (active) {
      LAS unsigned char* Kl = lds + cur * BUF; LAS unsigned char* Vl = Kl + KBYTES; LAS unsigned char* Fl = Vl + VBYTES;
      f32x16 s[2];
#pragma unroll
      for (int kb = 0; kb < 2; ++kb) {
#pragma unroll
        for (int i = 0; i < 16; ++i) s[kb][i] = 0.f;
#pragma unroll
        for (int ks = 0; ks < NKS; ++ks) {
          const bf16x8 kf = *(const LAS bf16x8*)(Kl + (32 * kb + r) * KSTR + (16 * ks + 8 * hh) * 2);
          s[kb] = __builtin_amdgcn_mfma_f32_32x32x16_bf16(kf, qf[ks], s[kb], 0, 0, 0);
        }
      }
      const bool needmask = (MODE == 1) || (key0 + 63 > qw);
      float mx = -1e30f;
#pragma unroll
      for (int kb = 0; kb < 2; ++kb)
#pragma unroll
        for (int g = 0; g < 4; ++g) {
          f32x4 fb = {0.f, 0.f, 0.f, 0.f};
          if (MODE == 2) fb = *(const LAS f32x4*)(Fl + (32 * kb + 8 * g + 4 * hh) * 4);
#pragma unroll
          for (int e = 0; e < 4; ++e) {
            const int i = 4 * g + e;
            const int key = key0 + 32 * kb + 8 * g + 4 * hh + e;
            float v = s[kb][i] * a.sl2 + fb[e];
            if (needmask) { bool valid = key <= myq; if (MODE == 1) valid = valid && (myq - key < 128); v = valid ? v : -1e30f; }
            s[kb][i] = v; mx = fmaxf(mx, v);
          }
        }
      mx = fmaxf(mx, __shfl_xor(mx, 32));
      const float mnew = fmaxf(m, mx);
      const float alpha = fast_exp2(m - mnew);
      m = mnew;
      float psum = 0.f;
#pragma unroll
      for (int kb = 0; kb < 2; ++kb)
#pragma unroll
        for (int i = 0; i < 16; ++i) { const float pv = fast_exp2(s[kb][i] - mnew); psum += pv; s[kb][i] = pv; }
      l = l * alpha + psum;
#pragma unroll
      for (int bl = 0; bl < NBLK; ++bl)
#pragma unroll
        for (int i = 0; i < 16; ++i) O[bl][i] *= alpha;
      bf16x8 pf[2][2];
#pragma unroll
      for (int kb = 0; kb < 2; ++kb)
#pragma unroll
        for (int s2 = 0; s2 < 2; ++s2) {
          u32x4 w;
          w.x = pk2(s[kb][8 * s2 + 0], s[kb][8 * s2 + 1]); w.y = pk2(s[kb][8 * s2 + 2], s[kb][8 * s2 + 3]);
          w.z = pk2(s[kb][8 * s2 + 4], s[kb][8 * s2 + 5]); w.w = pk2(s[kb][8 * s2 + 6], s[kb][8 * s2 + 7]);
          pf[kb][s2] = __builtin_bit_cast(bf16x8, w);
        }
#pragma unroll
      for (int bl = 0; bl < NBLK; ++bl)
#pragma unroll
        for (int kb = 0; kb < 2; ++kb)
#pragma unroll
          for (int s2 = 0; s2 < 2; ++s2) {
            LAS unsigned char* ad = Vl + (32 * kb + 16 * s2 + 4 * hh + q4) * VSTR + (32 * bl + 16 * grp) * 2 + 8 * p4;
            const s16x4 lo = __builtin_amdgcn_ds_read_tr16_b64_v4i16((LAS s16x4*)ad);
            const s16x4 hi = __builtin_amdgcn_ds_read_tr16_b64_v4i16((LAS s16x4*)(ad + 8 * VSTR));
            const bf16x8 vf = __builtin_shufflevector(lo, hi, 0, 1, 2, 3, 4, 5, 6, 7);
            O[bl] = __builtin_amdgcn_mfma_f32_32x32x16_bf16(vf, pf[kb][s2], O[bl], 0, 0, 0);
          }
    }
    if (more) lstore(cur ^ 1);
    __syncthreads();
    cur ^= 1;
  }
  l += __shfl_xor(l, 32);
  const float inv = 1.f / l;
#pragma unroll
  for (int bl = 0; bl < NBLK; ++bl)
#pragma unroll
    for (int g = 0; g < 4; ++g) {
      const int f = 32 * bl + 8 * g + 4 * hh;
      float o0 = O[bl][4 * g + 0] * inv, o1 = O[bl][4 * g + 1] * inv, o2 = O[bl][4 * g + 2] * inv, o3 = O[bl][4 * g + 3] * inv;
      if (a.gate) {
        const u32x2 gv = *(const u32x2*)(a.gate + (size_t)myq * a.ldg + f);
        o0 *= silu_f(bflo(gv.x)); o1 *= silu_f(bfhi(gv.x)); o2 *= silu_f(bflo(gv.y)); o3 *= silu_f(bfhi(gv.y));
      }
      u32x2 w; w.x = pk2(o0, o1); w.y = pk2(o2, o3);
      *(u32x2*)(a.out + (size_t)myq * a.ldo + f) = w;
    }
}

DI int snake_idx(int round, int G, int c) { return round * G + ((round & 1) ? (G - 1 - c) : c); }

DI void attn_even(const Params& p, LAS unsigned char* lds, int i) {
  const int G = gridDim.x, c = blockIdx.x;
  unsigned char* ws = p.ws;
  const bf16_t* z = (const bf16_t*)(ws + WS_ZBUF);
  const bf16_t* qb_ = (const bf16_t*)(ws + WS_QBUF);
  const bf16_t* kv = (const bf16_t*)(ws + WS_HBUF);
  bf16_t* ob = (bf16_t*)(ws + WS_OBUF);
  for (int rd = 0; rd * G < 1024; ++rd) {
    const int idx = snake_idx(rd, G, c);
    if (idx >= 1024) continue;
    const int qb = 7 - idx / 128, bh = idx % 128, b = bh >> 3, hd = bh & 7;
    AttnArgs a;
    a.q = qb_ + (size_t)b * SEQ * 768 + hd * 96; a.ldq = 768;
    a.k = kv + (size_t)b * SEQ * 1024 + hd * 128; a.ldk = 1024;
    a.k2 = z + (size_t)b * SEQ * 2560 + 2432; a.ldk2 = 2560;
    a.v = kv + (size_t)b * SEQ * 1024 + hd * 128 + 64; a.ldv = 1024;
    a.out = ob + (size_t)b * SEQ * 1024 + hd * 64; a.ldo = 1024;
    a.gate = z + (size_t)b * SEQ * 2560 + 768 + hd * 64; a.ldg = 2560;
    a.fcum = nullptr; a.sl2 = 0.10206207261596577f * LOG2E; a.sink = 0.f;
    attn_item<96, 64, 0>(lds, a, qb);
  }
  for (int rd = 0; rd * G < 1024; ++rd) {
    const int idx = snake_idx(rd, G, c);
    if (idx >= 1024) continue;
    const int qb = 7 - idx / 128, bh = idx % 128, b = bh >> 3, hd = bh & 7, kvh = hd >> 2;
    AttnArgs a;
    const bf16_t* zb = z + (size_t)b * SEQ * 2560;
    a.q = zb + hd * 64; a.ldq = 2560;
    a.k = zb + 512 + kvh * 64; a.ldk = 2560; a.k2 = nullptr; a.ldk2 = 0;
    a.v = zb + 640 + kvh * 64; a.ldv = 2560;
    a.out = ob + (size_t)b * SEQ * 1024 + 512 + hd * 64; a.ldo = 1024;
    a.gate = zb + 768 + 512 + hd * 64; a.ldg = 2560;
    a.fcum = nullptr; a.sl2 = 0.125f * LOG2E; a.sink = p.ev_sinks[i * 8 + hd] * LOG2E;
    attn_item<64, 64, 1>(lds, a, qb);
  }
}

DI void attn_odd(const Params& p, LAS unsigned char* lds) {
  const int G = gridDim.x, c = blockIdx.x;
  unsigned char* ws = p.ws;
  const bf16_t* z = (const bf16_t*)(ws + WS_ZBUF);
  bf16_t* od = (bf16_t*)(ws + WS_HBUF);
  bf16_t* ob = (bf16_t*)(ws + WS_OBUF);
  for (int rd = 0; rd * G < 1024; ++rd) {
    const int idx = snake_idx(rd, G, c);
    if (idx >= 1024) continue;
    const int qb = 7 - idx / 128, bh = idx % 128, b = bh >> 3, j = bh & 7;
    AttnArgs a;
    const bf16_t* zb = z + (size_t)b * SEQ * 4096;
    a.q = zb + j * 64; a.ldq = 4096;
    a.k = zb + 512 + j * 64; a.ldk = 4096; a.k2 = nullptr; a.ldk2 = 0;
    a.v = zb + 1024 + (j >> 1) * 128; a.ldv = 4096;
    a.out = od + (size_t)b * SEQ * 1024 + j * 128; a.ldo = 1024;
    a.gate = nullptr; a.ldg = 0;
    a.fcum = nullptr; a.sl2 = 0.125f * LOG2E; a.sink = 0.f;
    attn_item<64, 128, 0>(lds, a, qb);
  }
  for (int rd = 0; rd * G < 1024; ++rd) {
    const int idx = snake_idx(rd, G, c);
    if (idx >= 1024) continue;
    const int qb = 7 - idx / 128, bh = idx % 128, b = bh >> 3, hd = bh & 7;
    AttnArgs a;
    const bf16_t* zb = z + (size_t)b * SEQ * 4096;
    a.q = zb + 1536 + hd * 64; a.ldq = 4096;
    a.k = zb + 2048 + hd * 64; a.ldk = 4096; a.k2 = nullptr; a.ldk2 = 0;
    a.v = zb + 2560 + hd * 64; a.ldv = 4096;
    a.out = ob + (size_t)b * SEQ * 1024 + 512 + hd * 64; a.ldo = 1024;
    a.gate = zb + 3072 + 512 + hd * 64; a.ldg = 4096;
    a.fcum = (const float*)(ws + WS_FCUM) + (size_t)bh * SEQ; a.sl2 = 0.125f * LOG2E; a.sink = 0.f;
    attn_item<64, 64, 2>(lds, a, qb);
  }
}

DI void diff_combine(const Params& p, int layer) {
  const int tid = opaque_tid(), lane = tid & 63, wid = tid >> 6;
  const int gw = blockIdx.x * 8 + wid, nw = gridDim.x * 8;
  const int i = layer >> 1;
  unsigned char* ws = p.ws;
  const bf16_t* od = (const bf16_t*)(ws + WS_HBUF);
  const bf16_t* z = (const bf16_t*)(ws + WS_ZBUF);
  bf16_t* ob = (bf16_t*)(ws + WS_OBUF);
  const float* lp = p.od_lambda + i * 256;
  const float s1 = wave_sum(lp[lane] * lp[64 + lane]), s2 = wave_sum(lp[128 + lane] * lp[192 + lane]);
  const float lam_init = 0.8f - 0.6f * expf(-0.3f * (float)layer);
  const float lam = expf(s1) - expf(s2) + lam_init;
  const int hd = lane >> 4, dv = (lane & 15) * 8;
  float sub[8];
#pragma unroll
  for (int e = 0; e < 8; ++e) sub[e] = p.od_subln[i * 128 + dv + e] * (1.f - lam_init);
  for (int row = gw; row < T; row += nw) {
    const u32x4 a = *(const u32x4*)(od + (size_t)row * 1024 + (2 * hd) * 128 + dv);
    const u32x4 b = *(const u32x4*)(od + (size_t)row * 1024 + (2 * hd + 1) * 128 + dv);
    const u32x4 g = *(const u32x4*)(z + (size_t)row * 4096 + 3072 + hd * 128 + dv);
    float d[8]; float ss = 0.f;
#pragma unroll
    for (int e = 0; e < 4; ++e) { d[2 * e] = bflo(a[e]) - lam * bflo(b[e]); d[2 * e + 1] = bfhi(a[e]) - lam * bfhi(b[e]); ss += d[2 * e] * d[2 * e] + d[2 * e + 1] * d[2 * e + 1]; }
    ss += __shfl_xor(ss, 1); ss += __shfl_xor(ss, 2); ss += __shfl_xor(ss, 4); ss += __shfl_xor(ss, 8);
    const float rs = rsqrtf(ss * (1.f / 128.f) + EPS);
    u32x4 w;
#pragma unroll
    for (int e = 0; e < 4; ++e) {
      const float o0 = d[2 * e] * rs * sub[2 * e] * silu_f(bflo(g[e])), o1 = d[2 * e + 1] * rs * sub[2 * e + 1] * silu_f(bfhi(g[e]));
      w[e] = pk2(o0, o1);
    }
    *(u32x4*)(ob + (size_t)row * 1024 + hd * 128 + dv) = w;
  }
}

__global__ void __launch_bounds__(512) fwd_megakernel(Params p) {
  extern __shared__ __attribute__((aligned(16))) unsigned char lds_raw[];
  LAS unsigned char* lds = (LAS unsigned char*)lds_raw;
  cg::grid_group grid = cg::this_grid();
  unsigned char* ws = p.ws;
  const int G = gridDim.x, bid = blockIdx.x;
  const float* cosH = (const float*)(ws + WS_COSH); const float* sinH = (const float*)(ws + WS_SINH);
  const float* cosR = (const float*)(ws + WS_COSR); const float* sinR = (const float*)(ws + WS_SINR);

#ifndef SKIP_PRO
  prologue(p, lds);
#endif
  grid.sync();
#pragma unroll
  for (int layer = 0; layer < 4; ++layer) {
    const int i = layer >> 1; const bool odd = layer & 1;
#ifndef SKIP_ROW
    rowwise_phase(p, layer - 1, layer);
#endif
    grid.sync();
    {
#ifndef SKIP_SCAN
      if (odd && bid < 128) fox_scan(p, lds, bid);
#endif
      pg8::Gemm g; g.A = (const bf16_t*)(ws + WS_HBUF); g.lda = 1024; g.K = 1024; g.M = T;
      Epi e; e.out = (bf16_t*)(ws + WS_ZBUF); e.nsrc = nullptr; e.nld = 0; e.nK = 0; e.qmode = 0; e.cosH = cosH; e.sinH = sinH; e.cosR = cosR; e.sinR = sinR;
      if (!odd) { g.Bt = (const bf16_t*)(ws + WS_WEVIN + i * SZ_WEVIN); g.N = 2560; e.ldc = 2560; e.rope64_end = 640; e.rope32_lo = 2432; e.rope32_hi = 2464; }
      else { g.Bt = (const bf16_t*)(ws + WS_WODIN + i * SZ_WODIN); g.N = 4096; e.ldc = 4096; e.rope64_end = 1024; e.rope32_lo = 0; e.rope32_hi = 0; }
      pg8::StaticOrder S; S.init(g.M, g.N, G, bid);
#ifndef SKIP_G1
      pg8::gemm_phase<Epi>(lds, g, S, e);
#endif
    }
    grid.sync();
    if (!odd) {
      for (int which = 0; which < 2; ++which) {
        pg8::Gemm g; g.M = T; g.lda = 2560;
        Epi e; e.rope64_end = 0; e.rope32_lo = 0; e.rope32_hi = 0; e.cosH = cosH; e.sinH = sinH; e.cosR = cosR; e.sinR = sinR; e.nld = 2560;
        if (which == 0) { g.A = (const bf16_t*)(ws + WS_ZBUF) + 1792; g.Bt = (const bf16_t*)(ws + WS_WUQ + i * SZ_WUQ); g.N = 768; g.K = 384;
          e.out = (bf16_t*)(ws + WS_QBUF); e.ldc = 768; e.qmode = 1; e.nsrc = g.A; e.nK = 384; }
        else { g.A = (const bf16_t*)(ws + WS_ZBUF) + 2176; g.Bt = (const bf16_t*)(ws + WS_WUKV + i * SZ_WUKV); g.N = 1024; g.K = 256;
          e.out = (bf16_t*)(ws + WS_HBUF); e.ldc = 1024; e.qmode = 0; e.nsrc = g.A; e.nK = 256; }
        pg8::StaticOrder S; S.init(g.M, g.N, G, bid);
#ifndef SKIP_G2
        pg8::gemm_phase<Epi>(lds, g, S, e);
#endif
      }
      grid.sync();
#ifndef SKIP_ATTE
      attn_even(p, lds, i);
#endif
      grid.sync();
    } else {
#ifndef SKIP_ATTO
      attn_odd(p, lds);
#endif
      grid.sync();
#ifndef SKIP_COMB
      diff_combine(p, layer);
#endif
      grid.sync();
    }
    {
      pg8::Gemm g; g.A = (const bf16_t*)(ws + WS_OBUF); g.lda = 1024; g.K = 1024; g.M = T; g.N = 1024;
      g.Bt = (const bf16_t*)(ws + (odd ? WS_WODOUT : WS_WEVOUT) + i * SZ_WOUT);
      Epi e; e.out = (bf16_t*)(ws + WS_HBUF); e.ldc = 1024; e.nsrc = nullptr; e.nld = 0; e.nK = 0; e.qmode = 0; e.rope64_end = 0; e.rope32_lo = 0; e.rope32_hi = 0;
      e.cosH = cosH; e.sinH = sinH; e.cosR = cosR; e.sinR = sinR;
      pg8::StaticOrder S; S.init(g.M, g.N, G, bid);
#ifndef SKIP_G3
      pg8::gemm_phase<Epi>(lds, g, S, e);
#endif
    }
    grid.sync();
  }
#ifndef SKIP_ROW
  rowwise_phase(p, 3, 4);
#endif
}

constexpr int LDS_BYTES = 131072;

extern "C" void kernel_launch(void* const* d_in, const int* in_sizes, int n_in, void* d_out, int out_size, void* d_ws, size_t ws_size, hipStream_t stream) {
  static int grid_blocks = 0;
  if (grid_blocks == 0) {
    int dev = 0, cus = 0, per_cu = 0;
    if (hipGetDevice(&dev) != hipSuccess || hipDeviceGetAttribute(&cus, hipDeviceAttributeMultiprocessorCount, dev) != hipSuccess) { fprintf(stderr, "device query failed\n"); grid_blocks = -1; return; }
    if (hipFuncSetAttribute((const void*)fwd_megakernel, hipFuncAttributeMaxDynamicSharedMemorySize, LDS_BYTES) != hipSuccess) { fprintf(stderr, "hipFuncSetAttribute failed\n"); grid_blocks = -1; return; }
    if (hipOccupancyMaxActiveBlocksPerMultiprocessor(&per_cu, (const void*)fwd_megakernel, 512, LDS_BYTES) != hipSuccess || per_cu < 1) { fprintf(stderr, "occupancy query: %d\n", per_cu); per_cu = 1; }
    (void)hipGetLastError();
    grid_blocks = cus;
    if (ws_size < WS_END) { fprintf(stderr, "workspace too small: %zu < %zu\n", ws_size, (size_t)WS_END); grid_blocks = -1; return; }
  }
  if (grid_blocks < 0) return;
  Params p{};
  const float** fp = (const float**)&p;
  for (int i = 0; i < 18; ++i) fp[i] = (const float*)d_in[i];
  p.out = (float*)d_out; p.ws = (unsigned char*)d_ws;
  void* args[] = {&p};
  hipError_t e = hipLaunchCooperativeKernel((const void*)fwd_megakernel, dim3(grid_blocks), dim3(512), args, LDS_BYTES, stream);
  if (e != hipSuccess) fprintf(stderr, "cooperative launch failed: %s (grid %d)\n", hipGetErrorString(e), grid_blocks);
}
```

```cpp
#include <hip/hip_runtime.h>
#include <hip/hip_cooperative_groups.h>
#include <cstdio>
namespace cg = cooperative_groups;

#define DI __device__ __forceinline__
#define LAS __attribute__((address_space(3)))
typedef unsigned short bf16_t;
typedef short bf16x8 __attribute__((ext_vector_type(8)));
typedef short s16x4 __attribute__((ext_vector_type(4)));
typedef float f32x2 __attribute__((ext_vector_type(2)));
typedef float f32x4 __attribute__((ext_vector_type(4)));
typedef float f32x16 __attribute__((ext_vector_type(16)));
typedef unsigned u32x2 __attribute__((ext_vector_type(2)));
typedef unsigned u32x4 __attribute__((ext_vector_type(4)));
typedef __bf16 bf16x2_t __attribute__((ext_vector_type(2)));

constexpr int T = 32768, DM = 1024, NB = 16, SEQ = 2048;
constexpr float LOG2E = 1.4426950408889634f;
constexpr float EPS = 1e-6f;

constexpr size_t SZ_WEVIN = 2560ull * 1024 * 2, SZ_WODIN = 4096ull * 1024 * 2, SZ_WUQ = 768ull * 384 * 2, SZ_WUKV = 1024ull * 256 * 2, SZ_WOUT = 1024ull * 1024 * 2;
constexpr size_t WS_WEVIN = 0;
constexpr size_t WS_WODIN = WS_WEVIN + 2 * SZ_WEVIN;
constexpr size_t WS_WUQ = WS_WODIN + 2 * SZ_WODIN;
constexpr size_t WS_WUKV = WS_WUQ + 2 * SZ_WUQ;
constexpr size_t WS_WEVOUT = WS_WUKV + 2 * SZ_WUKV;
constexpr size_t WS_WODOUT = WS_WEVOUT + 2 * SZ_WOUT;
constexpr size_t WS_MOD = WS_WODOUT + 2 * SZ_WOUT;
constexpr size_t WS_COSH = WS_MOD + 4ull * 16 * 3072 * 4;
constexpr size_t WS_SINH = WS_COSH + 2048ull * 32 * 4;
constexpr size_t WS_COSR = WS_SINH + 2048ull * 32 * 4;
constexpr size_t WS_SINR = WS_COSR + 2048ull * 16 * 4;
constexpr size_t WS_LOGF = WS_SINR + 2048ull * 16 * 4;
constexpr size_t WS_FCUM = WS_LOGF + (size_t)T * 8 * 4;
constexpr size_t WS_HBUF = (WS_FCUM + (size_t)T * 8 * 4 + 4095) & ~(size_t)4095;
constexpr size_t WS_OBUF = WS_HBUF + (size_t)T * 1024 * 2;
constexpr size_t WS_ZBUF = WS_OBUF + (size_t)T * 1024 * 2;
constexpr size_t WS_QBUF = WS_ZBUF + (size_t)T * 2560 * 2;
constexpr size_t WS_BAR = WS_ZBUF + (size_t)T * 4096 * 2;
constexpr size_t WS_END = WS_BAR + 256;

struct Params {
  const float *x, *c, *w_ada, *b_ada, *g_pre, *g_post, *ev_w_in, *ev_q_norm, *ev_kv_norm, *ev_w_uq, *ev_w_ukv, *ev_sinks, *ev_w_out,
      *od_w_in, *od_forget_bias, *od_lambda, *od_subln, *od_w_out;
  float* out;
  unsigned char* ws;
};

DI int opaque_tid() { int t = threadIdx.x; asm volatile("" : "+v"(t)); return t; }
DI float bflo(unsigned u) { return __uint_as_float(u << 16); }
DI float bfhi(unsigned u) { return __uint_as_float(u & 0xffff0000u); }
DI unsigned pk2(float lo, float hi) { f32x2 f = {lo, hi}; bf16x2_t b = __builtin_convertvector(f, bf16x2_t); return __builtin_bit_cast(unsigned, b); }
DI bf16_t f2bf(float f) { return (bf16_t)(pk2(f, 0.f) & 0xffffu); }
DI float fast_exp2(float x) { return __builtin_amdgcn_exp2f(x); }
DI float silu_f(float x) { return x * __builtin_amdgcn_rcpf(1.f + fast_exp2(-x * LOG2E)); }
DI float wave_sum(float v) {
#pragma unroll
  for (int o = 32; o >= 1; o >>= 1) v += __shfl_xor(v, o);
  return v;
}

namespace pg8 {
constexpr int BM = 256, BK = 64, HALF = 128, HTB = HALF * BK * 2, STAGE_BYTES = 8 * HTB, NXCD = 8, WGM = 8;
DI int lds_byte(int r, int c) { const int st = (r >> 4) * 2 + (c >> 5), rr = r & 15, cc = c & 31, ob = rr * 64 + cc * 2; return st * 1024 + (ob ^ (((ob >> 9) & 1) << 5)); }
DI void stage_rc(int b, int& R, int& C) { const int st = b / 1024, sb = b % 1024, swz = sb ^ (((sb >> 9) & 1) << 5); R = (st >> 1) * 16 + swz / 64; C = (st & 1) * 32 + (swz % 64) / 2; }
DI int perm32(int rho) { const int n = rho >> 4, i = rho & 15; return 8 * (i >> 2) + 4 * n + (i & 3); }
struct Unit { int pm, pn; };
struct Gemm { const bf16_t* A; const bf16_t* Bt; int M, N, K, lda; };
struct StaticOrder {
  int nM, nN, nwg, G, c;
  DI void init(int M, int N, int G_, int c_) { nM = M / BM; nN = N / BM; nwg = nM * nN; G = G_; c = c_; }
  DI bool next(int i, Unit& u) const {
    const long L = (long)i * G + c; if (L >= nwg) return false;
    int wgid = (int)L; { const int q = nwg / NXCD, r = nwg % NXCD, xcd = wgid % NXCD, off = wgid / NXCD; wgid = (xcd < r ? xcd * (q + 1) : r * (q + 1) + (xcd - r) * q) + off; }
    const int nig = WGM * nN, gid = wgid / nig, fm = gid * WGM, gsz = (nM - fm) < WGM ? (nM - fm) : WGM;
    u.pm = fm + ((wgid % nig) % gsz); u.pn = (wgid % nig) / gsz; return true;
  }
};

template <class Epi>
DI void gemm_phase(LAS unsigned char* lds, const Gemm g, const StaticOrder& S, const Epi& E) {
  const int tid = opaque_tid(), wid = __builtin_amdgcn_readfirstlane(tid >> 6), lane = tid & 63, wr = wid >> 2, wc = wid & 3, fr = lane & 15, fq = lane >> 4;
  const int K = g.K, nt = K / BK, lda = g.lda;
  unsigned voffA[2], voffB[2];
#pragma unroll
  for (int i = 0; i < 2; ++i) { int R, C; stage_rc(tid * 16 + i * 8192, R, C); const int Rb = (R & ~31) + perm32(R & 31);
    voffA[i] = (unsigned)(R * lda + C) * 2u; voffB[i] = (unsigned)(Rb * K + C) * 2u; }
  const size_t kstep = (size_t)(BK * 2);
  const size_t hstepA = (size_t)HALF * lda * 2, hstepB = (size_t)HALF * K * 2;
  const size_t tstepA = 2 * hstepA, tstepB = 2 * hstepB;
  const unsigned ldsw = (unsigned)wid * 1024u;
  const int aoff = lds_byte(wr * 64 + fr, fq * 8), boff = lds_byte(wc * 32 + fr, fq * 8);
#define PG8_SA(b, h) (((b) * 2 + (h)) * HTB)
#define PG8_SB(b, h) ((4 + (b) * 2 + (h)) * HTB)
#define PG8_STAGE(bufoff, gbase, voff) do { _Pragma("unroll") for (int _i = 0; _i < 2; ++_i) \
    __builtin_amdgcn_global_load_lds((const unsigned*)((const char*)(gbase) + (voff)[_i]), (LAS unsigned*)(lds + (bufoff) + ldsw + _i * 8192), 16, 0, 0); } while (0)
#define PG8_LDA(dst, b, h) do { _Pragma("unroll") for (int m = 0; m < 4; ++m) _Pragma("unroll") for (int k = 0; k < 2; ++k) dst[m][k] = *(const LAS bf16x8*)(lds + PG8_SA(b, h) + aoff + m * 2048 + k * 1024); } while (0)
#define PG8_LDB(dst, b, h) do { _Pragma("unroll") for (int n = 0; n < 2; ++n) _Pragma("unroll") for (int k = 0; k < 2; ++k) dst[n][k] = *(const LAS bf16x8*)(lds + PG8_SB(b, h) + boff + n * 2048 + k * 1024); } while (0)
#define PG8_MMA(ai, bj, At, Bt) do { __builtin_amdgcn_s_setprio(1); _Pragma("unroll") for (int m = 0; m < 4; ++m) _Pragma("unroll") for (int n = 0; n < 2; ++n) _Pragma("unroll") for (int k = 0; k < 2; ++k) \
    acc[ai][bj][m][n] = __builtin_amdgcn_mfma_f32_16x16x32_bf16(Bt[n][k], At[m][k], acc[ai][bj][m][n], 0, 0, 0); __builtin_amdgcn_s_setprio(0); } while (0)
#define PG8_WAIT_V(n) asm volatile("s_waitcnt vmcnt(" #n ")" ::: "memory")
#define PG8_WAIT_L(n) asm volatile("s_waitcnt lgkmcnt(" #n ")" ::: "memory")
#define PG8_BAR __builtin_amdgcn_s_barrier()
#define PG8_SCHED __builtin_amdgcn_sched_barrier(0)
  Unit cur, nxt; int ui = 0;
  if (!S.next(0, cur)) return;
  f32x4 acc[2][2][4][2];
#pragma unroll
  for (int a = 0; a < 2; ++a)
#pragma unroll
    for (int b = 0; b < 2; ++b)
#pragma unroll
      for (int m = 0; m < 4; ++m)
#pragma unroll
        for (int n = 0; n < 2; ++n) acc[a][b][m][n] = (f32x4){0.f, 0.f, 0.f, 0.f};
  bf16x8 At[4][2], B0[2][2], B1[2][2];
  const char* cA = (const char*)g.A + (size_t)cur.pm * tstepA; const char* cB = (const char*)g.Bt + (size_t)cur.pn * tstepB;
  PG8_STAGE(PG8_SB(0, 0), cB, voffB); PG8_STAGE(PG8_SA(0, 0), cA, voffA); PG8_STAGE(PG8_SB(0, 1), cB + hstepB, voffB); PG8_STAGE(PG8_SA(0, 1), cA + hstepA, voffA);
  if (wr == 1) PG8_BAR;
  PG8_WAIT_V(4); PG8_BAR;
  PG8_STAGE(PG8_SB(1, 0), cB + kstep, voffB); PG8_STAGE(PG8_SA(1, 0), cA + kstep, voffA); PG8_STAGE(PG8_SB(1, 1), cB + hstepB + kstep, voffB);
  PG8_WAIT_V(6); PG8_BAR;
  for (;;) {
    const bool has_next = S.next(ui + 1, nxt);
    const char* nA = has_next ? (const char*)g.A + (size_t)nxt.pm * tstepA : cA; const char* nB = has_next ? (const char*)g.Bt + (size_t)nxt.pn * tstepB : cB;
    for (int t = 0; t < nt; t += 2) {
      const bool last = (t == nt - 2);
      const char* a1 = cA + (size_t)(t + 1) * kstep;
      const char* a2 = last ? nA : cA + (size_t)(t + 2) * kstep; const char* b2 = last ? nB : cB + (size_t)(t + 2) * kstep;
      const char* a3 = a2 + kstep; const char* b3 = b2 + kstep;
      PG8_LDB(B0, 0, 0); PG8_SCHED; PG8_LDA(At, 0, 0); PG8_STAGE(PG8_SA(1, 1), a1 + hstepA, voffA);
      PG8_WAIT_L(8); PG8_BAR; PG8_WAIT_L(0); PG8_MMA(0, 0, At, B0); PG8_BAR; PG8_SCHED;
      PG8_LDB(B1, 0, 1); PG8_STAGE(PG8_SB(0, 0), b2, voffB);
      PG8_BAR; PG8_WAIT_L(0); PG8_MMA(0, 1, At, B1); PG8_BAR;
      PG8_LDA(At, 0, 1); PG8_STAGE(PG8_SA(0, 0), a2, voffA);
      PG8_BAR; PG8_WAIT_L(0); PG8_MMA(1, 0, At, B0); PG8_BAR; PG8_SCHED;
      PG8_STAGE(PG8_SB(0, 1), b2 + hstepB, voffB);
      PG8_WAIT_V(6); PG8_BAR; PG8_MMA(1, 1, At, B1); PG8_BAR;
      PG8_LDB(B0, 1, 0); PG8_SCHED; PG8_LDA(At, 1, 0); PG8_STAGE(PG8_SA(0, 1), a2 + hstepA, voffA);
      PG8_WAIT_L(8); PG8_BAR; PG8_WAIT_L(0); PG8_MMA(0, 0, At, B0); PG8_BAR; PG8_SCHED;
      PG8_LDB(B1, 1, 1); PG8_STAGE(PG8_SB(1, 0), b3, voffB);
      PG8_BAR; PG8_WAIT_L(0); PG8_MMA(0, 1, At, B1); PG8_BAR;
      PG8_LDA(At, 1, 1); PG8_STAGE(PG8_SA(1, 0), a3, voffA);
      PG8_BAR; PG8_WAIT_L(0); PG8_MMA(1, 0, At, B0); PG8_BAR; PG8_SCHED;
      PG8_STAGE(PG8_SB(1, 1), b3 + hstepB, voffB);
      PG8_WAIT_V(6); PG8_BAR; PG8_MMA(1, 1, At, B1); PG8_BAR;
    }
    E(acc, cur, wr, wc, fr, fq);
    if (!has_next) break;
#pragma unroll
    for (int a = 0; a < 2; ++a)
#pragma unroll
      for (int b = 0; b < 2; ++b)
#pragma unroll
        for (int m = 0; m < 4; ++m)
#pragma unroll
          for (int n = 0; n < 2; ++n) acc[a][b][m][n] = (f32x4){0.f, 0.f, 0.f, 0.f};
    cur = nxt; cA = nA; cB = nB; ++ui;
  }
  PG8_WAIT_V(0);
  if (wr == 0) PG8_BAR;
  PG8_BAR;
#undef PG8_SA
#undef PG8_SB
#undef PG8_STAGE
#undef PG8_LDA
#undef PG8_LDB
#undef PG8_MMA
#undef PG8_WAIT_V
#undef PG8_WAIT_L
#undef PG8_BAR
#undef PG8_SCHED
}
}

struct Epi {
  bf16_t* out; int ldc;
  int rope64_end;
  int rope32_lo, rope32_hi;
  int qmode;
  const bf16_t* nsrc; int nld, nK;
  const float *cosH, *sinH, *cosR, *sinR;
  DI void operator()(const f32x4 (&acc)[2][2][4][2], const pg8::Unit& u, int wr, int wc, int fr, int fq) const {
    const int row0 = u.pm * 256 + wr * 64 + fr;
#pragma unroll
    for (int ai = 0; ai < 2; ++ai)
#pragma unroll
      for (int m = 0; m < 4; ++m) {
        const int row = row0 + ai * 128 + m * 16;
        const int pos = row & (SEQ - 1);
        float rs = 1.f;
        if (nsrc) {
          const int per = nK >> 2;
          const bf16_t* src = nsrc + (size_t)row * nld + fq * per;
          float ss = 0.f;
          for (int k = 0; k < per; k += 8) {
            const u32x4 v = *(const u32x4*)(src + k);
#pragma unroll
            for (int j = 0; j < 4; ++j) { const float a = bflo(v[j]), b = bfhi(v[j]); ss += a * a + b * b; }
          }
          ss += __shfl_xor(ss, 16); ss += __shfl_xor(ss, 32);
          rs = rsqrtf(ss / (float)nK + EPS);
        }
#pragma unroll
        for (int bj = 0; bj < 2; ++bj) {
          const int c0 = u.pn * 256 + bj * 128 + wc * 32 + 8 * fq;
          f32x4 v0 = acc[ai][bj][m][0] * rs, v1 = acc[ai][bj][m][1] * rs;
          const float* ct = nullptr; const float* st = nullptr;
          if (c0 < rope64_end) { const int i0 = ((c0 & 63) >> 3) * 4; ct = cosH + pos * 32 + i0; st = sinH + pos * 32 + i0; }
          else if (c0 >= rope32_lo && c0 < rope32_hi) { const int i0 = (((c0 - rope32_lo) & 31) >> 3) * 4; ct = cosR + pos * 16 + i0; st = sinR + pos * 16 + i0; }
          else if (qmode) { const int p = c0 % 96; if (p >= 64) { const int i0 = ((p - 64) >> 3) * 4; ct = cosR + pos * 16 + i0; st = sinR + pos * 16 + i0; } }
          if (ct) {
            const f32x4 cv = *(const f32x4*)ct, sv = *(const f32x4*)st;
            const f32x4 o1 = v0 * cv - v1 * sv, o2 = v1 * cv + v0 * sv;
            v0 = o1; v1 = o2;
          }
          u32x4 w; w.x = pk2(v0[0], v0[1]); w.y = pk2(v0[2], v0[3]); w.z = pk2(v1[0], v1[1]); w.w = pk2(v1[2], v1[3]);
          *(u32x4*)(out + (size_t)row * ldc + c0) = w;
        }
      }
  }
};

DI int ropeperm64(int p) { const int g = p >> 3, r = p & 7; return r < 4 ? 4 * g + r : 32 + 4 * g + (r - 4); }
DI int ropeperm32(int p) { const int g = p >> 3, r = p & 7; return r < 4 ? 4 * g + r : 16 + 4 * g + (r - 4); }
DI int srccol(int kind, int n) {
  if (kind == 0) {
    if (n < 512) return 672 + (n & ~63) + ropeperm64(n & 63);
    if (n < 640) return 1184 + ((n - 512) & ~63) + ropeperm64(n & 63);
    if (n < 768) return 1312 + (n - 640);
    if (n < 1792) return 1440 + (n - 768);
    if (n < 2176) return n - 1792;
    if (n < 2432) return 384 + (n - 2176);
    if (n < 2464) return 640 + ropeperm32(n - 2432);
    return -1;
  }
  if (kind == 1) {
    if (n < 1024) return (n & ~63) + ropeperm64(n & 63);
    if (n < 3072) return n;
    return 3080 + (n - 3072);
  }
  if (kind == 2) { const int hd = n / 96, p = n - hd * 96; return hd * 96 + (p < 64 ? p : 64 + ropeperm32(p - 64)); }
  return n;
}
DI void convert_tile(LAS unsigned char* lds, const float* W, int Nsrc, int K, bf16_t* Wt, int kind, const float* g, int tn, int tk) {
  const int tid = opaque_tid();
  LAS bf16_t* tile = (LAS bf16_t*)lds;
  const int nl = tid & 63, ks = tid >> 6;
  const int sc = srccol(kind, tn * 64 + nl);
#pragma unroll
  for (int kk = ks; kk < 64; kk += 8) {
    const int k = tk * 64 + kk;
    float v = 0.f;
    if (sc >= 0) { v = W[(size_t)k * Nsrc + sc]; if (g) v *= g[k]; }
    tile[nl * 72 + kk] = f2bf(v);
  }
  __syncthreads();
  { const int n2 = tid >> 3, ch = tid & 7;
    const u32x4 v = *(const LAS u32x4*)(tile + n2 * 72 + ch * 8);
    *(u32x4*)(Wt + (size_t)(tn * 64 + n2) * K + tk * 64 + ch * 8) = v; }
  __syncthreads();
}

DI void prologue(const Params& p, LAS unsigned char* lds) {
  const int tid = opaque_tid(), G = gridDim.x, bid = blockIdx.x;
  unsigned char* ws = p.ws;
  for (int idx = bid * 512 + tid; idx < 2048 * 48; idx += G * 512) {
    if (idx < 2048 * 32) {
      const int pos = idx >> 5, i = idx & 31;
      const float inv = 1.0f / powf(10000.f, (float)(2 * i) / 64.f);
      const float ang = (float)pos * inv;
      ((float*)(ws + WS_COSH))[idx] = (float)cos((double)ang); ((float*)(ws + WS_SINH))[idx] = (float)sin((double)ang);
    } else {
      const int j = idx - 2048 * 32; const int pos = j >> 4, i = j & 15;
      const float inv = 1.0f / powf(10000.f, (float)(2 * i) / 32.f);
      const float ang = (float)pos * inv;
      ((float*)(ws + WS_COSR))[j] = (float)cos((double)ang); ((float*)(ws + WS_SINR))[j] = (float)sin((double)ang);
    }
  }
  constexpr int NT0 = 40 * 16, NT1 = 64 * 16, NT2 = 12 * 6, NT3 = 16 * 4, NT4 = 16 * 16;
  constexpr int PER_I = NT0 + NT1 + NT2 + NT3 + 2 * NT4;
  for (int job = bid; job < 2 * PER_I; job += G) {
    const int i = job / PER_I; int j = job - i * PER_I;
    if (j < NT0) { convert_tile(lds, p.ev_w_in + (size_t)i * 1024 * 2464, 2464, 1024, (bf16_t*)(ws + WS_WEVIN + i * SZ_WEVIN), 0, nullptr, j / 16, j % 16); continue; }
    j -= NT0;
    if (j < NT1) { convert_tile(lds, p.od_w_in + (size_t)i * 1024 * 4104, 4104, 1024, (bf16_t*)(ws + WS_WODIN + i * SZ_WODIN), 1, nullptr, j / 16, j % 16); continue; }
    j -= NT1;
    if (j < NT2) { convert_tile(lds, p.ev_w_uq + (size_t)i * 384 * 768, 768, 384, (bf16_t*)(ws + WS_WUQ + i * SZ_WUQ), 2, p.ev_q_norm + i * 384, j / 6, j % 6); continue; }
    j -= NT2;
    if (j < NT3) { convert_tile(lds, p.ev_w_ukv + (size_t)i * 256 * 1024, 1024, 256, (bf16_t*)(ws + WS_WUKV + i * SZ_WUKV), 3, p.ev_kv_norm + i * 256, j / 4, j % 4); continue; }
    j -= NT3;
    if (j < NT4) { convert_tile(lds, p.ev_w_out + (size_t)i * 1024 * 1024, 1024, 1024, (bf16_t*)(ws + WS_WEVOUT + i * SZ_WOUT), 4, nullptr, j / 16, j % 16); continue; }
    j -= NT4;
    convert_tile(lds, p.od_w_out + (size_t)i * 1024 * 1024, 1024, 1024, (bf16_t*)(ws + WS_WODOUT + i * SZ_WOUT), 4, nullptr, j / 16, j % 16);
  }
  const int item0 = G - 1 - bid;
  if (item0 < 192) {
    LAS float* cond = (LAS float*)lds;
    LAS float* red = (LAS float*)(lds + 65536);
    for (int e = tid; e < 16 * 1024; e += 512) { const int b = e >> 10, k = e & 1023; cond[k * 16 + b] = silu_f(p.c[e]); }
    __syncthreads();
    for (int item = item0; item < 192; item += G) {
      const int l = item / 48, n0 = (item % 48) * 64;
      const int col = tid & 63, kg = tid >> 6;
      float a[16];
#pragma unroll
      for (int b = 0; b < 16; ++b) a[b] = 0.f;
      const float* wp = p.w_ada + (size_t)l * 1024 * 3072 + n0 + col;
      for (int k = kg * 128; k < kg * 128 + 128; ++k) {
        const float w = wp[(size_t)k * 3072];
#pragma unroll
        for (int b4 = 0; b4 < 4; ++b4) { const f32x4 cv = *(const LAS f32x4*)(cond + k * 16 + b4 * 4);
          a[b4 * 4 + 0] += cv[0] * w; a[b4 * 4 + 1] += cv[1] * w; a[b4 * 4 + 2] += cv[2] * w; a[b4 * 4 + 3] += cv[3] * w; }
      }
#pragma unroll
      for (int b = 0; b < 16; ++b) red[(kg * 16 + b) * 64 + col] = a[b];
      __syncthreads();
      for (int e = tid; e < 1024; e += 512) { const int b = e >> 6, cc = e & 63; float s = 0.f;
#pragma unroll
        for (int k8 = 0; k8 < 8; ++k8) s += red[(k8 * 16 + b) * 64 + cc];
        ((float*)(ws + WS_MOD))[((size_t)l * 16 + b) * 3072 + n0 + cc] = s + p.b_ada[l * 3072 + n0 + cc]; }
      __syncthreads();
    }
  }
}

DI void rowwise_phase(const Params& p, int lp, int ln) {
  const int tid = opaque_tid(), lane = tid & 63, wid = tid >> 6;
  const int gw = blockIdx.x * 8 + wid, nw = gridDim.x * 8;
  unsigned char* ws = p.ws;
  const float* mod = (const float*)(ws + WS_MOD);
  const bf16_t* ybuf = (const bf16_t*)(ws + WS_HBUF);
  bf16_t* hbuf = (bf16_t*)(ws + WS_HBUF);
  const bool ff = (ln < 4) && (ln & 1);
  float wff[16][8];
  float fbias[8];
#pragma unroll
  for (int a = 0; a < 16; ++a)
#pragma unroll
    for (int h = 0; h < 8; ++h) wff[a][h] = 0.f;
#pragma unroll
  for (int h = 0; h < 8; ++h) fbias[h] = 0.f;
  if (ff) {
    const float* w = p.od_w_in + (size_t)(ln >> 1) * 1024 * 4104 + 3072;
#pragma unroll
    for (int j = 0; j < 4; ++j)
#pragma unroll
      for (int e = 0; e < 4; ++e) {
        const int c = 4 * lane + 256 * j + e;
        const f32x4 w0 = *(const f32x4*)(w + (size_t)c * 4104), w1 = *(const f32x4*)(w + (size_t)c * 4104 + 4);
        wff[j * 4 + e][0] = w0[0]; wff[j * 4 + e][1] = w0[1]; wff[j * 4 + e][2] = w0[2]; wff[j * 4 + e][3] = w0[3];
        wff[j * 4 + e][4] = w1[0]; wff[j * 4 + e][5] = w1[1]; wff[j * 4 + e][6] = w1[2]; wff[j * 4 + e][7] = w1[3];
      }
#pragma unroll
    for (int h = 0; h < 8; ++h) fbias[h] = p.od_forget_bias[(ln >> 1) * 8 + h];
  }
  for (int row = gw; row < T; row += nw) {
    const int b = row >> 11;
    f32x4 xv[4];
    const float* xin = (lp <= 0 ? p.x : p.out) + (size_t)row * DM;
#pragma unroll
    for (int j = 0; j < 4; ++j) xv[j] = *(const f32x4*)(xin + 4 * lane + 256 * j);
    if (lp >= 0) {
      f32x4 yv[4]; float ss = 0.f;
#pragma unroll
      for (int j = 0; j < 4; ++j) { const u32x2 u = *(const u32x2*)(ybuf + (size_t)row * DM + 4 * lane + 256 * j);
        yv[j] = (f32x4){bflo(u.x), bfhi(u.x), bflo(u.y), bfhi(u.y)}; ss += yv[j][0] * yv[j][0] + yv[j][1] * yv[j][1] + yv[j][2] * yv[j][2] + yv[j][3] * yv[j][3]; }
      ss = wave_sum(ss);
      const float rs = rsqrtf(ss * (1.f / DM) + EPS);
#pragma unroll
      for (int j = 0; j < 4; ++j) {
        const int c = 4 * lane + 256 * j;
        const f32x4 gt = *(const f32x4*)(mod + ((size_t)lp * 16 + b) * 3072 + 2048 + c);
        const f32x4 gp = *(const f32x4*)(p.g_post + lp * DM + c);
        xv[j] = xv[j] + gt * (yv[j] * rs * gp);
        *(f32x4*)(p.out + (size_t)row * DM + c) = xv[j];
      }
    }
    if (ln < 4) {
      float ss = 0.f;
#pragma unroll
      for (int j = 0; j < 4; ++j) ss += xv[j][0] * xv[j][0] + xv[j][1] * xv[j][1] + xv[j][2] * xv[j][2] + xv[j][3] * xv[j][3];
      ss = wave_sum(ss);
      const float rs = rsqrtf(ss * (1.f / DM) + EPS);
      float zf[8];
#pragma unroll
      for (int h = 0; h < 8; ++h) zf[h] = 0.f;
#pragma unroll
      for (int j = 0; j < 4; ++j) {
        const int c = 4 * lane + 256 * j;
        const f32x4 sh = *(const f32x4*)(mod + ((size_t)ln * 16 + b) * 3072 + c);
        const f32x4 sc = *(const f32x4*)(mod + ((size_t)ln * 16 + b) * 3072 + 1024 + c);
        const f32x4 gp = *(const f32x4*)(p.g_pre + ln * DM + c);
        const f32x4 hv = (xv[j] * rs * gp) * (sc + 1.f) + sh;
        u32x2 w; w.x = pk2(hv[0], hv[1]); w.y = pk2(hv[2], hv[3]);
        *(u32x2*)(hbuf + (size_t)row * DM + c) = w;
        if (ff) {
#pragma unroll
          for (int e = 0; e < 4; ++e)
#pragma unroll
            for (int h = 0; h < 8; ++h) zf[h] += hv[e] * wff[j * 4 + e][h];
        }
      }
      if (ff) {
#pragma unroll
        for (int h = 0; h < 8; ++h) zf[h] = wave_sum(zf[h]);
        if (lane < 8) {
          float z = 0.f;
#pragma unroll
          for (int h = 0; h < 8; ++h) z = (lane == h) ? zf[h] + fbias[h] : z;
          const float ls = fminf(z, 0.f) - log1pf(expf(-fabsf(z)));
          ((float*)(ws + WS_LOGF))[(size_t)row * 8 + lane] = ls;
        }
      }
    }
  }
}

DI void fox_scan(const Params& p, LAS unsigned char* lds, int bh) {
  const int tid = opaque_tid();
  const int b = bh >> 3, h = bh & 7;
  const float* logf_ = (const float*)(p.ws + WS_LOGF);
  float* fcum = (float*)(p.ws + WS_FCUM) + (size_t)bh * SEQ;
  LAS float* s = (LAS float*)lds;
  float v[4];
#pragma unroll
  for (int j = 0; j < 4; ++j) v[j] = logf_[((size_t)b * SEQ + 4 * tid + j) * 8 + h];
  v[1] += v[0]; v[2] += v[1]; v[3] += v[2];
  s[tid] = v[3];
  __syncthreads();
  for (int off = 1; off < 512; off <<= 1) {
    float t = 0.f;
    if (tid >= off) t = s[tid - off];
    __syncthreads();
    s[tid] += t;
    __syncthreads();
  }
  const float excl = s[tid] - v[3];
#pragma unroll
  for (int j = 0; j < 4; ++j) fcum[4 * tid + j] = excl + v[j];
  __syncthreads();
}

struct AttnArgs { const bf16_t *q, *k, *k2, *v, *gate; bf16_t* out; const float* fcum; int ldq, ldk, ldk2, ldv, ldo, ldg; float sl2, sink; };

template <int DQK, int DV, int MODE>
DI void attn_item(LAS unsigned char* lds, const AttnArgs& a, int qb) {
  constexpr int KSTR = DQK * 2 + 16, VSTR = DV * 2 + 16;
  constexpr int KBYTES = 64 * KSTR, VBYTES = 64 * VSTR, FBYTES = 256;
  constexpr int BUF = KBYTES + VBYTES + FBYTES;
  constexpr int NKS = DQK / 16, NBLK = DV / 32, NVR = DV / 64;
  const int tid = opaque_tid(), wid = __builtin_amdgcn_readfirstlane(tid >> 6), lane = tid & 63, r = lane & 31, hh = lane >> 5;
  const int q0 = qb * 256, qw = q0 + 32 * wid, myq = qw + r;
  bf16x8 qf[NKS];
#pragma unroll
  for (int ks = 0; ks < NKS; ++ks) qf[ks] = *(const bf16x8*)(a.q + (size_t)myq * a.ldq + 16 * ks + 8 * hh);
  int kt_lo = 0; const int kt_hi = 4 * (qb + 1);
  if (MODE == 1) { kt_lo = 4 * qb - 2; if (kt_lo < 0) kt_lo = 0; }
  f32x16 O[NBLK];
#pragma unroll
  for (int bl = 0; bl < NBLK; ++bl)
#pragma unroll
    for (int i = 0; i < 16; ++i) O[bl][i] = 0.f;
  float m = (MODE == 1) ? a.sink : -1e30f;
  float l = (MODE == 1 && hh == 0) ? 1.f : 0.f;
  u32x4 kreg0, kreg1 = {0, 0, 0, 0}, vreg[NVR]; float freg = 0.f;
  const int krow = tid >> 3, kch = tid & 7, krow2 = tid >> 2, kch2 = tid & 3;
  auto gload = [&](int kt) {
    const int key0 = kt * 64;
    kreg0 = *(const u32x4*)(a.k + (size_t)(key0 + krow) * a.ldk + 8 * kch);
    if (DQK == 96) { if (tid < 256) kreg1 = *(const u32x4*)(a.k2 + (size_t)(key0 + krow2) * a.ldk2 + 8 * kch2); }
#pragma unroll
    for (int j = 0; j < NVR; ++j) { const int idx = tid + 512 * j; const int vrow = idx / (DV / 8), vch = idx % (DV / 8);
      vreg[j] = *(const u32x4*)(a.v + (size_t)(key0 + vrow) * a.ldv + 8 * vch); }
    if (MODE == 2) { if (tid < 64) freg = a.fcum[key0 + tid] * (-LOG2E); }
  };
  auto lstore = [&](int buf) {
    LAS unsigned char* base = lds + buf * BUF;
    *(LAS u32x4*)(base + krow * KSTR + kch * 16) = kreg0;
    if (DQK == 96) { if (tid < 256) *(LAS u32x4*)(base + krow2 * KSTR + 128 + kch2 * 16) = kreg1; }
#pragma unroll
    for (int j = 0; j < NVR; ++j) { const int idx = tid + 512 * j; const int vrow = idx / (DV / 8), vch = idx % (DV / 8);
      *(LAS u32x4*)(base + KBYTES + vrow * VSTR + vch * 16) = vreg[j]; }
    if (MODE == 2) { if (tid < 64) *(LAS float*)(base + KBYTES + VBYTES + tid * 4) = freg; }
  };
  const int i16 = lane & 15, q4 = i16 >> 2, p4 = i16 & 3, grp = (lane >> 4) & 1;
  gload(kt_lo); lstore(0); __syncthreads();
  int cur = 0;
  for (int kt = kt_lo; kt < kt_hi; ++kt) {
    const bool more = (kt + 1 < kt_hi);
    if (more) gload(kt + 1);
    const int key0 = kt * 64;
    bool active = (key0 <= qw + 31);
    if (MODE == 1) active = active && (key0 + 63 > qw - 128);
    if (active) {
      LAS unsigned char* Kl = lds + cur * BUF; LAS unsigned char* Vl = Kl + KBYTES; LAS unsigned char* Fl = Vl + VBYTES;
      f32x16 s[2];
#pragma unroll
      for (int kb = 0; kb < 2; ++kb) {
#pragma unroll
        for (int i = 0; i < 16; ++i) s[kb][i] = 0.f;
#pragma unroll
        for (int ks = 0; ks < NKS; ++ks) {
          const bf16x8 kf = *(const LAS bf16x8*)(Kl + (32 * kb + r) * KSTR + (16 * ks + 8 * hh) * 2);
          s[kb] = __builtin_amdgcn_mfma_f32_32x32x16_bf16(kf, qf[ks], s[kb], 0, 0, 0);
        }
      }
      const bool needmask = (MODE == 1) || (key0 + 63 > qw);
      float mx = -1e30f;
#pragma unroll
      for (int kb = 0; kb < 2; ++kb)
#pragma unroll
        for (int g = 0; g < 4; ++g) {
          f32x4 fb = {0.f, 0.f, 0.f, 0.f};
          if (MODE == 2) fb = *(const LAS f32x4*)(Fl + (32 * kb + 8 * g + 4 * hh) * 4);
#pragma unroll
          for (int e = 0; e < 4; ++e) {
            const int i = 4 * g + e;
            const int key = key0 + 32 * kb + 8 * g + 4 * hh + e;
            float v = s[kb][i] * a.sl2 + fb[e];
            if (needmask) { bool valid = key <= myq; if (MODE == 1) valid = valid && (myq - key < 128); v = valid ? v : -1e30f; }
            s[kb][i] = v; mx = fmaxf(mx, v);
          }
        }
      mx = fmaxf(mx, __shfl_xor(mx, 32));
      const float mnew = fmaxf(m, mx);
      const float alpha = fast_exp2(m - mnew);
      m = mnew;
      float psum = 0.f;
#pragma unroll
      for (int kb = 0; kb < 2; ++kb)
#pragma unroll
        for (int i = 0; i < 16; ++i) { const float pv = fast_exp2(s[kb][i] - mnew); psum += pv; s[kb][i] = pv; }
      l = l * alpha + psum;
#pragma unroll
      for (int bl = 0; bl < NBLK; ++bl)
#pragma unroll
        for (int i = 0; i < 16; ++i) O[bl][i] *= alpha;
      bf16x8 pf[2][2];
#pragma unroll
      for (int kb = 0; kb < 2; ++kb)
#pragma unroll
        for (int s2 = 0; s2 < 2; ++s2) {
          u32x4 w;
          w.x = pk2(s[kb][8 * s2 + 0], s[kb][8 * s2 + 1]); w.y = pk2(s[kb][8 * s2 + 2], s[kb][8 * s2 + 3]);
          w.z = pk2(s[kb][8 * s2 + 4], s[kb][8 * s2 + 5]); w.w = pk2(s[kb][8 * s2 + 6], s[kb][8 * s2 + 7]);
          pf[kb][s2] = __builtin_bit_cast(bf16x8, w);
        }
#pragma unroll
      for (int bl = 0; bl < NBLK; ++bl)
#pragma unroll
        for (int kb = 0; kb < 2; ++kb)
#pragma unroll
          for (int s2 = 0; s2 < 2; ++s2) {
            LAS unsigned char* ad = Vl + (32 * kb + 16 * s2 + 4 * hh + q4) * VSTR + (32 * bl + 16 * grp) * 2 + 8 * p4;
            const s16x4 lo = __builtin_amdgcn_ds_read_tr16_b64_v4i16((LAS s16x4*)ad);
            const s16x4 hi = __builtin_amdgcn_ds_read_tr16_b64_v4i16((LAS s16x4*)(ad + 8 * VSTR));
            const bf16x8 vf = __builtin_shufflevector(lo, hi, 0, 1, 2, 3, 4, 5, 6, 7);
            O[bl] = __builtin_amdgcn_mfma_f32_32x32x16_bf16(vf, pf[kb][s2], O[bl], 0, 0, 0);
          }
    }
    if (more) lstore(cur ^ 1);
    __syncthreads();
    cur ^= 1;
  }
  l += __shfl_xor(l, 32);
  const float inv = 1.f / l;
#pragma unroll
  for (int bl = 0; bl < NBLK; ++bl)
#pragma unroll
    for (int g = 0; g < 4; ++g) {
      const int f = 32 * bl + 8 * g + 4 * hh;
      float o0 = O[bl][4 * g + 0] * inv, o1 = O[bl][4 * g + 1] * inv, o2 = O[bl][4 * g + 2] * inv, o3 = O[bl][4 * g + 3] * inv;
      if (a.gate) {
        const u32x2 gv = *(const u32x2*)(a.gate + (size_t)myq * a.ldg + f);
        o0 *= silu_f(bflo(gv.x)); o1 *= silu_f(bfhi(gv.x)); o2 *= silu_f(bflo(gv.y)); o3 *= silu_f(bfhi(gv.y));
      }
      u32x2 w; w.x = pk2(o0, o1); w.y = pk2(o2, o3);
      *(u32x2*)(a.out + (size_t)myq * a.ldo + f) = w;
    }
}

DI int snake_idx(int round, int G, int c) { return round * G + ((round & 1) ? (G - 1 - c) : c); }

DI void attn_even(const Params& p, LAS unsigned char* lds, int i) {
  const int G = gridDim.x, c = blockIdx.x;
  unsigned char* ws = p.ws;
  const bf16_t* z = (const bf16_t*)(ws + WS_ZBUF);
  const bf16_t* qb_ = (const bf16_t*)(ws + WS_QBUF);
  const bf16_t* kv = (const bf16_t*)(ws + WS_HBUF);
  bf16_t* ob = (bf16_t*)(ws + WS_OBUF);
  for (int rd = 0; rd * G < 1024; ++rd) {
    const int idx = snake_idx(rd, G, c);
    if (idx >= 1024) continue;
    const int qb = 7 - idx / 128, bh = idx % 128, b = bh >> 3, hd = bh & 7;
    AttnArgs a;
    a.q = qb_ + (size_t)b * SEQ * 768 + hd * 96; a.ldq = 768;
    a.k = kv + (size_t)b * SEQ * 1024 + hd * 128; a.ldk = 1024;
    a.k2 = z + (size_t)b * SEQ * 2560 + 2432; a.ldk2 = 2560;
    a.v = kv + (size_t)b * SEQ * 1024 + hd * 128 + 64; a.ldv = 1024;
    a.out = ob + (size_t)b * SEQ * 1024 + hd * 64; a.ldo = 1024;
    a.gate = z + (size_t)b * SEQ * 2560 + 768 + hd * 64; a.ldg = 2560;
    a.fcum = nullptr; a.sl2 = 0.10206207261596577f * LOG2E; a.sink = 0.f;
    attn_item<96, 64, 0>(lds, a, qb);
  }
  for (int rd = 0; rd * G < 1024; ++rd) {
    const int idx = snake_idx(rd, G, c);
    if (idx >= 1024) continue;
    const int qb = 7 - idx / 128, bh = idx % 128, b = bh >> 3, hd = bh & 7, kvh = hd >> 2;
    AttnArgs a;
    const bf16_t* zb = z + (size_t)b * SEQ * 2560;
    a.q = zb + hd * 64; a.ldq = 2560;
    a.k = zb + 512 + kvh * 64; a.ldk = 2560; a.k2 = nullptr; a.ldk2 = 0;
    a.v = zb + 640 + kvh * 64; a.ldv = 2560;
    a.out = ob + (size_t)b * SEQ * 1024 + 512 + hd * 64; a.ldo = 1024;
    a.gate = zb + 768 + 512 + hd * 64; a.ldg = 2560;
    a.fcum = nullptr; a.sl2 = 0.125f * LOG2E; a.sink = p.ev_sinks[i * 8 + hd] * LOG2E;
    attn_item<64, 64, 1>(lds, a, qb);
  }
}

DI void attn_odd(const Params& p, LAS unsigned char* lds) {
  const int G = gridDim.x, c = blockIdx.x;
  unsigned char* ws = p.ws;
  const bf16_t* z = (const bf16_t*)(ws + WS_ZBUF);
  bf16_t* od = (bf16_t*)(ws + WS_HBUF);
  bf16_t* ob = (bf16_t*)(ws + WS_OBUF);
  for (int rd = 0; rd * G < 1024; ++rd) {
    const int idx = snake_idx(rd, G, c);
    if (idx >= 1024) continue;
    const int qb = 7 - idx / 128, bh = idx % 128, b = bh >> 3, j = bh & 7;
    AttnArgs a;
    const bf16_t* zb = z + (size_t)b * SEQ * 4096;
    a.q = zb + j * 64; a.ldq = 4096;
    a.k = zb + 512 + j * 64; a.ldk = 4096; a.k2 = nullptr; a.ldk2 = 0;
    a.v = zb + 1024 + (j >> 1) * 128; a.ldv = 4096;
    a.out = od + (size_t)b * SEQ * 1024 + j * 128; a.ldo = 1024;
    a.gate = nullptr; a.ldg = 0;
    a.fcum = nullptr; a.sl2 = 0.125f * LOG2E; a.sink = 0.f;
    attn_item<64, 128, 0>(lds, a, qb);
  }
  for (int rd = 0; rd * G < 1024; ++rd) {
    const int idx = snake_idx(rd, G, c);
    if (idx >= 1024) continue;
    const int qb = 7 - idx / 128, bh = idx % 128, b = bh >> 3, hd = bh & 7;
    AttnArgs a;
    const bf16_t* zb = z + (size_t)b * SEQ * 4096;
    a.q = zb + 1536 + hd * 64; a.ldq = 4096;
    a.k = zb + 2048 + hd * 64; a.ldk = 4096; a.k2 = nullptr; a.ldk2 = 0;
    a.v = zb + 2560 + hd * 64; a.ldv = 4096;
    a.out = ob + (size_t)b * SEQ * 1024 + 512 + hd * 64; a.ldo = 1024;
    a.gate = zb + 3072 + 512 + hd * 64; a.ldg = 4096;
    a.fcum = (const float*)(ws + WS_FCUM) + (size_t)bh * SEQ; a.sl2 = 0.125f * LOG2E; a.sink = 0.f;
    attn_item<64, 64, 2>(lds, a, qb);
  }
}

DI void diff_combine(const Params& p, int layer) {
  const int tid = opaque_tid(), lane = tid & 63, wid = tid >> 6;
  const int gw = blockIdx.x * 8 + wid, nw = gridDim.x * 8;
  const int i = layer >> 1;
  unsigned char* ws = p.ws;
  const bf16_t* od = (const bf16_t*)(ws + WS_HBUF);
  const bf16_t* z = (const bf16_t*)(ws + WS_ZBUF);
  bf16_t* ob = (bf16_t*)(ws + WS_OBUF);
  const float* lp = p.od_lambda + i * 256;
  const float s1 = wave_sum(lp[lane] * lp[64 + lane]), s2 = wave_sum(lp[128 + lane] * lp[192 + lane]);
  const float lam_init = 0.8f - 0.6f * expf(-0.3f * (float)layer);
  const float lam = expf(s1) - expf(s2) + lam_init;
  const int hd = lane >> 4, dv = (lane & 15) * 8;
  float sub[8];
#pragma unroll
  for (int e = 0; e < 8; ++e) sub[e] = p.od_subln[i * 128 + dv + e] * (1.f - lam_init);
  for (int row = gw; row < T; row += nw) {
    const u32x4 a = *(const u32x4*)(od + (size_t)row * 1024 + (2 * hd) * 128 + dv);
    const u32x4 b = *(const u32x4*)(od + (size_t)row * 1024 + (2 * hd + 1) * 128 + dv);
    const u32x4 g = *(const u32x4*)(z + (size_t)row * 4096 + 3072 + hd * 128 + dv);
    float d[8]; float ss = 0.f;
#pragma unroll
    for (int e = 0; e < 4; ++e) { d[2 * e] = bflo(a[e]) - lam * bflo(b[e]); d[2 * e + 1] = bfhi(a[e]) - lam * bfhi(b[e]); ss += d[2 * e] * d[2 * e] + d[2 * e + 1] * d[2 * e + 1]; }
    ss += __shfl_xor(ss, 1); ss += __shfl_xor(ss, 2); ss += __shfl_xor(ss, 4); ss += __shfl_xor(ss, 8);
    const float rs = rsqrtf(ss * (1.f / 128.f) + EPS);
    u32x4 w;
#pragma unroll
    for (int e = 0; e < 4; ++e) {
      const float o0 = d[2 * e] * rs * sub[2 * e] * silu_f(bflo(g[e])), o1 = d[2 * e + 1] * rs * sub[2 * e + 1] * silu_f(bfhi(g[e]));
      w[e] = pk2(o0, o1);
    }
    *(u32x4*)(ob + (size_t)row * 1024 + hd * 128 + dv) = w;
  }
}


DI void grid_barrier(unsigned* ctr, unsigned& epoch) {
  asm volatile("s_waitcnt vmcnt(0)" ::: "memory");
  __syncthreads();
  epoch += 1;
  if (threadIdx.x == 0) {
    __builtin_amdgcn_fence(__ATOMIC_RELEASE, "agent");
    asm volatile("s_waitcnt vmcnt(0)" ::: "memory");
    __hip_atomic_fetch_add(ctr, 1u, __ATOMIC_RELAXED, __HIP_MEMORY_SCOPE_AGENT);
    const unsigned target = epoch * gridDim.x;
    while (__hip_atomic_load(ctr, __ATOMIC_RELAXED, __HIP_MEMORY_SCOPE_AGENT) < target) __builtin_amdgcn_s_sleep(1);
    __builtin_amdgcn_fence(__ATOMIC_ACQUIRE, "agent");
    asm volatile("s_waitcnt vmcnt(0)" ::: "memory");
  }
  __syncthreads();
}

__global__ void __launch_bounds__(512) fwd_megakernel(Params p) {
  extern __shared__ __attribute__((aligned(16))) unsigned char lds_raw[];
  LAS unsigned char* lds = (LAS unsigned char*)lds_raw;
  cg::grid_group grid = cg::this_grid();
  unsigned char* ws = p.ws;
  const int G = gridDim.x, bid = blockIdx.x;
  const float* cosH = (const float*)(ws + WS_COSH); const float* sinH = (const float*)(ws + WS_SINH);
  const float* cosR = (const float*)(ws + WS_COSR); const float* sinR = (const float*)(ws + WS_SINR);

  unsigned* bar_ctr = (unsigned*)(ws + WS_BAR); unsigned bar_epoch = 0;
  if (bid == 0 && threadIdx.x == 0) __hip_atomic_store(bar_ctr, 0u, __ATOMIC_RELAXED, __HIP_MEMORY_SCOPE_AGENT);
#ifndef SKIP_PRO
  prologue(p, lds);
#endif
  grid.sync();
#pragma unroll
  for (int layer = 0; layer < 4; ++layer) {
    const int i = layer >> 1; const bool odd = layer & 1;
#ifndef SKIP_ROW
    rowwise_phase(p, layer - 1, layer);
#endif
    grid_barrier(bar_ctr, bar_epoch);
    {
#ifndef SKIP_SCAN
      if (odd && bid < 128) fox_scan(p, lds, bid);
#endif
      pg8::Gemm g; g.A = (const bf16_t*)(ws + WS_HBUF); g.lda = 1024; g.K = 1024; g.M = T;
      Epi e; e.out = (bf16_t*)(ws + WS_ZBUF); e.nsrc = nullptr; e.nld = 0; e.nK = 0; e.qmode = 0; e.cosH = cosH; e.sinH = sinH; e.cosR = cosR; e.sinR = sinR;
      if (!odd) { g.Bt = (const bf16_t*)(ws + WS_WEVIN + i * SZ_WEVIN); g.N = 2560; e.ldc = 2560; e.rope64_end = 640; e.rope32_lo = 2432; e.rope32_hi = 2464; }
      else { g.Bt = (const bf16_t*)(ws + WS_WODIN + i * SZ_WODIN); g.N = 4096; e.ldc = 4096; e.rope64_end = 1024; e.rope32_lo = 0; e.rope32_hi = 0; }
      pg8::StaticOrder S; S.init(g.M, g.N, G, bid);
#ifndef SKIP_G1
      pg8::gemm_phase<Epi>(lds, g, S, e);
#endif
    }
    grid_barrier(bar_ctr, bar_epoch);
    if (!odd) {
      for (int which = 0; which < 2; ++which) {
        pg8::Gemm g; g.M = T; g.lda = 2560;
        Epi e; e.rope64_end = 0; e.rope32_lo = 0; e.rope32_hi = 0; e.cosH = cosH; e.sinH = sinH; e.cosR = cosR; e.sinR = sinR; e.nld = 2560;
        if (which == 0) { g.A = (const bf16_t*)(ws + WS_ZBUF) + 1792; g.Bt = (const bf16_t*)(ws + WS_WUQ + i * SZ_WUQ); g.N = 768; g.K = 384;
          e.out = (bf16_t*)(ws + WS_QBUF); e.ldc = 768; e.qmode = 1; e.nsrc = g.A; e.nK = 384; }
        else { g.A = (const bf16_t*)(ws + WS_ZBUF) + 2176; g.Bt = (const bf16_t*)(ws + WS_WUKV + i * SZ_WUKV); g.N = 1024; g.K = 256;
          e.out = (bf16_t*)(ws + WS_HBUF); e.ldc = 1024; e.qmode = 0; e.nsrc = g.A; e.nK = 256; }
        pg8::StaticOrder S; S.init(g.M, g.N, G, bid);
#ifndef SKIP_G2
        pg8::gemm_phase<Epi>(lds, g, S, e);
#endif
      }
      grid_barrier(bar_ctr, bar_epoch);
#ifndef SKIP_ATTE
      attn_even(p, lds, i);
#endif
      grid_barrier(bar_ctr, bar_epoch);
    } else {
#ifndef SKIP_ATTO
      attn_odd(p, lds);
#endif
      grid_barrier(bar_ctr, bar_epoch);
#ifndef SKIP_COMB
      diff_combine(p, layer);
#endif
      grid_barrier(bar_ctr, bar_epoch);
    }
    {
      pg8::Gemm g; g.A = (const bf16_t*)(ws + WS_OBUF); g.lda = 1024; g.K = 1024; g.M = T; g.N = 1024;
      g.Bt = (const bf16_t*)(ws + (odd ? WS_WODOUT : WS_WEVOUT) + i * SZ_WOUT);
      Epi e; e.out = (bf16_t*)(ws + WS_HBUF); e.ldc = 1024; e.nsrc = nullptr; e.nld = 0; e.nK = 0; e.qmode = 0; e.rope64_end = 0; e.rope32_lo = 0; e.rope32_hi = 0;
      e.cosH = cosH; e.sinH = sinH; e.cosR = cosR; e.sinR = sinR;
      pg8::StaticOrder S; S.init(g.M, g.N, G, bid);
#ifndef SKIP_G3
      pg8::gemm_phase<Epi>(lds, g, S, e);
#endif
    }
    grid_barrier(bar_ctr, bar_epoch);
  }
#ifndef SKIP_ROW
  rowwise_phase(p, 3, 4);
#endif
}

constexpr int LDS_BYTES = 131072;

extern "C" void kernel_launch(void* const* d_in, const int* in_sizes, int n_in, void* d_out, int out_size, void* d_ws, size_t ws_size, hipStream_t stream) {
  static int grid_blocks = 0;
  if (grid_blocks == 0) {
    int dev = 0, cus = 0, per_cu = 0;
    if (hipGetDevice(&dev) != hipSuccess || hipDeviceGetAttribute(&cus, hipDeviceAttributeMultiprocessorCount, dev) != hipSuccess) { fprintf(stderr, "device query failed\n"); grid_blocks = -1; return; }
    if (hipFuncSetAttribute((const void*)fwd_megakernel, hipFuncAttributeMaxDynamicSharedMemorySize, LDS_BYTES) != hipSuccess) { fprintf(stderr, "hipFuncSetAttribute failed\n"); grid_blocks = -1; return; }
    if (hipOccupancyMaxActiveBlocksPerMultiprocessor(&per_cu, (const void*)fwd_megakernel, 512, LDS_BYTES) != hipSuccess || per_cu < 1) { fprintf(stderr, "occupancy query: %d\n", per_cu); per_cu = 1; }
    (void)hipGetLastError();
    grid_blocks = cus;
    if (ws_size < WS_END) { fprintf(stderr, "workspace too small: %zu < %zu\n", ws_size, (size_t)WS_END); grid_blocks = -1; return; }
  }
  if (grid_blocks < 0) return;
  Params p{};
  const float** fp = (const float**)&p;
  for (int i = 0; i < 18; ++i) fp[i] = (const float*)d_in[i];
  p.out = (float*)d_out; p.ws = (unsigned char*)d_ws;
  void* args[] = {&p};
  hipError_t e = hipLaunchCooperativeKernel((const void*)fwd_megakernel, dim3(grid_blocks), dim3(512), args, LDS_BYTES, stream);
  if (e != hipSuccess) fprintf(stderr, "cooperative launch failed: %s (grid %d)\n", hipGetErrorString(e), grid_blocks);
}
```

```cpp
#include <hip/hip_runtime.h>
#include <hip/hip_cooperative_groups.h>
#include <cstdio>
#include <type_traits>
namespace cg = cooperative_groups;

#define DI __device__ __forceinline__
#define LAS __attribute__((address_space(3)))
typedef unsigned short bf16_t;
typedef short bf16x8 __attribute__((ext_vector_type(8)));
typedef short s16x4 __attribute__((ext_vector_type(4)));
typedef float f32x2 __attribute__((ext_vector_type(2)));
typedef float f32x4 __attribute__((ext_vector_type(4)));
typedef float f32x16 __attribute__((ext_vector_type(16)));
typedef unsigned u32x2 __attribute__((ext_vector_type(2)));
typedef unsigned u32x4 __attribute__((ext_vector_type(4)));
typedef __bf16 bf16x2_t __attribute__((ext_vector_type(2)));

constexpr int T = 32768, DM = 1024, NB = 16, SEQ = 2048;
constexpr float LOG2E = 1.4426950408889634f;
constexpr float EPS = 1e-6f;

constexpr size_t SZ_WEVIN = 2560ull * 1024 * 2, SZ_WODIN = 4096ull * 1024 * 2, SZ_WUQ = 768ull * 384 * 2, SZ_WUKV = 1024ull * 256 * 2, SZ_WOUT = 1024ull * 1024 * 2;
constexpr size_t WS_WEVIN = 0;
constexpr size_t WS_WODIN = WS_WEVIN + 2 * SZ_WEVIN;
constexpr size_t WS_WUQ = WS_WODIN + 2 * SZ_WODIN;
constexpr size_t WS_WUKV = WS_WUQ + 2 * SZ_WUQ;
constexpr size_t WS_WEVOUT = WS_WUKV + 2 * SZ_WUKV;
constexpr size_t WS_WODOUT = WS_WEVOUT + 2 * SZ_WOUT;
constexpr size_t WS_MOD = WS_WODOUT + 2 * SZ_WOUT;
constexpr size_t WS_COSH = WS_MOD + 4ull * 16 * 3072 * 4;
constexpr size_t WS_SINH = WS_COSH + 2048ull * 32 * 4;
constexpr size_t WS_COSR = WS_SINH + 2048ull * 32 * 4;
constexpr size_t WS_SINR = WS_COSR + 2048ull * 16 * 4;
constexpr size_t WS_LOGF = WS_SINR + 2048ull * 16 * 4;
constexpr size_t WS_FCUM = WS_LOGF + (size_t)T * 8 * 4;
constexpr size_t WS_HBUF = (WS_FCUM + (size_t)T * 8 * 4 + 4095) & ~(size_t)4095;
constexpr size_t WS_OBUF = WS_HBUF + (size_t)T * 1024 * 2;
constexpr size_t WS_ZBUF = WS_OBUF + (size_t)T * 1024 * 2;
constexpr size_t WS_QBUF = WS_ZBUF + (size_t)T * 2560 * 2;
constexpr size_t WS_BAR = WS_ZBUF + (size_t)T * 4096 * 2;
constexpr size_t WS_PART = WS_BAR + 256;
constexpr size_t WS_END = WS_PART + (size_t)T * 20 * 4;

struct Params {
  const float *x, *c, *w_ada, *b_ada, *g_pre, *g_post, *ev_w_in, *ev_q_norm, *ev_kv_norm, *ev_w_uq, *ev_w_ukv, *ev_sinks, *ev_w_out,
      *od_w_in, *od_forget_bias, *od_lambda, *od_subln, *od_w_out;
  float* out;
  unsigned char* ws;
};

DI int opaque_tid() { int t = threadIdx.x; asm volatile("" : "+v"(t)); return t; }
DI float bflo(unsigned u) { return __uint_as_float(u << 16); }
DI float bfhi(unsigned u) { return __uint_as_float(u & 0xffff0000u); }
DI unsigned pk2(float lo, float hi) { f32x2 f = {lo, hi}; bf16x2_t b = __builtin_convertvector(f, bf16x2_t); return __builtin_bit_cast(unsigned, b); }
DI bf16_t f2bf(float f) { return (bf16_t)(pk2(f, 0.f) & 0xffffu); }
DI float fast_exp2(float x) { return __builtin_amdgcn_exp2f(x); }
DI float silu_f(float x) { return x * __builtin_amdgcn_rcpf(1.f + fast_exp2(-x * LOG2E)); }
DI float wave_sum(float v) {
#pragma unroll
  for (int o = 32; o >= 1; o >>= 1) v += __shfl_xor(v, o);
  return v;
}

namespace pg8 {
constexpr int BM = 256, BK = 64, HALF = 128, HTB = HALF * BK * 2, STAGE_BYTES = 8 * HTB, NXCD = 8, WGM = 8;
DI int lds_byte(int r, int c) { const int st = (r >> 4) * 2 + (c >> 5), rr = r & 15, cc = c & 31, ob = rr * 64 + cc * 2; return st * 1024 + (ob ^ (((ob >> 9) & 1) << 5)); }
DI void stage_rc(int b, int& R, int& C) { const int st = b / 1024, sb = b % 1024, swz = sb ^ (((sb >> 9) & 1) << 5); R = (st >> 1) * 16 + swz / 64; C = (st & 1) * 32 + (swz % 64) / 2; }
DI int perm32(int rho) { const int n = rho >> 4, i = rho & 15; return 8 * (i >> 2) + 4 * n + (i & 3); }
struct Unit { int pm, pn; };
struct Gemm { const bf16_t* A; const bf16_t* Bt; int M, N, K, lda; };
struct StaticOrder {
  int nM, nN, nwg, G, c;
  DI void init(int M, int N, int G_, int c_) { nM = M / BM; nN = N / BM; nwg = nM * nN; G = G_; c = c_; }
  DI bool next(int i, Unit& u) const {
    const long L = (long)i * G + c; if (L >= nwg) return false;
    int wgid = (int)L; { const int q = nwg / NXCD, r = nwg % NXCD, xcd = wgid % NXCD, off = wgid / NXCD; wgid = (xcd < r ? xcd * (q + 1) : r * (q + 1) + (xcd - r) * q) + off; }
    const int nig = WGM * nN, gid = wgid / nig, fm = gid * WGM, gsz = (nM - fm) < WGM ? (nM - fm) : WGM;
    u.pm = fm + ((wgid % nig) % gsz); u.pn = (wgid % nig) / gsz; return true;
  }
};

template <class Epi>
DI void gemm_phase(LAS unsigned char* lds, const Gemm g, const StaticOrder& S, const Epi& E) {
  const int tid = opaque_tid(), wid = __builtin_amdgcn_readfirstlane(tid >> 6), lane = tid & 63, wr = wid >> 2, wc = wid & 3, fr = lane & 15, fq = lane >> 4;
  const int K = g.K, nt = K / BK, lda = g.lda;
  unsigned voffA[2], voffB[2];
#pragma unroll
  for (int i = 0; i < 2; ++i) { int R, C; stage_rc(tid * 16 + i * 8192, R, C); const int Rb = (R & ~31) + perm32(R & 31);
    voffA[i] = (unsigned)(R * lda + C) * 2u; voffB[i] = (unsigned)(Rb * K + C) * 2u; }
  const size_t kstep = (size_t)(BK * 2);
  const size_t hstepA = (size_t)HALF * lda * 2, hstepB = (size_t)HALF * K * 2;
  const size_t tstepA = 2 * hstepA, tstepB = 2 * hstepB;
  const unsigned ldsw = (unsigned)wid * 1024u;
  const int aoff = lds_byte(wr * 64 + fr, fq * 8), boff = lds_byte(wc * 32 + fr, fq * 8);
#define PG8_SA(b, h) (((b) * 2 + (h)) * HTB)
#define PG8_SB(b, h) ((4 + (b) * 2 + (h)) * HTB)
#define PG8_STAGE(bufoff, gbase, voff) do { _Pragma("unroll") for (int _i = 0; _i < 2; ++_i) \
    __builtin_amdgcn_global_load_lds((const unsigned*)((const char*)(gbase) + (voff)[_i]), (LAS unsigned*)(lds + (bufoff) + ldsw + _i * 8192), 16, 0, 0); } while (0)
#define PG8_LDA(dst, b, h) do { _Pragma("unroll") for (int m = 0; m < 4; ++m) _Pragma("unroll") for (int k = 0; k < 2; ++k) dst[m][k] = *(const LAS bf16x8*)(lds + PG8_SA(b, h) + aoff + m * 2048 + k * 1024); } while (0)
#define PG8_LDB(dst, b, h) do { _Pragma("unroll") for (int n = 0; n < 2; ++n) _Pragma("unroll") for (int k = 0; k < 2; ++k) dst[n][k] = *(const LAS bf16x8*)(lds + PG8_SB(b, h) + boff + n * 2048 + k * 1024); } while (0)
#define PG8_MMA(ai, bj, At, Bt) do { __builtin_amdgcn_s_setprio(1); _Pragma("unroll") for (int m = 0; m < 4; ++m) _Pragma("unroll") for (int n = 0; n < 2; ++n) _Pragma("unroll") for (int k = 0; k < 2; ++k) \
    acc[ai][bj][m][n] = __builtin_amdgcn_mfma_f32_16x16x32_bf16(Bt[n][k], At[m][k], acc[ai][bj][m][n], 0, 0, 0); __builtin_amdgcn_s_setprio(0); } while (0)
#define PG8_WAIT_V(n) asm volatile("s_waitcnt vmcnt(" #n ")" ::: "memory")
#define PG8_WAIT_L(n) asm volatile("s_waitcnt lgkmcnt(" #n ")" ::: "memory")
#define PG8_BAR __builtin_amdgcn_s_barrier()
#define PG8_SCHED __builtin_amdgcn_sched_barrier(0)
  Unit cur, nxt; int ui = 0;
  if (!S.next(0, cur)) return;
  f32x4 acc[2][2][4][2];
#pragma unroll
  for (int a = 0; a < 2; ++a)
#pragma unroll
    for (int b = 0; b < 2; ++b)
#pragma unroll
      for (int m = 0; m < 4; ++m)
#pragma unroll
        for (int n = 0; n < 2; ++n) acc[a][b][m][n] = (f32x4){0.f, 0.f, 0.f, 0.f};
  bf16x8 At[4][2], B0[2][2], B1[2][2];
  const char* cA = (const char*)g.A + (size_t)cur.pm * tstepA; const char* cB = (const char*)g.Bt + (size_t)cur.pn * tstepB;
  PG8_STAGE(PG8_SB(0, 0), cB, voffB); PG8_STAGE(PG8_SA(0, 0), cA, voffA); PG8_STAGE(PG8_SB(0, 1), cB + hstepB, voffB); PG8_STAGE(PG8_SA(0, 1), cA + hstepA, voffA);
  if (wr == 1) PG8_BAR;
  PG8_WAIT_V(4); PG8_BAR;
  PG8_STAGE(PG8_SB(1, 0), cB + kstep, voffB); PG8_STAGE(PG8_SA(1, 0), cA + kstep, voffA); PG8_STAGE(PG8_SB(1, 1), cB + hstepB + kstep, voffB);
  PG8_WAIT_V(6); PG8_BAR;
  for (;;) {
    const bool has_next = S.next(ui + 1, nxt);
    const char* nA = has_next ? (const char*)g.A + (size_t)nxt.pm * tstepA : cA; const char* nB = has_next ? (const char*)g.Bt + (size_t)nxt.pn * tstepB : cB;
    for (int t = 0; t < nt; t += 2) {
      const bool last = (t == nt - 2);
      const char* a1 = cA + (size_t)(t + 1) * kstep;
      const char* a2 = last ? nA : cA + (size_t)(t + 2) * kstep; const char* b2 = last ? nB : cB + (size_t)(t + 2) * kstep;
      const char* a3 = a2 + kstep; const char* b3 = b2 + kstep;
      PG8_LDB(B0, 0, 0); PG8_SCHED; PG8_LDA(At, 0, 0); PG8_STAGE(PG8_SA(1, 1), a1 + hstepA, voffA);
      PG8_WAIT_L(8); PG8_BAR; PG8_WAIT_L(0); PG8_MMA(0, 0, At, B0); PG8_BAR; PG8_SCHED;
      PG8_LDB(B1, 0, 1); PG8_STAGE(PG8_SB(0, 0), b2, voffB);
      PG8_BAR; PG8_WAIT_L(0); PG8_MMA(0, 1, At, B1); PG8_BAR;
      PG8_LDA(At, 0, 1); PG8_STAGE(PG8_SA(0, 0), a2, voffA);
      PG8_BAR; PG8_WAIT_L(0); PG8_MMA(1, 0, At, B0); PG8_BAR; PG8_SCHED;
      PG8_STAGE(PG8_SB(0, 1), b2 + hstepB, voffB);
      PG8_WAIT_V(6); PG8_BAR; PG8_MMA(1, 1, At, B1); PG8_BAR;
      PG8_LDB(B0, 1, 0); PG8_SCHED; PG8_LDA(At, 1, 0); PG8_STAGE(PG8_SA(0, 1), a2 + hstepA, voffA);
      PG8_WAIT_L(8); PG8_BAR; PG8_WAIT_L(0); PG8_MMA(0, 0, At, B0); PG8_BAR; PG8_SCHED;
      PG8_LDB(B1, 1, 1); PG8_STAGE(PG8_SB(1, 0), b3, voffB);
      PG8_BAR; PG8_WAIT_L(0); PG8_MMA(0, 1, At, B1); PG8_BAR;
      PG8_LDA(At, 1, 1); PG8_STAGE(PG8_SA(1, 0), a3, voffA);
      PG8_BAR; PG8_WAIT_L(0); PG8_MMA(1, 0, At, B0); PG8_BAR; PG8_SCHED;
      PG8_STAGE(PG8_SB(1, 1), b3 + hstepB, voffB);
      PG8_WAIT_V(6); PG8_BAR; PG8_MMA(1, 1, At, B1); PG8_BAR;
    }
    E(acc, cur, wr, wc, fr, fq);
    if (!has_next) break;
#pragma unroll
    for (int a = 0; a < 2; ++a)
#pragma unroll
      for (int b = 0; b < 2; ++b)
#pragma unroll
        for (int m = 0; m < 4; ++m)
#pragma unroll
          for (int n = 0; n < 2; ++n) acc[a][b][m][n] = (f32x4){0.f, 0.f, 0.f, 0.f};
    cur = nxt; cA = nA; cB = nB; ++ui;
  }
  PG8_WAIT_V(0);
  if (wr == 0) PG8_BAR;
  PG8_BAR;
#undef PG8_SA
#undef PG8_SB
#undef PG8_STAGE
#undef PG8_LDA
#undef PG8_LDB
#undef PG8_MMA
#undef PG8_WAIT_V
#undef PG8_WAIT_L
#undef PG8_BAR
#undef PG8_SCHED
}
}

struct Epi {
  bf16_t* out; int ldc;
  int rope64_end;
  int rope32_lo, rope32_hi;
  int qmode;
  const float* pin; int nK;
  int pslot;
  float* pout;
  const float *cosH, *sinH, *cosR, *sinR;
  DI void operator()(const f32x4 (&acc)[2][2][4][2], const pg8::Unit& u, int wr, int wc, int fr, int fq) const {
    const int row0 = u.pm * 256 + wr * 64 + fr;
    int rt[2];
#pragma unroll
    for (int bj = 0; bj < 2; ++bj) {
      const int cw = u.pn * 256 + bj * 128 + wc * 32;
      rt[bj] = 0;
      if (cw < rope64_end) rt[bj] = 1;
      else if (cw >= rope32_lo && cw < rope32_hi) rt[bj] = 2;
      else if (qmode && ((cw >> 5) % 3) == 2) rt[bj] = 2;
    }
    const int tt = rt[0] | rt[1];
    const float* ctab = (tt == 1) ? cosH + (16 * (wc & 1) + 4 * fq) : cosR + 4 * fq;
    const float* stab = (tt == 1) ? sinH + (16 * (wc & 1) + 4 * fq) : sinR + 4 * fq;
    const int tstride = (tt == 1) ? 32 : 16;
    int ps[2] = {-1, -1};
    if (pout) {
#pragma unroll
      for (int bj = 0; bj < 2; ++bj) { const int cw = u.pn * 256 + bj * 128 + wc * 32;
        if (cw >= 1792 && cw < 2432) ps[bj] = ((cw - 1792) >> 7) * 4 + wc; }
    }
#pragma unroll
    for (int ai = 0; ai < 2; ++ai) {
      f32x4 cv[4], sv[4]; float rs[4];
#pragma unroll
      for (int m = 0; m < 4; ++m) {
        const int row = row0 + ai * 128 + m * 16;
        if (tt) { const int pos = row & (SEQ - 1); cv[m] = *(const f32x4*)(ctab + pos * tstride); sv[m] = *(const f32x4*)(stab + pos * tstride); }
        rs[m] = 1.f;
        if (pin) { const f32x4 p0 = *(const f32x4*)(pin + (size_t)row * 20 + pslot), p1 = *(const f32x4*)(pin + (size_t)row * 20 + pslot + 4);
          float ss = ((p0[0] + p0[1]) + (p0[2] + p0[3])) + ((p1[0] + p1[1]) + (p1[2] + p1[3]));
          if (nK == 384) { const f32x4 p2 = *(const f32x4*)(pin + (size_t)row * 20 + pslot + 8); ss += (p2[0] + p2[1]) + (p2[2] + p2[3]); }
          rs[m] = rsqrtf(ss / (float)nK + EPS); }
      }
#pragma unroll
      for (int m = 0; m < 4; ++m) {
        const int row = row0 + ai * 128 + m * 16;
#pragma unroll
        for (int bj = 0; bj < 2; ++bj) {
          const int c0 = u.pn * 256 + bj * 128 + wc * 32 + 8 * fq;
          f32x4 v0 = acc[ai][bj][m][0] * rs[m], v1 = acc[ai][bj][m][1] * rs[m];
          if (ps[bj] >= 0) {
            float sq = (v0[0] * v0[0] + v0[1] * v0[1]) + (v0[2] * v0[2] + v0[3] * v0[3]) + (v1[0] * v1[0] + v1[1] * v1[1]) + (v1[2] * v1[2] + v1[3] * v1[3]);
            sq += __shfl_xor(sq, 16); sq += __shfl_xor(sq, 32);
            if (fq == 0) pout[(size_t)row * 20 + ps[bj]] = sq;
          }
          if (rt[bj]) {
            const f32x4 o1 = v0 * cv[m] - v1 * sv[m], o2 = v1 * cv[m] + v0 * sv[m];
            v0 = o1; v1 = o2;
          }
          u32x4 w; w.x = pk2(v0[0], v0[1]); w.y = pk2(v0[2], v0[3]); w.z = pk2(v1[0], v1[1]); w.w = pk2(v1[2], v1[3]);
          *(u32x4*)(out + (size_t)row * ldc + c0) = w;
        }
      }
    }
  }
};

DI int ropeperm64(int p) { const int g = p >> 3, r = p & 7; return r < 4 ? 4 * g + r : 32 + 4 * g + (r - 4); }
DI int ropeperm32(int p) { const int g = p >> 3, r = p & 7; return r < 4 ? 4 * g + r : 16 + 4 * g + (r - 4); }
DI int srccol(int kind, int n) {
  if (kind == 0) {
    if (n < 512) return 672 + (n & ~63) + ropeperm64(n & 63);
    if (n < 640) return 1184 + ((n - 512) & ~63) + ropeperm64(n & 63);
    if (n < 768) return 1312 + (n - 640);
    if (n < 1792) return 1440 + (n - 768);
    if (n < 2176) return n - 1792;
    if (n < 2432) return 384 + (n - 2176);
    if (n < 2464) return 640 + ropeperm32(n - 2432);
    return -1;
  }
  if (kind == 1) {
    if (n < 1024) return (n & ~63) + ropeperm64(n & 63);
    if (n < 3072) return n;
    return 3080 + (n - 3072);
  }
  if (kind == 2) { const int hd = n / 96, p = n - hd * 96; return hd * 96 + (p < 64 ? p : 64 + ropeperm32(p - 64)); }
  return n;
}
DI void convert_tile(LAS unsigned char* lds, const float* W, int Nsrc, int K, bf16_t* Wt, int kind, const float* g, int tn, int tk) {
  const int tid = opaque_tid();
  LAS bf16_t* tile = (LAS bf16_t*)lds;
  const int nl = tid & 63, ks = tid >> 6;
  const int sc = srccol(kind, tn * 64 + nl);
#pragma unroll
  for (int kk = ks; kk < 64; kk += 8) {
    const int k = tk * 64 + kk;
    float v = 0.f;
    if (sc >= 0) { v = W[(size_t)k * Nsrc + sc]; if (g) v *= g[k]; }
    tile[nl * 72 + kk] = f2bf(v);
  }
  __syncthreads();
  { const int n2 = tid >> 3, ch = tid & 7;
    const u32x4 v = *(const LAS u32x4*)(tile + n2 * 72 + ch * 8);
    *(u32x4*)(Wt + (size_t)(tn * 64 + n2) * K + tk * 64 + ch * 8) = v; }
  __syncthreads();
}

DI void prologue(const Params& p, LAS unsigned char* lds) {
  const int tid = opaque_tid(), G = gridDim.x, bid = blockIdx.x;
  unsigned char* ws = p.ws;
  for (int idx = bid * 512 + tid; idx < 2048 * 48; idx += G * 512) {
    const bool isH = idx < 2048 * 32;
    const int j = isH ? idx : idx - 2048 * 32;
    const int pos = isH ? (j >> 5) : (j >> 4), i = isH ? (j & 31) : (j & 15);
    const float e = isH ? (float)(2 * i) * (1.f / 64.f) : (float)(2 * i) * (1.f / 32.f);
    const float inv = fast_exp2(-e * 13.287712379549449f);
    const float ang = (float)pos * inv;
    double t = (double)ang * 0.15915494309189535; t -= rint(t);
    const float fr = (float)t;
    const float cv = __builtin_amdgcn_cosf(fr), sv = __builtin_amdgcn_sinf(fr);
    if (isH) { ((float*)(ws + WS_COSH))[j] = cv; ((float*)(ws + WS_SINH))[j] = sv; }
    else { ((float*)(ws + WS_COSR))[j] = cv; ((float*)(ws + WS_SINR))[j] = sv; }
  }
  constexpr int NT0 = 40 * 16, NT1 = 64 * 16, NT2 = 12 * 6, NT3 = 16 * 4, NT4 = 16 * 16;
  constexpr int PER_I = NT0 + NT1 + NT2 + NT3 + 2 * NT4;
  for (int job = bid; job < 2 * PER_I; job += G) {
    const int i = job / PER_I; int j = job - i * PER_I;
    if (j < NT0) { convert_tile(lds, p.ev_w_in + (size_t)i * 1024 * 2464, 2464, 1024, (bf16_t*)(ws + WS_WEVIN + i * SZ_WEVIN), 0, nullptr, j / 16, j % 16); continue; }
    j -= NT0;
    if (j < NT1) { convert_tile(lds, p.od_w_in + (size_t)i * 1024 * 4104, 4104, 1024, (bf16_t*)(ws + WS_WODIN + i * SZ_WODIN), 1, nullptr, j / 16, j % 16); continue; }
    j -= NT1;
    if (j < NT2) { convert_tile(lds, p.ev_w_uq + (size_t)i * 384 * 768, 768, 384, (bf16_t*)(ws + WS_WUQ + i * SZ_WUQ), 2, p.ev_q_norm + i * 384, j / 6, j % 6); continue; }
    j -= NT2;
    if (j < NT3) { convert_tile(lds, p.ev_w_ukv + (size_t)i * 256 * 1024, 1024, 256, (bf16_t*)(ws + WS_WUKV + i * SZ_WUKV), 3, p.ev_kv_norm + i * 256, j / 4, j % 4); continue; }
    j -= NT3;
    if (j < NT4) { convert_tile(lds, p.ev_w_out + (size_t)i * 1024 * 1024, 1024, 1024, (bf16_t*)(ws + WS_WEVOUT + i * SZ_WOUT), 4, nullptr, j / 16, j % 16); continue; }
    j -= NT4;
    convert_tile(lds, p.od_w_out + (size_t)i * 1024 * 1024, 1024, 1024, (bf16_t*)(ws + WS_WODOUT + i * SZ_WOUT), 4, nullptr, j / 16, j % 16);
  }
  const int item0 = G - 1 - bid;
  if (item0 < 192) {
    LAS float* cond = (LAS float*)lds;
    LAS float* red = (LAS float*)(lds + 65536);
    for (int e = tid; e < 16 * 1024; e += 512) { const int b = e >> 10, k = e & 1023; cond[k * 16 + b] = silu_f(p.c[e]); }
    __syncthreads();
    for (int item = item0; item < 192; item += G) {
      const int l = item / 48, n0 = (item % 48) * 64;
      const int col = tid & 63, kg = tid >> 6;
      float a[16];
#pragma unroll
      for (int b = 0; b < 16; ++b) a[b] = 0.f;
      const float* wp = p.w_ada + (size_t)l * 1024 * 3072 + n0 + col;
      for (int k = kg * 128; k < kg * 128 + 128; ++k) {
        const float w = wp[(size_t)k * 3072];
#pragma unroll
        for (int b4 = 0; b4 < 4; ++b4) { const f32x4 cv = *(const LAS f32x4*)(cond + k * 16 + b4 * 4);
          a[b4 * 4 + 0] += cv[0] * w; a[b4 * 4 + 1] += cv[1] * w; a[b4 * 4 + 2] += cv[2] * w; a[b4 * 4 + 3] += cv[3] * w; }
      }
#pragma unroll
      for (int b = 0; b < 16; ++b) red[(kg * 16 + b) * 64 + col] = a[b];
      __syncthreads();
      for (int e = tid; e < 1024; e += 512) { const int b = e >> 6, cc = e & 63; float s = 0.f;
#pragma unroll
        for (int k8 = 0; k8 < 8; ++k8) s += red[(k8 * 16 + b) * 64 + cc];
        ((float*)(ws + WS_MOD))[((size_t)l * 16 + b) * 3072 + n0 + cc] = s + p.b_ada[l * 3072 + n0 + cc]; }
      __syncthreads();
    }
  }
}

DI void rowwise_phase(const Params& p, LAS unsigned char* lds, int lp, int ln) {
  const int tid = opaque_tid(), lane = tid & 63, wid = tid >> 6;
  const int gw = blockIdx.x * 8 + wid, nw = gridDim.x * 8;
  unsigned char* ws = p.ws;
  const float* mod = (const float*)(ws + WS_MOD);
  const bf16_t* ybuf = (const bf16_t*)(ws + WS_HBUF);
  bf16_t* hbuf = (bf16_t*)(ws + WS_HBUF);
  const bool ff = (ln < 4) && (ln & 1);
  float fbias[8];
#pragma unroll
  for (int h = 0; h < 8; ++h) fbias[h] = 0.f;
  LAS f32x4* wl = (LAS f32x4*)lds;
  if (ff) {
    const float* w = p.od_w_in + (size_t)(ln >> 1) * 1024 * 4104 + 3072;
    for (int c = tid; c < 1024; c += 512) {
      const f32x4 w0 = *(const f32x4*)(w + (size_t)c * 4104), w1 = *(const f32x4*)(w + (size_t)c * 4104 + 4);
      const int ln_ = (c & 255) >> 2, e = c & 3, j = c >> 8;
      wl[(j * 4 + e) * 64 + ln_] = w0; wl[1024 + (j * 4 + e) * 64 + ln_] = w1;
    }
#pragma unroll
    for (int h = 0; h < 8; ++h) fbias[h] = p.od_forget_bias[(ln >> 1) * 8 + h];
    __syncthreads();
  }
  for (int row = gw; row < T; row += nw) {
    const int b = row >> 11;
    f32x4 xv[4];
    const float* xin = (lp <= 0 ? p.x : p.out) + (size_t)row * DM;
#pragma unroll
    for (int j = 0; j < 4; ++j) xv[j] = *(const f32x4*)(xin + 4 * lane + 256 * j);
    if (lp >= 0) {
      f32x4 yv[4]; float ss = 0.f;
#pragma unroll
      for (int j = 0; j < 4; ++j) { const u32x2 u = *(const u32x2*)(ybuf + (size_t)row * DM + 4 * lane + 256 * j);
        yv[j] = (f32x4){bflo(u.x), bfhi(u.x), bflo(u.y), bfhi(u.y)}; ss += yv[j][0] * yv[j][0] + yv[j][1] * yv[j][1] + yv[j][2] * yv[j][2] + yv[j][3] * yv[j][3]; }
      ss = wave_sum(ss);
      const float rs = rsqrtf(ss * (1.f / DM) + EPS);
#pragma unroll
      for (int j = 0; j < 4; ++j) {
        const int c = 4 * lane + 256 * j;
        const f32x4 gt = *(const f32x4*)(mod + ((size_t)lp * 16 + b) * 3072 + 2048 + c);
        const f32x4 gp = *(const f32x4*)(p.g_post + lp * DM + c);
        xv[j] = xv[j] + gt * (yv[j] * rs * gp);
        *(f32x4*)(p.out + (size_t)row * DM + c) = xv[j];
      }
    }
    if (ln < 4) {
      float ss = 0.f;
#pragma unroll
      for (int j = 0; j < 4; ++j) ss += xv[j][0] * xv[j][0] + xv[j][1] * xv[j][1] + xv[j][2] * xv[j][2] + xv[j][3] * xv[j][3];
      ss = wave_sum(ss);
      const float rs = rsqrtf(ss * (1.f / DM) + EPS);
      float zf[8];
#pragma unroll
      for (int h = 0; h < 8; ++h) zf[h] = 0.f;
#pragma unroll
      for (int j = 0; j < 4; ++j) {
        const int c = 4 * lane + 256 * j;
        const f32x4 sh = *(const f32x4*)(mod + ((size_t)ln * 16 + b) * 3072 + c);
        const f32x4 sc = *(const f32x4*)(mod + ((size_t)ln * 16 + b) * 3072 + 1024 + c);
        const f32x4 gp = *(const f32x4*)(p.g_pre + ln * DM + c);
        const f32x4 hv = (xv[j] * rs * gp) * (sc + 1.f) + sh;
        u32x2 w; w.x = pk2(hv[0], hv[1]); w.y = pk2(hv[2], hv[3]);
        *(u32x2*)(hbuf + (size_t)row * DM + c) = w;
        if (ff) {
#pragma unroll
          for (int e = 0; e < 4; ++e) {
            const f32x4 w0 = wl[(j * 4 + e) * 64 + lane], w1 = wl[1024 + (j * 4 + e) * 64 + lane];
            zf[0] += hv[e] * w0[0]; zf[1] += hv[e] * w0[1]; zf[2] += hv[e] * w0[2]; zf[3] += hv[e] * w0[3];
            zf[4] += hv[e] * w1[0]; zf[5] += hv[e] * w1[1]; zf[6] += hv[e] * w1[2]; zf[7] += hv[e] * w1[3];
          }
        }
      }
      if (ff) {
#pragma unroll
        for (int h = 0; h < 8; ++h) zf[h] = wave_sum(zf[h]);
        if (lane < 8) {
          float z = 0.f;
#pragma unroll
          for (int h = 0; h < 8; ++h) z = (lane == h) ? zf[h] + fbias[h] : z;
          const float ls = fminf(z, 0.f) - __builtin_amdgcn_logf(1.f + fast_exp2(-fabsf(z) * LOG2E)) * 0.6931471805599453f;
          ((float*)(ws + WS_LOGF))[(size_t)row * 8 + lane] = ls;
        }
      }
    }
  }
  __syncthreads();
}

DI void fox_scan(const Params& p, LAS unsigned char* lds, int bh) {
  const int tid = opaque_tid();
  const int b = bh >> 3, h = bh & 7;
  const float* logf_ = (const float*)(p.ws + WS_LOGF);
  float* fcum = (float*)(p.ws + WS_FCUM) + (size_t)bh * SEQ;
  LAS float* s = (LAS float*)lds;
  float v[4];
#pragma unroll
  for (int j = 0; j < 4; ++j) v[j] = logf_[((size_t)b * SEQ + 4 * tid + j) * 8 + h];
  v[1] += v[0]; v[2] += v[1]; v[3] += v[2];
  s[tid] = v[3];
  __syncthreads();
  for (int off = 1; off < 512; off <<= 1) {
    float t = 0.f;
    if (tid >= off) t = s[tid - off];
    __syncthreads();
    s[tid] += t;
    __syncthreads();
  }
  const float excl = s[tid] - v[3];
#pragma unroll
  for (int j = 0; j < 4; ++j) fcum[4 * tid + j] = -8.0f * (excl + v[j]);
  __syncthreads();
}

struct AttnArgs { const bf16_t *q, *k, *k2, *v, *gate; bf16_t* out; const float* fcum; int ldq, ldk, ldk2, ldv, ldo, ldg; float sl2, sink; };

DI float half_max(float x) {
  const unsigned u = __float_as_uint(x);
  auto r = __builtin_amdgcn_permlane32_swap(u, u, false, false);
  return fmaxf(__uint_as_float(r[0]), __uint_as_float(r[1]));
}
DI float half_sum(float x) {
  const unsigned u = __float_as_uint(x);
  auto r = __builtin_amdgcn_permlane32_swap(u, u, false, false);
  return __uint_as_float(r[0]) + __uint_as_float(r[1]);
}

template <int N> DI void wait_vmcnt() { asm volatile("s_waitcnt vmcnt(%0)" ::"n"(N) : "memory"); }
DI void raw_barrier() { asm volatile("" ::: "memory"); __builtin_amdgcn_s_barrier(); asm volatile("" ::: "memory"); }

template <int DQK, int DV, int MODE>
DI void attn_item(LAS unsigned char* lds, const AttnArgs& a, int qb) {
  constexpr int KSTR = DQK * 2 + 16, VSTR = (DV == 64) ? 192 : 320;
  constexpr int KG16 = KSTR / 16, VG16 = VSTR / 16;
  constexpr int KCH = KG16, VCH = VG16, NCH = KCH + VCH;
  constexpr int TILE = NCH * 1024 + (MODE == 2 ? 2048 : 0);
  constexpr int NSLOT = (NCH + 7) / 8, REM = NCH - 8 * (NSLOT - 1);
  constexpr int FX = (MODE == 2) ? 1 : 0;
  constexpr int NKS = DQK / 16, NBLK = DV / 32;
  static_assert(4 * TILE <= 131072, "ring too large");
  const int tid = opaque_tid(), wid = __builtin_amdgcn_readfirstlane(tid >> 6), lane = tid & 63, r = lane & 31, hh = lane >> 5;
  const int q0 = qb * 256, qw = q0 + 32 * wid, myq = qw + r;
  const float c = a.sl2, tau = 8.0f / a.sl2;
  bf16x8 qf[NKS];
#pragma unroll
  for (int ks = 0; ks < NKS; ++ks) qf[ks] = *(const bf16x8*)(a.q + (size_t)myq * a.ldq + 16 * ks + 8 * hh);
  int lo = 0; const int hi = 4 * (qb + 1);
  if (MODE == 1) { lo = 4 * qb - 2; if (lo < 0) lo = 0; }
  const int last_w = (qw + 31) >> 6;
  int first_w = 0;
  if (MODE == 1) { first_w = (qw > 127 ? qw - 127 : 0) >> 6; }
  const char* sp[NSLOT]; unsigned sst[NSLOT];
#pragma unroll
  for (int j = 0; j < NSLOT; ++j) {
    const int ch_ = 8 * j + wid;
    if (ch_ < KCH) {
      const int p = ch_ * 64 + lane, row = p / KG16, g = p - row * KG16;
      if (DQK == 96 && g >= 8 && g < 12) { sp[j] = (const char*)(a.k2 + (size_t)row * a.ldk2 + 8 * (g - 8)); sst[j] = (unsigned)(128 * a.ldk2); }
      else { sp[j] = (const char*)(a.k + (size_t)row * a.ldk + 8 * (g < 8 ? g : 0)); sst[j] = (unsigned)(128 * a.ldk); }
    } else {
      const int p = (ch_ - KCH) * 64 + lane, row = (p / VG16) & 63, g = p - (p / VG16) * VG16;
      sp[j] = (const char*)(a.v + (size_t)row * a.ldv + 8 * (g < DV / 8 ? g : 0)); sst[j] = (unsigned)(128 * a.ldv);
    }
  }
  auto issue = [&](int kt) {
    LAS unsigned char* base = lds + (kt & 3) * TILE;
#pragma unroll
    for (int j = 0; j < NSLOT; ++j) {
      if (j < NSLOT - 1 || wid < REM)
        __builtin_amdgcn_global_load_lds((const unsigned*)(sp[j] + (size_t)kt * sst[j]), (LAS unsigned*)(base + (8 * j + wid) * 1024), 16, 0, 0);
    }
    if (MODE == 2) __builtin_amdgcn_global_load_lds((const unsigned*)(a.fcum + kt * 64 + lane), (LAS unsigned*)(base + NCH * 1024 + wid * 256), 4, 0, 0);
  };
  auto wait_tiles = [&](bool all) {
    if (all) wait_vmcnt<0>();
    else if (wid < REM) wait_vmcnt<NSLOT + FX>();
    else wait_vmcnt<NSLOT - 1 + FX>();
  };
  f32x16 O[NBLK];
#pragma unroll
  for (int bl = 0; bl < NBLK; ++bl)
#pragma unroll
    for (int i = 0; i < 16; ++i) O[bl][i] = 0.f;
  float m = (MODE == 1) ? a.sink / a.sl2 : -1e30f;
  float l0 = (MODE == 1 && hh == 0) ? 1.f : 0.f, l1 = 0.f;
  const int i16 = lane & 15, q4 = i16 >> 2, p4 = i16 & 3, grp = (lane >> 4) & 1;
  auto qk_load = [&](int kt, bf16x8 (&kf)[2][NKS]) {
    LAS unsigned char* Kl = lds + (kt & 3) * TILE;
#pragma unroll
    for (int kb = 0; kb < 2; ++kb)
#pragma unroll
      for (int ks = 0; ks < NKS; ++ks) kf[kb][ks] = *(const LAS bf16x8*)(Kl + (32 * kb + r) * KSTR + (16 * ks + 8 * hh) * 2);
  };
  auto qk_mma = [&](int kt, const bf16x8 (&kf)[2][NKS], f32x16 (&s)[2]) {
#pragma unroll
    for (int kb = 0; kb < 2; ++kb) {
      if (MODE == 2) {
        LAS unsigned char* Fl = lds + (kt & 3) * TILE + NCH * 1024 + wid * 256;
#pragma unroll
        for (int g = 0; g < 4; ++g) { const f32x4 fb = *(const LAS f32x4*)(Fl + (32 * kb + 8 * g + 4 * hh) * 4);
          s[kb][4 * g] = fb[0]; s[kb][4 * g + 1] = fb[1]; s[kb][4 * g + 2] = fb[2]; s[kb][4 * g + 3] = fb[3]; }
      } else {
#pragma unroll
        for (int i = 0; i < 16; ++i) s[kb][i] = 0.f;
      }
    }
#pragma unroll
    for (int ks = 0; ks < NKS; ++ks)
#pragma unroll
      for (int kb = 0; kb < 2; ++kb) s[kb] = __builtin_amdgcn_mfma_f32_32x32x16_bf16(kf[kb][ks], qf[ks], s[kb], 0, 0, 0);
  };
  auto softmax = [&](int kt, f32x16 (&s)[2], bf16x8 (&pf)[2][2], auto maskc) {
    constexpr bool MASK = decltype(maskc)::value;
    const int key0 = kt * 64;
    if (MASK) {
#pragma unroll
      for (int kb = 0; kb < 2; ++kb)
#pragma unroll
        for (int i = 0; i < 16; ++i) {
          const int key = key0 + 32 * kb + (i & 3) + 8 * (i >> 2) + 4 * hh;
          bool valid = key <= myq; if (MODE == 1) valid = valid && (myq - key < 128);
          s[kb][i] = valid ? s[kb][i] : -1e30f;
        }
    }
    float mx = fmaxf(s[0][0], s[1][0]);
#pragma unroll
    for (int i = 1; i < 16; ++i) mx = fmaxf(fmaxf(mx, s[0][i]), s[1][i]);
    mx = half_max(mx);
    if (__builtin_amdgcn_ballot_w64(mx > m + tau) != 0ull) {
      const float mnew = fmaxf(m, mx);
      const float alpha = fast_exp2((m - mnew) * c);
      m = mnew;
      l0 *= alpha; l1 *= alpha;
#pragma unroll
      for (int bl = 0; bl < NBLK; ++bl)
#pragma unroll
        for (int i = 0; i < 16; ++i) O[bl][i] *= alpha;
    }
    const float nmc = -m * c;
#pragma unroll
    for (int kb = 0; kb < 2; ++kb)
#pragma unroll
      for (int s2 = 0; s2 < 2; ++s2) {
        float pv[8];
#pragma unroll
        for (int e = 0; e < 8; ++e) pv[e] = fast_exp2(__builtin_fmaf(s[kb][8 * s2 + e], c, nmc));
        l0 += (pv[0] + pv[4]) + (pv[2] + pv[6]); l1 += (pv[1] + pv[5]) + (pv[3] + pv[7]);
        u32x4 w;
        w.x = pk2(pv[0], pv[1]); w.y = pk2(pv[2], pv[3]); w.z = pk2(pv[4], pv[5]); w.w = pk2(pv[6], pv[7]);
        pf[kb][s2] = __builtin_bit_cast(bf16x8, w);
      }
  };
  auto pvmm = [&](int kt, const bf16x8 (&pf)[2][2]) {
    constexpr int PD = (NBLK == 2) ? 2 : 1;
    const unsigned va = (unsigned)(size_t)(lds + (kt & 3) * TILE + KCH * 1024 + (4 * hh + q4) * VSTR + (16 * grp) * 2 + 8 * p4);
    s16x4 vl[PD + 1][NBLK], vh[PD + 1][NBLK];
#define TRRD(dst, off) asm volatile("ds_read_b64_tr_b16 %0, %1 offset:%2" : "=&v"(dst) : "v"(va), "n"(off) : "memory")
#define TRSTEP(st_) do { _Pragma("unroll") for (int bl = 0; bl < NBLK; ++bl) { TRRD(vl[(st_) % (PD + 1)][bl], 16 * (st_) * VSTR + 64 * bl); TRRD(vh[(st_) % (PD + 1)][bl], 16 * (st_) * VSTR + 64 * bl + 8 * VSTR); } } while (0)
#define TRWAIT(n_, b_) do { if (NBLK == 2) asm volatile("s_waitcnt lgkmcnt(" #n_ ")" : "+v"(vl[b_][0]), "+v"(vh[b_][0]), "+v"(vl[b_][1]), "+v"(vh[b_][1])::"memory"); \
    else asm volatile("s_waitcnt lgkmcnt(" #n_ ")" : "+v"(vl[b_][0]), "+v"(vh[b_][0]), "+v"(vl[b_][1]), "+v"(vh[b_][1]), "+v"(vl[b_][2 % NBLK]), "+v"(vh[b_][2 % NBLK]), "+v"(vl[b_][3 % NBLK]), "+v"(vh[b_][3 % NBLK])::"memory"); } while (0)
#pragma unroll
    for (int st = 0; st < PD; ++st) TRSTEP(st);
#pragma unroll
    for (int st = 0; st < 4; ++st) {
      if (st + PD < 4) TRSTEP(st + PD);
      const int ahead = ((st + PD < 4) ? st + PD : 3) - st;
      const int b_ = st % (PD + 1);
      if (ahead * 2 * NBLK == 8) TRWAIT(8, b_); else if (ahead * 2 * NBLK == 4) TRWAIT(4, b_); else TRWAIT(0, b_);
#pragma unroll
      for (int bl = 0; bl < NBLK; ++bl) {
        const bf16x8 vf = __builtin_shufflevector(vl[b_][bl], vh[b_][bl], 0, 1, 2, 3, 4, 5, 6, 7);
        O[bl] = __builtin_amdgcn_mfma_f32_32x32x16_bf16(vf, pf[st >> 1][st & 1], O[bl], 0, 0, 0);
      }
    }
#undef TRRD
#undef TRSTEP
#undef TRWAIT
  };
  auto act = [&](int kt) { return kt <= last_w && kt >= first_w; };
  f32x16 sA[2];
  wait_vmcnt<0>();
  issue(lo);
  if (lo + 1 < hi) issue(lo + 1);
  if (lo + 2 < hi) issue(lo + 2);
  wait_tiles(!(lo + 2 < hi));
  raw_barrier();
  if (act(lo)) { bf16x8 kf0[2][NKS]; qk_load(lo, kf0); qk_mma(lo, kf0, sA); }
  auto step = [&](int kt, auto maskc) {
    if (kt + 3 < hi) issue(kt + 3);
    const bool a0 = act(kt), a1 = (kt + 1 < hi) && act(kt + 1);
    bf16x8 pf[2][2], kf[2][NKS];
    if (a1) qk_load(kt + 1, kf);
    __builtin_amdgcn_sched_barrier(0);
    if (a0) softmax(kt, sA, pf, maskc);
    if (a1) qk_mma(kt + 1, kf, sA);
    if (a0) pvmm(kt, pf);
    wait_tiles(!(kt + 3 < hi));
    raw_barrier();
  };
  int split = lo;
  if (MODE != 1) { split = qw >> 6; if (split < lo) split = lo; if (split > hi) split = hi; }
  if (MODE != 1) { for (int kt = lo; kt < split; ++kt) step(kt, std::false_type{}); }
  for (int kt = split; kt < hi; ++kt) step(kt, std::true_type{});
  const float l = half_sum(l0 + l1);
  const float inv = 1.f / l;
#pragma unroll
  for (int bl = 0; bl < NBLK; ++bl)
#pragma unroll
    for (int g = 0; g < 4; ++g) {
      const int f = 32 * bl + 8 * g + 4 * hh;
      float o0 = O[bl][4 * g + 0] * inv, o1 = O[bl][4 * g + 1] * inv, o2 = O[bl][4 * g + 2] * inv, o3 = O[bl][4 * g + 3] * inv;
      if (a.gate) {
        const u32x2 gv = *(const u32x2*)(a.gate + (size_t)myq * a.ldg + f);
        o0 *= silu_f(bflo(gv.x)); o1 *= silu_f(bfhi(gv.x)); o2 *= silu_f(bflo(gv.y)); o3 *= silu_f(bfhi(gv.y));
      }
      u32x2 w; w.x = pk2(o0, o1); w.y = pk2(o2, o3);
      *(u32x2*)(a.out + (size_t)myq * a.ldo + f) = w;
    }
}

DI int snake_idx(int round, int G, int c) { return round * G + ((round & 1) ? (G - 1 - c) : c); }

DI void attn_even(const Params& p, LAS unsigned char* lds, int i) {
  const int G = gridDim.x, c = blockIdx.x;
  unsigned char* ws = p.ws;
  const bf16_t* z = (const bf16_t*)(ws + WS_ZBUF);
  const bf16_t* qb_ = (const bf16_t*)(ws + WS_QBUF);
  const bf16_t* kv = (const bf16_t*)(ws + WS_HBUF);
  bf16_t* ob = (bf16_t*)(ws + WS_OBUF);
  for (int rd = 0; rd * G < 1024; ++rd) {
    const int idx = snake_idx(rd, G, c);
    if (idx >= 1024) continue;
    const int qb = 7 - idx / 128, bh = idx % 128, b = bh >> 3, hd = bh & 7;
    AttnArgs a;
    a.q = qb_ + (size_t)b * SEQ * 768 + hd * 96; a.ldq = 768;
    a.k = kv + (size_t)b * SEQ * 1024 + hd * 128; a.ldk = 1024;
    a.k2 = z + (size_t)b * SEQ * 2560 + 2432; a.ldk2 = 2560;
    a.v = kv + (size_t)b * SEQ * 1024 + hd * 128 + 64; a.ldv = 1024;
    a.out = ob + (size_t)b * SEQ * 1024 + hd * 64; a.ldo = 1024;
    a.gate = z + (size_t)b * SEQ * 2560 + 768 + hd * 64; a.ldg = 2560;
    a.fcum = nullptr; a.sl2 = 0.10206207261596577f * LOG2E; a.sink = 0.f;
    attn_item<96, 64, 0>(lds, a, qb);
  }
  for (int rd = 0; rd * G < 1024; ++rd) {
    const int idx = snake_idx(rd, G, c);
    if (idx >= 1024) continue;
    const int qb = 7 - idx / 128, bh = idx % 128, b = bh >> 3, hd = bh & 7, kvh = hd >> 2;
    AttnArgs a;
    const bf16_t* zb = z + (size_t)b * SEQ * 2560;
    a.q = zb + hd * 64; a.ldq = 2560;
    a.k = zb + 512 + kvh * 64; a.ldk = 2560; a.k2 = nullptr; a.ldk2 = 0;
    a.v = zb + 640 + kvh * 64; a.ldv = 2560;
    a.out = ob + (size_t)b * SEQ * 1024 + 512 + hd * 64; a.ldo = 1024;
    a.gate = zb + 768 + 512 + hd * 64; a.ldg = 2560;
    a.fcum = nullptr; a.sl2 = 0.125f * LOG2E; a.sink = p.ev_sinks[i * 8 + hd] * LOG2E;
    attn_item<64, 64, 1>(lds, a, qb);
  }
}

DI void attn_odd(const Params& p, LAS unsigned char* lds) {
  const int G = gridDim.x, c = blockIdx.x;
  unsigned char* ws = p.ws;
  const bf16_t* z = (const bf16_t*)(ws + WS_ZBUF);
  bf16_t* od = (bf16_t*)(ws + WS_HBUF);
  bf16_t* ob = (bf16_t*)(ws + WS_OBUF);
  for (int rd = 0; rd * G < 1024; ++rd) {
    const int idx = snake_idx(rd, G, c);
    if (idx >= 1024) continue;
    const int qb = 7 - idx / 128, bh = idx % 128, b = bh >> 3, j = bh & 7;
    AttnArgs a;
    const bf16_t* zb = z + (size_t)b * SEQ * 4096;
    a.q = zb + j * 64; a.ldq = 4096;
    a.k = zb + 512 + j * 64; a.ldk = 4096; a.k2 = nullptr; a.ldk2 = 0;
    a.v = zb + 1024 + (j >> 1) * 128; a.ldv = 4096;
    a.out = od + (size_t)b * SEQ * 1024 + j * 128; a.ldo = 1024;
    a.gate = nullptr; a.ldg = 0;
    a.fcum = nullptr; a.sl2 = 0.125f * LOG2E; a.sink = 0.f;
#ifndef SKIP_DIFF
    attn_item<64, 128, 0>(lds, a, qb);
#endif
  }
  for (int rd = 0; rd * G < 1024; ++rd) {
    const int idx = snake_idx(rd, G, c);
    if (idx >= 1024) continue;
    const int qb = 7 - idx / 128, bh = idx % 128, b = bh >> 3, hd = bh & 7;
    AttnArgs a;
    const bf16_t* zb = z + (size_t)b * SEQ * 4096;
    a.q = zb + 1536 + hd * 64; a.ldq = 4096;
    a.k = zb + 2048 + hd * 64; a.ldk = 4096; a.k2 = nullptr; a.ldk2 = 0;
    a.v = zb + 2560 + hd * 64; a.ldv = 4096;
    a.out = ob + (size_t)b * SEQ * 1024 + 512 + hd * 64; a.ldo = 1024;
    a.gate = zb + 3072 + 512 + hd * 64; a.ldg = 4096;
    a.fcum = (const float*)(ws + WS_FCUM) + (size_t)bh * SEQ; a.sl2 = 0.125f * LOG2E; a.sink = 0.f;
#ifndef SKIP_FOX
    attn_item<64, 64, 2>(lds, a, qb);
#endif
  }
}

DI void diff_combine(const Params& p, int layer) {
  const int tid = opaque_tid(), lane = tid & 63, wid = tid >> 6;
  const int gw = blockIdx.x * 8 + wid, nw = gridDim.x * 8;
  const int i = layer >> 1;
  unsigned char* ws = p.ws;
  const bf16_t* od = (const bf16_t*)(ws + WS_HBUF);
  const bf16_t* z = (const bf16_t*)(ws + WS_ZBUF);
  bf16_t* ob = (bf16_t*)(ws + WS_OBUF);
  const float* lp = p.od_lambda + i * 256;
  const float s1 = wave_sum(lp[lane] * lp[64 + lane]), s2 = wave_sum(lp[128 + lane] * lp[192 + lane]);
  const float lam_init = 0.8f - 0.6f * expf(-0.3f * (float)layer);
  const float lam = expf(s1) - expf(s2) + lam_init;
  const int hd = lane >> 4, dv = (lane & 15) * 8;
  float sub[8];
#pragma unroll
  for (int e = 0; e < 8; ++e) sub[e] = p.od_subln[i * 128 + dv + e] * (1.f - lam_init);
  for (int row = gw; row < T; row += nw) {
    const u32x4 a = *(const u32x4*)(od + (size_t)row * 1024 + (2 * hd) * 128 + dv);
    const u32x4 b = *(const u32x4*)(od + (size_t)row * 1024 + (2 * hd + 1) * 128 + dv);
    const u32x4 g = *(const u32x4*)(z + (size_t)row * 4096 + 3072 + hd * 128 + dv);
    float d[8]; float ss = 0.f;
#pragma unroll
    for (int e = 0; e < 4; ++e) { d[2 * e] = bflo(a[e]) - lam * bflo(b[e]); d[2 * e + 1] = bfhi(a[e]) - lam * bfhi(b[e]); ss += d[2 * e] * d[2 * e] + d[2 * e + 1] * d[2 * e + 1]; }
    ss += __shfl_xor(ss, 1); ss += __shfl_xor(ss, 2); ss += __shfl_xor(ss, 4); ss += __shfl_xor(ss, 8);
    const float rs = rsqrtf(ss * (1.f / 128.f) + EPS);
    u32x4 w;
#pragma unroll
    for (int e = 0; e < 4; ++e) {
      const float o0 = d[2 * e] * rs * sub[2 * e] * silu_f(bflo(g[e])), o1 = d[2 * e + 1] * rs * sub[2 * e + 1] * silu_f(bfhi(g[e]));
      w[e] = pk2(o0, o1);
    }
    *(u32x4*)(ob + (size_t)row * 1024 + hd * 128 + dv) = w;
  }
}


DI void grid_barrier(unsigned* ctr, unsigned& epoch) {
  asm volatile("s_waitcnt vmcnt(0)" ::: "memory");
  __syncthreads();
  epoch += 1;
  if (threadIdx.x == 0) {
    __builtin_amdgcn_fence(__ATOMIC_RELEASE, "agent");
    asm volatile("s_waitcnt vmcnt(0)" ::: "memory");
    __hip_atomic_fetch_add(ctr, 1u, __ATOMIC_RELAXED, __HIP_MEMORY_SCOPE_AGENT);
    const unsigned target = epoch * gridDim.x;
    while (__hip_atomic_load(ctr, __ATOMIC_RELAXED, __HIP_MEMORY_SCOPE_AGENT) < target) __builtin_amdgcn_s_sleep(1);
    __builtin_amdgcn_fence(__ATOMIC_ACQUIRE, "agent");
    asm volatile("s_waitcnt vmcnt(0)" ::: "memory");
  }
  __syncthreads();
}

__global__ void __launch_bounds__(512) fwd_megakernel(Params p) {
  extern __shared__ __attribute__((aligned(16))) unsigned char lds_raw[];
  LAS unsigned char* lds = (LAS unsigned char*)lds_raw;
  cg::grid_group grid = cg::this_grid();
  unsigned char* ws = p.ws;
  const int G = gridDim.x, bid = blockIdx.x;
  const float* cosH = (const float*)(ws + WS_COSH); const float* sinH = (const float*)(ws + WS_SINH);
  const float* cosR = (const float*)(ws + WS_COSR); const float* sinR = (const float*)(ws + WS_SINR);

  unsigned* bar_ctr = (unsigned*)(ws + WS_BAR); unsigned bar_epoch = 0;
  if (bid == 0 && threadIdx.x == 0) __hip_atomic_store(bar_ctr, 0u, __ATOMIC_RELAXED, __HIP_MEMORY_SCOPE_AGENT);
#ifndef SKIP_PRO
  prologue(p, lds);
#endif
  grid.sync();
#pragma unroll
  for (int layer = 0; layer < 4; ++layer) {
    const int i = layer >> 1; const bool odd = layer & 1;
#ifndef SKIP_ROW
    rowwise_phase(p, lds, layer - 1, layer);
#endif
    grid_barrier(bar_ctr, bar_epoch);
    {
#ifndef SKIP_SCAN
      if (odd && bid < 128) fox_scan(p, lds, bid);
#endif
      pg8::Gemm g; g.A = (const bf16_t*)(ws + WS_HBUF); g.lda = 1024; g.K = 1024; g.M = T;
      Epi e; e.out = (bf16_t*)(ws + WS_ZBUF); e.pin = nullptr; e.pslot = 0; e.nK = 0; e.qmode = 0; e.pout = odd ? nullptr : (float*)(ws + WS_PART); e.cosH = cosH; e.sinH = sinH; e.cosR = cosR; e.sinR = sinR;
      if (!odd) { g.Bt = (const bf16_t*)(ws + WS_WEVIN + i * SZ_WEVIN); g.N = 2560; e.ldc = 2560; e.rope64_end = 640; e.rope32_lo = 2432; e.rope32_hi = 2464; }
      else { g.Bt = (const bf16_t*)(ws + WS_WODIN + i * SZ_WODIN); g.N = 4096; e.ldc = 4096; e.rope64_end = 1024; e.rope32_lo = 0; e.rope32_hi = 0; }
      pg8::StaticOrder S; S.init(g.M, g.N, G, bid);
#ifndef SKIP_G1
      pg8::gemm_phase<Epi>(lds, g, S, e);
#endif
    }
    grid_barrier(bar_ctr, bar_epoch);
    if (!odd) {
      for (int which = 0; which < 2; ++which) {
        pg8::Gemm g; g.M = T; g.lda = 2560;
        Epi e; e.rope64_end = 0; e.rope32_lo = 0; e.rope32_hi = 0; e.cosH = cosH; e.sinH = sinH; e.cosR = cosR; e.sinR = sinR; e.pout = nullptr; e.pin = (const float*)(ws + WS_PART);
        if (which == 0) { g.A = (const bf16_t*)(ws + WS_ZBUF) + 1792; g.Bt = (const bf16_t*)(ws + WS_WUQ + i * SZ_WUQ); g.N = 768; g.K = 384;
          e.out = (bf16_t*)(ws + WS_QBUF); e.ldc = 768; e.qmode = 1; e.pslot = 0; e.nK = 384; }
        else { g.A = (const bf16_t*)(ws + WS_ZBUF) + 2176; g.Bt = (const bf16_t*)(ws + WS_WUKV + i * SZ_WUKV); g.N = 1024; g.K = 256;
          e.out = (bf16_t*)(ws + WS_HBUF); e.ldc = 1024; e.qmode = 0; e.pslot = 12; e.nK = 256; }
        pg8::StaticOrder S; S.init(g.M, g.N, G, bid);
#ifndef SKIP_G2
        pg8::gemm_phase<Epi>(lds, g, S, e);
#endif
      }
      grid_barrier(bar_ctr, bar_epoch);
#ifndef SKIP_ATTE
      attn_even(p, lds, i);
#endif
      grid_barrier(bar_ctr, bar_epoch);
    } else {
#ifndef SKIP_ATTO
      attn_odd(p, lds);
#endif
      grid_barrier(bar_ctr, bar_epoch);
#ifndef SKIP_COMB
      diff_combine(p, layer);
#endif
      grid_barrier(bar_ctr, bar_epoch);
    }
    {
      pg8::Gemm g; g.A = (const bf16_t*)(ws + WS_OBUF); g.lda = 1024; g.K = 1024; g.M = T; g.N = 1024;
      g.Bt = (const bf16_t*)(ws + (odd ? WS_WODOUT : WS_WEVOUT) + i * SZ_WOUT);
      Epi e; e.out = (bf16_t*)(ws + WS_HBUF); e.ldc = 1024; e.pin = nullptr; e.pslot = 0; e.pout = nullptr; e.nK = 0; e.qmode = 0; e.rope64_end = 0; e.rope32_lo = 0; e.rope32_hi = 0;
      e.cosH = cosH; e.sinH = sinH; e.cosR = cosR; e.sinR = sinR;
      pg8::StaticOrder S; S.init(g.M, g.N, G, bid);
#ifndef SKIP_G3
      pg8::gemm_phase<Epi>(lds, g, S, e);
#endif
    }
    grid_barrier(bar_ctr, bar_epoch);
  }
#ifndef SKIP_ROW
  rowwise_phase(p, lds, 3, 4);
#endif
}

constexpr int LDS_BYTES = 131072;

extern "C" void kernel_launch(void* const* d_in, const int* in_sizes, int n_in, void* d_out, int out_size, void* d_ws, size_t ws_size, hipStream_t stream) {
  static int grid_blocks = 0;
  if (grid_blocks == 0) {
    int dev = 0, cus = 0, per_cu = 0;
    if (hipGetDevice(&dev) != hipSuccess || hipDeviceGetAttribute(&cus, hipDeviceAttributeMultiprocessorCount, dev) != hipSuccess) { fprintf(stderr, "device query failed\n"); grid_blocks = -1; return; }
    if (hipFuncSetAttribute((const void*)fwd_megakernel, hipFuncAttributeMaxDynamicSharedMemorySize, LDS_BYTES) != hipSuccess) { fprintf(stderr, "hipFuncSetAttribute failed\n"); grid_blocks = -1; return; }
    if (hipOccupancyMaxActiveBlocksPerMultiprocessor(&per_cu, (const void*)fwd_megakernel, 512, LDS_BYTES) != hipSuccess || per_cu < 1) { fprintf(stderr, "occupancy query: %d\n", per_cu); per_cu = 1; }
    (void)hipGetLastError();
    grid_blocks = cus;
    if (ws_size < WS_END) { fprintf(stderr, "workspace too small: %zu < %zu\n", ws_size, (size_t)WS_END); grid_blocks = -1; return; }
  }
  if (grid_blocks < 0) return;
  Params p{};
  const float** fp = (const float**)&p;
  for (int i = 0; i < 18; ++i) fp[i] = (const float*)d_in[i];
  p.out = (float*)d_out; p.ws = (unsigned char*)d_ws;
  void* args[] = {&p};
  hipError_t e = hipLaunchCooperativeKernel((const void*)fwd_megakernel, dim3(grid_blocks), dim3(512), args, LDS_BYTES, stream);
  if (e != hipSuccess) fprintf(stderr, "cooperative launch failed: %s (grid %d)\n", hipGetErrorString(e), grid_blocks);
}
```

```cpp
#include <hip/hip_runtime.h>
#include <hip/hip_cooperative_groups.h>
#include <cstdio>
#include <type_traits>
namespace cg = cooperative_groups;

#define DI __device__ __forceinline__
#define LAS __attribute__((address_space(3)))
typedef unsigned short bf16_t;
typedef short bf16x8 __attribute__((ext_vector_type(8)));
typedef short s16x4 __attribute__((ext_vector_type(4)));
typedef float f32x2 __attribute__((ext_vector_type(2)));
typedef float f32x4 __attribute__((ext_vector_type(4)));
typedef float f32x16 __attribute__((ext_vector_type(16)));
typedef unsigned u32x2 __attribute__((ext_vector_type(2)));
typedef unsigned u32x4 __attribute__((ext_vector_type(4)));
typedef __bf16 bf16x2_t __attribute__((ext_vector_type(2)));

constexpr int T = 32768, DM = 1024, NB = 16, SEQ = 2048;
constexpr float LOG2E = 1.4426950408889634f;
constexpr float EPS = 1e-6f;

constexpr size_t SZ_WEVIN = 2560ull * 1024 * 2, SZ_WODIN = 4096ull * 1024 * 2, SZ_WUQ = 768ull * 384 * 2, SZ_WUKV = 1024ull * 256 * 2, SZ_WOUT = 1024ull * 1024 * 2;
constexpr size_t WS_WEVIN = 0;
constexpr size_t WS_WODIN = WS_WEVIN + 2 * SZ_WEVIN;
constexpr size_t WS_WUQ = WS_WODIN + 2 * SZ_WODIN;
constexpr size_t WS_WUKV = WS_WUQ + 2 * SZ_WUQ;
constexpr size_t WS_WEVOUT = WS_WUKV + 2 * SZ_WUKV;
constexpr size_t WS_WODOUT = WS_WEVOUT + 2 * SZ_WOUT;
constexpr size_t WS_MOD = WS_WODOUT + 2 * SZ_WOUT;
constexpr size_t WS_COSH = WS_MOD + 4ull * 16 * 3072 * 4;
constexpr size_t WS_SINH = WS_COSH + 2048ull * 32 * 4;
constexpr size_t WS_COSR = WS_SINH + 2048ull * 32 * 4;
constexpr size_t WS_SINR = WS_COSR + 2048ull * 16 * 4;
constexpr size_t WS_LOGF = WS_SINR + 2048ull * 16 * 4;
constexpr size_t WS_FCUM = WS_LOGF + (size_t)T * 8 * 4;
constexpr size_t WS_HBUF = (WS_FCUM + (size_t)T * 8 * 4 + 4095) & ~(size_t)4095;
constexpr size_t WS_OBUF = WS_HBUF + (size_t)T * 1024 * 2;
constexpr size_t WS_ZBUF = WS_OBUF + (size_t)T * 1024 * 2;
constexpr size_t WS_QBUF = WS_ZBUF + (size_t)T * 2560 * 2;
constexpr size_t WS_BAR = WS_ZBUF + (size_t)T * 4096 * 2;
constexpr size_t WS_PART = WS_BAR + 256;
constexpr size_t WS_END = WS_PART + (size_t)T * 20 * 4;

struct Params {
  const float *x, *c, *w_ada, *b_ada, *g_pre, *g_post, *ev_w_in, *ev_q_norm, *ev_kv_norm, *ev_w_uq, *ev_w_ukv, *ev_sinks, *ev_w_out,
      *od_w_in, *od_forget_bias, *od_lambda, *od_subln, *od_w_out;
  float* out;
  unsigned char* ws;
};

DI int opaque_tid() { int t = threadIdx.x; asm volatile("" : "+v"(t)); return t; }
DI float bflo(unsigned u) { return __uint_as_float(u << 16); }
DI float bfhi(unsigned u) { return __uint_as_float(u & 0xffff0000u); }
DI unsigned pk2(float lo, float hi) { f32x2 f = {lo, hi}; bf16x2_t b = __builtin_convertvector(f, bf16x2_t); return __builtin_bit_cast(unsigned, b); }
DI bf16_t f2bf(float f) { return (bf16_t)(pk2(f, 0.f) & 0xffffu); }
DI float fast_exp2(float x) { return __builtin_amdgcn_exp2f(x); }
DI float silu_f(float x) { return x * __builtin_amdgcn_rcpf(1.f + fast_exp2(-x * LOG2E)); }
DI float wave_sum(float v) {
#pragma unroll
  for (int o = 32; o >= 1; o >>= 1) v += __shfl_xor(v, o);
  return v;
}

namespace pg8 {
constexpr int BM = 256, BK = 64, HALF = 128, HTB = HALF * BK * 2, STAGE_BYTES = 8 * HTB, NXCD = 8, WGM = 8;
DI int lds_byte(int r, int c) { const int st = (r >> 4) * 2 + (c >> 5), rr = r & 15, cc = c & 31, ob = rr * 64 + cc * 2; return st * 1024 + (ob ^ (((ob >> 9) & 1) << 5)); }
DI void stage_rc(int b, int& R, int& C) { const int st = b / 1024, sb = b % 1024, swz = sb ^ (((sb >> 9) & 1) << 5); R = (st >> 1) * 16 + swz / 64; C = (st & 1) * 32 + (swz % 64) / 2; }
DI int perm32(int rho) { const int n = rho >> 4, i = rho & 15; return 8 * (i >> 2) + 4 * n + (i & 3); }
struct Unit { int pm, pn; };
struct Gemm { const bf16_t* A; const bf16_t* Bt; int M, N, K, lda; };
struct StaticOrder {
  int nM, nN, nwg, G, c;
  DI void init(int M, int N, int G_, int c_) { nM = M / BM; nN = N / BM; nwg = nM * nN; G = G_; c = c_; }
  DI bool next(int i, Unit& u) const {
    const long L = (long)i * G + c; if (L >= nwg) return false;
    int wgid = (int)L; { const int q = nwg / NXCD, r = nwg % NXCD, xcd = wgid % NXCD, off = wgid / NXCD; wgid = (xcd < r ? xcd * (q + 1) : r * (q + 1) + (xcd - r) * q) + off; }
    const int nig = WGM * nN, gid = wgid / nig, fm = gid * WGM, gsz = (nM - fm) < WGM ? (nM - fm) : WGM;
    u.pm = fm + ((wgid % nig) % gsz); u.pn = (wgid % nig) / gsz; return true;
  }
};

template <class Epi>
DI void gemm_phase(LAS unsigned char* lds, const Gemm g, const StaticOrder& S, const Epi& E) {
  const int tid = opaque_tid(), wid = __builtin_amdgcn_readfirstlane(tid >> 6), lane = tid & 63, wr = wid >> 2, wc = wid & 3, fr = lane & 15, fq = lane >> 4;
  const int K = g.K, nt = K / BK, lda = g.lda;
  unsigned voffA[2], voffB[2];
#pragma unroll
  for (int i = 0; i < 2; ++i) { int R, C; stage_rc(tid * 16 + i * 8192, R, C); const int Rb = (R & ~31) + perm32(R & 31);
    voffA[i] = (unsigned)(R * lda + C) * 2u; voffB[i] = (unsigned)(Rb * K + C) * 2u; }
  const size_t kstep = (size_t)(BK * 2);
  const size_t hstepA = (size_t)HALF * lda * 2, hstepB = (size_t)HALF * K * 2;
  const size_t tstepA = 2 * hstepA, tstepB = 2 * hstepB;
  const unsigned ldsw = (unsigned)wid * 1024u;
  const int aoff = lds_byte(wr * 64 + fr, fq * 8), boff = lds_byte(wc * 32 + fr, fq * 8);
#define PG8_SA(b, h) (((b) * 2 + (h)) * HTB)
#define PG8_SB(b, h) ((4 + (b) * 2 + (h)) * HTB)
#define PG8_STAGE(bufoff, gbase, voff) do { _Pragma("unroll") for (int _i = 0; _i < 2; ++_i) \
    __builtin_amdgcn_global_load_lds((const unsigned*)((const char*)(gbase) + (voff)[_i]), (LAS unsigned*)(lds + (bufoff) + ldsw + _i * 8192), 16, 0, 0); } while (0)
#define PG8_LDA(dst, b, h) do { _Pragma("unroll") for (int m = 0; m < 4; ++m) _Pragma("unroll") for (int k = 0; k < 2; ++k) dst[m][k] = *(const LAS bf16x8*)(lds + PG8_SA(b, h) + aoff + m * 2048 + k * 1024); } while (0)
#define PG8_LDB(dst, b, h) do { _Pragma("unroll") for (int n = 0; n < 2; ++n) _Pragma("unroll") for (int k = 0; k < 2; ++k) dst[n][k] = *(const LAS bf16x8*)(lds + PG8_SB(b, h) + boff + n * 2048 + k * 1024); } while (0)
#define PG8_MMA(ai, bj, At, Bt) do { __builtin_amdgcn_s_setprio(1); _Pragma("unroll") for (int m = 0; m < 4; ++m) _Pragma("unroll") for (int n = 0; n < 2; ++n) _Pragma("unroll") for (int k = 0; k < 2; ++k) \
    acc[ai][bj][m][n] = __builtin_amdgcn_mfma_f32_16x16x32_bf16(Bt[n][k], At[m][k], acc[ai][bj][m][n], 0, 0, 0); __builtin_amdgcn_s_setprio(0); } while (0)
#define PG8_WAIT_V(n) asm volatile("s_waitcnt vmcnt(" #n ")" ::: "memory")
#define PG8_WAIT_L(n) asm volatile("s_waitcnt lgkmcnt(" #n ")" ::: "memory")
#define PG8_BAR __builtin_amdgcn_s_barrier()
#define PG8_SCHED __builtin_amdgcn_sched_barrier(0)
  Unit cur, nxt; int ui = 0;
  if (!S.next(0, cur)) return;
  f32x4 acc[2][2][4][2];
#pragma unroll
  for (int a = 0; a < 2; ++a)
#pragma unroll
    for (int b = 0; b < 2; ++b)
#pragma unroll
      for (int m = 0; m < 4; ++m)
#pragma unroll
        for (int n = 0; n < 2; ++n) acc[a][b][m][n] = (f32x4){0.f, 0.f, 0.f, 0.f};
  bf16x8 At[4][2], B0[2][2], B1[2][2];
  const char* cA = (const char*)g.A + (size_t)cur.pm * tstepA; const char* cB = (const char*)g.Bt + (size_t)cur.pn * tstepB;
  PG8_STAGE(PG8_SB(0, 0), cB, voffB); PG8_STAGE(PG8_SA(0, 0), cA, voffA); PG8_STAGE(PG8_SB(0, 1), cB + hstepB, voffB); PG8_STAGE(PG8_SA(0, 1), cA + hstepA, voffA);
  if (wr == 1) PG8_BAR;
  PG8_WAIT_V(4); PG8_BAR;
  PG8_STAGE(PG8_SB(1, 0), cB + kstep, voffB); PG8_STAGE(PG8_SA(1, 0), cA + kstep, voffA); PG8_STAGE(PG8_SB(1, 1), cB + hstepB + kstep, voffB);
  PG8_WAIT_V(6); PG8_BAR;
  for (;;) {
    const bool has_next = S.next(ui + 1, nxt);
    const char* nA = has_next ? (const char*)g.A + (size_t)nxt.pm * tstepA : cA; const char* nB = has_next ? (const char*)g.Bt + (size_t)nxt.pn * tstepB : cB;
    for (int t = 0; t < nt; t += 2) {
      const bool last = (t == nt - 2);
      const char* a1 = cA + (size_t)(t + 1) * kstep;
      const char* a2 = last ? nA : cA + (size_t)(t + 2) * kstep; const char* b2 = last ? nB : cB + (size_t)(t + 2) * kstep;
      const char* a3 = a2 + kstep; const char* b3 = b2 + kstep;
      PG8_LDB(B0, 0, 0); PG8_SCHED; PG8_LDA(At, 0, 0); PG8_STAGE(PG8_SA(1, 1), a1 + hstepA, voffA);
      PG8_WAIT_L(8); PG8_BAR; PG8_WAIT_L(0); PG8_MMA(0, 0, At, B0); PG8_BAR; PG8_SCHED;
      PG8_LDB(B1, 0, 1); PG8_STAGE(PG8_SB(0, 0), b2, voffB);
      PG8_BAR; PG8_WAIT_L(0); PG8_MMA(0, 1, At, B1); PG8_BAR;
      PG8_LDA(At, 0, 1); PG8_STAGE(PG8_SA(0, 0), a2, voffA);
      PG8_BAR; PG8_WAIT_L(0); PG8_MMA(1, 0, At, B0); PG8_BAR; PG8_SCHED;
      PG8_STAGE(PG8_SB(0, 1), b2 + hstepB, voffB);
      PG8_WAIT_V(6); PG8_BAR; PG8_MMA(1, 1, At, B1); PG8_BAR;
      PG8_LDB(B0, 1, 0); PG8_SCHED; PG8_LDA(At, 1, 0); PG8_STAGE(PG8_SA(0, 1), a2 + hstepA, voffA);
      PG8_WAIT_L(8); PG8_BAR; PG8_WAIT_L(0); PG8_MMA(0, 0, At, B0); PG8_BAR; PG8_SCHED;
      PG8_LDB(B1, 1, 1); PG8_STAGE(PG8_SB(1, 0), b3, voffB);
      PG8_BAR; PG8_WAIT_L(0); PG8_MMA(0, 1, At, B1); PG8_BAR;
      PG8_LDA(At, 1, 1); PG8_STAGE(PG8_SA(1, 0), a3, voffA);
      PG8_BAR; PG8_WAIT_L(0); PG8_MMA(1, 0, At, B0); PG8_BAR; PG8_SCHED;
      PG8_STAGE(PG8_SB(1, 1), b3 + hstepB, voffB);
      PG8_WAIT_V(6); PG8_BAR; PG8_MMA(1, 1, At, B1); PG8_BAR;
    }
    E(acc, cur, wr, wc, fr, fq);
    if (!has_next) break;
#pragma unroll
    for (int a = 0; a < 2; ++a)
#pragma unroll
      for (int b = 0; b < 2; ++b)
#pragma unroll
        for (int m = 0; m < 4; ++m)
#pragma unroll
          for (int n = 0; n < 2; ++n) acc[a][b][m][n] = (f32x4){0.f, 0.f, 0.f, 0.f};
    cur = nxt; cA = nA; cB = nB; ++ui;
  }
  PG8_WAIT_V(0);
  if (wr == 0) PG8_BAR;
  PG8_BAR;
#undef PG8_SA
#undef PG8_SB
#undef PG8_STAGE
#undef PG8_LDA
#undef PG8_LDB
#undef PG8_MMA
#undef PG8_WAIT_V
#undef PG8_WAIT_L
#undef PG8_BAR
#undef PG8_SCHED
}
}

struct Epi {
  bf16_t* out; int ldc;
  int rope64_end;
  int rope32_lo, rope32_hi;
  int qmode;
  const float* pin; int nK;
  int pslot;
  float* pout;
  const float *cosH, *sinH, *cosR, *sinR;
  DI void operator()(const f32x4 (&acc)[2][2][4][2], const pg8::Unit& u, int wr, int wc, int fr, int fq) const {
    const int row0 = u.pm * 256 + wr * 64 + fr;
    int rt[2];
#pragma unroll
    for (int bj = 0; bj < 2; ++bj) {
      const int cw = u.pn * 256 + bj * 128 + wc * 32;
      rt[bj] = 0;
      if (cw < rope64_end) rt[bj] = 1;
      else if (cw >= rope32_lo && cw < rope32_hi) rt[bj] = 2;
      else if (qmode && ((cw >> 5) % 3) == 2) rt[bj] = 2;
    }
    const int tt = rt[0] | rt[1];
    const float* ctab = (tt == 1) ? cosH + (16 * (wc & 1) + 4 * fq) : cosR + 4 * fq;
    const float* stab = (tt == 1) ? sinH + (16 * (wc & 1) + 4 * fq) : sinR + 4 * fq;
    const int tstride = (tt == 1) ? 32 : 16;
    int ps[2] = {-1, -1};
    if (pout) {
#pragma unroll
      for (int bj = 0; bj < 2; ++bj) { const int cw = u.pn * 256 + bj * 128 + wc * 32;
        if (cw >= 1792 && cw < 2432) ps[bj] = ((cw - 1792) >> 7) * 4 + wc; }
    }
#pragma unroll
    for (int ai = 0; ai < 2; ++ai) {
      f32x4 cv[4], sv[4]; float rs[4];
#pragma unroll
      for (int m = 0; m < 4; ++m) {
        const int row = row0 + ai * 128 + m * 16;
        if (tt) { const int pos = row & (SEQ - 1); cv[m] = *(const f32x4*)(ctab + pos * tstride); sv[m] = *(const f32x4*)(stab + pos * tstride); }
        rs[m] = 1.f;
        if (pin) { const f32x4 p0 = *(const f32x4*)(pin + (size_t)row * 20 + pslot), p1 = *(const f32x4*)(pin + (size_t)row * 20 + pslot + 4);
          float ss = ((p0[0] + p0[1]) + (p0[2] + p0[3])) + ((p1[0] + p1[1]) + (p1[2] + p1[3]));
          if (nK == 384) { const f32x4 p2 = *(const f32x4*)(pin + (size_t)row * 20 + pslot + 8); ss += (p2[0] + p2[1]) + (p2[2] + p2[3]); }
          rs[m] = rsqrtf(ss / (float)nK + EPS); }
      }
#pragma unroll
      for (int m = 0; m < 4; ++m) {
        const int row = row0 + ai * 128 + m * 16;
#pragma unroll
        for (int bj = 0; bj < 2; ++bj) {
          const int c0 = u.pn * 256 + bj * 128 + wc * 32 + 8 * fq;
          f32x4 v0 = acc[ai][bj][m][0] * rs[m], v1 = acc[ai][bj][m][1] * rs[m];
          if (ps[bj] >= 0) {
            float sq = (v0[0] * v0[0] + v0[1] * v0[1]) + (v0[2] * v0[2] + v0[3] * v0[3]) + (v1[0] * v1[0] + v1[1] * v1[1]) + (v1[2] * v1[2] + v1[3] * v1[3]);
            sq += __shfl_xor(sq, 16); sq += __shfl_xor(sq, 32);
            if (fq == 0) pout[(size_t)row * 20 + ps[bj]] = sq;
          }
          if (rt[bj]) {
            const f32x4 o1 = v0 * cv[m] - v1 * sv[m], o2 = v1 * cv[m] + v0 * sv[m];
            v0 = o1; v1 = o2;
          }
          u32x4 w; w.x = pk2(v0[0], v0[1]); w.y = pk2(v0[2], v0[3]); w.z = pk2(v1[0], v1[1]); w.w = pk2(v1[2], v1[3]);
          *(u32x4*)(out + (size_t)row * ldc + c0) = w;
        }
      }
    }
  }
};

DI int ropeperm64(int p) { const int g = p >> 3, r = p & 7; return r < 4 ? 4 * g + r : 32 + 4 * g + (r - 4); }
DI int ropeperm32(int p) { const int g = p >> 3, r = p & 7; return r < 4 ? 4 * g + r : 16 + 4 * g + (r - 4); }
DI int srccol(int kind, int n) {
  if (kind == 0) {
    if (n < 512) return 672 + (n & ~63) + ropeperm64(n & 63);
    if (n < 640) return 1184 + ((n - 512) & ~63) + ropeperm64(n & 63);
    if (n < 768) return 1312 + (n - 640);
    if (n < 1792) return 1440 + (n - 768);
    if (n < 2176) return n - 1792;
    if (n < 2432) return 384 + (n - 2176);
    if (n < 2464) return 640 + ropeperm32(n - 2432);
    return -1;
  }
  if (kind == 1) {
    if (n < 1024) return (n & ~63) + ropeperm64(n & 63);
    if (n < 3072) return n;
    return 3080 + (n - 3072);
  }
  if (kind == 2) { const int hd = n / 96, p = n - hd * 96; return hd * 96 + (p < 64 ? p : 64 + ropeperm32(p - 64)); }
  return n;
}
DI void convert_tile(LAS unsigned char* lds, const float* W, int Nsrc, int K, bf16_t* Wt, int kind, const float* g, int tn, int tk) {
  const int tid = opaque_tid();
  LAS bf16_t* tile = (LAS bf16_t*)lds;
  const int nl = tid & 63, ks = tid >> 6;
  const int sc = srccol(kind, tn * 64 + nl);
#pragma unroll
  for (int kk = ks; kk < 64; kk += 8) {
    const int k = tk * 64 + kk;
    float v = 0.f;
    if (sc >= 0) { v = W[(size_t)k * Nsrc + sc]; if (g) v *= g[k]; }
    tile[nl * 72 + kk] = f2bf(v);
  }
  __syncthreads();
  { const int n2 = tid >> 3, ch = tid & 7;
    const u32x4 v = *(const LAS u32x4*)(tile + n2 * 72 + ch * 8);
    *(u32x4*)(Wt + (size_t)(tn * 64 + n2) * K + tk * 64 + ch * 8) = v; }
  __syncthreads();
}

DI void prologue(const Params& p, LAS unsigned char* lds) {
  const int tid = opaque_tid(), G = gridDim.x, bid = blockIdx.x;
  unsigned char* ws = p.ws;
  for (int idx = bid * 512 + tid; idx < 2048 * 48; idx += G * 512) {
    const bool isH = idx < 2048 * 32;
    const int j = isH ? idx : idx - 2048 * 32;
    const int pos = isH ? (j >> 5) : (j >> 4), i = isH ? (j & 31) : (j & 15);
    const float e = isH ? (float)(2 * i) * (1.f / 64.f) : (float)(2 * i) * (1.f / 32.f);
    const float inv = fast_exp2(-e * 13.287712379549449f);
    const float ang = (float)pos * inv;
    double t = (double)ang * 0.15915494309189535; t -= rint(t);
    const float fr = (float)t;
    const float cv = __builtin_amdgcn_cosf(fr), sv = __builtin_amdgcn_sinf(fr);
    if (isH) { ((float*)(ws + WS_COSH))[j] = cv; ((float*)(ws + WS_SINH))[j] = sv; }
    else { ((float*)(ws + WS_COSR))[j] = cv; ((float*)(ws + WS_SINR))[j] = sv; }
  }
  constexpr int NT0 = 40 * 16, NT1 = 64 * 16, NT2 = 12 * 6, NT3 = 16 * 4, NT4 = 16 * 16;
  constexpr int PER_I = NT0 + NT1 + NT2 + NT3 + 2 * NT4;
  for (int job = bid; job < 2 * PER_I; job += G) {
    const int i = job / PER_I; int j = job - i * PER_I;
    if (j < NT0) { convert_tile(lds, p.ev_w_in + (size_t)i * 1024 * 2464, 2464, 1024, (bf16_t*)(ws + WS_WEVIN + i * SZ_WEVIN), 0, nullptr, j / 16, j % 16); continue; }
    j -= NT0;
    if (j < NT1) { convert_tile(lds, p.od_w_in + (size_t)i * 1024 * 4104, 4104, 1024, (bf16_t*)(ws + WS_WODIN + i * SZ_WODIN), 1, nullptr, j / 16, j % 16); continue; }
    j -= NT1;
    if (j < NT2) { convert_tile(lds, p.ev_w_uq + (size_t)i * 384 * 768, 768, 384, (bf16_t*)(ws + WS_WUQ + i * SZ_WUQ), 2, p.ev_q_norm + i * 384, j / 6, j % 6); continue; }
    j -= NT2;
    if (j < NT3) { convert_tile(lds, p.ev_w_ukv + (size_t)i * 256 * 1024, 1024, 256, (bf16_t*)(ws + WS_WUKV + i * SZ_WUKV), 3, p.ev_kv_norm + i * 256, j / 4, j % 4); continue; }
    j -= NT3;
    if (j < NT4) { convert_tile(lds, p.ev_w_out + (size_t)i * 1024 * 1024, 1024, 1024, (bf16_t*)(ws + WS_WEVOUT + i * SZ_WOUT), 4, nullptr, j / 16, j % 16); continue; }
    j -= NT4;
    convert_tile(lds, p.od_w_out + (size_t)i * 1024 * 1024, 1024, 1024, (bf16_t*)(ws + WS_WODOUT + i * SZ_WOUT), 4, nullptr, j / 16, j % 16);
  }
  const int item0 = G - 1 - bid;
  if (item0 < 192) {
    LAS float* cond = (LAS float*)lds;
    LAS float* red = (LAS float*)(lds + 65536);
    for (int e = tid; e < 16 * 1024; e += 512) { const int b = e >> 10, k = e & 1023; cond[k * 16 + b] = silu_f(p.c[e]); }
    __syncthreads();
    for (int item = item0; item < 192; item += G) {
      const int l = item / 48, n0 = (item % 48) * 64;
      const int col = tid & 63, kg = tid >> 6;
      float a[16];
#pragma unroll
      for (int b = 0; b < 16; ++b) a[b] = 0.f;
      const float* wp = p.w_ada + (size_t)l * 1024 * 3072 + n0 + col;
      for (int k = kg * 128; k < kg * 128 + 128; ++k) {
        const float w = wp[(size_t)k * 3072];
#pragma unroll
        for (int b4 = 0; b4 < 4; ++b4) { const f32x4 cv = *(const LAS f32x4*)(cond + k * 16 + b4 * 4);
          a[b4 * 4 + 0] += cv[0] * w; a[b4 * 4 + 1] += cv[1] * w; a[b4 * 4 + 2] += cv[2] * w; a[b4 * 4 + 3] += cv[3] * w; }
      }
#pragma unroll
      for (int b = 0; b < 16; ++b) red[(kg * 16 + b) * 64 + col] = a[b];
      __syncthreads();
      for (int e = tid; e < 1024; e += 512) { const int b = e >> 6, cc = e & 63; float s = 0.f;
#pragma unroll
        for (int k8 = 0; k8 < 8; ++k8) s += red[(k8 * 16 + b) * 64 + cc];
        ((float*)(ws + WS_MOD))[((size_t)l * 16 + b) * 3072 + n0 + cc] = s + p.b_ada[l * 3072 + n0 + cc]; }
      __syncthreads();
    }
  }
}

DI void rowwise_phase(const Params& p, LAS unsigned char* lds, int lp, int ln) {
  const int tid = opaque_tid(), lane = tid & 63, wid = tid >> 6;
  const int gw = blockIdx.x * 8 + wid, nw = gridDim.x * 8;
  unsigned char* ws = p.ws;
  const float* mod = (const float*)(ws + WS_MOD);
  const bf16_t* ybuf = (const bf16_t*)(ws + WS_HBUF);
  bf16_t* hbuf = (bf16_t*)(ws + WS_HBUF);
  const bool ff = (ln < 4) && (ln & 1);
  float fbias[8];
#pragma unroll
  for (int h = 0; h < 8; ++h) fbias[h] = 0.f;
  LAS f32x4* wl = (LAS f32x4*)lds;
  if (ff) {
    const float* w = p.od_w_in + (size_t)(ln >> 1) * 1024 * 4104 + 3072;
    for (int c = tid; c < 1024; c += 512) {
      const f32x4 w0 = *(const f32x4*)(w + (size_t)c * 4104), w1 = *(const f32x4*)(w + (size_t)c * 4104 + 4);
      const int ln_ = (c & 255) >> 2, e = c & 3, j = c >> 8;
      wl[(j * 4 + e) * 64 + ln_] = w0; wl[1024 + (j * 4 + e) * 64 + ln_] = w1;
    }
#pragma unroll
    for (int h = 0; h < 8; ++h) fbias[h] = p.od_forget_bias[(ln >> 1) * 8 + h];
    __syncthreads();
  }
  for (int row = gw; row < T; row += nw) {
    const int b = row >> 11;
    f32x4 xv[4];
    const float* xin = (lp <= 0 ? p.x : p.out) + (size_t)row * DM;
#pragma unroll
    for (int j = 0; j < 4; ++j) xv[j] = *(const f32x4*)(xin + 4 * lane + 256 * j);
    if (lp >= 0) {
      f32x4 yv[4]; float ss = 0.f;
#pragma unroll
      for (int j = 0; j < 4; ++j) { const u32x2 u = *(const u32x2*)(ybuf + (size_t)row * DM + 4 * lane + 256 * j);
        yv[j] = (f32x4){bflo(u.x), bfhi(u.x), bflo(u.y), bfhi(u.y)}; ss += yv[j][0] * yv[j][0] + yv[j][1] * yv[j][1] + yv[j][2] * yv[j][2] + yv[j][3] * yv[j][3]; }
      ss = wave_sum(ss);
      const float rs = rsqrtf(ss * (1.f / DM) + EPS);
#pragma unroll
      for (int j = 0; j < 4; ++j) {
        const int c = 4 * lane + 256 * j;
        const f32x4 gt = *(const f32x4*)(mod + ((size_t)lp * 16 + b) * 3072 + 2048 + c);
        const f32x4 gp = *(const f32x4*)(p.g_post + lp * DM + c);
        xv[j] = xv[j] + gt * (yv[j] * rs * gp);
        *(f32x4*)(p.out + (size_t)row * DM + c) = xv[j];
      }
    }
    if (ln < 4) {
      float ss = 0.f;
#pragma unroll
      for (int j = 0; j < 4; ++j) ss += xv[j][0] * xv[j][0] + xv[j][1] * xv[j][1] + xv[j][2] * xv[j][2] + xv[j][3] * xv[j][3];
      ss = wave_sum(ss);
      const float rs = rsqrtf(ss * (1.f / DM) + EPS);
      float zf[8];
#pragma unroll
      for (int h = 0; h < 8; ++h) zf[h] = 0.f;
#pragma unroll
      for (int j = 0; j < 4; ++j) {
        const int c = 4 * lane + 256 * j;
        const f32x4 sh = *(const f32x4*)(mod + ((size_t)ln * 16 + b) * 3072 + c);
        const f32x4 sc = *(const f32x4*)(mod + ((size_t)ln * 16 + b) * 3072 + 1024 + c);
        const f32x4 gp = *(const f32x4*)(p.g_pre + ln * DM + c);
        const f32x4 hv = (xv[j] * rs * gp) * (sc + 1.f) + sh;
        u32x2 w; w.x = pk2(hv[0], hv[1]); w.y = pk2(hv[2], hv[3]);
        *(u32x2*)(hbuf + (size_t)row * DM + c) = w;
        if (ff) {
#pragma unroll
          for (int e = 0; e < 4; ++e) {
            const f32x4 w0 = wl[(j * 4 + e) * 64 + lane], w1 = wl[1024 + (j * 4 + e) * 64 + lane];
            zf[0] += hv[e] * w0[0]; zf[1] += hv[e] * w0[1]; zf[2] += hv[e] * w0[2]; zf[3] += hv[e] * w0[3];
            zf[4] += hv[e] * w1[0]; zf[5] += hv[e] * w1[1]; zf[6] += hv[e] * w1[2]; zf[7] += hv[e] * w1[3];
          }
        }
      }
      if (ff) {
#pragma unroll
        for (int h = 0; h < 8; ++h) zf[h] = wave_sum(zf[h]);
        if (lane < 8) {
          float z = 0.f;
#pragma unroll
          for (int h = 0; h < 8; ++h) z = (lane == h) ? zf[h] + fbias[h] : z;
          const float ls = fminf(z, 0.f) - __builtin_amdgcn_logf(1.f + fast_exp2(-fabsf(z) * LOG2E)) * 0.6931471805599453f;
          ((float*)(ws + WS_LOGF))[(size_t)row * 8 + lane] = ls;
        }
      }
    }
  }
  __syncthreads();
}

DI void fox_scan(const Params& p, LAS unsigned char* lds, int bh) {
  const int tid = opaque_tid();
  const int b = bh >> 3, h = bh & 7;
  const float* logf_ = (const float*)(p.ws + WS_LOGF);
  float* fcum = (float*)(p.ws + WS_FCUM) + (size_t)bh * SEQ;
  LAS float* s = (LAS float*)lds;
  float v[4];
#pragma unroll
  for (int j = 0; j < 4; ++j) v[j] = logf_[((size_t)b * SEQ + 4 * tid + j) * 8 + h];
  v[1] += v[0]; v[2] += v[1]; v[3] += v[2];
  s[tid] = v[3];
  __syncthreads();
  for (int off = 1; off < 512; off <<= 1) {
    float t = 0.f;
    if (tid >= off) t = s[tid - off];
    __syncthreads();
    s[tid] += t;
    __syncthreads();
  }
  const float excl = s[tid] - v[3];
#pragma unroll
  for (int j = 0; j < 4; ++j) fcum[4 * tid + j] = -8.0f * (excl + v[j]);
  __syncthreads();
}

struct AttnArgs { const bf16_t *q, *k, *k2, *v, *gate; bf16_t* out; const float* fcum; int ldq, ldk, ldk2, ldv, ldo, ldg; float sl2, sink; };

DI float half_max(float x) {
  const unsigned u = __float_as_uint(x);
  auto r = __builtin_amdgcn_permlane32_swap(u, u, false, false);
  return fmaxf(__uint_as_float(r[0]), __uint_as_float(r[1]));
}
DI float half_sum(float x) {
  const unsigned u = __float_as_uint(x);
  auto r = __builtin_amdgcn_permlane32_swap(u, u, false, false);
  return __uint_as_float(r[0]) + __uint_as_float(r[1]);
}

template <int N> DI void wait_vmcnt() { asm volatile("s_waitcnt vmcnt(%0)" ::"n"(N) : "memory"); }
DI void raw_barrier() { asm volatile("" ::: "memory"); __builtin_amdgcn_s_barrier(); asm volatile("" ::: "memory"); }

template <int DQK, int DV, int MODE>
DI void attn_item(LAS unsigned char* lds, const AttnArgs& a, int qb) {
  constexpr int KSTR = DQK * 2 + 16, VSTR = (DV == 64) ? 192 : 320;
  constexpr int KG16 = KSTR / 16, VG16 = VSTR / 16;
  constexpr int KCH = KG16, VCH = VG16, NCH = KCH + VCH;
  constexpr int TILE = NCH * 1024 + (MODE == 2 ? 2048 : 0);
  constexpr int NSLOT = (NCH + 7) / 8, REM = NCH - 8 * (NSLOT - 1);
  constexpr int FX = (MODE == 2) ? 1 : 0;
  constexpr int NKS = DQK / 16, NBLK = DV / 32;
  static_assert(5 * TILE <= 155648, "ring too large");
  const int tid = opaque_tid(), wid = __builtin_amdgcn_readfirstlane(tid >> 6), lane = tid & 63, r = lane & 31, hh = lane >> 5;
  const int q0 = qb * 256, qw = q0 + 32 * wid, myq = qw + r;
  const float c = a.sl2, tau = 8.0f / a.sl2;
  bf16x8 qf[NKS];
#pragma unroll
  for (int ks = 0; ks < NKS; ++ks) qf[ks] = *(const bf16x8*)(a.q + (size_t)myq * a.ldq + 16 * ks + 8 * hh);
  int lo = 0; const int hi = 4 * (qb + 1);
  if (MODE == 1) { lo = 4 * qb - 2; if (lo < 0) lo = 0; }
  const int last_w = (qw + 31) >> 6;
  int first_w = 0;
  if (MODE == 1) { first_w = (qw > 127 ? qw - 127 : 0) >> 6; }
  const char* sp[NSLOT]; unsigned sst[NSLOT];
#pragma unroll
  for (int j = 0; j < NSLOT; ++j) {
    const int ch_ = 8 * j + wid;
    if (ch_ < KCH) {
      const int p = ch_ * 64 + lane, row = p / KG16, g = p - row * KG16;
      if (DQK == 96 && g >= 8 && g < 12) { sp[j] = (const char*)(a.k2 + (size_t)row * a.ldk2 + 8 * (g - 8)); sst[j] = (unsigned)(128 * a.ldk2); }
      else { sp[j] = (const char*)(a.k + (size_t)row * a.ldk + 8 * (g < 8 ? g : 0)); sst[j] = (unsigned)(128 * a.ldk); }
    } else {
      const int p = (ch_ - KCH) * 64 + lane, row = (p / VG16) & 63, g = p - (p / VG16) * VG16;
      sp[j] = (const char*)(a.v + (size_t)row * a.ldv + 8 * (g < DV / 8 ? g : 0)); sst[j] = (unsigned)(128 * a.ldv);
    }
  }
  auto issue = [&](int kt) {
    LAS unsigned char* base = lds + (kt % 5) * TILE;
#pragma unroll
    for (int j = 0; j < NSLOT; ++j) {
      if (j < NSLOT - 1 || wid < REM)
        __builtin_amdgcn_global_load_lds((const unsigned*)(sp[j] + (size_t)kt * sst[j]), (LAS unsigned*)(base + (8 * j + wid) * 1024), 16, 0, 0);
    }
    if (MODE == 2) __builtin_amdgcn_global_load_lds((const unsigned*)(a.fcum + kt * 64 + lane), (LAS unsigned*)(base + NCH * 1024 + wid * 256), 4, 0, 0);
  };
  auto wait_tiles = [&](bool all) {
    if (all) wait_vmcnt<0>();
    else if (wid < REM) wait_vmcnt<NSLOT + FX>();
    else wait_vmcnt<NSLOT - 1 + FX>();
  };
  f32x16 O[NBLK];
#pragma unroll
  for (int bl = 0; bl < NBLK; ++bl)
#pragma unroll
    for (int i = 0; i < 16; ++i) O[bl][i] = 0.f;
  float m = (MODE == 1) ? a.sink / a.sl2 : -1e30f;
  float l0 = (MODE == 1 && hh == 0) ? 1.f : 0.f, l1 = 0.f;
  const int i16 = lane & 15, q4 = i16 >> 2, p4 = i16 & 3, grp = (lane >> 4) & 1;
  auto qk_load = [&](int kt, bf16x8 (&kf)[2][NKS]) {
    LAS unsigned char* Kl = lds + (kt % 5) * TILE;
#pragma unroll
    for (int kb = 0; kb < 2; ++kb)
#pragma unroll
      for (int ks = 0; ks < NKS; ++ks) kf[kb][ks] = *(const LAS bf16x8*)(Kl + (32 * kb + r) * KSTR + (16 * ks + 8 * hh) * 2);
  };
  auto qk_mma = [&](int kt, const bf16x8 (&kf)[2][NKS], f32x16 (&s)[2]) {
#pragma unroll
    for (int kb = 0; kb < 2; ++kb) {
      if (MODE == 2) {
        LAS unsigned char* Fl = lds + (kt % 5) * TILE + NCH * 1024 + wid * 256;
#pragma unroll
        for (int g = 0; g < 4; ++g) { const f32x4 fb = *(const LAS f32x4*)(Fl + (32 * kb + 8 * g + 4 * hh) * 4);
          s[kb][4 * g] = fb[0]; s[kb][4 * g + 1] = fb[1]; s[kb][4 * g + 2] = fb[2]; s[kb][4 * g + 3] = fb[3]; }
      } else {
#pragma unroll
        for (int i = 0; i < 16; ++i) s[kb][i] = 0.f;
      }
    }
#pragma unroll
    for (int ks = 0; ks < NKS; ++ks)
#pragma unroll
      for (int kb = 0; kb < 2; ++kb) s[kb] = __builtin_amdgcn_mfma_f32_32x32x16_bf16(kf[kb][ks], qf[ks], s[kb], 0, 0, 0);
  };
  auto softmax = [&](int kt, f32x16 (&s)[2], bf16x8 (&pf)[2][2], auto maskc) {
    constexpr bool MASK = decltype(maskc)::value;
    const int key0 = kt * 64;
    if (MASK) {
#pragma unroll
      for (int kb = 0; kb < 2; ++kb)
#pragma unroll
        for (int i = 0; i < 16; ++i) {
          const int key = key0 + 32 * kb + (i & 3) + 8 * (i >> 2) + 4 * hh;
          bool valid = key <= myq; if (MODE == 1) valid = valid && (myq - key < 128);
          s[kb][i] = valid ? s[kb][i] : -1e30f;
        }
    }
    float mx = fmaxf(s[0][0], s[1][0]);
#pragma unroll
    for (int i = 1; i < 16; ++i) mx = fmaxf(fmaxf(mx, s[0][i]), s[1][i]);
    mx = half_max(mx);
    if (__builtin_amdgcn_ballot_w64(mx > m + tau) != 0ull) {
      const float mnew = fmaxf(m, mx);
      const float alpha = fast_exp2((m - mnew) * c);
      m = mnew;
      l0 *= alpha; l1 *= alpha;
#pragma unroll
      for (int bl = 0; bl < NBLK; ++bl)
#pragma unroll
        for (int i = 0; i < 16; ++i) O[bl][i] *= alpha;
    }
    const float nmc = -m * c;
#pragma unroll
    for (int kb = 0; kb < 2; ++kb)
#pragma unroll
      for (int s2 = 0; s2 < 2; ++s2) {
        float pv[8];
#pragma unroll
        for (int e = 0; e < 8; ++e) pv[e] = fast_exp2(__builtin_fmaf(s[kb][8 * s2 + e], c, nmc));
        l0 += (pv[0] + pv[4]) + (pv[2] + pv[6]); l1 += (pv[1] + pv[5]) + (pv[3] + pv[7]);
        u32x4 w;
        w.x = pk2(pv[0], pv[1]); w.y = pk2(pv[2], pv[3]); w.z = pk2(pv[4], pv[5]); w.w = pk2(pv[6], pv[7]);
        pf[kb][s2] = __builtin_bit_cast(bf16x8, w);
      }
  };
  auto pvmm = [&](int kt, const bf16x8 (&pf)[2][2]) {
    constexpr int PD = (NBLK == 2) ? 2 : 1;
    const unsigned va = (unsigned)(size_t)(lds + (kt % 5) * TILE + KCH * 1024 + (4 * hh + q4) * VSTR + (16 * grp) * 2 + 8 * p4);
    s16x4 vl[PD + 1][NBLK], vh[PD + 1][NBLK];
#define TRRD(dst, off) asm volatile("ds_read_b64_tr_b16 %0, %1 offset:%2" : "=&v"(dst) : "v"(va), "n"(off) : "memory")
#define TRSTEP(st_) do { _Pragma("unroll") for (int bl = 0; bl < NBLK; ++bl) { TRRD(vl[(st_) % (PD + 1)][bl], 16 * (st_) * VSTR + 64 * bl); TRRD(vh[(st_) % (PD + 1)][bl], 16 * (st_) * VSTR + 64 * bl + 8 * VSTR); } } while (0)
#define TRWAIT(n_, b_) do { if (NBLK == 2) asm volatile("s_waitcnt lgkmcnt(" #n_ ")" : "+v"(vl[b_][0]), "+v"(vh[b_][0]), "+v"(vl[b_][1]), "+v"(vh[b_][1])::"memory"); \
    else asm volatile("s_waitcnt lgkmcnt(" #n_ ")" : "+v"(vl[b_][0]), "+v"(vh[b_][0]), "+v"(vl[b_][1]), "+v"(vh[b_][1]), "+v"(vl[b_][2 % NBLK]), "+v"(vh[b_][2 % NBLK]), "+v"(vl[b_][3 % NBLK]), "+v"(vh[b_][3 % NBLK])::"memory"); } while (0)
#pragma unroll
    for (int st = 0; st < PD; ++st) TRSTEP(st);
#pragma unroll
    for (int st = 0; st < 4; ++st) {
      if (st + PD < 4) TRSTEP(st + PD);
      const int ahead = ((st + PD < 4) ? st + PD : 3) - st;
      const int b_ = st % (PD + 1);
      if (ahead * 2 * NBLK == 8) TRWAIT(8, b_); else if (ahead * 2 * NBLK == 4) TRWAIT(4, b_); else TRWAIT(0, b_);
#pragma unroll
      for (int bl = 0; bl < NBLK; ++bl) {
        const bf16x8 vf = __builtin_shufflevector(vl[b_][bl], vh[b_][bl], 0, 1, 2, 3, 4, 5, 6, 7);
        O[bl] = __builtin_amdgcn_mfma_f32_32x32x16_bf16(vf, pf[st >> 1][st & 1], O[bl], 0, 0, 0);
      }
    }
#undef TRRD
#undef TRSTEP
#undef TRWAIT
  };
  auto act = [&](int kt) { return kt <= last_w && kt >= first_w; };
  f32x16 sA[2];
  const bool halfB = wid >= 4;
  issue(lo);
  if (lo + 1 < hi) issue(lo + 1);
  if (lo + 2 < hi) issue(lo + 2);
  if (lo + 3 < hi) issue(lo + 3);
  wait_tiles(!(lo + 3 < hi));
  raw_barrier();
  if (halfB) raw_barrier();
  if (act(lo)) { bf16x8 kf0[2][NKS]; qk_load(lo, kf0); qk_mma(lo, kf0, sA); }
  auto step = [&](int kt, auto maskc) {
    const bool a0 = act(kt), a1 = (kt + 1 < hi) && act(kt + 1);
    bf16x8 pf[2][2], kf[2][NKS];
    if (a1) qk_load(kt + 1, kf);
    __builtin_amdgcn_sched_barrier(0);
    if (a0) softmax(kt, sA, pf, maskc);
    wait_tiles(!(kt + 3 < hi));
    raw_barrier();
    if (kt + 4 < hi) issue(kt + 4);
    if (a1) qk_mma(kt + 1, kf, sA);
    if (a0) pvmm(kt, pf);
    raw_barrier();
  };
  int split = lo;
  if (MODE != 1) { split = qw >> 6; if (split < lo) split = lo; if (split > hi) split = hi; }
  if (MODE != 1) { for (int kt = lo; kt < split; ++kt) step(kt, std::false_type{}); }
  for (int kt = split; kt < hi; ++kt) step(kt, std::true_type{});
  if (!halfB) raw_barrier();
  const float l = half_sum(l0 + l1);
  const float inv = 1.f / l;
#pragma unroll
  for (int bl = 0; bl < NBLK; ++bl)
#pragma unroll
    for (int g = 0; g < 4; ++g) {
      const int f = 32 * bl + 8 * g + 4 * hh;
      float o0 = O[bl][4 * g + 0] * inv, o1 = O[bl][4 * g + 1] * inv, o2 = O[bl][4 * g + 2] * inv, o3 = O[bl][4 * g + 3] * inv;
      if (a.gate) {
        const u32x2 gv = *(const u32x2*)(a.gate + (size_t)myq * a.ldg + f);
        o0 *= silu_f(bflo(gv.x)); o1 *= silu_f(bfhi(gv.x)); o2 *= silu_f(bflo(gv.y)); o3 *= silu_f(bfhi(gv.y));
      }
      u32x2 w; w.x = pk2(o0, o1); w.y = pk2(o2, o3);
      *(u32x2*)(a.out + (size_t)myq * a.ldo + f) = w;
    }
}


DI void swa_item(LAS unsigned char* lds, const AttnArgs& a, const float* sinks4, int qb) {
  constexpr int KSTR = 144, VSTR = 192, KCH = 9, VCH = 12, NCH = 21, TILE = NCH * 1024, NSLOT = 3, REM = 5, NKS = 4, NBLK = 2;
  const int tid = opaque_tid(), wid = __builtin_amdgcn_readfirstlane(tid >> 6), lane = tid & 63, r = lane & 31, hh = lane >> 5;
  const int q0 = qb * 256, qw = q0 + 32 * wid, myq = qw + r;
  const float c = a.sl2, tau = 8.0f / a.sl2;
  int lo = 4 * qb - 2; if (lo < 0) lo = 0;
  const int hi = 4 * (qb + 1);
  const int last_w = (qw + 31) >> 6, first_w = (qw > 127 ? qw - 127 : 0) >> 6;
#pragma unroll
  for (int j = 0; j < NSLOT; ++j) {
    const int ch_ = 8 * j + wid;
    if (j < NSLOT - 1 || wid < REM) {
      const char* sp; unsigned sst;
      if (ch_ < KCH) { const int p = ch_ * 64 + lane, row = p / 9, g = p - row * 9;
        sp = (const char*)(a.k + (size_t)row * a.ldk + 8 * (g < 8 ? g : 0)); sst = (unsigned)(128 * a.ldk); }
      else { const int p = (ch_ - KCH) * 64 + lane, row = (p / 12) & 63, g = p - (p / 12) * 12;
        sp = (const char*)(a.v + (size_t)row * a.ldv + 8 * (g < 8 ? g : 0)); sst = (unsigned)(128 * a.ldv); }
      for (int kt = lo; kt < hi; ++kt)
        __builtin_amdgcn_global_load_lds((const unsigned*)(sp + (size_t)kt * sst), (LAS unsigned*)(lds + (kt - lo) * TILE + ch_ * 1024), 16, 0, 0);
    }
  }
  wait_vmcnt<0>();
  raw_barrier();
  const int i16 = lane & 15, q4 = i16 >> 2, p4 = i16 & 3, grp = (lane >> 4) & 1;
  for (int h4 = 0; h4 < 4; ++h4) {
    bf16x8 qf[NKS];
#pragma unroll
    for (int ks = 0; ks < NKS; ++ks) qf[ks] = *(const bf16x8*)(a.q + (size_t)myq * a.ldq + h4 * 64 + 16 * ks + 8 * hh);
    f32x16 O[NBLK];
#pragma unroll
    for (int bl = 0; bl < NBLK; ++bl)
#pragma unroll
      for (int i = 0; i < 16; ++i) O[bl][i] = 0.f;
    float m = sinks4[h4] / a.sl2;
    float l0 = (hh == 0) ? 1.f : 0.f, l1 = 0.f;
    for (int kt = first_w; kt <= last_w; ++kt) {
      LAS unsigned char* Kl = lds + (kt - lo) * TILE;
      f32x16 s[2];
      bf16x8 kf[2][NKS];
#pragma unroll
      for (int kb = 0; kb < 2; ++kb)
#pragma unroll
        for (int ks = 0; ks < NKS; ++ks) kf[kb][ks] = *(const LAS bf16x8*)(Kl + (32 * kb + r) * KSTR + (16 * ks + 8 * hh) * 2);
#pragma unroll
      for (int kb = 0; kb < 2; ++kb)
#pragma unroll
        for (int i = 0; i < 16; ++i) s[kb][i] = 0.f;
#pragma unroll
      for (int ks = 0; ks < NKS; ++ks)
#pragma unroll
        for (int kb = 0; kb < 2; ++kb) s[kb] = __builtin_amdgcn_mfma_f32_32x32x16_bf16(kf[kb][ks], qf[ks], s[kb], 0, 0, 0);
      const int key0 = kt * 64;
#pragma unroll
      for (int kb = 0; kb < 2; ++kb)
#pragma unroll
        for (int i = 0; i < 16; ++i) {
          const int key = key0 + 32 * kb + (i & 3) + 8 * (i >> 2) + 4 * hh;
          const bool valid = (key <= myq) && (myq - key < 128);
          s[kb][i] = valid ? s[kb][i] : -1e30f;
        }
      float mx = fmaxf(s[0][0], s[1][0]);
#pragma unroll
      for (int i = 1; i < 16; ++i) mx = fmaxf(fmaxf(mx, s[0][i]), s[1][i]);
      mx = half_max(mx);
      if (__builtin_amdgcn_ballot_w64(mx > m + tau) != 0ull) {
        const float mnew = fmaxf(m, mx);
        const float alpha = fast_exp2((m - mnew) * c);
        m = mnew; l0 *= alpha; l1 *= alpha;
#pragma unroll
        for (int bl = 0; bl < NBLK; ++bl)
#pragma unroll
          for (int i = 0; i < 16; ++i) O[bl][i] *= alpha;
      }
      const float nmc = -m * c;
      bf16x8 pf[2][2];
#pragma unroll
      for (int kb = 0; kb < 2; ++kb)
#pragma unroll
        for (int s2 = 0; s2 < 2; ++s2) {
          float pv[8];
#pragma unroll
          for (int e = 0; e < 8; ++e) pv[e] = fast_exp2(__builtin_fmaf(s[kb][8 * s2 + e], c, nmc));
          l0 += (pv[0] + pv[4]) + (pv[2] + pv[6]); l1 += (pv[1] + pv[5]) + (pv[3] + pv[7]);
          u32x4 w;
          w.x = pk2(pv[0], pv[1]); w.y = pk2(pv[2], pv[3]); w.z = pk2(pv[4], pv[5]); w.w = pk2(pv[6], pv[7]);
          pf[kb][s2] = __builtin_bit_cast(bf16x8, w);
        }
      LAS unsigned char* Vl = Kl + KCH * 1024 + (4 * hh + q4) * VSTR + (16 * grp) * 2 + 8 * p4;
#pragma unroll
      for (int st = 0; st < 4; ++st)
#pragma unroll
        for (int bl = 0; bl < NBLK; ++bl) {
          LAS unsigned char* ad = Vl + (16 * st) * VSTR + (32 * bl) * 2;
          const s16x4 lo_ = __builtin_amdgcn_ds_read_tr16_b64_v4i16((LAS s16x4*)ad);
          const s16x4 hi_ = __builtin_amdgcn_ds_read_tr16_b64_v4i16((LAS s16x4*)(ad + 8 * VSTR));
          const bf16x8 vf = __builtin_shufflevector(lo_, hi_, 0, 1, 2, 3, 4, 5, 6, 7);
          O[bl] = __builtin_amdgcn_mfma_f32_32x32x16_bf16(vf, pf[st >> 1][st & 1], O[bl], 0, 0, 0);
        }
    }
    const float l = half_sum(l0 + l1);
    const float inv = 1.f / l;
#pragma unroll
    for (int bl = 0; bl < NBLK; ++bl)
#pragma unroll
      for (int g = 0; g < 4; ++g) {
        const int f = h4 * 64 + 32 * bl + 8 * g + 4 * hh;
        float o0 = O[bl][4 * g + 0] * inv, o1 = O[bl][4 * g + 1] * inv, o2 = O[bl][4 * g + 2] * inv, o3 = O[bl][4 * g + 3] * inv;
        const u32x2 gv = *(const u32x2*)(a.gate + (size_t)myq * a.ldg + f);
        o0 *= silu_f(bflo(gv.x)); o1 *= silu_f(bfhi(gv.x)); o2 *= silu_f(bflo(gv.y)); o3 *= silu_f(bfhi(gv.y));
        u32x2 w; w.x = pk2(o0, o1); w.y = pk2(o2, o3);
        *(u32x2*)(a.out + (size_t)myq * a.ldo + f) = w;
      }
  }
  __syncthreads();
}

DI bool team_item(int G, int c, int n, int& bh, int& qb) {
  if (G == 256) {
    const int x = c & 7, li = c >> 3, t = li >> 3, i = li & 7;
    bh = x + 8 * (4 * t + n);
    const int j = (i + 4) & 7;
    qb = (n == 0) ? i : (n == 1) ? 7 - i : (n == 2) ? j : 7 - j;
    return true;
  }
  const int idx = n * G + ((n & 1) ? (G - 1 - c) : c);
  if (idx >= 1024) return false;
  qb = 7 - idx / 128; bh = idx % 128;
  return true;
}

DI int snake_idx(int round, int G, int c) { return round * G + ((round & 1) ? (G - 1 - c) : c); }

DI void attn_even(const Params& p, LAS unsigned char* lds, int i) {
  const int G = gridDim.x, c = blockIdx.x;
  unsigned char* ws = p.ws;
  const bf16_t* z = (const bf16_t*)(ws + WS_ZBUF);
  const bf16_t* qb_ = (const bf16_t*)(ws + WS_QBUF);
  const bf16_t* kv = (const bf16_t*)(ws + WS_HBUF);
  bf16_t* ob = (bf16_t*)(ws + WS_OBUF);
  for (int rd = 0; rd * G < 1024; ++rd) {
    int qb, bh;
    if (!team_item(G, c, rd, bh, qb)) continue;
    const int b = bh >> 3, hd = bh & 7;
    AttnArgs a;
    a.q = qb_ + (size_t)b * SEQ * 768 + hd * 96; a.ldq = 768;
    a.k = kv + (size_t)b * SEQ * 1024 + hd * 128; a.ldk = 1024;
    a.k2 = z + (size_t)b * SEQ * 2560 + 2432; a.ldk2 = 2560;
    a.v = kv + (size_t)b * SEQ * 1024 + hd * 128 + 64; a.ldv = 1024;
    a.out = ob + (size_t)b * SEQ * 1024 + hd * 64; a.ldo = 1024;
    a.gate = z + (size_t)b * SEQ * 2560 + 768 + hd * 64; a.ldg = 2560;
    a.fcum = nullptr; a.sl2 = 0.10206207261596577f * LOG2E; a.sink = 0.f;
    attn_item<96, 64, 0>(lds, a, qb);
  }
  for (int it = c; it < 256; it += G) {
    const int b = it >> 4, kvh = (it >> 3) & 1, qb = it & 7;
    AttnArgs a;
    const bf16_t* zb = z + (size_t)b * SEQ * 2560;
    a.q = zb + kvh * 256; a.ldq = 2560;
    a.k = zb + 512 + kvh * 64; a.ldk = 2560; a.k2 = nullptr; a.ldk2 = 0;
    a.v = zb + 640 + kvh * 64; a.ldv = 2560;
    a.out = ob + (size_t)b * SEQ * 1024 + 512 + kvh * 256; a.ldo = 1024;
    a.gate = zb + 768 + 512 + kvh * 256; a.ldg = 2560;
    a.fcum = nullptr; a.sl2 = 0.125f * LOG2E; a.sink = 0.f;
    float sk[4];
#pragma unroll
    for (int h4 = 0; h4 < 4; ++h4) sk[h4] = p.ev_sinks[i * 8 + kvh * 4 + h4] * LOG2E;
    swa_item(lds, a, sk, qb);
  }
}

DI void attn_odd(const Params& p, LAS unsigned char* lds) {
  const int G = gridDim.x, c = blockIdx.x;
  unsigned char* ws = p.ws;
  const bf16_t* z = (const bf16_t*)(ws + WS_ZBUF);
  bf16_t* od = (bf16_t*)(ws + WS_HBUF);
  bf16_t* ob = (bf16_t*)(ws + WS_OBUF);
  for (int rd = 0; rd * G < 1024; ++rd) {
    int qb, bh;
    if (!team_item(G, c, rd, bh, qb)) continue;
    const int b = bh >> 3, j = bh & 7;
    AttnArgs a;
    const bf16_t* zb = z + (size_t)b * SEQ * 4096;
    a.q = zb + j * 64; a.ldq = 4096;
    a.k = zb + 512 + j * 64; a.ldk = 4096; a.k2 = nullptr; a.ldk2 = 0;
    a.v = zb + 1024 + (j >> 1) * 128; a.ldv = 4096;
    a.out = od + (size_t)b * SEQ * 1024 + j * 128; a.ldo = 1024;
    a.gate = nullptr; a.ldg = 0;
    a.fcum = nullptr; a.sl2 = 0.125f * LOG2E; a.sink = 0.f;
#ifndef SKIP_DIFF
    attn_item<64, 128, 0>(lds, a, qb);
#endif
  }
  for (int rd = 0; rd * G < 1024; ++rd) {
    int qb, bh;
    if (!team_item(G, c, rd, bh, qb)) continue;
    const int b = bh >> 3, hd = bh & 7;
    AttnArgs a;
    const bf16_t* zb = z + (size_t)b * SEQ * 4096;
    a.q = zb + 1536 + hd * 64; a.ldq = 4096;
    a.k = zb + 2048 + hd * 64; a.ldk = 4096; a.k2 = nullptr; a.ldk2 = 0;
    a.v = zb + 2560 + hd * 64; a.ldv = 4096;
    a.out = ob + (size_t)b * SEQ * 1024 + 512 + hd * 64; a.ldo = 1024;
    a.gate = zb + 3072 + 512 + hd * 64; a.ldg = 4096;
    a.fcum = (const float*)(ws + WS_FCUM) + (size_t)bh * SEQ; a.sl2 = 0.125f * LOG2E; a.sink = 0.f;
#ifndef SKIP_FOX
    attn_item<64, 64, 2>(lds, a, qb);
#endif
  }
}

DI void diff_combine(const Params& p, int layer) {
  const int tid = opaque_tid(), lane = tid & 63, wid = tid >> 6;
  const int gw = blockIdx.x * 8 + wid, nw = gridDim.x * 8;
  const int i = layer >> 1;
  unsigned char* ws = p.ws;
  const bf16_t* od = (const bf16_t*)(ws + WS_HBUF);
  const bf16_t* z = (const bf16_t*)(ws + WS_ZBUF);
  bf16_t* ob = (bf16_t*)(ws + WS_OBUF);
  const float* lp = p.od_lambda + i * 256;
  const float s1 = wave_sum(lp[lane] * lp[64 + lane]), s2 = wave_sum(lp[128 + lane] * lp[192 + lane]);
  const float lam_init = 0.8f - 0.6f * expf(-0.3f * (float)layer);
  const float lam = expf(s1) - expf(s2) + lam_init;
  const int hd = lane >> 4, dv = (lane & 15) * 8;
  float sub[8];
#pragma unroll
  for (int e = 0; e < 8; ++e) sub[e] = p.od_subln[i * 128 + dv + e] * (1.f - lam_init);
  for (int row = gw; row < T; row += nw) {
    const u32x4 a = *(const u32x4*)(od + (size_t)row * 1024 + (2 * hd) * 128 + dv);
    const u32x4 b = *(const u32x4*)(od + (size_t)row * 1024 + (2 * hd + 1) * 128 + dv);
    const u32x4 g = *(const u32x4*)(z + (size_t)row * 4096 + 3072 + hd * 128 + dv);
    float d[8]; float ss = 0.f;
#pragma unroll
    for (int e = 0; e < 4; ++e) { d[2 * e] = bflo(a[e]) - lam * bflo(b[e]); d[2 * e + 1] = bfhi(a[e]) - lam * bfhi(b[e]); ss += d[2 * e] * d[2 * e] + d[2 * e + 1] * d[2 * e + 1]; }
    ss += __shfl_xor(ss, 1); ss += __shfl_xor(ss, 2); ss += __shfl_xor(ss, 4); ss += __shfl_xor(ss, 8);
    const float rs = rsqrtf(ss * (1.f / 128.f) + EPS);
    u32x4 w;
#pragma unroll
    for (int e = 0; e < 4; ++e) {
      const float o0 = d[2 * e] * rs * sub[2 * e] * silu_f(bflo(g[e])), o1 = d[2 * e + 1] * rs * sub[2 * e + 1] * silu_f(bfhi(g[e]));
      w[e] = pk2(o0, o1);
    }
    *(u32x4*)(ob + (size_t)row * 1024 + hd * 128 + dv) = w;
  }
}


DI void grid_barrier(unsigned* ctr, unsigned& epoch) {
  asm volatile("s_waitcnt vmcnt(0)" ::: "memory");
  __syncthreads();
  epoch += 1;
  if (threadIdx.x == 0) {
    __builtin_amdgcn_fence(__ATOMIC_RELEASE, "agent");
    asm volatile("s_waitcnt vmcnt(0)" ::: "memory");
    __hip_atomic_fetch_add(ctr, 1u, __ATOMIC_RELAXED, __HIP_MEMORY_SCOPE_AGENT);
    const unsigned target = epoch * gridDim.x;
    while (__hip_atomic_load(ctr, __ATOMIC_RELAXED, __HIP_MEMORY_SCOPE_AGENT) < target) __builtin_amdgcn_s_sleep(1);
    __builtin_amdgcn_fence(__ATOMIC_ACQUIRE, "agent");
    asm volatile("s_waitcnt vmcnt(0)" ::: "memory");
  }
  __syncthreads();
}

__global__ void __launch_bounds__(512) fwd_megakernel(Params p) {
  extern __shared__ __attribute__((aligned(16))) unsigned char lds_raw[];
  LAS unsigned char* lds = (LAS unsigned char*)lds_raw;
  cg::grid_group grid = cg::this_grid();
  unsigned char* ws = p.ws;
  const int G = gridDim.x, bid = blockIdx.x;
  const float* cosH = (const float*)(ws + WS_COSH); const float* sinH = (const float*)(ws + WS_SINH);
  const float* cosR = (const float*)(ws + WS_COSR); const float* sinR = (const float*)(ws + WS_SINR);

  unsigned* bar_ctr = (unsigned*)(ws + WS_BAR); unsigned bar_epoch = 0;
  if (bid == 0 && threadIdx.x == 0) __hip_atomic_store(bar_ctr, 0u, __ATOMIC_RELAXED, __HIP_MEMORY_SCOPE_AGENT);
#ifndef SKIP_PRO
  prologue(p, lds);
#endif
  grid.sync();
#pragma unroll
  for (int layer = 0; layer < 4; ++layer) {
    const int i = layer >> 1; const bool odd = layer & 1;
#ifndef SKIP_ROW
    rowwise_phase(p, lds, layer - 1, layer);
#endif
    grid_barrier(bar_ctr, bar_epoch);
    {
#ifndef SKIP_SCAN
      if (odd && bid < 128) fox_scan(p, lds, bid);
#endif
      pg8::Gemm g; g.A = (const bf16_t*)(ws + WS_HBUF); g.lda = 1024; g.K = 1024; g.M = T;
      Epi e; e.out = (bf16_t*)(ws + WS_ZBUF); e.pin = nullptr; e.pslot = 0; e.nK = 0; e.qmode = 0; e.pout = odd ? nullptr : (float*)(ws + WS_PART); e.cosH = cosH; e.sinH = sinH; e.cosR = cosR; e.sinR = sinR;
      if (!odd) { g.Bt = (const bf16_t*)(ws + WS_WEVIN + i * SZ_WEVIN); g.N = 2560; e.ldc = 2560; e.rope64_end = 640; e.rope32_lo = 2432; e.rope32_hi = 2464; }
      else { g.Bt = (const bf16_t*)(ws + WS_WODIN + i * SZ_WODIN); g.N = 4096; e.ldc = 4096; e.rope64_end = 1024; e.rope32_lo = 0; e.rope32_hi = 0; }
      pg8::StaticOrder S; S.init(g.M, g.N, G, bid);
#ifndef SKIP_G1
      pg8::gemm_phase<Epi>(lds, g, S, e);
#endif
    }
    grid_barrier(bar_ctr, bar_epoch);
    if (!odd) {
      for (int which = 0; which < 2; ++which) {
        pg8::Gemm g; g.M = T; g.lda = 2560;
        Epi e; e.rope64_end = 0; e.rope32_lo = 0; e.rope32_hi = 0; e.cosH = cosH; e.sinH = sinH; e.cosR = cosR; e.sinR = sinR; e.pout = nullptr; e.pin = (const float*)(ws + WS_PART);
        if (which == 0) { g.A = (const bf16_t*)(ws + WS_ZBUF) + 1792; g.Bt = (const bf16_t*)(ws + WS_WUQ + i * SZ_WUQ); g.N = 768; g.K = 384;
          e.out = (bf16_t*)(ws + WS_QBUF); e.ldc = 768; e.qmode = 1; e.pslot = 0; e.nK = 384; }
        else { g.A = (const bf16_t*)(ws + WS_ZBUF) + 2176; g.Bt = (const bf16_t*)(ws + WS_WUKV + i * SZ_WUKV); g.N = 1024; g.K = 256;
          e.out = (bf16_t*)(ws + WS_HBUF); e.ldc = 1024; e.qmode = 0; e.pslot = 12; e.nK = 256; }
        pg8::StaticOrder S; S.init(g.M, g.N, G, bid);
#ifndef SKIP_G2
        pg8::gemm_phase<Epi>(lds, g, S, e);
#endif
      }
      grid_barrier(bar_ctr, bar_epoch);
#ifndef SKIP_ATTE
      attn_even(p, lds, i);
#endif
      grid_barrier(bar_ctr, bar_epoch);
    } else {
#ifndef SKIP_ATTO
      attn_odd(p, lds);
#endif
      grid_barrier(bar_ctr, bar_epoch);
#ifndef SKIP_COMB
      diff_combine(p, layer);
#endif
      grid_barrier(bar_ctr, bar_epoch);
    }
    {
      pg8::Gemm g; g.A = (const bf16_t*)(ws + WS_OBUF); g.lda = 1024; g.K = 1024; g.M = T; g.N = 1024;
      g.Bt = (const bf16_t*)(ws + (odd ? WS_WODOUT : WS_WEVOUT) + i * SZ_WOUT);
      Epi e; e.out = (bf16_t*)(ws + WS_HBUF); e.ldc = 1024; e.pin = nullptr; e.pslot = 0; e.pout = nullptr; e.nK = 0; e.qmode = 0; e.rope64_end = 0; e.rope32_lo = 0; e.rope32_hi = 0;
      e.cosH = cosH; e.sinH = sinH; e.cosR = cosR; e.sinR = sinR;
      pg8::StaticOrder S; S.init(g.M, g.N, G, bid);
#ifndef SKIP_G3
      pg8::gemm_phase<Epi>(lds, g, S, e);
#endif
    }
    grid_barrier(bar_ctr, bar_epoch);
  }
#ifndef SKIP_ROW
  rowwise_phase(p, lds, 3, 4);
#endif
}

constexpr int LDS_BYTES = 155648;

extern "C" void kernel_launch(void* const* d_in, const int* in_sizes, int n_in, void* d_out, int out_size, void* d_ws, size_t ws_size, hipStream_t stream) {
  static int grid_blocks = 0;
  if (grid_blocks == 0) {
    int dev = 0, cus = 0, per_cu = 0;
    if (hipGetDevice(&dev) != hipSuccess || hipDeviceGetAttribute(&cus, hipDeviceAttributeMultiprocessorCount, dev) != hipSuccess) { fprintf(stderr, "device query failed\n"); grid_blocks = -1; return; }
    if (hipFuncSetAttribute((const void*)fwd_megakernel, hipFuncAttributeMaxDynamicSharedMemorySize, LDS_BYTES) != hipSuccess) { fprintf(stderr, "hipFuncSetAttribute failed\n"); grid_blocks = -1; return; }
    if (hipOccupancyMaxActiveBlocksPerMultiprocessor(&per_cu, (const void*)fwd_megakernel, 512, LDS_BYTES) != hipSuccess || per_cu < 1) { fprintf(stderr, "occupancy query: %d\n", per_cu); per_cu = 1; }
    (void)hipGetLastError();
    grid_blocks = cus;
    if (ws_size < WS_END) { fprintf(stderr, "workspace too small: %zu < %zu\n", ws_size, (size_t)WS_END); grid_blocks = -1; return; }
  }
  if (grid_blocks < 0) return;
  Params p{};
  const float** fp = (const float**)&p;
  for (int i = 0; i < 18; ++i) fp[i] = (const float*)d_in[i];
  p.out = (float*)d_out; p.ws = (unsigned char*)d_ws;
  void* args[] = {&p};
  hipError_t e = hipLaunchCooperativeKernel((const void*)fwd_megakernel, dim3(grid_blocks), dim3(512), args, LDS_BYTES, stream);
  if (e != hipSuccess) fprintf(stderr, "cooperative launch failed: %s (grid %d)\n", hipGetErrorString(e), grid_blocks);
}
```

```cpp
#include <hip/hip_runtime.h>
#include <hip/hip_cooperative_groups.h>
#include <cstdio>
#include <type_traits>
namespace cg = cooperative_groups;

#define DI __device__ __forceinline__
#define LAS __attribute__((address_space(3)))
typedef unsigned short bf16_t;
typedef short bf16x8 __attribute__((ext_vector_type(8)));
typedef short s16x4 __attribute__((ext_vector_type(4)));
typedef float f32x2 __attribute__((ext_vector_type(2)));
typedef float f32x4 __attribute__((ext_vector_type(4)));
typedef float f32x16 __attribute__((ext_vector_type(16)));
typedef unsigned u32x2 __attribute__((ext_vector_type(2)));
typedef unsigned u32x4 __attribute__((ext_vector_type(4)));
typedef __bf16 bf16x2_t __attribute__((ext_vector_type(2)));

constexpr int T = 32768, DM = 1024, NB = 16, SEQ = 2048;
constexpr float LOG2E = 1.4426950408889634f;
constexpr float EPS = 1e-6f;

constexpr size_t SZ_WEVIN = 2560ull * 1024 * 2, SZ_WODIN = 4096ull * 1024 * 2, SZ_WUQ = 768ull * 384 * 2, SZ_WUKV = 1024ull * 256 * 2, SZ_WOUT = 1024ull * 1024 * 2;
constexpr size_t WS_WEVIN = 0;
constexpr size_t WS_WODIN = WS_WEVIN + 2 * SZ_WEVIN;
constexpr size_t WS_WUQ = WS_WODIN + 2 * SZ_WODIN;
constexpr size_t WS_WUKV = WS_WUQ + 2 * SZ_WUQ;
constexpr size_t WS_WEVOUT = WS_WUKV + 2 * SZ_WUKV;
constexpr size_t WS_WODOUT = WS_WEVOUT + 2 * SZ_WOUT;
constexpr size_t WS_MOD = WS_WODOUT + 2 * SZ_WOUT;
constexpr size_t WS_COSH = WS_MOD + 4ull * 16 * 3072 * 4;
constexpr size_t WS_SINH = WS_COSH + 2048ull * 32 * 4;
constexpr size_t WS_COSR = WS_SINH + 2048ull * 32 * 4;
constexpr size_t WS_SINR = WS_COSR + 2048ull * 16 * 4;
constexpr size_t WS_LOGF = WS_SINR + 2048ull * 16 * 4;
constexpr size_t WS_FCUM = WS_LOGF + (size_t)T * 8 * 4;
constexpr size_t WS_HBUF = (WS_FCUM + (size_t)T * 8 * 4 + 4095) & ~(size_t)4095;
constexpr size_t WS_OBUF = WS_HBUF + (size_t)T * 1024 * 2;
constexpr size_t WS_ZBUF = WS_OBUF + (size_t)T * 1024 * 2;
constexpr size_t WS_QBUF = WS_ZBUF + (size_t)T * 2560 * 2;
constexpr size_t WS_BAR = WS_ZBUF + (size_t)T * 4096 * 2;
constexpr size_t WS_PART = WS_BAR + 256;
constexpr size_t WS_XBF = (WS_PART + (size_t)T * 20 * 4 + 4095) & ~(size_t)4095;
constexpr size_t WS_END = WS_XBF + (size_t)T * 1024 * 2;

struct Params {
  const float *x, *c, *w_ada, *b_ada, *g_pre, *g_post, *ev_w_in, *ev_q_norm, *ev_kv_norm, *ev_w_uq, *ev_w_ukv, *ev_sinks, *ev_w_out,
      *od_w_in, *od_forget_bias, *od_lambda, *od_subln, *od_w_out;
  float* out;
  unsigned char* ws;
};

DI int opaque_tid() { int t = threadIdx.x; asm volatile("" : "+v"(t)); return t; }
DI float bflo(unsigned u) { return __uint_as_float(u << 16); }
DI float bfhi(unsigned u) { return __uint_as_float(u & 0xffff0000u); }
DI unsigned pk2(float lo, float hi) { f32x2 f = {lo, hi}; bf16x2_t b = __builtin_convertvector(f, bf16x2_t); return __builtin_bit_cast(unsigned, b); }
DI bf16_t f2bf(float f) { return (bf16_t)(pk2(f, 0.f) & 0xffffu); }
DI float fast_exp2(float x) { return __builtin_amdgcn_exp2f(x); }
DI float silu_f(float x) { return x * __builtin_amdgcn_rcpf(1.f + fast_exp2(-x * LOG2E)); }
DI float wave_sum(float v) {
#pragma unroll
  for (int o = 32; o >= 1; o >>= 1) v += __shfl_xor(v, o);
  return v;
}

namespace pg8 {
constexpr int BM = 256, BK = 64, HALF = 128, HTB = HALF * BK * 2, STAGE_BYTES = 8 * HTB, NXCD = 8, WGM = 8;
DI int lds_byte(int r, int c) { const int st = (r >> 4) * 2 + (c >> 5), rr = r & 15, cc = c & 31, ob = rr * 64 + cc * 2; return st * 1024 + (ob ^ (((ob >> 9) & 1) << 5)); }
DI void stage_rc(int b, int& R, int& C) { const int st = b / 1024, sb = b % 1024, swz = sb ^ (((sb >> 9) & 1) << 5); R = (st >> 1) * 16 + swz / 64; C = (st & 1) * 32 + (swz % 64) / 2; }
DI int perm32(int rho) { const int n = rho >> 4, i = rho & 15; return 8 * (i >> 2) + 4 * n + (i & 3); }
struct Unit { int pm, pn; };
struct Gemm { const bf16_t* A; const bf16_t* Bt; int M, N, K, lda; };
struct StaticOrder {
  int nM, nN, nwg, G, c;
  DI void init(int M, int N, int G_, int c_) { nM = M / BM; nN = N / BM; nwg = nM * nN; G = G_; c = c_; }
  DI bool next(int i, Unit& u) const {
    const long L = (long)i * G + c; if (L >= nwg) return false;
    int wgid = (int)L; { const int q = nwg / NXCD, r = nwg % NXCD, xcd = wgid % NXCD, off = wgid / NXCD; wgid = (xcd < r ? xcd * (q + 1) : r * (q + 1) + (xcd - r) * q) + off; }
    const int nig = WGM * nN, gid = wgid / nig, fm = gid * WGM, gsz = (nM - fm) < WGM ? (nM - fm) : WGM;
    u.pm = fm + ((wgid % nig) % gsz); u.pn = (wgid % nig) / gsz; return true;
  }
};

template <class Epi>
DI void gemm_phase(LAS unsigned char* lds, const Gemm g, const StaticOrder& S, const Epi& E) {
  const int tid = opaque_tid(), wid = __builtin_amdgcn_readfirstlane(tid >> 6), lane = tid & 63, wr = wid >> 2, wc = wid & 3, fr = lane & 15, fq = lane >> 4;
  const int K = g.K, nt = K / BK, lda = g.lda;
  unsigned voffA[2], voffB[2];
#pragma unroll
  for (int i = 0; i < 2; ++i) { int R, C; stage_rc(tid * 16 + i * 8192, R, C); const int Rb = (R & ~31) + perm32(R & 31);
    voffA[i] = (unsigned)(R * lda + C) * 2u; voffB[i] = (unsigned)(Rb * K + C) * 2u; }
  const size_t kstep = (size_t)(BK * 2);
  const size_t hstepA = (size_t)HALF * lda * 2, hstepB = (size_t)HALF * K * 2;
  const size_t tstepA = 2 * hstepA, tstepB = 2 * hstepB;
  const unsigned ldsw = (unsigned)wid * 1024u;
  const int aoff = lds_byte(wr * 64 + fr, fq * 8), boff = lds_byte(wc * 32 + fr, fq * 8);
#define PG8_SA(b, h) (((b) * 2 + (h)) * HTB)
#define PG8_SB(b, h) ((4 + (b) * 2 + (h)) * HTB)
#define PG8_STAGE(bufoff, gbase, voff) do { _Pragma("unroll") for (int _i = 0; _i < 2; ++_i) \
    __builtin_amdgcn_global_load_lds((const unsigned*)((const char*)(gbase) + (voff)[_i]), (LAS unsigned*)(lds + (bufoff) + ldsw + _i * 8192), 16, 0, 0); } while (0)
#define PG8_LDA(dst, b, h) do { _Pragma("unroll") for (int m = 0; m < 4; ++m) _Pragma("unroll") for (int k = 0; k < 2; ++k) dst[m][k] = *(const LAS bf16x8*)(lds + PG8_SA(b, h) + aoff + m * 2048 + k * 1024); } while (0)
#define PG8_LDB(dst, b, h) do { _Pragma("unroll") for (int n = 0; n < 2; ++n) _Pragma("unroll") for (int k = 0; k < 2; ++k) dst[n][k] = *(const LAS bf16x8*)(lds + PG8_SB(b, h) + boff + n * 2048 + k * 1024); } while (0)
#define PG8_MMA(ai, bj, At, Bt) do { __builtin_amdgcn_s_setprio(1); _Pragma("unroll") for (int m = 0; m < 4; ++m) _Pragma("unroll") for (int n = 0; n < 2; ++n) _Pragma("unroll") for (int k = 0; k < 2; ++k) \
    acc[ai][bj][m][n] = __builtin_amdgcn_mfma_f32_16x16x32_bf16(Bt[n][k], At[m][k], acc[ai][bj][m][n], 0, 0, 0); __builtin_amdgcn_s_setprio(0); } while (0)
#define PG8_WAIT_V(n) asm volatile("s_waitcnt vmcnt(" #n ")" ::: "memory")
#define PG8_WAIT_L(n) asm volatile("s_waitcnt lgkmcnt(" #n ")" ::: "memory")
#define PG8_BAR __builtin_amdgcn_s_barrier()
#define PG8_SCHED __builtin_amdgcn_sched_barrier(0)
  Unit cur, nxt; int ui = 0;
  if (!S.next(0, cur)) return;
  f32x4 acc[2][2][4][2];
#pragma unroll
  for (int a = 0; a < 2; ++a)
#pragma unroll
    for (int b = 0; b < 2; ++b)
#pragma unroll
      for (int m = 0; m < 4; ++m)
#pragma unroll
        for (int n = 0; n < 2; ++n) acc[a][b][m][n] = (f32x4){0.f, 0.f, 0.f, 0.f};
  bf16x8 At[4][2], B0[2][2], B1[2][2];
  const char* cA = (const char*)g.A + (size_t)cur.pm * tstepA; const char* cB = (const char*)g.Bt + (size_t)cur.pn * tstepB;
  PG8_STAGE(PG8_SB(0, 0), cB, voffB); PG8_STAGE(PG8_SA(0, 0), cA, voffA); PG8_STAGE(PG8_SB(0, 1), cB + hstepB, voffB); PG8_STAGE(PG8_SA(0, 1), cA + hstepA, voffA);
  if (wr == 1) PG8_BAR;
  PG8_WAIT_V(4); PG8_BAR;
  PG8_STAGE(PG8_SB(1, 0), cB + kstep, voffB); PG8_STAGE(PG8_SA(1, 0), cA + kstep, voffA); PG8_STAGE(PG8_SB(1, 1), cB + hstepB + kstep, voffB);
  PG8_WAIT_V(6); PG8_BAR;
  for (;;) {
    const bool has_next = S.next(ui + 1, nxt);
    const char* nA = has_next ? (const char*)g.A + (size_t)nxt.pm * tstepA : cA; const char* nB = has_next ? (const char*)g.Bt + (size_t)nxt.pn * tstepB : cB;
    for (int t = 0; t < nt; t += 2) {
      const bool last = (t == nt - 2);
      const char* a1 = cA + (size_t)(t + 1) * kstep;
      const char* a2 = last ? nA : cA + (size_t)(t + 2) * kstep; const char* b2 = last ? nB : cB + (size_t)(t + 2) * kstep;
      const char* a3 = a2 + kstep; const char* b3 = b2 + kstep;
      PG8_LDB(B0, 0, 0); PG8_SCHED; PG8_LDA(At, 0, 0); PG8_STAGE(PG8_SA(1, 1), a1 + hstepA, voffA);
      PG8_WAIT_L(8); PG8_BAR; PG8_WAIT_L(0); PG8_MMA(0, 0, At, B0); PG8_BAR; PG8_SCHED;
      PG8_LDB(B1, 0, 1); PG8_STAGE(PG8_SB(0, 0), b2, voffB);
      PG8_BAR; PG8_WAIT_L(0); PG8_MMA(0, 1, At, B1); PG8_BAR;
      PG8_LDA(At, 0, 1); PG8_STAGE(PG8_SA(0, 0), a2, voffA);
      PG8_BAR; PG8_WAIT_L(0); PG8_MMA(1, 0, At, B0); PG8_BAR; PG8_SCHED;
      PG8_STAGE(PG8_SB(0, 1), b2 + hstepB, voffB);
      PG8_WAIT_V(6); PG8_BAR; PG8_MMA(1, 1, At, B1); PG8_BAR;
      PG8_LDB(B0, 1, 0); PG8_SCHED; PG8_LDA(At, 1, 0); PG8_STAGE(PG8_SA(0, 1), a2 + hstepA, voffA);
      PG8_WAIT_L(8); PG8_BAR; PG8_WAIT_L(0); PG8_MMA(0, 0, At, B0); PG8_BAR; PG8_SCHED;
      PG8_LDB(B1, 1, 1); PG8_STAGE(PG8_SB(1, 0), b3, voffB);
      PG8_BAR; PG8_WAIT_L(0); PG8_MMA(0, 1, At, B1); PG8_BAR;
      PG8_LDA(At, 1, 1); PG8_STAGE(PG8_SA(1, 0), a3, voffA);
      PG8_BAR; PG8_WAIT_L(0); PG8_MMA(1, 0, At, B0); PG8_BAR; PG8_SCHED;
      PG8_STAGE(PG8_SB(1, 1), b3 + hstepB, voffB);
      PG8_WAIT_V(6); PG8_BAR; PG8_MMA(1, 1, At, B1); PG8_BAR;
    }
    E(acc, cur, wr, wc, fr, fq);
    if (!has_next) break;
#pragma unroll
    for (int a = 0; a < 2; ++a)
#pragma unroll
      for (int b = 0; b < 2; ++b)
#pragma unroll
        for (int m = 0; m < 4; ++m)
#pragma unroll
          for (int n = 0; n < 2; ++n) acc[a][b][m][n] = (f32x4){0.f, 0.f, 0.f, 0.f};
    cur = nxt; cA = nA; cB = nB; ++ui;
  }
  PG8_WAIT_V(0);
  if (wr == 0) PG8_BAR;
  PG8_BAR;
#undef PG8_SA
#undef PG8_SB
#undef PG8_STAGE
#undef PG8_LDA
#undef PG8_LDB
#undef PG8_MMA
#undef PG8_WAIT_V
#undef PG8_WAIT_L
#undef PG8_BAR
#undef PG8_SCHED
}
}

struct Epi {
  bf16_t* out; int ldc;
  int rope64_end;
  int rope32_lo, rope32_hi;
  int qmode;
  const float* pin; int nK;
  int pslot;
  float* pout;
  const float *cosH, *sinH, *cosR, *sinR;
  DI void operator()(const f32x4 (&acc)[2][2][4][2], const pg8::Unit& u, int wr, int wc, int fr, int fq) const {
    const int row0 = u.pm * 256 + wr * 64 + fr;
    int rt[2];
#pragma unroll
    for (int bj = 0; bj < 2; ++bj) {
      const int cw = u.pn * 256 + bj * 128 + wc * 32;
      rt[bj] = 0;
      if (cw < rope64_end) rt[bj] = 1;
      else if (cw >= rope32_lo && cw < rope32_hi) rt[bj] = 2;
      else if (qmode && ((cw >> 5) % 3) == 2) rt[bj] = 2;
    }
    const int tt = rt[0] | rt[1];
    const float* ctab = (tt == 1) ? cosH + (16 * (wc & 1) + 4 * fq) : cosR + 4 * fq;
    const float* stab = (tt == 1) ? sinH + (16 * (wc & 1) + 4 * fq) : sinR + 4 * fq;
    const int tstride = (tt == 1) ? 32 : 16;
    int ps[2] = {-1, -1};
    if (pout) {
#pragma unroll
      for (int bj = 0; bj < 2; ++bj) { const int cw = u.pn * 256 + bj * 128 + wc * 32;
        if (cw >= 1792 && cw < 2432) ps[bj] = ((cw - 1792) >> 7) * 4 + wc; }
    }
#pragma unroll
    for (int ai = 0; ai < 2; ++ai) {
      f32x4 cv[4], sv[4]; float rs[4];
#pragma unroll
      for (int m = 0; m < 4; ++m) {
        const int row = row0 + ai * 128 + m * 16;
        if (tt) { const int pos = row & (SEQ - 1); cv[m] = *(const f32x4*)(ctab + pos * tstride); sv[m] = *(const f32x4*)(stab + pos * tstride); }
        rs[m] = 1.f;
        if (pin) { const f32x4 p0 = *(const f32x4*)(pin + (size_t)row * 20 + pslot), p1 = *(const f32x4*)(pin + (size_t)row * 20 + pslot + 4);
          float ss = ((p0[0] + p0[1]) + (p0[2] + p0[3])) + ((p1[0] + p1[1]) + (p1[2] + p1[3]));
          if (nK == 384) { const f32x4 p2 = *(const f32x4*)(pin + (size_t)row * 20 + pslot + 8); ss += (p2[0] + p2[1]) + (p2[2] + p2[3]); }
          rs[m] = rsqrtf(ss / (float)nK + EPS); }
      }
#pragma unroll
      for (int m = 0; m < 4; ++m) {
        const int row = row0 + ai * 128 + m * 16;
#pragma unroll
        for (int bj = 0; bj < 2; ++bj) {
          const int c0 = u.pn * 256 + bj * 128 + wc * 32 + 8 * fq;
          f32x4 v0 = acc[ai][bj][m][0] * rs[m], v1 = acc[ai][bj][m][1] * rs[m];
          if (ps[bj] >= 0) {
            float sq = (v0[0] * v0[0] + v0[1] * v0[1]) + (v0[2] * v0[2] + v0[3] * v0[3]) + (v1[0] * v1[0] + v1[1] * v1[1]) + (v1[2] * v1[2] + v1[3] * v1[3]);
            sq += __shfl_xor(sq, 16); sq += __shfl_xor(sq, 32);
            if (fq == 0) pout[(size_t)row * 20 + ps[bj]] = sq;
          }
          if (rt[bj]) {
            const f32x4 o1 = v0 * cv[m] - v1 * sv[m], o2 = v1 * cv[m] + v0 * sv[m];
            v0 = o1; v1 = o2;
          }
          u32x4 w; w.x = pk2(v0[0], v0[1]); w.y = pk2(v0[2], v0[3]); w.z = pk2(v1[0], v1[1]); w.w = pk2(v1[2], v1[3]);
          *(u32x4*)(out + (size_t)row * ldc + c0) = w;
        }
      }
    }
  }
};

DI int ropeperm64(int p) { const int g = p >> 3, r = p & 7; return r < 4 ? 4 * g + r : 32 + 4 * g + (r - 4); }
DI int ropeperm32(int p) { const int g = p >> 3, r = p & 7; return r < 4 ? 4 * g + r : 16 + 4 * g + (r - 4); }
DI int srccol(int kind, int n) {
  if (kind == 0) {
    if (n < 512) return 672 + (n & ~63) + ropeperm64(n & 63);
    if (n < 640) return 1184 + ((n - 512) & ~63) + ropeperm64(n & 63);
    if (n < 768) return 1312 + (n - 640);
    if (n < 1792) return 1440 + (n - 768);
    if (n < 2176) return n - 1792;
    if (n < 2432) return 384 + (n - 2176);
    if (n < 2464) return 640 + ropeperm32(n - 2432);
    return -1;
  }
  if (kind == 1) {
    if (n < 1024) return (n & ~63) + ropeperm64(n & 63);
    if (n < 3072) return n;
    return 3080 + (n - 3072);
  }
  if (kind == 2) { const int hd = n / 96, p = n - hd * 96; return hd * 96 + (p < 64 ? p : 64 + ropeperm32(p - 64)); }
  return n;
}
DI void convert_tile(LAS unsigned char* lds, const float* W, int Nsrc, int K, bf16_t* Wt, int kind, const float* g, int tn, int tk) {
  const int tid = opaque_tid();
  LAS bf16_t* tile = (LAS bf16_t*)lds;
  const int nl = tid & 63, ks = tid >> 6;
  const int sc = srccol(kind, tn * 64 + nl);
#pragma unroll
  for (int kk = ks; kk < 64; kk += 8) {
    const int k = tk * 64 + kk;
    float v = 0.f;
    if (sc >= 0) { v = W[(size_t)k * Nsrc + sc]; if (g) v *= g[k]; }
    tile[nl * 72 + kk] = f2bf(v);
  }
  __syncthreads();
  { const int n2 = tid >> 3, ch = tid & 7;
    const u32x4 v = *(const LAS u32x4*)(tile + n2 * 72 + ch * 8);
    *(u32x4*)(Wt + (size_t)(tn * 64 + n2) * K + tk * 64 + ch * 8) = v; }
  __syncthreads();
}

DI void prologue(const Params& p, LAS unsigned char* lds) {
  const int tid = opaque_tid(), G = gridDim.x, bid = blockIdx.x;
  unsigned char* ws = p.ws;
  for (int idx = bid * 512 + tid; idx < 2048 * 48; idx += G * 512) {
    const bool isH = idx < 2048 * 32;
    const int j = isH ? idx : idx - 2048 * 32;
    const int pos = isH ? (j >> 5) : (j >> 4), i = isH ? (j & 31) : (j & 15);
    const float e = isH ? (float)(2 * i) * (1.f / 64.f) : (float)(2 * i) * (1.f / 32.f);
    const float inv = fast_exp2(-e * 13.287712379549449f);
    const float ang = (float)pos * inv;
    double t = (double)ang * 0.15915494309189535; t -= rint(t);
    const float fr = (float)t;
    const float cv = __builtin_amdgcn_cosf(fr), sv = __builtin_amdgcn_sinf(fr);
    if (isH) { ((float*)(ws + WS_COSH))[j] = cv; ((float*)(ws + WS_SINH))[j] = sv; }
    else { ((float*)(ws + WS_COSR))[j] = cv; ((float*)(ws + WS_SINR))[j] = sv; }
  }
  constexpr int NT0 = 40 * 16, NT1 = 64 * 16, NT2 = 12 * 6, NT3 = 16 * 4, NT4 = 16 * 16;
  constexpr int PER_I = NT0 + NT1 + NT2 + NT3 + 2 * NT4;
  for (int job = bid; job < 2 * PER_I; job += G) {
    const int i = job / PER_I; int j = job - i * PER_I;
    if (j < NT0) { convert_tile(lds, p.ev_w_in + (size_t)i * 1024 * 2464, 2464, 1024, (bf16_t*)(ws + WS_WEVIN + i * SZ_WEVIN), 0, nullptr, j / 16, j % 16); continue; }
    j -= NT0;
    if (j < NT1) { convert_tile(lds, p.od_w_in + (size_t)i * 1024 * 4104, 4104, 1024, (bf16_t*)(ws + WS_WODIN + i * SZ_WODIN), 1, nullptr, j / 16, j % 16); continue; }
    j -= NT1;
    if (j < NT2) { convert_tile(lds, p.ev_w_uq + (size_t)i * 384 * 768, 768, 384, (bf16_t*)(ws + WS_WUQ + i * SZ_WUQ), 2, p.ev_q_norm + i * 384, j / 6, j % 6); continue; }
    j -= NT2;
    if (j < NT3) { convert_tile(lds, p.ev_w_ukv + (size_t)i * 256 * 1024, 1024, 256, (bf16_t*)(ws + WS_WUKV + i * SZ_WUKV), 3, p.ev_kv_norm + i * 256, j / 4, j % 4); continue; }
    j -= NT3;
    if (j < NT4) { convert_tile(lds, p.ev_w_out + (size_t)i * 1024 * 1024, 1024, 1024, (bf16_t*)(ws + WS_WEVOUT + i * SZ_WOUT), 4, nullptr, j / 16, j % 16); continue; }
    j -= NT4;
    convert_tile(lds, p.od_w_out + (size_t)i * 1024 * 1024, 1024, 1024, (bf16_t*)(ws + WS_WODOUT + i * SZ_WOUT), 4, nullptr, j / 16, j % 16);
  }
  const int item0 = G - 1 - bid;
  if (item0 < 192) {
    LAS float* cond = (LAS float*)lds;
    LAS float* red = (LAS float*)(lds + 65536);
    for (int e = tid; e < 16 * 1024; e += 512) { const int b = e >> 10, k = e & 1023; cond[k * 16 + b] = silu_f(p.c[e]); }
    __syncthreads();
    for (int item = item0; item < 192; item += G) {
      const int l = item / 48, n0 = (item % 48) * 64;
      const int col = tid & 63, kg = tid >> 6;
      float a[16];
#pragma unroll
      for (int b = 0; b < 16; ++b) a[b] = 0.f;
      const float* wp = p.w_ada + (size_t)l * 1024 * 3072 + n0 + col;
      for (int k = kg * 128; k < kg * 128 + 128; ++k) {
        const float w = wp[(size_t)k * 3072];
#pragma unroll
        for (int b4 = 0; b4 < 4; ++b4) { const f32x4 cv = *(const LAS f32x4*)(cond + k * 16 + b4 * 4);
          a[b4 * 4 + 0] += cv[0] * w; a[b4 * 4 + 1] += cv[1] * w; a[b4 * 4 + 2] += cv[2] * w; a[b4 * 4 + 3] += cv[3] * w; }
      }
#pragma unroll
      for (int b = 0; b < 16; ++b) red[(kg * 16 + b) * 64 + col] = a[b];
      __syncthreads();
      for (int e = tid; e < 1024; e += 512) { const int b = e >> 6, cc = e & 63; float s = 0.f;
#pragma unroll
        for (int k8 = 0; k8 < 8; ++k8) s += red[(k8 * 16 + b) * 64 + cc];
        ((float*)(ws + WS_MOD))[((size_t)l * 16 + b) * 3072 + n0 + cc] = s + p.b_ada[l * 3072 + n0 + cc]; }
      __syncthreads();
    }
  }
}

DI void rowwise_phase(const Params& p, LAS unsigned char* lds, int lp, int ln) {
  const int tid = opaque_tid(), lane = tid & 63, wid = tid >> 6;
  const int gw = blockIdx.x * 8 + wid, nw = gridDim.x * 8;
  unsigned char* ws = p.ws;
  const float* mod = (const float*)(ws + WS_MOD);
  const bf16_t* ybuf = (const bf16_t*)(ws + WS_HBUF);
  bf16_t* hbuf = (bf16_t*)(ws + WS_HBUF);
  const bool ff = (ln < 4) && (ln & 1);
  LAS f32x4* wl = (LAS f32x4*)lds;
  if (ff) {
    const float* w = p.od_w_in + (size_t)(ln >> 1) * 1024 * 4104 + 3072;
    for (int c = tid; c < 1024; c += 512) {
      const f32x4 w0 = *(const f32x4*)(w + (size_t)c * 4104), w1 = *(const f32x4*)(w + (size_t)c * 4104 + 4);
      const int ln_ = (c & 255) >> 2, e = c & 3, j = c >> 8;
      wl[(j * 4 + e) * 64 + ln_] = w0; wl[1024 + (j * 4 + e) * 64 + ln_] = w1;
    }
    __syncthreads();
  }
  for (int row = gw; row < T; row += nw) {
    const int b = row >> 11;
    f32x4 xv[4];
    bf16_t* xbf = (bf16_t*)(ws + WS_XBF) + (size_t)row * DM;
    if (lp <= 0) {
      const float* xin = p.x + (size_t)row * DM;
#pragma unroll
      for (int j = 0; j < 4; ++j) xv[j] = *(const f32x4*)(xin + 4 * lane + 256 * j);
    } else {
#pragma unroll
      for (int j = 0; j < 4; ++j) { const u32x2 u = *(const u32x2*)(xbf + 4 * lane + 256 * j); xv[j] = (f32x4){bflo(u.x), bfhi(u.x), bflo(u.y), bfhi(u.y)}; }
    }
    if (lp >= 0) {
      f32x4 yv[4]; float ss = 0.f;
#pragma unroll
      for (int j = 0; j < 4; ++j) { const u32x2 u = *(const u32x2*)(ybuf + (size_t)row * DM + 4 * lane + 256 * j);
        yv[j] = (f32x4){bflo(u.x), bfhi(u.x), bflo(u.y), bfhi(u.y)}; ss += yv[j][0] * yv[j][0] + yv[j][1] * yv[j][1] + yv[j][2] * yv[j][2] + yv[j][3] * yv[j][3]; }
      ss = wave_sum(ss);
      const float rs = rsqrtf(ss * (1.f / DM) + EPS);
#pragma unroll
      for (int j = 0; j < 4; ++j) {
        const int c = 4 * lane + 256 * j;
        const f32x4 gt = *(const f32x4*)(mod + ((size_t)lp * 16 + b) * 3072 + 2048 + c);
        const f32x4 gp = *(const f32x4*)(p.g_post + lp * DM + c);
        xv[j] = xv[j] + gt * (yv[j] * rs * gp);
        if (ln >= 4) *(f32x4*)(p.out + (size_t)row * DM + c) = xv[j];
        else { u32x2 w; w.x = pk2(xv[j][0], xv[j][1]); w.y = pk2(xv[j][2], xv[j][3]); *(u32x2*)(xbf + c) = w; }
      }
    }
    if (ln < 4) {
      float ss = 0.f;
#pragma unroll
      for (int j = 0; j < 4; ++j) ss += xv[j][0] * xv[j][0] + xv[j][1] * xv[j][1] + xv[j][2] * xv[j][2] + xv[j][3] * xv[j][3];
      ss = wave_sum(ss);
      const float rs = rsqrtf(ss * (1.f / DM) + EPS);
      float zf[8];
#pragma unroll
      for (int h = 0; h < 8; ++h) zf[h] = 0.f;
#pragma unroll
      for (int j = 0; j < 4; ++j) {
        const int c = 4 * lane + 256 * j;
        const f32x4 sh = *(const f32x4*)(mod + ((size_t)ln * 16 + b) * 3072 + c);
        const f32x4 sc = *(const f32x4*)(mod + ((size_t)ln * 16 + b) * 3072 + 1024 + c);
        const f32x4 gp = *(const f32x4*)(p.g_pre + ln * DM + c);
        const f32x4 hv = (xv[j] * rs * gp) * (sc + 1.f) + sh;
        u32x2 w; w.x = pk2(hv[0], hv[1]); w.y = pk2(hv[2], hv[3]);
        *(u32x2*)(hbuf + (size_t)row * DM + c) = w;
        if (ff) {
#pragma unroll
          for (int e = 0; e < 4; ++e) {
            const f32x4 w0 = wl[(j * 4 + e) * 64 + lane], w1 = wl[1024 + (j * 4 + e) * 64 + lane];
            zf[0] += hv[e] * w0[0]; zf[1] += hv[e] * w0[1]; zf[2] += hv[e] * w0[2]; zf[3] += hv[e] * w0[3];
            zf[4] += hv[e] * w1[0]; zf[5] += hv[e] * w1[1]; zf[6] += hv[e] * w1[2]; zf[7] += hv[e] * w1[3];
          }
        }
      }
      if (ff) {
        const bool b5 = lane & 32, b4 = lane & 16, b3 = lane & 8;
        float w4[4], u2[2], t;
#pragma unroll
        for (int k = 0; k < 4; ++k) { const float send = b5 ? zf[k] : zf[4 + k], keep = b5 ? zf[4 + k] : zf[k]; w4[k] = keep + __shfl_xor(send, 32); }
#pragma unroll
        for (int k = 0; k < 2; ++k) { const float send = b4 ? w4[k] : w4[2 + k], keep = b4 ? w4[2 + k] : w4[k]; u2[k] = keep + __shfl_xor(send, 16); }
        { const float send = b3 ? u2[0] : u2[1], keep = b3 ? u2[1] : u2[0]; t = keep + __shfl_xor(send, 8); }
        t += __shfl_xor(t, 4); t += __shfl_xor(t, 2); t += __shfl_xor(t, 1);
        if ((lane & 7) == 0) {
          const int h = lane >> 3;
          const float z = t + p.od_forget_bias[(ln >> 1) * 8 + h];
          const float ls = fminf(z, 0.f) - __builtin_amdgcn_logf(1.f + fast_exp2(-fabsf(z) * LOG2E)) * 0.6931471805599453f;
          ((float*)(ws + WS_LOGF))[(size_t)row * 8 + h] = ls;
        }
      }
    }
  }
  __syncthreads();
}

DI void fox_scan(const Params& p, LAS unsigned char* lds, int bh) {
  const int tid = opaque_tid();
  const int b = bh >> 3, h = bh & 7;
  const float* logf_ = (const float*)(p.ws + WS_LOGF);
  float* fcum = (float*)(p.ws + WS_FCUM) + (size_t)bh * SEQ;
  LAS float* s = (LAS float*)lds;
  float v[4];
#pragma unroll
  for (int j = 0; j < 4; ++j) v[j] = logf_[((size_t)b * SEQ + 4 * tid + j) * 8 + h];
  v[1] += v[0]; v[2] += v[1]; v[3] += v[2];
  s[tid] = v[3];
  __syncthreads();
  for (int off = 1; off < 512; off <<= 1) {
    float t = 0.f;
    if (tid >= off) t = s[tid - off];
    __syncthreads();
    s[tid] += t;
    __syncthreads();
  }
  const float excl = s[tid] - v[3];
#pragma unroll
  for (int j = 0; j < 4; ++j) fcum[4 * tid + j] = -8.0f * (excl + v[j]);
  __syncthreads();
}

struct AttnArgs { const bf16_t *q, *k, *k2, *v, *gate; bf16_t* out; const float* fcum; int ldq, ldk, ldk2, ldv, ldo, ldg; float sl2, sink; };

DI float half_max(float x) {
  const unsigned u = __float_as_uint(x);
  auto r = __builtin_amdgcn_permlane32_swap(u, u, false, false);
  return fmaxf(__uint_as_float(r[0]), __uint_as_float(r[1]));
}
DI float half_sum(float x) {
  const unsigned u = __float_as_uint(x);
  auto r = __builtin_amdgcn_permlane32_swap(u, u, false, false);
  return __uint_as_float(r[0]) + __uint_as_float(r[1]);
}

template <int N> DI void wait_vmcnt() { asm volatile("s_waitcnt vmcnt(%0)" ::"n"(N) : "memory"); }
DI void raw_barrier() { asm volatile("" ::: "memory"); __builtin_amdgcn_s_barrier(); asm volatile("" ::: "memory"); }

template <int DQK, int DV, int MODE>
DI void attn_item(LAS unsigned char* lds, const AttnArgs& a, int qb) {
  constexpr int KSTR = DQK * 2 + 16, VSTR = (DV == 64) ? 192 : 320;
  constexpr int KG16 = KSTR / 16, VG16 = VSTR / 16;
  constexpr int KCH = KG16, VCH = VG16, NCH = KCH + VCH;
  constexpr int TILE = NCH * 1024 + (MODE == 2 ? 2048 : 0);
  constexpr int NSLOT = (NCH + 7) / 8, REM = NCH - 8 * (NSLOT - 1);
  constexpr int FX = (MODE == 2) ? 1 : 0;
  constexpr int NKS = DQK / 16, NBLK = DV / 32;
  static_assert(5 * TILE <= 155648, "ring too large");
  const int tid = opaque_tid(), wid = __builtin_amdgcn_readfirstlane(tid >> 6), lane = tid & 63, r = lane & 31, hh = lane >> 5;
  const int q0 = qb * 256, qw = q0 + 32 * wid, myq = qw + r;
  const float c = a.sl2, tau = 8.0f / a.sl2;
  bf16x8 qf[NKS];
#pragma unroll
  for (int ks = 0; ks < NKS; ++ks) qf[ks] = *(const bf16x8*)(a.q + (size_t)myq * a.ldq + 16 * ks + 8 * hh);
  int lo = 0; const int hi = 4 * (qb + 1);
  if (MODE == 1) { lo = 4 * qb - 2; if (lo < 0) lo = 0; }
  const int last_w = (qw + 31) >> 6;
  int first_w = 0;
  if (MODE == 1) { first_w = (qw > 127 ? qw - 127 : 0) >> 6; }
  const char* sp[NSLOT]; unsigned sst[NSLOT];
#pragma unroll
  for (int j = 0; j < NSLOT; ++j) {
    const int ch_ = 8 * j + wid;
    if (ch_ < KCH) {
      const int p = ch_ * 64 + lane, row = p / KG16, g = p - row * KG16;
      if (DQK == 96 && g >= 8 && g < 12) { sp[j] = (const char*)(a.k2 + (size_t)row * a.ldk2 + 8 * (g - 8)); sst[j] = (unsigned)(128 * a.ldk2); }
      else { sp[j] = (const char*)(a.k + (size_t)row * a.ldk + 8 * (g < 8 ? g : 0)); sst[j] = (unsigned)(128 * a.ldk); }
    } else {
      const int p = (ch_ - KCH) * 64 + lane, row = (p / VG16) & 63, g = p - (p / VG16) * VG16;
      sp[j] = (const char*)(a.v + (size_t)row * a.ldv + 8 * (g < DV / 8 ? g : 0)); sst[j] = (unsigned)(128 * a.ldv);
    }
  }
  auto issue = [&](int kt) {
    LAS unsigned char* base = lds + (kt % 5) * TILE;
#pragma unroll
    for (int j = 0; j < NSLOT; ++j) {
      if (j < NSLOT - 1 || wid < REM)
        __builtin_amdgcn_global_load_lds((const unsigned*)(sp[j] + (size_t)kt * sst[j]), (LAS unsigned*)(base + (8 * j + wid) * 1024), 16, 0, 0);
    }
    if (MODE == 2) __builtin_amdgcn_global_load_lds((const unsigned*)(a.fcum + kt * 64 + lane), (LAS unsigned*)(base + NCH * 1024 + wid * 256), 4, 0, 0);
  };
  auto wait_tiles = [&](bool all) {
    if (all) wait_vmcnt<0>();
    else if (wid < REM) wait_vmcnt<NSLOT + FX>();
    else wait_vmcnt<NSLOT - 1 + FX>();
  };
  f32x16 O[NBLK];
#pragma unroll
  for (int bl = 0; bl < NBLK; ++bl)
#pragma unroll
    for (int i = 0; i < 16; ++i) O[bl][i] = 0.f;
  float m = (MODE == 1) ? a.sink / a.sl2 : -1e30f;
  float l0 = (MODE == 1 && hh == 0) ? 1.f : 0.f, l1 = 0.f;
  const int i16 = lane & 15, q4 = i16 >> 2, p4 = i16 & 3, grp = (lane >> 4) & 1;
  auto qk_load = [&](int kt, bf16x8 (&kf)[2][NKS]) {
    LAS unsigned char* Kl = lds + (kt % 5) * TILE;
#pragma unroll
    for (int kb = 0; kb < 2; ++kb)
#pragma unroll
      for (int ks = 0; ks < NKS; ++ks) kf[kb][ks] = *(const LAS bf16x8*)(Kl + (32 * kb + r) * KSTR + (16 * ks + 8 * hh) * 2);
  };
  auto qk_mma = [&](int kt, const bf16x8 (&kf)[2][NKS], f32x16 (&s)[2]) {
#pragma unroll
    for (int kb = 0; kb < 2; ++kb) {
      if (MODE == 2) {
        LAS unsigned char* Fl = lds + (kt % 5) * TILE + NCH * 1024 + wid * 256;
#pragma unroll
        for (int g = 0; g < 4; ++g) { const f32x4 fb = *(const LAS f32x4*)(Fl + (32 * kb + 8 * g + 4 * hh) * 4);
          s[kb][4 * g] = fb[0]; s[kb][4 * g + 1] = fb[1]; s[kb][4 * g + 2] = fb[2]; s[kb][4 * g + 3] = fb[3]; }
      } else {
#pragma unroll
        for (int i = 0; i < 16; ++i) s[kb][i] = 0.f;
      }
    }
#pragma unroll
    for (int ks = 0; ks < NKS; ++ks)
#pragma unroll
      for (int kb = 0; kb < 2; ++kb) s[kb] = __builtin_amdgcn_mfma_f32_32x32x16_bf16(kf[kb][ks], qf[ks], s[kb], 0, 0, 0);
  };
  auto softmax = [&](int kt, f32x16 (&s)[2], bf16x8 (&pf)[2][2], auto maskc) {
    constexpr bool MASK = decltype(maskc)::value;
    const int key0 = kt * 64;
    if (MASK) {
#pragma unroll
      for (int kb = 0; kb < 2; ++kb)
#pragma unroll
        for (int i = 0; i < 16; ++i) {
          const int key = key0 + 32 * kb + (i & 3) + 8 * (i >> 2) + 4 * hh;
          bool valid = key <= myq; if (MODE == 1) valid = valid && (myq - key < 128);
          s[kb][i] = valid ? s[kb][i] : -1e30f;
        }
    }
    float mx = fmaxf(s[0][0], s[1][0]);
#pragma unroll
    for (int i = 1; i < 16; ++i) mx = fmaxf(fmaxf(mx, s[0][i]), s[1][i]);
    mx = half_max(mx);
    if (__builtin_amdgcn_ballot_w64(mx > m + tau) != 0ull) {
      const float mnew = fmaxf(m, mx);
      const float alpha = fast_exp2((m - mnew) * c);
      m = mnew;
      l0 *= alpha; l1 *= alpha;
#pragma unroll
      for (int bl = 0; bl < NBLK; ++bl)
#pragma unroll
        for (int i = 0; i < 16; ++i) O[bl][i] *= alpha;
    }
    const float nmc = -m * c;
#pragma unroll
    for (int kb = 0; kb < 2; ++kb)
#pragma unroll
      for (int s2 = 0; s2 < 2; ++s2) {
        float pv[8];
#pragma unroll
        for (int e = 0; e < 8; ++e) pv[e] = fast_exp2(__builtin_fmaf(s[kb][8 * s2 + e], c, nmc));
        l0 += (pv[0] + pv[4]) + (pv[2] + pv[6]); l1 += (pv[1] + pv[5]) + (pv[3] + pv[7]);
        u32x4 w;
        w.x = pk2(pv[0], pv[1]); w.y = pk2(pv[2], pv[3]); w.z = pk2(pv[4], pv[5]); w.w = pk2(pv[6], pv[7]);
        pf[kb][s2] = __builtin_bit_cast(bf16x8, w);
      }
  };
  auto pvmm = [&](int kt, const bf16x8 (&pf)[2][2]) {
    constexpr int PD = (NBLK == 2) ? 2 : 1;
    const unsigned va = (unsigned)(size_t)(lds + (kt % 5) * TILE + KCH * 1024 + (4 * hh + q4) * VSTR + (16 * grp) * 2 + 8 * p4);
    s16x4 vl[PD + 1][NBLK], vh[PD + 1][NBLK];
#define TRRD(dst, off) asm volatile("ds_read_b64_tr_b16 %0, %1 offset:%2" : "=&v"(dst) : "v"(va), "n"(off) : "memory")
#define TRSTEP(st_) do { _Pragma("unroll") for (int bl = 0; bl < NBLK; ++bl) { TRRD(vl[(st_) % (PD + 1)][bl], 16 * (st_) * VSTR + 64 * bl); TRRD(vh[(st_) % (PD + 1)][bl], 16 * (st_) * VSTR + 64 * bl + 8 * VSTR); } } while (0)
#define TRWAIT(n_, b_) do { if (NBLK == 2) asm volatile("s_waitcnt lgkmcnt(" #n_ ")" : "+v"(vl[b_][0]), "+v"(vh[b_][0]), "+v"(vl[b_][1]), "+v"(vh[b_][1])::"memory"); \
    else asm volatile("s_waitcnt lgkmcnt(" #n_ ")" : "+v"(vl[b_][0]), "+v"(vh[b_][0]), "+v"(vl[b_][1]), "+v"(vh[b_][1]), "+v"(vl[b_][2 % NBLK]), "+v"(vh[b_][2 % NBLK]), "+v"(vl[b_][3 % NBLK]), "+v"(vh[b_][3 % NBLK])::"memory"); } while (0)
#pragma unroll
    for (int st = 0; st < PD; ++st) TRSTEP(st);
#pragma unroll
    for (int st = 0; st < 4; ++st) {
      if (st + PD < 4) TRSTEP(st + PD);
      const int ahead = ((st + PD < 4) ? st + PD : 3) - st;
      const int b_ = st % (PD + 1);
      if (ahead * 2 * NBLK == 8) TRWAIT(8, b_); else if (ahead * 2 * NBLK == 4) TRWAIT(4, b_); else TRWAIT(0, b_);
#pragma unroll
      for (int bl = 0; bl < NBLK; ++bl) {
        const bf16x8 vf = __builtin_shufflevector(vl[b_][bl], vh[b_][bl], 0, 1, 2, 3, 4, 5, 6, 7);
        O[bl] = __builtin_amdgcn_mfma_f32_32x32x16_bf16(vf, pf[st >> 1][st & 1], O[bl], 0, 0, 0);
      }
    }
#undef TRRD
#undef TRSTEP
#undef TRWAIT
  };
  auto act = [&](int kt) { return kt <= last_w && kt >= first_w; };
  f32x16 sA[2];
  const bool halfB = wid >= 4;
  issue(lo);
  if (lo + 1 < hi) issue(lo + 1);
  if (lo + 2 < hi) issue(lo + 2);
  if (lo + 3 < hi) issue(lo + 3);
  wait_tiles(!(lo + 3 < hi));
  raw_barrier();
  if (halfB) raw_barrier();
  if (act(lo)) { bf16x8 kf0[2][NKS]; qk_load(lo, kf0); qk_mma(lo, kf0, sA); }
  auto step = [&](int kt, auto maskc) {
    const bool a0 = act(kt), a1 = (kt + 1 < hi) && act(kt + 1);
    bf16x8 pf[2][2], kf[2][NKS];
    if (a1) qk_load(kt + 1, kf);
    __builtin_amdgcn_sched_barrier(0);
    if (a0) softmax(kt, sA, pf, maskc);
    wait_tiles(!(kt + 3 < hi));
    raw_barrier();
    if (kt + 4 < hi) issue(kt + 4);
    if (a1) qk_mma(kt + 1, kf, sA);
    if (a0) pvmm(kt, pf);
    raw_barrier();
  };
  int split = lo;
  if (MODE != 1) { split = qw >> 6; if (split < lo) split = lo; if (split > hi) split = hi; }
  if (MODE != 1) { for (int kt = lo; kt < split; ++kt) step(kt, std::false_type{}); }
  for (int kt = split; kt < hi; ++kt) step(kt, std::true_type{});
  if (!halfB) raw_barrier();
  const float l = half_sum(l0 + l1);
  const float inv = 1.f / l;
#pragma unroll
  for (int bl = 0; bl < NBLK; ++bl)
#pragma unroll
    for (int g = 0; g < 4; ++g) {
      const int f = 32 * bl + 8 * g + 4 * hh;
      float o0 = O[bl][4 * g + 0] * inv, o1 = O[bl][4 * g + 1] * inv, o2 = O[bl][4 * g + 2] * inv, o3 = O[bl][4 * g + 3] * inv;
      if (a.gate) {
        const u32x2 gv = *(const u32x2*)(a.gate + (size_t)myq * a.ldg + f);
        o0 *= silu_f(bflo(gv.x)); o1 *= silu_f(bfhi(gv.x)); o2 *= silu_f(bflo(gv.y)); o3 *= silu_f(bfhi(gv.y));
      }
      u32x2 w; w.x = pk2(o0, o1); w.y = pk2(o2, o3);
      *(u32x2*)(a.out + (size_t)myq * a.ldo + f) = w;
    }
}


DI void swa_item(LAS unsigned char* lds, const AttnArgs& a, const float* sinks4, int qb) {
  constexpr int KSTR = 144, VSTR = 192, KCH = 9, VCH = 12, NCH = 21, TILE = NCH * 1024, NSLOT = 3, REM = 5, NKS = 4, NBLK = 2;
  const int tid = opaque_tid(), wid = __builtin_amdgcn_readfirstlane(tid >> 6), lane = tid & 63, r = lane & 31, hh = lane >> 5;
  const int q0 = qb * 256, qw = q0 + 32 * wid, myq = qw + r;
  const float c = a.sl2, tau = 8.0f / a.sl2;
  int lo = 4 * qb - 2; if (lo < 0) lo = 0;
  const int hi = 4 * (qb + 1);
  const int last_w = (qw + 31) >> 6, first_w = (qw > 127 ? qw - 127 : 0) >> 6;
#pragma unroll
  for (int j = 0; j < NSLOT; ++j) {
    const int ch_ = 8 * j + wid;
    if (j < NSLOT - 1 || wid < REM) {
      const char* sp; unsigned sst;
      if (ch_ < KCH) { const int p = ch_ * 64 + lane, row = p / 9, g = p - row * 9;
        sp = (const char*)(a.k + (size_t)row * a.ldk + 8 * (g < 8 ? g : 0)); sst = (unsigned)(128 * a.ldk); }
      else { const int p = (ch_ - KCH) * 64 + lane, row = (p / 12) & 63, g = p - (p / 12) * 12;
        sp = (const char*)(a.v + (size_t)row * a.ldv + 8 * (g < 8 ? g : 0)); sst = (unsigned)(128 * a.ldv); }
      for (int kt = lo; kt < hi; ++kt)
        __builtin_amdgcn_global_load_lds((const unsigned*)(sp + (size_t)kt * sst), (LAS unsigned*)(lds + (kt - lo) * TILE + ch_ * 1024), 16, 0, 0);
    }
  }
  wait_vmcnt<0>();
  raw_barrier();
  const int i16 = lane & 15, q4 = i16 >> 2, p4 = i16 & 3, grp = (lane >> 4) & 1;
  for (int h4 = 0; h4 < 4; ++h4) {
    bf16x8 qf[NKS];
#pragma unroll
    for (int ks = 0; ks < NKS; ++ks) qf[ks] = *(const bf16x8*)(a.q + (size_t)myq * a.ldq + h4 * 64 + 16 * ks + 8 * hh);
    f32x16 O[NBLK];
#pragma unroll
    for (int bl = 0; bl < NBLK; ++bl)
#pragma unroll
      for (int i = 0; i < 16; ++i) O[bl][i] = 0.f;
    float m = sinks4[h4] / a.sl2;
    float l0 = (hh == 0) ? 1.f : 0.f, l1 = 0.f;
    for (int kt = first_w; kt <= last_w; ++kt) {
      LAS unsigned char* Kl = lds + (kt - lo) * TILE;
      f32x16 s[2];
      bf16x8 kf[2][NKS];
#pragma unroll
      for (int kb = 0; kb < 2; ++kb)
#pragma unroll
        for (int ks = 0; ks < NKS; ++ks) kf[kb][ks] = *(const LAS bf16x8*)(Kl + (32 * kb + r) * KSTR + (16 * ks + 8 * hh) * 2);
#pragma unroll
      for (int kb = 0; kb < 2; ++kb)
#pragma unroll
        for (int i = 0; i < 16; ++i) s[kb][i] = 0.f;
#pragma unroll
      for (int ks = 0; ks < NKS; ++ks)
#pragma unroll
        for (int kb = 0; kb < 2; ++kb) s[kb] = __builtin_amdgcn_mfma_f32_32x32x16_bf16(kf[kb][ks], qf[ks], s[kb], 0, 0, 0);
      const int key0 = kt * 64;
#pragma unroll
      for (int kb = 0; kb < 2; ++kb)
#pragma unroll
        for (int i = 0; i < 16; ++i) {
          const int key = key0 + 32 * kb + (i & 3) + 8 * (i >> 2) + 4 * hh;
          const bool valid = (key <= myq) && (myq - key < 128);
          s[kb][i] = valid ? s[kb][i] : -1e30f;
        }
      float mx = fmaxf(s[0][0], s[1][0]);
#pragma unroll
      for (int i = 1; i < 16; ++i) mx = fmaxf(fmaxf(mx, s[0][i]), s[1][i]);
      mx = half_max(mx);
      if (__builtin_amdgcn_ballot_w64(mx > m + tau) != 0ull) {
        const float mnew = fmaxf(m, mx);
        const float alpha = fast_exp2((m - mnew) * c);
        m = mnew; l0 *= alpha; l1 *= alpha;
#pragma unroll
        for (int bl = 0; bl < NBLK; ++bl)
#pragma unroll
          for (int i = 0; i < 16; ++i) O[bl][i] *= alpha;
      }
      const float nmc = -m * c;
      bf16x8 pf[2][2];
#pragma unroll
      for (int kb = 0; kb < 2; ++kb)
#pragma unroll
        for (int s2 = 0; s2 < 2; ++s2) {
          float pv[8];
#pragma unroll
          for (int e = 0; e < 8; ++e) pv[e] = fast_exp2(__builtin_fmaf(s[kb][8 * s2 + e], c, nmc));
          l0 += (pv[0] + pv[4]) + (pv[2] + pv[6]); l1 += (pv[1] + pv[5]) + (pv[3] + pv[7]);
          u32x4 w;
          w.x = pk2(pv[0], pv[1]); w.y = pk2(pv[2], pv[3]); w.z = pk2(pv[4], pv[5]); w.w = pk2(pv[6], pv[7]);
          pf[kb][s2] = __builtin_bit_cast(bf16x8, w);
        }
      LAS unsigned char* Vl = Kl + KCH * 1024 + (4 * hh + q4) * VSTR + (16 * grp) * 2 + 8 * p4;
#pragma unroll
      for (int st = 0; st < 4; ++st)
#pragma unroll
        for (int bl = 0; bl < NBLK; ++bl) {
          LAS unsigned char* ad = Vl + (16 * st) * VSTR + (32 * bl) * 2;
          const s16x4 lo_ = __builtin_amdgcn_ds_read_tr16_b64_v4i16((LAS s16x4*)ad);
          const s16x4 hi_ = __builtin_amdgcn_ds_read_tr16_b64_v4i16((LAS s16x4*)(ad + 8 * VSTR));
          const bf16x8 vf = __builtin_shufflevector(lo_, hi_, 0, 1, 2, 3, 4, 5, 6, 7);
          O[bl] = __builtin_amdgcn_mfma_f32_32x32x16_bf16(vf, pf[st >> 1][st & 1], O[bl], 0, 0, 0);
        }
    }
    const float l = half_sum(l0 + l1);
    const float inv = 1.f / l;
#pragma unroll
    for (int bl = 0; bl < NBLK; ++bl)
#pragma unroll
      for (int g = 0; g < 4; ++g) {
        const int f = h4 * 64 + 32 * bl + 8 * g + 4 * hh;
        float o0 = O[bl][4 * g + 0] * inv, o1 = O[bl][4 * g + 1] * inv, o2 = O[bl][4 * g + 2] * inv, o3 = O[bl][4 * g + 3] * inv;
        const u32x2 gv = *(const u32x2*)(a.gate + (size_t)myq * a.ldg + f);
        o0 *= silu_f(bflo(gv.x)); o1 *= silu_f(bfhi(gv.x)); o2 *= silu_f(bflo(gv.y)); o3 *= silu_f(bfhi(gv.y));
        u32x2 w; w.x = pk2(o0, o1); w.y = pk2(o2, o3);
        *(u32x2*)(a.out + (size_t)myq * a.ldo + f) = w;
      }
  }
  __syncthreads();
}

DI bool team_item(int G, int c, int n, int& bh, int& qb) {
  if (G == 256) {
    const int x = c & 7, li = c >> 3, t = li >> 3, i = li & 7;
    bh = x + 8 * (4 * t + n);
    const int j = (i + 4) & 7;
    qb = (n == 0) ? i : (n == 1) ? 7 - i : (n == 2) ? j : 7 - j;
    return true;
  }
  const int idx = n * G + ((n & 1) ? (G - 1 - c) : c);
  if (idx >= 1024) return false;
  qb = 7 - idx / 128; bh = idx % 128;
  return true;
}

DI int snake_idx(int round, int G, int c) { return round * G + ((round & 1) ? (G - 1 - c) : c); }

DI void attn_even(const Params& p, LAS unsigned char* lds, int i) {
  const int G = gridDim.x, c = blockIdx.x;
  unsigned char* ws = p.ws;
  const bf16_t* z = (const bf16_t*)(ws + WS_ZBUF);
  const bf16_t* qb_ = (const bf16_t*)(ws + WS_QBUF);
  const bf16_t* kv = (const bf16_t*)(ws + WS_HBUF);
  bf16_t* ob = (bf16_t*)(ws + WS_OBUF);
  for (int rd = 0; rd * G < 1024; ++rd) {
    int qb, bh;
    if (!team_item(G, c, rd, bh, qb)) continue;
    const int b = bh >> 3, hd = bh & 7;
    AttnArgs a;
    a.q = qb_ + (size_t)b * SEQ * 768 + hd * 96; a.ldq = 768;
    a.k = kv + (size_t)b * SEQ * 1024 + hd * 128; a.ldk = 1024;
    a.k2 = z + (size_t)b * SEQ * 2560 + 2432; a.ldk2 = 2560;
    a.v = kv + (size_t)b * SEQ * 1024 + hd * 128 + 64; a.ldv = 1024;
    a.out = ob + (size_t)b * SEQ * 1024 + hd * 64; a.ldo = 1024;
    a.gate = z + (size_t)b * SEQ * 2560 + 768 + hd * 64; a.ldg = 2560;
    a.fcum = nullptr; a.sl2 = 0.10206207261596577f * LOG2E; a.sink = 0.f;
    attn_item<96, 64, 0>(lds, a, qb);
  }
  for (int it = c; it < 256; it += G) {
    const int b = it >> 4, kvh = (it >> 3) & 1, qb = it & 7;
    AttnArgs a;
    const bf16_t* zb = z + (size_t)b * SEQ * 2560;
    a.q = zb + kvh * 256; a.ldq = 2560;
    a.k = zb + 512 + kvh * 64; a.ldk = 2560; a.k2 = nullptr; a.ldk2 = 0;
    a.v = zb + 640 + kvh * 64; a.ldv = 2560;
    a.out = ob + (size_t)b * SEQ * 1024 + 512 + kvh * 256; a.ldo = 1024;
    a.gate = zb + 768 + 512 + kvh * 256; a.ldg = 2560;
    a.fcum = nullptr; a.sl2 = 0.125f * LOG2E; a.sink = 0.f;
    float sk[4];
#pragma unroll
    for (int h4 = 0; h4 < 4; ++h4) sk[h4] = p.ev_sinks[i * 8 + kvh * 4 + h4] * LOG2E;
    swa_item(lds, a, sk, qb);
  }
}

DI void attn_odd(const Params& p, LAS unsigned char* lds, int layer) {
  const int G = gridDim.x, c = blockIdx.x;
  unsigned char* ws = p.ws;
  const bf16_t* z = (const bf16_t*)(ws + WS_ZBUF);
  bf16_t* od = (bf16_t*)(ws + WS_HBUF);
  bf16_t* ob = (bf16_t*)(ws + WS_OBUF);
  {
    for (int rd = 0; rd * G < 512; ++rd) {
      int qb, bh2;
      if (G == 256) { const int x = c & 7, li = c >> 3, t = li >> 3, i = li & 7; bh2 = x + 8 * (2 * t + rd); qb = (rd == 0) ? i : 7 - i; }
      else { const int idx = snake_idx(rd, G, c); if (idx >= 512) continue; qb = 7 - idx / 64; bh2 = idx % 64; }
      const int b = bh2 >> 2, h = bh2 & 3;
      const bf16_t* zb = z + (size_t)b * SEQ * 4096;
      for (int mp = 0; mp < 2; ++mp) {
        const int j = 2 * h + mp;
        AttnArgs a;
        a.q = zb + j * 64; a.ldq = 4096;
        a.k = zb + 512 + j * 64; a.ldk = 4096; a.k2 = nullptr; a.ldk2 = 0;
        a.v = zb + 1024 + h * 128; a.ldv = 4096;
        a.out = od + (size_t)b * SEQ * 1024 + j * 128; a.ldo = 1024;
        a.gate = nullptr; a.ldg = 0;
        a.fcum = nullptr; a.sl2 = 0.125f * LOG2E; a.sink = 0.f;
#ifndef SKIP_DIFF
        attn_item<64, 128, 0>(lds, a, qb);
#endif
      }
      __builtin_amdgcn_fence(__ATOMIC_SEQ_CST, "workgroup");
      asm volatile("s_waitcnt vmcnt(0)" ::: "memory");
      const int tid2 = opaque_tid(), lane = tid2 & 63, wid = tid2 >> 6, li_ = layer >> 1;
      const float* lp = p.od_lambda + li_ * 256;
      const float s1 = wave_sum(lp[lane] * lp[64 + lane]), s2 = wave_sum(lp[128 + lane] * lp[192 + lane]);
      const float lam_init = 0.8f - 0.6f * fast_exp2(-0.3f * LOG2E * (float)layer);
      const float lam = fast_exp2(s1 * LOG2E) - fast_exp2(s2 * LOG2E) + lam_init;
      const int rsub = lane >> 4, dv = (lane & 15) * 8;
      float sub[8];
#pragma unroll
      for (int e = 0; e < 8; ++e) sub[e] = p.od_subln[li_ * 128 + dv + e] * (1.f - lam_init);
      const size_t row0 = (size_t)b * SEQ + qb * 256 + 32 * wid;
#pragma unroll 2
      for (int rr = 0; rr < 8; ++rr) {
        const size_t row = row0 + 4 * rr + rsub;
        const u32x4 va = *(const u32x4*)(od + row * 1024 + (2 * h) * 128 + dv);
        const u32x4 vb = *(const u32x4*)(od + row * 1024 + (2 * h + 1) * 128 + dv);
        const u32x4 vg = *(const u32x4*)(z + row * 4096 + 3072 + h * 128 + dv);
        float d[8]; float ss = 0.f;
#pragma unroll
        for (int e = 0; e < 4; ++e) { d[2 * e] = bflo(va[e]) - lam * bflo(vb[e]); d[2 * e + 1] = bfhi(va[e]) - lam * bfhi(vb[e]); ss += d[2 * e] * d[2 * e] + d[2 * e + 1] * d[2 * e + 1]; }
        ss += __shfl_xor(ss, 1); ss += __shfl_xor(ss, 2); ss += __shfl_xor(ss, 4); ss += __shfl_xor(ss, 8);
        const float rs = rsqrtf(ss * (1.f / 128.f) + EPS);
        u32x4 w;
#pragma unroll
        for (int e = 0; e < 4; ++e) {
          const float o0 = d[2 * e] * rs * sub[2 * e] * silu_f(bflo(vg[e])), o1 = d[2 * e + 1] * rs * sub[2 * e + 1] * silu_f(bfhi(vg[e]));
          w[e] = pk2(o0, o1);
        }
        *(u32x4*)(ob + row * 1024 + h * 128 + dv) = w;
      }
    }
  }
  for (int rd = 0; rd * G < 1024; ++rd) {
    int qb, bh;
    if (!team_item(G, c, rd, bh, qb)) continue;
    const int b = bh >> 3, hd = bh & 7;
    AttnArgs a;
    const bf16_t* zb = z + (size_t)b * SEQ * 4096;
    a.q = zb + 1536 + hd * 64; a.ldq = 4096;
    a.k = zb + 2048 + hd * 64; a.ldk = 4096; a.k2 = nullptr; a.ldk2 = 0;
    a.v = zb + 2560 + hd * 64; a.ldv = 4096;
    a.out = ob + (size_t)b * SEQ * 1024 + 512 + hd * 64; a.ldo = 1024;
    a.gate = zb + 3072 + 512 + hd * 64; a.ldg = 4096;
    a.fcum = (const float*)(ws + WS_FCUM) + (size_t)bh * SEQ; a.sl2 = 0.125f * LOG2E; a.sink = 0.f;
#ifndef SKIP_FOX
    attn_item<64, 64, 2>(lds, a, qb);
#endif
  }
}

DI void diff_combine(const Params& p, int layer) {
  const int tid = opaque_tid(), lane = tid & 63, wid = tid >> 6;
  const int gw = blockIdx.x * 8 + wid, nw = gridDim.x * 8;
  const int i = layer >> 1;
  unsigned char* ws = p.ws;
  const bf16_t* od = (const bf16_t*)(ws + WS_HBUF);
  const bf16_t* z = (const bf16_t*)(ws + WS_ZBUF);
  bf16_t* ob = (bf16_t*)(ws + WS_OBUF);
  const float* lp = p.od_lambda + i * 256;
  const float s1 = wave_sum(lp[lane] * lp[64 + lane]), s2 = wave_sum(lp[128 + lane] * lp[192 + lane]);
  const float lam_init = 0.8f - 0.6f * expf(-0.3f * (float)layer);
  const float lam = expf(s1) - expf(s2) + lam_init;
  const int hd = lane >> 4, dv = (lane & 15) * 8;
  float sub[8];
#pragma unroll
  for (int e = 0; e < 8; ++e) sub[e] = p.od_subln[i * 128 + dv + e] * (1.f - lam_init);
  for (int row = gw; row < T; row += nw) {
    const u32x4 a = *(const u32x4*)(od + (size_t)row * 1024 + (2 * hd) * 128 + dv);
    const u32x4 b = *(const u32x4*)(od + (size_t)row * 1024 + (2 * hd + 1) * 128 + dv);
    const u32x4 g = *(const u32x4*)(z + (size_t)row * 4096 + 3072 + hd * 128 + dv);
    float d[8]; float ss = 0.f;
#pragma unroll
    for (int e = 0; e < 4; ++e) { d[2 * e] = bflo(a[e]) - lam * bflo(b[e]); d[2 * e + 1] = bfhi(a[e]) - lam * bfhi(b[e]); ss += d[2 * e] * d[2 * e] + d[2 * e + 1] * d[2 * e + 1]; }
    ss += __shfl_xor(ss, 1); ss += __shfl_xor(ss, 2); ss += __shfl_xor(ss, 4); ss += __shfl_xor(ss, 8);
    const float rs = rsqrtf(ss * (1.f / 128.f) + EPS);
    u32x4 w;
#pragma unroll
    for (int e = 0; e < 4; ++e) {
      const float o0 = d[2 * e] * rs * sub[2 * e] * silu_f(bflo(g[e])), o1 = d[2 * e + 1] * rs * sub[2 * e + 1] * silu_f(bfhi(g[e]));
      w[e] = pk2(o0, o1);
    }
    *(u32x4*)(ob + (size_t)row * 1024 + hd * 128 + dv) = w;
  }
}


DI void grid_barrier(unsigned* ctr, unsigned& epoch) {
  asm volatile("s_waitcnt vmcnt(0)" ::: "memory");
  __syncthreads();
  epoch += 1;
  if (threadIdx.x == 0) {
    __builtin_amdgcn_fence(__ATOMIC_RELEASE, "agent");
    asm volatile("s_waitcnt vmcnt(0)" ::: "memory");
    __hip_atomic_fetch_add(ctr, 1u, __ATOMIC_RELAXED, __HIP_MEMORY_SCOPE_AGENT);
    const unsigned target = epoch * gridDim.x;
    while (__hip_atomic_load(ctr, __ATOMIC_RELAXED, __HIP_MEMORY_SCOPE_AGENT) < target) __builtin_amdgcn_s_sleep(1);
    __builtin_amdgcn_fence(__ATOMIC_ACQUIRE, "agent");
    asm volatile("s_waitcnt vmcnt(0)" ::: "memory");
  }
  __syncthreads();
}

__global__ void __launch_bounds__(512) fwd_megakernel(Params p) {
  extern __shared__ __attribute__((aligned(16))) unsigned char lds_raw[];
  LAS unsigned char* lds = (LAS unsigned char*)lds_raw;
  cg::grid_group grid = cg::this_grid();
  unsigned char* ws = p.ws;
  const int G = gridDim.x, bid = blockIdx.x;
  const float* cosH = (const float*)(ws + WS_COSH); const float* sinH = (const float*)(ws + WS_SINH);
  const float* cosR = (const float*)(ws + WS_COSR); const float* sinR = (const float*)(ws + WS_SINR);

  unsigned* bar_ctr = (unsigned*)(ws + WS_BAR); unsigned bar_epoch = 0;
  if (bid == 0 && threadIdx.x == 0) __hip_atomic_store(bar_ctr, 0u, __ATOMIC_RELAXED, __HIP_MEMORY_SCOPE_AGENT);
#ifndef SKIP_PRO
  prologue(p, lds);
#endif
  grid.sync();
#pragma unroll
  for (int layer = 0; layer < 4; ++layer) {
    const int i = layer >> 1; const bool odd = layer & 1;
#ifndef SKIP_ROW
    rowwise_phase(p, lds, layer - 1, layer);
#endif
    grid_barrier(bar_ctr, bar_epoch);
    {
#ifndef SKIP_SCAN
      if (odd && bid < 128) fox_scan(p, lds, bid);
#endif
      pg8::Gemm g; g.A = (const bf16_t*)(ws + WS_HBUF); g.lda = 1024; g.K = 1024; g.M = T;
      Epi e; e.out = (bf16_t*)(ws + WS_ZBUF); e.pin = nullptr; e.pslot = 0; e.nK = 0; e.qmode = 0; e.pout = odd ? nullptr : (float*)(ws + WS_PART); e.cosH = cosH; e.sinH = sinH; e.cosR = cosR; e.sinR = sinR;
      if (!odd) { g.Bt = (const bf16_t*)(ws + WS_WEVIN + i * SZ_WEVIN); g.N = 2560; e.ldc = 2560; e.rope64_end = 640; e.rope32_lo = 2432; e.rope32_hi = 2464; }
      else { g.Bt = (const bf16_t*)(ws + WS_WODIN + i * SZ_WODIN); g.N = 4096; e.ldc = 4096; e.rope64_end = 1024; e.rope32_lo = 0; e.rope32_hi = 0; }
      pg8::StaticOrder S; S.init(g.M, g.N, G, bid);
#ifndef SKIP_G1
      pg8::gemm_phase<Epi>(lds, g, S, e);
#endif
    }
    grid_barrier(bar_ctr, bar_epoch);
    if (!odd) {
      for (int which = 0; which < 2; ++which) {
        pg8::Gemm g; g.M = T; g.lda = 2560;
        Epi e; e.rope64_end = 0; e.rope32_lo = 0; e.rope32_hi = 0; e.cosH = cosH; e.sinH = sinH; e.cosR = cosR; e.sinR = sinR; e.pout = nullptr; e.pin = (const float*)(ws + WS_PART);
        if (which == 0) { g.A = (const bf16_t*)(ws + WS_ZBUF) + 1792; g.Bt = (const bf16_t*)(ws + WS_WUQ + i * SZ_WUQ); g.N = 768; g.K = 384;
          e.out = (bf16_t*)(ws + WS_QBUF); e.ldc = 768; e.qmode = 1; e.pslot = 0; e.nK = 384; }
        else { g.A = (const bf16_t*)(ws + WS_ZBUF) + 2176; g.Bt = (const bf16_t*)(ws + WS_WUKV + i * SZ_WUKV); g.N = 1024; g.K = 256;
          e.out = (bf16_t*)(ws + WS_HBUF); e.ldc = 1024; e.qmode = 0; e.pslot = 12; e.nK = 256; }
        pg8::StaticOrder S; S.init(g.M, g.N, G, bid);
#ifndef SKIP_G2
        pg8::gemm_phase<Epi>(lds, g, S, e);
#endif
      }
      grid_barrier(bar_ctr, bar_epoch);
#ifndef SKIP_ATTE
      attn_even(p, lds, i);
#endif
      grid_barrier(bar_ctr, bar_epoch);
    } else {
#ifndef SKIP_ATTO
      attn_odd(p, lds, layer);
#endif
      grid_barrier(bar_ctr, bar_epoch);
    }
    {
      pg8::Gemm g; g.A = (const bf16_t*)(ws + WS_OBUF); g.lda = 1024; g.K = 1024; g.M = T; g.N = 1024;
      g.Bt = (const bf16_t*)(ws + (odd ? WS_WODOUT : WS_WEVOUT) + i * SZ_WOUT);
      Epi e; e.out = (bf16_t*)(ws + WS_HBUF); e.ldc = 1024; e.pin = nullptr; e.pslot = 0; e.pout = nullptr; e.nK = 0; e.qmode = 0; e.rope64_end = 0; e.rope32_lo = 0; e.rope32_hi = 0;
      e.cosH = cosH; e.sinH = sinH; e.cosR = cosR; e.sinR = sinR;
      pg8::StaticOrder S; S.init(g.M, g.N, G, bid);
#ifndef SKIP_G3
      pg8::gemm_phase<Epi>(lds, g, S, e);
#endif
    }
    grid_barrier(bar_ctr, bar_epoch);
  }
#ifndef SKIP_ROW
  rowwise_phase(p, lds, 3, 4);
#endif
}

constexpr int LDS_BYTES = 155648;

extern "C" void kernel_launch(void* const* d_in, const int* in_sizes, int n_in, void* d_out, int out_size, void* d_ws, size_t ws_size, hipStream_t stream) {
  static int grid_blocks = 0;
  if (grid_blocks == 0) {
    int dev = 0, cus = 0, per_cu = 0;
    if (hipGetDevice(&dev) != hipSuccess || hipDeviceGetAttribute(&cus, hipDeviceAttributeMultiprocessorCount, dev) != hipSuccess) { fprintf(stderr, "device query failed\n"); grid_blocks = -1; return; }
    if (hipFuncSetAttribute((const void*)fwd_megakernel, hipFuncAttributeMaxDynamicSharedMemorySize, LDS_BYTES) != hipSuccess) { fprintf(stderr, "hipFuncSetAttribute failed\n"); grid_blocks = -1; return; }
    if (hipOccupancyMaxActiveBlocksPerMultiprocessor(&per_cu, (const void*)fwd_megakernel, 512, LDS_BYTES) != hipSuccess || per_cu < 1) { fprintf(stderr, "occupancy query: %d\n", per_cu); per_cu = 1; }
    (void)hipGetLastError();
    grid_blocks = cus;
    if (ws_size < WS_END) { fprintf(stderr, "workspace too small: %zu < %zu\n", ws_size, (size_t)WS_END); grid_blocks = -1; return; }
  }
  if (grid_blocks < 0) return;
  Params p{};
  const float** fp = (const float**)&p;
  for (int i = 0; i < 18; ++i) fp[i] = (const float*)d_in[i];
  p.out = (float*)d_out; p.ws = (unsigned char*)d_ws;
  void* args[] = {&p};
  hipError_t e = hipLaunchCooperativeKernel((const void*)fwd_megakernel, dim3(grid_blocks), dim3(512), args, LDS_BYTES, stream);
  if (e != hipSuccess) fprintf(stderr, "cooperative launch failed: %s (grid %d)\n", hipGetErrorString(e), grid_blocks);
}
```

```cpp
#include <hip/hip_runtime.h>
#include <hip/hip_cooperative_groups.h>
#include <cstdio>
#include <type_traits>
namespace cg = cooperative_groups;

#define DI __device__ __forceinline__
#define LAS __attribute__((address_space(3)))
typedef unsigned short bf16_t;
typedef short bf16x8 __attribute__((ext_vector_type(8)));
typedef short s16x4 __attribute__((ext_vector_type(4)));
typedef float f32x2 __attribute__((ext_vector_type(2)));
typedef float f32x4 __attribute__((ext_vector_type(4)));
typedef float f32x16 __attribute__((ext_vector_type(16)));
typedef unsigned u32x2 __attribute__((ext_vector_type(2)));
typedef unsigned u32x4 __attribute__((ext_vector_type(4)));
typedef __bf16 bf16x2_t __attribute__((ext_vector_type(2)));

constexpr int T = 32768, DM = 1024, NB = 16, SEQ = 2048;
constexpr float LOG2E = 1.4426950408889634f;
constexpr float EPS = 1e-6f;
constexpr int LDS_BYTES_C = 155648;

constexpr size_t SZ_WEVIN = 2560ull * 1024 * 2, SZ_WODIN = 4096ull * 1024 * 2, SZ_WUQ = 768ull * 384 * 2, SZ_WUKV = 1024ull * 256 * 2, SZ_WOUT = 1024ull * 1024 * 2;
constexpr size_t WS_WEVIN = 0;
constexpr size_t WS_WODIN = WS_WEVIN + 2 * SZ_WEVIN;
constexpr size_t WS_WUQ = WS_WODIN + 2 * SZ_WODIN;
constexpr size_t WS_WUKV = WS_WUQ + 2 * SZ_WUQ;
constexpr size_t WS_WEVOUT = WS_WUKV + 2 * SZ_WUKV;
constexpr size_t WS_WODOUT = WS_WEVOUT + 2 * SZ_WOUT;
constexpr size_t WS_MOD = WS_WODOUT + 2 * SZ_WOUT;
constexpr size_t WS_COSH = WS_MOD + 4ull * 16 * 3072 * 4;
constexpr size_t WS_SINH = WS_COSH + 2048ull * 32 * 4;
constexpr size_t WS_COSR = WS_SINH + 2048ull * 32 * 4;
constexpr size_t WS_SINR = WS_COSR + 2048ull * 16 * 4;
constexpr size_t WS_LOGF = WS_SINR + 2048ull * 16 * 4;
constexpr size_t WS_FCUM = WS_LOGF + (size_t)T * 8 * 4;
constexpr size_t WS_HBUF = (WS_FCUM + (size_t)T * 8 * 4 + 4095) & ~(size_t)4095;
constexpr size_t WS_OBUF = WS_HBUF + (size_t)T * 1024 * 2;
constexpr size_t WS_ZBUF = WS_OBUF + (size_t)T * 1024 * 2;
constexpr size_t WS_QBUF = WS_ZBUF + (size_t)T * 2560 * 2;
constexpr size_t WS_BAR = WS_ZBUF + (size_t)T * 4096 * 2;
constexpr size_t WS_PART = WS_BAR + 256;
constexpr size_t WS_XBAR = (WS_PART + (size_t)T * 20 * 4 + 4095) & ~(size_t)4095;
constexpr size_t WS_XBF_PRE = WS_XBAR + 16384;
constexpr size_t WS_XBF = WS_XBF_PRE;
constexpr size_t WS_END = WS_XBF + (size_t)T * 1024 * 2;

struct Params {
  const float *x, *c, *w_ada, *b_ada, *g_pre, *g_post, *ev_w_in, *ev_q_norm, *ev_kv_norm, *ev_w_uq, *ev_w_ukv, *ev_sinks, *ev_w_out,
      *od_w_in, *od_forget_bias, *od_lambda, *od_subln, *od_w_out;
  float* out;
  unsigned char* ws;
};

DI int opaque_tid() { int t = threadIdx.x; asm volatile("" : "+v"(t)); return t; }
DI float bflo(unsigned u) { return __uint_as_float(u << 16); }
DI float bfhi(unsigned u) { return __uint_as_float(u & 0xffff0000u); }
DI unsigned pk2(float lo, float hi) { f32x2 f = {lo, hi}; bf16x2_t b = __builtin_convertvector(f, bf16x2_t); return __builtin_bit_cast(unsigned, b); }
DI bf16_t f2bf(float f) { return (bf16_t)(pk2(f, 0.f) & 0xffffu); }
DI float fast_exp2(float x) { return __builtin_amdgcn_exp2f(x); }
DI float silu_f(float x) { return x * __builtin_amdgcn_rcpf(1.f + fast_exp2(-x * LOG2E)); }
DI float wave_sum(float v) {
#pragma unroll
  for (int o = 32; o >= 1; o >>= 1) v += __shfl_xor(v, o);
  return v;
}

namespace pg8 {
constexpr int BM = 256, BK = 64, HALF = 128, HTB = HALF * BK * 2, STAGE_BYTES = 8 * HTB, NXCD = 8, WGM = 8;
DI int lds_byte(int r, int c) { const int st = (r >> 4) * 2 + (c >> 5), rr = r & 15, cc = c & 31, ob = rr * 64 + cc * 2; return st * 1024 + (ob ^ (((ob >> 9) & 1) << 5)); }
DI void stage_rc(int b, int& R, int& C) { const int st = b / 1024, sb = b % 1024, swz = sb ^ (((sb >> 9) & 1) << 5); R = (st >> 1) * 16 + swz / 64; C = (st & 1) * 32 + (swz % 64) / 2; }
DI int perm32(int rho) { const int n = rho >> 4, i = rho & 15; return 8 * (i >> 2) + 4 * n + (i & 3); }
struct Unit { int pm, pn; };
struct Gemm { const bf16_t* A; const bf16_t* Bt; int M, N, K, lda; };
struct StaticOrder {
  int nM, nN, nwg, G, c;
  DI void init(int M, int N, int G_, int c_) { nM = M / BM; nN = N / BM; nwg = nM * nN; G = G_; c = c_; }
  DI bool next(int i, Unit& u) const {
    const long L = (long)i * G + c; if (L >= nwg) return false;
    int wgid = (int)L; { const int q = nwg / NXCD, r = nwg % NXCD, xcd = wgid % NXCD, off = wgid / NXCD; wgid = (xcd < r ? xcd * (q + 1) : r * (q + 1) + (xcd - r) * q) + off; }
    const int nig = WGM * nN, gid = wgid / nig, fm = gid * WGM, gsz = (nM - fm) < WGM ? (nM - fm) : WGM;
    u.pm = fm + ((wgid % nig) % gsz); u.pn = (wgid % nig) / gsz; return true;
  }
};

template <class Epi>
DI void gemm_phase(LAS unsigned char* lds, const Gemm g, const StaticOrder& S, const Epi& E) {
  const int tid = opaque_tid(), wid = __builtin_amdgcn_readfirstlane(tid >> 6), lane = tid & 63, wr = wid >> 2, wc = wid & 3, fr = lane & 15, fq = lane >> 4;
  const int K = g.K, nt = K / BK, lda = g.lda;
  unsigned voffA[2], voffB[2];
#pragma unroll
  for (int i = 0; i < 2; ++i) { int R, C; stage_rc(tid * 16 + i * 8192, R, C); const int Rb = (R & ~31) + perm32(R & 31);
    voffA[i] = (unsigned)(R * lda + C) * 2u; voffB[i] = (unsigned)(Rb * K + C) * 2u; }
  const size_t kstep = (size_t)(BK * 2);
  const size_t hstepA = (size_t)HALF * lda * 2, hstepB = (size_t)HALF * K * 2;
  const size_t tstepA = 2 * hstepA, tstepB = 2 * hstepB;
  const unsigned ldsw = (unsigned)wid * 1024u;
  const int aoff = lds_byte(wr * 64 + fr, fq * 8), boff = lds_byte(wc * 32 + fr, fq * 8);
#define PG8_SA(b, h) (((b) * 2 + (h)) * HTB)
#define PG8_SB(b, h) ((4 + (b) * 2 + (h)) * HTB)
#define PG8_STAGE(bufoff, gbase, voff) do { _Pragma("unroll") for (int _i = 0; _i < 2; ++_i) \
    __builtin_amdgcn_global_load_lds((const unsigned*)((const char*)(gbase) + (voff)[_i]), (LAS unsigned*)(lds + (bufoff) + ldsw + _i * 8192), 16, 0, 0); } while (0)
#define PG8_LDA(dst, b, h) do { _Pragma("unroll") for (int m = 0; m < 4; ++m) _Pragma("unroll") for (int k = 0; k < 2; ++k) dst[m][k] = *(const LAS bf16x8*)(lds + PG8_SA(b, h) + aoff + m * 2048 + k * 1024); } while (0)
#define PG8_LDB(dst, b, h) do { _Pragma("unroll") for (int n = 0; n < 2; ++n) _Pragma("unroll") for (int k = 0; k < 2; ++k) dst[n][k] = *(const LAS bf16x8*)(lds + PG8_SB(b, h) + boff + n * 2048 + k * 1024); } while (0)
#define PG8_MMA(ai, bj, At, Bt) do { __builtin_amdgcn_s_setprio(1); _Pragma("unroll") for (int m = 0; m < 4; ++m) _Pragma("unroll") for (int n = 0; n < 2; ++n) _Pragma("unroll") for (int k = 0; k < 2; ++k) \
    acc[ai][bj][m][n] = __builtin_amdgcn_mfma_f32_16x16x32_bf16(Bt[n][k], At[m][k], acc[ai][bj][m][n], 0, 0, 0); __builtin_amdgcn_s_setprio(0); } while (0)
#define PG8_WAIT_V(n) asm volatile("s_waitcnt vmcnt(" #n ")" ::: "memory")
#define PG8_WAIT_L(n) asm volatile("s_waitcnt lgkmcnt(" #n ")" ::: "memory")
#define PG8_BAR __builtin_amdgcn_s_barrier()
#define PG8_SCHED __builtin_amdgcn_sched_barrier(0)
  Unit cur, nxt; int ui = 0;
  if (!S.next(0, cur)) return;
  f32x4 acc[2][2][4][2];
#pragma unroll
  for (int a = 0; a < 2; ++a)
#pragma unroll
    for (int b = 0; b < 2; ++b)
#pragma unroll
      for (int m = 0; m < 4; ++m)
#pragma unroll
        for (int n = 0; n < 2; ++n) acc[a][b][m][n] = (f32x4){0.f, 0.f, 0.f, 0.f};
  bf16x8 At[4][2], B0[2][2], B1[2][2];
  const char* cA = (const char*)g.A + (size_t)cur.pm * tstepA; const char* cB = (const char*)g.Bt + (size_t)cur.pn * tstepB;
  PG8_STAGE(PG8_SB(0, 0), cB, voffB); PG8_STAGE(PG8_SA(0, 0), cA, voffA); PG8_STAGE(PG8_SB(0, 1), cB + hstepB, voffB); PG8_STAGE(PG8_SA(0, 1), cA + hstepA, voffA);
  if (wr == 1) PG8_BAR;
  PG8_WAIT_V(4); PG8_BAR;
  PG8_STAGE(PG8_SB(1, 0), cB + kstep, voffB); PG8_STAGE(PG8_SA(1, 0), cA + kstep, voffA); PG8_STAGE(PG8_SB(1, 1), cB + hstepB + kstep, voffB);
  PG8_WAIT_V(6); PG8_BAR;
  for (;;) {
    const bool has_next = S.next(ui + 1, nxt);
    const char* nA = has_next ? (const char*)g.A + (size_t)nxt.pm * tstepA : cA; const char* nB = has_next ? (const char*)g.Bt + (size_t)nxt.pn * tstepB : cB;
    for (int t = 0; t < nt; t += 2) {
      const bool last = (t == nt - 2);
      const char* a1 = cA + (size_t)(t + 1) * kstep;
      const char* a2 = last ? nA : cA + (size_t)(t + 2) * kstep; const char* b2 = last ? nB : cB + (size_t)(t + 2) * kstep;
      const char* a3 = a2 + kstep; const char* b3 = b2 + kstep;
      PG8_LDB(B0, 0, 0); PG8_SCHED; PG8_LDA(At, 0, 0); PG8_STAGE(PG8_SA(1, 1), a1 + hstepA, voffA);
      PG8_WAIT_L(8); PG8_BAR; PG8_WAIT_L(0); PG8_MMA(0, 0, At, B0); PG8_BAR; PG8_SCHED;
      PG8_LDB(B1, 0, 1); PG8_STAGE(PG8_SB(0, 0), b2, voffB);
      PG8_BAR; PG8_WAIT_L(0); PG8_MMA(0, 1, At, B1); PG8_BAR;
      PG8_LDA(At, 0, 1); PG8_STAGE(PG8_SA(0, 0), a2, voffA);
      PG8_BAR; PG8_WAIT_L(0); PG8_MMA(1, 0, At, B0); PG8_BAR; PG8_SCHED;
      PG8_STAGE(PG8_SB(0, 1), b2 + hstepB, voffB);
      PG8_WAIT_V(6); PG8_BAR; PG8_MMA(1, 1, At, B1); PG8_BAR;
      PG8_LDB(B0, 1, 0); PG8_SCHED; PG8_LDA(At, 1, 0); PG8_STAGE(PG8_SA(0, 1), a2 + hstepA, voffA);
      PG8_WAIT_L(8); PG8_BAR; PG8_WAIT_L(0); PG8_MMA(0, 0, At, B0); PG8_BAR; PG8_SCHED;
      PG8_LDB(B1, 1, 1); PG8_STAGE(PG8_SB(1, 0), b3, voffB);
      PG8_BAR; PG8_WAIT_L(0); PG8_MMA(0, 1, At, B1); PG8_BAR;
      PG8_LDA(At, 1, 1); PG8_STAGE(PG8_SA(1, 0), a3, voffA);
      PG8_BAR; PG8_WAIT_L(0); PG8_MMA(1, 0, At, B0); PG8_BAR; PG8_SCHED;
      PG8_STAGE(PG8_SB(1, 1), b3 + hstepB, voffB);
      PG8_WAIT_V(6); PG8_BAR; PG8_MMA(1, 1, At, B1); PG8_BAR;
    }
    E(acc, cur, wr, wc, fr, fq);
    if (!has_next) break;
#pragma unroll
    for (int a = 0; a < 2; ++a)
#pragma unroll
      for (int b = 0; b < 2; ++b)
#pragma unroll
        for (int m = 0; m < 4; ++m)
#pragma unroll
          for (int n = 0; n < 2; ++n) acc[a][b][m][n] = (f32x4){0.f, 0.f, 0.f, 0.f};
    cur = nxt; cA = nA; cB = nB; ++ui;
  }
  PG8_WAIT_V(0);
  if (wr == 0) PG8_BAR;
  PG8_BAR;
#undef PG8_SA
#undef PG8_SB
#undef PG8_STAGE
#undef PG8_LDA
#undef PG8_LDB
#undef PG8_MMA
#undef PG8_WAIT_V
#undef PG8_WAIT_L
#undef PG8_BAR
#undef PG8_SCHED
}
}

struct Epi {
  bf16_t* out; int ldc;
  int rope64_end;
  int rope32_lo, rope32_hi;
  int qmode;
  const float* pin; int nK;
  int pslot;
  float* pout;
  const float *cosH, *sinH, *cosR, *sinR;
  DI void operator()(const f32x4 (&acc)[2][2][4][2], const pg8::Unit& u, int wr, int wc, int fr, int fq) const {
    const int row0 = u.pm * 256 + wr * 64 + fr;
    int rt[2];
#pragma unroll
    for (int bj = 0; bj < 2; ++bj) {
      const int cw = u.pn * 256 + bj * 128 + wc * 32;
      rt[bj] = 0;
      if (cw < rope64_end) rt[bj] = 1;
      else if (cw >= rope32_lo && cw < rope32_hi) rt[bj] = 2;
      else if (qmode && ((cw >> 5) % 3) == 2) rt[bj] = 2;
    }
    const int tt = rt[0] | rt[1];
    const float* ctab = (tt == 1) ? cosH + (16 * (wc & 1) + 4 * fq) : cosR + 4 * fq;
    const float* stab = (tt == 1) ? sinH + (16 * (wc & 1) + 4 * fq) : sinR + 4 * fq;
    const int tstride = (tt == 1) ? 32 : 16;
    int ps[2] = {-1, -1};
    if (pout) {
#pragma unroll
      for (int bj = 0; bj < 2; ++bj) { const int cw = u.pn * 256 + bj * 128 + wc * 32;
        if (cw >= 1792 && cw < 2432) ps[bj] = ((cw - 1792) >> 7) * 4 + wc; }
    }
#pragma unroll
    for (int ai = 0; ai < 2; ++ai) {
      f32x4 cv[4], sv[4]; float rs[4];
#pragma unroll
      for (int m = 0; m < 4; ++m) {
        const int row = row0 + ai * 128 + m * 16;
        if (tt) { const int pos = row & (SEQ - 1); cv[m] = *(const f32x4*)(ctab + pos * tstride); sv[m] = *(const f32x4*)(stab + pos * tstride); }
        rs[m] = 1.f;
        if (pin) { const f32x4 p0 = *(const f32x4*)(pin + (size_t)row * 20 + pslot), p1 = *(const f32x4*)(pin + (size_t)row * 20 + pslot + 4);
          float ss = ((p0[0] + p0[1]) + (p0[2] + p0[3])) + ((p1[0] + p1[1]) + (p1[2] + p1[3]));
          if (nK == 384) { const f32x4 p2 = *(const f32x4*)(pin + (size_t)row * 20 + pslot + 8); ss += (p2[0] + p2[1]) + (p2[2] + p2[3]); }
          rs[m] = rsqrtf(ss / (float)nK + EPS); }
      }
#pragma unroll
      for (int m = 0; m < 4; ++m) {
        const int row = row0 + ai * 128 + m * 16;
#pragma unroll
        for (int bj = 0; bj < 2; ++bj) {
          const int c0 = u.pn * 256 + bj * 128 + wc * 32 + 8 * fq;
          f32x4 v0 = acc[ai][bj][m][0] * rs[m], v1 = acc[ai][bj][m][1] * rs[m];
          if (ps[bj] >= 0) {
            float sq = (v0[0] * v0[0] + v0[1] * v0[1]) + (v0[2] * v0[2] + v0[3] * v0[3]) + (v1[0] * v1[0] + v1[1] * v1[1]) + (v1[2] * v1[2] + v1[3] * v1[3]);
            sq += __shfl_xor(sq, 16); sq += __shfl_xor(sq, 32);
            if (fq == 0) pout[(size_t)row * 20 + ps[bj]] = sq;
          }
          if (rt[bj]) {
            const f32x4 o1 = v0 * cv[m] - v1 * sv[m], o2 = v1 * cv[m] + v0 * sv[m];
            v0 = o1; v1 = o2;
          }
          u32x4 w; w.x = pk2(v0[0], v0[1]); w.y = pk2(v0[2], v0[3]); w.z = pk2(v1[0], v1[1]); w.w = pk2(v1[2], v1[3]);
          *(u32x4*)(out + (size_t)row * ldc + c0) = w;
        }
      }
    }
  }
};

DI int ropeperm64(int p) { const int g = p >> 3, r = p & 7; return r < 4 ? 4 * g + r : 32 + 4 * g + (r - 4); }
DI int ropeperm32(int p) { const int g = p >> 3, r = p & 7; return r < 4 ? 4 * g + r : 16 + 4 * g + (r - 4); }
DI int srccol(int kind, int n) {
  if (kind == 0) {
    if (n < 512) return 672 + (n & ~63) + ropeperm64(n & 63);
    if (n < 640) return 1184 + ((n - 512) & ~63) + ropeperm64(n & 63);
    if (n < 768) return 1312 + (n - 640);
    if (n < 1792) return 1440 + (n - 768);
    if (n < 2176) return n - 1792;
    if (n < 2432) return 384 + (n - 2176);
    if (n < 2464) return 640 + ropeperm32(n - 2432);
    return -1;
  }
  if (kind == 1) {
    if (n < 1024) return (n & ~63) + ropeperm64(n & 63);
    if (n < 3072) return n;
    return 3080 + (n - 3072);
  }
  if (kind == 2) { const int hd = n / 96, p = n - hd * 96; return hd * 96 + (p < 64 ? p : 64 + ropeperm32(p - 64)); }
  return n;
}
DI void convert_tile(LAS unsigned char* lds, const float* W, int Nsrc, int K, bf16_t* Wt, int kind, const float* g, int tn, int tk) {
  const int tid = opaque_tid();
  LAS bf16_t* tile = (LAS bf16_t*)lds;
  const int nl = tid & 63, ks = tid >> 6;
  const int sc = srccol(kind, tn * 64 + nl);
#pragma unroll
  for (int kk = ks; kk < 64; kk += 8) {
    const int k = tk * 64 + kk;
    float v = 0.f;
    if (sc >= 0) { v = W[(size_t)k * Nsrc + sc]; if (g) v *= g[k]; }
    tile[nl * 72 + kk] = f2bf(v);
  }
  __syncthreads();
  { const int n2 = tid >> 3, ch = tid & 7;
    const u32x4 v = *(const LAS u32x4*)(tile + n2 * 72 + ch * 8);
    *(u32x4*)(Wt + (size_t)(tn * 64 + n2) * K + tk * 64 + ch * 8) = v; }
  __syncthreads();
}

DI void prologue(const Params& p, LAS unsigned char* lds) {
  const int tid = opaque_tid(), G = gridDim.x, bid = blockIdx.x;
  unsigned char* ws = p.ws;
  for (int idx = bid * 512 + tid; idx < 2048 * 48; idx += G * 512) {
    const bool isH = idx < 2048 * 32;
    const int j = isH ? idx : idx - 2048 * 32;
    const int pos = isH ? (j >> 5) : (j >> 4), i = isH ? (j & 31) : (j & 15);
    const float e = isH ? (float)(2 * i) * (1.f / 64.f) : (float)(2 * i) * (1.f / 32.f);
    const float inv = fast_exp2(-e * 13.287712379549449f);
    const float ang = (float)pos * inv;
    double t = (double)ang * 0.15915494309189535; t -= rint(t);
    const float fr = (float)t;
    const float cv = __builtin_amdgcn_cosf(fr), sv = __builtin_amdgcn_sinf(fr);
    if (isH) { ((float*)(ws + WS_COSH))[j] = cv; ((float*)(ws + WS_SINH))[j] = sv; }
    else { ((float*)(ws + WS_COSR))[j] = cv; ((float*)(ws + WS_SINR))[j] = sv; }
  }
  constexpr int NT0 = 40 * 16, NT1 = 64 * 16, NT2 = 12 * 6, NT3 = 16 * 4, NT4 = 16 * 16;
  constexpr int PER_I = NT0 + NT1 + NT2 + NT3 + 2 * NT4;
  for (int job = bid; job < 2 * PER_I; job += G) {
    const int i = job / PER_I; int j = job - i * PER_I;
    if (j < NT0) { convert_tile(lds, p.ev_w_in + (size_t)i * 1024 * 2464, 2464, 1024, (bf16_t*)(ws + WS_WEVIN + i * SZ_WEVIN), 0, nullptr, j / 16, j % 16); continue; }
    j -= NT0;
    if (j < NT1) { convert_tile(lds, p.od_w_in + (size_t)i * 1024 * 4104, 4104, 1024, (bf16_t*)(ws + WS_WODIN + i * SZ_WODIN), 1, nullptr, j / 16, j % 16); continue; }
    j -= NT1;
    if (j < NT2) { convert_tile(lds, p.ev_w_uq + (size_t)i * 384 * 768, 768, 384, (bf16_t*)(ws + WS_WUQ + i * SZ_WUQ), 2, p.ev_q_norm + i * 384, j / 6, j % 6); continue; }
    j -= NT2;
    if (j < NT3) { convert_tile(lds, p.ev_w_ukv + (size_t)i * 256 * 1024, 1024, 256, (bf16_t*)(ws + WS_WUKV + i * SZ_WUKV), 3, p.ev_kv_norm + i * 256, j / 4, j % 4); continue; }
    j -= NT3;
    if (j < NT4) { convert_tile(lds, p.ev_w_out + (size_t)i * 1024 * 1024, 1024, 1024, (bf16_t*)(ws + WS_WEVOUT + i * SZ_WOUT), 4, nullptr, j / 16, j % 16); continue; }
    j -= NT4;
    convert_tile(lds, p.od_w_out + (size_t)i * 1024 * 1024, 1024, 1024, (bf16_t*)(ws + WS_WODOUT + i * SZ_WOUT), 4, nullptr, j / 16, j % 16);
  }
  const int item0 = G - 1 - bid;
  if (item0 < 192) {
    LAS float* cond = (LAS float*)lds;
    LAS float* red = (LAS float*)(lds + 65536);
    for (int e = tid; e < 16 * 1024; e += 512) { const int b = e >> 10, k = e & 1023; cond[k * 16 + b] = silu_f(p.c[e]); }
    __syncthreads();
    for (int item = item0; item < 192; item += G) {
      const int l = item / 48, n0 = (item % 48) * 64;
      const int col = tid & 63, kg = tid >> 6;
      float a[16];
#pragma unroll
      for (int b = 0; b < 16; ++b) a[b] = 0.f;
      const float* wp = p.w_ada + (size_t)l * 1024 * 3072 + n0 + col;
      for (int k = kg * 128; k < kg * 128 + 128; ++k) {
        const float w = wp[(size_t)k * 3072];
#pragma unroll
        for (int b4 = 0; b4 < 4; ++b4) { const f32x4 cv = *(const LAS f32x4*)(cond + k * 16 + b4 * 4);
          a[b4 * 4 + 0] += cv[0] * w; a[b4 * 4 + 1] += cv[1] * w; a[b4 * 4 + 2] += cv[2] * w; a[b4 * 4 + 3] += cv[3] * w; }
      }
#pragma unroll
      for (int b = 0; b < 16; ++b) red[(kg * 16 + b) * 64 + col] = a[b];
      __syncthreads();
      for (int e = tid; e < 1024; e += 512) { const int b = e >> 6, cc = e & 63; float s = 0.f;
#pragma unroll
        for (int k8 = 0; k8 < 8; ++k8) s += red[(k8 * 16 + b) * 64 + cc];
        ((float*)(ws + WS_MOD))[((size_t)l * 16 + b) * 3072 + n0 + cc] = s + p.b_ada[l * 3072 + n0 + cc]; }
      __syncthreads();
    }
  }
}

DI void rowwise_phase(const Params& p, LAS unsigned char* lds, int lp, int ln) {
  const int tid = opaque_tid(), lane = tid & 63, wid = tid >> 6;
  const int gw = blockIdx.x * 8 + wid, nw = gridDim.x * 8;
  unsigned char* ws = p.ws;
  const float* mod = (const float*)(ws + WS_MOD);
  const bf16_t* ybuf = (const bf16_t*)(ws + WS_HBUF);
  bf16_t* hbuf = (bf16_t*)(ws + WS_HBUF);
  const bool ff = (ln < 4) && (ln & 1);
  LAS f32x4* wl = (LAS f32x4*)lds;
  if (ff) {
    const float* w = p.od_w_in + (size_t)(ln >> 1) * 1024 * 4104 + 3072;
    for (int c = tid; c < 1024; c += 512) {
      const f32x4 w0 = *(const f32x4*)(w + (size_t)c * 4104), w1 = *(const f32x4*)(w + (size_t)c * 4104 + 4);
      const int ln_ = (c & 255) >> 2, e = c & 3, j = c >> 8;
      wl[(j * 4 + e) * 64 + ln_] = w0; wl[1024 + (j * 4 + e) * 64 + ln_] = w1;
    }
    __syncthreads();
  }
  for (int row = gw; row < T; row += nw) {
    const int b = row >> 11;
    f32x4 xv[4];
    bf16_t* xbf = (bf16_t*)(ws + WS_XBF) + (size_t)row * DM;
    if (lp <= 0) {
      const float* xin = p.x + (size_t)row * DM;
#pragma unroll
      for (int j = 0; j < 4; ++j) xv[j] = *(const f32x4*)(xin + 4 * lane + 256 * j);
    } else {
#pragma unroll
      for (int j = 0; j < 4; ++j) { const u32x2 u = *(const u32x2*)(xbf + 4 * lane + 256 * j); xv[j] = (f32x4){bflo(u.x), bfhi(u.x), bflo(u.y), bfhi(u.y)}; }
    }
    if (lp >= 0) {
      f32x4 yv[4]; float ss = 0.f;
#pragma unroll
      for (int j = 0; j < 4; ++j) { const u32x2 u = *(const u32x2*)(ybuf + (size_t)row * DM + 4 * lane + 256 * j);
        yv[j] = (f32x4){bflo(u.x), bfhi(u.x), bflo(u.y), bfhi(u.y)}; ss += yv[j][0] * yv[j][0] + yv[j][1] * yv[j][1] + yv[j][2] * yv[j][2] + yv[j][3] * yv[j][3]; }
      ss = wave_sum(ss);
      const float rs = rsqrtf(ss * (1.f / DM) + EPS);
#pragma unroll
      for (int j = 0; j < 4; ++j) {
        const int c = 4 * lane + 256 * j;
        const f32x4 gt = *(const f32x4*)(mod + ((size_t)lp * 16 + b) * 3072 + 2048 + c);
        const f32x4 gp = *(const f32x4*)(p.g_post + lp * DM + c);
        xv[j] = xv[j] + gt * (yv[j] * rs * gp);
        if (ln >= 4) *(f32x4*)(p.out + (size_t)row * DM + c) = xv[j];
        else { u32x2 w; w.x = pk2(xv[j][0], xv[j][1]); w.y = pk2(xv[j][2], xv[j][3]); *(u32x2*)(xbf + c) = w; }
      }
    }
    if (ln < 4) {
      float ss = 0.f;
#pragma unroll
      for (int j = 0; j < 4; ++j) ss += xv[j][0] * xv[j][0] + xv[j][1] * xv[j][1] + xv[j][2] * xv[j][2] + xv[j][3] * xv[j][3];
      ss = wave_sum(ss);
      const float rs = rsqrtf(ss * (1.f / DM) + EPS);
      float zf[8];
#pragma unroll
      for (int h = 0; h < 8; ++h) zf[h] = 0.f;
#pragma unroll
      for (int j = 0; j < 4; ++j) {
        const int c = 4 * lane + 256 * j;
        const f32x4 sh = *(const f32x4*)(mod + ((size_t)ln * 16 + b) * 3072 + c);
        const f32x4 sc = *(const f32x4*)(mod + ((size_t)ln * 16 + b) * 3072 + 1024 + c);
        const f32x4 gp = *(const f32x4*)(p.g_pre + ln * DM + c);
        const f32x4 hv = (xv[j] * rs * gp) * (sc + 1.f) + sh;
        u32x2 w; w.x = pk2(hv[0], hv[1]); w.y = pk2(hv[2], hv[3]);
        *(u32x2*)(hbuf + (size_t)row * DM + c) = w;
        if (ff) {
#pragma unroll
          for (int e = 0; e < 4; ++e) {
            const f32x4 w0 = wl[(j * 4 + e) * 64 + lane], w1 = wl[1024 + (j * 4 + e) * 64 + lane];
            zf[0] += hv[e] * w0[0]; zf[1] += hv[e] * w0[1]; zf[2] += hv[e] * w0[2]; zf[3] += hv[e] * w0[3];
            zf[4] += hv[e] * w1[0]; zf[5] += hv[e] * w1[1]; zf[6] += hv[e] * w1[2]; zf[7] += hv[e] * w1[3];
          }
        }
      }
      if (ff) {
        const bool b5 = lane & 32, b4 = lane & 16, b3 = lane & 8;
        float w4[4], u2[2], t;
#pragma unroll
        for (int k = 0; k < 4; ++k) { const float send = b5 ? zf[k] : zf[4 + k], keep = b5 ? zf[4 + k] : zf[k]; w4[k] = keep + __shfl_xor(send, 32); }
#pragma unroll
        for (int k = 0; k < 2; ++k) { const float send = b4 ? w4[k] : w4[2 + k], keep = b4 ? w4[2 + k] : w4[k]; u2[k] = keep + __shfl_xor(send, 16); }
        { const float send = b3 ? u2[0] : u2[1], keep = b3 ? u2[1] : u2[0]; t = keep + __shfl_xor(send, 8); }
        t += __shfl_xor(t, 4); t += __shfl_xor(t, 2); t += __shfl_xor(t, 1);
        if ((lane & 7) == 0) {
          const int h = lane >> 3;
          const float z = t + p.od_forget_bias[(ln >> 1) * 8 + h];
          const float ls = fminf(z, 0.f) - __builtin_amdgcn_logf(1.f + fast_exp2(-fabsf(z) * LOG2E)) * 0.6931471805599453f;
          ((float*)(ws + WS_LOGF))[(size_t)row * 8 + h] = ls;
        }
      }
    }
  }
  __syncthreads();
}

DI void fox_scan(const Params& p, LAS unsigned char* lds, int bh) {
  const int tid = opaque_tid();
  const int b = bh >> 3, h = bh & 7;
  const float* logf_ = (const float*)(p.ws + WS_LOGF);
  float* fcum = (float*)(p.ws + WS_FCUM) + (size_t)bh * SEQ;
  LAS float* s = (LAS float*)lds;
  float v[4];
#pragma unroll
  for (int j = 0; j < 4; ++j) v[j] = logf_[((size_t)b * SEQ + 4 * tid + j) * 8 + h];
  v[1] += v[0]; v[2] += v[1]; v[3] += v[2];
  s[tid] = v[3];
  __syncthreads();
  for (int off = 1; off < 512; off <<= 1) {
    float t = 0.f;
    if (tid >= off) t = s[tid - off];
    __syncthreads();
    s[tid] += t;
    __syncthreads();
  }
  const float excl = s[tid] - v[3];
#pragma unroll
  for (int j = 0; j < 4; ++j) fcum[4 * tid + j] = -8.0f * (excl + v[j]);
  __syncthreads();
}

struct AttnArgs { const bf16_t *q, *k, *k2, *v, *gate; bf16_t* out; const float* fcum; int ldq, ldk, ldk2, ldv, ldo, ldg; float sl2, sink; };

DI float half_max(float x) {
  const unsigned u = __float_as_uint(x);
  auto r = __builtin_amdgcn_permlane32_swap(u, u, false, false);
  return fmaxf(__uint_as_float(r[0]), __uint_as_float(r[1]));
}
DI float half_sum(float x) {
  const unsigned u = __float_as_uint(x);
  auto r = __builtin_amdgcn_permlane32_swap(u, u, false, false);
  return __uint_as_float(r[0]) + __uint_as_float(r[1]);
}

template <int N> DI void wait_vmcnt() { asm volatile("s_waitcnt vmcnt(%0)" ::"n"(N) : "memory"); }
DI void raw_barrier() { asm volatile("" ::: "memory"); __builtin_amdgcn_s_barrier(); asm volatile("" ::: "memory"); }

template <int DQK, int DV, int MODE>
DI void attn_item(LAS unsigned char* lds, const AttnArgs& a, int qb) {
  constexpr int KSTR = DQK * 2 + 16, VSTR = (DV == 64) ? 192 : 320;
  constexpr int KG16 = KSTR / 16, VG16 = VSTR / 16;
  constexpr int KCH = KG16, VCH = VG16, NCH = KCH + VCH;
  constexpr int TILE = NCH * 1024 + (MODE == 2 ? 2048 : 0);
  constexpr int NSLOT = (NCH + 7) / 8, REM = NCH - 8 * (NSLOT - 1);
  constexpr int FX = (MODE == 2) ? 1 : 0;
  constexpr int NKS = DQK / 16, NBLK = DV / 32;
  static_assert(5 * TILE <= 155648, "ring too large");
  const int tid = opaque_tid(), wid = __builtin_amdgcn_readfirstlane(tid >> 6), lane = tid & 63, r = lane & 31, hh = lane >> 5;
  const int q0 = qb * 256, qw = q0 + 32 * wid, myq = qw + r;
  const float c = a.sl2, tau = 8.0f / a.sl2;
  bf16x8 qf[NKS];
#pragma unroll
  for (int ks = 0; ks < NKS; ++ks) qf[ks] = *(const bf16x8*)(a.q + (size_t)myq * a.ldq + 16 * ks + 8 * hh);
  int lo = 0; const int hi = 4 * (qb + 1);
  if (MODE == 1) { lo = 4 * qb - 2; if (lo < 0) lo = 0; }
  const int last_w = (qw + 31) >> 6;
  int first_w = 0;
  if (MODE == 1) { first_w = (qw > 127 ? qw - 127 : 0) >> 6; }
  const char* sp[NSLOT]; unsigned sst[NSLOT];
#pragma unroll
  for (int j = 0; j < NSLOT; ++j) {
    const int ch_ = 8 * j + wid;
    if (ch_ < KCH) {
      const int p = ch_ * 64 + lane, row = p / KG16, g = p - row * KG16;
      if (DQK == 96 && g >= 8 && g < 12) { sp[j] = (const char*)(a.k2 + (size_t)row * a.ldk2 + 8 * (g - 8)); sst[j] = (unsigned)(128 * a.ldk2); }
      else { sp[j] = (const char*)(a.k + (size_t)row * a.ldk + 8 * (g < 8 ? g : 0)); sst[j] = (unsigned)(128 * a.ldk); }
    } else {
      const int p = (ch_ - KCH) * 64 + lane, row = (p / VG16) & 63, g = p - (p / VG16) * VG16;
      sp[j] = (const char*)(a.v + (size_t)row * a.ldv + 8 * (g < DV / 8 ? g : 0)); sst[j] = (unsigned)(128 * a.ldv);
    }
  }
  auto issue = [&](int kt) {
    LAS unsigned char* base = lds + (kt % 5) * TILE;
#pragma unroll
    for (int j = 0; j < NSLOT; ++j) {
      if (j < NSLOT - 1 || wid < REM)
        __builtin_amdgcn_global_load_lds((const unsigned*)(sp[j] + (size_t)kt * sst[j]), (LAS unsigned*)(base + (8 * j + wid) * 1024), 16, 0, 0);
    }
    if (MODE == 2) __builtin_amdgcn_global_load_lds((const unsigned*)(a.fcum + kt * 64 + lane), (LAS unsigned*)(base + NCH * 1024 + wid * 256), 4, 0, 0);
  };
  auto wait_tiles = [&](bool all) {
    if (all) wait_vmcnt<0>();
    else if (wid < REM) wait_vmcnt<NSLOT + FX>();
    else wait_vmcnt<NSLOT - 1 + FX>();
  };
  f32x16 O[NBLK];
#pragma unroll
  for (int bl = 0; bl < NBLK; ++bl)
#pragma unroll
    for (int i = 0; i < 16; ++i) O[bl][i] = 0.f;
  float m = (MODE == 1) ? a.sink / a.sl2 : -1e30f;
  float l0 = (MODE == 1 && hh == 0) ? 1.f : 0.f, l1 = 0.f;
  const int i16 = lane & 15, q4 = i16 >> 2, p4 = i16 & 3, grp = (lane >> 4) & 1;
  auto qk_load = [&](int kt, bf16x8 (&kf)[2][NKS]) {
    LAS unsigned char* Kl = lds + (kt % 5) * TILE;
#pragma unroll
    for (int kb = 0; kb < 2; ++kb)
#pragma unroll
      for (int ks = 0; ks < NKS; ++ks) kf[kb][ks] = *(const LAS bf16x8*)(Kl + (32 * kb + r) * KSTR + (16 * ks + 8 * hh) * 2);
  };
  auto qk_mma = [&](int kt, const bf16x8 (&kf)[2][NKS], f32x16 (&s)[2]) {
#pragma unroll
    for (int kb = 0; kb < 2; ++kb) {
      if (MODE == 2) {
        LAS unsigned char* Fl = lds + (kt % 5) * TILE + NCH * 1024 + wid * 256;
#pragma unroll
        for (int g = 0; g < 4; ++g) { const f32x4 fb = *(const LAS f32x4*)(Fl + (32 * kb + 8 * g + 4 * hh) * 4);
          s[kb][4 * g] = fb[0]; s[kb][4 * g + 1] = fb[1]; s[kb][4 * g + 2] = fb[2]; s[kb][4 * g + 3] = fb[3]; }
      } else {
#pragma unroll
        for (int i = 0; i < 16; ++i) s[kb][i] = 0.f;
      }
    }
#pragma unroll
    for (int ks = 0; ks < NKS; ++ks)
#pragma unroll
      for (int kb = 0; kb < 2; ++kb) s[kb] = __builtin_amdgcn_mfma_f32_32x32x16_bf16(kf[kb][ks], qf[ks], s[kb], 0, 0, 0);
  };
  auto softmax = [&](int kt, f32x16 (&s)[2], bf16x8 (&pf)[2][2], auto maskc) {
    constexpr bool MASK = decltype(maskc)::value;
    const int key0 = kt * 64;
    if (MASK) {
#pragma unroll
      for (int kb = 0; kb < 2; ++kb)
#pragma unroll
        for (int i = 0; i < 16; ++i) {
          const int key = key0 + 32 * kb + (i & 3) + 8 * (i >> 2) + 4 * hh;
          bool valid = key <= myq; if (MODE == 1) valid = valid && (myq - key < 128);
          s[kb][i] = valid ? s[kb][i] : -1e30f;
        }
    }
    float mx = fmaxf(s[0][0], s[1][0]);
#pragma unroll
    for (int i = 1; i < 16; ++i) mx = fmaxf(fmaxf(mx, s[0][i]), s[1][i]);
    mx = half_max(mx);
    if (__builtin_amdgcn_ballot_w64(mx > m + tau) != 0ull) {
      const float mnew = fmaxf(m, mx);
      const float alpha = fast_exp2((m - mnew) * c);
      m = mnew;
      l0 *= alpha; l1 *= alpha;
#pragma unroll
      for (int bl = 0; bl < NBLK; ++bl)
#pragma unroll
        for (int i = 0; i < 16; ++i) O[bl][i] *= alpha;
    }
    const float nmc = -m * c;
#pragma unroll
    for (int kb = 0; kb < 2; ++kb)
#pragma unroll
      for (int s2 = 0; s2 < 2; ++s2) {
        float pv[8];
#pragma unroll
        for (int e = 0; e < 8; ++e) pv[e] = fast_exp2(__builtin_fmaf(s[kb][8 * s2 + e], c, nmc));
        l0 += (pv[0] + pv[4]) + (pv[2] + pv[6]); l1 += (pv[1] + pv[5]) + (pv[3] + pv[7]);
        u32x4 w;
        w.x = pk2(pv[0], pv[1]); w.y = pk2(pv[2], pv[3]); w.z = pk2(pv[4], pv[5]); w.w = pk2(pv[6], pv[7]);
        pf[kb][s2] = __builtin_bit_cast(bf16x8, w);
      }
  };
  auto pvmm = [&](int kt, const bf16x8 (&pf)[2][2]) {
    constexpr int PD = (NBLK == 2) ? 2 : 1;
    const unsigned va = (unsigned)(size_t)(lds + (kt % 5) * TILE + KCH * 1024 + (4 * hh + q4) * VSTR + (16 * grp) * 2 + 8 * p4);
    s16x4 vl[PD + 1][NBLK], vh[PD + 1][NBLK];
#define TRRD(dst, off) asm volatile("ds_read_b64_tr_b16 %0, %1 offset:%2" : "=&v"(dst) : "v"(va), "n"(off) : "memory")
#define TRSTEP(st_) do { _Pragma("unroll") for (int bl = 0; bl < NBLK; ++bl) { TRRD(vl[(st_) % (PD + 1)][bl], 16 * (st_) * VSTR + 64 * bl); TRRD(vh[(st_) % (PD + 1)][bl], 16 * (st_) * VSTR + 64 * bl + 8 * VSTR); } } while (0)
#define TRWAIT(n_, b_) do { if (NBLK == 2) asm volatile("s_waitcnt lgkmcnt(" #n_ ")" : "+v"(vl[b_][0]), "+v"(vh[b_][0]), "+v"(vl[b_][1]), "+v"(vh[b_][1])::"memory"); \
    else asm volatile("s_waitcnt lgkmcnt(" #n_ ")" : "+v"(vl[b_][0]), "+v"(vh[b_][0]), "+v"(vl[b_][1]), "+v"(vh[b_][1]), "+v"(vl[b_][2 % NBLK]), "+v"(vh[b_][2 % NBLK]), "+v"(vl[b_][3 % NBLK]), "+v"(vh[b_][3 % NBLK])::"memory"); } while (0)
#pragma unroll
    for (int st = 0; st < PD; ++st) TRSTEP(st);
#pragma unroll
    for (int st = 0; st < 4; ++st) {
      if (st + PD < 4) TRSTEP(st + PD);
      const int ahead = ((st + PD < 4) ? st + PD : 3) - st;
      const int b_ = st % (PD + 1);
      if (ahead * 2 * NBLK == 8) TRWAIT(8, b_); else if (ahead * 2 * NBLK == 4) TRWAIT(4, b_); else TRWAIT(0, b_);
#pragma unroll
      for (int bl = 0; bl < NBLK; ++bl) {
        const bf16x8 vf = __builtin_shufflevector(vl[b_][bl], vh[b_][bl], 0, 1, 2, 3, 4, 5, 6, 7);
        O[bl] = __builtin_amdgcn_mfma_f32_32x32x16_bf16(vf, pf[st >> 1][st & 1], O[bl], 0, 0, 0);
      }
    }
#undef TRRD
#undef TRSTEP
#undef TRWAIT
  };
  auto act = [&](int kt) { return kt <= last_w && kt >= first_w; };
  f32x16 sA[2];
  const bool halfB = wid >= 4;
  issue(lo);
  if (lo + 1 < hi) issue(lo + 1);
  if (lo + 2 < hi) issue(lo + 2);
  if (lo + 3 < hi) issue(lo + 3);
  wait_tiles(!(lo + 3 < hi));
  raw_barrier();
  if (halfB) raw_barrier();
  if (act(lo)) { bf16x8 kf0[2][NKS]; qk_load(lo, kf0); qk_mma(lo, kf0, sA); }
  auto step = [&](int kt, auto maskc) {
    const bool a0 = act(kt), a1 = (kt + 1 < hi) && act(kt + 1);
    bf16x8 pf[2][2], kf[2][NKS];
    if (a1) qk_load(kt + 1, kf);
    __builtin_amdgcn_sched_barrier(0);
    if (a0) softmax(kt, sA, pf, maskc);
    wait_tiles(!(kt + 3 < hi));
    raw_barrier();
    if (kt + 4 < hi) issue(kt + 4);
    if (a1) qk_mma(kt + 1, kf, sA);
    if (a0) pvmm(kt, pf);
    raw_barrier();
  };
  int split = lo;
  if (MODE != 1) { split = qw >> 6; if (split < lo) split = lo; if (split > hi) split = hi; }
  if (MODE != 1) { for (int kt = lo; kt < split; ++kt) step(kt, std::false_type{}); }
  for (int kt = split; kt < hi; ++kt) step(kt, std::true_type{});
  if (!halfB) raw_barrier();
  const float l = half_sum(l0 + l1);
  const float inv = 1.f / l;
#pragma unroll
  for (int bl = 0; bl < NBLK; ++bl)
#pragma unroll
    for (int g = 0; g < 4; ++g) {
      const int f = 32 * bl + 8 * g + 4 * hh;
      float o0 = O[bl][4 * g + 0] * inv, o1 = O[bl][4 * g + 1] * inv, o2 = O[bl][4 * g + 2] * inv, o3 = O[bl][4 * g + 3] * inv;
      if (a.gate) {
        const u32x2 gv = *(const u32x2*)(a.gate + (size_t)myq * a.ldg + f);
        o0 *= silu_f(bflo(gv.x)); o1 *= silu_f(bfhi(gv.x)); o2 *= silu_f(bflo(gv.y)); o3 *= silu_f(bfhi(gv.y));
      }
      u32x2 w; w.x = pk2(o0, o1); w.y = pk2(o2, o3);
      *(u32x2*)(a.out + (size_t)myq * a.ldo + f) = w;
    }
}


DI void swa_item(LAS unsigned char* lds, const AttnArgs& a, const float* sinks4, int qb) {
  constexpr int KSTR = 144, VSTR = 192, KCH = 9, VCH = 12, NCH = 21, TILE = NCH * 1024, NSLOT = 3, REM = 5, NKS = 4, NBLK = 2;
  const int tid = opaque_tid(), wid = __builtin_amdgcn_readfirstlane(tid >> 6), lane = tid & 63, r = lane & 31, hh = lane >> 5;
  const int q0 = qb * 256, qw = q0 + 32 * wid, myq = qw + r;
  const float c = a.sl2, tau = 8.0f / a.sl2;
  int lo = 4 * qb - 2; if (lo < 0) lo = 0;
  const int hi = 4 * (qb + 1);
  const int last_w = (qw + 31) >> 6, first_w = (qw > 127 ? qw - 127 : 0) >> 6;
#pragma unroll
  for (int j = 0; j < NSLOT; ++j) {
    const int ch_ = 8 * j + wid;
    if (j < NSLOT - 1 || wid < REM) {
      const char* sp; unsigned sst;
      if (ch_ < KCH) { const int p = ch_ * 64 + lane, row = p / 9, g = p - row * 9;
        sp = (const char*)(a.k + (size_t)row * a.ldk + 8 * (g < 8 ? g : 0)); sst = (unsigned)(128 * a.ldk); }
      else { const int p = (ch_ - KCH) * 64 + lane, row = (p / 12) & 63, g = p - (p / 12) * 12;
        sp = (const char*)(a.v + (size_t)row * a.ldv + 8 * (g < 8 ? g : 0)); sst = (unsigned)(128 * a.ldv); }
      for (int kt = lo; kt < hi; ++kt)
        __builtin_amdgcn_global_load_lds((const unsigned*)(sp + (size_t)kt * sst), (LAS unsigned*)(lds + (kt - lo) * TILE + ch_ * 1024), 16, 0, 0);
    }
  }
  wait_vmcnt<0>();
  raw_barrier();
  const int i16 = lane & 15, q4 = i16 >> 2, p4 = i16 & 3, grp = (lane >> 4) & 1;
  for (int h4 = 0; h4 < 4; ++h4) {
    bf16x8 qf[NKS];
#pragma unroll
    for (int ks = 0; ks < NKS; ++ks) qf[ks] = *(const bf16x8*)(a.q + (size_t)myq * a.ldq + h4 * 64 + 16 * ks + 8 * hh);
    f32x16 O[NBLK];
#pragma unroll
    for (int bl = 0; bl < NBLK; ++bl)
#pragma unroll
      for (int i = 0; i < 16; ++i) O[bl][i] = 0.f;
    float m = sinks4[h4] / a.sl2;
    float l0 = (hh == 0) ? 1.f : 0.f, l1 = 0.f;
    for (int kt = first_w; kt <= last_w; ++kt) {
      LAS unsigned char* Kl = lds + (kt - lo) * TILE;
      f32x16 s[2];
      bf16x8 kf[2][NKS];
#pragma unroll
      for (int kb = 0; kb < 2; ++kb)
#pragma unroll
        for (int ks = 0; ks < NKS; ++ks) kf[kb][ks] = *(const LAS bf16x8*)(Kl + (32 * kb + r) * KSTR + (16 * ks + 8 * hh) * 2);
#pragma unroll
      for (int kb = 0; kb < 2; ++kb)
#pragma unroll
        for (int i = 0; i < 16; ++i) s[kb][i] = 0.f;
#pragma unroll
      for (int ks = 0; ks < NKS; ++ks)
#pragma unroll
        for (int kb = 0; kb < 2; ++kb) s[kb] = __builtin_amdgcn_mfma_f32_32x32x16_bf16(kf[kb][ks], qf[ks], s[kb], 0, 0, 0);
      const int key0 = kt * 64;
#pragma unroll
      for (int kb = 0; kb < 2; ++kb)
#pragma unroll
        for (int i = 0; i < 16; ++i) {
          const int key = key0 + 32 * kb + (i & 3) + 8 * (i >> 2) + 4 * hh;
          const bool valid = (key <= myq) && (myq - key < 128);
          s[kb][i] = valid ? s[kb][i] : -1e30f;
        }
      float mx = fmaxf(s[0][0], s[1][0]);
#pragma unroll
      for (int i = 1; i < 16; ++i) mx = fmaxf(fmaxf(mx, s[0][i]), s[1][i]);
      mx = half_max(mx);
      if (__builtin_amdgcn_ballot_w64(mx > m + tau) != 0ull) {
        const float mnew = fmaxf(m, mx);
        const float alpha = fast_exp2((m - mnew) * c);
        m = mnew; l0 *= alpha; l1 *= alpha;
#pragma unroll
        for (int bl = 0; bl < NBLK; ++bl)
#pragma unroll
          for (int i = 0; i < 16; ++i) O[bl][i] *= alpha;
      }
      const float nmc = -m * c;
      bf16x8 pf[2][2];
#pragma unroll
      for (int kb = 0; kb < 2; ++kb)
#pragma unroll
        for (int s2 = 0; s2 < 2; ++s2) {
          float pv[8];
#pragma unroll
          for (int e = 0; e < 8; ++e) pv[e] = fast_exp2(__builtin_fmaf(s[kb][8 * s2 + e], c, nmc));
          l0 += (pv[0] + pv[4]) + (pv[2] + pv[6]); l1 += (pv[1] + pv[5]) + (pv[3] + pv[7]);
          u32x4 w;
          w.x = pk2(pv[0], pv[1]); w.y = pk2(pv[2], pv[3]); w.z = pk2(pv[4], pv[5]); w.w = pk2(pv[6], pv[7]);
          pf[kb][s2] = __builtin_bit_cast(bf16x8, w);
        }
      LAS unsigned char* Vl = Kl + KCH * 1024 + (4 * hh + q4) * VSTR + (16 * grp) * 2 + 8 * p4;
#pragma unroll
      for (int st = 0; st < 4; ++st)
#pragma unroll
        for (int bl = 0; bl < NBLK; ++bl) {
          LAS unsigned char* ad = Vl + (16 * st) * VSTR + (32 * bl) * 2;
          const s16x4 lo_ = __builtin_amdgcn_ds_read_tr16_b64_v4i16((LAS s16x4*)ad);
          const s16x4 hi_ = __builtin_amdgcn_ds_read_tr16_b64_v4i16((LAS s16x4*)(ad + 8 * VSTR));
          const bf16x8 vf = __builtin_shufflevector(lo_, hi_, 0, 1, 2, 3, 4, 5, 6, 7);
          O[bl] = __builtin_amdgcn_mfma_f32_32x32x16_bf16(vf, pf[st >> 1][st & 1], O[bl], 0, 0, 0);
        }
    }
    const float l = half_sum(l0 + l1);
    const float inv = 1.f / l;
#pragma unroll
    for (int bl = 0; bl < NBLK; ++bl)
#pragma unroll
      for (int g = 0; g < 4; ++g) {
        const int f = h4 * 64 + 32 * bl + 8 * g + 4 * hh;
        float o0 = O[bl][4 * g + 0] * inv, o1 = O[bl][4 * g + 1] * inv, o2 = O[bl][4 * g + 2] * inv, o3 = O[bl][4 * g + 3] * inv;
        const u32x2 gv = *(const u32x2*)(a.gate + (size_t)myq * a.ldg + f);
        o0 *= silu_f(bflo(gv.x)); o1 *= silu_f(bfhi(gv.x)); o2 *= silu_f(bflo(gv.y)); o3 *= silu_f(bfhi(gv.y));
        u32x2 w; w.x = pk2(o0, o1); w.y = pk2(o2, o3);
        *(u32x2*)(a.out + (size_t)myq * a.ldo + f) = w;
      }
  }
  __syncthreads();
}

DI bool team_item(int G, int c, int n, int& bh, int& qb) {
  if (G == 256) {
    const int x = c & 7, li = c >> 3, t = li >> 3, i = li & 7;
    bh = x + 8 * (4 * t + n);
    const int j = (i + 4) & 7;
    qb = (n == 0) ? i : (n == 1) ? 7 - i : (n == 2) ? j : 7 - j;
    return true;
  }
  const int idx = n * G + ((n & 1) ? (G - 1 - c) : c);
  if (idx >= 1024) return false;
  qb = 7 - idx / 128; bh = idx % 128;
  return true;
}

DI int snake_idx(int round, int G, int c) { return round * G + ((round & 1) ? (G - 1 - c) : c); }

DI void attn_even(const Params& p, LAS unsigned char* lds, int i) {
  const int G = gridDim.x, c = blockIdx.x;
  unsigned char* ws = p.ws;
  const bf16_t* z = (const bf16_t*)(ws + WS_ZBUF);
  const bf16_t* qb_ = (const bf16_t*)(ws + WS_QBUF);
  const bf16_t* kv = (const bf16_t*)(ws + WS_HBUF);
  bf16_t* ob = (bf16_t*)(ws + WS_OBUF);
  for (int rd = 0; rd * G < 1024; ++rd) {
    int qb, bh;
    if (!team_item(G, c, rd, bh, qb)) continue;
    const int b = bh >> 3, hd = bh & 7;
    AttnArgs a;
    a.q = qb_ + (size_t)b * SEQ * 768 + hd * 96; a.ldq = 768;
    a.k = kv + (size_t)b * SEQ * 1024 + hd * 128; a.ldk = 1024;
    a.k2 = z + (size_t)b * SEQ * 2560 + 2432; a.ldk2 = 2560;
    a.v = kv + (size_t)b * SEQ * 1024 + hd * 128 + 64; a.ldv = 1024;
    a.out = ob + (size_t)b * SEQ * 1024 + hd * 64; a.ldo = 1024;
    a.gate = z + (size_t)b * SEQ * 2560 + 768 + hd * 64; a.ldg = 2560;
    a.fcum = nullptr; a.sl2 = 0.10206207261596577f * LOG2E; a.sink = 0.f;
    attn_item<96, 64, 0>(lds, a, qb);
  }
  for (int it = c; it < 256; it += G) {
    const int b = it >> 4, kvh = (it >> 3) & 1, qb = it & 7;
    AttnArgs a;
    const bf16_t* zb = z + (size_t)b * SEQ * 2560;
    a.q = zb + kvh * 256; a.ldq = 2560;
    a.k = zb + 512 + kvh * 64; a.ldk = 2560; a.k2 = nullptr; a.ldk2 = 0;
    a.v = zb + 640 + kvh * 64; a.ldv = 2560;
    a.out = ob + (size_t)b * SEQ * 1024 + 512 + kvh * 256; a.ldo = 1024;
    a.gate = zb + 768 + 512 + kvh * 256; a.ldg = 2560;
    a.fcum = nullptr; a.sl2 = 0.125f * LOG2E; a.sink = 0.f;
    float sk[4];
#pragma unroll
    for (int h4 = 0; h4 < 4; ++h4) sk[h4] = p.ev_sinks[i * 8 + kvh * 4 + h4] * LOG2E;
    swa_item(lds, a, sk, qb);
  }
}

DI void attn_odd(const Params& p, LAS unsigned char* lds, int layer) {
  const int G = gridDim.x, c = blockIdx.x;
  unsigned char* ws = p.ws;
  const bf16_t* z = (const bf16_t*)(ws + WS_ZBUF);
  bf16_t* od = (bf16_t*)(ws + WS_HBUF);
  bf16_t* ob = (bf16_t*)(ws + WS_OBUF);
  {
    for (int rd = 0; rd * G < 512; ++rd) {
      int qb, bh2;
      if (G == 256) { const int x = c & 7, li = c >> 3, t = li >> 3, i = li & 7; bh2 = x + 8 * (2 * t + rd); qb = (rd == 0) ? i : 7 - i; }
      else { const int idx = snake_idx(rd, G, c); if (idx >= 512) continue; qb = 7 - idx / 64; bh2 = idx % 64; }
      const int b = bh2 >> 2, h = bh2 & 3;
      const bf16_t* zb = z + (size_t)b * SEQ * 4096;
      for (int mp = 0; mp < 2; ++mp) {
        const int j = 2 * h + mp;
        AttnArgs a;
        a.q = zb + j * 64; a.ldq = 4096;
        a.k = zb + 512 + j * 64; a.ldk = 4096; a.k2 = nullptr; a.ldk2 = 0;
        a.v = zb + 1024 + h * 128; a.ldv = 4096;
        a.out = od + (size_t)b * SEQ * 1024 + j * 128; a.ldo = 1024;
        a.gate = nullptr; a.ldg = 0;
        a.fcum = nullptr; a.sl2 = 0.125f * LOG2E; a.sink = 0.f;
#ifndef SKIP_DIFF
        attn_item<64, 128, 0>(lds, a, qb);
#endif
      }
      __builtin_amdgcn_fence(__ATOMIC_SEQ_CST, "workgroup");
      asm volatile("s_waitcnt vmcnt(0)" ::: "memory");
      const int tid2 = opaque_tid(), lane = tid2 & 63, wid = tid2 >> 6, li_ = layer >> 1;
      const float* lp = p.od_lambda + li_ * 256;
      const float s1 = wave_sum(lp[lane] * lp[64 + lane]), s2 = wave_sum(lp[128 + lane] * lp[192 + lane]);
      const float lam_init = 0.8f - 0.6f * fast_exp2(-0.3f * LOG2E * (float)layer);
      const float lam = fast_exp2(s1 * LOG2E) - fast_exp2(s2 * LOG2E) + lam_init;
      const int rsub = lane >> 4, dv = (lane & 15) * 8;
      float sub[8];
#pragma unroll
      for (int e = 0; e < 8; ++e) sub[e] = p.od_subln[li_ * 128 + dv + e] * (1.f - lam_init);
      const size_t row0 = (size_t)b * SEQ + qb * 256 + 32 * wid;
#pragma unroll 2
      for (int rr = 0; rr < 8; ++rr) {
        const size_t row = row0 + 4 * rr + rsub;
        const u32x4 va = *(const u32x4*)(od + row * 1024 + (2 * h) * 128 + dv);
        const u32x4 vb = *(const u32x4*)(od + row * 1024 + (2 * h + 1) * 128 + dv);
        const u32x4 vg = *(const u32x4*)(z + row * 4096 + 3072 + h * 128 + dv);
        float d[8]; float ss = 0.f;
#pragma unroll
        for (int e = 0; e < 4; ++e) { d[2 * e] = bflo(va[e]) - lam * bflo(vb[e]); d[2 * e + 1] = bfhi(va[e]) - lam * bfhi(vb[e]); ss += d[2 * e] * d[2 * e] + d[2 * e + 1] * d[2 * e + 1]; }
        ss += __shfl_xor(ss, 1); ss += __shfl_xor(ss, 2); ss += __shfl_xor(ss, 4); ss += __shfl_xor(ss, 8);
        const float rs = rsqrtf(ss * (1.f / 128.f) + EPS);
        u32x4 w;
#pragma unroll
        for (int e = 0; e < 4; ++e) {
          const float o0 = d[2 * e] * rs * sub[2 * e] * silu_f(bflo(vg[e])), o1 = d[2 * e + 1] * rs * sub[2 * e + 1] * silu_f(bfhi(vg[e]));
          w[e] = pk2(o0, o1);
        }
        *(u32x4*)(ob + row * 1024 + h * 128 + dv) = w;
      }
    }
  }
  for (int rd = 0; rd * G < 1024; ++rd) {
    int qb, bh;
    if (!team_item(G, c, rd, bh, qb)) continue;
    const int b = bh >> 3, hd = bh & 7;
    AttnArgs a;
    const bf16_t* zb = z + (size_t)b * SEQ * 4096;
    a.q = zb + 1536 + hd * 64; a.ldq = 4096;
    a.k = zb + 2048 + hd * 64; a.ldk = 4096; a.k2 = nullptr; a.ldk2 = 0;
    a.v = zb + 2560 + hd * 64; a.ldv = 4096;
    a.out = ob + (size_t)b * SEQ * 1024 + 512 + hd * 64; a.ldo = 1024;
    a.gate = zb + 3072 + 512 + hd * 64; a.ldg = 4096;
    a.fcum = (const float*)(ws + WS_FCUM) + (size_t)bh * SEQ; a.sl2 = 0.125f * LOG2E; a.sink = 0.f;
#ifndef SKIP_FOX
    attn_item<64, 64, 2>(lds, a, qb);
#endif
  }
}

DI void diff_combine(const Params& p, int layer) {
  const int tid = opaque_tid(), lane = tid & 63, wid = tid >> 6;
  const int gw = blockIdx.x * 8 + wid, nw = gridDim.x * 8;
  const int i = layer >> 1;
  unsigned char* ws = p.ws;
  const bf16_t* od = (const bf16_t*)(ws + WS_HBUF);
  const bf16_t* z = (const bf16_t*)(ws + WS_ZBUF);
  bf16_t* ob = (bf16_t*)(ws + WS_OBUF);
  const float* lp = p.od_lambda + i * 256;
  const float s1 = wave_sum(lp[lane] * lp[64 + lane]), s2 = wave_sum(lp[128 + lane] * lp[192 + lane]);
  const float lam_init = 0.8f - 0.6f * expf(-0.3f * (float)layer);
  const float lam = expf(s1) - expf(s2) + lam_init;
  const int hd = lane >> 4, dv = (lane & 15) * 8;
  float sub[8];
#pragma unroll
  for (int e = 0; e < 8; ++e) sub[e] = p.od_subln[i * 128 + dv + e] * (1.f - lam_init);
  for (int row = gw; row < T; row += nw) {
    const u32x4 a = *(const u32x4*)(od + (size_t)row * 1024 + (2 * hd) * 128 + dv);
    const u32x4 b = *(const u32x4*)(od + (size_t)row * 1024 + (2 * hd + 1) * 128 + dv);
    const u32x4 g = *(const u32x4*)(z + (size_t)row * 4096 + 3072 + hd * 128 + dv);
    float d[8]; float ss = 0.f;
#pragma unroll
    for (int e = 0; e < 4; ++e) { d[2 * e] = bflo(a[e]) - lam * bflo(b[e]); d[2 * e + 1] = bfhi(a[e]) - lam * bfhi(b[e]); ss += d[2 * e] * d[2 * e] + d[2 * e + 1] * d[2 * e + 1]; }
    ss += __shfl_xor(ss, 1); ss += __shfl_xor(ss, 2); ss += __shfl_xor(ss, 4); ss += __shfl_xor(ss, 8);
    const float rs = rsqrtf(ss * (1.f / 128.f) + EPS);
    u32x4 w;
#pragma unroll
    for (int e = 0; e < 4; ++e) {
      const float o0 = d[2 * e] * rs * sub[2 * e] * silu_f(bflo(g[e])), o1 = d[2 * e + 1] * rs * sub[2 * e + 1] * silu_f(bfhi(g[e]));
      w[e] = pk2(o0, o1);
    }
    *(u32x4*)(ob + (size_t)row * 1024 + hd * 128 + dv) = w;
  }
}


DI void grid_barrier(unsigned* ctr, unsigned& epoch) {
  asm volatile("s_waitcnt vmcnt(0)" ::: "memory");
  __syncthreads();
  epoch += 1;
  if (threadIdx.x == 0) {
    __builtin_amdgcn_fence(__ATOMIC_RELEASE, "agent");
    asm volatile("s_waitcnt vmcnt(0)" ::: "memory");
    __hip_atomic_fetch_add(ctr, 1u, __ATOMIC_RELAXED, __HIP_MEMORY_SCOPE_AGENT);
    const unsigned target = epoch * gridDim.x;
    while (__hip_atomic_load(ctr, __ATOMIC_RELAXED, __HIP_MEMORY_SCOPE_AGENT) < target) __builtin_amdgcn_s_sleep(1);
    __builtin_amdgcn_fence(__ATOMIC_ACQUIRE, "agent");
    asm volatile("s_waitcnt vmcnt(0)" ::: "memory");
  }
  __syncthreads();
}


#define XB_TMO      128
#define XB_XCNT(j)  (256  + 64 * (j))
#define XB_XSUB(j)  (1280 + 64 * (j))
#define XB_XGEN(j)  (2304 + 64 * (j))
#define XB_TOP      3328
#define XB_TOPGEN   3392
#define XCD_BAR_WORDS 3456
#define XB_SPIN_CAP (1u << 20)
DI unsigned xb_ld(unsigned* p) { return __hip_atomic_load(p, __ATOMIC_RELAXED, __HIP_MEMORY_SCOPE_AGENT); }
DI unsigned xb_add(unsigned* p, unsigned v) { return __hip_atomic_fetch_add(p, v, __ATOMIC_RELAXED, __HIP_MEMORY_SCOPE_AGENT); }
DI unsigned xb_xcc_id() { return (unsigned)__builtin_amdgcn_s_getreg((3 << 11) | 20) & 0xFu; }
#define XB_SPIN(cond, bar) do { unsigned _sp = 0; while (cond) { __builtin_amdgcn_s_sleep(1); \
    if ((++_sp & 255u) == 0u) { if (xb_ld(&(bar)[XB_TMO])) break; if (_sp > XB_SPIN_CAP) { atomicAdd(&(bar)[XB_TMO], 1u); break; } } } } while (0)
struct XcdBarrier { unsigned* bar; unsigned x; volatile LAS unsigned* st; };
DI void xcd_barrier_complete(unsigned* bar, unsigned x, unsigned& nloc, unsigned& nx) {
  const unsigned G = gridDim.x;
  unsigned sum, cnt, mine, sp = 0u;
  for (;;) {
    sum = 0u; cnt = 0u; mine = 0u;
#pragma unroll
    for (unsigned j = 0; j < 16; ++j) { const unsigned c = xb_ld(&bar[XB_XCNT(j)]); sum += c; cnt += (c > 0u) ? 1u : 0u; mine = (j == x) ? c : mine; }
    if (sum == G) break;
    __builtin_amdgcn_s_sleep(1);
    if ((++sp & 255u) == 0u) { if (xb_ld(&bar[XB_TMO])) break; if (sp > XB_SPIN_CAP) { atomicAdd(&bar[XB_TMO], 1u); break; } }
  }
  nloc = mine > 0u ? mine : 1u; nx = cnt > 0u ? cnt : 1u;
}
DI void xcd_barrier(const XcdBarrier& b) {
  asm volatile("s_waitcnt vmcnt(0)" ::: "memory");
  __syncthreads();
  if (threadIdx.x == 0) {
    unsigned* bar = b.bar;
    __builtin_amdgcn_s_waitcnt(0);
    unsigned nloc = b.st[0], nx = b.st[1];
    if (nloc == 0u) { xcd_barrier_complete(bar, b.x, nloc, nx); b.st[0] = nloc; b.st[1] = nx; }
    const unsigned old = xb_add(&bar[XB_XSUB(b.x)], 1u);
    const unsigned gen = old / nloc;
    if (old + 1u == (gen + 1u) * nloc) {
      __builtin_amdgcn_fence(__ATOMIC_RELEASE, "agent");
      asm volatile("s_waitcnt vmcnt(0)" ::: "memory");
      const unsigned og = xb_add(&bar[XB_TOP], 1u);
      const unsigned tg = og / nx;
      if (og + 1u == (tg + 1u) * nx) xb_add(&bar[XB_TOPGEN], 1u);
      else XB_SPIN(xb_ld(&bar[XB_TOPGEN]) == tg, bar);
      __builtin_amdgcn_fence(__ATOMIC_ACQUIRE, "agent");
      xb_add(&bar[XB_XGEN(b.x)], 1u);
      asm volatile("s_waitcnt vmcnt(0)" ::: "memory");
    } else {
      XB_SPIN(xb_ld(&bar[XB_XGEN(b.x)]) == gen, bar);
      __builtin_amdgcn_fence(__ATOMIC_ACQUIRE, "agent");
      asm volatile("s_waitcnt vmcnt(0)" ::: "memory");
    }
  }
  __syncthreads();
}

__global__ void __launch_bounds__(512) fwd_megakernel(Params p) {
  extern __shared__ __attribute__((aligned(16))) unsigned char lds_raw[];
  LAS unsigned char* lds = (LAS unsigned char*)lds_raw;
  cg::grid_group grid = cg::this_grid();
  unsigned char* ws = p.ws;
  const int G = gridDim.x, bid = blockIdx.x;
  const float* cosH = (const float*)(ws + WS_COSH); const float* sinH = (const float*)(ws + WS_SINH);
  const float* cosR = (const float*)(ws + WS_COSR); const float* sinR = (const float*)(ws + WS_SINR);

  unsigned* xbar = (unsigned*)(ws + WS_XBAR);
  if (bid == 0) { for (int w = threadIdx.x; w < XCD_BAR_WORDS; w += 512) __hip_atomic_store(xbar + w, 0u, __ATOMIC_RELAXED, __HIP_MEMORY_SCOPE_AGENT); }
  volatile LAS unsigned* xst = (volatile LAS unsigned*)(lds + LDS_BYTES_C - 16);
  if (threadIdx.x == 0) { xst[0] = 0u; xst[1] = 0u; }
#ifndef SKIP_PRO
  prologue(p, lds);
#endif
  grid.sync();
  XcdBarrier xb; xb.bar = xbar; xb.x = xb_xcc_id(); xb.st = xst;
  if (threadIdx.x == 0) (void)xb_add(&xbar[XB_XCNT(xb.x)], 1u);
#pragma unroll
  for (int layer = 0; layer < 4; ++layer) {
    const int i = layer >> 1; const bool odd = layer & 1;
#ifndef SKIP_ROW
    rowwise_phase(p, lds, layer - 1, layer);
#endif
    xcd_barrier(xb);
    {
#ifndef SKIP_SCAN
      if (odd && bid < 128) fox_scan(p, lds, bid);
#endif
      pg8::Gemm g; g.A = (const bf16_t*)(ws + WS_HBUF); g.lda = 1024; g.K = 1024; g.M = T;
      Epi e; e.out = (bf16_t*)(ws + WS_ZBUF); e.pin = nullptr; e.pslot = 0; e.nK = 0; e.qmode = 0; e.pout = odd ? nullptr : (float*)(ws + WS_PART); e.cosH = cosH; e.sinH = sinH; e.cosR = cosR; e.sinR = sinR;
      if (!odd) { g.Bt = (const bf16_t*)(ws + WS_WEVIN + i * SZ_WEVIN); g.N = 2560; e.ldc = 2560; e.rope64_end = 640; e.rope32_lo = 2432; e.rope32_hi = 2464; }
      else { g.Bt = (const bf16_t*)(ws + WS_WODIN + i * SZ_WODIN); g.N = 4096; e.ldc = 4096; e.rope64_end = 1024; e.rope32_lo = 0; e.rope32_hi = 0; }
      pg8::StaticOrder S; S.init(g.M, g.N, G, bid);
#ifndef SKIP_G1
      pg8::gemm_phase<Epi>(lds, g, S, e);
#endif
    }
    xcd_barrier(xb);
    if (!odd) {
      for (int which = 0; which < 2; ++which) {
        pg8::Gemm g; g.M = T; g.lda = 2560;
        Epi e; e.rope64_end = 0; e.rope32_lo = 0; e.rope32_hi = 0; e.cosH = cosH; e.sinH = sinH; e.cosR = cosR; e.sinR = sinR; e.pout = nullptr; e.pin = (const float*)(ws + WS_PART);
        if (which == 0) { g.A = (const bf16_t*)(ws + WS_ZBUF) + 1792; g.Bt = (const bf16_t*)(ws + WS_WUQ + i * SZ_WUQ); g.N = 768; g.K = 384;
          e.out = (bf16_t*)(ws + WS_QBUF); e.ldc = 768; e.qmode = 1; e.pslot = 0; e.nK = 384; }
        else { g.A = (const bf16_t*)(ws + WS_ZBUF) + 2176; g.Bt = (const bf16_t*)(ws + WS_WUKV + i * SZ_WUKV); g.N = 1024; g.K = 256;
          e.out = (bf16_t*)(ws + WS_HBUF); e.ldc = 1024; e.qmode = 0; e.pslot = 12; e.nK = 256; }
        pg8::StaticOrder S; S.init(g.M, g.N, G, bid);
#ifndef SKIP_G2
        pg8::gemm_phase<Epi>(lds, g, S, e);
#endif
      }
      xcd_barrier(xb);
#ifndef SKIP_ATTE
      attn_even(p, lds, i);
#endif
      xcd_barrier(xb);
    } else {
#ifndef SKIP_ATTO
      attn_odd(p, lds, layer);
#endif
      xcd_barrier(xb);
    }
    {
      pg8::Gemm g; g.A = (const bf16_t*)(ws + WS_OBUF); g.lda = 1024; g.K = 1024; g.M = T; g.N = 1024;
      g.Bt = (const bf16_t*)(ws + (odd ? WS_WODOUT : WS_WEVOUT) + i * SZ_WOUT);
      Epi e; e.out = (bf16_t*)(ws + WS_HBUF); e.ldc = 1024; e.pin = nullptr; e.pslot = 0; e.pout = nullptr; e.nK = 0; e.qmode = 0; e.rope64_end = 0; e.rope32_lo = 0; e.rope32_hi = 0;
      e.cosH = cosH; e.sinH = sinH; e.cosR = cosR; e.sinR = sinR;
      pg8::StaticOrder S; S.init(g.M, g.N, G, bid);
#ifndef SKIP_G3
      pg8::gemm_phase<Epi>(lds, g, S, e);
#endif
    }
    xcd_barrier(xb);
  }
#ifndef SKIP_ROW
  rowwise_phase(p, lds, 3, 4);
#endif
}

constexpr int LDS_BYTES = 155648;
static_assert(LDS_BYTES == LDS_BYTES_C, "LDS size mismatch");

extern "C" void kernel_launch(void* const* d_in, const int* in_sizes, int n_in, void* d_out, int out_size, void* d_ws, size_t ws_size, hipStream_t stream) {
  static int grid_blocks = 0;
  if (grid_blocks == 0) {
    int dev = 0, cus = 0, per_cu = 0;
    if (hipGetDevice(&dev) != hipSuccess || hipDeviceGetAttribute(&cus, hipDeviceAttributeMultiprocessorCount, dev) != hipSuccess) { fprintf(stderr, "device query failed\n"); grid_blocks = -1; return; }
    if (hipFuncSetAttribute((const void*)fwd_megakernel, hipFuncAttributeMaxDynamicSharedMemorySize, LDS_BYTES) != hipSuccess) { fprintf(stderr, "hipFuncSetAttribute failed\n"); grid_blocks = -1; return; }
    if (hipOccupancyMaxActiveBlocksPerMultiprocessor(&per_cu, (const void*)fwd_megakernel, 512, LDS_BYTES) != hipSuccess || per_cu < 1) { fprintf(stderr, "occupancy query: %d\n", per_cu); per_cu = 1; }
    (void)hipGetLastError();
    grid_blocks = cus;
    if (ws_size < WS_END) { fprintf(stderr, "workspace too small: %zu < %zu\n", ws_size, (size_t)WS_END); grid_blocks = -1; return; }
  }
  if (grid_blocks < 0) return;
  Params p{};
  const float** fp = (const float**)&p;
  for (int i = 0; i < 18; ++i) fp[i] = (const float*)d_in[i];
  p.out = (float*)d_out; p.ws = (unsigned char*)d_ws;
  void* args[] = {&p};
  hipError_t e = hipLaunchCooperativeKernel((const void*)fwd_megakernel, dim3(grid_blocks), dim3(512), args, LDS_BYTES, stream);
  if (e != hipSuccess) fprintf(stderr, "cooperative launch failed: %s (grid %d)\n", hipGetErrorString(e), grid_blocks);
}
```

```cpp
#include <hip/hip_runtime.h>
#include <hip/hip_cooperative_groups.h>
#include <cstdio>
#include <type_traits>
namespace cg = cooperative_groups;

#define DI __device__ __forceinline__
#define LAS __attribute__((address_space(3)))
typedef unsigned short bf16_t;
typedef short bf16x8 __attribute__((ext_vector_type(8)));
typedef short s16x4 __attribute__((ext_vector_type(4)));
typedef float f32x2 __attribute__((ext_vector_type(2)));
typedef float f32x4 __attribute__((ext_vector_type(4)));
typedef float f32x16 __attribute__((ext_vector_type(16)));
typedef unsigned u32x2 __attribute__((ext_vector_type(2)));
typedef unsigned u32x4 __attribute__((ext_vector_type(4)));
typedef __bf16 bf16x2_t __attribute__((ext_vector_type(2)));

constexpr int T = 32768, DM = 1024, NB = 16, SEQ = 2048;
constexpr float LOG2E = 1.4426950408889634f;
constexpr float EPS = 1e-6f;
constexpr int LDS_BYTES_C = 155648;

constexpr size_t SZ_WEVIN = 2560ull * 1024 * 2, SZ_WODIN = 4096ull * 1024 * 2, SZ_WUQ = 768ull * 384 * 2, SZ_WUKV = 1024ull * 256 * 2, SZ_WOUT = 1024ull * 1024 * 2;
constexpr size_t WS_WEVIN = 0;
constexpr size_t WS_WODIN = WS_WEVIN + 2 * SZ_WEVIN;
constexpr size_t WS_WUQ = WS_WODIN + 2 * SZ_WODIN;
constexpr size_t WS_WUKV = WS_WUQ + 2 * SZ_WUQ;
constexpr size_t WS_WEVOUT = WS_WUKV + 2 * SZ_WUKV;
constexpr size_t WS_WODOUT = WS_WEVOUT + 2 * SZ_WOUT;
constexpr size_t WS_MOD = WS_WODOUT + 2 * SZ_WOUT;
constexpr size_t WS_COSH = WS_MOD + 4ull * 16 * 3072 * 4;
constexpr size_t WS_SINH = WS_COSH + 2048ull * 32 * 4;
constexpr size_t WS_COSR = WS_SINH + 2048ull * 32 * 4;
constexpr size_t WS_SINR = WS_COSR + 2048ull * 16 * 4;
constexpr size_t WS_LOGF = WS_SINR + 2048ull * 16 * 4;
constexpr size_t WS_FCUM = WS_LOGF + (size_t)T * 8 * 4;
constexpr size_t WS_HBUF = (WS_FCUM + (size_t)T * 8 * 4 + 4095) & ~(size_t)4095;
constexpr size_t WS_OBUF = WS_HBUF + (size_t)T * 1024 * 2;
constexpr size_t WS_ZBUF = WS_OBUF + (size_t)T * 1024 * 2;
constexpr size_t WS_QBUF = WS_ZBUF + (size_t)T * 2560 * 2;
constexpr size_t WS_BAR = WS_ZBUF + (size_t)T * 4096 * 2;
constexpr size_t WS_PART = WS_BAR + 256;
constexpr size_t WS_XBAR = (WS_PART + (size_t)T * 20 * 4 + 4095) & ~(size_t)4095;
constexpr size_t WS_XBF_PRE = WS_XBAR + 16384;
constexpr size_t WS_XBF = WS_XBF_PRE;
constexpr size_t WS_END = WS_XBF + (size_t)T * 1024 * 2;

struct Params {
  const float *x, *c, *w_ada, *b_ada, *g_pre, *g_post, *ev_w_in, *ev_q_norm, *ev_kv_norm, *ev_w_uq, *ev_w_ukv, *ev_sinks, *ev_w_out,
      *od_w_in, *od_forget_bias, *od_lambda, *od_subln, *od_w_out;
  float* out;
  unsigned char* ws;
};

DI int opaque_tid() { int t = threadIdx.x; asm volatile("" : "+v"(t)); return t; }
DI float bflo(unsigned u) { return __uint_as_float(u << 16); }
DI float bfhi(unsigned u) { return __uint_as_float(u & 0xffff0000u); }
DI unsigned pk2(float lo, float hi) { f32x2 f = {lo, hi}; bf16x2_t b = __builtin_convertvector(f, bf16x2_t); return __builtin_bit_cast(unsigned, b); }
DI bf16_t f2bf(float f) { return (bf16_t)(pk2(f, 0.f) & 0xffffu); }
DI float fast_exp2(float x) { return __builtin_amdgcn_exp2f(x); }
DI float silu_f(float x) { return x * __builtin_amdgcn_rcpf(1.f + fast_exp2(-x * LOG2E)); }
DI float wave_sum(float v) {
#pragma unroll
  for (int o = 32; o >= 1; o >>= 1) v += __shfl_xor(v, o);
  return v;
}

namespace pg8 {
constexpr int BM = 256, BK = 64, HALF = 128, HTB = HALF * BK * 2, STAGE_BYTES = 8 * HTB, NXCD = 8, WGM = 8;
DI int lds_byte(int r, int c) { const int st = (r >> 4) * 2 + (c >> 5), rr = r & 15, cc = c & 31, ob = rr * 64 + cc * 2; return st * 1024 + (ob ^ (((ob >> 9) & 1) << 5)); }
DI void stage_rc(int b, int& R, int& C) { const int st = b / 1024, sb = b % 1024, swz = sb ^ (((sb >> 9) & 1) << 5); R = (st >> 1) * 16 + swz / 64; C = (st & 1) * 32 + (swz % 64) / 2; }
DI int perm32(int rho) { const int n = rho >> 4, i = rho & 15; return 8 * (i >> 2) + 4 * n + (i & 3); }
struct Unit { int pm, pn; };
struct Gemm { const bf16_t* A; const bf16_t* Bt; int M, N, K, lda; };
struct StaticOrder {
  int nM, nN, nwg, G, c;
  DI void init(int M, int N, int G_, int c_) { nM = M / BM; nN = N / BM; nwg = nM * nN; G = G_; c = c_; }
  DI bool next(int i, Unit& u) const {
    const long L = (long)i * G + c; if (L >= nwg) return false;
    int wgid = (int)L; { const int q = nwg / NXCD, r = nwg % NXCD, xcd = wgid % NXCD, off = wgid / NXCD; wgid = (xcd < r ? xcd * (q + 1) : r * (q + 1) + (xcd - r) * q) + off; }
    const int nig = WGM * nN, gid = wgid / nig, fm = gid * WGM, gsz = (nM - fm) < WGM ? (nM - fm) : WGM;
    u.pm = fm + ((wgid % nig) % gsz); u.pn = (wgid % nig) / gsz; return true;
  }
};

template <class Epi>
DI void gemm_phase(LAS unsigned char* lds, const Gemm g, const StaticOrder& S, const Epi& E) {
  const int tid = opaque_tid(), wid = __builtin_amdgcn_readfirstlane(tid >> 6), lane = tid & 63, wr = wid >> 2, wc = wid & 3, fr = lane & 15, fq = lane >> 4;
  const int K = g.K, nt = K / BK, lda = g.lda;
  unsigned voffA[2], voffB[2];
#pragma unroll
  for (int i = 0; i < 2; ++i) { int R, C; stage_rc(tid * 16 + i * 8192, R, C); const int Rb = (R & ~31) + perm32(R & 31);
    voffA[i] = (unsigned)(R * lda + C) * 2u; voffB[i] = (unsigned)(Rb * K + C) * 2u; }
  const size_t kstep = (size_t)(BK * 2);
  const size_t hstepA = (size_t)HALF * lda * 2, hstepB = (size_t)HALF * K * 2;
  const size_t tstepA = 2 * hstepA, tstepB = 2 * hstepB;
  const unsigned ldsw = (unsigned)wid * 1024u;
  const int aoff = lds_byte(wr * 64 + fr, fq * 8), boff = lds_byte(wc * 32 + fr, fq * 8);
#define PG8_SA(b, h) (((b) * 2 + (h)) * HTB)
#define PG8_SB(b, h) ((4 + (b) * 2 + (h)) * HTB)
#define PG8_STAGE(bufoff, gbase, voff) do { _Pragma("unroll") for (int _i = 0; _i < 2; ++_i) \
    __builtin_amdgcn_global_load_lds((const unsigned*)((const char*)(gbase) + (voff)[_i]), (LAS unsigned*)(lds + (bufoff) + ldsw + _i * 8192), 16, 0, 0); } while (0)
#define PG8_LDA(dst, b, h) do { _Pragma("unroll") for (int m = 0; m < 4; ++m) _Pragma("unroll") for (int k = 0; k < 2; ++k) dst[m][k] = *(const LAS bf16x8*)(lds + PG8_SA(b, h) + aoff + m * 2048 + k * 1024); } while (0)
#define PG8_LDB(dst, b, h) do { _Pragma("unroll") for (int n = 0; n < 2; ++n) _Pragma("unroll") for (int k = 0; k < 2; ++k) dst[n][k] = *(const LAS bf16x8*)(lds + PG8_SB(b, h) + boff + n * 2048 + k * 1024); } while (0)
#define PG8_MMA(ai, bj, At, Bt) do { __builtin_amdgcn_s_setprio(1); _Pragma("unroll") for (int m = 0; m < 4; ++m) _Pragma("unroll") for (int n = 0; n < 2; ++n) _Pragma("unroll") for (int k = 0; k < 2; ++k) \
    acc[ai][bj][m][n] = __builtin_amdgcn_mfma_f32_16x16x32_bf16(Bt[n][k], At[m][k], acc[ai][bj][m][n], 0, 0, 0); __builtin_amdgcn_s_setprio(0); } while (0)
#define PG8_WAIT_V(n) asm volatile("s_waitcnt vmcnt(" #n ")" ::: "memory")
#define PG8_WAIT_L(n) asm volatile("s_waitcnt lgkmcnt(" #n ")" ::: "memory")
#define PG8_BAR __builtin_amdgcn_s_barrier()
#define PG8_SCHED __builtin_amdgcn_sched_barrier(0)
  Unit cur, nxt; int ui = 0;
  if (!S.next(0, cur)) return;
  f32x4 acc[2][2][4][2];
#pragma unroll
  for (int a = 0; a < 2; ++a)
#pragma unroll
    for (int b = 0; b < 2; ++b)
#pragma unroll
      for (int m = 0; m < 4; ++m)
#pragma unroll
        for (int n = 0; n < 2; ++n) acc[a][b][m][n] = (f32x4){0.f, 0.f, 0.f, 0.f};
  bf16x8 At[4][2], B0[2][2], B1[2][2];
  const char* cA = (const char*)g.A + (size_t)cur.pm * tstepA; const char* cB = (const char*)g.Bt + (size_t)cur.pn * tstepB;
  PG8_STAGE(PG8_SB(0, 0), cB, voffB); PG8_STAGE(PG8_SA(0, 0), cA, voffA); PG8_STAGE(PG8_SB(0, 1), cB + hstepB, voffB); PG8_STAGE(PG8_SA(0, 1), cA + hstepA, voffA);
  if (wr == 1) PG8_BAR;
  PG8_WAIT_V(4); PG8_BAR;
  PG8_STAGE(PG8_SB(1, 0), cB + kstep, voffB); PG8_STAGE(PG8_SA(1, 0), cA + kstep, voffA); PG8_STAGE(PG8_SB(1, 1), cB + hstepB + kstep, voffB);
  PG8_WAIT_V(6); PG8_BAR;
  for (;;) {
    const bool has_next = S.next(ui + 1, nxt);
    const char* nA = has_next ? (const char*)g.A + (size_t)nxt.pm * tstepA : cA; const char* nB = has_next ? (const char*)g.Bt + (size_t)nxt.pn * tstepB : cB;
    for (int t = 0; t < nt; t += 2) {
      const bool last = (t == nt - 2);
      const char* a1 = cA + (size_t)(t + 1) * kstep;
      const char* a2 = last ? nA : cA + (size_t)(t + 2) * kstep; const char* b2 = last ? nB : cB + (size_t)(t + 2) * kstep;
      const char* a3 = a2 + kstep; const char* b3 = b2 + kstep;
      PG8_LDB(B0, 0, 0); PG8_SCHED; PG8_LDA(At, 0, 0); PG8_STAGE(PG8_SA(1, 1), a1 + hstepA, voffA);
      PG8_WAIT_L(8); PG8_BAR; PG8_WAIT_L(0); PG8_MMA(0, 0, At, B0); PG8_BAR; PG8_SCHED;
      PG8_LDB(B1, 0, 1); PG8_STAGE(PG8_SB(0, 0), b2, voffB);
      PG8_BAR; PG8_WAIT_L(0); PG8_MMA(0, 1, At, B1); PG8_BAR;
      PG8_LDA(At, 0, 1); PG8_STAGE(PG8_SA(0, 0), a2, voffA);
      PG8_BAR; PG8_WAIT_L(0); PG8_MMA(1, 0, At, B0); PG8_BAR; PG8_SCHED;
      PG8_STAGE(PG8_SB(0, 1), b2 + hstepB, voffB);
      PG8_WAIT_V(6); PG8_BAR; PG8_MMA(1, 1, At, B1); PG8_BAR;
      PG8_LDB(B0, 1, 0); PG8_SCHED; PG8_LDA(At, 1, 0); PG8_STAGE(PG8_SA(0, 1), a2 + hstepA, voffA);
      PG8_WAIT_L(8); PG8_BAR; PG8_WAIT_L(0); PG8_MMA(0, 0, At, B0); PG8_BAR; PG8_SCHED;
      PG8_LDB(B1, 1, 1); PG8_STAGE(PG8_SB(1, 0), b3, voffB);
      PG8_BAR; PG8_WAIT_L(0); PG8_MMA(0, 1, At, B1); PG8_BAR;
      PG8_LDA(At, 1, 1); PG8_STAGE(PG8_SA(1, 0), a3, voffA);
      PG8_BAR; PG8_WAIT_L(0); PG8_MMA(1, 0, At, B0); PG8_BAR; PG8_SCHED;
      PG8_STAGE(PG8_SB(1, 1), b3 + hstepB, voffB);
      PG8_WAIT_V(6); PG8_BAR; PG8_MMA(1, 1, At, B1); PG8_BAR;
    }
    E(acc, cur, wr, wc, fr, fq);
    if (!has_next) break;
#pragma unroll
    for (int a = 0; a < 2; ++a)
#pragma unroll
      for (int b = 0; b < 2; ++b)
#pragma unroll
        for (int m = 0; m < 4; ++m)
#pragma unroll
          for (int n = 0; n < 2; ++n) acc[a][b][m][n] = (f32x4){0.f, 0.f, 0.f, 0.f};
    cur = nxt; cA = nA; cB = nB; ++ui;
  }
  PG8_WAIT_V(0);
  if (wr == 0) PG8_BAR;
  PG8_BAR;
#undef PG8_SA
#undef PG8_SB
#undef PG8_STAGE
#undef PG8_LDA
#undef PG8_LDB
#undef PG8_MMA
#undef PG8_WAIT_V
#undef PG8_WAIT_L
#undef PG8_BAR
#undef PG8_SCHED
}
}

struct Epi {
  bf16_t* out; int ldc;
  int rope64_end;
  int rope32_lo, rope32_hi;
  int qmode;
  const float* pin; int nK;
  int pslot;
  float* pout;
  const float *cosH, *sinH, *cosR, *sinR;
  DI void operator()(const f32x4 (&acc)[2][2][4][2], const pg8::Unit& u, int wr, int wc, int fr, int fq) const {
    const int row0 = u.pm * 256 + wr * 64 + fr;
    int rt[2];
#pragma unroll
    for (int bj = 0; bj < 2; ++bj) {
      const int cw = u.pn * 256 + bj * 128 + wc * 32;
      rt[bj] = 0;
      if (cw < rope64_end) rt[bj] = 1;
      else if (cw >= rope32_lo && cw < rope32_hi) rt[bj] = 2;
      else if (qmode && ((cw >> 5) % 3) == 2) rt[bj] = 2;
    }
    const int tt = rt[0] | rt[1];
    const float* ctab = (tt == 1) ? cosH + (16 * (wc & 1) + 4 * fq) : cosR + 4 * fq;
    const float* stab = (tt == 1) ? sinH + (16 * (wc & 1) + 4 * fq) : sinR + 4 * fq;
    const int tstride = (tt == 1) ? 32 : 16;
    int ps[2] = {-1, -1};
    if (pout) {
#pragma unroll
      for (int bj = 0; bj < 2; ++bj) { const int cw = u.pn * 256 + bj * 128 + wc * 32;
        if (cw >= 1792 && cw < 2432) ps[bj] = ((cw - 1792) >> 7) * 4 + wc; }
    }
#pragma unroll
    for (int ai = 0; ai < 2; ++ai) {
      f32x4 cv[4], sv[4]; float rs[4];
#pragma unroll
      for (int m = 0; m < 4; ++m) {
        const int row = row0 + ai * 128 + m * 16;
        if (tt) { const int pos = row & (SEQ - 1); cv[m] = *(const f32x4*)(ctab + pos * tstride); sv[m] = *(const f32x4*)(stab + pos * tstride); }
        rs[m] = 1.f;
        if (pin) { const f32x4 p0 = *(const f32x4*)(pin + (size_t)row * 20 + pslot), p1 = *(const f32x4*)(pin + (size_t)row * 20 + pslot + 4);
          float ss = ((p0[0] + p0[1]) + (p0[2] + p0[3])) + ((p1[0] + p1[1]) + (p1[2] + p1[3]));
          if (nK == 384) { const f32x4 p2 = *(const f32x4*)(pin + (size_t)row * 20 + pslot + 8); ss += (p2[0] + p2[1]) + (p2[2] + p2[3]); }
          rs[m] = rsqrtf(ss / (float)nK + EPS); }
      }
#pragma unroll
      for (int m = 0; m < 4; ++m) {
        const int row = row0 + ai * 128 + m * 16;
#pragma unroll
        for (int bj = 0; bj < 2; ++bj) {
          const int c0 = u.pn * 256 + bj * 128 + wc * 32 + 8 * fq;
          f32x4 v0 = acc[ai][bj][m][0] * rs[m], v1 = acc[ai][bj][m][1] * rs[m];
          if (ps[bj] >= 0) {
            float sq = (v0[0] * v0[0] + v0[1] * v0[1]) + (v0[2] * v0[2] + v0[3] * v0[3]) + (v1[0] * v1[0] + v1[1] * v1[1]) + (v1[2] * v1[2] + v1[3] * v1[3]);
            sq += __shfl_xor(sq, 16); sq += __shfl_xor(sq, 32);
            if (fq == 0) pout[(size_t)row * 20 + ps[bj]] = sq;
          }
          if (rt[bj]) {
            const f32x4 o1 = v0 * cv[m] - v1 * sv[m], o2 = v1 * cv[m] + v0 * sv[m];
            v0 = o1; v1 = o2;
          }
          u32x4 w; w.x = pk2(v0[0], v0[1]); w.y = pk2(v0[2], v0[3]); w.z = pk2(v1[0], v1[1]); w.w = pk2(v1[2], v1[3]);
          *(u32x4*)(out + (size_t)row * ldc + c0) = w;
        }
      }
    }
  }
};

DI int ropeperm64(int p) { const int g = p >> 3, r = p & 7; return r < 4 ? 4 * g + r : 32 + 4 * g + (r - 4); }
DI int ropeperm32(int p) { const int g = p >> 3, r = p & 7; return r < 4 ? 4 * g + r : 16 + 4 * g + (r - 4); }
DI int srccol(int kind, int n) {
  if (kind == 0) {
    if (n < 512) return 672 + (n & ~63) + ropeperm64(n & 63);
    if (n < 640) return 1184 + ((n - 512) & ~63) + ropeperm64(n & 63);
    if (n < 768) return 1312 + (n - 640);
    if (n < 1792) return 1440 + (n - 768);
    if (n < 2176) return n - 1792;
    if (n < 2432) return 384 + (n - 2176);
    if (n < 2464) return 640 + ropeperm32(n - 2432);
    return -1;
  }
  if (kind == 1) {
    if (n < 1024) return (n & ~63) + ropeperm64(n & 63);
    if (n < 3072) return n;
    return 3080 + (n - 3072);
  }
  if (kind == 2) { const int hd = n / 96, p = n - hd * 96; return hd * 96 + (p < 64 ? p : 64 + ropeperm32(p - 64)); }
  return n;
}
DI void convert_tile(LAS unsigned char* lds, const float* W, int Nsrc, int K, bf16_t* Wt, int kind, const float* g, int tn, int tk) {
  const int tid = opaque_tid();
  LAS bf16_t* tile = (LAS bf16_t*)lds;
  const int nl = tid & 63, ks = tid >> 6;
  const int sc = srccol(kind, tn * 64 + nl);
#pragma unroll
  for (int kk = ks; kk < 64; kk += 8) {
    const int k = tk * 64 + kk;
    float v = 0.f;
    if (sc >= 0) { v = W[(size_t)k * Nsrc + sc]; if (g) v *= g[k]; }
    tile[nl * 72 + kk] = f2bf(v);
  }
  __syncthreads();
  { const int n2 = tid >> 3, ch = tid & 7;
    const u32x4 v = *(const LAS u32x4*)(tile + n2 * 72 + ch * 8);
    *(u32x4*)(Wt + (size_t)(tn * 64 + n2) * K + tk * 64 + ch * 8) = v; }
  __syncthreads();
}

DI void prologue(const Params& p, LAS unsigned char* lds) {
  const int tid = opaque_tid(), G = gridDim.x, bid = blockIdx.x;
  unsigned char* ws = p.ws;
  for (int idx = bid * 512 + tid; idx < 2048 * 48; idx += G * 512) {
    const bool isH = idx < 2048 * 32;
    const int j = isH ? idx : idx - 2048 * 32;
    const int pos = isH ? (j >> 5) : (j >> 4), i = isH ? (j & 31) : (j & 15);
    const float e = isH ? (float)(2 * i) * (1.f / 64.f) : (float)(2 * i) * (1.f / 32.f);
    const float inv = fast_exp2(-e * 13.287712379549449f);
    const float ang = (float)pos * inv;
    double t = (double)ang * 0.15915494309189535; t -= rint(t);
    const float fr = (float)t;
    const float cv = __builtin_amdgcn_cosf(fr), sv = __builtin_amdgcn_sinf(fr);
    if (isH) { ((float*)(ws + WS_COSH))[j] = cv; ((float*)(ws + WS_SINH))[j] = sv; }
    else { ((float*)(ws + WS_COSR))[j] = cv; ((float*)(ws + WS_SINR))[j] = sv; }
  }
  constexpr int NT0 = 40 * 16, NT1 = 64 * 16, NT2 = 12 * 6, NT3 = 16 * 4, NT4 = 16 * 16;
  constexpr int PER_I = NT0 + NT1 + NT2 + NT3 + 2 * NT4;
  for (int job = bid; job < 2 * PER_I; job += G) {
    const int i = job / PER_I; int j = job - i * PER_I;
    if (j < NT0) { convert_tile(lds, p.ev_w_in + (size_t)i * 1024 * 2464, 2464, 1024, (bf16_t*)(ws + WS_WEVIN + i * SZ_WEVIN), 0, nullptr, j / 16, j % 16); continue; }
    j -= NT0;
    if (j < NT1) { convert_tile(lds, p.od_w_in + (size_t)i * 1024 * 4104, 4104, 1024, (bf16_t*)(ws + WS_WODIN + i * SZ_WODIN), 1, nullptr, j / 16, j % 16); continue; }
    j -= NT1;
    if (j < NT2) { convert_tile(lds, p.ev_w_uq + (size_t)i * 384 * 768, 768, 384, (bf16_t*)(ws + WS_WUQ + i * SZ_WUQ), 2, p.ev_q_norm + i * 384, j / 6, j % 6); continue; }
    j -= NT2;
    if (j < NT3) { convert_tile(lds, p.ev_w_ukv + (size_t)i * 256 * 1024, 1024, 256, (bf16_t*)(ws + WS_WUKV + i * SZ_WUKV), 3, p.ev_kv_norm + i * 256, j / 4, j % 4); continue; }
    j -= NT3;
    if (j < NT4) { convert_tile(lds, p.ev_w_out + (size_t)i * 1024 * 1024, 1024, 1024, (bf16_t*)(ws + WS_WEVOUT + i * SZ_WOUT), 4, nullptr, j / 16, j % 16); continue; }
    j -= NT4;
    convert_tile(lds, p.od_w_out + (size_t)i * 1024 * 1024, 1024, 1024, (bf16_t*)(ws + WS_WODOUT + i * SZ_WOUT), 4, nullptr, j / 16, j % 16);
  }
  const int item0 = G - 1 - bid;
  if (item0 < 192) {
    LAS float* cond = (LAS float*)lds;
    LAS float* red = (LAS float*)(lds + 65536);
    for (int e = tid; e < 16 * 1024; e += 512) { const int b = e >> 10, k = e & 1023; cond[k * 16 + b] = silu_f(p.c[e]); }
    __syncthreads();
    for (int item = item0; item < 192; item += G) {
      const int l = item / 48, n0 = (item % 48) * 64;
      const int col = tid & 63, kg = tid >> 6;
      float a[16];
#pragma unroll
      for (int b = 0; b < 16; ++b) a[b] = 0.f;
      const float* wp = p.w_ada + (size_t)l * 1024 * 3072 + n0 + col;
      for (int k = kg * 128; k < kg * 128 + 128; ++k) {
        const float w = wp[(size_t)k * 3072];
#pragma unroll
        for (int b4 = 0; b4 < 4; ++b4) { const f32x4 cv = *(const LAS f32x4*)(cond + k * 16 + b4 * 4);
          a[b4 * 4 + 0] += cv[0] * w; a[b4 * 4 + 1] += cv[1] * w; a[b4 * 4 + 2] += cv[2] * w; a[b4 * 4 + 3] += cv[3] * w; }
      }
#pragma unroll
      for (int b = 0; b < 16; ++b) red[(kg * 16 + b) * 64 + col] = a[b];
      __syncthreads();
      for (int e = tid; e < 1024; e += 512) { const int b = e >> 6, cc = e & 63; float s = 0.f;
#pragma unroll
        for (int k8 = 0; k8 < 8; ++k8) s += red[(k8 * 16 + b) * 64 + cc];
        ((float*)(ws + WS_MOD))[((size_t)l * 16 + b) * 3072 + n0 + cc] = s + p.b_ada[l * 3072 + n0 + cc]; }
      __syncthreads();
    }
  }
}

DI void rowwise_phase(const Params& p, LAS unsigned char* lds, int lp, int ln) {
  const int tid = opaque_tid(), lane = tid & 63, wid = tid >> 6;
  const int gw = blockIdx.x * 8 + wid, nw = gridDim.x * 8;
  unsigned char* ws = p.ws;
  const float* mod = (const float*)(ws + WS_MOD);
  const bf16_t* ybuf = (const bf16_t*)(ws + WS_HBUF);
  bf16_t* hbuf = (bf16_t*)(ws + WS_HBUF);
  const bool ff = (ln < 4) && (ln & 1);
  LAS f32x4* wl = (LAS f32x4*)lds;
  if (ff) {
    const float* w = p.od_w_in + (size_t)(ln >> 1) * 1024 * 4104 + 3072;
    for (int c = tid; c < 1024; c += 512) {
      const f32x4 w0 = *(const f32x4*)(w + (size_t)c * 4104), w1 = *(const f32x4*)(w + (size_t)c * 4104 + 4);
      const int ln_ = (c & 255) >> 2, e = c & 3, j = c >> 8;
      wl[(j * 4 + e) * 64 + ln_] = w0; wl[1024 + (j * 4 + e) * 64 + ln_] = w1;
    }
    __syncthreads();
  }
  for (int row = gw; row < T; row += nw) {
    const int b = row >> 11;
    f32x4 xv[4];
    bf16_t* xbf = (bf16_t*)(ws + WS_XBF) + (size_t)row * DM;
    if (lp <= 0) {
      const float* xin = p.x + (size_t)row * DM;
#pragma unroll
      for (int j = 0; j < 4; ++j) xv[j] = *(const f32x4*)(xin + 4 * lane + 256 * j);
    } else {
#pragma unroll
      for (int j = 0; j < 4; ++j) { const u32x2 u = *(const u32x2*)(xbf + 4 * lane + 256 * j); xv[j] = (f32x4){bflo(u.x), bfhi(u.x), bflo(u.y), bfhi(u.y)}; }
    }
    if (lp >= 0) {
      f32x4 yv[4]; float ss = 0.f;
#pragma unroll
      for (int j = 0; j < 4; ++j) { const u32x2 u = *(const u32x2*)(ybuf + (size_t)row * DM + 4 * lane + 256 * j);
        yv[j] = (f32x4){bflo(u.x), bfhi(u.x), bflo(u.y), bfhi(u.y)}; ss += yv[j][0] * yv[j][0] + yv[j][1] * yv[j][1] + yv[j][2] * yv[j][2] + yv[j][3] * yv[j][3]; }
      ss = wave_sum(ss);
      const float rs = rsqrtf(ss * (1.f / DM) + EPS);
#pragma unroll
      for (int j = 0; j < 4; ++j) {
        const int c = 4 * lane + 256 * j;
        const f32x4 gt = *(const f32x4*)(mod + ((size_t)lp * 16 + b) * 3072 + 2048 + c);
        const f32x4 gp = *(const f32x4*)(p.g_post + lp * DM + c);
        xv[j] = xv[j] + gt * (yv[j] * rs * gp);
        if (ln >= 4) *(f32x4*)(p.out + (size_t)row * DM + c) = xv[j];
        else { u32x2 w; w.x = pk2(xv[j][0], xv[j][1]); w.y = pk2(xv[j][2], xv[j][3]); *(u32x2*)(xbf + c) = w; }
      }
    }
    if (ln < 4) {
      float ss = 0.f;
#pragma unroll
      for (int j = 0; j < 4; ++j) ss += xv[j][0] * xv[j][0] + xv[j][1] * xv[j][1] + xv[j][2] * xv[j][2] + xv[j][3] * xv[j][3];
      ss = wave_sum(ss);
      const float rs = rsqrtf(ss * (1.f / DM) + EPS);
      float zf[8];
#pragma unroll
      for (int h = 0; h < 8; ++h) zf[h] = 0.f;
#pragma unroll
      for (int j = 0; j < 4; ++j) {
        const int c = 4 * lane + 256 * j;
        const f32x4 sh = *(const f32x4*)(mod + ((size_t)ln * 16 + b) * 3072 + c);
        const f32x4 sc = *(const f32x4*)(mod + ((size_t)ln * 16 + b) * 3072 + 1024 + c);
        const f32x4 gp = *(const f32x4*)(p.g_pre + ln * DM + c);
        const f32x4 hv = (xv[j] * rs * gp) * (sc + 1.f) + sh;
        u32x2 w; w.x = pk2(hv[0], hv[1]); w.y = pk2(hv[2], hv[3]);
        *(u32x2*)(hbuf + (size_t)row * DM + c) = w;
        if (ff) {
#pragma unroll
          for (int e = 0; e < 4; ++e) {
            const f32x4 w0 = wl[(j * 4 + e) * 64 + lane], w1 = wl[1024 + (j * 4 + e) * 64 + lane];
            zf[0] += hv[e] * w0[0]; zf[1] += hv[e] * w0[1]; zf[2] += hv[e] * w0[2]; zf[3] += hv[e] * w0[3];
            zf[4] += hv[e] * w1[0]; zf[5] += hv[e] * w1[1]; zf[6] += hv[e] * w1[2]; zf[7] += hv[e] * w1[3];
          }
        }
      }
      if (ff) {
        const bool b5 = lane & 32, b4 = lane & 16, b3 = lane & 8;
        float w4[4], u2[2], t;
#pragma unroll
        for (int k = 0; k < 4; ++k) { const float send = b5 ? zf[k] : zf[4 + k], keep = b5 ? zf[4 + k] : zf[k]; w4[k] = keep + __shfl_xor(send, 32); }
#pragma unroll
        for (int k = 0; k < 2; ++k) { const float send = b4 ? w4[k] : w4[2 + k], keep = b4 ? w4[2 + k] : w4[k]; u2[k] = keep + __shfl_xor(send, 16); }
        { const float send = b3 ? u2[0] : u2[1], keep = b3 ? u2[1] : u2[0]; t = keep + __shfl_xor(send, 8); }
        t += __shfl_xor(t, 4); t += __shfl_xor(t, 2); t += __shfl_xor(t, 1);
        if ((lane & 7) == 0) {
          const int h = lane >> 3;
          const float z = t + p.od_forget_bias[(ln >> 1) * 8 + h];
          const float ls = fminf(z, 0.f) - __builtin_amdgcn_logf(1.f + fast_exp2(-fabsf(z) * LOG2E)) * 0.6931471805599453f;
          ((float*)(ws + WS_LOGF))[(size_t)row * 8 + h] = ls;
        }
      }
    }
  }
  __syncthreads();
}

DI void fox_scan(const Params& p, LAS unsigned char* lds, int bh) {
  const int tid = opaque_tid();
  const int b = bh >> 3, h = bh & 7;
  const float* logf_ = (const float*)(p.ws + WS_LOGF);
  float* fcum = (float*)(p.ws + WS_FCUM) + (size_t)bh * SEQ;
  LAS float* s = (LAS float*)lds;
  float v[4];
#pragma unroll
  for (int j = 0; j < 4; ++j) v[j] = logf_[((size_t)b * SEQ + 4 * tid + j) * 8 + h];
  v[1] += v[0]; v[2] += v[1]; v[3] += v[2];
  s[tid] = v[3];
  __syncthreads();
  for (int off = 1; off < 512; off <<= 1) {
    float t = 0.f;
    if (tid >= off) t = s[tid - off];
    __syncthreads();
    s[tid] += t;
    __syncthreads();
  }
  const float excl = s[tid] - v[3];
#pragma unroll
  for (int j = 0; j < 4; ++j) fcum[4 * tid + j] = -8.0f * (excl + v[j]);
  __syncthreads();
}

struct AttnArgs { const bf16_t *q, *k, *k2, *v, *gate; bf16_t* out; const float* fcum; int ldq, ldk, ldk2, ldv, ldo, ldg; float sl2, sink; };

DI float half_max(float x) {
  const unsigned u = __float_as_uint(x);
  auto r = __builtin_amdgcn_permlane32_swap(u, u, false, false);
  return fmaxf(__uint_as_float(r[0]), __uint_as_float(r[1]));
}
DI float half_sum(float x) {
  const unsigned u = __float_as_uint(x);
  auto r = __builtin_amdgcn_permlane32_swap(u, u, false, false);
  return __uint_as_float(r[0]) + __uint_as_float(r[1]);
}

template <int N> DI void wait_vmcnt() { asm volatile("s_waitcnt vmcnt(%0)" ::"n"(N) : "memory"); }
DI void raw_barrier() { asm volatile("" ::: "memory"); __builtin_amdgcn_s_barrier(); asm volatile("" ::: "memory"); }

template <int DQK, int DV, int MODE>
DI void attn_item(LAS unsigned char* lds, const AttnArgs& a, int qb) {
  constexpr int KSTR = DQK * 2 + 16, VSTR = (DV == 64) ? 192 : 320;
  constexpr int KG16 = KSTR / 16, VG16 = VSTR / 16;
  constexpr int KCH = KG16, VCH = VG16, NCH = KCH + VCH;
  constexpr int TILE = NCH * 1024 + (MODE == 2 ? 2048 : 0);
  constexpr int NSLOT = (NCH + 7) / 8, REM = NCH - 8 * (NSLOT - 1);
  constexpr int FX = (MODE == 2) ? 1 : 0;
  constexpr int NKS = DQK / 16, NBLK = DV / 32;
  static_assert(5 * TILE <= 155648, "ring too large");
  const int tid = opaque_tid(), wid = __builtin_amdgcn_readfirstlane(tid >> 6), lane = tid & 63, r = lane & 31, hh = lane >> 5;
  const int q0 = qb * 256, qw = q0 + 32 * wid, myq = qw + r;
  const float c = a.sl2, tau = 8.0f / a.sl2;
  bf16x8 qf[NKS];
#pragma unroll
  for (int ks = 0; ks < NKS; ++ks) qf[ks] = *(const bf16x8*)(a.q + (size_t)myq * a.ldq + 16 * ks + 8 * hh);
  int lo = 0; const int hi = 4 * (qb + 1);
  if (MODE == 1) { lo = 4 * qb - 2; if (lo < 0) lo = 0; }
  const int last_w = (qw + 31) >> 6;
  int first_w = 0;
  if (MODE == 1) { first_w = (qw > 127 ? qw - 127 : 0) >> 6; }
  const char* sp[NSLOT]; unsigned sst[NSLOT];
#pragma unroll
  for (int j = 0; j < NSLOT; ++j) {
    const int ch_ = 8 * j + wid;
    if (ch_ < KCH) {
      const int p = ch_ * 64 + lane, row = p / KG16, g = p - row * KG16;
      if (DQK == 96 && g >= 8 && g < 12) { sp[j] = (const char*)(a.k2 + (size_t)row * a.ldk2 + 8 * (g - 8)); sst[j] = (unsigned)(128 * a.ldk2); }
      else { sp[j] = (const char*)(a.k + (size_t)row * a.ldk + 8 * (g < 8 ? g : 0)); sst[j] = (unsigned)(128 * a.ldk); }
    } else {
      const int p = (ch_ - KCH) * 64 + lane, row = (p / VG16) & 63, g = p - (p / VG16) * VG16;
      sp[j] = (const char*)(a.v + (size_t)row * a.ldv + 8 * (g < DV / 8 ? g : 0)); sst[j] = (unsigned)(128 * a.ldv);
    }
  }
  auto issue = [&](int kt) {
    LAS unsigned char* base = lds + (kt % 5) * TILE;
#pragma unroll
    for (int j = 0; j < NSLOT; ++j) {
      if (j < NSLOT - 1 || wid < REM)
        __builtin_amdgcn_global_load_lds((const unsigned*)(sp[j] + (size_t)kt * sst[j]), (LAS unsigned*)(base + (8 * j + wid) * 1024), 16, 0, 0);
    }
    if (MODE == 2) __builtin_amdgcn_global_load_lds((const unsigned*)(a.fcum + kt * 64 + lane), (LAS unsigned*)(base + NCH * 1024 + wid * 256), 4, 0, 0);
  };
  auto wait_tiles = [&](bool all) {
    if (all) wait_vmcnt<0>();
    else if (wid < REM) wait_vmcnt<NSLOT + FX>();
    else wait_vmcnt<NSLOT - 1 + FX>();
  };
  f32x16 O[NBLK];
#pragma unroll
  for (int bl = 0; bl < NBLK; ++bl)
#pragma unroll
    for (int i = 0; i < 16; ++i) O[bl][i] = 0.f;
  float m = (MODE == 1) ? a.sink / a.sl2 : -1e30f;
  float l0 = (MODE == 1 && hh == 0) ? 1.f : 0.f, l1 = 0.f;
  const int i16 = lane & 15, q4 = i16 >> 2, p4 = i16 & 3, grp = (lane >> 4) & 1;
  auto qk_load = [&](int kt, bf16x8 (&kf)[2][NKS]) {
    LAS unsigned char* Kl = lds + (kt % 5) * TILE;
#pragma unroll
    for (int kb = 0; kb < 2; ++kb)
#pragma unroll
      for (int ks = 0; ks < NKS; ++ks) kf[kb][ks] = *(const LAS bf16x8*)(Kl + (32 * kb + r) * KSTR + (16 * ks + 8 * hh) * 2);
  };
  auto qk_mma = [&](int kt, const bf16x8 (&kf)[2][NKS], f32x16 (&s)[2]) {
#pragma unroll
    for (int kb = 0; kb < 2; ++kb) {
      if (MODE == 2) {
        LAS unsigned char* Fl = lds + (kt % 5) * TILE + NCH * 1024 + wid * 256;
#pragma unroll
        for (int g = 0; g < 4; ++g) { const f32x4 fb = *(const LAS f32x4*)(Fl + (32 * kb + 8 * g + 4 * hh) * 4);
          s[kb][4 * g] = fb[0]; s[kb][4 * g + 1] = fb[1]; s[kb][4 * g + 2] = fb[2]; s[kb][4 * g + 3] = fb[3]; }
      } else {
#pragma unroll
        for (int i = 0; i < 16; ++i) s[kb][i] = 0.f;
      }
    }
#pragma unroll
    for (int ks = 0; ks < NKS; ++ks)
#pragma unroll
      for (int kb = 0; kb < 2; ++kb) s[kb] = __builtin_amdgcn_mfma_f32_32x32x16_bf16(kf[kb][ks], qf[ks], s[kb], 0, 0, 0);
  };
  auto softmax = [&](int kt, f32x16 (&s)[2], bf16x8 (&pf)[2][2], auto maskc) {
    constexpr bool MASK = decltype(maskc)::value;
    const int key0 = kt * 64;
    if (MASK) {
#pragma unroll
      for (int kb = 0; kb < 2; ++kb)
#pragma unroll
        for (int i = 0; i < 16; ++i) {
          const int key = key0 + 32 * kb + (i & 3) + 8 * (i >> 2) + 4 * hh;
          bool valid = key <= myq; if (MODE == 1) valid = valid && (myq - key < 128);
          s[kb][i] = valid ? s[kb][i] : -1e30f;
        }
    }
    float mx = fmaxf(s[0][0], s[1][0]);
#pragma unroll
    for (int i = 1; i < 16; ++i) mx = fmaxf(fmaxf(mx, s[0][i]), s[1][i]);
    mx = half_max(mx);
    if (__builtin_amdgcn_ballot_w64(mx > m + tau) != 0ull) {
      const float mnew = fmaxf(m, mx);
      const float alpha = fast_exp2((m - mnew) * c);
      m = mnew;
      l0 *= alpha; l1 *= alpha;
#pragma unroll
      for (int bl = 0; bl < NBLK; ++bl)
#pragma unroll
        for (int i = 0; i < 16; ++i) O[bl][i] *= alpha;
    }
    const float nmc = -m * c;
#pragma unroll
    for (int kb = 0; kb < 2; ++kb)
#pragma unroll
      for (int s2 = 0; s2 < 2; ++s2) {
        float pv[8];
#pragma unroll
        for (int e = 0; e < 8; ++e) pv[e] = fast_exp2(__builtin_fmaf(s[kb][8 * s2 + e], c, nmc));
        l0 += (pv[0] + pv[4]) + (pv[2] + pv[6]); l1 += (pv[1] + pv[5]) + (pv[3] + pv[7]);
        u32x4 w;
        w.x = pk2(pv[0], pv[1]); w.y = pk2(pv[2], pv[3]); w.z = pk2(pv[4], pv[5]); w.w = pk2(pv[6], pv[7]);
        pf[kb][s2] = __builtin_bit_cast(bf16x8, w);
      }
  };
  auto pvmm = [&](int kt, const bf16x8 (&pf)[2][2]) {
    constexpr int PD = (NBLK == 2) ? 2 : 1;
    const unsigned va = (unsigned)(size_t)(lds + (kt % 5) * TILE + KCH * 1024 + (4 * hh + q4) * VSTR + (16 * grp) * 2 + 8 * p4);
    s16x4 vl[PD + 1][NBLK], vh[PD + 1][NBLK];
#define TRRD(dst, off) asm volatile("ds_read_b64_tr_b16 %0, %1 offset:%2" : "=&v"(dst) : "v"(va), "n"(off) : "memory")
#define TRSTEP(st_) do { _Pragma("unroll") for (int bl = 0; bl < NBLK; ++bl) { TRRD(vl[(st_) % (PD + 1)][bl], 16 * (st_) * VSTR + 64 * bl); TRRD(vh[(st_) % (PD + 1)][bl], 16 * (st_) * VSTR + 64 * bl + 8 * VSTR); } } while (0)
#define TRWAIT(n_, b_) do { if (NBLK == 2) asm volatile("s_waitcnt lgkmcnt(" #n_ ")" : "+v"(vl[b_][0]), "+v"(vh[b_][0]), "+v"(vl[b_][1]), "+v"(vh[b_][1])::"memory"); \
    else asm volatile("s_waitcnt lgkmcnt(" #n_ ")" : "+v"(vl[b_][0]), "+v"(vh[b_][0]), "+v"(vl[b_][1]), "+v"(vh[b_][1]), "+v"(vl[b_][2 % NBLK]), "+v"(vh[b_][2 % NBLK]), "+v"(vl[b_][3 % NBLK]), "+v"(vh[b_][3 % NBLK])::"memory"); } while (0)
#pragma unroll
    for (int st = 0; st < PD; ++st) TRSTEP(st);
#pragma unroll
    for (int st = 0; st < 4; ++st) {
      if (st + PD < 4) TRSTEP(st + PD);
      const int ahead = ((st + PD < 4) ? st + PD : 3) - st;
      const int b_ = st % (PD + 1);
      if (ahead * 2 * NBLK == 8) TRWAIT(8, b_); else if (ahead * 2 * NBLK == 4) TRWAIT(4, b_); else TRWAIT(0, b_);
#pragma unroll
      for (int bl = 0; bl < NBLK; ++bl) {
        const bf16x8 vf = __builtin_shufflevector(vl[b_][bl], vh[b_][bl], 0, 1, 2, 3, 4, 5, 6, 7);
        O[bl] = __builtin_amdgcn_mfma_f32_32x32x16_bf16(vf, pf[st >> 1][st & 1], O[bl], 0, 0, 0);
      }
    }
#undef TRRD
#undef TRSTEP
#undef TRWAIT
  };
  auto act = [&](int kt) { return kt <= last_w && kt >= first_w; };
  f32x16 sA[2];
  const bool halfB = wid >= 4;
  issue(lo);
  if (lo + 1 < hi) issue(lo + 1);
  if (lo + 2 < hi) issue(lo + 2);
  if (lo + 3 < hi) issue(lo + 3);
  wait_tiles(!(lo + 3 < hi));
  raw_barrier();
  if (halfB) raw_barrier();
  if (act(lo)) { bf16x8 kf0[2][NKS]; qk_load(lo, kf0); qk_mma(lo, kf0, sA); }
  auto step = [&](int kt, auto maskc) {
    const bool a0 = act(kt), a1 = (kt + 1 < hi) && act(kt + 1);
    bf16x8 pf[2][2], kf[2][NKS];
    if (a1) qk_load(kt + 1, kf);
    __builtin_amdgcn_sched_barrier(0);
    if (a0) softmax(kt, sA, pf, maskc);
    wait_tiles(!(kt + 3 < hi));
    raw_barrier();
    if (kt + 4 < hi) issue(kt + 4);
    __builtin_amdgcn_s_setprio(1);
    if (a1) qk_mma(kt + 1, kf, sA);
    if (a0) pvmm(kt, pf);
    __builtin_amdgcn_s_setprio(0);
    raw_barrier();
  };
  int split = lo;
  if (MODE != 1) { split = qw >> 6; if (split < lo) split = lo; if (split > hi) split = hi; }
  if (MODE != 1) { for (int kt = lo; kt < split; ++kt) step(kt, std::false_type{}); }
  for (int kt = split; kt < hi; ++kt) step(kt, std::true_type{});
  if (!halfB) raw_barrier();
  const float l = half_sum(l0 + l1);
  const float inv = 1.f / l;
#pragma unroll
  for (int bl = 0; bl < NBLK; ++bl)
#pragma unroll
    for (int g = 0; g < 4; ++g) {
      const int f = 32 * bl + 8 * g + 4 * hh;
      float o0 = O[bl][4 * g + 0] * inv, o1 = O[bl][4 * g + 1] * inv, o2 = O[bl][4 * g + 2] * inv, o3 = O[bl][4 * g + 3] * inv;
      if (a.gate) {
        const u32x2 gv = *(const u32x2*)(a.gate + (size_t)myq * a.ldg + f);
        o0 *= silu_f(bflo(gv.x)); o1 *= silu_f(bfhi(gv.x)); o2 *= silu_f(bflo(gv.y)); o3 *= silu_f(bfhi(gv.y));
      }
      u32x2 w; w.x = pk2(o0, o1); w.y = pk2(o2, o3);
      *(u32x2*)(a.out + (size_t)myq * a.ldo + f) = w;
    }
}


DI void swa_item(LAS unsigned char* lds, const AttnArgs& a, const float* sinks4, int qb) {
  constexpr int KSTR = 144, VSTR = 192, KCH = 9, VCH = 12, NCH = 21, TILE = NCH * 1024, NSLOT = 3, REM = 5, NKS = 4, NBLK = 2;
  const int tid = opaque_tid(), wid = __builtin_amdgcn_readfirstlane(tid >> 6), lane = tid & 63, r = lane & 31, hh = lane >> 5;
  const int q0 = qb * 256, qw = q0 + 32 * wid, myq = qw + r;
  const float c = a.sl2, tau = 8.0f / a.sl2;
  int lo = 4 * qb - 2; if (lo < 0) lo = 0;
  const int hi = 4 * (qb + 1);
  const int last_w = (qw + 31) >> 6, first_w = (qw > 127 ? qw - 127 : 0) >> 6;
#pragma unroll
  for (int j = 0; j < NSLOT; ++j) {
    const int ch_ = 8 * j + wid;
    if (j < NSLOT - 1 || wid < REM) {
      const char* sp; unsigned sst;
      if (ch_ < KCH) { const int p = ch_ * 64 + lane, row = p / 9, g = p - row * 9;
        sp = (const char*)(a.k + (size_t)row * a.ldk + 8 * (g < 8 ? g : 0)); sst = (unsigned)(128 * a.ldk); }
      else { const int p = (ch_ - KCH) * 64 + lane, row = (p / 12) & 63, g = p - (p / 12) * 12;
        sp = (const char*)(a.v + (size_t)row * a.ldv + 8 * (g < 8 ? g : 0)); sst = (unsigned)(128 * a.ldv); }
      for (int kt = lo; kt < hi; ++kt)
        __builtin_amdgcn_global_load_lds((const unsigned*)(sp + (size_t)kt * sst), (LAS unsigned*)(lds + (kt - lo) * TILE + ch_ * 1024), 16, 0, 0);
    }
  }
  wait_vmcnt<0>();
  raw_barrier();
  const int i16 = lane & 15, q4 = i16 >> 2, p4 = i16 & 3, grp = (lane >> 4) & 1;
  for (int h4 = 0; h4 < 4; ++h4) {
    bf16x8 qf[NKS];
#pragma unroll
    for (int ks = 0; ks < NKS; ++ks) qf[ks] = *(const bf16x8*)(a.q + (size_t)myq * a.ldq + h4 * 64 + 16 * ks + 8 * hh);
    f32x16 O[NBLK];
#pragma unroll
    for (int bl = 0; bl < NBLK; ++bl)
#pragma unroll
      for (int i = 0; i < 16; ++i) O[bl][i] = 0.f;
    float m = sinks4[h4] / a.sl2;
    float l0 = (hh == 0) ? 1.f : 0.f, l1 = 0.f;
    for (int kt = first_w; kt <= last_w; ++kt) {
      LAS unsigned char* Kl = lds + (kt - lo) * TILE;
      f32x16 s[2];
      bf16x8 kf[2][NKS];
#pragma unroll
      for (int kb = 0; kb < 2; ++kb)
#pragma unroll
        for (int ks = 0; ks < NKS; ++ks) kf[kb][ks] = *(const LAS bf16x8*)(Kl + (32 * kb + r) * KSTR + (16 * ks + 8 * hh) * 2);
#pragma unroll
      for (int kb = 0; kb < 2; ++kb)
#pragma unroll
        for (int i = 0; i < 16; ++i) s[kb][i] = 0.f;
#pragma unroll
      for (int ks = 0; ks < NKS; ++ks)
#pragma unroll
        for (int kb = 0; kb < 2; ++kb) s[kb] = __builtin_amdgcn_mfma_f32_32x32x16_bf16(kf[kb][ks], qf[ks], s[kb], 0, 0, 0);
      const int key0 = kt * 64;
#pragma unroll
      for (int kb = 0; kb < 2; ++kb)
#pragma unroll
        for (int i = 0; i < 16; ++i) {
          const int key = key0 + 32 * kb + (i & 3) + 8 * (i >> 2) + 4 * hh;
          const bool valid = (key <= myq) && (myq - key < 128);
          s[kb][i] = valid ? s[kb][i] : -1e30f;
        }
      float mx = fmaxf(s[0][0], s[1][0]);
#pragma unroll
      for (int i = 1; i < 16; ++i) mx = fmaxf(fmaxf(mx, s[0][i]), s[1][i]);
      mx = half_max(mx);
      if (__builtin_amdgcn_ballot_w64(mx > m + tau) != 0ull) {
        const float mnew = fmaxf(m, mx);
        const float alpha = fast_exp2((m - mnew) * c);
        m = mnew; l0 *= alpha; l1 *= alpha;
#pragma unroll
        for (int bl = 0; bl < NBLK; ++bl)
#pragma unroll
          for (int i = 0; i < 16; ++i) O[bl][i] *= alpha;
      }
      const float nmc = -m * c;
      bf16x8 pf[2][2];
#pragma unroll
      for (int kb = 0; kb < 2; ++kb)
#pragma unroll
        for (int s2 = 0; s2 < 2; ++s2) {
          float pv[8];
#pragma unroll
          for (int e = 0; e < 8; ++e) pv[e] = fast_exp2(__builtin_fmaf(s[kb][8 * s2 + e], c, nmc));
          l0 += (pv[0] + pv[4]) + (pv[2] + pv[6]); l1 += (pv[1] + pv[5]) + (pv[3] + pv[7]);
          u32x4 w;
          w.x = pk2(pv[0], pv[1]); w.y = pk2(pv[2], pv[3]); w.z = pk2(pv[4], pv[5]); w.w = pk2(pv[6], pv[7]);
          pf[kb][s2] = __builtin_bit_cast(bf16x8, w);
        }
      LAS unsigned char* Vl = Kl + KCH * 1024 + (4 * hh + q4) * VSTR + (16 * grp) * 2 + 8 * p4;
#pragma unroll
      for (int st = 0; st < 4; ++st)
#pragma unroll
        for (int bl = 0; bl < NBLK; ++bl) {
          LAS unsigned char* ad = Vl + (16 * st) * VSTR + (32 * bl) * 2;
          const s16x4 lo_ = __builtin_amdgcn_ds_read_tr16_b64_v4i16((LAS s16x4*)ad);
          const s16x4 hi_ = __builtin_amdgcn_ds_read_tr16_b64_v4i16((LAS s16x4*)(ad + 8 * VSTR));
          const bf16x8 vf = __builtin_shufflevector(lo_, hi_, 0, 1, 2, 3, 4, 5, 6, 7);
          O[bl] = __builtin_amdgcn_mfma_f32_32x32x16_bf16(vf, pf[st >> 1][st & 1], O[bl], 0, 0, 0);
        }
    }
    const float l = half_sum(l0 + l1);
    const float inv = 1.f / l;
#pragma unroll
    for (int bl = 0; bl < NBLK; ++bl)
#pragma unroll
      for (int g = 0; g < 4; ++g) {
        const int f = h4 * 64 + 32 * bl + 8 * g + 4 * hh;
        float o0 = O[bl][4 * g + 0] * inv, o1 = O[bl][4 * g + 1] * inv, o2 = O[bl][4 * g + 2] * inv, o3 = O[bl][4 * g + 3] * inv;
        const u32x2 gv = *(const u32x2*)(a.gate + (size_t)myq * a.ldg + f);
        o0 *= silu_f(bflo(gv.x)); o1 *= silu_f(bfhi(gv.x)); o2 *= silu_f(bflo(gv.y)); o3 *= silu_f(bfhi(gv.y));
        u32x2 w; w.x = pk2(o0, o1); w.y = pk2(o2, o3);
        *(u32x2*)(a.out + (size_t)myq * a.ldo + f) = w;
      }
  }
  __syncthreads();
}

DI bool team_item(int G, int c, int n, int& bh, int& qb) {
  if (G == 256) {
    const int x = c & 7, li = c >> 3, t = li >> 3, i = li & 7;
    bh = x + 8 * (4 * t + n);
    const int j = (i + 4) & 7;
    qb = (n == 0) ? i : (n == 1) ? 7 - i : (n == 2) ? j : 7 - j;
    return true;
  }
  const int idx = n * G + ((n & 1) ? (G - 1 - c) : c);
  if (idx >= 1024) return false;
  qb = 7 - idx / 128; bh = idx % 128;
  return true;
}

DI int snake_idx(int round, int G, int c) { return round * G + ((round & 1) ? (G - 1 - c) : c); }

DI void attn_even(const Params& p, LAS unsigned char* lds, int i) {
  const int G = gridDim.x, c = blockIdx.x;
  unsigned char* ws = p.ws;
  const bf16_t* z = (const bf16_t*)(ws + WS_ZBUF);
  const bf16_t* qb_ = (const bf16_t*)(ws + WS_QBUF);
  const bf16_t* kv = (const bf16_t*)(ws + WS_HBUF);
  bf16_t* ob = (bf16_t*)(ws + WS_OBUF);
  for (int rd = 0; rd * G < 1024; ++rd) {
    int qb, bh;
    if (!team_item(G, c, rd, bh, qb)) continue;
    const int b = bh >> 3, hd = bh & 7;
    AttnArgs a;
    a.q = qb_ + (size_t)b * SEQ * 768 + hd * 96; a.ldq = 768;
    a.k = kv + (size_t)b * SEQ * 1024 + hd * 128; a.ldk = 1024;
    a.k2 = z + (size_t)b * SEQ * 2560 + 2432; a.ldk2 = 2560;
    a.v = kv + (size_t)b * SEQ * 1024 + hd * 128 + 64; a.ldv = 1024;
    a.out = ob + (size_t)b * SEQ * 1024 + hd * 64; a.ldo = 1024;
    a.gate = z + (size_t)b * SEQ * 2560 + 768 + hd * 64; a.ldg = 2560;
    a.fcum = nullptr; a.sl2 = 0.10206207261596577f * LOG2E; a.sink = 0.f;
    attn_item<96, 64, 0>(lds, a, qb);
  }
  for (int it = c; it < 256; it += G) {
    const int b = it >> 4, kvh = (it >> 3) & 1, qb = it & 7;
    AttnArgs a;
    const bf16_t* zb = z + (size_t)b * SEQ * 2560;
    a.q = zb + kvh * 256; a.ldq = 2560;
    a.k = zb + 512 + kvh * 64; a.ldk = 2560; a.k2 = nullptr; a.ldk2 = 0;
    a.v = zb + 640 + kvh * 64; a.ldv = 2560;
    a.out = ob + (size_t)b * SEQ * 1024 + 512 + kvh * 256; a.ldo = 1024;
    a.gate = zb + 768 + 512 + kvh * 256; a.ldg = 2560;
    a.fcum = nullptr; a.sl2 = 0.125f * LOG2E; a.sink = 0.f;
    float sk[4];
#pragma unroll
    for (int h4 = 0; h4 < 4; ++h4) sk[h4] = p.ev_sinks[i * 8 + kvh * 4 + h4] * LOG2E;
    swa_item(lds, a, sk, qb);
  }
}

DI void attn_odd(const Params& p, LAS unsigned char* lds, int layer) {
  const int G = gridDim.x, c = blockIdx.x;
  unsigned char* ws = p.ws;
  const bf16_t* z = (const bf16_t*)(ws + WS_ZBUF);
  bf16_t* od = (bf16_t*)(ws + WS_HBUF);
  bf16_t* ob = (bf16_t*)(ws + WS_OBUF);
  {
    for (int rd = 0; rd * G < 512; ++rd) {
      int qb, bh2;
      if (G == 256) { const int x = c & 7, li = c >> 3, t = li >> 3, i = li & 7; bh2 = x + 8 * (2 * t + rd); qb = (rd == 0) ? i : 7 - i; }
      else { const int idx = snake_idx(rd, G, c); if (idx >= 512) continue; qb = 7 - idx / 64; bh2 = idx % 64; }
      const int b = bh2 >> 2, h = bh2 & 3;
      const bf16_t* zb = z + (size_t)b * SEQ * 4096;
      for (int mp = 0; mp < 2; ++mp) {
        const int j = 2 * h + mp;
        AttnArgs a;
        a.q = zb + j * 64; a.ldq = 4096;
        a.k = zb + 512 + j * 64; a.ldk = 4096; a.k2 = nullptr; a.ldk2 = 0;
        a.v = zb + 1024 + h * 128; a.ldv = 4096;
        a.out = od + (size_t)b * SEQ * 1024 + j * 128; a.ldo = 1024;
        a.gate = nullptr; a.ldg = 0;
        a.fcum = nullptr; a.sl2 = 0.125f * LOG2E; a.sink = 0.f;
#ifndef SKIP_DIFF
        attn_item<64, 128, 0>(lds, a, qb);
#endif
      }
      __builtin_amdgcn_fence(__ATOMIC_SEQ_CST, "workgroup");
      asm volatile("s_waitcnt vmcnt(0)" ::: "memory");
      const int tid2 = opaque_tid(), lane = tid2 & 63, wid = tid2 >> 6, li_ = layer >> 1;
      const float* lp = p.od_lambda + li_ * 256;
      const float s1 = wave_sum(lp[lane] * lp[64 + lane]), s2 = wave_sum(lp[128 + lane] * lp[192 + lane]);
      const float lam_init = 0.8f - 0.6f * fast_exp2(-0.3f * LOG2E * (float)layer);
      const float lam = fast_exp2(s1 * LOG2E) - fast_exp2(s2 * LOG2E) + lam_init;
      const int rsub = lane >> 4, dv = (lane & 15) * 8;
      float sub[8];
#pragma unroll
      for (int e = 0; e < 8; ++e) sub[e] = p.od_subln[li_ * 128 + dv + e] * (1.f - lam_init);
      const size_t row0 = (size_t)b * SEQ + qb * 256 + 32 * wid;
#pragma unroll 2
      for (int rr = 0; rr < 8; ++rr) {
        const size_t row = row0 + 4 * rr + rsub;
        const u32x4 va = *(const u32x4*)(od + row * 1024 + (2 * h) * 128 + dv);
        const u32x4 vb = *(const u32x4*)(od + row * 1024 + (2 * h + 1) * 128 + dv);
        const u32x4 vg = *(const u32x4*)(z + row * 4096 + 3072 + h * 128 + dv);
        float d[8]; float ss = 0.f;
#pragma unroll
        for (int e = 0; e < 4; ++e) { d[2 * e] = bflo(va[e]) - lam * bflo(vb[e]); d[2 * e + 1] = bfhi(va[e]) - lam * bfhi(vb[e]); ss += d[2 * e] * d[2 * e] + d[2 * e + 1] * d[2 * e + 1]; }
        ss += __shfl_xor(ss, 1); ss += __shfl_xor(ss, 2); ss += __shfl_xor(ss, 4); ss += __shfl_xor(ss, 8);
        const float rs = rsqrtf(ss * (1.f / 128.f) + EPS);
        u32x4 w;
#pragma unroll
        for (int e = 0; e < 4; ++e) {
          const float o0 = d[2 * e] * rs * sub[2 * e] * silu_f(bflo(vg[e])), o1 = d[2 * e + 1] * rs * sub[2 * e + 1] * silu_f(bfhi(vg[e]));
          w[e] = pk2(o0, o1);
        }
        *(u32x4*)(ob + row * 1024 + h * 128 + dv) = w;
      }
    }
  }
  for (int rd = 0; rd * G < 1024; ++rd) {
    int qb, bh;
    if (!team_item(G, c, rd, bh, qb)) continue;
    const int b = bh >> 3, hd = bh & 7;
    AttnArgs a;
    const bf16_t* zb = z + (size_t)b * SEQ * 4096;
    a.q = zb + 1536 + hd * 64; a.ldq = 4096;
    a.k = zb + 2048 + hd * 64; a.ldk = 4096; a.k2 = nullptr; a.ldk2 = 0;
    a.v = zb + 2560 + hd * 64; a.ldv = 4096;
    a.out = ob + (size_t)b * SEQ * 1024 + 512 + hd * 64; a.ldo = 1024;
    a.gate = zb + 3072 + 512 + hd * 64; a.ldg = 4096;
    a.fcum = (const float*)(ws + WS_FCUM) + (size_t)bh * SEQ; a.sl2 = 0.125f * LOG2E; a.sink = 0.f;
#ifndef SKIP_FOX
    attn_item<64, 64, 2>(lds, a, qb);
#endif
  }
}

DI void diff_combine(const Params& p, int layer) {
  const int tid = opaque_tid(), lane = tid & 63, wid = tid >> 6;
  const int gw = blockIdx.x * 8 + wid, nw = gridDim.x * 8;
  const int i = layer >> 1;
  unsigned char* ws = p.ws;
  const bf16_t* od = (const bf16_t*)(ws + WS_HBUF);
  const bf16_t* z = (const bf16_t*)(ws + WS_ZBUF);
  bf16_t* ob = (bf16_t*)(ws + WS_OBUF);
  const float* lp = p.od_lambda + i * 256;
  const float s1 = wave_sum(lp[lane] * lp[64 + lane]), s2 = wave_sum(lp[128 + lane] * lp[192 + lane]);
  const float lam_init = 0.8f - 0.6f * expf(-0.3f * (float)layer);
  const float lam = expf(s1) - expf(s2) + lam_init;
  const int hd = lane >> 4, dv = (lane & 15) * 8;
  float sub[8];
#pragma unroll
  for (int e = 0; e < 8; ++e) sub[e] = p.od_subln[i * 128 + dv + e] * (1.f - lam_init);
  for (int row = gw; row < T; row += nw) {
    const u32x4 a = *(const u32x4*)(od + (size_t)row * 1024 + (2 * hd) * 128 + dv);
    const u32x4 b = *(const u32x4*)(od + (size_t)row * 1024 + (2 * hd + 1) * 128 + dv);
    const u32x4 g = *(const u32x4*)(z + (size_t)row * 4096 + 3072 + hd * 128 + dv);
    float d[8]; float ss = 0.f;
#pragma unroll
    for (int e = 0; e < 4; ++e) { d[2 * e] = bflo(a[e]) - lam * bflo(b[e]); d[2 * e + 1] = bfhi(a[e]) - lam * bfhi(b[e]); ss += d[2 * e] * d[2 * e] + d[2 * e + 1] * d[2 * e + 1]; }
    ss += __shfl_xor(ss, 1); ss += __shfl_xor(ss, 2); ss += __shfl_xor(ss, 4); ss += __shfl_xor(ss, 8);
    const float rs = rsqrtf(ss * (1.f / 128.f) + EPS);
    u32x4 w;
#pragma unroll
    for (int e = 0; e < 4; ++e) {
      const float o0 = d[2 * e] * rs * sub[2 * e] * silu_f(bflo(g[e])), o1 = d[2 * e + 1] * rs * sub[2 * e + 1] * silu_f(bfhi(g[e]));
      w[e] = pk2(o0, o1);
    }
    *(u32x4*)(ob + (size_t)row * 1024 + hd * 128 + dv) = w;
  }
}


DI void grid_barrier(unsigned* ctr, unsigned& epoch) {
  asm volatile("s_waitcnt vmcnt(0)" ::: "memory");
  __syncthreads();
  epoch += 1;
  if (threadIdx.x == 0) {
    __builtin_amdgcn_fence(__ATOMIC_RELEASE, "agent");
    asm volatile("s_waitcnt vmcnt(0)" ::: "memory");
    __hip_atomic_fetch_add(ctr, 1u, __ATOMIC_RELAXED, __HIP_MEMORY_SCOPE_AGENT);
    const unsigned target = epoch * gridDim.x;
    while (__hip_atomic_load(ctr, __ATOMIC_RELAXED, __HIP_MEMORY_SCOPE_AGENT) < target) __builtin_amdgcn_s_sleep(1);
    __builtin_amdgcn_fence(__ATOMIC_ACQUIRE, "agent");
    asm volatile("s_waitcnt vmcnt(0)" ::: "memory");
  }
  __syncthreads();
}


#define XB_TMO      128
#define XB_XCNT(j)  (256  + 64 * (j))
#define XB_XSUB(j)  (1280 + 64 * (j))
#define XB_XGEN(j)  (2304 + 64 * (j))
#define XB_TOP      3328
#define XB_TOPGEN   3392
#define XCD_BAR_WORDS 3456
#define XB_SPIN_CAP (1u << 20)
DI unsigned xb_ld(unsigned* p) { return __hip_atomic_load(p, __ATOMIC_RELAXED, __HIP_MEMORY_SCOPE_AGENT); }
DI unsigned xb_add(unsigned* p, unsigned v) { return __hip_atomic_fetch_add(p, v, __ATOMIC_RELAXED, __HIP_MEMORY_SCOPE_AGENT); }
DI unsigned xb_xcc_id() { return (unsigned)__builtin_amdgcn_s_getreg((3 << 11) | 20) & 0xFu; }
#define XB_SPIN(cond, bar) do { unsigned _sp = 0; while (cond) { __builtin_amdgcn_s_sleep(1); \
    if ((++_sp & 255u) == 0u) { if (xb_ld(&(bar)[XB_TMO])) break; if (_sp > XB_SPIN_CAP) { atomicAdd(&(bar)[XB_TMO], 1u); break; } } } } while (0)
struct XcdBarrier { unsigned* bar; unsigned x; volatile LAS unsigned* st; };
DI void xcd_barrier_complete(unsigned* bar, unsigned x, unsigned& nloc, unsigned& nx) {
  const unsigned G = gridDim.x;
  unsigned sum, cnt, mine, sp = 0u;
  for (;;) {
    sum = 0u; cnt = 0u; mine = 0u;
#pragma unroll
    for (unsigned j = 0; j < 16; ++j) { const unsigned c = xb_ld(&bar[XB_XCNT(j)]); sum += c; cnt += (c > 0u) ? 1u : 0u; mine = (j == x) ? c : mine; }
    if (sum == G) break;
    __builtin_amdgcn_s_sleep(1);
    if ((++sp & 255u) == 0u) { if (xb_ld(&bar[XB_TMO])) break; if (sp > XB_SPIN_CAP) { atomicAdd(&bar[XB_TMO], 1u); break; } }
  }
  nloc = mine > 0u ? mine : 1u; nx = cnt > 0u ? cnt : 1u;
}
DI void xcd_barrier(const XcdBarrier& b) {
  asm volatile("s_waitcnt vmcnt(0)" ::: "memory");
  __syncthreads();
  if (threadIdx.x == 0) {
    unsigned* bar = b.bar;
    __builtin_amdgcn_s_waitcnt(0);
    unsigned nloc = b.st[0], nx = b.st[1];
    if (nloc == 0u) { xcd_barrier_complete(bar, b.x, nloc, nx); b.st[0] = nloc; b.st[1] = nx; }
    const unsigned old = xb_add(&bar[XB_XSUB(b.x)], 1u);
    const unsigned gen = old / nloc;
    if (old + 1u == (gen + 1u) * nloc) {
      __builtin_amdgcn_fence(__ATOMIC_RELEASE, "agent");
      asm volatile("s_waitcnt vmcnt(0)" ::: "memory");
      const unsigned og = xb_add(&bar[XB_TOP], 1u);
      const unsigned tg = og / nx;
      if (og + 1u == (tg + 1u) * nx) xb_add(&bar[XB_TOPGEN], 1u);
      else XB_SPIN(xb_ld(&bar[XB_TOPGEN]) == tg, bar);
      __builtin_amdgcn_fence(__ATOMIC_ACQUIRE, "agent");
      xb_add(&bar[XB_XGEN(b.x)], 1u);
      asm volatile("s_waitcnt vmcnt(0)" ::: "memory");
    } else {
      XB_SPIN(xb_ld(&bar[XB_XGEN(b.x)]) == gen, bar);
      __builtin_amdgcn_fence(__ATOMIC_ACQUIRE, "agent");
      asm volatile("s_waitcnt vmcnt(0)" ::: "memory");
    }
  }
  __syncthreads();
}

__global__ void __launch_bounds__(512) fwd_megakernel(Params p) {
  extern __shared__ __attribute__((aligned(16))) unsigned char lds_raw[];
  LAS unsigned char* lds = (LAS unsigned char*)lds_raw;
  cg::grid_group grid = cg::this_grid();
  unsigned char* ws = p.ws;
  const int G = gridDim.x, bid = blockIdx.x;
  const float* cosH = (const float*)(ws + WS_COSH); const float* sinH = (const float*)(ws + WS_SINH);
  const float* cosR = (const float*)(ws + WS_COSR); const float* sinR = (const float*)(ws + WS_SINR);

  unsigned* xbar = (unsigned*)(ws + WS_XBAR);
  if (bid == 0) { for (int w = threadIdx.x; w < XCD_BAR_WORDS; w += 512) __hip_atomic_store(xbar + w, 0u, __ATOMIC_RELAXED, __HIP_MEMORY_SCOPE_AGENT); }
  volatile LAS unsigned* xst = (volatile LAS unsigned*)(lds + LDS_BYTES_C - 16);
  if (threadIdx.x == 0) { xst[0] = 0u; xst[1] = 0u; }
#ifndef SKIP_PRO
  prologue(p, lds);
#endif
  grid.sync();
  XcdBarrier xb; xb.bar = xbar; xb.x = xb_xcc_id(); xb.st = xst;
  if (threadIdx.x == 0) (void)xb_add(&xbar[XB_XCNT(xb.x)], 1u);
#pragma unroll
  for (int layer = 0; layer < 4; ++layer) {
    const int i = layer >> 1; const bool odd = layer & 1;
#ifndef SKIP_ROW
    rowwise_phase(p, lds, layer - 1, layer);
#endif
    xcd_barrier(xb);
    {
#ifndef SKIP_SCAN
      if (odd && bid < 128) fox_scan(p, lds, bid);
#endif
      pg8::Gemm g; g.A = (const bf16_t*)(ws + WS_HBUF); g.lda = 1024; g.K = 1024; g.M = T;
      Epi e; e.out = (bf16_t*)(ws + WS_ZBUF); e.pin = nullptr; e.pslot = 0; e.nK = 0; e.qmode = 0; e.pout = odd ? nullptr : (float*)(ws + WS_PART); e.cosH = cosH; e.sinH = sinH; e.cosR = cosR; e.sinR = sinR;
      if (!odd) { g.Bt = (const bf16_t*)(ws + WS_WEVIN + i * SZ_WEVIN); g.N = 2560; e.ldc = 2560; e.rope64_end = 640; e.rope32_lo = 2432; e.rope32_hi = 2464; }
      else { g.Bt = (const bf16_t*)(ws + WS_WODIN + i * SZ_WODIN); g.N = 4096; e.ldc = 4096; e.rope64_end = 1024; e.rope32_lo = 0; e.rope32_hi = 0; }
      pg8::StaticOrder S; S.init(g.M, g.N, G, bid);
#ifndef SKIP_G1
      pg8::gemm_phase<Epi>(lds, g, S, e);
#endif
    }
    xcd_barrier(xb);
    if (!odd) {
      for (int which = 0; which < 2; ++which) {
        pg8::Gemm g; g.M = T; g.lda = 2560;
        Epi e; e.rope64_end = 0; e.rope32_lo = 0; e.rope32_hi = 0; e.cosH = cosH; e.sinH = sinH; e.cosR = cosR; e.sinR = sinR; e.pout = nullptr; e.pin = (const float*)(ws + WS_PART);
        if (which == 0) { g.A = (const bf16_t*)(ws + WS_ZBUF) + 1792; g.Bt = (const bf16_t*)(ws + WS_WUQ + i * SZ_WUQ); g.N = 768; g.K = 384;
          e.out = (bf16_t*)(ws + WS_QBUF); e.ldc = 768; e.qmode = 1; e.pslot = 0; e.nK = 384; }
        else { g.A = (const bf16_t*)(ws + WS_ZBUF) + 2176; g.Bt = (const bf16_t*)(ws + WS_WUKV + i * SZ_WUKV); g.N = 1024; g.K = 256;
          e.out = (bf16_t*)(ws + WS_HBUF); e.ldc = 1024; e.qmode = 0; e.pslot = 12; e.nK = 256; }
        pg8::StaticOrder S; S.init(g.M, g.N, G, bid);
#ifndef SKIP_G2
        pg8::gemm_phase<Epi>(lds, g, S, e);
#endif
      }
      xcd_barrier(xb);
#ifndef SKIP_ATTE
      attn_even(p, lds, i);
#endif
      xcd_barrier(xb);
    } else {
#ifndef SKIP_ATTO
      attn_odd(p, lds, layer);
#endif
      xcd_barrier(xb);
    }
    {
      pg8::Gemm g; g.A = (const bf16_t*)(ws + WS_OBUF); g.lda = 1024; g.K = 1024; g.M = T; g.N = 1024;
      g.Bt = (const bf16_t*)(ws + (odd ? WS_WODOUT : WS_WEVOUT) + i * SZ_WOUT);
      Epi e; e.out = (bf16_t*)(ws + WS_HBUF); e.ldc = 1024; e.pin = nullptr; e.pslot = 0; e.pout = nullptr; e.nK = 0; e.qmode = 0; e.rope64_end = 0; e.rope32_lo = 0; e.rope32_hi = 0;
      e.cosH = cosH; e.sinH = sinH; e.cosR = cosR; e.sinR = sinR;
      pg8::StaticOrder S; S.init(g.M, g.N, G, bid);
#ifndef SKIP_G3
      pg8::gemm_phase<Epi>(lds, g, S, e);
#endif
    }
    xcd_barrier(xb);
  }
#ifndef SKIP_ROW
  rowwise_phase(p, lds, 3, 4);
#endif
}

constexpr int LDS_BYTES = 155648;
static_assert(LDS_BYTES == LDS_BYTES_C, "LDS size mismatch");

extern "C" void kernel_launch(void* const* d_in, const int* in_sizes, int n_in, void* d_out, int out_size, void* d_ws, size_t ws_size, hipStream_t stream) {
  static int grid_blocks = 0;
  if (grid_blocks == 0) {
    int dev = 0, cus = 0, per_cu = 0;
    if (hipGetDevice(&dev) != hipSuccess || hipDeviceGetAttribute(&cus, hipDeviceAttributeMultiprocessorCount, dev) != hipSuccess) { fprintf(stderr, "device query failed\n"); grid_blocks = -1; return; }
    if (hipFuncSetAttribute((const void*)fwd_megakernel, hipFuncAttributeMaxDynamicSharedMemorySize, LDS_BYTES) != hipSuccess) { fprintf(stderr, "hipFuncSetAttribute failed\n"); grid_blocks = -1; return; }
    if (hipOccupancyMaxActiveBlocksPerMultiprocessor(&per_cu, (const void*)fwd_megakernel, 512, LDS_BYTES) != hipSuccess || per_cu < 1) { fprintf(stderr, "occupancy query: %d\n", per_cu); per_cu = 1; }
    (void)hipGetLastError();
    grid_blocks = cus;
    if (ws_size < WS_END) { fprintf(stderr, "workspace too small: %zu < %zu\n", ws_size, (size_t)WS_END); grid_blocks = -1; return; }
  }
  if (grid_blocks < 0) return;
  Params p{};
  const float** fp = (const float**)&p;
  for (int i = 0; i < 18; ++i) fp[i] = (const float*)d_in[i];
  p.out = (float*)d_out; p.ws = (unsigned char*)d_ws;
  void* args[] = {&p};
  hipError_t e = hipLaunchCooperativeKernel((const void*)fwd_megakernel, dim3(grid_blocks), dim3(512), args, LDS_BYTES, stream);
  if (e != hipSuccess) fprintf(stderr, "cooperative launch failed: %s (grid %d)\n", hipGetErrorString(e), grid_blocks);
}
```

```cpp
#include <hip/hip_runtime.h>
#include <hip/hip_cooperative_groups.h>
#include <cstdio>
#include <type_traits>
namespace cg = cooperative_groups;

#define DI __device__ __forceinline__
#define LAS __attribute__((address_space(3)))
typedef unsigned short bf16_t;
typedef short bf16x8 __attribute__((ext_vector_type(8)));
typedef short s16x4 __attribute__((ext_vector_type(4)));
typedef float f32x2 __attribute__((ext_vector_type(2)));
typedef float f32x4 __attribute__((ext_vector_type(4)));
typedef float f32x16 __attribute__((ext_vector_type(16)));
typedef unsigned u32x2 __attribute__((ext_vector_type(2)));
typedef unsigned u32x4 __attribute__((ext_vector_type(4)));
typedef __bf16 bf16x2_t __attribute__((ext_vector_type(2)));

constexpr int T = 32768, DM = 1024, NB = 16, SEQ = 2048;
constexpr float LOG2E = 1.4426950408889634f;
constexpr float EPS = 1e-6f;
constexpr int LDS_BYTES_C = 155648;

constexpr size_t SZ_WEVIN = 2560ull * 1024 * 2, SZ_WODIN = 4096ull * 1024 * 2, SZ_WUQ = 768ull * 384 * 2, SZ_WUKV = 1024ull * 256 * 2, SZ_WOUT = 1024ull * 1024 * 2;
constexpr size_t WS_WEVIN = 0;
constexpr size_t WS_WODIN = WS_WEVIN + 2 * SZ_WEVIN;
constexpr size_t WS_WUQ = WS_WODIN + 2 * SZ_WODIN;
constexpr size_t WS_WUKV = WS_WUQ + 2 * SZ_WUQ;
constexpr size_t WS_WEVOUT = WS_WUKV + 2 * SZ_WUKV;
constexpr size_t WS_WODOUT = WS_WEVOUT + 2 * SZ_WOUT;
constexpr size_t WS_MOD = WS_WODOUT + 2 * SZ_WOUT;
constexpr size_t WS_COSH = WS_MOD + 4ull * 16 * 3072 * 4;
constexpr size_t WS_SINH = WS_COSH + 2048ull * 32 * 4;
constexpr size_t WS_COSR = WS_SINH + 2048ull * 32 * 4;
constexpr size_t WS_SINR = WS_COSR + 2048ull * 16 * 4;
constexpr size_t WS_LOGF = WS_SINR + 2048ull * 16 * 4;
constexpr size_t WS_FCUM = WS_LOGF + (size_t)T * 8 * 4;
constexpr size_t WS_HBUF = (WS_FCUM + (size_t)T * 8 * 4 + 4095) & ~(size_t)4095;
constexpr size_t WS_OBUF = WS_HBUF + (size_t)T * 1024 * 2;
constexpr size_t WS_ZBUF = WS_OBUF + (size_t)T * 1024 * 2;
constexpr size_t WS_QBUF = WS_ZBUF + (size_t)T * 2560 * 2;
constexpr size_t WS_BAR = WS_ZBUF + (size_t)T * 4096 * 2;
constexpr size_t WS_PART = WS_BAR + 256;
constexpr size_t WS_XBAR = (WS_PART + (size_t)T * 20 * 4 + 4095) & ~(size_t)4095;
constexpr size_t WS_XBF_PRE = WS_XBAR + 16384;
constexpr size_t WS_XBF = WS_XBF_PRE;
constexpr size_t WS_END = WS_XBF + (size_t)T * 1024 * 2;

struct Params {
  const float *x, *c, *w_ada, *b_ada, *g_pre, *g_post, *ev_w_in, *ev_q_norm, *ev_kv_norm, *ev_w_uq, *ev_w_ukv, *ev_sinks, *ev_w_out,
      *od_w_in, *od_forget_bias, *od_lambda, *od_subln, *od_w_out;
  float* out;
  unsigned char* ws;
};

DI int opaque_tid() { int t = threadIdx.x; asm volatile("" : "+v"(t)); return t; }
DI float bflo(unsigned u) { return __uint_as_float(u << 16); }
DI float bfhi(unsigned u) { return __uint_as_float(u & 0xffff0000u); }
DI unsigned pk2(float lo, float hi) { f32x2 f = {lo, hi}; bf16x2_t b = __builtin_convertvector(f, bf16x2_t); return __builtin_bit_cast(unsigned, b); }
DI bf16_t f2bf(float f) { return (bf16_t)(pk2(f, 0.f) & 0xffffu); }
DI float fast_exp2(float x) { return __builtin_amdgcn_exp2f(x); }
DI float silu_f(float x) { return x * __builtin_amdgcn_rcpf(1.f + fast_exp2(-x * LOG2E)); }
template <int CTRL> DI float dpp_mov(float v) { return __builtin_bit_cast(float, __builtin_amdgcn_update_dpp(0, __builtin_bit_cast(int, v), CTRL, 0xf, 0xf, false)); }
DI float wave_sum(float v) {
  v += dpp_mov<0xB1>(v);
  v += dpp_mov<0x4E>(v);
  v += dpp_mov<0x141>(v);
  v += dpp_mov<0x140>(v);
  { const unsigned u = __float_as_uint(v); auto r = __builtin_amdgcn_permlane16_swap(u, u, false, false); v = __uint_as_float(r[0]) + __uint_as_float(r[1]); }
  { const unsigned u = __float_as_uint(v); auto r = __builtin_amdgcn_permlane32_swap(u, u, false, false); v = __uint_as_float(r[0]) + __uint_as_float(r[1]); }
  return v;
}

namespace pg8 {
constexpr int BM = 256, BK = 64, HALF = 128, HTB = HALF * BK * 2, STAGE_BYTES = 8 * HTB, NXCD = 8, WGM = 8;
DI int lds_byte(int r, int c) { const int st = (r >> 4) * 2 + (c >> 5), rr = r & 15, cc = c & 31, ob = rr * 64 + cc * 2; return st * 1024 + (ob ^ (((ob >> 9) & 1) << 5)); }
DI void stage_rc(int b, int& R, int& C) { const int st = b / 1024, sb = b % 1024, swz = sb ^ (((sb >> 9) & 1) << 5); R = (st >> 1) * 16 + swz / 64; C = (st & 1) * 32 + (swz % 64) / 2; }
DI int perm32(int rho) { const int n = rho >> 4, i = rho & 15; return 8 * (i >> 2) + 4 * n + (i & 3); }
struct Unit { int pm, pn; };
struct Gemm { const bf16_t* A; const bf16_t* Bt; int M, N, K, lda; };
struct StaticOrder {
  int nM, nN, nwg, G, c;
  DI void init(int M, int N, int G_, int c_) { nM = M / BM; nN = N / BM; nwg = nM * nN; G = G_; c = c_; }
  DI bool next(int i, Unit& u) const {
    const long L = (long)i * G + c; if (L >= nwg) return false;
    int wgid = (int)L; { const int q = nwg / NXCD, r = nwg % NXCD, xcd = wgid % NXCD, off = wgid / NXCD; wgid = (xcd < r ? xcd * (q + 1) : r * (q + 1) + (xcd - r) * q) + off; }
    const int nig = WGM * nN, gid = wgid / nig, fm = gid * WGM, gsz = (nM - fm) < WGM ? (nM - fm) : WGM;
    u.pm = fm + ((wgid % nig) % gsz); u.pn = (wgid % nig) / gsz; return true;
  }
};

template <class Epi>
DI void gemm_phase(LAS unsigned char* lds, const Gemm g, const StaticOrder& S, const Epi& E) {
  const int tid = opaque_tid(), wid = __builtin_amdgcn_readfirstlane(tid >> 6), lane = tid & 63, wr = wid >> 2, wc = wid & 3, fr = lane & 15, fq = lane >> 4;
  const int K = g.K, nt = K / BK, lda = g.lda;
  unsigned voffA[2], voffB[2];
#pragma unroll
  for (int i = 0; i < 2; ++i) { int R, C; stage_rc(tid * 16 + i * 8192, R, C); const int Rb = (R & ~31) + perm32(R & 31);
    voffA[i] = (unsigned)(R * lda + C) * 2u; voffB[i] = (unsigned)(Rb * K + C) * 2u; }
  const size_t kstep = (size_t)(BK * 2);
  const size_t hstepA = (size_t)HALF * lda * 2, hstepB = (size_t)HALF * K * 2;
  const size_t tstepA = 2 * hstepA, tstepB = 2 * hstepB;
  const unsigned ldsw = (unsigned)wid * 1024u;
  const int aoff = lds_byte(wr * 64 + fr, fq * 8), boff = lds_byte(wc * 32 + fr, fq * 8);
#define PG8_SA(b, h) (((b) * 2 + (h)) * HTB)
#define PG8_SB(b, h) ((4 + (b) * 2 + (h)) * HTB)
#define PG8_STAGE(bufoff, gbase, voff) do { _Pragma("unroll") for (int _i = 0; _i < 2; ++_i) \
    __builtin_amdgcn_global_load_lds((const unsigned*)((const char*)(gbase) + (voff)[_i]), (LAS unsigned*)(lds + (bufoff) + ldsw + _i * 8192), 16, 0, 0); } while (0)
#define PG8_LDA(dst, b, h) do { _Pragma("unroll") for (int m = 0; m < 4; ++m) _Pragma("unroll") for (int k = 0; k < 2; ++k) dst[m][k] = *(const LAS bf16x8*)(lds + PG8_SA(b, h) + aoff + m * 2048 + k * 1024); } while (0)
#define PG8_LDB(dst, b, h) do { _Pragma("unroll") for (int n = 0; n < 2; ++n) _Pragma("unroll") for (int k = 0; k < 2; ++k) dst[n][k] = *(const LAS bf16x8*)(lds + PG8_SB(b, h) + boff + n * 2048 + k * 1024); } while (0)
#define PG8_MMA(ai, bj, At, Bt) do { __builtin_amdgcn_s_setprio(1); _Pragma("unroll") for (int m = 0; m < 4; ++m) _Pragma("unroll") for (int n = 0; n < 2; ++n) _Pragma("unroll") for (int k = 0; k < 2; ++k) \
    acc[ai][bj][m][n] = __builtin_amdgcn_mfma_f32_16x16x32_bf16(Bt[n][k], At[m][k], acc[ai][bj][m][n], 0, 0, 0); __builtin_amdgcn_s_setprio(0); } while (0)
#define PG8_WAIT_V(n) asm volatile("s_waitcnt vmcnt(" #n ")" ::: "memory")
#define PG8_WAIT_L(n) asm volatile("s_waitcnt lgkmcnt(" #n ")" ::: "memory")
#define PG8_BAR __builtin_amdgcn_s_barrier()
#define PG8_SCHED __builtin_amdgcn_sched_barrier(0)
  Unit cur, nxt; int ui = 0;
  if (!S.next(0, cur)) return;
  f32x4 acc[2][2][4][2];
#pragma unroll
  for (int a = 0; a < 2; ++a)
#pragma unroll
    for (int b = 0; b < 2; ++b)
#pragma unroll
      for (int m = 0; m < 4; ++m)
#pragma unroll
        for (int n = 0; n < 2; ++n) acc[a][b][m][n] = (f32x4){0.f, 0.f, 0.f, 0.f};
  bf16x8 At[4][2], B0[2][2], B1[2][2];
  const char* cA = (const char*)g.A + (size_t)cur.pm * tstepA; const char* cB = (const char*)g.Bt + (size_t)cur.pn * tstepB;
  PG8_STAGE(PG8_SB(0, 0), cB, voffB); PG8_STAGE(PG8_SA(0, 0), cA, voffA); PG8_STAGE(PG8_SB(0, 1), cB + hstepB, voffB); PG8_STAGE(PG8_SA(0, 1), cA + hstepA, voffA);
  if (wr == 1) PG8_BAR;
  PG8_WAIT_V(4); PG8_BAR;
  PG8_STAGE(PG8_SB(1, 0), cB + kstep, voffB); PG8_STAGE(PG8_SA(1, 0), cA + kstep, voffA); PG8_STAGE(PG8_SB(1, 1), cB + hstepB + kstep, voffB);
  PG8_WAIT_V(6); PG8_BAR;
  for (;;) {
    const bool has_next = S.next(ui + 1, nxt);
    const char* nA = has_next ? (const char*)g.A + (size_t)nxt.pm * tstepA : cA; const char* nB = has_next ? (const char*)g.Bt + (size_t)nxt.pn * tstepB : cB;
    for (int t = 0; t < nt; t += 2) {
      const bool last = (t == nt - 2);
      const char* a1 = cA + (size_t)(t + 1) * kstep;
      const char* a2 = last ? nA : cA + (size_t)(t + 2) * kstep; const char* b2 = last ? nB : cB + (size_t)(t + 2) * kstep;
      const char* a3 = a2 + kstep; const char* b3 = b2 + kstep;
      PG8_LDB(B0, 0, 0); PG8_SCHED; PG8_LDA(At, 0, 0); PG8_STAGE(PG8_SA(1, 1), a1 + hstepA, voffA);
      PG8_WAIT_L(8); PG8_BAR; PG8_WAIT_L(0); PG8_MMA(0, 0, At, B0); PG8_BAR; PG8_SCHED;
      PG8_LDB(B1, 0, 1); PG8_STAGE(PG8_SB(0, 0), b2, voffB);
      PG8_BAR; PG8_WAIT_L(0); PG8_MMA(0, 1, At, B1); PG8_BAR;
      PG8_LDA(At, 0, 1); PG8_STAGE(PG8_SA(0, 0), a2, voffA);
      PG8_BAR; PG8_WAIT_L(0); PG8_MMA(1, 0, At, B0); PG8_BAR; PG8_SCHED;
      PG8_STAGE(PG8_SB(0, 1), b2 + hstepB, voffB);
      PG8_WAIT_V(6); PG8_BAR; PG8_MMA(1, 1, At, B1); PG8_BAR;
      PG8_LDB(B0, 1, 0); PG8_SCHED; PG8_LDA(At, 1, 0); PG8_STAGE(PG8_SA(0, 1), a2 + hstepA, voffA);
      PG8_WAIT_L(8); PG8_BAR; PG8_WAIT_L(0); PG8_MMA(0, 0, At, B0); PG8_BAR; PG8_SCHED;
      PG8_LDB(B1, 1, 1); PG8_STAGE(PG8_SB(1, 0), b3, voffB);
      PG8_BAR; PG8_WAIT_L(0); PG8_MMA(0, 1, At, B1); PG8_BAR;
      PG8_LDA(At, 1, 1); PG8_STAGE(PG8_SA(1, 0), a3, voffA);
      PG8_BAR; PG8_WAIT_L(0); PG8_MMA(1, 0, At, B0); PG8_BAR; PG8_SCHED;
      PG8_STAGE(PG8_SB(1, 1), b3 + hstepB, voffB);
      PG8_WAIT_V(6); PG8_BAR; PG8_MMA(1, 1, At, B1); PG8_BAR;
    }
    E(acc, cur, wr, wc, fr, fq);
    if (!has_next) break;
#pragma unroll
    for (int a = 0; a < 2; ++a)
#pragma unroll
      for (int b = 0; b < 2; ++b)
#pragma unroll
        for (int m = 0; m < 4; ++m)
#pragma unroll
          for (int n = 0; n < 2; ++n) acc[a][b][m][n] = (f32x4){0.f, 0.f, 0.f, 0.f};
    cur = nxt; cA = nA; cB = nB; ++ui;
  }
  PG8_WAIT_V(0);
  if (wr == 0) PG8_BAR;
  PG8_BAR;
#undef PG8_SA
#undef PG8_SB
#undef PG8_STAGE
#undef PG8_LDA
#undef PG8_LDB
#undef PG8_MMA
#undef PG8_WAIT_V
#undef PG8_WAIT_L
#undef PG8_BAR
#undef PG8_SCHED
}
}

struct Epi {
  bf16_t* out; int ldc;
  int rope64_end;
  int rope32_lo, rope32_hi;
  int qmode;
  const float* pin; int nK;
  int pslot;
  float* pout;
  const float *cosH, *sinH, *cosR, *sinR;
  DI void operator()(const f32x4 (&acc)[2][2][4][2], const pg8::Unit& u, int wr, int wc, int fr, int fq) const {
    const int row0 = u.pm * 256 + wr * 64 + fr;
    int rt[2];
#pragma unroll
    for (int bj = 0; bj < 2; ++bj) {
      const int cw = u.pn * 256 + bj * 128 + wc * 32;
      rt[bj] = 0;
      if (cw < rope64_end) rt[bj] = 1;
      else if (cw >= rope32_lo && cw < rope32_hi) rt[bj] = 2;
      else if (qmode && ((cw >> 5) % 3) == 2) rt[bj] = 2;
    }
    const int tt = rt[0] | rt[1];
    const float* ctab = (tt == 1) ? cosH + (16 * (wc & 1) + 4 * fq) : cosR + 4 * fq;
    const float* stab = (tt == 1) ? sinH + (16 * (wc & 1) + 4 * fq) : sinR + 4 * fq;
    const int tstride = (tt == 1) ? 32 : 16;
    int ps[2] = {-1, -1};
    if (pout) {
#pragma unroll
      for (int bj = 0; bj < 2; ++bj) { const int cw = u.pn * 256 + bj * 128 + wc * 32;
        if (cw >= 1792 && cw < 2432) ps[bj] = ((cw - 1792) >> 7) * 4 + wc; }
    }
#pragma unroll
    for (int ai = 0; ai < 2; ++ai) {
      f32x4 cv[4], sv[4]; float rs[4];
#pragma unroll
      for (int m = 0; m < 4; ++m) {
        const int row = row0 + ai * 128 + m * 16;
        if (tt) { const int pos = row & (SEQ - 1); cv[m] = *(const f32x4*)(ctab + pos * tstride); sv[m] = *(const f32x4*)(stab + pos * tstride); }
        rs[m] = 1.f;
        if (pin) { const f32x4 p0 = *(const f32x4*)(pin + (size_t)row * 20 + pslot), p1 = *(const f32x4*)(pin + (size_t)row * 20 + pslot + 4);
          float ss = ((p0[0] + p0[1]) + (p0[2] + p0[3])) + ((p1[0] + p1[1]) + (p1[2] + p1[3]));
          if (nK == 384) { const f32x4 p2 = *(const f32x4*)(pin + (size_t)row * 20 + pslot + 8); ss += (p2[0] + p2[1]) + (p2[2] + p2[3]); }
          rs[m] = rsqrtf(ss / (float)nK + EPS); }
      }
#pragma unroll
      for (int m = 0; m < 4; ++m) {
        const int row = row0 + ai * 128 + m * 16;
#pragma unroll
        for (int bj = 0; bj < 2; ++bj) {
          const int c0 = u.pn * 256 + bj * 128 + wc * 32 + 8 * fq;
          f32x4 v0 = acc[ai][bj][m][0] * rs[m], v1 = acc[ai][bj][m][1] * rs[m];
          if (ps[bj] >= 0) {
            float sq = (v0[0] * v0[0] + v0[1] * v0[1]) + (v0[2] * v0[2] + v0[3] * v0[3]) + (v1[0] * v1[0] + v1[1] * v1[1]) + (v1[2] * v1[2] + v1[3] * v1[3]);
            sq += __shfl_xor(sq, 16); sq += __shfl_xor(sq, 32);
            if (fq == 0) pout[(size_t)row * 20 + ps[bj]] = sq;
          }
          if (rt[bj]) {
            const f32x4 o1 = v0 * cv[m] - v1 * sv[m], o2 = v1 * cv[m] + v0 * sv[m];
            v0 = o1; v1 = o2;
          }
          u32x4 w; w.x = pk2(v0[0], v0[1]); w.y = pk2(v0[2], v0[3]); w.z = pk2(v1[0], v1[1]); w.w = pk2(v1[2], v1[3]);
          *(u32x4*)(out + (size_t)row * ldc + c0) = w;
        }
      }
    }
  }
};

DI int ropeperm64(int p) { const int g = p >> 3, r = p & 7; return r < 4 ? 4 * g + r : 32 + 4 * g + (r - 4); }
DI int ropeperm32(int p) { const int g = p >> 3, r = p & 7; return r < 4 ? 4 * g + r : 16 + 4 * g + (r - 4); }
DI int srccol(int kind, int n) {
  if (kind == 0) {
    if (n < 512) return 672 + (n & ~63) + ropeperm64(n & 63);
    if (n < 640) return 1184 + ((n - 512) & ~63) + ropeperm64(n & 63);
    if (n < 768) return 1312 + (n - 640);
    if (n < 1792) return 1440 + (n - 768);
    if (n < 2176) return n - 1792;
    if (n < 2432) return 384 + (n - 2176);
    if (n < 2464) return 640 + ropeperm32(n - 2432);
    return -1;
  }
  if (kind == 1) {
    if (n < 1024) return (n & ~63) + ropeperm64(n & 63);
    if (n < 3072) return n;
    return 3080 + (n - 3072);
  }
  if (kind == 2) { const int hd = n / 96, p = n - hd * 96; return hd * 96 + (p < 64 ? p : 64 + ropeperm32(p - 64)); }
  return n;
}
struct ConvJob { const float* W; const float* g; bf16_t* Wt; int Nsrc, K, kind, tn, tk; };
DI bool conv_decode(const Params& p, int job, ConvJob& j) {
  constexpr int NT0 = 40 * 16, NT1 = 64 * 16, NT2 = 12 * 6, NT3 = 16 * 4, NT4 = 16 * 16;
  constexpr int PER_I = NT0 + NT1 + NT2 + NT3 + 2 * NT4;
  if (job >= 2 * PER_I) return false;
  unsigned char* ws = p.ws;
  const int i = job / PER_I; int t = job - i * PER_I;
  j.g = nullptr;
  if (t < NT0) { j.W = p.ev_w_in + (size_t)i * 1024 * 2464; j.Nsrc = 2464; j.K = 1024; j.Wt = (bf16_t*)(ws + WS_WEVIN + i * SZ_WEVIN); j.kind = 0; j.tn = t / 16; j.tk = t % 16; return true; }
  t -= NT0;
  if (t < NT1) { j.W = p.od_w_in + (size_t)i * 1024 * 4104; j.Nsrc = 4104; j.K = 1024; j.Wt = (bf16_t*)(ws + WS_WODIN + i * SZ_WODIN); j.kind = 1; j.tn = t / 16; j.tk = t % 16; return true; }
  t -= NT1;
  if (t < NT2) { j.W = p.ev_w_uq + (size_t)i * 384 * 768; j.Nsrc = 768; j.K = 384; j.Wt = (bf16_t*)(ws + WS_WUQ + i * SZ_WUQ); j.kind = 2; j.g = p.ev_q_norm + i * 384; j.tn = t / 6; j.tk = t % 6; return true; }
  t -= NT2;
  if (t < NT3) { j.W = p.ev_w_ukv + (size_t)i * 256 * 1024; j.Nsrc = 1024; j.K = 256; j.Wt = (bf16_t*)(ws + WS_WUKV + i * SZ_WUKV); j.kind = 3; j.g = p.ev_kv_norm + i * 256; j.tn = t / 4; j.tk = t % 4; return true; }
  t -= NT3;
  if (t < NT4) { j.W = p.ev_w_out + (size_t)i * 1024 * 1024; j.Nsrc = 1024; j.K = 1024; j.Wt = (bf16_t*)(ws + WS_WEVOUT + i * SZ_WOUT); j.kind = 4; j.tn = t / 16; j.tk = t % 16; return true; }
  t -= NT4;
  j.W = p.od_w_out + (size_t)i * 1024 * 1024; j.Nsrc = 1024; j.K = 1024; j.Wt = (bf16_t*)(ws + WS_WODOUT + i * SZ_WOUT); j.kind = 4; j.tn = t / 16; j.tk = t % 16; return true;
}
template <int NJ>
DI void convert_tiles(const Params& p, LAS unsigned char* lds, int job0, int jstride) {
  const int tid = opaque_tid();
  const int nl = tid & 63, ks = tid >> 6;
  ConvJob j[NJ] = {}; bool ok[NJ]; float v[NJ][8];
#pragma unroll
  for (int q = 0; q < NJ; ++q) {
    ok[q] = conv_decode(p, job0 + q * jstride, j[q]);
    const int sc = ok[q] ? srccol(j[q].kind, j[q].tn * 64 + nl) : -1;
#pragma unroll
    for (int e = 0; e < 8; ++e) {
      const int k = j[q].tk * 64 + ks + 8 * e;
      v[q][e] = 0.f;
      if (sc >= 0) { v[q][e] = j[q].W[(size_t)k * j[q].Nsrc + sc]; if (j[q].g) v[q][e] *= j[q].g[k]; }
    }
  }
#pragma unroll
  for (int q = 0; q < NJ; ++q) {
    LAS bf16_t* tile = (LAS bf16_t*)(lds + q * 9216);
#pragma unroll
    for (int e = 0; e < 8; ++e) tile[nl * 72 + ks + 8 * e] = f2bf(v[q][e]);
  }
  __syncthreads();
#pragma unroll
  for (int q = 0; q < NJ; ++q) {
    if (ok[q]) {
      LAS bf16_t* tile = (LAS bf16_t*)(lds + q * 9216);
      const int n2 = tid >> 3, ch = tid & 7;
      const u32x4 w = *(const LAS u32x4*)(tile + n2 * 72 + ch * 8);
      *(u32x4*)(j[q].Wt + (size_t)(j[q].tn * 64 + n2) * j[q].K + j[q].tk * 64 + ch * 8) = w;
    }
  }
  __syncthreads();
}

DI void prologue(const Params& p, LAS unsigned char* lds) {
  const int tid = opaque_tid(), G = gridDim.x, bid = blockIdx.x;
  unsigned char* ws = p.ws;
  for (int idx = bid * 512 + tid; idx < 2048 * 48; idx += G * 512) {
    const bool isH = idx < 2048 * 32;
    const int j = isH ? idx : idx - 2048 * 32;
    const int pos = isH ? (j >> 5) : (j >> 4), i = isH ? (j & 31) : (j & 15);
    const float e = isH ? (float)(2 * i) * (1.f / 64.f) : (float)(2 * i) * (1.f / 32.f);
    const float inv = fast_exp2(-e * 13.287712379549449f);
    const float ang = (float)pos * inv;
    double t = (double)ang * 0.15915494309189535; t -= rint(t);
    const float fr = (float)t;
    const float cv = __builtin_amdgcn_cosf(fr), sv = __builtin_amdgcn_sinf(fr);
    if (isH) { ((float*)(ws + WS_COSH))[j] = cv; ((float*)(ws + WS_SINH))[j] = sv; }
    else { ((float*)(ws + WS_COSR))[j] = cv; ((float*)(ws + WS_SINR))[j] = sv; }
  }
  for (int job = bid; job < 4624; job += 4 * G) convert_tiles<4>(p, lds, job, G);
  const int item0 = G - 1 - bid;
  if (item0 < 192) {
    LAS float* cond = (LAS float*)lds;
    LAS float* red = (LAS float*)(lds + 65536);
    for (int e = tid; e < 16 * 1024; e += 512) { const int b = e >> 10, k = e & 1023; cond[k * 16 + b] = silu_f(p.c[e]); }
    __syncthreads();
    for (int item = item0; item < 192; item += G) {
      const int l = item / 48, n0 = (item % 48) * 64;
      const int col = tid & 63, kg = tid >> 6;
      float a[16];
#pragma unroll
      for (int b = 0; b < 16; ++b) a[b] = 0.f;
      const float* wp = p.w_ada + (size_t)l * 1024 * 3072 + n0 + col;
      for (int k0 = kg * 128; k0 < kg * 128 + 128; k0 += 16) {
        float wv[16];
#pragma unroll
        for (int e = 0; e < 16; ++e) wv[e] = wp[(size_t)(k0 + e) * 3072];
#pragma unroll
        for (int e = 0; e < 16; ++e) {
          const float w = wv[e]; const int k = k0 + e;
#pragma unroll
          for (int b4 = 0; b4 < 4; ++b4) { const f32x4 cv = *(const LAS f32x4*)(cond + k * 16 + b4 * 4);
            a[b4 * 4 + 0] += cv[0] * w; a[b4 * 4 + 1] += cv[1] * w; a[b4 * 4 + 2] += cv[2] * w; a[b4 * 4 + 3] += cv[3] * w; }
        }
      }
#pragma unroll
      for (int b = 0; b < 16; ++b) red[(kg * 16 + b) * 64 + col] = a[b];
      __syncthreads();
      for (int e = tid; e < 1024; e += 512) { const int b = e >> 6, cc = e & 63; float s = 0.f;
#pragma unroll
        for (int k8 = 0; k8 < 8; ++k8) s += red[(k8 * 16 + b) * 64 + cc];
        ((float*)(ws + WS_MOD))[((size_t)l * 16 + b) * 3072 + n0 + cc] = s + p.b_ada[l * 3072 + n0 + cc]; }
      __syncthreads();
    }
  }
}

DI void rowwise_phase(const Params& p, LAS unsigned char* lds, int lp, int ln) {
  const int tid = opaque_tid(), lane = tid & 63, wid = tid >> 6;
  const int gw = blockIdx.x * 8 + wid, nw = gridDim.x * 8;
  unsigned char* ws = p.ws;
  const float* mod = (const float*)(ws + WS_MOD);
  const bf16_t* ybuf = (const bf16_t*)(ws + WS_HBUF);
  bf16_t* hbuf = (bf16_t*)(ws + WS_HBUF);
  const bool ff = (ln < 4) && (ln & 1);
  LAS f32x4* wl = (LAS f32x4*)lds;
  if (ff) {
    const float* w = p.od_w_in + (size_t)(ln >> 1) * 1024 * 4104 + 3072;
    for (int c = tid; c < 1024; c += 512) {
      const f32x4 w0 = *(const f32x4*)(w + (size_t)c * 4104), w1 = *(const f32x4*)(w + (size_t)c * 4104 + 4);
      const int ln_ = (c & 255) >> 2, e = c & 3, j = c >> 8;
      wl[(j * 4 + e) * 64 + ln_] = w0; wl[1024 + (j * 4 + e) * 64 + ln_] = w1;
    }
    __syncthreads();
  }
  for (int row = gw; row < T; row += nw) {
    const int b = row >> 11;
    f32x4 xv[4];
    bf16_t* xbf = (bf16_t*)(ws + WS_XBF) + (size_t)row * DM;
    if (lp <= 0) {
      const float* xin = p.x + (size_t)row * DM;
#pragma unroll
      for (int j = 0; j < 4; ++j) xv[j] = *(const f32x4*)(xin + 4 * lane + 256 * j);
    } else {
#pragma unroll
      for (int j = 0; j < 4; ++j) { const u32x2 u = *(const u32x2*)(xbf + 4 * lane + 256 * j); xv[j] = (f32x4){bflo(u.x), bfhi(u.x), bflo(u.y), bfhi(u.y)}; }
    }
    if (lp >= 0) {
      f32x4 yv[4]; float ss = 0.f;
#pragma unroll
      for (int j = 0; j < 4; ++j) { const u32x2 u = *(const u32x2*)(ybuf + (size_t)row * DM + 4 * lane + 256 * j);
        yv[j] = (f32x4){bflo(u.x), bfhi(u.x), bflo(u.y), bfhi(u.y)}; ss += yv[j][0] * yv[j][0] + yv[j][1] * yv[j][1] + yv[j][2] * yv[j][2] + yv[j][3] * yv[j][3]; }
      ss = wave_sum(ss);
      const float rs = rsqrtf(ss * (1.f / DM) + EPS);
#pragma unroll
      for (int j = 0; j < 4; ++j) {
        const int c = 4 * lane + 256 * j;
        const f32x4 gt = *(const f32x4*)(mod + ((size_t)lp * 16 + b) * 3072 + 2048 + c);
        const f32x4 gp = *(const f32x4*)(p.g_post + lp * DM + c);
        xv[j] = xv[j] + gt * (yv[j] * rs * gp);
        if (ln >= 4) *(f32x4*)(p.out + (size_t)row * DM + c) = xv[j];
        else { u32x2 w; w.x = pk2(xv[j][0], xv[j][1]); w.y = pk2(xv[j][2], xv[j][3]); *(u32x2*)(xbf + c) = w; }
      }
    }
    if (ln < 4) {
      float ss = 0.f;
#pragma unroll
      for (int j = 0; j < 4; ++j) ss += xv[j][0] * xv[j][0] + xv[j][1] * xv[j][1] + xv[j][2] * xv[j][2] + xv[j][3] * xv[j][3];
      ss = wave_sum(ss);
      const float rs = rsqrtf(ss * (1.f / DM) + EPS);
      float zf[8];
#pragma unroll
      for (int h = 0; h < 8; ++h) zf[h] = 0.f;
#pragma unroll
      for (int j = 0; j < 4; ++j) {
        const int c = 4 * lane + 256 * j;
        const f32x4 sh = *(const f32x4*)(mod + ((size_t)ln * 16 + b) * 3072 + c);
        const f32x4 sc = *(const f32x4*)(mod + ((size_t)ln * 16 + b) * 3072 + 1024 + c);
        const f32x4 gp = *(const f32x4*)(p.g_pre + ln * DM + c);
        const f32x4 hv = (xv[j] * rs * gp) * (sc + 1.f) + sh;
        u32x2 w; w.x = pk2(hv[0], hv[1]); w.y = pk2(hv[2], hv[3]);
        *(u32x2*)(hbuf + (size_t)row * DM + c) = w;
        if (ff) {
#pragma unroll
          for (int e = 0; e < 4; ++e) {
            const f32x4 w0 = wl[(j * 4 + e) * 64 + lane], w1 = wl[1024 + (j * 4 + e) * 64 + lane];
            zf[0] += hv[e] * w0[0]; zf[1] += hv[e] * w0[1]; zf[2] += hv[e] * w0[2]; zf[3] += hv[e] * w0[3];
            zf[4] += hv[e] * w1[0]; zf[5] += hv[e] * w1[1]; zf[6] += hv[e] * w1[2]; zf[7] += hv[e] * w1[3];
          }
        }
      }
      if (ff) {
        const bool b5 = lane & 32, b4 = lane & 16, b3 = lane & 8;
        float w4[4], u2[2], t;
#pragma unroll
        for (int k = 0; k < 4; ++k) { const float send = b5 ? zf[k] : zf[4 + k], keep = b5 ? zf[4 + k] : zf[k]; w4[k] = keep + __shfl_xor(send, 32); }
#pragma unroll
        for (int k = 0; k < 2; ++k) { const float send = b4 ? w4[k] : w4[2 + k], keep = b4 ? w4[2 + k] : w4[k]; u2[k] = keep + __shfl_xor(send, 16); }
        { const float send = b3 ? u2[0] : u2[1], keep = b3 ? u2[1] : u2[0]; t = keep + __shfl_xor(send, 8); }
        t += __shfl_xor(t, 4); t += __shfl_xor(t, 2); t += __shfl_xor(t, 1);
        if ((lane & 7) == 0) {
          const int h = lane >> 3;
          const float z = t + p.od_forget_bias[(ln >> 1) * 8 + h];
          const float ls = fminf(z, 0.f) - __builtin_amdgcn_logf(1.f + fast_exp2(-fabsf(z) * LOG2E)) * 0.6931471805599453f;
          ((float*)(ws + WS_LOGF))[(size_t)row * 8 + h] = ls;
        }
      }
    }
  }
  __syncthreads();
}

DI void fox_scan(const Params& p, LAS unsigned char* lds, int bh) {
  const int tid = opaque_tid();
  const int b = bh >> 3, h = bh & 7;
  const float* logf_ = (const float*)(p.ws + WS_LOGF);
  float* fcum = (float*)(p.ws + WS_FCUM) + (size_t)bh * SEQ;
  LAS float* s = (LAS float*)lds;
  float v[4];
#pragma unroll
  for (int j = 0; j < 4; ++j) v[j] = logf_[((size_t)b * SEQ + 4 * tid + j) * 8 + h];
  v[1] += v[0]; v[2] += v[1]; v[3] += v[2];
  s[tid] = v[3];
  __syncthreads();
  for (int off = 1; off < 512; off <<= 1) {
    float t = 0.f;
    if (tid >= off) t = s[tid - off];
    __syncthreads();
    s[tid] += t;
    __syncthreads();
  }
  const float excl = s[tid] - v[3];
#pragma unroll
  for (int j = 0; j < 4; ++j) fcum[4 * tid + j] = -8.0f * (excl + v[j]);
  __syncthreads();
}

struct AttnArgs { const bf16_t *q, *k, *k2, *v, *gate; bf16_t* out; const float* fcum; int ldq, ldk, ldk2, ldv, ldo, ldg; float sl2, sink; };

DI float half_max(float x) {
  const unsigned u = __float_as_uint(x);
  auto r = __builtin_amdgcn_permlane32_swap(u, u, false, false);
  return fmaxf(__uint_as_float(r[0]), __uint_as_float(r[1]));
}
DI float half_sum(float x) {
  const unsigned u = __float_as_uint(x);
  auto r = __builtin_amdgcn_permlane32_swap(u, u, false, false);
  return __uint_as_float(r[0]) + __uint_as_float(r[1]);
}

template <int N> DI void wait_vmcnt() { asm volatile("s_waitcnt vmcnt(%0)" ::"n"(N) : "memory"); }
DI void raw_barrier() { asm volatile("" ::: "memory"); __builtin_amdgcn_s_barrier(); asm volatile("" ::: "memory"); }

template <int DQK, int DV, int MODE>
DI void attn_item(LAS unsigned char* lds, const AttnArgs& a, int qb) {
  constexpr int KSTR = DQK * 2 + 16, VSTR = (DV == 64) ? 192 : 320;
  constexpr int KG16 = KSTR / 16, VG16 = VSTR / 16;
  constexpr int KCH = KG16, VCH = VG16, NCH = KCH + VCH;
  constexpr int TILE = NCH * 1024 + (MODE == 2 ? 2048 : 0);
  constexpr int NSLOT = (NCH + 7) / 8, REM = NCH - 8 * (NSLOT - 1);
  constexpr int FX = (MODE == 2) ? 1 : 0;
  constexpr int NKS = DQK / 16, NBLK = DV / 32;
  static_assert(5 * TILE <= 155648, "ring too large");
  const int tid = opaque_tid(), wid = __builtin_amdgcn_readfirstlane(tid >> 6), lane = tid & 63, r = lane & 31, hh = lane >> 5;
  const int q0 = qb * 256, qw = q0 + 32 * wid, myq = qw + r;
  const float c = a.sl2, tau = 8.0f / a.sl2;
  bf16x8 qf[NKS];
#pragma unroll
  for (int ks = 0; ks < NKS; ++ks) qf[ks] = *(const bf16x8*)(a.q + (size_t)myq * a.ldq + 16 * ks + 8 * hh);
  int lo = 0; const int hi = 4 * (qb + 1);
  if (MODE == 1) { lo = 4 * qb - 2; if (lo < 0) lo = 0; }
  const int last_w = (qw + 31) >> 6;
  int first_w = 0;
  if (MODE == 1) { first_w = (qw > 127 ? qw - 127 : 0) >> 6; }
  const char* sp[NSLOT]; unsigned sst[NSLOT];
#pragma unroll
  for (int j = 0; j < NSLOT; ++j) {
    const int ch_ = 8 * j + wid;
    if (ch_ < KCH) {
      const int p = ch_ * 64 + lane, row = p / KG16, g = p - row * KG16;
      if (DQK == 96 && g >= 8 && g < 12) { sp[j] = (const char*)(a.k2 + (size_t)row * a.ldk2 + 8 * (g - 8)); sst[j] = (unsigned)(128 * a.ldk2); }
      else { sp[j] = (const char*)(a.k + (size_t)row * a.ldk + 8 * (g < 8 ? g : 0)); sst[j] = (unsigned)(128 * a.ldk); }
    } else {
      const int p = (ch_ - KCH) * 64 + lane, row = (p / VG16) & 63, g = p - (p / VG16) * VG16;
      sp[j] = (const char*)(a.v + (size_t)row * a.ldv + 8 * (g < DV / 8 ? g : 0)); sst[j] = (unsigned)(128 * a.ldv);
    }
  }
  auto issue = [&](int kt) {
    LAS unsigned char* base = lds + (kt % 5) * TILE;
#pragma unroll
    for (int j = 0; j < NSLOT; ++j) {
      if (j < NSLOT - 1 || wid < REM)
        __builtin_amdgcn_global_load_lds((const unsigned*)(sp[j] + (size_t)kt * sst[j]), (LAS unsigned*)(base + (8 * j + wid) * 1024), 16, 0, 0);
    }
    if (MODE == 2) __builtin_amdgcn_global_load_lds((const unsigned*)(a.fcum + kt * 64 + lane), (LAS unsigned*)(base + NCH * 1024 + wid * 256), 4, 0, 0);
  };
  auto wait_tiles = [&](bool all) {
    if (all) wait_vmcnt<0>();
    else if (wid < REM) wait_vmcnt<NSLOT + FX>();
    else wait_vmcnt<NSLOT - 1 + FX>();
  };
  f32x16 O[NBLK];
#pragma unroll
  for (int bl = 0; bl < NBLK; ++bl)
#pragma unroll
    for (int i = 0; i < 16; ++i) O[bl][i] = 0.f;
  float m = (MODE == 1) ? a.sink / a.sl2 : -1e30f;
  float l0 = (MODE == 1 && hh == 0) ? 1.f : 0.f, l1 = 0.f;
  const int i16 = lane & 15, q4 = i16 >> 2, p4 = i16 & 3, grp = (lane >> 4) & 1;
  auto qk_load = [&](int kt, bf16x8 (&kf)[2][NKS]) {
    LAS unsigned char* Kl = lds + (kt % 5) * TILE;
#pragma unroll
    for (int kb = 0; kb < 2; ++kb)
#pragma unroll
      for (int ks = 0; ks < NKS; ++ks) kf[kb][ks] = *(const LAS bf16x8*)(Kl + (32 * kb + r) * KSTR + (16 * ks + 8 * hh) * 2);
  };
  auto qk_mma = [&](int kt, const bf16x8 (&kf)[2][NKS], f32x16 (&s)[2]) {
#pragma unroll
    for (int kb = 0; kb < 2; ++kb) {
      if (MODE == 2) {
        LAS unsigned char* Fl = lds + (kt % 5) * TILE + NCH * 1024 + wid * 256;
#pragma unroll
        for (int g = 0; g < 4; ++g) { const f32x4 fb = *(const LAS f32x4*)(Fl + (32 * kb + 8 * g + 4 * hh) * 4);
          s[kb][4 * g] = fb[0]; s[kb][4 * g + 1] = fb[1]; s[kb][4 * g + 2] = fb[2]; s[kb][4 * g + 3] = fb[3]; }
      } else {
#pragma unroll
        for (int i = 0; i < 16; ++i) s[kb][i] = 0.f;
      }
    }
#pragma unroll
    for (int ks = 0; ks < NKS; ++ks)
#pragma unroll
      for (int kb = 0; kb < 2; ++kb) s[kb] = __builtin_amdgcn_mfma_f32_32x32x16_bf16(kf[kb][ks], qf[ks], s[kb], 0, 0, 0);
  };
  auto softmax = [&](int kt, f32x16 (&s)[2], bf16x8 (&pf)[2][2], auto maskc) {
    constexpr bool MASK = decltype(maskc)::value;
    const int key0 = kt * 64;
    if (MASK) {
#pragma unroll
      for (int kb = 0; kb < 2; ++kb)
#pragma unroll
        for (int i = 0; i < 16; ++i) {
          const int key = key0 + 32 * kb + (i & 3) + 8 * (i >> 2) + 4 * hh;
          bool valid = key <= myq; if (MODE == 1) valid = valid && (myq - key < 128);
          s[kb][i] = valid ? s[kb][i] : -1e30f;
        }
    }
    float mx = fmaxf(s[0][0], s[1][0]);
#pragma unroll
    for (int i = 1; i < 16; ++i) mx = fmaxf(fmaxf(mx, s[0][i]), s[1][i]);
    mx = half_max(mx);
    if (__builtin_amdgcn_ballot_w64(mx > m + tau) != 0ull) {
      const float mnew = fmaxf(m, mx);
      const float alpha = fast_exp2((m - mnew) * c);
      m = mnew;
      l0 *= alpha; l1 *= alpha;
#pragma unroll
      for (int bl = 0; bl < NBLK; ++bl)
#pragma unroll
        for (int i = 0; i < 16; ++i) O[bl][i] *= alpha;
    }
    const float nmc = -m * c;
#pragma unroll
    for (int kb = 0; kb < 2; ++kb)
#pragma unroll
      for (int s2 = 0; s2 < 2; ++s2) {
        float pv[8];
#pragma unroll
        for (int e = 0; e < 8; ++e) pv[e] = fast_exp2(__builtin_fmaf(s[kb][8 * s2 + e], c, nmc));
        l0 += (pv[0] + pv[4]) + (pv[2] + pv[6]); l1 += (pv[1] + pv[5]) + (pv[3] + pv[7]);
        u32x4 w;
        w.x = pk2(pv[0], pv[1]); w.y = pk2(pv[2], pv[3]); w.z = pk2(pv[4], pv[5]); w.w = pk2(pv[6], pv[7]);
        pf[kb][s2] = __builtin_bit_cast(bf16x8, w);
      }
  };
  auto pvmm = [&](int kt, const bf16x8 (&pf)[2][2]) {
    constexpr int PD = (NBLK == 2) ? 2 : 1;
    const unsigned va = (unsigned)(size_t)(lds + (kt % 5) * TILE + KCH * 1024 + (4 * hh + q4) * VSTR + (16 * grp) * 2 + 8 * p4);
    s16x4 vl[PD + 1][NBLK], vh[PD + 1][NBLK];
#define TRRD(dst, off) asm volatile("ds_read_b64_tr_b16 %0, %1 offset:%2" : "=&v"(dst) : "v"(va), "n"(off) : "memory")
#define TRSTEP(st_) do { _Pragma("unroll") for (int bl = 0; bl < NBLK; ++bl) { TRRD(vl[(st_) % (PD + 1)][bl], 16 * (st_) * VSTR + 64 * bl); TRRD(vh[(st_) % (PD + 1)][bl], 16 * (st_) * VSTR + 64 * bl + 8 * VSTR); } } while (0)
#define TRWAIT(n_, b_) do { if (NBLK == 2) asm volatile("s_waitcnt lgkmcnt(" #n_ ")" : "+v"(vl[b_][0]), "+v"(vh[b_][0]), "+v"(vl[b_][1]), "+v"(vh[b_][1])::"memory"); \
    else asm volatile("s_waitcnt lgkmcnt(" #n_ ")" : "+v"(vl[b_][0]), "+v"(vh[b_][0]), "+v"(vl[b_][1]), "+v"(vh[b_][1]), "+v"(vl[b_][2 % NBLK]), "+v"(vh[b_][2 % NBLK]), "+v"(vl[b_][3 % NBLK]), "+v"(vh[b_][3 % NBLK])::"memory"); } while (0)
#pragma unroll
    for (int st = 0; st < PD; ++st) TRSTEP(st);
#pragma unroll
    for (int st = 0; st < 4; ++st) {
      if (st + PD < 4) TRSTEP(st + PD);
      const int ahead = ((st + PD < 4) ? st + PD : 3) - st;
      const int b_ = st % (PD + 1);
      if (ahead * 2 * NBLK == 8) TRWAIT(8, b_); else if (ahead * 2 * NBLK == 4) TRWAIT(4, b_); else TRWAIT(0, b_);
#pragma unroll
      for (int bl = 0; bl < NBLK; ++bl) {
        const bf16x8 vf = __builtin_shufflevector(vl[b_][bl], vh[b_][bl], 0, 1, 2, 3, 4, 5, 6, 7);
        O[bl] = __builtin_amdgcn_mfma_f32_32x32x16_bf16(vf, pf[st >> 1][st & 1], O[bl], 0, 0, 0);
      }
    }
#undef TRRD
#undef TRSTEP
#undef TRWAIT
  };
  auto act = [&](int kt) { return kt <= last_w && kt >= first_w; };
  f32x16 sA[2];
  const bool halfB = wid >= 4;
  issue(lo);
  if (lo + 1 < hi) issue(lo + 1);
  if (lo + 2 < hi) issue(lo + 2);
  if (lo + 3 < hi) issue(lo + 3);
  wait_tiles(!(lo + 3 < hi));
  raw_barrier();
  if (halfB) raw_barrier();
  if (act(lo)) { bf16x8 kf0[2][NKS]; qk_load(lo, kf0); qk_mma(lo, kf0, sA); }
  auto step = [&](int kt, auto maskc) {
    const bool a0 = act(kt), a1 = (kt + 1 < hi) && act(kt + 1);
    bf16x8 pf[2][2], kf[2][NKS];
    if (a1) qk_load(kt + 1, kf);
    __builtin_amdgcn_sched_barrier(0);
    if (a0) softmax(kt, sA, pf, maskc);
    wait_tiles(!(kt + 3 < hi));
    raw_barrier();
    if (kt + 4 < hi) issue(kt + 4);
    __builtin_amdgcn_s_setprio(1);
    if (a1) qk_mma(kt + 1, kf, sA);
    if (a0) pvmm(kt, pf);
    __builtin_amdgcn_s_setprio(0);
    raw_barrier();
  };
  int split = lo;
  if (MODE != 1) { split = qw >> 6; if (split < lo) split = lo; if (split > hi) split = hi; }
  if (MODE != 1) { for (int kt = lo; kt < split; ++kt) step(kt, std::false_type{}); }
  for (int kt = split; kt < hi; ++kt) step(kt, std::true_type{});
  if (!halfB) raw_barrier();
  const float l = half_sum(l0 + l1);
  const float inv = 1.f / l;
#pragma unroll
  for (int bl = 0; bl < NBLK; ++bl)
#pragma unroll
    for (int g = 0; g < 4; ++g) {
      const int f = 32 * bl + 8 * g + 4 * hh;
      float o0 = O[bl][4 * g + 0] * inv, o1 = O[bl][4 * g + 1] * inv, o2 = O[bl][4 * g + 2] * inv, o3 = O[bl][4 * g + 3] * inv;
      if (a.gate) {
        const u32x2 gv = *(const u32x2*)(a.gate + (size_t)myq * a.ldg + f);
        o0 *= silu_f(bflo(gv.x)); o1 *= silu_f(bfhi(gv.x)); o2 *= silu_f(bflo(gv.y)); o3 *= silu_f(bfhi(gv.y));
      }
      u32x2 w; w.x = pk2(o0, o1); w.y = pk2(o2, o3);
      *(u32x2*)(a.out + (size_t)myq * a.ldo + f) = w;
    }
}


DI void swa_item(LAS unsigned char* lds, const AttnArgs& a, const float* sinks4, int qb) {
  constexpr int KSTR = 144, VSTR = 192, KCH = 9, VCH = 12, NCH = 21, TILE = NCH * 1024, NSLOT = 3, REM = 5, NKS = 4, NBLK = 2;
  const int tid = opaque_tid(), wid = __builtin_amdgcn_readfirstlane(tid >> 6), lane = tid & 63, r = lane & 31, hh = lane >> 5;
  const int q0 = qb * 256, qw = q0 + 32 * wid, myq = qw + r;
  const float c = a.sl2, tau = 8.0f / a.sl2;
  int lo = 4 * qb - 2; if (lo < 0) lo = 0;
  const int hi = 4 * (qb + 1);
  const int last_w = (qw + 31) >> 6, first_w = (qw > 127 ? qw - 127 : 0) >> 6;
#pragma unroll
  for (int j = 0; j < NSLOT; ++j) {
    const int ch_ = 8 * j + wid;
    if (j < NSLOT - 1 || wid < REM) {
      const char* sp; unsigned sst;
      if (ch_ < KCH) { const int p = ch_ * 64 + lane, row = p / 9, g = p - row * 9;
        sp = (const char*)(a.k + (size_t)row * a.ldk + 8 * (g < 8 ? g : 0)); sst = (unsigned)(128 * a.ldk); }
      else { const int p = (ch_ - KCH) * 64 + lane, row = (p / 12) & 63, g = p - (p / 12) * 12;
        sp = (const char*)(a.v + (size_t)row * a.ldv + 8 * (g < 8 ? g : 0)); sst = (unsigned)(128 * a.ldv); }
      for (int kt = lo; kt < hi; ++kt)
        __builtin_amdgcn_global_load_lds((const unsigned*)(sp + (size_t)kt * sst), (LAS unsigned*)(lds + (kt - lo) * TILE + ch_ * 1024), 16, 0, 0);
    }
  }
  wait_vmcnt<0>();
  raw_barrier();
  const int i16 = lane & 15, q4 = i16 >> 2, p4 = i16 & 3, grp = (lane >> 4) & 1;
  for (int h4 = 0; h4 < 4; ++h4) {
    bf16x8 qf[NKS];
#pragma unroll
    for (int ks = 0; ks < NKS; ++ks) qf[ks] = *(const bf16x8*)(a.q + (size_t)myq * a.ldq + h4 * 64 + 16 * ks + 8 * hh);
    f32x16 O[NBLK];
#pragma unroll
    for (int bl = 0; bl < NBLK; ++bl)
#pragma unroll
      for (int i = 0; i < 16; ++i) O[bl][i] = 0.f;
    float m = sinks4[h4] / a.sl2;
    float l0 = (hh == 0) ? 1.f : 0.f, l1 = 0.f;
    for (int kt = first_w; kt <= last_w; ++kt) {
      LAS unsigned char* Kl = lds + (kt - lo) * TILE;
      f32x16 s[2];
      bf16x8 kf[2][NKS];
#pragma unroll
      for (int kb = 0; kb < 2; ++kb)
#pragma unroll
        for (int ks = 0; ks < NKS; ++ks) kf[kb][ks] = *(const LAS bf16x8*)(Kl + (32 * kb + r) * KSTR + (16 * ks + 8 * hh) * 2);
#pragma unroll
      for (int kb = 0; kb < 2; ++kb)
#pragma unroll
        for (int i = 0; i < 16; ++i) s[kb][i] = 0.f;
#pragma unroll
      for (int ks = 0; ks < NKS; ++ks)
#pragma unroll
        for (int kb = 0; kb < 2; ++kb) s[kb] = __builtin_amdgcn_mfma_f32_32x32x16_bf16(kf[kb][ks], qf[ks], s[kb], 0, 0, 0);
      const int key0 = kt * 64;
#pragma unroll
      for (int kb = 0; kb < 2; ++kb)
#pragma unroll
        for (int i = 0; i < 16; ++i) {
          const int key = key0 + 32 * kb + (i & 3) + 8 * (i >> 2) + 4 * hh;
          const bool valid = (key <= myq) && (myq - key < 128);
          s[kb][i] = valid ? s[kb][i] : -1e30f;
        }
      float mx = fmaxf(s[0][0], s[1][0]);
#pragma unroll
      for (int i = 1; i < 16; ++i) mx = fmaxf(fmaxf(mx, s[0][i]), s[1][i]);
      mx = half_max(mx);
      if (__builtin_amdgcn_ballot_w64(mx > m + tau) != 0ull) {
        const float mnew = fmaxf(m, mx);
        const float alpha = fast_exp2((m - mnew) * c);
        m = mnew; l0 *= alpha; l1 *= alpha;
#pragma unroll
        for (int bl = 0; bl < NBLK; ++bl)
#pragma unroll
          for (int i = 0; i < 16; ++i) O[bl][i] *= alpha;
      }
      const float nmc = -m * c;
      bf16x8 pf[2][2];
#pragma unroll
      for (int kb = 0; kb < 2; ++kb)
#pragma unroll
        for (int s2 = 0; s2 < 2; ++s2) {
          float pv[8];
#pragma unroll
          for (int e = 0; e < 8; ++e) pv[e] = fast_exp2(__builtin_fmaf(s[kb][8 * s2 + e], c, nmc));
          l0 += (pv[0] + pv[4]) + (pv[2] + pv[6]); l1 += (pv[1] + pv[5]) + (pv[3] + pv[7]);
          u32x4 w;
          w.x = pk2(pv[0], pv[1]); w.y = pk2(pv[2], pv[3]); w.z = pk2(pv[4], pv[5]); w.w = pk2(pv[6], pv[7]);
          pf[kb][s2] = __builtin_bit_cast(bf16x8, w);
        }
      LAS unsigned char* Vl = Kl + KCH * 1024 + (4 * hh + q4) * VSTR + (16 * grp) * 2 + 8 * p4;
#pragma unroll
      for (int st = 0; st < 4; ++st)
#pragma unroll
        for (int bl = 0; bl < NBLK; ++bl) {
          LAS unsigned char* ad = Vl + (16 * st) * VSTR + (32 * bl) * 2;
          const s16x4 lo_ = __builtin_amdgcn_ds_read_tr16_b64_v4i16((LAS s16x4*)ad);
          const s16x4 hi_ = __builtin_amdgcn_ds_read_tr16_b64_v4i16((LAS s16x4*)(ad + 8 * VSTR));
          const bf16x8 vf = __builtin_shufflevector(lo_, hi_, 0, 1, 2, 3, 4, 5, 6, 7);
          O[bl] = __builtin_amdgcn_mfma_f32_32x32x16_bf16(vf, pf[st >> 1][st & 1], O[bl], 0, 0, 0);
        }
    }
    const float l = half_sum(l0 + l1);
    const float inv = 1.f / l;
#pragma unroll
    for (int bl = 0; bl < NBLK; ++bl)
#pragma unroll
      for (int g = 0; g < 4; ++g) {
        const int f = h4 * 64 + 32 * bl + 8 * g + 4 * hh;
        float o0 = O[bl][4 * g + 0] * inv, o1 = O[bl][4 * g + 1] * inv, o2 = O[bl][4 * g + 2] * inv, o3 = O[bl][4 * g + 3] * inv;
        const u32x2 gv = *(const u32x2*)(a.gate + (size_t)myq * a.ldg + f);
        o0 *= silu_f(bflo(gv.x)); o1 *= silu_f(bfhi(gv.x)); o2 *= silu_f(bflo(gv.y)); o3 *= silu_f(bfhi(gv.y));
        u32x2 w; w.x = pk2(o0, o1); w.y = pk2(o2, o3);
        *(u32x2*)(a.out + (size_t)myq * a.ldo + f) = w;
      }
  }
  __syncthreads();
}

DI bool team_item(int G, int c, int n, int& bh, int& qb) {
  if (G == 256) {
    const int x = c & 7, li = c >> 3, t = li >> 3, i = li & 7;
    bh = x + 8 * (4 * t + n);
    const int j = (i + 4) & 7;
    qb = (n == 0) ? i : (n == 1) ? 7 - i : (n == 2) ? j : 7 - j;
    return true;
  }
  const int idx = n * G + ((n & 1) ? (G - 1 - c) : c);
  if (idx >= 1024) return false;
  qb = 7 - idx / 128; bh = idx % 128;
  return true;
}

DI int snake_idx(int round, int G, int c) { return round * G + ((round & 1) ? (G - 1 - c) : c); }

DI void attn_even(const Params& p, LAS unsigned char* lds, int i) {
  const int G = gridDim.x, c = blockIdx.x;
  unsigned char* ws = p.ws;
  const bf16_t* z = (const bf16_t*)(ws + WS_ZBUF);
  const bf16_t* qb_ = (const bf16_t*)(ws + WS_QBUF);
  const bf16_t* kv = (const bf16_t*)(ws + WS_HBUF);
  bf16_t* ob = (bf16_t*)(ws + WS_OBUF);
  for (int rd = 0; rd * G < 1024; ++rd) {
    int qb, bh;
    if (!team_item(G, c, rd, bh, qb)) continue;
    const int b = bh >> 3, hd = bh & 7;
    AttnArgs a;
    a.q = qb_ + (size_t)b * SEQ * 768 + hd * 96; a.ldq = 768;
    a.k = kv + (size_t)b * SEQ * 1024 + hd * 128; a.ldk = 1024;
    a.k2 = z + (size_t)b * SEQ * 2560 + 2432; a.ldk2 = 2560;
    a.v = kv + (size_t)b * SEQ * 1024 + hd * 128 + 64; a.ldv = 1024;
    a.out = ob + (size_t)b * SEQ * 1024 + hd * 64; a.ldo = 1024;
    a.gate = z + (size_t)b * SEQ * 2560 + 768 + hd * 64; a.ldg = 2560;
    a.fcum = nullptr; a.sl2 = 0.10206207261596577f * LOG2E; a.sink = 0.f;
    attn_item<96, 64, 0>(lds, a, qb);
  }
  for (int it = c; it < 256; it += G) {
    const int b = it >> 4, kvh = (it >> 3) & 1, qb = it & 7;
    AttnArgs a;
    const bf16_t* zb = z + (size_t)b * SEQ * 2560;
    a.q = zb + kvh * 256; a.ldq = 2560;
    a.k = zb + 512 + kvh * 64; a.ldk = 2560; a.k2 = nullptr; a.ldk2 = 0;
    a.v = zb + 640 + kvh * 64; a.ldv = 2560;
    a.out = ob + (size_t)b * SEQ * 1024 + 512 + kvh * 256; a.ldo = 1024;
    a.gate = zb + 768 + 512 + kvh * 256; a.ldg = 2560;
    a.fcum = nullptr; a.sl2 = 0.125f * LOG2E; a.sink = 0.f;
    float sk[4];
#pragma unroll
    for (int h4 = 0; h4 < 4; ++h4) sk[h4] = p.ev_sinks[i * 8 + kvh * 4 + h4] * LOG2E;
    swa_item(lds, a, sk, qb);
  }
}

DI void attn_odd(const Params& p, LAS unsigned char* lds, int layer) {
  const int G = gridDim.x, c = blockIdx.x;
  unsigned char* ws = p.ws;
  const bf16_t* z = (const bf16_t*)(ws + WS_ZBUF);
  bf16_t* od = (bf16_t*)(ws + WS_HBUF);
  bf16_t* ob = (bf16_t*)(ws + WS_OBUF);
  {
    for (int rd = 0; rd * G < 512; ++rd) {
      int qb, bh2;
      if (G == 256) { const int x = c & 7, li = c >> 3, t = li >> 3, i = li & 7; bh2 = x + 8 * (2 * t + rd); qb = (rd == 0) ? i : 7 - i; }
      else { const int idx = snake_idx(rd, G, c); if (idx >= 512) continue; qb = 7 - idx / 64; bh2 = idx % 64; }
      const int b = bh2 >> 2, h = bh2 & 3;
      const bf16_t* zb = z + (size_t)b * SEQ * 4096;
      for (int mp = 0; mp < 2; ++mp) {
        const int j = 2 * h + mp;
        AttnArgs a;
        a.q = zb + j * 64; a.ldq = 4096;
        a.k = zb + 512 + j * 64; a.ldk = 4096; a.k2 = nullptr; a.ldk2 = 0;
        a.v = zb + 1024 + h * 128; a.ldv = 4096;
        a.out = od + (size_t)b * SEQ * 1024 + j * 128; a.ldo = 1024;
        a.gate = nullptr; a.ldg = 0;
        a.fcum = nullptr; a.sl2 = 0.125f * LOG2E; a.sink = 0.f;
#ifndef SKIP_DIFF
        attn_item<64, 128, 0>(lds, a, qb);
#endif
      }
      __builtin_amdgcn_fence(__ATOMIC_SEQ_CST, "workgroup");
      asm volatile("s_waitcnt vmcnt(0)" ::: "memory");
      const int tid2 = opaque_tid(), lane = tid2 & 63, wid = tid2 >> 6, li_ = layer >> 1;
      const float* lp = p.od_lambda + li_ * 256;
      const float s1 = wave_sum(lp[lane] * lp[64 + lane]), s2 = wave_sum(lp[128 + lane] * lp[192 + lane]);
      const float lam_init = 0.8f - 0.6f * fast_exp2(-0.3f * LOG2E * (float)layer);
      const float lam = fast_exp2(s1 * LOG2E) - fast_exp2(s2 * LOG2E) + lam_init;
      const int rsub = lane >> 4, dv = (lane & 15) * 8;
      float sub[8];
#pragma unroll
      for (int e = 0; e < 8; ++e) sub[e] = p.od_subln[li_ * 128 + dv + e] * (1.f - lam_init);
      const size_t row0 = (size_t)b * SEQ + qb * 256 + 32 * wid;
#pragma unroll 2
      for (int rr = 0; rr < 8; ++rr) {
        const size_t row = row0 + 4 * rr + rsub;
        const u32x4 va = *(const u32x4*)(od + row * 1024 + (2 * h) * 128 + dv);
        const u32x4 vb = *(const u32x4*)(od + row * 1024 + (2 * h + 1) * 128 + dv);
        const u32x4 vg = *(const u32x4*)(z + row * 4096 + 3072 + h * 128 + dv);
        float d[8]; float ss = 0.f;
#pragma unroll
        for (int e = 0; e < 4; ++e) { d[2 * e] = bflo(va[e]) - lam * bflo(vb[e]); d[2 * e + 1] = bfhi(va[e]) - lam * bfhi(vb[e]); ss += d[2 * e] * d[2 * e] + d[2 * e + 1] * d[2 * e + 1]; }
        ss += __shfl_xor(ss, 1); ss += __shfl_xor(ss, 2); ss += __shfl_xor(ss, 4); ss += __shfl_xor(ss, 8);
        const float rs = rsqrtf(ss * (1.f / 128.f) + EPS);
        u32x4 w;
#pragma unroll
        for (int e = 0; e < 4; ++e) {
          const float o0 = d[2 * e] * rs * sub[2 * e] * silu_f(bflo(vg[e])), o1 = d[2 * e + 1] * rs * sub[2 * e + 1] * silu_f(bfhi(vg[e]));
          w[e] = pk2(o0, o1);
        }
        *(u32x4*)(ob + row * 1024 + h * 128 + dv) = w;
      }
    }
  }
  for (int rd = 0; rd * G < 1024; ++rd) {
    int qb, bh;
    if (!team_item(G, c, rd, bh, qb)) continue;
    const int b = bh >> 3, hd = bh & 7;
    AttnArgs a;
    const bf16_t* zb = z + (size_t)b * SEQ * 4096;
    a.q = zb + 1536 + hd * 64; a.ldq = 4096;
    a.k = zb + 2048 + hd * 64; a.ldk = 4096; a.k2 = nullptr; a.ldk2 = 0;
    a.v = zb + 2560 + hd * 64; a.ldv = 4096;
    a.out = ob + (size_t)b * SEQ * 1024 + 512 + hd * 64; a.ldo = 1024;
    a.gate = zb + 3072 + 512 + hd * 64; a.ldg = 4096;
    a.fcum = (const float*)(ws + WS_FCUM) + (size_t)bh * SEQ; a.sl2 = 0.125f * LOG2E; a.sink = 0.f;
#ifndef SKIP_FOX
    attn_item<64, 64, 2>(lds, a, qb);
#endif
  }
}

DI void diff_combine(const Params& p, int layer) {
  const int tid = opaque_tid(), lane = tid & 63, wid = tid >> 6;
  const int gw = blockIdx.x * 8 + wid, nw = gridDim.x * 8;
  const int i = layer >> 1;
  unsigned char* ws = p.ws;
  const bf16_t* od = (const bf16_t*)(ws + WS_HBUF);
  const bf16_t* z = (const bf16_t*)(ws + WS_ZBUF);
  bf16_t* ob = (bf16_t*)(ws + WS_OBUF);
  const float* lp = p.od_lambda + i * 256;
  const float s1 = wave_sum(lp[lane] * lp[64 + lane]), s2 = wave_sum(lp[128 + lane] * lp[192 + lane]);
  const float lam_init = 0.8f - 0.6f * expf(-0.3f * (float)layer);
  const float lam = expf(s1) - expf(s2) + lam_init;
  const int hd = lane >> 4, dv = (lane & 15) * 8;
  float sub[8];
#pragma unroll
  for (int e = 0; e < 8; ++e) sub[e] = p.od_subln[i * 128 + dv + e] * (1.f - lam_init);
  for (int row = gw; row < T; row += nw) {
    const u32x4 a = *(const u32x4*)(od + (size_t)row * 1024 + (2 * hd) * 128 + dv);
    const u32x4 b = *(const u32x4*)(od + (size_t)row * 1024 + (2 * hd + 1) * 128 + dv);
    const u32x4 g = *(const u32x4*)(z + (size_t)row * 4096 + 3072 + hd * 128 + dv);
    float d[8]; float ss = 0.f;
#pragma unroll
    for (int e = 0; e < 4; ++e) { d[2 * e] = bflo(a[e]) - lam * bflo(b[e]); d[2 * e + 1] = bfhi(a[e]) - lam * bfhi(b[e]); ss += d[2 * e] * d[2 * e] + d[2 * e + 1] * d[2 * e + 1]; }
    ss += __shfl_xor(ss, 1); ss += __shfl_xor(ss, 2); ss += __shfl_xor(ss, 4); ss += __shfl_xor(ss, 8);
    const float rs = rsqrtf(ss * (1.f / 128.f) + EPS);
    u32x4 w;
#pragma unroll
    for (int e = 0; e < 4; ++e) {
      const float o0 = d[2 * e] * rs * sub[2 * e] * silu_f(bflo(g[e])), o1 = d[2 * e + 1] * rs * sub[2 * e + 1] * silu_f(bfhi(g[e]));
      w[e] = pk2(o0, o1);
    }
    *(u32x4*)(ob + (size_t)row * 1024 + hd * 128 + dv) = w;
  }
}


DI void grid_barrier(unsigned* ctr, unsigned& epoch) {
  asm volatile("s_waitcnt vmcnt(0)" ::: "memory");
  __syncthreads();
  epoch += 1;
  if (threadIdx.x == 0) {
    __builtin_amdgcn_fence(__ATOMIC_RELEASE, "agent");
    asm volatile("s_waitcnt vmcnt(0)" ::: "memory");
    __hip_atomic_fetch_add(ctr, 1u, __ATOMIC_RELAXED, __HIP_MEMORY_SCOPE_AGENT);
    const unsigned target = epoch * gridDim.x;
    while (__hip_atomic_load(ctr, __ATOMIC_RELAXED, __HIP_MEMORY_SCOPE_AGENT) < target) __builtin_amdgcn_s_sleep(1);
    __builtin_amdgcn_fence(__ATOMIC_ACQUIRE, "agent");
    asm volatile("s_waitcnt vmcnt(0)" ::: "memory");
  }
  __syncthreads();
}


#define XB_TMO      128
#define XB_XCNT(j)  (256  + 64 * (j))
#define XB_XSUB(j)  (1280 + 64 * (j))
#define XB_XGEN(j)  (2304 + 64 * (j))
#define XB_TOP      3328
#define XB_TOPGEN   3392
#define XCD_BAR_WORDS 3456
#define XB_SPIN_CAP (1u << 20)
DI unsigned xb_ld(unsigned* p) { return __hip_atomic_load(p, __ATOMIC_RELAXED, __HIP_MEMORY_SCOPE_AGENT); }
DI unsigned xb_add(unsigned* p, unsigned v) { return __hip_atomic_fetch_add(p, v, __ATOMIC_RELAXED, __HIP_MEMORY_SCOPE_AGENT); }
DI unsigned xb_xcc_id() { return (unsigned)__builtin_amdgcn_s_getreg((3 << 11) | 20) & 0xFu; }
#define XB_SPIN(cond, bar) do { unsigned _sp = 0; while (cond) { __builtin_amdgcn_s_sleep(1); \
    if ((++_sp & 255u) == 0u) { if (xb_ld(&(bar)[XB_TMO])) break; if (_sp > XB_SPIN_CAP) { atomicAdd(&(bar)[XB_TMO], 1u); break; } } } } while (0)
struct XcdBarrier { unsigned* bar; unsigned x; volatile LAS unsigned* st; };
DI void xcd_barrier_complete(unsigned* bar, unsigned x, unsigned& nloc, unsigned& nx) {
  const unsigned G = gridDim.x;
  unsigned sum, cnt, mine, sp = 0u;
  for (;;) {
    sum = 0u; cnt = 0u; mine = 0u;
#pragma unroll
    for (unsigned j = 0; j < 16; ++j) { const unsigned c = xb_ld(&bar[XB_XCNT(j)]); sum += c; cnt += (c > 0u) ? 1u : 0u; mine = (j == x) ? c : mine; }
    if (sum == G) break;
    __builtin_amdgcn_s_sleep(1);
    if ((++sp & 255u) == 0u) { if (xb_ld(&bar[XB_TMO])) break; if (sp > XB_SPIN_CAP) { atomicAdd(&bar[XB_TMO], 1u); break; } }
  }
  nloc = mine > 0u ? mine : 1u; nx = cnt > 0u ? cnt : 1u;
}
DI void xcd_barrier(const XcdBarrier& b) {
  asm volatile("s_waitcnt vmcnt(0)" ::: "memory");
  __syncthreads();
  if (threadIdx.x == 0) {
    unsigned* bar = b.bar;
    __builtin_amdgcn_s_waitcnt(0);
    unsigned nloc = b.st[0], nx = b.st[1];
    if (nloc == 0u) { xcd_barrier_complete(bar, b.x, nloc, nx); b.st[0] = nloc; b.st[1] = nx; }
    const unsigned old = xb_add(&bar[XB_XSUB(b.x)], 1u);
    const unsigned gen = old / nloc;
    if (old + 1u == (gen + 1u) * nloc) {
      __builtin_amdgcn_fence(__ATOMIC_RELEASE, "agent");
      asm volatile("s_waitcnt vmcnt(0)" ::: "memory");
      const unsigned og = xb_add(&bar[XB_TOP], 1u);
      const unsigned tg = og / nx;
      if (og + 1u == (tg + 1u) * nx) xb_add(&bar[XB_TOPGEN], 1u);
      else XB_SPIN(xb_ld(&bar[XB_TOPGEN]) == tg, bar);
      __builtin_amdgcn_fence(__ATOMIC_ACQUIRE, "agent");
      xb_add(&bar[XB_XGEN(b.x)], 1u);
      asm volatile("s_waitcnt vmcnt(0)" ::: "memory");
    } else {
      XB_SPIN(xb_ld(&bar[XB_XGEN(b.x)]) == gen, bar);
      __builtin_amdgcn_fence(__ATOMIC_ACQUIRE, "agent");
      asm volatile("s_waitcnt vmcnt(0)" ::: "memory");
    }
  }
  __syncthreads();
}

__global__ void __launch_bounds__(512) fwd_megakernel(Params p) {
  extern __shared__ __attribute__((aligned(16))) unsigned char lds_raw[];
  LAS unsigned char* lds = (LAS unsigned char*)lds_raw;
  cg::grid_group grid = cg::this_grid();
  unsigned char* ws = p.ws;
  const int G = gridDim.x, bid = blockIdx.x;
  const float* cosH = (const float*)(ws + WS_COSH); const float* sinH = (const float*)(ws + WS_SINH);
  const float* cosR = (const float*)(ws + WS_COSR); const float* sinR = (const float*)(ws + WS_SINR);

  unsigned* xbar = (unsigned*)(ws + WS_XBAR);
  if (bid == 0) { for (int w = threadIdx.x; w < XCD_BAR_WORDS; w += 512) __hip_atomic_store(xbar + w, 0u, __ATOMIC_RELAXED, __HIP_MEMORY_SCOPE_AGENT); }
  volatile LAS unsigned* xst = (volatile LAS unsigned*)(lds + LDS_BYTES_C - 16);
  if (threadIdx.x == 0) { xst[0] = 0u; xst[1] = 0u; }
#ifndef SKIP_PRO
  prologue(p, lds);
#endif
  grid.sync();
  XcdBarrier xb; xb.bar = xbar; xb.x = xb_xcc_id(); xb.st = xst;
  if (threadIdx.x == 0) (void)xb_add(&xbar[XB_XCNT(xb.x)], 1u);
#pragma unroll
  for (int layer = 0; layer < 4; ++layer) {
    const int i = layer >> 1; const bool odd = layer & 1;
#ifndef SKIP_ROW
    rowwise_phase(p, lds, layer - 1, layer);
#endif
    xcd_barrier(xb);
    {
#ifndef SKIP_SCAN
      if (odd && bid < 128) fox_scan(p, lds, bid);
#endif
      pg8::Gemm g; g.A = (const bf16_t*)(ws + WS_HBUF); g.lda = 1024; g.K = 1024; g.M = T;
      Epi e; e.out = (bf16_t*)(ws + WS_ZBUF); e.pin = nullptr; e.pslot = 0; e.nK = 0; e.qmode = 0; e.pout = odd ? nullptr : (float*)(ws + WS_PART); e.cosH = cosH; e.sinH = sinH; e.cosR = cosR; e.sinR = sinR;
      if (!odd) { g.Bt = (const bf16_t*)(ws + WS_WEVIN + i * SZ_WEVIN); g.N = 2560; e.ldc = 2560; e.rope64_end = 640; e.rope32_lo = 2432; e.rope32_hi = 2464; }
      else { g.Bt = (const bf16_t*)(ws + WS_WODIN + i * SZ_WODIN); g.N = 4096; e.ldc = 4096; e.rope64_end = 1024; e.rope32_lo = 0; e.rope32_hi = 0; }
      pg8::StaticOrder S; S.init(g.M, g.N, G, bid);
#ifndef SKIP_G1
      pg8::gemm_phase<Epi>(lds, g, S, e);
#endif
    }
    xcd_barrier(xb);
    if (!odd) {
      for (int which = 0; which < 2; ++which) {
        pg8::Gemm g; g.M = T; g.lda = 2560;
        Epi e; e.rope64_end = 0; e.rope32_lo = 0; e.rope32_hi = 0; e.cosH = cosH; e.sinH = sinH; e.cosR = cosR; e.sinR = sinR; e.pout = nullptr; e.pin = (const float*)(ws + WS_PART);
        if (which == 0) { g.A = (const bf16_t*)(ws + WS_ZBUF) + 1792; g.Bt = (const bf16_t*)(ws + WS_WUQ + i * SZ_WUQ); g.N = 768; g.K = 384;
          e.out = (bf16_t*)(ws + WS_QBUF); e.ldc = 768; e.qmode = 1; e.pslot = 0; e.nK = 384; }
        else { g.A = (const bf16_t*)(ws + WS_ZBUF) + 2176; g.Bt = (const bf16_t*)(ws + WS_WUKV + i * SZ_WUKV); g.N = 1024; g.K = 256;
          e.out = (bf16_t*)(ws + WS_HBUF); e.ldc = 1024; e.qmode = 0; e.pslot = 12; e.nK = 256; }
        pg8::StaticOrder S; S.init(g.M, g.N, G, bid);
#ifndef SKIP_G2
        pg8::gemm_phase<Epi>(lds, g, S, e);
#endif
      }
      xcd_barrier(xb);
#ifndef SKIP_ATTE
      attn_even(p, lds, i);
#endif
      xcd_barrier(xb);
    } else {
#ifndef SKIP_ATTO
      attn_odd(p, lds, layer);
#endif
      xcd_barrier(xb);
    }
    {
      pg8::Gemm g; g.A = (const bf16_t*)(ws + WS_OBUF); g.lda = 1024; g.K = 1024; g.M = T; g.N = 1024;
      g.Bt = (const bf16_t*)(ws + (odd ? WS_WODOUT : WS_WEVOUT) + i * SZ_WOUT);
      Epi e; e.out = (bf16_t*)(ws + WS_HBUF); e.ldc = 1024; e.pin = nullptr; e.pslot = 0; e.pout = nullptr; e.nK = 0; e.qmode = 0; e.rope64_end = 0; e.rope32_lo = 0; e.rope32_hi = 0;
      e.cosH = cosH; e.sinH = sinH; e.cosR = cosR; e.sinR = sinR;
      pg8::StaticOrder S; S.init(g.M, g.N, G, bid);
#ifndef SKIP_G3
      pg8::gemm_phase<Epi>(lds, g, S, e);
#endif
    }
    xcd_barrier(xb);
  }
#ifndef SKIP_ROW
  rowwise_phase(p, lds, 3, 4);
#endif
}

constexpr int LDS_BYTES = 155648;
static_assert(LDS_BYTES == LDS_BYTES_C, "LDS size mismatch");

extern "C" void kernel_launch(void* const* d_in, const int* in_sizes, int n_in, void* d_out, int out_size, void* d_ws, size_t ws_size, hipStream_t stream) {
  static int grid_blocks = 0;
  if (grid_blocks == 0) {
    int dev = 0, cus = 0, per_cu = 0;
    if (hipGetDevice(&dev) != hipSuccess || hipDeviceGetAttribute(&cus, hipDeviceAttributeMultiprocessorCount, dev) != hipSuccess) { fprintf(stderr, "device query failed\n"); grid_blocks = -1; return; }
    if (hipFuncSetAttribute((const void*)fwd_megakernel, hipFuncAttributeMaxDynamicSharedMemorySize, LDS_BYTES) != hipSuccess) { fprintf(stderr, "hipFuncSetAttribute failed\n"); grid_blocks = -1; return; }
    if (hipOccupancyMaxActiveBlocksPerMultiprocessor(&per_cu, (const void*)fwd_megakernel, 512, LDS_BYTES) != hipSuccess || per_cu < 1) { fprintf(stderr, "occupancy query: %d\n", per_cu); per_cu = 1; }
    (void)hipGetLastError();
    grid_blocks = cus;
    if (ws_size < WS_END) { fprintf(stderr, "workspace too small: %zu < %zu\n", ws_size, (size_t)WS_END); grid_blocks = -1; return; }
  }
  if (grid_blocks < 0) return;
  Params p{};
  const float** fp = (const float**)&p;
  for (int i = 0; i < 18; ++i) fp[i] = (const float*)d_in[i];
  p.out = (float*)d_out; p.ws = (unsigned char*)d_ws;
  void* args[] = {&p};
  hipError_t e = hipLaunchCooperativeKernel((const void*)fwd_megakernel, dim3(grid_blocks), dim3(512), args, LDS_BYTES, stream);
  if (e != hipSuccess) fprintf(stderr, "cooperative launch failed: %s (grid %d)\n", hipGetErrorString(e), grid_blocks);
}
```

```cpp
#include <hip/hip_runtime.h>
#include <hip/hip_cooperative_groups.h>
#include <cstdio>
#include <type_traits>
namespace cg = cooperative_groups;

#define DI __device__ __forceinline__
#define LAS __attribute__((address_space(3)))
typedef unsigned short bf16_t;
typedef short bf16x8 __attribute__((ext_vector_type(8)));
typedef short s16x4 __attribute__((ext_vector_type(4)));
typedef float f32x2 __attribute__((ext_vector_type(2)));
typedef float f32x4 __attribute__((ext_vector_type(4)));
typedef float f32x16 __attribute__((ext_vector_type(16)));
typedef unsigned u32x2 __attribute__((ext_vector_type(2)));
typedef unsigned u32x4 __attribute__((ext_vector_type(4)));
typedef __bf16 bf16x2_t __attribute__((ext_vector_type(2)));

constexpr int T = 32768, DM = 1024, NB = 16, SEQ = 2048;
constexpr float LOG2E = 1.4426950408889634f;
constexpr float EPS = 1e-6f;
constexpr int LDS_BYTES_C = 155648;

constexpr size_t SZ_WEVIN = 2560ull * 1024 * 2, SZ_WODIN = 4096ull * 1024 * 2, SZ_WUQ = 768ull * 384 * 2, SZ_WUKV = 1024ull * 256 * 2, SZ_WOUT = 1024ull * 1024 * 2;
constexpr size_t WS_WEVIN = 0;
constexpr size_t WS_WODIN = WS_WEVIN + 2 * SZ_WEVIN;
constexpr size_t WS_WUQ = WS_WODIN + 2 * SZ_WODIN;
constexpr size_t WS_WUKV = WS_WUQ + 2 * SZ_WUQ;
constexpr size_t WS_WEVOUT = WS_WUKV + 2 * SZ_WUKV;
constexpr size_t WS_WODOUT = WS_WEVOUT + 2 * SZ_WOUT;
constexpr size_t WS_MOD = WS_WODOUT + 2 * SZ_WOUT;
constexpr size_t WS_COSH = WS_MOD + 4ull * 16 * 3072 * 4;
constexpr size_t WS_SINH = WS_COSH + 2048ull * 32 * 4;
constexpr size_t WS_COSR = WS_SINH + 2048ull * 32 * 4;
constexpr size_t WS_SINR = WS_COSR + 2048ull * 16 * 4;
constexpr size_t WS_LOGF = WS_SINR + 2048ull * 16 * 4;
constexpr size_t WS_FCUM = WS_LOGF + (size_t)T * 8 * 4;
constexpr size_t WS_HBUF = (WS_FCUM + (size_t)T * 8 * 4 + 4095) & ~(size_t)4095;
constexpr size_t WS_OBUF = WS_HBUF + (size_t)T * 1024 * 2;
constexpr size_t WS_ZBUF = WS_OBUF + (size_t)T * 1024 * 2;
constexpr size_t WS_QBUF = WS_ZBUF + (size_t)T * 2560 * 2;
constexpr size_t WS_BAR = WS_ZBUF + (size_t)T * 4096 * 2;
constexpr size_t WS_PART = WS_BAR + 256;
constexpr size_t WS_XBAR = (WS_PART + (size_t)T * 20 * 4 + 4095) & ~(size_t)4095;
constexpr size_t WS_XBF_PRE = WS_XBAR + 16384;
constexpr size_t WS_XBF = WS_XBF_PRE;
constexpr size_t WS_END = WS_XBF + (size_t)T * 1024 * 2;

struct Params {
  const float *x, *c, *w_ada, *b_ada, *g_pre, *g_post, *ev_w_in, *ev_q_norm, *ev_kv_norm, *ev_w_uq, *ev_w_ukv, *ev_sinks, *ev_w_out,
      *od_w_in, *od_forget_bias, *od_lambda, *od_subln, *od_w_out;
  float* out;
  unsigned char* ws;
};

DI int opaque_tid() { int t = threadIdx.x; asm volatile("" : "+v"(t)); return t; }
DI float bflo(unsigned u) { return __uint_as_float(u << 16); }
DI float bfhi(unsigned u) { return __uint_as_float(u & 0xffff0000u); }
DI unsigned pk2(float lo, float hi) { f32x2 f = {lo, hi}; bf16x2_t b = __builtin_convertvector(f, bf16x2_t); return __builtin_bit_cast(unsigned, b); }
DI bf16_t f2bf(float f) { return (bf16_t)(pk2(f, 0.f) & 0xffffu); }
DI float fast_exp2(float x) { return __builtin_amdgcn_exp2f(x); }
DI float silu_f(float x) { return x * __builtin_amdgcn_rcpf(1.f + fast_exp2(-x * LOG2E)); }
template <int CTRL> DI float dpp_mov(float v) { return __builtin_bit_cast(float, __builtin_amdgcn_update_dpp(0, __builtin_bit_cast(int, v), CTRL, 0xf, 0xf, false)); }
DI float wave_sum(float v) {
  v += dpp_mov<0xB1>(v);
  v += dpp_mov<0x4E>(v);
  v += dpp_mov<0x141>(v);
  v += dpp_mov<0x140>(v);
  { const unsigned u = __float_as_uint(v); auto r = __builtin_amdgcn_permlane16_swap(u, u, false, false); v = __uint_as_float(r[0]) + __uint_as_float(r[1]); }
  { const unsigned u = __float_as_uint(v); auto r = __builtin_amdgcn_permlane32_swap(u, u, false, false); v = __uint_as_float(r[0]) + __uint_as_float(r[1]); }
  return v;
}

namespace pg8 {
constexpr int BM = 256, BK = 64, HALF = 128, HTB = HALF * BK * 2, STAGE_BYTES = 8 * HTB, NXCD = 8, WGM = 8;
DI int lds_byte(int r, int c) { const int st = (r >> 4) * 2 + (c >> 5), rr = r & 15, cc = c & 31, ob = rr * 64 + cc * 2; return st * 1024 + (ob ^ (((ob >> 9) & 1) << 5)); }
DI void stage_rc(int b, int& R, int& C) { const int st = b / 1024, sb = b % 1024, swz = sb ^ (((sb >> 9) & 1) << 5); R = (st >> 1) * 16 + swz / 64; C = (st & 1) * 32 + (swz % 64) / 2; }
DI int perm32(int rho) { const int n = rho >> 4, i = rho & 15; return 8 * (i >> 2) + 4 * n + (i & 3); }
struct Unit { int pm, pn; };
struct Gemm { const bf16_t* A; const bf16_t* Bt; int M, N, K, lda; };
struct StaticOrder {
  int nM, nN, nwg, G, c;
  DI void init(int M, int N, int G_, int c_) { nM = M / BM; nN = N / BM; nwg = nM * nN; G = G_; c = c_; }
  DI bool next(int i, Unit& u) const {
    const long L = (long)i * G + c; if (L >= nwg) return false;
    int wgid = (int)L; { const int q = nwg / NXCD, r = nwg % NXCD, xcd = wgid % NXCD, off = wgid / NXCD; wgid = (xcd < r ? xcd * (q + 1) : r * (q + 1) + (xcd - r) * q) + off; }
    const int nig = WGM * nN, gid = wgid / nig, fm = gid * WGM, gsz = (nM - fm) < WGM ? (nM - fm) : WGM;
    u.pm = fm + ((wgid % nig) % gsz); u.pn = (wgid % nig) / gsz; return true;
  }
};

template <class Epi>
DI void gemm_phase(LAS unsigned char* lds, const Gemm g, const StaticOrder& S, const Epi& E) {
  const int tid = opaque_tid(), wid = __builtin_amdgcn_readfirstlane(tid >> 6), lane = tid & 63, wr = wid >> 2, wc = wid & 3, fr = lane & 15, fq = lane >> 4;
  const int K = g.K, nt = K / BK, lda = g.lda;
  unsigned voffA[2], voffB[2];
#pragma unroll
  for (int i = 0; i < 2; ++i) { int R, C; stage_rc(tid * 16 + i * 8192, R, C); const int Rb = (R & ~31) + perm32(R & 31);
    voffA[i] = (unsigned)(R * lda + C) * 2u; voffB[i] = (unsigned)(Rb * K + C) * 2u; }
  const size_t kstep = (size_t)(BK * 2);
  const size_t hstepA = (size_t)HALF * lda * 2, hstepB = (size_t)HALF * K * 2;
  const size_t tstepA = 2 * hstepA, tstepB = 2 * hstepB;
  const unsigned ldsw = (unsigned)wid * 1024u;
  const int aoff = lds_byte(wr * 64 + fr, fq * 8), boff = lds_byte(wc * 32 + fr, fq * 8);
#define PG8_SA(b, h) (((b) * 2 + (h)) * HTB)
#define PG8_SB(b, h) ((4 + (b) * 2 + (h)) * HTB)
#define PG8_STAGE(bufoff, gbase, voff) do { _Pragma("unroll") for (int _i = 0; _i < 2; ++_i) \
    __builtin_amdgcn_global_load_lds((const unsigned*)((const char*)(gbase) + (voff)[_i]), (LAS unsigned*)(lds + (bufoff) + ldsw + _i * 8192), 16, 0, 0); } while (0)
#define PG8_LDA(dst, b, h) do { _Pragma("unroll") for (int m = 0; m < 4; ++m) _Pragma("unroll") for (int k = 0; k < 2; ++k) dst[m][k] = *(const LAS bf16x8*)(lds + PG8_SA(b, h) + aoff + m * 2048 + k * 1024); } while (0)
#define PG8_LDB(dst, b, h) do { _Pragma("unroll") for (int n = 0; n < 2; ++n) _Pragma("unroll") for (int k = 0; k < 2; ++k) dst[n][k] = *(const LAS bf16x8*)(lds + PG8_SB(b, h) + boff + n * 2048 + k * 1024); } while (0)
#define PG8_MMA(ai, bj, At, Bt) do { __builtin_amdgcn_s_setprio(1); _Pragma("unroll") for (int m = 0; m < 4; ++m) _Pragma("unroll") for (int n = 0; n < 2; ++n) _Pragma("unroll") for (int k = 0; k < 2; ++k) \
    acc[ai][bj][m][n] = __builtin_amdgcn_mfma_f32_16x16x32_bf16(Bt[n][k], At[m][k], acc[ai][bj][m][n], 0, 0, 0); __builtin_amdgcn_s_setprio(0); } while (0)
#define PG8_WAIT_V(n) asm volatile("s_waitcnt vmcnt(" #n ")" ::: "memory")
#define PG8_WAIT_L(n) asm volatile("s_waitcnt lgkmcnt(" #n ")" ::: "memory")
#define PG8_BAR __builtin_amdgcn_s_barrier()
#define PG8_SCHED __builtin_amdgcn_sched_barrier(0)
  Unit cur, nxt; int ui = 0;
  if (!S.next(0, cur)) return;
  f32x4 acc[2][2][4][2];
#pragma unroll
  for (int a = 0; a < 2; ++a)
#pragma unroll
    for (int b = 0; b < 2; ++b)
#pragma unroll
      for (int m = 0; m < 4; ++m)
#pragma unroll
        for (int n = 0; n < 2; ++n) acc[a][b][m][n] = (f32x4){0.f, 0.f, 0.f, 0.f};
  bf16x8 At[4][2], B0[2][2], B1[2][2];
  const char* cA = (const char*)g.A + (size_t)cur.pm * tstepA; const char* cB = (const char*)g.Bt + (size_t)cur.pn * tstepB;
  PG8_STAGE(PG8_SB(0, 0), cB, voffB); PG8_STAGE(PG8_SA(0, 0), cA, voffA); PG8_STAGE(PG8_SB(0, 1), cB + hstepB, voffB); PG8_STAGE(PG8_SA(0, 1), cA + hstepA, voffA);
  if (wr == 1) PG8_BAR;
  PG8_WAIT_V(4); PG8_BAR;
  PG8_STAGE(PG8_SB(1, 0), cB + kstep, voffB); PG8_STAGE(PG8_SA(1, 0), cA + kstep, voffA); PG8_STAGE(PG8_SB(1, 1), cB + hstepB + kstep, voffB);
  PG8_WAIT_V(6); PG8_BAR;
  for (;;) {
    const bool has_next = S.next(ui + 1, nxt);
    const char* nA = has_next ? (const char*)g.A + (size_t)nxt.pm * tstepA : cA; const char* nB = has_next ? (const char*)g.Bt + (size_t)nxt.pn * tstepB : cB;
    for (int t = 0; t < nt; t += 2) {
      const bool last = (t == nt - 2);
      const char* a1 = cA + (size_t)(t + 1) * kstep;
      const char* a2 = last ? nA : cA + (size_t)(t + 2) * kstep; const char* b2 = last ? nB : cB + (size_t)(t + 2) * kstep;
      const char* a3 = a2 + kstep; const char* b3 = b2 + kstep;
      PG8_LDB(B0, 0, 0); PG8_SCHED; PG8_LDA(At, 0, 0); PG8_STAGE(PG8_SA(1, 1), a1 + hstepA, voffA);
      PG8_WAIT_L(8); PG8_BAR; PG8_WAIT_L(0); PG8_MMA(0, 0, At, B0); PG8_BAR; PG8_SCHED;
      PG8_LDB(B1, 0, 1); PG8_STAGE(PG8_SB(0, 0), b2, voffB);
      PG8_BAR; PG8_WAIT_L(0); PG8_MMA(0, 1, At, B1); PG8_BAR;
      PG8_LDA(At, 0, 1); PG8_STAGE(PG8_SA(0, 0), a2, voffA);
      PG8_BAR; PG8_WAIT_L(0); PG8_MMA(1, 0, At, B0); PG8_BAR; PG8_SCHED;
      PG8_STAGE(PG8_SB(0, 1), b2 + hstepB, voffB);
      PG8_WAIT_V(6); PG8_BAR; PG8_MMA(1, 1, At, B1); PG8_BAR;
      PG8_LDB(B0, 1, 0); PG8_SCHED; PG8_LDA(At, 1, 0); PG8_STAGE(PG8_SA(0, 1), a2 + hstepA, voffA);
      PG8_WAIT_L(8); PG8_BAR; PG8_WAIT_L(0); PG8_MMA(0, 0, At, B0); PG8_BAR; PG8_SCHED;
      PG8_LDB(B1, 1, 1); PG8_STAGE(PG8_SB(1, 0), b3, voffB);
      PG8_BAR; PG8_WAIT_L(0); PG8_MMA(0, 1, At, B1); PG8_BAR;
      PG8_LDA(At, 1, 1); PG8_STAGE(PG8_SA(1, 0), a3, voffA);
      PG8_BAR; PG8_WAIT_L(0); PG8_MMA(1, 0, At, B0); PG8_BAR; PG8_SCHED;
      PG8_STAGE(PG8_SB(1, 1), b3 + hstepB, voffB);
      PG8_WAIT_V(6); PG8_BAR; PG8_MMA(1, 1, At, B1); PG8_BAR;
    }
    E(acc, cur, wr, wc, fr, fq);
    if (!has_next) break;
#pragma unroll
    for (int a = 0; a < 2; ++a)
#pragma unroll
      for (int b = 0; b < 2; ++b)
#pragma unroll
        for (int m = 0; m < 4; ++m)
#pragma unroll
          for (int n = 0; n < 2; ++n) acc[a][b][m][n] = (f32x4){0.f, 0.f, 0.f, 0.f};
    cur = nxt; cA = nA; cB = nB; ++ui;
  }
  PG8_WAIT_V(0);
  if (wr == 0) PG8_BAR;
  PG8_BAR;
#undef PG8_SA
#undef PG8_SB
#undef PG8_STAGE
#undef PG8_LDA
#undef PG8_LDB
#undef PG8_MMA
#undef PG8_WAIT_V
#undef PG8_WAIT_L
#undef PG8_BAR
#undef PG8_SCHED
}
}

struct Epi {
  bf16_t* out; int ldc;
  int rope64_end;
  int rope32_lo, rope32_hi;
  int qmode;
  const float* pin; int nK;
  int pslot;
  float* pout;
  const float *cosH, *sinH, *cosR, *sinR;
  DI void operator()(const f32x4 (&acc)[2][2][4][2], const pg8::Unit& u, int wr, int wc, int fr, int fq) const {
    const int row0 = u.pm * 256 + wr * 64 + fr;
    int rt[2];
#pragma unroll
    for (int bj = 0; bj < 2; ++bj) {
      const int cw = u.pn * 256 + bj * 128 + wc * 32;
      rt[bj] = 0;
      if (cw < rope64_end) rt[bj] = 1;
      else if (cw >= rope32_lo && cw < rope32_hi) rt[bj] = 2;
      else if (qmode && ((cw >> 5) % 3) == 2) rt[bj] = 2;
    }
    const int tt = rt[0] | rt[1];
    const float* ctab = (tt == 1) ? cosH + (16 * (wc & 1) + 4 * fq) : cosR + 4 * fq;
    const float* stab = (tt == 1) ? sinH + (16 * (wc & 1) + 4 * fq) : sinR + 4 * fq;
    const int tstride = (tt == 1) ? 32 : 16;
    int ps[2] = {-1, -1};
    if (pout) {
#pragma unroll
      for (int bj = 0; bj < 2; ++bj) { const int cw = u.pn * 256 + bj * 128 + wc * 32;
        if (cw >= 1792 && cw < 2432) ps[bj] = ((cw - 1792) >> 7) * 4 + wc; }
    }
#pragma unroll
    for (int ai = 0; ai < 2; ++ai) {
      f32x4 cv[4], sv[4]; float rs[4];
#pragma unroll
      for (int m = 0; m < 4; ++m) {
        const int row = row0 + ai * 128 + m * 16;
        if (tt) { const int pos = row & (SEQ - 1); cv[m] = *(const f32x4*)(ctab + pos * tstride); sv[m] = *(const f32x4*)(stab + pos * tstride); }
        rs[m] = 1.f;
        if (pin) { const f32x4 p0 = *(const f32x4*)(pin + (size_t)row * 20 + pslot), p1 = *(const f32x4*)(pin + (size_t)row * 20 + pslot + 4);
          float ss = ((p0[0] + p0[1]) + (p0[2] + p0[3])) + ((p1[0] + p1[1]) + (p1[2] + p1[3]));
          if (nK == 384) { const f32x4 p2 = *(const f32x4*)(pin + (size_t)row * 20 + pslot + 8); ss += (p2[0] + p2[1]) + (p2[2] + p2[3]); }
          rs[m] = rsqrtf(ss / (float)nK + EPS); }
      }
#pragma unroll
      for (int m = 0; m < 4; ++m) {
        const int row = row0 + ai * 128 + m * 16;
#pragma unroll
        for (int bj = 0; bj < 2; ++bj) {
          const int c0 = u.pn * 256 + bj * 128 + wc * 32 + 8 * fq;
          f32x4 v0 = acc[ai][bj][m][0] * rs[m], v1 = acc[ai][bj][m][1] * rs[m];
          if (ps[bj] >= 0) {
            float sq = (v0[0] * v0[0] + v0[1] * v0[1]) + (v0[2] * v0[2] + v0[3] * v0[3]) + (v1[0] * v1[0] + v1[1] * v1[1]) + (v1[2] * v1[2] + v1[3] * v1[3]);
            sq += __shfl_xor(sq, 16); sq += __shfl_xor(sq, 32);
            if (fq == 0) pout[(size_t)row * 20 + ps[bj]] = sq;
          }
          if (rt[bj]) {
            const f32x4 o1 = v0 * cv[m] - v1 * sv[m], o2 = v1 * cv[m] + v0 * sv[m];
            v0 = o1; v1 = o2;
          }
          u32x4 w; w.x = pk2(v0[0], v0[1]); w.y = pk2(v0[2], v0[3]); w.z = pk2(v1[0], v1[1]); w.w = pk2(v1[2], v1[3]);
          *(u32x4*)(out + (size_t)row * ldc + c0) = w;
        }
      }
    }
  }
};

DI int ropeperm64(int p) { const int g = p >> 3, r = p & 7; return r < 4 ? 4 * g + r : 32 + 4 * g + (r - 4); }
DI int ropeperm32(int p) { const int g = p >> 3, r = p & 7; return r < 4 ? 4 * g + r : 16 + 4 * g + (r - 4); }
DI int srccol(int kind, int n) {
  if (kind == 0) {
    if (n < 512) return 672 + (n & ~63) + ropeperm64(n & 63);
    if (n < 640) return 1184 + ((n - 512) & ~63) + ropeperm64(n & 63);
    if (n < 768) return 1312 + (n - 640);
    if (n < 1792) return 1440 + (n - 768);
    if (n < 2176) return n - 1792;
    if (n < 2432) return 384 + (n - 2176);
    if (n < 2464) return 640 + ropeperm32(n - 2432);
    return -1;
  }
  if (kind == 1) {
    if (n < 1024) return (n & ~63) + ropeperm64(n & 63);
    if (n < 3072) return n;
    return 3080 + (n - 3072);
  }
  if (kind == 2) { const int hd = n / 96, p = n - hd * 96; return hd * 96 + (p < 64 ? p : 64 + ropeperm32(p - 64)); }
  return n;
}
struct ConvJob { const float* W; const float* g; bf16_t* Wt; int Nsrc, K, kind, tn, tk; };
DI bool conv_decode(const Params& p, int job, ConvJob& j) {
  constexpr int NT0 = 40 * 16, NT1 = 64 * 16, NT2 = 12 * 6, NT3 = 16 * 4, NT4 = 16 * 16;
  constexpr int PER_I = NT0 + NT1 + NT2 + NT3 + 2 * NT4;
  if (job >= 2 * PER_I) return false;
  unsigned char* ws = p.ws;
  const int i = job / PER_I; int t = job - i * PER_I;
  j.g = nullptr;
  if (t < NT0) { j.W = p.ev_w_in + (size_t)i * 1024 * 2464; j.Nsrc = 2464; j.K = 1024; j.Wt = (bf16_t*)(ws + WS_WEVIN + i * SZ_WEVIN); j.kind = 0; j.tn = t / 16; j.tk = t % 16; return true; }
  t -= NT0;
  if (t < NT1) { j.W = p.od_w_in + (size_t)i * 1024 * 4104; j.Nsrc = 4104; j.K = 1024; j.Wt = (bf16_t*)(ws + WS_WODIN + i * SZ_WODIN); j.kind = 1; j.tn = t / 16; j.tk = t % 16; return true; }
  t -= NT1;
  if (t < NT2) { j.W = p.ev_w_uq + (size_t)i * 384 * 768; j.Nsrc = 768; j.K = 384; j.Wt = (bf16_t*)(ws + WS_WUQ + i * SZ_WUQ); j.kind = 2; j.g = p.ev_q_norm + i * 384; j.tn = t / 6; j.tk = t % 6; return true; }
  t -= NT2;
  if (t < NT3) { j.W = p.ev_w_ukv + (size_t)i * 256 * 1024; j.Nsrc = 1024; j.K = 256; j.Wt = (bf16_t*)(ws + WS_WUKV + i * SZ_WUKV); j.kind = 3; j.g = p.ev_kv_norm + i * 256; j.tn = t / 4; j.tk = t % 4; return true; }
  t -= NT3;
  if (t < NT4) { j.W = p.ev_w_out + (size_t)i * 1024 * 1024; j.Nsrc = 1024; j.K = 1024; j.Wt = (bf16_t*)(ws + WS_WEVOUT + i * SZ_WOUT); j.kind = 4; j.tn = t / 16; j.tk = t % 16; return true; }
  t -= NT4;
  j.W = p.od_w_out + (size_t)i * 1024 * 1024; j.Nsrc = 1024; j.K = 1024; j.Wt = (bf16_t*)(ws + WS_WODOUT + i * SZ_WOUT); j.kind = 4; j.tn = t / 16; j.tk = t % 16; return true;
}
template <int NJ>
DI void convert_tiles(const Params& p, LAS unsigned char* lds, int job0, int jstride) {
  const int tid = opaque_tid();
  const int nl = tid & 63, ks = tid >> 6;
  ConvJob j[NJ] = {}; bool ok[NJ]; float v[NJ][8];
#pragma unroll
  for (int q = 0; q < NJ; ++q) {
    ok[q] = conv_decode(p, job0 + q * jstride, j[q]);
    const int sc = ok[q] ? srccol(j[q].kind, j[q].tn * 64 + nl) : -1;
#pragma unroll
    for (int e = 0; e < 8; ++e) {
      const int k = j[q].tk * 64 + ks + 8 * e;
      v[q][e] = 0.f;
      if (sc >= 0) { v[q][e] = j[q].W[(size_t)k * j[q].Nsrc + sc]; if (j[q].g) v[q][e] *= j[q].g[k]; }
    }
  }
#pragma unroll
  for (int q = 0; q < NJ; ++q) {
    LAS bf16_t* tile = (LAS bf16_t*)(lds + q * 9216);
#pragma unroll
    for (int e = 0; e < 8; ++e) tile[nl * 72 + ks + 8 * e] = f2bf(v[q][e]);
  }
  __syncthreads();
#pragma unroll
  for (int q = 0; q < NJ; ++q) {
    if (ok[q]) {
      LAS bf16_t* tile = (LAS bf16_t*)(lds + q * 9216);
      const int n2 = tid >> 3, ch = tid & 7;
      const u32x4 w = *(const LAS u32x4*)(tile + n2 * 72 + ch * 8);
      *(u32x4*)(j[q].Wt + (size_t)(j[q].tn * 64 + n2) * j[q].K + j[q].tk * 64 + ch * 8) = w;
    }
  }
  __syncthreads();
}

DI void prologue(const Params& p, LAS unsigned char* lds) {
  const int tid = opaque_tid(), G = gridDim.x, bid = blockIdx.x;
  unsigned char* ws = p.ws;
  for (int idx = bid * 512 + tid; idx < 2048 * 48; idx += G * 512) {
    const bool isH = idx < 2048 * 32;
    const int j = isH ? idx : idx - 2048 * 32;
    const int pos = isH ? (j >> 5) : (j >> 4), i = isH ? (j & 31) : (j & 15);
    const float e = isH ? (float)(2 * i) * (1.f / 64.f) : (float)(2 * i) * (1.f / 32.f);
    const float inv = fast_exp2(-e * 13.287712379549449f);
    const float ang = (float)pos * inv;
    double t = (double)ang * 0.15915494309189535; t -= rint(t);
    const float fr = (float)t;
    const float cv = __builtin_amdgcn_cosf(fr), sv = __builtin_amdgcn_sinf(fr);
    if (isH) { ((float*)(ws + WS_COSH))[j] = cv; ((float*)(ws + WS_SINH))[j] = sv; }
    else { ((float*)(ws + WS_COSR))[j] = cv; ((float*)(ws + WS_SINR))[j] = sv; }
  }
  for (int job = bid; job < 4624; job += 4 * G) convert_tiles<4>(p, lds, job, G);
  const int item0 = G - 1 - bid;
  if (item0 < 192) {
    LAS float* cond = (LAS float*)lds;
    LAS float* red = (LAS float*)(lds + 65536);
    for (int e = tid; e < 16 * 1024; e += 512) { const int b = e >> 10, k = e & 1023; cond[k * 16 + b] = silu_f(p.c[e]); }
    __syncthreads();
    for (int item = item0; item < 192; item += G) {
      const int l = item / 48, n0 = (item % 48) * 64;
      const int col = tid & 63, kg = tid >> 6;
      float a[16];
#pragma unroll
      for (int b = 0; b < 16; ++b) a[b] = 0.f;
      const float* wp = p.w_ada + (size_t)l * 1024 * 3072 + n0 + col;
      for (int k0 = kg * 128; k0 < kg * 128 + 128; k0 += 16) {
        float wv[16];
#pragma unroll
        for (int e = 0; e < 16; ++e) wv[e] = wp[(size_t)(k0 + e) * 3072];
#pragma unroll
        for (int e = 0; e < 16; ++e) {
          const float w = wv[e]; const int k = k0 + e;
#pragma unroll
          for (int b4 = 0; b4 < 4; ++b4) { const f32x4 cv = *(const LAS f32x4*)(cond + k * 16 + b4 * 4);
            a[b4 * 4 + 0] += cv[0] * w; a[b4 * 4 + 1] += cv[1] * w; a[b4 * 4 + 2] += cv[2] * w; a[b4 * 4 + 3] += cv[3] * w; }
        }
      }
#pragma unroll
      for (int b = 0; b < 16; ++b) red[(kg * 16 + b) * 64 + col] = a[b];
      __syncthreads();
      for (int e = tid; e < 1024; e += 512) { const int b = e >> 6, cc = e & 63; float s = 0.f;
#pragma unroll
        for (int k8 = 0; k8 < 8; ++k8) s += red[(k8 * 16 + b) * 64 + cc];
        ((float*)(ws + WS_MOD))[((size_t)l * 16 + b) * 3072 + n0 + cc] = s + p.b_ada[l * 3072 + n0 + cc]; }
      __syncthreads();
    }
  }
}

DI void rowwise_phase(const Params& p, LAS unsigned char* lds, int lp, int ln) {
  const int tid = opaque_tid(), lane = tid & 63, wid = tid >> 6;
  const int gw = blockIdx.x * 8 + wid, nw = gridDim.x * 8;
  unsigned char* ws = p.ws;
  const float* mod = (const float*)(ws + WS_MOD);
  const bf16_t* ybuf = (const bf16_t*)(ws + WS_HBUF);
  bf16_t* hbuf = (bf16_t*)(ws + WS_HBUF);
  const bool ff = (ln < 4) && (ln & 1);
  LAS f32x4* wl = (LAS f32x4*)lds;
  if (ff) {
    const float* w = p.od_w_in + (size_t)(ln >> 1) * 1024 * 4104 + 3072;
    for (int c = tid; c < 1024; c += 512) {
      const f32x4 w0 = *(const f32x4*)(w + (size_t)c * 4104), w1 = *(const f32x4*)(w + (size_t)c * 4104 + 4);
      const int ln_ = (c & 255) >> 2, e = c & 3, j = c >> 8;
      wl[(j * 4 + e) * 64 + ln_] = w0; wl[1024 + (j * 4 + e) * 64 + ln_] = w1;
    }
    __syncthreads();
  }
  for (int row = gw; row < T; row += nw) {
    const int b = row >> 11;
    f32x4 xv[4];
    bf16_t* xbf = (bf16_t*)(ws + WS_XBF) + (size_t)row * DM;
    if (lp <= 0) {
      const float* xin = p.x + (size_t)row * DM;
#pragma unroll
      for (int j = 0; j < 4; ++j) xv[j] = *(const f32x4*)(xin + 4 * lane + 256 * j);
    } else {
#pragma unroll
      for (int j = 0; j < 4; ++j) { const u32x2 u = *(const u32x2*)(xbf + 4 * lane + 256 * j); xv[j] = (f32x4){bflo(u.x), bfhi(u.x), bflo(u.y), bfhi(u.y)}; }
    }
    if (lp >= 0) {
      f32x4 yv[4]; float ss = 0.f;
#pragma unroll
      for (int j = 0; j < 4; ++j) { const u32x2 u = *(const u32x2*)(ybuf + (size_t)row * DM + 4 * lane + 256 * j);
        yv[j] = (f32x4){bflo(u.x), bfhi(u.x), bflo(u.y), bfhi(u.y)}; ss += yv[j][0] * yv[j][0] + yv[j][1] * yv[j][1] + yv[j][2] * yv[j][2] + yv[j][3] * yv[j][3]; }
      ss = wave_sum(ss);
      const float rs = rsqrtf(ss * (1.f / DM) + EPS);
#pragma unroll
      for (int j = 0; j < 4; ++j) {
        const int c = 4 * lane + 256 * j;
        const f32x4 gt = *(const f32x4*)(mod + ((size_t)lp * 16 + b) * 3072 + 2048 + c);
        const f32x4 gp = *(const f32x4*)(p.g_post + lp * DM + c);
        xv[j] = xv[j] + gt * (yv[j] * rs * gp);
        if (ln >= 4) *(f32x4*)(p.out + (size_t)row * DM + c) = xv[j];
        else { u32x2 w; w.x = pk2(xv[j][0], xv[j][1]); w.y = pk2(xv[j][2], xv[j][3]); *(u32x2*)(xbf + c) = w; }
      }
    }
    if (ln < 4) {
      float ss = 0.f;
#pragma unroll
      for (int j = 0; j < 4; ++j) ss += xv[j][0] * xv[j][0] + xv[j][1] * xv[j][1] + xv[j][2] * xv[j][2] + xv[j][3] * xv[j][3];
      ss = wave_sum(ss);
      const float rs = rsqrtf(ss * (1.f / DM) + EPS);
      float zf[8];
#pragma unroll
      for (int h = 0; h < 8; ++h) zf[h] = 0.f;
#pragma unroll
      for (int j = 0; j < 4; ++j) {
        const int c = 4 * lane + 256 * j;
        const f32x4 sh = *(const f32x4*)(mod + ((size_t)ln * 16 + b) * 3072 + c);
        const f32x4 sc = *(const f32x4*)(mod + ((size_t)ln * 16 + b) * 3072 + 1024 + c);
        const f32x4 gp = *(const f32x4*)(p.g_pre + ln * DM + c);
        const f32x4 hv = (xv[j] * rs * gp) * (sc + 1.f) + sh;
        u32x2 w; w.x = pk2(hv[0], hv[1]); w.y = pk2(hv[2], hv[3]);
        *(u32x2*)(hbuf + (size_t)row * DM + c) = w;
        if (ff) {
#pragma unroll
          for (int e = 0; e < 4; ++e) {
            const f32x4 w0 = wl[(j * 4 + e) * 64 + lane], w1 = wl[1024 + (j * 4 + e) * 64 + lane];
            zf[0] += hv[e] * w0[0]; zf[1] += hv[e] * w0[1]; zf[2] += hv[e] * w0[2]; zf[3] += hv[e] * w0[3];
            zf[4] += hv[e] * w1[0]; zf[5] += hv[e] * w1[1]; zf[6] += hv[e] * w1[2]; zf[7] += hv[e] * w1[3];
          }
        }
      }
      if (ff) {
        const bool b5 = lane & 32, b4 = lane & 16, b3 = lane & 8;
        float w4[4], u2[2], t;
#pragma unroll
        for (int k = 0; k < 4; ++k) { const float send = b5 ? zf[k] : zf[4 + k], keep = b5 ? zf[4 + k] : zf[k]; w4[k] = keep + __shfl_xor(send, 32); }
#pragma unroll
        for (int k = 0; k < 2; ++k) { const float send = b4 ? w4[k] : w4[2 + k], keep = b4 ? w4[2 + k] : w4[k]; u2[k] = keep + __shfl_xor(send, 16); }
        { const float send = b3 ? u2[0] : u2[1], keep = b3 ? u2[1] : u2[0]; t = keep + __shfl_xor(send, 8); }
        t += __shfl_xor(t, 4); t += __shfl_xor(t, 2); t += __shfl_xor(t, 1);
        if ((lane & 7) == 0) {
          const int h = lane >> 3;
          const float z = t + p.od_forget_bias[(ln >> 1) * 8 + h];
          const float ls = fminf(z, 0.f) - __builtin_amdgcn_logf(1.f + fast_exp2(-fabsf(z) * LOG2E)) * 0.6931471805599453f;
          ((float*)(ws + WS_LOGF))[(size_t)row * 8 + h] = ls;
        }
      }
    }
  }
  __syncthreads();
}

DI void fox_scan(const Params& p, LAS unsigned char* lds, int bh) {
  const int tid = opaque_tid();
  const int b = bh >> 3, h = bh & 7;
  const float* logf_ = (const float*)(p.ws + WS_LOGF);
  float* fcum = (float*)(p.ws + WS_FCUM) + (size_t)bh * SEQ;
  LAS float* s = (LAS float*)lds;
  float v[4];
#pragma unroll
  for (int j = 0; j < 4; ++j) v[j] = logf_[((size_t)b * SEQ + 4 * tid + j) * 8 + h];
  v[1] += v[0]; v[2] += v[1]; v[3] += v[2];
  s[tid] = v[3];
  __syncthreads();
  for (int off = 1; off < 512; off <<= 1) {
    float t = 0.f;
    if (tid >= off) t = s[tid - off];
    __syncthreads();
    s[tid] += t;
    __syncthreads();
  }
  const float excl = s[tid] - v[3];
#pragma unroll
  for (int j = 0; j < 4; ++j) fcum[4 * tid + j] = -8.0f * (excl + v[j]);
  __syncthreads();
}

struct AttnArgs { const bf16_t *q, *k, *k2, *v, *gate; bf16_t* out; const float* fcum; int ldq, ldk, ldk2, ldv, ldo, ldg; float sl2, sink; };

DI float half_max(float x) {
  const unsigned u = __float_as_uint(x);
  auto r = __builtin_amdgcn_permlane32_swap(u, u, false, false);
  return fmaxf(__uint_as_float(r[0]), __uint_as_float(r[1]));
}
DI float half_sum(float x) {
  const unsigned u = __float_as_uint(x);
  auto r = __builtin_amdgcn_permlane32_swap(u, u, false, false);
  return __uint_as_float(r[0]) + __uint_as_float(r[1]);
}

template <int N> DI void wait_vmcnt() { asm volatile("s_waitcnt vmcnt(%0)" ::"n"(N) : "memory"); }
DI void raw_barrier() { asm volatile("" ::: "memory"); __builtin_amdgcn_s_barrier(); asm volatile("" ::: "memory"); }

template <int DQK, int DV, int MODE>
DI void attn_item(LAS unsigned char* lds, const AttnArgs& a, int qb) {
  constexpr int KSTR = DQK * 2 + 16, VSTR = (DV == 64) ? 192 : 320;
  constexpr int KG16 = KSTR / 16, VG16 = VSTR / 16;
  constexpr int KCH = KG16, VCH = VG16, NCH = KCH + VCH;
  constexpr int TILE = NCH * 1024 + (MODE == 2 ? 2048 : 0);
  constexpr int NSLOT = (NCH + 7) / 8, REM = NCH - 8 * (NSLOT - 1);
  constexpr int FX = (MODE == 2) ? 1 : 0;
  constexpr int NKS = DQK / 16, NBLK = DV / 32;
  static_assert(5 * TILE <= 155648, "ring too large");
  const int tid = opaque_tid(), wid = __builtin_amdgcn_readfirstlane(tid >> 6), lane = tid & 63, r = lane & 31, hh = lane >> 5;
  const int q0 = qb * 256, qw = q0 + 32 * wid, myq = qw + r;
  const float c = a.sl2, tau = 8.0f / a.sl2;
  bf16x8 qf[NKS];
#pragma unroll
  for (int ks = 0; ks < NKS; ++ks) qf[ks] = *(const bf16x8*)(a.q + (size_t)myq * a.ldq + 16 * ks + 8 * hh);
  int lo = 0; const int hi = 4 * (qb + 1);
  if (MODE == 1) { lo = 4 * qb - 2; if (lo < 0) lo = 0; }
  const int last_w = (qw + 31) >> 6;
  int first_w = 0;
  if (MODE == 1) { first_w = (qw > 127 ? qw - 127 : 0) >> 6; }
  const char* sp[NSLOT]; unsigned sst[NSLOT];
#pragma unroll
  for (int j = 0; j < NSLOT; ++j) {
    const int ch_ = 8 * j + wid;
    if (ch_ < KCH) {
      const int p = ch_ * 64 + lane, row = p / KG16, g = p - row * KG16;
      if (DQK == 96 && g >= 8 && g < 12) { sp[j] = (const char*)(a.k2 + (size_t)row * a.ldk2 + 8 * (g - 8)); sst[j] = (unsigned)(128 * a.ldk2); }
      else { sp[j] = (const char*)(a.k + (size_t)row * a.ldk + 8 * (g < 8 ? g : 0)); sst[j] = (unsigned)(128 * a.ldk); }
    } else {
      const int p = (ch_ - KCH) * 64 + lane, row = (p / VG16) & 63, g = p - (p / VG16) * VG16;
      sp[j] = (const char*)(a.v + (size_t)row * a.ldv + 8 * (g < DV / 8 ? g : 0)); sst[j] = (unsigned)(128 * a.ldv);
    }
  }
  auto issue = [&](int kt) {
    LAS unsigned char* base = lds + (kt % 4) * TILE;
#pragma unroll
    for (int j = 0; j < NSLOT; ++j) {
      if (j < NSLOT - 1 || wid < REM)
        __builtin_amdgcn_global_load_lds((const unsigned*)(sp[j] + (size_t)kt * sst[j]), (LAS unsigned*)(base + (8 * j + wid) * 1024), 16, 0, 0);
    }
    if (MODE == 2) __builtin_amdgcn_global_load_lds((const unsigned*)(a.fcum + kt * 64 + lane), (LAS unsigned*)(base + NCH * 1024 + wid * 256), 4, 0, 0);
  };
  auto wait_tiles = [&](bool all) {
    if (all) wait_vmcnt<0>();
    else if (wid < REM) wait_vmcnt<NSLOT + FX>();
    else wait_vmcnt<NSLOT - 1 + FX>();
  };
  f32x16 O[NBLK];
#pragma unroll
  for (int bl = 0; bl < NBLK; ++bl)
#pragma unroll
    for (int i = 0; i < 16; ++i) O[bl][i] = 0.f;
  float m = (MODE == 1) ? a.sink / a.sl2 : -1e30f;
  float l0 = (MODE == 1 && hh == 0) ? 1.f : 0.f, l1 = 0.f;
  const int i16 = lane & 15, q4 = i16 >> 2, p4 = i16 & 3, grp = (lane >> 4) & 1;
  auto qk_load = [&](int kt, bf16x8 (&kf)[2][NKS]) {
    LAS unsigned char* Kl = lds + (kt % 4) * TILE;
#pragma unroll
    for (int kb = 0; kb < 2; ++kb)
#pragma unroll
      for (int ks = 0; ks < NKS; ++ks) kf[kb][ks] = *(const LAS bf16x8*)(Kl + (32 * kb + r) * KSTR + (16 * ks + 8 * hh) * 2);
  };
  auto qk_mma = [&](int kt, const bf16x8 (&kf)[2][NKS], f32x16 (&s)[2]) {
#pragma unroll
    for (int kb = 0; kb < 2; ++kb) {
      if (MODE == 2) {
        LAS unsigned char* Fl = lds + (kt % 4) * TILE + NCH * 1024 + wid * 256;
#pragma unroll
        for (int g = 0; g < 4; ++g) { const f32x4 fb = *(const LAS f32x4*)(Fl + (32 * kb + 8 * g + 4 * hh) * 4);
          s[kb][4 * g] = fb[0]; s[kb][4 * g + 1] = fb[1]; s[kb][4 * g + 2] = fb[2]; s[kb][4 * g + 3] = fb[3]; }
      } else {
#pragma unroll
        for (int i = 0; i < 16; ++i) s[kb][i] = 0.f;
      }
    }
#pragma unroll
    for (int ks = 0; ks < NKS; ++ks)
#pragma unroll
      for (int kb = 0; kb < 2; ++kb) s[kb] = __builtin_amdgcn_mfma_f32_32x32x16_bf16(kf[kb][ks], qf[ks], s[kb], 0, 0, 0);
  };
  auto softmax = [&](int kt, f32x16 (&s)[2], bf16x8 (&pf)[2][2], auto maskc) {
    constexpr bool MASK = decltype(maskc)::value;
    const int key0 = kt * 64;
    if (MASK) {
#pragma unroll
      for (int kb = 0; kb < 2; ++kb)
#pragma unroll
        for (int i = 0; i < 16; ++i) {
          const int key = key0 + 32 * kb + (i & 3) + 8 * (i >> 2) + 4 * hh;
          bool valid = key <= myq; if (MODE == 1) valid = valid && (myq - key < 128);
          s[kb][i] = valid ? s[kb][i] : -1e30f;
        }
    }
    float mx = fmaxf(s[0][0], s[1][0]);
#pragma unroll
    for (int i = 1; i < 16; ++i) mx = fmaxf(fmaxf(mx, s[0][i]), s[1][i]);
    mx = half_max(mx);
    if (__builtin_amdgcn_ballot_w64(mx > m + tau) != 0ull) {
      const float mnew = fmaxf(m, mx);
      const float alpha = fast_exp2((m - mnew) * c);
      m = mnew;
      l0 *= alpha; l1 *= alpha;
#pragma unroll
      for (int bl = 0; bl < NBLK; ++bl)
#pragma unroll
        for (int i = 0; i < 16; ++i) O[bl][i] *= alpha;
    }
    const float nmc = -m * c;
#pragma unroll
    for (int kb = 0; kb < 2; ++kb)
#pragma unroll
      for (int s2 = 0; s2 < 2; ++s2) {
        float pv[8];
#pragma unroll
        for (int e = 0; e < 8; ++e) pv[e] = fast_exp2(__builtin_fmaf(s[kb][8 * s2 + e], c, nmc));
        l0 += (pv[0] + pv[4]) + (pv[2] + pv[6]); l1 += (pv[1] + pv[5]) + (pv[3] + pv[7]);
        u32x4 w;
        w.x = pk2(pv[0], pv[1]); w.y = pk2(pv[2], pv[3]); w.z = pk2(pv[4], pv[5]); w.w = pk2(pv[6], pv[7]);
        pf[kb][s2] = __builtin_bit_cast(bf16x8, w);
      }
  };
  auto pvmm = [&](int kt, const bf16x8 (&pf)[2][2]) {
    constexpr int PD = (NBLK == 2) ? 2 : 1;
    const unsigned va = (unsigned)(size_t)(lds + (kt % 4) * TILE + KCH * 1024 + (4 * hh + q4) * VSTR + (16 * grp) * 2 + 8 * p4);
    s16x4 vl[PD + 1][NBLK], vh[PD + 1][NBLK];
#define TRRD(dst, off) asm volatile("ds_read_b64_tr_b16 %0, %1 offset:%2" : "=&v"(dst) : "v"(va), "n"(off) : "memory")
#define TRSTEP(st_) do { _Pragma("unroll") for (int bl = 0; bl < NBLK; ++bl) { TRRD(vl[(st_) % (PD + 1)][bl], 16 * (st_) * VSTR + 64 * bl); TRRD(vh[(st_) % (PD + 1)][bl], 16 * (st_) * VSTR + 64 * bl + 8 * VSTR); } } while (0)
#define TRWAIT(n_, b_) do { if (NBLK == 2) asm volatile("s_waitcnt lgkmcnt(" #n_ ")" : "+v"(vl[b_][0]), "+v"(vh[b_][0]), "+v"(vl[b_][1]), "+v"(vh[b_][1])::"memory"); \
    else asm volatile("s_waitcnt lgkmcnt(" #n_ ")" : "+v"(vl[b_][0]), "+v"(vh[b_][0]), "+v"(vl[b_][1]), "+v"(vh[b_][1]), "+v"(vl[b_][2 % NBLK]), "+v"(vh[b_][2 % NBLK]), "+v"(vl[b_][3 % NBLK]), "+v"(vh[b_][3 % NBLK])::"memory"); } while (0)
#pragma unroll
    for (int st = 0; st < PD; ++st) TRSTEP(st);
#pragma unroll
    for (int st = 0; st < 4; ++st) {
      if (st + PD < 4) TRSTEP(st + PD);
      const int ahead = ((st + PD < 4) ? st + PD : 3) - st;
      const int b_ = st % (PD + 1);
      if (ahead * 2 * NBLK == 8) TRWAIT(8, b_); else if (ahead * 2 * NBLK == 4) TRWAIT(4, b_); else TRWAIT(0, b_);
#pragma unroll
      for (int bl = 0; bl < NBLK; ++bl) {
        const bf16x8 vf = __builtin_shufflevector(vl[b_][bl], vh[b_][bl], 0, 1, 2, 3, 4, 5, 6, 7);
        O[bl] = __builtin_amdgcn_mfma_f32_32x32x16_bf16(vf, pf[st >> 1][st & 1], O[bl], 0, 0, 0);
      }
    }
#undef TRRD
#undef TRSTEP
#undef TRWAIT
  };
  auto act = [&](int kt) { return kt <= last_w && kt >= first_w; };
  f32x16 sA[2];
  const bool halfB = wid >= 4;
  issue(lo);
  if (lo + 1 < hi) issue(lo + 1);
  if (lo + 2 < hi) issue(lo + 2);
  wait_tiles(true);
  raw_barrier();
  if (halfB) raw_barrier();
  if (act(lo)) { bf16x8 kf0[2][NKS]; qk_load(lo, kf0); qk_mma(lo, kf0, sA); }
  auto step = [&](int kt, auto maskc) {
    const bool a0 = act(kt), a1 = (kt + 1 < hi) && act(kt + 1);
    bf16x8 pf[2][2], kf[2][NKS];
    if (a1) qk_load(kt + 1, kf);
    __builtin_amdgcn_sched_barrier(0);
    if (a0) softmax(kt, sA, pf, maskc);
    wait_tiles(true);
    raw_barrier();
    if (kt + 3 < hi) issue(kt + 3);
    __builtin_amdgcn_s_setprio(1);
    if (a1) qk_mma(kt + 1, kf, sA);
    if (a0) pvmm(kt, pf);
    __builtin_amdgcn_s_setprio(0);
    raw_barrier();
  };
  int split = lo;
  if (MODE != 1) { split = qw >> 6; if (split < lo) split = lo; if (split > hi) split = hi; }
  if (MODE != 1) { for (int kt = lo; kt < split; ++kt) step(kt, std::false_type{}); }
  for (int kt = split; kt < hi; ++kt) step(kt, std::true_type{});
  if (!halfB) raw_barrier();
  const float l = half_sum(l0 + l1);
  const float inv = 1.f / l;
#pragma unroll
  for (int bl = 0; bl < NBLK; ++bl)
#pragma unroll
    for (int g = 0; g < 4; ++g) {
      const int f = 32 * bl + 8 * g + 4 * hh;
      float o0 = O[bl][4 * g + 0] * inv, o1 = O[bl][4 * g + 1] * inv, o2 = O[bl][4 * g + 2] * inv, o3 = O[bl][4 * g + 3] * inv;
      if (a.gate) {
        const u32x2 gv = *(const u32x2*)(a.gate + (size_t)myq * a.ldg + f);
        o0 *= silu_f(bflo(gv.x)); o1 *= silu_f(bfhi(gv.x)); o2 *= silu_f(bflo(gv.y)); o3 *= silu_f(bfhi(gv.y));
      }
      u32x2 w; w.x = pk2(o0, o1); w.y = pk2(o2, o3);
      *(u32x2*)(a.out + (size_t)myq * a.ldo + f) = w;
    }
}


DI void swa_item(LAS unsigned char* lds, const AttnArgs& a, const float* sinks4, int qb) {
  constexpr int KSTR = 144, VSTR = 192, KCH = 9, VCH = 12, NCH = 21, TILE = NCH * 1024, NSLOT = 3, REM = 5, NKS = 4, NBLK = 2;
  const int tid = opaque_tid(), wid = __builtin_amdgcn_readfirstlane(tid >> 6), lane = tid & 63, r = lane & 31, hh = lane >> 5;
  const int q0 = qb * 256, qw = q0 + 32 * wid, myq = qw + r;
  const float c = a.sl2, tau = 8.0f / a.sl2;
  int lo = 4 * qb - 2; if (lo < 0) lo = 0;
  const int hi = 4 * (qb + 1);
  const int last_w = (qw + 31) >> 6, first_w = (qw > 127 ? qw - 127 : 0) >> 6;
#pragma unroll
  for (int j = 0; j < NSLOT; ++j) {
    const int ch_ = 8 * j + wid;
    if (j < NSLOT - 1 || wid < REM) {
      const char* sp; unsigned sst;
      if (ch_ < KCH) { const int p = ch_ * 64 + lane, row = p / 9, g = p - row * 9;
        sp = (const char*)(a.k + (size_t)row * a.ldk + 8 * (g < 8 ? g : 0)); sst = (unsigned)(128 * a.ldk); }
      else { const int p = (ch_ - KCH) * 64 + lane, row = (p / 12) & 63, g = p - (p / 12) * 12;
        sp = (const char*)(a.v + (size_t)row * a.ldv + 8 * (g < 8 ? g : 0)); sst = (unsigned)(128 * a.ldv); }
      for (int kt = lo; kt < hi; ++kt)
        __builtin_amdgcn_global_load_lds((const unsigned*)(sp + (size_t)kt * sst), (LAS unsigned*)(lds + (kt - lo) * TILE + ch_ * 1024), 16, 0, 0);
    }
  }
  wait_vmcnt<0>();
  raw_barrier();
  const int i16 = lane & 15, q4 = i16 >> 2, p4 = i16 & 3, grp = (lane >> 4) & 1;
  for (int h4 = 0; h4 < 4; ++h4) {
    bf16x8 qf[NKS];
#pragma unroll
    for (int ks = 0; ks < NKS; ++ks) qf[ks] = *(const bf16x8*)(a.q + (size_t)myq * a.ldq + h4 * 64 + 16 * ks + 8 * hh);
    f32x16 O[NBLK];
#pragma unroll
    for (int bl = 0; bl < NBLK; ++bl)
#pragma unroll
      for (int i = 0; i < 16; ++i) O[bl][i] = 0.f;
    float m = sinks4[h4] / a.sl2;
    float l0 = (hh == 0) ? 1.f : 0.f, l1 = 0.f;
    for (int kt = first_w; kt <= last_w; ++kt) {
      LAS unsigned char* Kl = lds + (kt - lo) * TILE;
      f32x16 s[2];
      bf16x8 kf[2][NKS];
#pragma unroll
      for (int kb = 0; kb < 2; ++kb)
#pragma unroll
        for (int ks = 0; ks < NKS; ++ks) kf[kb][ks] = *(const LAS bf16x8*)(Kl + (32 * kb + r) * KSTR + (16 * ks + 8 * hh) * 2);
#pragma unroll
      for (int kb = 0; kb < 2; ++kb)
#pragma unroll
        for (int i = 0; i < 16; ++i) s[kb][i] = 0.f;
#pragma unroll
      for (int ks = 0; ks < NKS; ++ks)
#pragma unroll
        for (int kb = 0; kb < 2; ++kb) s[kb] = __builtin_amdgcn_mfma_f32_32x32x16_bf16(kf[kb][ks], qf[ks], s[kb], 0, 0, 0);
      const int key0 = kt * 64;
#pragma unroll
      for (int kb = 0; kb < 2; ++kb)
#pragma unroll
        for (int i = 0; i < 16; ++i) {
          const int key = key0 + 32 * kb + (i & 3) + 8 * (i >> 2) + 4 * hh;
          const bool valid = (key <= myq) && (myq - key < 128);
          s[kb][i] = valid ? s[kb][i] : -1e30f;
        }
      float mx = fmaxf(s[0][0], s[1][0]);
#pragma unroll
      for (int i = 1; i < 16; ++i) mx = fmaxf(fmaxf(mx, s[0][i]), s[1][i]);
      mx = half_max(mx);
      if (__builtin_amdgcn_ballot_w64(mx > m + tau) != 0ull) {
        const float mnew = fmaxf(m, mx);
        const float alpha = fast_exp2((m - mnew) * c);
        m = mnew; l0 *= alpha; l1 *= alpha;
#pragma unroll
        for (int bl = 0; bl < NBLK; ++bl)
#pragma unroll
          for (int i = 0; i < 16; ++i) O[bl][i] *= alpha;
      }
      const float nmc = -m * c;
      bf16x8 pf[2][2];
#pragma unroll
      for (int kb = 0; kb < 2; ++kb)
#pragma unroll
        for (int s2 = 0; s2 < 2; ++s2) {
          float pv[8];
#pragma unroll
          for (int e = 0; e < 8; ++e) pv[e] = fast_exp2(__builtin_fmaf(s[kb][8 * s2 + e], c, nmc));
          l0 += (pv[0] + pv[4]) + (pv[2] + pv[6]); l1 += (pv[1] + pv[5]) + (pv[3] + pv[7]);
          u32x4 w;
          w.x = pk2(pv[0], pv[1]); w.y = pk2(pv[2], pv[3]); w.z = pk2(pv[4], pv[5]); w.w = pk2(pv[6], pv[7]);
          pf[kb][s2] = __builtin_bit_cast(bf16x8, w);
        }
      LAS unsigned char* Vl = Kl + KCH * 1024 + (4 * hh + q4) * VSTR + (16 * grp) * 2 + 8 * p4;
#pragma unroll
      for (int st = 0; st < 4; ++st)
#pragma unroll
        for (int bl = 0; bl < NBLK; ++bl) {
          LAS unsigned char* ad = Vl + (16 * st) * VSTR + (32 * bl) * 2;
          const s16x4 lo_ = __builtin_amdgcn_ds_read_tr16_b64_v4i16((LAS s16x4*)ad);
          const s16x4 hi_ = __builtin_amdgcn_ds_read_tr16_b64_v4i16((LAS s16x4*)(ad + 8 * VSTR));
          const bf16x8 vf = __builtin_shufflevector(lo_, hi_, 0, 1, 2, 3, 4, 5, 6, 7);
          O[bl] = __builtin_amdgcn_mfma_f32_32x32x16_bf16(vf, pf[st >> 1][st & 1], O[bl], 0, 0, 0);
        }
    }
    const float l = half_sum(l0 + l1);
    const float inv = 1.f / l;
#pragma unroll
    for (int bl = 0; bl < NBLK; ++bl)
#pragma unroll
      for (int g = 0; g < 4; ++g) {
        const int f = h4 * 64 + 32 * bl + 8 * g + 4 * hh;
        float o0 = O[bl][4 * g + 0] * inv, o1 = O[bl][4 * g + 1] * inv, o2 = O[bl][4 * g + 2] * inv, o3 = O[bl][4 * g + 3] * inv;
        const u32x2 gv = *(const u32x2*)(a.gate + (size_t)myq * a.ldg + f);
        o0 *= silu_f(bflo(gv.x)); o1 *= silu_f(bfhi(gv.x)); o2 *= silu_f(bflo(gv.y)); o3 *= silu_f(bfhi(gv.y));
        u32x2 w; w.x = pk2(o0, o1); w.y = pk2(o2, o3);
        *(u32x2*)(a.out + (size_t)myq * a.ldo + f) = w;
      }
  }
  __syncthreads();
}

DI bool team_item(int G, int c, int n, int& bh, int& qb) {
  if (G == 256) {
    const int x = c & 7, li = c >> 3, t = li >> 3, i = li & 7;
    bh = x + 8 * (4 * t + n);
    const int j = (i + 4) & 7;
    qb = (n == 0) ? i : (n == 1) ? 7 - i : (n == 2) ? j : 7 - j;
    return true;
  }
  const int idx = n * G + ((n & 1) ? (G - 1 - c) : c);
  if (idx >= 1024) return false;
  qb = 7 - idx / 128; bh = idx % 128;
  return true;
}

DI int snake_idx(int round, int G, int c) { return round * G + ((round & 1) ? (G - 1 - c) : c); }

DI void attn_even(const Params& p, LAS unsigned char* lds, int i) {
  const int G = gridDim.x, c = blockIdx.x;
  unsigned char* ws = p.ws;
  const bf16_t* z = (const bf16_t*)(ws + WS_ZBUF);
  const bf16_t* qb_ = (const bf16_t*)(ws + WS_QBUF);
  const bf16_t* kv = (const bf16_t*)(ws + WS_HBUF);
  bf16_t* ob = (bf16_t*)(ws + WS_OBUF);
  for (int rd = 0; rd * G < 1024; ++rd) {
    int qb, bh;
    if (!team_item(G, c, rd, bh, qb)) continue;
    const int b = bh >> 3, hd = bh & 7;
    AttnArgs a;
    a.q = qb_ + (size_t)b * SEQ * 768 + hd * 96; a.ldq = 768;
    a.k = kv + (size_t)b * SEQ * 1024 + hd * 128; a.ldk = 1024;
    a.k2 = z + (size_t)b * SEQ * 2560 + 2432; a.ldk2 = 2560;
    a.v = kv + (size_t)b * SEQ * 1024 + hd * 128 + 64; a.ldv = 1024;
    a.out = ob + (size_t)b * SEQ * 1024 + hd * 64; a.ldo = 1024;
    a.gate = z + (size_t)b * SEQ * 2560 + 768 + hd * 64; a.ldg = 2560;
    a.fcum = nullptr; a.sl2 = 0.10206207261596577f * LOG2E; a.sink = 0.f;
    attn_item<96, 64, 0>(lds, a, qb);
  }
  for (int it = c; it < 256; it += G) {
    const int b = it >> 4, kvh = (it >> 3) & 1, qb = it & 7;
    AttnArgs a;
    const bf16_t* zb = z + (size_t)b * SEQ * 2560;
    a.q = zb + kvh * 256; a.ldq = 2560;
    a.k = zb + 512 + kvh * 64; a.ldk = 2560; a.k2 = nullptr; a.ldk2 = 0;
    a.v = zb + 640 + kvh * 64; a.ldv = 2560;
    a.out = ob + (size_t)b * SEQ * 1024 + 512 + kvh * 256; a.ldo = 1024;
    a.gate = zb + 768 + 512 + kvh * 256; a.ldg = 2560;
    a.fcum = nullptr; a.sl2 = 0.125f * LOG2E; a.sink = 0.f;
    float sk[4];
#pragma unroll
    for (int h4 = 0; h4 < 4; ++h4) sk[h4] = p.ev_sinks[i * 8 + kvh * 4 + h4] * LOG2E;
    swa_item(lds, a, sk, qb);
  }
}

DI void attn_odd(const Params& p, LAS unsigned char* lds, int layer) {
  const int G = gridDim.x, c = blockIdx.x;
  unsigned char* ws = p.ws;
  const bf16_t* z = (const bf16_t*)(ws + WS_ZBUF);
  bf16_t* od = (bf16_t*)(ws + WS_HBUF);
  bf16_t* ob = (bf16_t*)(ws + WS_OBUF);
  {
    for (int rd = 0; rd * G < 512; ++rd) {
      int qb, bh2;
      if (G == 256) { const int x = c & 7, li = c >> 3, t = li >> 3, i = li & 7; bh2 = x + 8 * (2 * t + rd); qb = (rd == 0) ? i : 7 - i; }
      else { const int idx = snake_idx(rd, G, c); if (idx >= 512) continue; qb = 7 - idx / 64; bh2 = idx % 64; }
      const int b = bh2 >> 2, h = bh2 & 3;
      const bf16_t* zb = z + (size_t)b * SEQ * 4096;
      for (int mp = 0; mp < 2; ++mp) {
        const int j = 2 * h + mp;
        AttnArgs a;
        a.q = zb + j * 64; a.ldq = 4096;
        a.k = zb + 512 + j * 64; a.ldk = 4096; a.k2 = nullptr; a.ldk2 = 0;
        a.v = zb + 1024 + h * 128; a.ldv = 4096;
        a.out = od + (size_t)b * SEQ * 1024 + j * 128; a.ldo = 1024;
        a.gate = nullptr; a.ldg = 0;
        a.fcum = nullptr; a.sl2 = 0.125f * LOG2E; a.sink = 0.f;
#ifndef SKIP_DIFF
        attn_item<64, 128, 0>(lds, a, qb);
#endif
      }
      __builtin_amdgcn_fence(__ATOMIC_SEQ_CST, "workgroup");
      asm volatile("s_waitcnt vmcnt(0)" ::: "memory");
      const int tid2 = opaque_tid(), lane = tid2 & 63, wid = tid2 >> 6, li_ = layer >> 1;
      const float* lp = p.od_lambda + li_ * 256;
      const float s1 = wave_sum(lp[lane] * lp[64 + lane]), s2 = wave_sum(lp[128 + lane] * lp[192 + lane]);
      const float lam_init = 0.8f - 0.6f * fast_exp2(-0.3f * LOG2E * (float)layer);
      const float lam = fast_exp2(s1 * LOG2E) - fast_exp2(s2 * LOG2E) + lam_init;
      const int rsub = lane >> 4, dv = (lane & 15) * 8;
      float sub[8];
#pragma unroll
      for (int e = 0; e < 8; ++e) sub[e] = p.od_subln[li_ * 128 + dv + e] * (1.f - lam_init);
      const size_t row0 = (size_t)b * SEQ + qb * 256 + 32 * wid;
#pragma unroll 2
      for (int rr = 0; rr < 8; ++rr) {
        const size_t row = row0 + 4 * rr + rsub;
        const u32x4 va = *(const u32x4*)(od + row * 1024 + (2 * h) * 128 + dv);
        const u32x4 vb = *(const u32x4*)(od + row * 1024 + (2 * h + 1) * 128 + dv);
        const u32x4 vg = *(const u32x4*)(z + row * 4096 + 3072 + h * 128 + dv);
        float d[8]; float ss = 0.f;
#pragma unroll
        for (int e = 0; e < 4; ++e) { d[2 * e] = bflo(va[e]) - lam * bflo(vb[e]); d[2 * e + 1] = bfhi(va[e]) - lam * bfhi(vb[e]); ss += d[2 * e] * d[2 * e] + d[2 * e + 1] * d[2 * e + 1]; }
        ss += __shfl_xor(ss, 1); ss += __shfl_xor(ss, 2); ss += __shfl_xor(ss, 4); ss += __shfl_xor(ss, 8);
        const float rs = rsqrtf(ss * (1.f / 128.f) + EPS);
        u32x4 w;
#pragma unroll
        for (int e = 0; e < 4; ++e) {
          const float o0 = d[2 * e] * rs * sub[2 * e] * silu_f(bflo(vg[e])), o1 = d[2 * e + 1] * rs * sub[2 * e + 1] * silu_f(bfhi(vg[e]));
          w[e] = pk2(o0, o1);
        }
        *(u32x4*)(ob + row * 1024 + h * 128 + dv) = w;
      }
    }
  }
  for (int rd = 0; rd * G < 1024; ++rd) {
    int qb, bh;
    if (!team_item(G, c, rd, bh, qb)) continue;
    const int b = bh >> 3, hd = bh & 7;
    AttnArgs a;
    const bf16_t* zb = z + (size_t)b * SEQ * 4096;
    a.q = zb + 1536 + hd * 64; a.ldq = 4096;
    a.k = zb + 2048 + hd * 64; a.ldk = 4096; a.k2 = nullptr; a.ldk2 = 0;
    a.v = zb + 2560 + hd * 64; a.ldv = 4096;
    a.out = ob + (size_t)b * SEQ * 1024 + 512 + hd * 64; a.ldo = 1024;
    a.gate = zb + 3072 + 512 + hd * 64; a.ldg = 4096;
    a.fcum = (const float*)(ws + WS_FCUM) + (size_t)bh * SEQ; a.sl2 = 0.125f * LOG2E; a.sink = 0.f;
#ifndef SKIP_FOX
    attn_item<64, 64, 2>(lds, a, qb);
#endif
  }
}

DI void diff_combine(const Params& p, int layer) {
  const int tid = opaque_tid(), lane = tid & 63, wid = tid >> 6;
  const int gw = blockIdx.x * 8 + wid, nw = gridDim.x * 8;
  const int i = layer >> 1;
  unsigned char* ws = p.ws;
  const bf16_t* od = (const bf16_t*)(ws + WS_HBUF);
  const bf16_t* z = (const bf16_t*)(ws + WS_ZBUF);
  bf16_t* ob = (bf16_t*)(ws + WS_OBUF);
  const float* lp = p.od_lambda + i * 256;
  const float s1 = wave_sum(lp[lane] * lp[64 + lane]), s2 = wave_sum(lp[128 + lane] * lp[192 + lane]);
  const float lam_init = 0.8f - 0.6f * expf(-0.3f * (float)layer);
  const float lam = expf(s1) - expf(s2) + lam_init;
  const int hd = lane >> 4, dv = (lane & 15) * 8;
  float sub[8];
#pragma unroll
  for (int e = 0; e < 8; ++e) sub[e] = p.od_subln[i * 128 + dv + e] * (1.f - lam_init);
  for (int row = gw; row < T; row += nw) {
    const u32x4 a = *(const u32x4*)(od + (size_t)row * 1024 + (2 * hd) * 128 + dv);
    const u32x4 b = *(const u32x4*)(od + (size_t)row * 1024 + (2 * hd + 1) * 128 + dv);
    const u32x4 g = *(const u32x4*)(z + (size_t)row * 4096 + 3072 + hd * 128 + dv);
    float d[8]; float ss = 0.f;
#pragma unroll
    for (int e = 0; e < 4; ++e) { d[2 * e] = bflo(a[e]) - lam * bflo(b[e]); d[2 * e + 1] = bfhi(a[e]) - lam * bfhi(b[e]); ss += d[2 * e] * d[2 * e] + d[2 * e + 1] * d[2 * e + 1]; }
    ss += __shfl_xor(ss, 1); ss += __shfl_xor(ss, 2); ss += __shfl_xor(ss, 4); ss += __shfl_xor(ss, 8);
    const float rs = rsqrtf(ss * (1.f / 128.f) + EPS);
    u32x4 w;
#pragma unroll
    for (int e = 0; e < 4; ++e) {
      const float o0 = d[2 * e] * rs * sub[2 * e] * silu_f(bflo(g[e])), o1 = d[2 * e + 1] * rs * sub[2 * e + 1] * silu_f(bfhi(g[e]));
      w[e] = pk2(o0, o1);
    }
    *(u32x4*)(ob + (size_t)row * 1024 + hd * 128 + dv) = w;
  }
}


DI void grid_barrier(unsigned* ctr, unsigned& epoch) {
  asm volatile("s_waitcnt vmcnt(0)" ::: "memory");
  __syncthreads();
  epoch += 1;
  if (threadIdx.x == 0) {
    __builtin_amdgcn_fence(__ATOMIC_RELEASE, "agent");
    asm volatile("s_waitcnt vmcnt(0)" ::: "memory");
    __hip_atomic_fetch_add(ctr, 1u, __ATOMIC_RELAXED, __HIP_MEMORY_SCOPE_AGENT);
    const unsigned target = epoch * gridDim.x;
    while (__hip_atomic_load(ctr, __ATOMIC_RELAXED, __HIP_MEMORY_SCOPE_AGENT) < target) __builtin_amdgcn_s_sleep(1);
    __builtin_amdgcn_fence(__ATOMIC_ACQUIRE, "agent");
    asm volatile("s_waitcnt vmcnt(0)" ::: "memory");
  }
  __syncthreads();
}


#define XB_TMO      128
#define XB_XCNT(j)  (256  + 64 * (j))
#define XB_XSUB(j)  (1280 + 64 * (j))
#define XB_XGEN(j)  (2304 + 64 * (j))
#define XB_TOP      3328
#define XB_TOPGEN   3392
#define XCD_BAR_WORDS 3456
#define XB_SPIN_CAP (1u << 20)
DI unsigned xb_ld(unsigned* p) { return __hip_atomic_load(p, __ATOMIC_RELAXED, __HIP_MEMORY_SCOPE_AGENT); }
DI unsigned xb_add(unsigned* p, unsigned v) { return __hip_atomic_fetch_add(p, v, __ATOMIC_RELAXED, __HIP_MEMORY_SCOPE_AGENT); }
DI unsigned xb_xcc_id() { return (unsigned)__builtin_amdgcn_s_getreg((3 << 11) | 20) & 0xFu; }
#define XB_SPIN(cond, bar) do { unsigned _sp = 0; while (cond) { __builtin_amdgcn_s_sleep(1); \
    if ((++_sp & 255u) == 0u) { if (xb_ld(&(bar)[XB_TMO])) break; if (_sp > XB_SPIN_CAP) { atomicAdd(&(bar)[XB_TMO], 1u); break; } } } } while (0)
struct XcdBarrier { unsigned* bar; unsigned x; volatile LAS unsigned* st; };
DI void xcd_barrier_complete(unsigned* bar, unsigned x, unsigned& nloc, unsigned& nx) {
  const unsigned G = gridDim.x;
  unsigned sum, cnt, mine, sp = 0u;
  for (;;) {
    sum = 0u; cnt = 0u; mine = 0u;
#pragma unroll
    for (unsigned j = 0; j < 16; ++j) { const unsigned c = xb_ld(&bar[XB_XCNT(j)]); sum += c; cnt += (c > 0u) ? 1u : 0u; mine = (j == x) ? c : mine; }
    if (sum == G) break;
    __builtin_amdgcn_s_sleep(1);
    if ((++sp & 255u) == 0u) { if (xb_ld(&bar[XB_TMO])) break; if (sp > XB_SPIN_CAP) { atomicAdd(&bar[XB_TMO], 1u); break; } }
  }
  nloc = mine > 0u ? mine : 1u; nx = cnt > 0u ? cnt : 1u;
}
DI void xcd_barrier(const XcdBarrier& b) {
  asm volatile("s_waitcnt vmcnt(0)" ::: "memory");
  __syncthreads();
  if (threadIdx.x == 0) {
    unsigned* bar = b.bar;
    __builtin_amdgcn_s_waitcnt(0);
    unsigned nloc = b.st[0], nx = b.st[1];
    if (nloc == 0u) { xcd_barrier_complete(bar, b.x, nloc, nx); b.st[0] = nloc; b.st[1] = nx; }
    const unsigned old = xb_add(&bar[XB_XSUB(b.x)], 1u);
    const unsigned gen = old / nloc;
    if (old + 1u == (gen + 1u) * nloc) {
      __builtin_amdgcn_fence(__ATOMIC_RELEASE, "agent");
      asm volatile("s_waitcnt vmcnt(0)" ::: "memory");
      const unsigned og = xb_add(&bar[XB_TOP], 1u);
      const unsigned tg = og / nx;
      if (og + 1u == (tg + 1u) * nx) xb_add(&bar[XB_TOPGEN], 1u);
      else XB_SPIN(xb_ld(&bar[XB_TOPGEN]) == tg, bar);
      __builtin_amdgcn_fence(__ATOMIC_ACQUIRE, "agent");
      xb_add(&bar[XB_XGEN(b.x)], 1u);
      asm volatile("s_waitcnt vmcnt(0)" ::: "memory");
    } else {
      XB_SPIN(xb_ld(&bar[XB_XGEN(b.x)]) == gen, bar);
      __builtin_amdgcn_fence(__ATOMIC_ACQUIRE, "agent");
      asm volatile("s_waitcnt vmcnt(0)" ::: "memory");
    }
  }
  __syncthreads();
}

__global__ void __launch_bounds__(512) fwd_megakernel(Params p) {
  extern __shared__ __attribute__((aligned(16))) unsigned char lds_raw[];
  LAS unsigned char* lds = (LAS unsigned char*)lds_raw;
  cg::grid_group grid = cg::this_grid();
  unsigned char* ws = p.ws;
  const int G = gridDim.x, bid = blockIdx.x;
  const float* cosH = (const float*)(ws + WS_COSH); const float* sinH = (const float*)(ws + WS_SINH);
  const float* cosR = (const float*)(ws + WS_COSR); const float* sinR = (const float*)(ws + WS_SINR);

  unsigned* xbar = (unsigned*)(ws + WS_XBAR);
  if (bid == 0) { for (int w = threadIdx.x; w < XCD_BAR_WORDS; w += 512) __hip_atomic_store(xbar + w, 0u, __ATOMIC_RELAXED, __HIP_MEMORY_SCOPE_AGENT); }
  volatile LAS unsigned* xst = (volatile LAS unsigned*)(lds + LDS_BYTES_C - 16);
  if (threadIdx.x == 0) { xst[0] = 0u; xst[1] = 0u; }
#ifndef SKIP_PRO
  prologue(p, lds);
#endif
  grid.sync();
  XcdBarrier xb; xb.bar = xbar; xb.x = xb_xcc_id(); xb.st = xst;
  if (threadIdx.x == 0) (void)xb_add(&xbar[XB_XCNT(xb.x)], 1u);
#pragma unroll
  for (int layer = 0; layer < 4; ++layer) {
    const int i = layer >> 1; const bool odd = layer & 1;
#ifndef SKIP_ROW
    rowwise_phase(p, lds, layer - 1, layer);
#endif
    xcd_barrier(xb);
    {
#ifndef SKIP_SCAN
      if (odd && bid < 128) fox_scan(p, lds, bid);
#endif
      pg8::Gemm g; g.A = (const bf16_t*)(ws + WS_HBUF); g.lda = 1024; g.K = 1024; g.M = T;
      Epi e; e.out = (bf16_t*)(ws + WS_ZBUF); e.pin = nullptr; e.pslot = 0; e.nK = 0; e.qmode = 0; e.pout = odd ? nullptr : (float*)(ws + WS_PART); e.cosH = cosH; e.sinH = sinH; e.cosR = cosR; e.sinR = sinR;
      if (!odd) { g.Bt = (const bf16_t*)(ws + WS_WEVIN + i * SZ_WEVIN); g.N = 2560; e.ldc = 2560; e.rope64_end = 640; e.rope32_lo = 2432; e.rope32_hi = 2464; }
      else { g.Bt = (const bf16_t*)(ws + WS_WODIN + i * SZ_WODIN); g.N = 4096; e.ldc = 4096; e.rope64_end = 1024; e.rope32_lo = 0; e.rope32_hi = 0; }
      pg8::StaticOrder S; S.init(g.M, g.N, G, bid);
#ifndef SKIP_G1
      pg8::gemm_phase<Epi>(lds, g, S, e);
#endif
    }
    xcd_barrier(xb);
    if (!odd) {
      for (int which = 0; which < 2; ++which) {
        pg8::Gemm g; g.M = T; g.lda = 2560;
        Epi e; e.rope64_end = 0; e.rope32_lo = 0; e.rope32_hi = 0; e.cosH = cosH; e.sinH = sinH; e.cosR = cosR; e.sinR = sinR; e.pout = nullptr; e.pin = (const float*)(ws + WS_PART);
        if (which == 0) { g.A = (const bf16_t*)(ws + WS_ZBUF) + 1792; g.Bt = (const bf16_t*)(ws + WS_WUQ + i * SZ_WUQ); g.N = 768; g.K = 384;
          e.out = (bf16_t*)(ws + WS_QBUF); e.ldc = 768; e.qmode = 1; e.pslot = 0; e.nK = 384; }
        else { g.A = (const bf16_t*)(ws + WS_ZBUF) + 2176; g.Bt = (const bf16_t*)(ws + WS_WUKV + i * SZ_WUKV); g.N = 1024; g.K = 256;
          e.out = (bf16_t*)(ws + WS_HBUF); e.ldc = 1024; e.qmode = 0; e.pslot = 12; e.nK = 256; }
        pg8::StaticOrder S; S.init(g.M, g.N, G, bid);
#ifndef SKIP_G2
        pg8::gemm_phase<Epi>(lds, g, S, e);
#endif
      }
      xcd_barrier(xb);
#ifndef SKIP_ATTE
      attn_even(p, lds, i);
#endif
      xcd_barrier(xb);
    } else {
#ifndef SKIP_ATTO
      attn_odd(p, lds, layer);
#endif
      xcd_barrier(xb);
    }
    {
      pg8::Gemm g; g.A = (const bf16_t*)(ws + WS_OBUF); g.lda = 1024; g.K = 1024; g.M = T; g.N = 1024;
      g.Bt = (const bf16_t*)(ws + (odd ? WS_WODOUT : WS_WEVOUT) + i * SZ_WOUT);
      Epi e; e.out = (bf16_t*)(ws + WS_HBUF); e.ldc = 1024; e.pin = nullptr; e.pslot = 0; e.pout = nullptr; e.nK = 0; e.qmode = 0; e.rope64_end = 0; e.rope32_lo = 0; e.rope32_hi = 0;
      e.cosH = cosH; e.sinH = sinH; e.cosR = cosR; e.sinR = sinR;
      pg8::StaticOrder S; S.init(g.M, g.N, G, bid);
#ifndef SKIP_G3
      pg8::gemm_phase<Epi>(lds, g, S, e);
#endif
    }
    xcd_barrier(xb);
  }
#ifndef SKIP_ROW
  rowwise_phase(p, lds, 3, 4);
#endif
}

constexpr int LDS_BYTES = 155648;
static_assert(LDS_BYTES == LDS_BYTES_C, "LDS size mismatch");

extern "C" void kernel_launch(void* const* d_in, const int* in_sizes, int n_in, void* d_out, int out_size, void* d_ws, size_t ws_size, hipStream_t stream) {
  static int grid_blocks = 0;
  if (grid_blocks == 0) {
    int dev = 0, cus = 0, per_cu = 0;
    if (hipGetDevice(&dev) != hipSuccess || hipDeviceGetAttribute(&cus, hipDeviceAttributeMultiprocessorCount, dev) != hipSuccess) { fprintf(stderr, "device query failed\n"); grid_blocks = -1; return; }
    if (hipFuncSetAttribute((const void*)fwd_megakernel, hipFuncAttributeMaxDynamicSharedMemorySize, LDS_BYTES) != hipSuccess) { fprintf(stderr, "hipFuncSetAttribute failed\n"); grid_blocks = -1; return; }
    if (hipOccupancyMaxActiveBlocksPerMultiprocessor(&per_cu, (const void*)fwd_megakernel, 512, LDS_BYTES) != hipSuccess || per_cu < 1) { fprintf(stderr, "occupancy query: %d\n", per_cu); per_cu = 1; }
    (void)hipGetLastError();
    grid_blocks = cus;
    if (ws_size < WS_END) { fprintf(stderr, "workspace too small: %zu < %zu\n", ws_size, (size_t)WS_END); grid_blocks = -1; return; }
  }
  if (grid_blocks < 0) return;
  Params p{};
  const float** fp = (const float**)&p;
  for (int i = 0; i < 18; ++i) fp[i] = (const float*)d_in[i];
  p.out = (float*)d_out; p.ws = (unsigned char*)d_ws;
  void* args[] = {&p};
  hipError_t e = hipLaunchCooperativeKernel((const void*)fwd_megakernel, dim3(grid_blocks), dim3(512), args, LDS_BYTES, stream);
  if (e != hipSuccess) fprintf(stderr, "cooperative launch failed: %s (grid %d)\n", hipGetErrorString(e), grid_blocks);
}
```

```cpp
#include <hip/hip_runtime.h>
#include <hip/hip_cooperative_groups.h>
#include <cstdio>
#include <type_traits>
namespace cg = cooperative_groups;

#define DI __device__ __forceinline__
#define LAS __attribute__((address_space(3)))
typedef unsigned short bf16_t;
typedef short bf16x8 __attribute__((ext_vector_type(8)));
typedef short s16x4 __attribute__((ext_vector_type(4)));
typedef float f32x2 __attribute__((ext_vector_type(2)));
typedef float f32x4 __attribute__((ext_vector_type(4)));
typedef float f32x16 __attribute__((ext_vector_type(16)));
typedef unsigned u32x2 __attribute__((ext_vector_type(2)));
typedef unsigned u32x4 __attribute__((ext_vector_type(4)));
typedef __bf16 bf16x2_t __attribute__((ext_vector_type(2)));

constexpr int T = 32768, DM = 1024, NB = 16, SEQ = 2048;
constexpr float LOG2E = 1.4426950408889634f;
constexpr float EPS = 1e-6f;
constexpr int LDS_BYTES_C = 155648;

constexpr size_t SZ_WEVIN = 2560ull * 1024 * 2, SZ_WODIN = 4096ull * 1024 * 2, SZ_WUQ = 768ull * 384 * 2, SZ_WUKV = 1024ull * 256 * 2, SZ_WOUT = 1024ull * 1024 * 2;
constexpr size_t WS_WEVIN = 0;
constexpr size_t WS_WODIN = WS_WEVIN + 2 * SZ_WEVIN;
constexpr size_t WS_WUQ = WS_WODIN + 2 * SZ_WODIN;
constexpr size_t WS_WUKV = WS_WUQ + 2 * SZ_WUQ;
constexpr size_t WS_WEVOUT = WS_WUKV + 2 * SZ_WUKV;
constexpr size_t WS_WODOUT = WS_WEVOUT + 2 * SZ_WOUT;
constexpr size_t WS_MOD = WS_WODOUT + 2 * SZ_WOUT;
constexpr size_t WS_COSH = WS_MOD + 4ull * 16 * 3072 * 4;
constexpr size_t WS_SINH = WS_COSH + 2048ull * 32 * 4;
constexpr size_t WS_COSR = WS_SINH + 2048ull * 32 * 4;
constexpr size_t WS_SINR = WS_COSR + 2048ull * 16 * 4;
constexpr size_t WS_LOGF = WS_SINR + 2048ull * 16 * 4;
constexpr size_t WS_FCUM = WS_LOGF + (size_t)T * 8 * 4;
constexpr size_t WS_HBUF = (WS_FCUM + (size_t)T * 8 * 4 + 4095) & ~(size_t)4095;
constexpr size_t WS_OBUF = WS_HBUF + (size_t)T * 1024 * 2;
constexpr size_t WS_ZBUF = WS_OBUF + (size_t)T * 1024 * 2;
constexpr size_t WS_QBUF = WS_ZBUF + (size_t)T * 2560 * 2;
constexpr size_t WS_BAR = WS_ZBUF + (size_t)T * 4096 * 2;
constexpr size_t WS_PART = WS_BAR + 256;
constexpr size_t WS_XBAR = (WS_PART + (size_t)T * 20 * 4 + 4095) & ~(size_t)4095;
constexpr size_t WS_XBF_PRE = WS_XBAR + 16384;
constexpr size_t WS_XBF = WS_XBF_PRE;
constexpr size_t WS_END = WS_XBF + (size_t)T * 1024 * 2;

struct Params {
  const float *x, *c, *w_ada, *b_ada, *g_pre, *g_post, *ev_w_in, *ev_q_norm, *ev_kv_norm, *ev_w_uq, *ev_w_ukv, *ev_sinks, *ev_w_out,
      *od_w_in, *od_forget_bias, *od_lambda, *od_subln, *od_w_out;
  float* out;
  unsigned char* ws;
};

DI int opaque_tid() { int t = threadIdx.x; asm volatile("" : "+v"(t)); return t; }
DI float bflo(unsigned u) { return __uint_as_float(u << 16); }
DI float bfhi(unsigned u) { return __uint_as_float(u & 0xffff0000u); }
DI unsigned pk2(float lo, float hi) { f32x2 f = {lo, hi}; bf16x2_t b = __builtin_convertvector(f, bf16x2_t); return __builtin_bit_cast(unsigned, b); }
DI bf16_t f2bf(float f) { return (bf16_t)(pk2(f, 0.f) & 0xffffu); }
DI float fast_exp2(float x) { return __builtin_amdgcn_exp2f(x); }
DI float silu_f(float x) { return x * __builtin_amdgcn_rcpf(1.f + fast_exp2(-x * LOG2E)); }
template <int CTRL> DI float dpp_mov(float v) { return __builtin_bit_cast(float, __builtin_amdgcn_update_dpp(0, __builtin_bit_cast(int, v), CTRL, 0xf, 0xf, false)); }
DI float wave_sum(float v) {
  v += dpp_mov<0xB1>(v);
  v += dpp_mov<0x4E>(v);
  v += dpp_mov<0x141>(v);
  v += dpp_mov<0x140>(v);
  { const unsigned u = __float_as_uint(v); auto r = __builtin_amdgcn_permlane16_swap(u, u, false, false); v = __uint_as_float(r[0]) + __uint_as_float(r[1]); }
  { const unsigned u = __float_as_uint(v); auto r = __builtin_amdgcn_permlane32_swap(u, u, false, false); v = __uint_as_float(r[0]) + __uint_as_float(r[1]); }
  return v;
}

namespace pg8 {
constexpr int BM = 256, BK = 64, HALF = 128, HTB = HALF * BK * 2, STAGE_BYTES = 8 * HTB, NXCD = 8, WGM = 8;
DI int lds_byte(int r, int c) { const int st = (r >> 4) * 2 + (c >> 5), rr = r & 15, cc = c & 31, ob = rr * 64 + cc * 2; return st * 1024 + (ob ^ (((ob >> 9) & 1) << 5)); }
DI void stage_rc(int b, int& R, int& C) { const int st = b / 1024, sb = b % 1024, swz = sb ^ (((sb >> 9) & 1) << 5); R = (st >> 1) * 16 + swz / 64; C = (st & 1) * 32 + (swz % 64) / 2; }
DI int perm32(int rho) { const int n = rho >> 4, i = rho & 15; return 8 * (i >> 2) + 4 * n + (i & 3); }
struct Unit { int pm, pn; };
struct Gemm { const bf16_t* A; const bf16_t* Bt; int M, N, K, lda; };
struct StaticOrder {
  int nM, nN, nwg, G, c;
  DI void init(int M, int N, int G_, int c_) { nM = M / BM; nN = N / BM; nwg = nM * nN; G = G_; c = c_; }
  DI bool next(int i, Unit& u) const {
    const long L = (long)i * G + c; if (L >= nwg) return false;
    int wgid = (int)L; { const int q = nwg / NXCD, r = nwg % NXCD, xcd = wgid % NXCD, off = wgid / NXCD; wgid = (xcd < r ? xcd * (q + 1) : r * (q + 1) + (xcd - r) * q) + off; }
    const int nig = WGM * nN, gid = wgid / nig, fm = gid * WGM, gsz = (nM - fm) < WGM ? (nM - fm) : WGM;
    u.pm = fm + ((wgid % nig) % gsz); u.pn = (wgid % nig) / gsz; return true;
  }
};

template <class Epi>
DI void gemm_phase(LAS unsigned char* lds, const Gemm g, const StaticOrder& S, const Epi& E) {
  const int tid = opaque_tid(), wid = __builtin_amdgcn_readfirstlane(tid >> 6), lane = tid & 63, wr = wid >> 2, wc = wid & 3, fr = lane & 15, fq = lane >> 4;
  const int K = g.K, nt = K / BK, lda = g.lda;
  unsigned voffA[2], voffB[2];
#pragma unroll
  for (int i = 0; i < 2; ++i) { int R, C; stage_rc(tid * 16 + i * 8192, R, C); const int Rb = (R & ~31) + perm32(R & 31);
    voffA[i] = (unsigned)(R * lda + C) * 2u; voffB[i] = (unsigned)(Rb * K + C) * 2u; }
  const size_t kstep = (size_t)(BK * 2);
  const size_t hstepA = (size_t)HALF * lda * 2, hstepB = (size_t)HALF * K * 2;
  const size_t tstepA = 2 * hstepA, tstepB = 2 * hstepB;
  const unsigned ldsw = (unsigned)wid * 1024u;
  const int aoff = lds_byte(wr * 64 + fr, fq * 8), boff = lds_byte(wc * 32 + fr, fq * 8);
#define PG8_SA(b, h) (((b) * 2 + (h)) * HTB)
#define PG8_SB(b, h) ((4 + (b) * 2 + (h)) * HTB)
#define PG8_STAGE(bufoff, gbase, voff) do { _Pragma("unroll") for (int _i = 0; _i < 2; ++_i) \
    __builtin_amdgcn_global_load_lds((const unsigned*)((const char*)(gbase) + (voff)[_i]), (LAS unsigned*)(lds + (bufoff) + ldsw + _i * 8192), 16, 0, 0); } while (0)
#define PG8_LDA(dst, b, h) do { _Pragma("unroll") for (int m = 0; m < 4; ++m) _Pragma("unroll") for (int k = 0; k < 2; ++k) dst[m][k] = *(const LAS bf16x8*)(lds + PG8_SA(b, h) + aoff + m * 2048 + k * 1024); } while (0)
#define PG8_LDB(dst, b, h) do { _Pragma("unroll") for (int n = 0; n < 2; ++n) _Pragma("unroll") for (int k = 0; k < 2; ++k) dst[n][k] = *(const LAS bf16x8*)(lds + PG8_SB(b, h) + boff + n * 2048 + k * 1024); } while (0)
#define PG8_MMA(ai, bj, At, Bt) do { __builtin_amdgcn_s_setprio(1); _Pragma("unroll") for (int m = 0; m < 4; ++m) _Pragma("unroll") for (int n = 0; n < 2; ++n) _Pragma("unroll") for (int k = 0; k < 2; ++k) \
    acc[ai][bj][m][n] = __builtin_amdgcn_mfma_f32_16x16x32_bf16(Bt[n][k], At[m][k], acc[ai][bj][m][n], 0, 0, 0); __builtin_amdgcn_s_setprio(0); } while (0)
#define PG8_WAIT_V(n) asm volatile("s_waitcnt vmcnt(" #n ")" ::: "memory")
#define PG8_WAIT_L(n) asm volatile("s_waitcnt lgkmcnt(" #n ")" ::: "memory")
#define PG8_BAR __builtin_amdgcn_s_barrier()
#define PG8_SCHED __builtin_amdgcn_sched_barrier(0)
  Unit cur, nxt; int ui = 0;
  if (!S.next(0, cur)) return;
  f32x4 acc[2][2][4][2];
#pragma unroll
  for (int a = 0; a < 2; ++a)
#pragma unroll
    for (int b = 0; b < 2; ++b)
#pragma unroll
      for (int m = 0; m < 4; ++m)
#pragma unroll
        for (int n = 0; n < 2; ++n) acc[a][b][m][n] = (f32x4){0.f, 0.f, 0.f, 0.f};
  bf16x8 At[4][2], B0[2][2], B1[2][2];
  const char* cA = (const char*)g.A + (size_t)cur.pm * tstepA; const char* cB = (const char*)g.Bt + (size_t)cur.pn * tstepB;
  PG8_STAGE(PG8_SB(0, 0), cB, voffB); PG8_STAGE(PG8_SA(0, 0), cA, voffA); PG8_STAGE(PG8_SB(0, 1), cB + hstepB, voffB); PG8_STAGE(PG8_SA(0, 1), cA + hstepA, voffA);
  if (wr == 1) PG8_BAR;
  PG8_WAIT_V(4); PG8_BAR;
  PG8_STAGE(PG8_SB(1, 0), cB + kstep, voffB); PG8_STAGE(PG8_SA(1, 0), cA + kstep, voffA); PG8_STAGE(PG8_SB(1, 1), cB + hstepB + kstep, voffB);
  PG8_WAIT_V(6); PG8_BAR;
  for (;;) {
    const bool has_next = S.next(ui + 1, nxt);
    const char* nA = has_next ? (const char*)g.A + (size_t)nxt.pm * tstepA : cA; const char* nB = has_next ? (const char*)g.Bt + (size_t)nxt.pn * tstepB : cB;
    for (int t = 0; t < nt; t += 2) {
      const bool last = (t == nt - 2);
      const char* a1 = cA + (size_t)(t + 1) * kstep;
      const char* a2 = last ? nA : cA + (size_t)(t + 2) * kstep; const char* b2 = last ? nB : cB + (size_t)(t + 2) * kstep;
      const char* a3 = a2 + kstep; const char* b3 = b2 + kstep;
      PG8_LDB(B0, 0, 0); PG8_SCHED; PG8_LDA(At, 0, 0); PG8_STAGE(PG8_SA(1, 1), a1 + hstepA, voffA);
      PG8_WAIT_L(8); PG8_BAR; PG8_WAIT_L(0); PG8_MMA(0, 0, At, B0); PG8_BAR; PG8_SCHED;
      PG8_LDB(B1, 0, 1); PG8_STAGE(PG8_SB(0, 0), b2, voffB);
      PG8_BAR; PG8_WAIT_L(0); PG8_MMA(0, 1, At, B1); PG8_BAR;
      PG8_LDA(At, 0, 1); PG8_STAGE(PG8_SA(0, 0), a2, voffA);
      PG8_BAR; PG8_WAIT_L(0); PG8_MMA(1, 0, At, B0); PG8_BAR; PG8_SCHED;
      PG8_STAGE(PG8_SB(0, 1), b2 + hstepB, voffB);
      PG8_WAIT_V(6); PG8_BAR; PG8_MMA(1, 1, At, B1); PG8_BAR;
      PG8_LDB(B0, 1, 0); PG8_SCHED; PG8_LDA(At, 1, 0); PG8_STAGE(PG8_SA(0, 1), a2 + hstepA, voffA);
      PG8_WAIT_L(8); PG8_BAR; PG8_WAIT_L(0); PG8_MMA(0, 0, At, B0); PG8_BAR; PG8_SCHED;
      PG8_LDB(B1, 1, 1); PG8_STAGE(PG8_SB(1, 0), b3, voffB);
      PG8_BAR; PG8_WAIT_L(0); PG8_MMA(0, 1, At, B1); PG8_BAR;
      PG8_LDA(At, 1, 1); PG8_STAGE(PG8_SA(1, 0), a3, voffA);
      PG8_BAR; PG8_WAIT_L(0); PG8_MMA(1, 0, At, B0); PG8_BAR; PG8_SCHED;
      PG8_STAGE(PG8_SB(1, 1), b3 + hstepB, voffB);
      PG8_WAIT_V(6); PG8_BAR; PG8_MMA(1, 1, At, B1); PG8_BAR;
    }
    E(acc, cur, wr, wc, fr, fq);
    if (!has_next) break;
#pragma unroll
    for (int a = 0; a < 2; ++a)
#pragma unroll
      for (int b = 0; b < 2; ++b)
#pragma unroll
        for (int m = 0; m < 4; ++m)
#pragma unroll
          for (int n = 0; n < 2; ++n) acc[a][b][m][n] = (f32x4){0.f, 0.f, 0.f, 0.f};
    cur = nxt; cA = nA; cB = nB; ++ui;
  }
  PG8_WAIT_V(0);
  if (wr == 0) PG8_BAR;
  PG8_BAR;
#undef PG8_SA
#undef PG8_SB
#undef PG8_STAGE
#undef PG8_LDA
#undef PG8_LDB
#undef PG8_MMA
#undef PG8_WAIT_V
#undef PG8_WAIT_L
#undef PG8_BAR
#undef PG8_SCHED
}
}

struct Epi {
  bf16_t* out; int ldc;
  int rope64_end;
  int rope32_lo, rope32_hi;
  int qmode;
  const float* pin; int nK;
  int pslot;
  float* pout;
  const float *cosH, *sinH, *cosR, *sinR;
  DI void operator()(const f32x4 (&acc)[2][2][4][2], const pg8::Unit& u, int wr, int wc, int fr, int fq) const {
    const int row0 = u.pm * 256 + wr * 64 + fr;
    int rt[2];
#pragma unroll
    for (int bj = 0; bj < 2; ++bj) {
      const int cw = u.pn * 256 + bj * 128 + wc * 32;
      rt[bj] = 0;
      if (cw < rope64_end) rt[bj] = 1;
      else if (cw >= rope32_lo && cw < rope32_hi) rt[bj] = 2;
      else if (qmode && ((cw >> 5) % 3) == 2) rt[bj] = 2;
    }
    const int tt = rt[0] | rt[1];
    const float* ctab = (tt == 1) ? cosH + (16 * (wc & 1) + 4 * fq) : cosR + 4 * fq;
    const float* stab = (tt == 1) ? sinH + (16 * (wc & 1) + 4 * fq) : sinR + 4 * fq;
    const int tstride = (tt == 1) ? 32 : 16;
    int ps[2] = {-1, -1};
    if (pout) {
#pragma unroll
      for (int bj = 0; bj < 2; ++bj) { const int cw = u.pn * 256 + bj * 128 + wc * 32;
        if (cw >= 1792 && cw < 2432) ps[bj] = ((cw - 1792) >> 7) * 4 + wc; }
    }
#pragma unroll
    for (int ai = 0; ai < 2; ++ai) {
      f32x4 cv[4], sv[4]; float rs[4];
#pragma unroll
      for (int m = 0; m < 4; ++m) {
        const int row = row0 + ai * 128 + m * 16;
        if (tt) { const int pos = row & (SEQ - 1); cv[m] = *(const f32x4*)(ctab + pos * tstride); sv[m] = *(const f32x4*)(stab + pos * tstride); }
        rs[m] = 1.f;
        if (pin) { const f32x4 p0 = *(const f32x4*)(pin + (size_t)row * 20 + pslot), p1 = *(const f32x4*)(pin + (size_t)row * 20 + pslot + 4);
          float ss = ((p0[0] + p0[1]) + (p0[2] + p0[3])) + ((p1[0] + p1[1]) + (p1[2] + p1[3]));
          if (nK == 384) { const f32x4 p2 = *(const f32x4*)(pin + (size_t)row * 20 + pslot + 8); ss += (p2[0] + p2[1]) + (p2[2] + p2[3]); }
          rs[m] = rsqrtf(ss / (float)nK + EPS); }
      }
#pragma unroll
      for (int m = 0; m < 4; ++m) {
        const int row = row0 + ai * 128 + m * 16;
#pragma unroll
        for (int bj = 0; bj < 2; ++bj) {
          const int c0 = u.pn * 256 + bj * 128 + wc * 32 + 8 * fq;
          f32x4 v0 = acc[ai][bj][m][0] * rs[m], v1 = acc[ai][bj][m][1] * rs[m];
          if (ps[bj] >= 0) {
            float sq = (v0[0] * v0[0] + v0[1] * v0[1]) + (v0[2] * v0[2] + v0[3] * v0[3]) + (v1[0] * v1[0] + v1[1] * v1[1]) + (v1[2] * v1[2] + v1[3] * v1[3]);
            sq += __shfl_xor(sq, 16); sq += __shfl_xor(sq, 32);
            if (fq == 0) pout[(size_t)row * 20 + ps[bj]] = sq;
          }
          if (rt[bj]) {
            const f32x4 o1 = v0 * cv[m] - v1 * sv[m], o2 = v1 * cv[m] + v0 * sv[m];
            v0 = o1; v1 = o2;
          }
          u32x4 w; w.x = pk2(v0[0], v0[1]); w.y = pk2(v0[2], v0[3]); w.z = pk2(v1[0], v1[1]); w.w = pk2(v1[2], v1[3]);
          *(u32x4*)(out + (size_t)row * ldc + c0) = w;
        }
      }
    }
  }
};

DI int ropeperm64(int p) { const int g = p >> 3, r = p & 7; return r < 4 ? 4 * g + r : 32 + 4 * g + (r - 4); }
DI int ropeperm32(int p) { const int g = p >> 3, r = p & 7; return r < 4 ? 4 * g + r : 16 + 4 * g + (r - 4); }
DI int srccol(int kind, int n) {
  if (kind == 0) {
    if (n < 512) return 672 + (n & ~63) + ropeperm64(n & 63);
    if (n < 640) return 1184 + ((n - 512) & ~63) + ropeperm64(n & 63);
    if (n < 768) return 1312 + (n - 640);
    if (n < 1792) return 1440 + (n - 768);
    if (n < 2176) return n - 1792;
    if (n < 2432) return 384 + (n - 2176);
    if (n < 2464) return 640 + ropeperm32(n - 2432);
    return -1;
  }
  if (kind == 1) {
    if (n < 1024) return (n & ~63) + ropeperm64(n & 63);
    if (n < 3072) return n;
    return 3080 + (n - 3072);
  }
  if (kind == 2) { const int hd = n / 96, p = n - hd * 96; return hd * 96 + (p < 64 ? p : 64 + ropeperm32(p - 64)); }
  return n;
}
struct ConvJob { const float* W; const float* g; bf16_t* Wt; int Nsrc, K, kind, tn, tk; };
DI bool conv_decode(const Params& p, int job, ConvJob& j) {
  constexpr int NT0 = 40 * 16, NT1 = 64 * 16, NT2 = 12 * 6, NT3 = 16 * 4, NT4 = 16 * 16;
  constexpr int PER_I = NT0 + NT1 + NT2 + NT3 + 2 * NT4;
  if (job >= 2 * PER_I) return false;
  unsigned char* ws = p.ws;
  const int i = job / PER_I; int t = job - i * PER_I;
  j.g = nullptr;
  if (t < NT0) { j.W = p.ev_w_in + (size_t)i * 1024 * 2464; j.Nsrc = 2464; j.K = 1024; j.Wt = (bf16_t*)(ws + WS_WEVIN + i * SZ_WEVIN); j.kind = 0; j.tn = t / 16; j.tk = t % 16; return true; }
  t -= NT0;
  if (t < NT1) { j.W = p.od_w_in + (size_t)i * 1024 * 4104; j.Nsrc = 4104; j.K = 1024; j.Wt = (bf16_t*)(ws + WS_WODIN + i * SZ_WODIN); j.kind = 1; j.tn = t / 16; j.tk = t % 16; return true; }
  t -= NT1;
  if (t < NT2) { j.W = p.ev_w_uq + (size_t)i * 384 * 768; j.Nsrc = 768; j.K = 384; j.Wt = (bf16_t*)(ws + WS_WUQ + i * SZ_WUQ); j.kind = 2; j.g = p.ev_q_norm + i * 384; j.tn = t / 6; j.tk = t % 6; return true; }
  t -= NT2;
  if (t < NT3) { j.W = p.ev_w_ukv + (size_t)i * 256 * 1024; j.Nsrc = 1024; j.K = 256; j.Wt = (bf16_t*)(ws + WS_WUKV + i * SZ_WUKV); j.kind = 3; j.g = p.ev_kv_norm + i * 256; j.tn = t / 4; j.tk = t % 4; return true; }
  t -= NT3;
  if (t < NT4) { j.W = p.ev_w_out + (size_t)i * 1024 * 1024; j.Nsrc = 1024; j.K = 1024; j.Wt = (bf16_t*)(ws + WS_WEVOUT + i * SZ_WOUT); j.kind = 4; j.tn = t / 16; j.tk = t % 16; return true; }
  t -= NT4;
  j.W = p.od_w_out + (size_t)i * 1024 * 1024; j.Nsrc = 1024; j.K = 1024; j.Wt = (bf16_t*)(ws + WS_WODOUT + i * SZ_WOUT); j.kind = 4; j.tn = t / 16; j.tk = t % 16; return true;
}
template <int NJ>
DI void convert_tiles(const Params& p, LAS unsigned char* lds, int job0, int jstride) {
  const int tid = opaque_tid();
  const int nl = tid & 63, ks = tid >> 6;
  ConvJob j[NJ] = {}; bool ok[NJ]; float v[NJ][8];
#pragma unroll
  for (int q = 0; q < NJ; ++q) {
    ok[q] = conv_decode(p, job0 + q * jstride, j[q]);
    const int sc = ok[q] ? srccol(j[q].kind, j[q].tn * 64 + nl) : -1;
#pragma unroll
    for (int e = 0; e < 8; ++e) {
      const int k = j[q].tk * 64 + ks + 8 * e;
      v[q][e] = 0.f;
      if (sc >= 0) { v[q][e] = j[q].W[(size_t)k * j[q].Nsrc + sc]; if (j[q].g) v[q][e] *= j[q].g[k]; }
    }
  }
#pragma unroll
  for (int q = 0; q < NJ; ++q) {
    LAS bf16_t* tile = (LAS bf16_t*)(lds + q * 9216);
#pragma unroll
    for (int e = 0; e < 8; ++e) tile[nl * 72 + ks + 8 * e] = f2bf(v[q][e]);
  }
  __syncthreads();
#pragma unroll
  for (int q = 0; q < NJ; ++q) {
    if (ok[q]) {
      LAS bf16_t* tile = (LAS bf16_t*)(lds + q * 9216);
      const int n2 = tid >> 3, ch = tid & 7;
      const u32x4 w = *(const LAS u32x4*)(tile + n2 * 72 + ch * 8);
      *(u32x4*)(j[q].Wt + (size_t)(j[q].tn * 64 + n2) * j[q].K + j[q].tk * 64 + ch * 8) = w;
    }
  }
  __syncthreads();
}

DI void prologue(const Params& p, LAS unsigned char* lds) {
  const int tid = opaque_tid(), G = gridDim.x, bid = blockIdx.x;
  unsigned char* ws = p.ws;
  for (int idx = bid * 512 + tid; idx < 2048 * 48; idx += G * 512) {
    const bool isH = idx < 2048 * 32;
    const int j = isH ? idx : idx - 2048 * 32;
    const int pos = isH ? (j >> 5) : (j >> 4), i = isH ? (j & 31) : (j & 15);
    const float e = isH ? (float)(2 * i) * (1.f / 64.f) : (float)(2 * i) * (1.f / 32.f);
    const float inv = fast_exp2(-e * 13.287712379549449f);
    const float ang = (float)pos * inv;
    double t = (double)ang * 0.15915494309189535; t -= rint(t);
    const float fr = (float)t;
    const float cv = __builtin_amdgcn_cosf(fr), sv = __builtin_amdgcn_sinf(fr);
    if (isH) { ((float*)(ws + WS_COSH))[j] = cv; ((float*)(ws + WS_SINH))[j] = sv; }
    else { ((float*)(ws + WS_COSR))[j] = cv; ((float*)(ws + WS_SINR))[j] = sv; }
  }
  for (int job = bid; job < 4624; job += 4 * G) convert_tiles<4>(p, lds, job, G);
  const int item0 = G - 1 - bid;
  if (item0 < 192) {
    LAS float* cond = (LAS float*)lds;
    LAS float* red = (LAS float*)(lds + 65536);
    for (int e = tid; e < 16 * 1024; e += 512) { const int b = e >> 10, k = e & 1023; cond[k * 16 + b] = silu_f(p.c[e]); }
    __syncthreads();
    for (int item = item0; item < 192; item += G) {
      const int l = item / 48, n0 = (item % 48) * 64;
      const int col = tid & 63, kg = tid >> 6;
      float a[16];
#pragma unroll
      for (int b = 0; b < 16; ++b) a[b] = 0.f;
      const float* wp = p.w_ada + (size_t)l * 1024 * 3072 + n0 + col;
      for (int k0 = kg * 128; k0 < kg * 128 + 128; k0 += 16) {
        float wv[16];
#pragma unroll
        for (int e = 0; e < 16; ++e) wv[e] = wp[(size_t)(k0 + e) * 3072];
#pragma unroll
        for (int e = 0; e < 16; ++e) {
          const float w = wv[e]; const int k = k0 + e;
#pragma unroll
          for (int b4 = 0; b4 < 4; ++b4) { const f32x4 cv = *(const LAS f32x4*)(cond + k * 16 + b4 * 4);
            a[b4 * 4 + 0] += cv[0] * w; a[b4 * 4 + 1] += cv[1] * w; a[b4 * 4 + 2] += cv[2] * w; a[b4 * 4 + 3] += cv[3] * w; }
        }
      }
#pragma unroll
      for (int b = 0; b < 16; ++b) red[(kg * 16 + b) * 64 + col] = a[b];
      __syncthreads();
      for (int e = tid; e < 1024; e += 512) { const int b = e >> 6, cc = e & 63; float s = 0.f;
#pragma unroll
        for (int k8 = 0; k8 < 8; ++k8) s += red[(k8 * 16 + b) * 64 + cc];
        ((float*)(ws + WS_MOD))[((size_t)l * 16 + b) * 3072 + n0 + cc] = s + p.b_ada[l * 3072 + n0 + cc]; }
      __syncthreads();
    }
  }
}

DI void rowwise_phase(const Params& p, LAS unsigned char* lds, int lp, int ln) {
  const int tid = opaque_tid(), lane = tid & 63, wid = tid >> 6;
  const int gw = blockIdx.x * 8 + wid, nw = gridDim.x * 8;
  unsigned char* ws = p.ws;
  const float* mod = (const float*)(ws + WS_MOD);
  const bf16_t* ybuf = (const bf16_t*)(ws + WS_HBUF);
  bf16_t* hbuf = (bf16_t*)(ws + WS_HBUF);
  const bool ff = (ln < 4) && (ln & 1);
  LAS f32x4* wl = (LAS f32x4*)lds;
  if (ff) {
    const float* w = p.od_w_in + (size_t)(ln >> 1) * 1024 * 4104 + 3072;
    for (int c = tid; c < 1024; c += 512) {
      const f32x4 w0 = *(const f32x4*)(w + (size_t)c * 4104), w1 = *(const f32x4*)(w + (size_t)c * 4104 + 4);
      const int ln_ = (c & 255) >> 2, e = c & 3, j = c >> 8;
      wl[(j * 4 + e) * 64 + ln_] = w0; wl[1024 + (j * 4 + e) * 64 + ln_] = w1;
    }
    __syncthreads();
  }
  for (int row = gw; row < T; row += nw) {
    const int b = row >> 11;
    f32x4 xv[4];
    bf16_t* xbf = (bf16_t*)(ws + WS_XBF) + (size_t)row * DM;
    if (lp <= 0) {
      const float* xin = p.x + (size_t)row * DM;
#pragma unroll
      for (int j = 0; j < 4; ++j) xv[j] = *(const f32x4*)(xin + 4 * lane + 256 * j);
    } else {
#pragma unroll
      for (int j = 0; j < 4; ++j) { const u32x2 u = *(const u32x2*)(xbf + 4 * lane + 256 * j); xv[j] = (f32x4){bflo(u.x), bfhi(u.x), bflo(u.y), bfhi(u.y)}; }
    }
    if (lp >= 0) {
      f32x4 yv[4]; float ss = 0.f;
#pragma unroll
      for (int j = 0; j < 4; ++j) { const u32x2 u = *(const u32x2*)(ybuf + (size_t)row * DM + 4 * lane + 256 * j);
        yv[j] = (f32x4){bflo(u.x), bfhi(u.x), bflo(u.y), bfhi(u.y)}; ss += yv[j][0] * yv[j][0] + yv[j][1] * yv[j][1] + yv[j][2] * yv[j][2] + yv[j][3] * yv[j][3]; }
      ss = wave_sum(ss);
      const float rs = rsqrtf(ss * (1.f / DM) + EPS);
#pragma unroll
      for (int j = 0; j < 4; ++j) {
        const int c = 4 * lane + 256 * j;
        const f32x4 gt = *(const f32x4*)(mod + ((size_t)lp * 16 + b) * 3072 + 2048 + c);
        const f32x4 gp = *(const f32x4*)(p.g_post + lp * DM + c);
        xv[j] = xv[j] + gt * (yv[j] * rs * gp);
        if (ln >= 4) *(f32x4*)(p.out + (size_t)row * DM + c) = xv[j];
        else { u32x2 w; w.x = pk2(xv[j][0], xv[j][1]); w.y = pk2(xv[j][2], xv[j][3]); *(u32x2*)(xbf + c) = w; }
      }
    }
    if (ln < 4) {
      float ss = 0.f;
#pragma unroll
      for (int j = 0; j < 4; ++j) ss += xv[j][0] * xv[j][0] + xv[j][1] * xv[j][1] + xv[j][2] * xv[j][2] + xv[j][3] * xv[j][3];
      ss = wave_sum(ss);
      const float rs = rsqrtf(ss * (1.f / DM) + EPS);
      float zf[8];
#pragma unroll
      for (int h = 0; h < 8; ++h) zf[h] = 0.f;
#pragma unroll
      for (int j = 0; j < 4; ++j) {
        const int c = 4 * lane + 256 * j;
        const f32x4 sh = *(const f32x4*)(mod + ((size_t)ln * 16 + b) * 3072 + c);
        const f32x4 sc = *(const f32x4*)(mod + ((size_t)ln * 16 + b) * 3072 + 1024 + c);
        const f32x4 gp = *(const f32x4*)(p.g_pre + ln * DM + c);
        const f32x4 hv = (xv[j] * rs * gp) * (sc + 1.f) + sh;
        u32x2 w; w.x = pk2(hv[0], hv[1]); w.y = pk2(hv[2], hv[3]);
        *(u32x2*)(hbuf + (size_t)row * DM + c) = w;
        if (ff) {
#pragma unroll
          for (int e = 0; e < 4; ++e) {
            const f32x4 w0 = wl[(j * 4 + e) * 64 + lane], w1 = wl[1024 + (j * 4 + e) * 64 + lane];
            zf[0] += hv[e] * w0[0]; zf[1] += hv[e] * w0[1]; zf[2] += hv[e] * w0[2]; zf[3] += hv[e] * w0[3];
            zf[4] += hv[e] * w1[0]; zf[5] += hv[e] * w1[1]; zf[6] += hv[e] * w1[2]; zf[7] += hv[e] * w1[3];
          }
        }
      }
      if (ff) {
        const bool b5 = lane & 32, b4 = lane & 16, b3 = lane & 8;
        float w4[4], u2[2], t;
#pragma unroll
        for (int k = 0; k < 4; ++k) { const float send = b5 ? zf[k] : zf[4 + k], keep = b5 ? zf[4 + k] : zf[k]; w4[k] = keep + __shfl_xor(send, 32); }
#pragma unroll
        for (int k = 0; k < 2; ++k) { const float send = b4 ? w4[k] : w4[2 + k], keep = b4 ? w4[2 + k] : w4[k]; u2[k] = keep + __shfl_xor(send, 16); }
        { const float send = b3 ? u2[0] : u2[1], keep = b3 ? u2[1] : u2[0]; t = keep + __shfl_xor(send, 8); }
        t += __shfl_xor(t, 4); t += __shfl_xor(t, 2); t += __shfl_xor(t, 1);
        if ((lane & 7) == 0) {
          const int h = lane >> 3;
          const float z = t + p.od_forget_bias[(ln >> 1) * 8 + h];
          const float ls = fminf(z, 0.f) - __builtin_amdgcn_logf(1.f + fast_exp2(-fabsf(z) * LOG2E)) * 0.6931471805599453f;
          ((float*)(ws + WS_LOGF))[(size_t)row * 8 + h] = ls;
        }
      }
    }
  }
  __syncthreads();
}

DI void fox_scan(const Params& p, LAS unsigned char* lds, int bh) {
  const int tid = opaque_tid();
  const int b = bh >> 3, h = bh & 7;
  const float* logf_ = (const float*)(p.ws + WS_LOGF);
  float* fcum = (float*)(p.ws + WS_FCUM) + (size_t)bh * SEQ;
  LAS float* s = (LAS float*)lds;
  float v[4];
#pragma unroll
  for (int j = 0; j < 4; ++j) v[j] = logf_[((size_t)b * SEQ + 4 * tid + j) * 8 + h];
  v[1] += v[0]; v[2] += v[1]; v[3] += v[2];
  s[tid] = v[3];
  __syncthreads();
  for (int off = 1; off < 512; off <<= 1) {
    float t = 0.f;
    if (tid >= off) t = s[tid - off];
    __syncthreads();
    s[tid] += t;
    __syncthreads();
  }
  const float excl = s[tid] - v[3];
#pragma unroll
  for (int j = 0; j < 4; ++j) fcum[4 * tid + j] = -8.0f * (excl + v[j]);
  __syncthreads();
}

struct AttnArgs { const bf16_t *q, *k, *k2, *v, *gate; bf16_t* out; const float* fcum; int ldq, ldk, ldk2, ldv, ldo, ldg; float sl2, sink; };

DI float half_max(float x) {
  const unsigned u = __float_as_uint(x);
  auto r = __builtin_amdgcn_permlane32_swap(u, u, false, false);
  return fmaxf(__uint_as_float(r[0]), __uint_as_float(r[1]));
}
DI float half_sum(float x) {
  const unsigned u = __float_as_uint(x);
  auto r = __builtin_amdgcn_permlane32_swap(u, u, false, false);
  return __uint_as_float(r[0]) + __uint_as_float(r[1]);
}

template <int N> DI void wait_vmcnt() { asm volatile("s_waitcnt vmcnt(%0)" ::"n"(N) : "memory"); }
DI void raw_barrier() { asm volatile("" ::: "memory"); __builtin_amdgcn_s_barrier(); asm volatile("" ::: "memory"); }

template <int DQK, int DV, int MODE>
DI void attn_item(LAS unsigned char* lds, const AttnArgs& a, int qb) {
  constexpr int KSTR = DQK * 2 + 16, VSTR = (DV == 64) ? 192 : 320;
  constexpr int KG16 = KSTR / 16, VG16 = VSTR / 16;
  constexpr int KCH = KG16, VCH = VG16, NCH = KCH + VCH;
  constexpr int TILE = NCH * 1024 + (MODE == 2 ? 2048 : 0);
  constexpr int NSLOT = (NCH + 7) / 8, REM = NCH - 8 * (NSLOT - 1);
  constexpr int FX = (MODE == 2) ? 1 : 0;
  constexpr int NKS = DQK / 16, NBLK = DV / 32;
  static_assert(5 * TILE <= 155648, "ring too large");
  const int tid = opaque_tid(), wid = __builtin_amdgcn_readfirstlane(tid >> 6), lane = tid & 63, r = lane & 31, hh = lane >> 5;
  const int q0 = qb * 256, qw = q0 + 32 * wid, myq = qw + r;
  const float c = a.sl2, tau = 8.0f / a.sl2;
  bf16x8 qf[NKS];
#pragma unroll
  for (int ks = 0; ks < NKS; ++ks) qf[ks] = *(const bf16x8*)(a.q + (size_t)myq * a.ldq + 16 * ks + 8 * hh);
  int lo = 0; const int hi = 4 * (qb + 1);
  if (MODE == 1) { lo = 4 * qb - 2; if (lo < 0) lo = 0; }
  const int last_w = (qw + 31) >> 6;
  int first_w = 0;
  if (MODE == 1) { first_w = (qw > 127 ? qw - 127 : 0) >> 6; }
  const char* sp[NSLOT]; unsigned sst[NSLOT];
#pragma unroll
  for (int j = 0; j < NSLOT; ++j) {
    const int ch_ = 8 * j + wid;
    if (ch_ < KCH) {
      const int p = ch_ * 64 + lane, row = p / KG16, g = p - row * KG16;
      if (DQK == 96 && g >= 8 && g < 12) { sp[j] = (const char*)(a.k2 + (size_t)row * a.ldk2 + 8 * (g - 8)); sst[j] = (unsigned)(128 * a.ldk2); }
      else { sp[j] = (const char*)(a.k + (size_t)row * a.ldk + 8 * (g < 8 ? g : 0)); sst[j] = (unsigned)(128 * a.ldk); }
    } else {
      const int p = (ch_ - KCH) * 64 + lane, row = (p / VG16) & 63, g = p - (p / VG16) * VG16;
      sp[j] = (const char*)(a.v + (size_t)row * a.ldv + 8 * (g < DV / 8 ? g : 0)); sst[j] = (unsigned)(128 * a.ldv);
    }
  }
  auto issue = [&](int kt) {
    LAS unsigned char* base = lds + (kt % 4) * TILE;
#pragma unroll
    for (int j = 0; j < NSLOT; ++j) {
      if (j < NSLOT - 1 || wid < REM)
        __builtin_amdgcn_global_load_lds((const unsigned*)(sp[j] + (size_t)kt * sst[j]), (LAS unsigned*)(base + (8 * j + wid) * 1024), 16, 0, 0);
    }
    if (MODE == 2) __builtin_amdgcn_global_load_lds((const unsigned*)(a.fcum + kt * 64 + lane), (LAS unsigned*)(base + NCH * 1024 + wid * 256), 4, 0, 0);
  };
  auto wait_tiles = [&](bool all) {
    if (all) wait_vmcnt<0>();
    else if (wid < REM) wait_vmcnt<NSLOT + FX>();
    else wait_vmcnt<NSLOT - 1 + FX>();
  };
  f32x16 O[NBLK];
#pragma unroll
  for (int bl = 0; bl < NBLK; ++bl)
#pragma unroll
    for (int i = 0; i < 16; ++i) O[bl][i] = 0.f;
  float m = (MODE == 1) ? a.sink / a.sl2 : -1e30f;
  float l0 = (MODE == 1 && hh == 0) ? 1.f : 0.f, l1 = 0.f;
  const int i16 = lane & 15, q4 = i16 >> 2, p4 = i16 & 3, grp = (lane >> 4) & 1;
  auto qk_load = [&](int kt, bf16x8 (&kf)[2][NKS]) {
    LAS unsigned char* Kl = lds + (kt % 4) * TILE;
#pragma unroll
    for (int kb = 0; kb < 2; ++kb)
#pragma unroll
      for (int ks = 0; ks < NKS; ++ks) kf[kb][ks] = *(const LAS bf16x8*)(Kl + (32 * kb + r) * KSTR + (16 * ks + 8 * hh) * 2);
  };
  auto qk_mma = [&](int kt, const bf16x8 (&kf)[2][NKS], f32x16 (&s)[2]) {
#pragma unroll
    for (int kb = 0; kb < 2; ++kb) {
      if (MODE == 2) {
        LAS unsigned char* Fl = lds + (kt % 4) * TILE + NCH * 1024 + wid * 256;
#pragma unroll
        for (int g = 0; g < 4; ++g) { const f32x4 fb = *(const LAS f32x4*)(Fl + (32 * kb + 8 * g + 4 * hh) * 4);
          s[kb][4 * g] = fb[0]; s[kb][4 * g + 1] = fb[1]; s[kb][4 * g + 2] = fb[2]; s[kb][4 * g + 3] = fb[3]; }
      } else {
#pragma unroll
        for (int i = 0; i < 16; ++i) s[kb][i] = 0.f;
      }
    }
#pragma unroll
    for (int ks = 0; ks < NKS; ++ks)
#pragma unroll
      for (int kb = 0; kb < 2; ++kb) s[kb] = __builtin_amdgcn_mfma_f32_32x32x16_bf16(kf[kb][ks], qf[ks], s[kb], 0, 0, 0);
  };
  auto softmax = [&](int kt, f32x16 (&s)[2], bf16x8 (&pf)[2][2], auto maskc) {
    constexpr bool MASK = decltype(maskc)::value;
    const int key0 = kt * 64;
    if (MASK) {
#pragma unroll
      for (int kb = 0; kb < 2; ++kb)
#pragma unroll
        for (int i = 0; i < 16; ++i) {
          const int key = key0 + 32 * kb + (i & 3) + 8 * (i >> 2) + 4 * hh;
          bool valid = key <= myq; if (MODE == 1) valid = valid && (myq - key < 128);
          s[kb][i] = valid ? s[kb][i] : -1e30f;
        }
    }
    float mx = fmaxf(s[0][0], s[1][0]);
#pragma unroll
    for (int i = 1; i < 16; ++i) mx = fmaxf(fmaxf(mx, s[0][i]), s[1][i]);
    mx = half_max(mx);
    if (__builtin_amdgcn_ballot_w64(mx > m + tau) != 0ull) {
      const float mnew = fmaxf(m, mx);
      const float alpha = fast_exp2((m - mnew) * c);
      m = mnew;
      l0 *= alpha; l1 *= alpha;
#pragma unroll
      for (int bl = 0; bl < NBLK; ++bl)
#pragma unroll
        for (int i = 0; i < 16; ++i) O[bl][i] *= alpha;
    }
    const float nmc = -m * c;
#pragma unroll
    for (int kb = 0; kb < 2; ++kb)
#pragma unroll
      for (int s2 = 0; s2 < 2; ++s2) {
        float pv[8];
#pragma unroll
        for (int e = 0; e < 8; ++e) pv[e] = fast_exp2(__builtin_fmaf(s[kb][8 * s2 + e], c, nmc));
        l0 += (pv[0] + pv[4]) + (pv[2] + pv[6]); l1 += (pv[1] + pv[5]) + (pv[3] + pv[7]);
        u32x4 w;
        w.x = pk2(pv[0], pv[1]); w.y = pk2(pv[2], pv[3]); w.z = pk2(pv[4], pv[5]); w.w = pk2(pv[6], pv[7]);
        pf[kb][s2] = __builtin_bit_cast(bf16x8, w);
      }
  };
  auto pvmm = [&](int kt, const bf16x8 (&pf)[2][2]) {
    constexpr int PD = (NBLK == 2) ? 2 : 1;
    const unsigned va = (unsigned)(size_t)(lds + (kt % 4) * TILE + KCH * 1024 + (4 * hh + q4) * VSTR + (16 * grp) * 2 + 8 * p4);
    s16x4 vl[PD + 1][NBLK], vh[PD + 1][NBLK];
#define TRRD(dst, off) asm volatile("ds_read_b64_tr_b16 %0, %1 offset:%2" : "=&v"(dst) : "v"(va), "n"(off) : "memory")
#define TRSTEP(st_) do { _Pragma("unroll") for (int bl = 0; bl < NBLK; ++bl) { TRRD(vl[(st_) % (PD + 1)][bl], 16 * (st_) * VSTR + 64 * bl); TRRD(vh[(st_) % (PD + 1)][bl], 16 * (st_) * VSTR + 64 * bl + 8 * VSTR); } } while (0)
#define TRWAIT(n_, b_) do { if (NBLK == 2) asm volatile("s_waitcnt lgkmcnt(" #n_ ")" : "+v"(vl[b_][0]), "+v"(vh[b_][0]), "+v"(vl[b_][1]), "+v"(vh[b_][1])::"memory"); \
    else asm volatile("s_waitcnt lgkmcnt(" #n_ ")" : "+v"(vl[b_][0]), "+v"(vh[b_][0]), "+v"(vl[b_][1]), "+v"(vh[b_][1]), "+v"(vl[b_][2 % NBLK]), "+v"(vh[b_][2 % NBLK]), "+v"(vl[b_][3 % NBLK]), "+v"(vh[b_][3 % NBLK])::"memory"); } while (0)
#pragma unroll
    for (int st = 0; st < PD; ++st) TRSTEP(st);
#pragma unroll
    for (int st = 0; st < 4; ++st) {
      if (st + PD < 4) TRSTEP(st + PD);
      const int ahead = ((st + PD < 4) ? st + PD : 3) - st;
      const int b_ = st % (PD + 1);
      if (ahead * 2 * NBLK == 8) TRWAIT(8, b_); else if (ahead * 2 * NBLK == 4) TRWAIT(4, b_); else TRWAIT(0, b_);
#pragma unroll
      for (int bl = 0; bl < NBLK; ++bl) {
        const bf16x8 vf = __builtin_shufflevector(vl[b_][bl], vh[b_][bl], 0, 1, 2, 3, 4, 5, 6, 7);
        O[bl] = __builtin_amdgcn_mfma_f32_32x32x16_bf16(vf, pf[st >> 1][st & 1], O[bl], 0, 0, 0);
      }
    }
#undef TRRD
#undef TRSTEP
#undef TRWAIT
  };
  auto act = [&](int kt) { return kt <= last_w && kt >= first_w; };
  f32x16 sA[2];
  const bool halfB = wid >= 4;
  issue(lo);
  if (lo + 1 < hi) issue(lo + 1);
  if (lo + 2 < hi) issue(lo + 2);
  wait_tiles(true);
  raw_barrier();
  if (halfB) raw_barrier();
  if (act(lo)) { bf16x8 kf0[2][NKS]; qk_load(lo, kf0); qk_mma(lo, kf0, sA); }
  auto step = [&](int kt, auto maskc) {
    const bool a0 = act(kt), a1 = (kt + 1 < hi) && act(kt + 1);
    bf16x8 pf[2][2], kf[2][NKS];
    if (a0) softmax(kt, sA, pf, maskc);
    wait_tiles(true);
    raw_barrier();
    if (a1) qk_load(kt + 1, kf);
    __builtin_amdgcn_s_setprio(1);
    if (a1) qk_mma(kt + 1, kf, sA);
    if (a0) pvmm(kt, pf);
    __builtin_amdgcn_s_setprio(0);
    if (kt + 3 < hi) issue(kt + 3);
    raw_barrier();
  };
  int split = lo;
  if (MODE != 1) { split = qw >> 6; if (split < lo) split = lo; if (split > hi) split = hi; }
  if (MODE != 1) { for (int kt = lo; kt < split; ++kt) step(kt, std::false_type{}); }
  for (int kt = split; kt < hi; ++kt) step(kt, std::true_type{});
  if (!halfB) raw_barrier();
  const float l = half_sum(l0 + l1);
  const float inv = 1.f / l;
#pragma unroll
  for (int bl = 0; bl < NBLK; ++bl)
#pragma unroll
    for (int g = 0; g < 4; ++g) {
      const int f = 32 * bl + 8 * g + 4 * hh;
      float o0 = O[bl][4 * g + 0] * inv, o1 = O[bl][4 * g + 1] * inv, o2 = O[bl][4 * g + 2] * inv, o3 = O[bl][4 * g + 3] * inv;
      if (a.gate) {
        const u32x2 gv = *(const u32x2*)(a.gate + (size_t)myq * a.ldg + f);
        o0 *= silu_f(bflo(gv.x)); o1 *= silu_f(bfhi(gv.x)); o2 *= silu_f(bflo(gv.y)); o3 *= silu_f(bfhi(gv.y));
      }
      u32x2 w; w.x = pk2(o0, o1); w.y = pk2(o2, o3);
      *(u32x2*)(a.out + (size_t)myq * a.ldo + f) = w;
    }
}


DI void swa_item(LAS unsigned char* lds, const AttnArgs& a, const float* sinks4, int qb) {
  constexpr int KSTR = 144, VSTR = 192, KCH = 9, VCH = 12, NCH = 21, TILE = NCH * 1024, NSLOT = 3, REM = 5, NKS = 4, NBLK = 2;
  const int tid = opaque_tid(), wid = __builtin_amdgcn_readfirstlane(tid >> 6), lane = tid & 63, r = lane & 31, hh = lane >> 5;
  const int q0 = qb * 256, qw = q0 + 32 * wid, myq = qw + r;
  const float c = a.sl2, tau = 8.0f / a.sl2;
  int lo = 4 * qb - 2; if (lo < 0) lo = 0;
  const int hi = 4 * (qb + 1);
  const int last_w = (qw + 31) >> 6, first_w = (qw > 127 ? qw - 127 : 0) >> 6;
#pragma unroll
  for (int j = 0; j < NSLOT; ++j) {
    const int ch_ = 8 * j + wid;
    if (j < NSLOT - 1 || wid < REM) {
      const char* sp; unsigned sst;
      if (ch_ < KCH) { const int p = ch_ * 64 + lane, row = p / 9, g = p - row * 9;
        sp = (const char*)(a.k + (size_t)row * a.ldk + 8 * (g < 8 ? g : 0)); sst = (unsigned)(128 * a.ldk); }
      else { const int p = (ch_ - KCH) * 64 + lane, row = (p / 12) & 63, g = p - (p / 12) * 12;
        sp = (const char*)(a.v + (size_t)row * a.ldv + 8 * (g < 8 ? g : 0)); sst = (unsigned)(128 * a.ldv); }
      for (int kt = lo; kt < hi; ++kt)
        __builtin_amdgcn_global_load_lds((const unsigned*)(sp + (size_t)kt * sst), (LAS unsigned*)(lds + (kt - lo) * TILE + ch_ * 1024), 16, 0, 0);
    }
  }
  wait_vmcnt<0>();
  raw_barrier();
  const int i16 = lane & 15, q4 = i16 >> 2, p4 = i16 & 3, grp = (lane >> 4) & 1;
  for (int h4 = 0; h4 < 4; ++h4) {
    bf16x8 qf[NKS];
#pragma unroll
    for (int ks = 0; ks < NKS; ++ks) qf[ks] = *(const bf16x8*)(a.q + (size_t)myq * a.ldq + h4 * 64 + 16 * ks + 8 * hh);
    f32x16 O[NBLK];
#pragma unroll
    for (int bl = 0; bl < NBLK; ++bl)
#pragma unroll
      for (int i = 0; i < 16; ++i) O[bl][i] = 0.f;
    float m = sinks4[h4] / a.sl2;
    float l0 = (hh == 0) ? 1.f : 0.f, l1 = 0.f;
    for (int kt = first_w; kt <= last_w; ++kt) {
      LAS unsigned char* Kl = lds + (kt - lo) * TILE;
      f32x16 s[2];
      bf16x8 kf[2][NKS];
#pragma unroll
      for (int kb = 0; kb < 2; ++kb)
#pragma unroll
        for (int ks = 0; ks < NKS; ++ks) kf[kb][ks] = *(const LAS bf16x8*)(Kl + (32 * kb + r) * KSTR + (16 * ks + 8 * hh) * 2);
#pragma unroll
      for (int kb = 0; kb < 2; ++kb)
#pragma unroll
        for (int i = 0; i < 16; ++i) s[kb][i] = 0.f;
#pragma unroll
      for (int ks = 0; ks < NKS; ++ks)
#pragma unroll
        for (int kb = 0; kb < 2; ++kb) s[kb] = __builtin_amdgcn_mfma_f32_32x32x16_bf16(kf[kb][ks], qf[ks], s[kb], 0, 0, 0);
      const int key0 = kt * 64;
#pragma unroll
      for (int kb = 0; kb < 2; ++kb)
#pragma unroll
        for (int i = 0; i < 16; ++i) {
          const int key = key0 + 32 * kb + (i & 3) + 8 * (i >> 2) + 4 * hh;
          const bool valid = (key <= myq) && (myq - key < 128);
          s[kb][i] = valid ? s[kb][i] : -1e30f;
        }
      float mx = fmaxf(s[0][0], s[1][0]);
#pragma unroll
      for (int i = 1; i < 16; ++i) mx = fmaxf(fmaxf(mx, s[0][i]), s[1][i]);
      mx = half_max(mx);
      if (__builtin_amdgcn_ballot_w64(mx > m + tau) != 0ull) {
        const float mnew = fmaxf(m, mx);
        const float alpha = fast_exp2((m - mnew) * c);
        m = mnew; l0 *= alpha; l1 *= alpha;
#pragma unroll
        for (int bl = 0; bl < NBLK; ++bl)
#pragma unroll
          for (int i = 0; i < 16; ++i) O[bl][i] *= alpha;
      }
      const float nmc = -m * c;
      bf16x8 pf[2][2];
#pragma unroll
      for (int kb = 0; kb < 2; ++kb)
#pragma unroll
        for (int s2 = 0; s2 < 2; ++s2) {
          float pv[8];
#pragma unroll
          for (int e = 0; e < 8; ++e) pv[e] = fast_exp2(__builtin_fmaf(s[kb][8 * s2 + e], c, nmc));
          l0 += (pv[0] + pv[4]) + (pv[2] + pv[6]); l1 += (pv[1] + pv[5]) + (pv[3] + pv[7]);
          u32x4 w;
          w.x = pk2(pv[0], pv[1]); w.y = pk2(pv[2], pv[3]); w.z = pk2(pv[4], pv[5]); w.w = pk2(pv[6], pv[7]);
          pf[kb][s2] = __builtin_bit_cast(bf16x8, w);
        }
      LAS unsigned char* Vl = Kl + KCH * 1024 + (4 * hh + q4) * VSTR + (16 * grp) * 2 + 8 * p4;
#pragma unroll
      for (int st = 0; st < 4; ++st)
#pragma unroll
        for (int bl = 0; bl < NBLK; ++bl) {
          LAS unsigned char* ad = Vl + (16 * st) * VSTR + (32 * bl) * 2;
          const s16x4 lo_ = __builtin_amdgcn_ds_read_tr16_b64_v4i16((LAS s16x4*)ad);
          const s16x4 hi_ = __builtin_amdgcn_ds_read_tr16_b64_v4i16((LAS s16x4*)(ad + 8 * VSTR));
          const bf16x8 vf = __builtin_shufflevector(lo_, hi_, 0, 1, 2, 3, 4, 5, 6, 7);
          O[bl] = __builtin_amdgcn_mfma_f32_32x32x16_bf16(vf, pf[st >> 1][st & 1], O[bl], 0, 0, 0);
        }
    }
    const float l = half_sum(l0 + l1);
    const float inv = 1.f / l;
#pragma unroll
    for (int bl = 0; bl < NBLK; ++bl)
#pragma unroll
      for (int g = 0; g < 4; ++g) {
        const int f = h4 * 64 + 32 * bl + 8 * g + 4 * hh;
        float o0 = O[bl][4 * g + 0] * inv, o1 = O[bl][4 * g + 1] * inv, o2 = O[bl][4 * g + 2] * inv, o3 = O[bl][4 * g + 3] * inv;
        const u32x2 gv = *(const u32x2*)(a.gate + (size_t)myq * a.ldg + f);
        o0 *= silu_f(bflo(gv.x)); o1 *= silu_f(bfhi(gv.x)); o2 *= silu_f(bflo(gv.y)); o3 *= silu_f(bfhi(gv.y));
        u32x2 w; w.x = pk2(o0, o1); w.y = pk2(o2, o3);
        *(u32x2*)(a.out + (size_t)myq * a.ldo + f) = w;
      }
  }
  __syncthreads();
}

DI bool team_item(int G, int c, int n, int& bh, int& qb) {
  if (G == 256) {
    const int x = c & 7, li = c >> 3, t = li >> 3, i = li & 7;
    bh = x + 8 * (4 * t + n);
    const int j = (i + 4) & 7;
    qb = (n == 0) ? i : (n == 1) ? 7 - i : (n == 2) ? j : 7 - j;
    return true;
  }
  const int idx = n * G + ((n & 1) ? (G - 1 - c) : c);
  if (idx >= 1024) return false;
  qb = 7 - idx / 128; bh = idx % 128;
  return true;
}

DI int snake_idx(int round, int G, int c) { return round * G + ((round & 1) ? (G - 1 - c) : c); }

DI void attn_even(const Params& p, LAS unsigned char* lds, int i) {
  const int G = gridDim.x, c = blockIdx.x;
  unsigned char* ws = p.ws;
  const bf16_t* z = (const bf16_t*)(ws + WS_ZBUF);
  const bf16_t* qb_ = (const bf16_t*)(ws + WS_QBUF);
  const bf16_t* kv = (const bf16_t*)(ws + WS_HBUF);
  bf16_t* ob = (bf16_t*)(ws + WS_OBUF);
  for (int rd = 0; rd * G < 1024; ++rd) {
    int qb, bh;
    if (!team_item(G, c, rd, bh, qb)) continue;
    const int b = bh >> 3, hd = bh & 7;
    AttnArgs a;
    a.q = qb_ + (size_t)b * SEQ * 768 + hd * 96; a.ldq = 768;
    a.k = kv + (size_t)b * SEQ * 1024 + hd * 128; a.ldk = 1024;
    a.k2 = z + (size_t)b * SEQ * 2560 + 2432; a.ldk2 = 2560;
    a.v = kv + (size_t)b * SEQ * 1024 + hd * 128 + 64; a.ldv = 1024;
    a.out = ob + (size_t)b * SEQ * 1024 + hd * 64; a.ldo = 1024;
    a.gate = z + (size_t)b * SEQ * 2560 + 768 + hd * 64; a.ldg = 2560;
    a.fcum = nullptr; a.sl2 = 0.10206207261596577f * LOG2E; a.sink = 0.f;
    attn_item<96, 64, 0>(lds, a, qb);
  }
  for (int it = c; it < 256; it += G) {
    const int b = it >> 4, kvh = (it >> 3) & 1, qb = it & 7;
    AttnArgs a;
    const bf16_t* zb = z + (size_t)b * SEQ * 2560;
    a.q = zb + kvh * 256; a.ldq = 2560;
    a.k = zb + 512 + kvh * 64; a.ldk = 2560; a.k2 = nullptr; a.ldk2 = 0;
    a.v = zb + 640 + kvh * 64; a.ldv = 2560;
    a.out = ob + (size_t)b * SEQ * 1024 + 512 + kvh * 256; a.ldo = 1024;
    a.gate = zb + 768 + 512 + kvh * 256; a.ldg = 2560;
    a.fcum = nullptr; a.sl2 = 0.125f * LOG2E; a.sink = 0.f;
    float sk[4];
#pragma unroll
    for (int h4 = 0; h4 < 4; ++h4) sk[h4] = p.ev_sinks[i * 8 + kvh * 4 + h4] * LOG2E;
    swa_item(lds, a, sk, qb);
  }
}

DI void attn_odd(const Params& p, LAS unsigned char* lds, int layer) {
  const int G = gridDim.x, c = blockIdx.x;
  unsigned char* ws = p.ws;
  const bf16_t* z = (const bf16_t*)(ws + WS_ZBUF);
  bf16_t* od = (bf16_t*)(ws + WS_HBUF);
  bf16_t* ob = (bf16_t*)(ws + WS_OBUF);
  {
    for (int rd = 0; rd * G < 512; ++rd) {
      int qb, bh2;
      if (G == 256) { const int x = c & 7, li = c >> 3, t = li >> 3, i = li & 7; bh2 = x + 8 * (2 * t + rd); qb = (rd == 0) ? i : 7 - i; }
      else { const int idx = snake_idx(rd, G, c); if (idx >= 512) continue; qb = 7 - idx / 64; bh2 = idx % 64; }
      const int b = bh2 >> 2, h = bh2 & 3;
      const bf16_t* zb = z + (size_t)b * SEQ * 4096;
      for (int mp = 0; mp < 2; ++mp) {
        const int j = 2 * h + mp;
        AttnArgs a;
        a.q = zb + j * 64; a.ldq = 4096;
        a.k = zb + 512 + j * 64; a.ldk = 4096; a.k2 = nullptr; a.ldk2 = 0;
        a.v = zb + 1024 + h * 128; a.ldv = 4096;
        a.out = od + (size_t)b * SEQ * 1024 + j * 128; a.ldo = 1024;
        a.gate = nullptr; a.ldg = 0;
        a.fcum = nullptr; a.sl2 = 0.125f * LOG2E; a.sink = 0.f;
#ifndef SKIP_DIFF
        attn_item<64, 128, 0>(lds, a, qb);
#endif
      }
      __builtin_amdgcn_fence(__ATOMIC_SEQ_CST, "workgroup");
      asm volatile("s_waitcnt vmcnt(0)" ::: "memory");
      const int tid2 = opaque_tid(), lane = tid2 & 63, wid = tid2 >> 6, li_ = layer >> 1;
      const float* lp = p.od_lambda + li_ * 256;
      const float s1 = wave_sum(lp[lane] * lp[64 + lane]), s2 = wave_sum(lp[128 + lane] * lp[192 + lane]);
      const float lam_init = 0.8f - 0.6f * fast_exp2(-0.3f * LOG2E * (float)layer);
      const float lam = fast_exp2(s1 * LOG2E) - fast_exp2(s2 * LOG2E) + lam_init;
      const int rsub = lane >> 4, dv = (lane & 15) * 8;
      float sub[8];
#pragma unroll
      for (int e = 0; e < 8; ++e) sub[e] = p.od_subln[li_ * 128 + dv + e] * (1.f - lam_init);
      const size_t row0 = (size_t)b * SEQ + qb * 256 + 32 * wid;
#pragma unroll 2
      for (int rr = 0; rr < 8; ++rr) {
        const size_t row = row0 + 4 * rr + rsub;
        const u32x4 va = *(const u32x4*)(od + row * 1024 + (2 * h) * 128 + dv);
        const u32x4 vb = *(const u32x4*)(od + row * 1024 + (2 * h + 1) * 128 + dv);
        const u32x4 vg = *(const u32x4*)(z + row * 4096 + 3072 + h * 128 + dv);
        float d[8]; float ss = 0.f;
#pragma unroll
        for (int e = 0; e < 4; ++e) { d[2 * e] = bflo(va[e]) - lam * bflo(vb[e]); d[2 * e + 1] = bfhi(va[e]) - lam * bfhi(vb[e]); ss += d[2 * e] * d[2 * e] + d[2 * e + 1] * d[2 * e + 1]; }
        ss += __shfl_xor(ss, 1); ss += __shfl_xor(ss, 2); ss += __shfl_xor(ss, 4); ss += __shfl_xor(ss, 8);
        const float rs = rsqrtf(ss * (1.f / 128.f) + EPS);
        u32x4 w;
#pragma unroll
        for (int e = 0; e < 4; ++e) {
          const float o0 = d[2 * e] * rs * sub[2 * e] * silu_f(bflo(vg[e])), o1 = d[2 * e + 1] * rs * sub[2 * e + 1] * silu_f(bfhi(vg[e]));
          w[e] = pk2(o0, o1);
        }
        *(u32x4*)(ob + row * 1024 + h * 128 + dv) = w;
      }
    }
  }
  for (int rd = 0; rd * G < 1024; ++rd) {
    int qb, bh;
    if (!team_item(G, c, rd, bh, qb)) continue;
    const int b = bh >> 3, hd = bh & 7;
    AttnArgs a;
    const bf16_t* zb = z + (size_t)b * SEQ * 4096;
    a.q = zb + 1536 + hd * 64; a.ldq = 4096;
    a.k = zb + 2048 + hd * 64; a.ldk = 4096; a.k2 = nullptr; a.ldk2 = 0;
    a.v = zb + 2560 + hd * 64; a.ldv = 4096;
    a.out = ob + (size_t)b * SEQ * 1024 + 512 + hd * 64; a.ldo = 1024;
    a.gate = zb + 3072 + 512 + hd * 64; a.ldg = 4096;
    a.fcum = (const float*)(ws + WS_FCUM) + (size_t)bh * SEQ; a.sl2 = 0.125f * LOG2E; a.sink = 0.f;
#ifndef SKIP_FOX
    attn_item<64, 64, 2>(lds, a, qb);
#endif
  }
}

DI void diff_combine(const Params& p, int layer) {
  const int tid = opaque_tid(), lane = tid & 63, wid = tid >> 6;
  const int gw = blockIdx.x * 8 + wid, nw = gridDim.x * 8;
  const int i = layer >> 1;
  unsigned char* ws = p.ws;
  const bf16_t* od = (const bf16_t*)(ws + WS_HBUF);
  const bf16_t* z = (const bf16_t*)(ws + WS_ZBUF);
  bf16_t* ob = (bf16_t*)(ws + WS_OBUF);
  const float* lp = p.od_lambda + i * 256;
  const float s1 = wave_sum(lp[lane] * lp[64 + lane]), s2 = wave_sum(lp[128 + lane] * lp[192 + lane]);
  const float lam_init = 0.8f - 0.6f * expf(-0.3f * (float)layer);
  const float lam = expf(s1) - expf(s2) + lam_init;
  const int hd = lane >> 4, dv = (lane & 15) * 8;
  float sub[8];
#pragma unroll
  for (int e = 0; e < 8; ++e) sub[e] = p.od_subln[i * 128 + dv + e] * (1.f - lam_init);
  for (int row = gw; row < T; row += nw) {
    const u32x4 a = *(const u32x4*)(od + (size_t)row * 1024 + (2 * hd) * 128 + dv);
    const u32x4 b = *(const u32x4*)(od + (size_t)row * 1024 + (2 * hd + 1) * 128 + dv);
    const u32x4 g = *(const u32x4*)(z + (size_t)row * 4096 + 3072 + hd * 128 + dv);
    float d[8]; float ss = 0.f;
#pragma unroll
    for (int e = 0; e < 4; ++e) { d[2 * e] = bflo(a[e]) - lam * bflo(b[e]); d[2 * e + 1] = bfhi(a[e]) - lam * bfhi(b[e]); ss += d[2 * e] * d[2 * e] + d[2 * e + 1] * d[2 * e + 1]; }
    ss += __shfl_xor(ss, 1); ss += __shfl_xor(ss, 2); ss += __shfl_xor(ss, 4); ss += __shfl_xor(ss, 8);
    const float rs = rsqrtf(ss * (1.f / 128.f) + EPS);
    u32x4 w;
#pragma unroll
    for (int e = 0; e < 4; ++e) {
      const float o0 = d[2 * e] * rs * sub[2 * e] * silu_f(bflo(g[e])), o1 = d[2 * e + 1] * rs * sub[2 * e + 1] * silu_f(bfhi(g[e]));
      w[e] = pk2(o0, o1);
    }
    *(u32x4*)(ob + (size_t)row * 1024 + hd * 128 + dv) = w;
  }
}


DI void grid_barrier(unsigned* ctr, unsigned& epoch) {
  asm volatile("s_waitcnt vmcnt(0)" ::: "memory");
  __syncthreads();
  epoch += 1;
  if (threadIdx.x == 0) {
    __builtin_amdgcn_fence(__ATOMIC_RELEASE, "agent");
    asm volatile("s_waitcnt vmcnt(0)" ::: "memory");
    __hip_atomic_fetch_add(ctr, 1u, __ATOMIC_RELAXED, __HIP_MEMORY_SCOPE_AGENT);
    const unsigned target = epoch * gridDim.x;
    while (__hip_atomic_load(ctr, __ATOMIC_RELAXED, __HIP_MEMORY_SCOPE_AGENT) < target) __builtin_amdgcn_s_sleep(1);
    __builtin_amdgcn_fence(__ATOMIC_ACQUIRE, "agent");
    asm volatile("s_waitcnt vmcnt(0)" ::: "memory");
  }
  __syncthreads();
}


#define XB_TMO      128
#define XB_XCNT(j)  (256  + 64 * (j))
#define XB_XSUB(j)  (1280 + 64 * (j))
#define XB_XGEN(j)  (2304 + 64 * (j))
#define XB_TOP      3328
#define XB_TOPGEN   3392
#define XCD_BAR_WORDS 3456
#define XB_SPIN_CAP (1u << 20)
DI unsigned xb_ld(unsigned* p) { return __hip_atomic_load(p, __ATOMIC_RELAXED, __HIP_MEMORY_SCOPE_AGENT); }
DI unsigned xb_add(unsigned* p, unsigned v) { return __hip_atomic_fetch_add(p, v, __ATOMIC_RELAXED, __HIP_MEMORY_SCOPE_AGENT); }
DI unsigned xb_xcc_id() { return (unsigned)__builtin_amdgcn_s_getreg((3 << 11) | 20) & 0xFu; }
#define XB_SPIN(cond, bar) do { unsigned _sp = 0; while (cond) { __builtin_amdgcn_s_sleep(1); \
    if ((++_sp & 255u) == 0u) { if (xb_ld(&(bar)[XB_TMO])) break; if (_sp > XB_SPIN_CAP) { atomicAdd(&(bar)[XB_TMO], 1u); break; } } } } while (0)
struct XcdBarrier { unsigned* bar; unsigned x; volatile LAS unsigned* st; };
DI void xcd_barrier_complete(unsigned* bar, unsigned x, unsigned& nloc, unsigned& nx) {
  const unsigned G = gridDim.x;
  unsigned sum, cnt, mine, sp = 0u;
  for (;;) {
    sum = 0u; cnt = 0u; mine = 0u;
#pragma unroll
    for (unsigned j = 0; j < 16; ++j) { const unsigned c = xb_ld(&bar[XB_XCNT(j)]); sum += c; cnt += (c > 0u) ? 1u : 0u; mine = (j == x) ? c : mine; }
    if (sum == G) break;
    __builtin_amdgcn_s_sleep(1);
    if ((++sp & 255u) == 0u) { if (xb_ld(&bar[XB_TMO])) break; if (sp > XB_SPIN_CAP) { atomicAdd(&bar[XB_TMO], 1u); break; } }
  }
  nloc = mine > 0u ? mine : 1u; nx = cnt > 0u ? cnt : 1u;
}
DI void xcd_barrier(const XcdBarrier& b) {
  asm volatile("s_waitcnt vmcnt(0)" ::: "memory");
  __syncthreads();
  if (threadIdx.x == 0) {
    unsigned* bar = b.bar;
    __builtin_amdgcn_s_waitcnt(0);
    unsigned nloc = b.st[0], nx = b.st[1];
    if (nloc == 0u) { xcd_barrier_complete(bar, b.x, nloc, nx); b.st[0] = nloc; b.st[1] = nx; }
    const unsigned old = xb_add(&bar[XB_XSUB(b.x)], 1u);
    const unsigned gen = old / nloc;
    if (old + 1u == (gen + 1u) * nloc) {
      __builtin_amdgcn_fence(__ATOMIC_RELEASE, "agent");
      asm volatile("s_waitcnt vmcnt(0)" ::: "memory");
      const unsigned og = xb_add(&bar[XB_TOP], 1u);
      const unsigned tg = og / nx;
      if (og + 1u == (tg + 1u) * nx) xb_add(&bar[XB_TOPGEN], 1u);
      else XB_SPIN(xb_ld(&bar[XB_TOPGEN]) == tg, bar);
      __builtin_amdgcn_fence(__ATOMIC_ACQUIRE, "agent");
      xb_add(&bar[XB_XGEN(b.x)], 1u);
      asm volatile("s_waitcnt vmcnt(0)" ::: "memory");
    } else {
      XB_SPIN(xb_ld(&bar[XB_XGEN(b.x)]) == gen, bar);
      __builtin_amdgcn_fence(__ATOMIC_ACQUIRE, "agent");
      asm volatile("s_waitcnt vmcnt(0)" ::: "memory");
    }
  }
  __syncthreads();
}

__global__ void __launch_bounds__(512) fwd_megakernel(Params p) {
  extern __shared__ __attribute__((aligned(16))) unsigned char lds_raw[];
  LAS unsigned char* lds = (LAS unsigned char*)lds_raw;
  cg::grid_group grid = cg::this_grid();
  unsigned char* ws = p.ws;
  const int G = gridDim.x, bid = blockIdx.x;
  const float* cosH = (const float*)(ws + WS_COSH); const float* sinH = (const float*)(ws + WS_SINH);
  const float* cosR = (const float*)(ws + WS_COSR); const float* sinR = (const float*)(ws + WS_SINR);

  unsigned* xbar = (unsigned*)(ws + WS_XBAR);
  if (bid == 0) { for (int w = threadIdx.x; w < XCD_BAR_WORDS; w += 512) __hip_atomic_store(xbar + w, 0u, __ATOMIC_RELAXED, __HIP_MEMORY_SCOPE_AGENT); }
  volatile LAS unsigned* xst = (volatile LAS unsigned*)(lds + LDS_BYTES_C - 16);
  if (threadIdx.x == 0) { xst[0] = 0u; xst[1] = 0u; }
#ifndef SKIP_PRO
  prologue(p, lds);
#endif
  grid.sync();
  XcdBarrier xb; xb.bar = xbar; xb.x = xb_xcc_id(); xb.st = xst;
  if (threadIdx.x == 0) (void)xb_add(&xbar[XB_XCNT(xb.x)], 1u);
#pragma unroll
  for (int layer = 0; layer < 4; ++layer) {
    const int i = layer >> 1; const bool odd = layer & 1;
#ifndef SKIP_ROW
    rowwise_phase(p, lds, layer - 1, layer);
#endif
    xcd_barrier(xb);
    {
#ifndef SKIP_SCAN
      if (odd) { for (int bh = bid; bh < 128; bh += G) fox_scan(p, lds, bh); }
#endif
      pg8::Gemm g; g.A = (const bf16_t*)(ws + WS_HBUF); g.lda = 1024; g.K = 1024; g.M = T;
      Epi e; e.out = (bf16_t*)(ws + WS_ZBUF); e.pin = nullptr; e.pslot = 0; e.nK = 0; e.qmode = 0; e.pout = odd ? nullptr : (float*)(ws + WS_PART); e.cosH = cosH; e.sinH = sinH; e.cosR = cosR; e.sinR = sinR;
      if (!odd) { g.Bt = (const bf16_t*)(ws + WS_WEVIN + i * SZ_WEVIN); g.N = 2560; e.ldc = 2560; e.rope64_end = 640; e.rope32_lo = 2432; e.rope32_hi = 2464; }
      else { g.Bt = (const bf16_t*)(ws + WS_WODIN + i * SZ_WODIN); g.N = 4096; e.ldc = 4096; e.rope64_end = 1024; e.rope32_lo = 0; e.rope32_hi = 0; }
      pg8::StaticOrder S; S.init(g.M, g.N, G, bid);
#ifndef SKIP_G1
      pg8::gemm_phase<Epi>(lds, g, S, e);
#endif
    }
    xcd_barrier(xb);
    if (!odd) {
      for (int which = 0; which < 2; ++which) {
        pg8::Gemm g; g.M = T; g.lda = 2560;
        Epi e; e.rope64_end = 0; e.rope32_lo = 0; e.rope32_hi = 0; e.cosH = cosH; e.sinH = sinH; e.cosR = cosR; e.sinR = sinR; e.pout = nullptr; e.pin = (const float*)(ws + WS_PART);
        if (which == 0) { g.A = (const bf16_t*)(ws + WS_ZBUF) + 1792; g.Bt = (const bf16_t*)(ws + WS_WUQ + i * SZ_WUQ); g.N = 768; g.K = 384;
          e.out = (bf16_t*)(ws + WS_QBUF); e.ldc = 768; e.qmode = 1; e.pslot = 0; e.nK = 384; }
        else { g.A = (const bf16_t*)(ws + WS_ZBUF) + 2176; g.Bt = (const bf16_t*)(ws + WS_WUKV + i * SZ_WUKV); g.N = 1024; g.K = 256;
          e.out = (bf16_t*)(ws + WS_HBUF); e.ldc = 1024; e.qmode = 0; e.pslot = 12; e.nK = 256; }
        pg8::StaticOrder S; S.init(g.M, g.N, G, bid);
#ifndef SKIP_G2
        pg8::gemm_phase<Epi>(lds, g, S, e);
#endif
      }
      xcd_barrier(xb);
#ifndef SKIP_ATTE
      attn_even(p, lds, i);
#endif
      xcd_barrier(xb);
    } else {
#ifndef SKIP_ATTO
      attn_odd(p, lds, layer);
#endif
      xcd_barrier(xb);
    }
    {
      pg8::Gemm g; g.A = (const bf16_t*)(ws + WS_OBUF); g.lda = 1024; g.K = 1024; g.M = T; g.N = 1024;
      g.Bt = (const bf16_t*)(ws + (odd ? WS_WODOUT : WS_WEVOUT) + i * SZ_WOUT);
      Epi e; e.out = (bf16_t*)(ws + WS_HBUF); e.ldc = 1024; e.pin = nullptr; e.pslot = 0; e.pout = nullptr; e.nK = 0; e.qmode = 0; e.rope64_end = 0; e.rope32_lo = 0; e.rope32_hi = 0;
      e.cosH = cosH; e.sinH = sinH; e.cosR = cosR; e.sinR = sinR;
      pg8::StaticOrder S; S.init(g.M, g.N, G, bid);
#ifndef SKIP_G3
      pg8::gemm_phase<Epi>(lds, g, S, e);
#endif
    }
    xcd_barrier(xb);
  }
#ifndef SKIP_ROW
  rowwise_phase(p, lds, 3, 4);
#endif
}

constexpr int LDS_BYTES = 155648;
static_assert(LDS_BYTES == LDS_BYTES_C, "LDS size mismatch");

extern "C" void kernel_launch(void* const* d_in, const int* in_sizes, int n_in, void* d_out, int out_size, void* d_ws, size_t ws_size, hipStream_t stream) {
  static int grid_blocks = 0;
  if (grid_blocks == 0) {
    int dev = 0, cus = 0, per_cu = 0;
    if (hipGetDevice(&dev) != hipSuccess || hipDeviceGetAttribute(&cus, hipDeviceAttributeMultiprocessorCount, dev) != hipSuccess) { fprintf(stderr, "device query failed\n"); grid_blocks = -1; return; }
    if (hipFuncSetAttribute((const void*)fwd_megakernel, hipFuncAttributeMaxDynamicSharedMemorySize, LDS_BYTES) != hipSuccess) { fprintf(stderr, "hipFuncSetAttribute failed\n"); grid_blocks = -1; return; }
    if (hipOccupancyMaxActiveBlocksPerMultiprocessor(&per_cu, (const void*)fwd_megakernel, 512, LDS_BYTES) != hipSuccess || per_cu < 1) { fprintf(stderr, "occupancy query: %d\n", per_cu); per_cu = 1; }
    (void)hipGetLastError();
    grid_blocks = cus;
    if (ws_size < WS_END) { fprintf(stderr, "workspace too small: %zu < %zu\n", ws_size, (size_t)WS_END); grid_blocks = -1; return; }
  }
  if (grid_blocks < 0) return;
  Params p{};
  const float** fp = (const float**)&p;
  for (int i = 0; i < 18; ++i) fp[i] = (const float*)d_in[i];
  p.out = (float*)d_out; p.ws = (unsigned char*)d_ws;
  void* args[] = {&p};
  hipError_t e = hipLaunchCooperativeKernel((const void*)fwd_megakernel, dim3(grid_blocks), dim3(512), args, LDS_BYTES, stream);
  if (e != hipSuccess) fprintf(stderr, "cooperative launch failed: %s (grid %d)\n", hipGetErrorString(e), grid_blocks);
}
```

```cpp
#include <hip/hip_runtime.h>
#include <hip/hip_cooperative_groups.h>
#include <cstdio>
#include <type_traits>
namespace cg = cooperative_groups;

#define DI __device__ __forceinline__
#define LAS __attribute__((address_space(3)))
typedef unsigned short bf16_t;
typedef short bf16x8 __attribute__((ext_vector_type(8)));
typedef short s16x4 __attribute__((ext_vector_type(4)));
typedef float f32x2 __attribute__((ext_vector_type(2)));
typedef float f32x4 __attribute__((ext_vector_type(4)));
typedef float f32x16 __attribute__((ext_vector_type(16)));
typedef unsigned u32x2 __attribute__((ext_vector_type(2)));
typedef unsigned u32x4 __attribute__((ext_vector_type(4)));
typedef __bf16 bf16x2_t __attribute__((ext_vector_type(2)));

constexpr int T = 32768, DM = 1024, NB = 16, SEQ = 2048;
constexpr float LOG2E = 1.4426950408889634f;
constexpr float EPS = 1e-6f;
constexpr int LDS_BYTES_C = 155648;

constexpr size_t SZ_WEVIN = 2560ull * 1024 * 2, SZ_WODIN = 4096ull * 1024 * 2, SZ_WUQ = 768ull * 384 * 2, SZ_WUKV = 1024ull * 256 * 2, SZ_WOUT = 1024ull * 1024 * 2;
constexpr size_t WS_WEVIN = 0;
constexpr size_t WS_WODIN = WS_WEVIN + 2 * SZ_WEVIN;
constexpr size_t WS_WUQ = WS_WODIN + 2 * SZ_WODIN;
constexpr size_t WS_WUKV = WS_WUQ + 2 * SZ_WUQ;
constexpr size_t WS_WEVOUT = WS_WUKV + 2 * SZ_WUKV;
constexpr size_t WS_WODOUT = WS_WEVOUT + 2 * SZ_WOUT;
constexpr size_t WS_MOD = WS_WODOUT + 2 * SZ_WOUT;
constexpr size_t WS_COSH = WS_MOD + 4ull * 16 * 3072 * 4;
constexpr size_t WS_SINH = WS_COSH + 2048ull * 32 * 4;
constexpr size_t WS_COSR = WS_SINH + 2048ull * 32 * 4;
constexpr size_t WS_SINR = WS_COSR + 2048ull * 16 * 4;
constexpr size_t WS_LOGF = WS_SINR + 2048ull * 16 * 4;
constexpr size_t WS_FCUM = WS_LOGF + (size_t)T * 8 * 4;
constexpr size_t WS_HBUF = (WS_FCUM + (size_t)T * 8 * 4 + 4095) & ~(size_t)4095;
constexpr size_t WS_OBUF = WS_HBUF + (size_t)T * 1024 * 2;
constexpr size_t WS_ZBUF = WS_OBUF + (size_t)T * 1024 * 2;
constexpr size_t WS_QBUF = WS_ZBUF + (size_t)T * 2560 * 2;
constexpr size_t WS_BAR = WS_ZBUF + (size_t)T * 4096 * 2;
constexpr size_t WS_PART = WS_BAR + 256;
constexpr size_t WS_XBAR = (WS_PART + (size_t)T * 20 * 4 + 4095) & ~(size_t)4095;
constexpr size_t WS_XBF_PRE = WS_XBAR + 16384;
constexpr size_t WS_XBF = WS_XBF_PRE;
constexpr size_t WS_END = WS_XBF + (size_t)T * 1024 * 2;

struct Params {
  const float *x, *c, *w_ada, *b_ada, *g_pre, *g_post, *ev_w_in, *ev_q_norm, *ev_kv_norm, *ev_w_uq, *ev_w_ukv, *ev_sinks, *ev_w_out,
      *od_w_in, *od_forget_bias, *od_lambda, *od_subln, *od_w_out;
  float* out;
  unsigned char* ws;
};

DI int opaque_tid() { int t = threadIdx.x; asm volatile("" : "+v"(t)); return t; }
DI float bflo(unsigned u) { return __uint_as_float(u << 16); }
DI float bfhi(unsigned u) { return __uint_as_float(u & 0xffff0000u); }
DI unsigned pk2(float lo, float hi) { f32x2 f = {lo, hi}; bf16x2_t b = __builtin_convertvector(f, bf16x2_t); return __builtin_bit_cast(unsigned, b); }
DI bf16_t f2bf(float f) { return (bf16_t)(pk2(f, 0.f) & 0xffffu); }
DI float fast_exp2(float x) { return __builtin_amdgcn_exp2f(x); }
DI float silu_f(float x) { return x * __builtin_amdgcn_rcpf(1.f + fast_exp2(-x * LOG2E)); }
template <int CTRL> DI float dpp_mov(float v) { return __builtin_bit_cast(float, __builtin_amdgcn_update_dpp(0, __builtin_bit_cast(int, v), CTRL, 0xf, 0xf, false)); }
DI float wave_sum(float v) {
  v += dpp_mov<0xB1>(v);
  v += dpp_mov<0x4E>(v);
  v += dpp_mov<0x141>(v);
  v += dpp_mov<0x140>(v);
  { const unsigned u = __float_as_uint(v); auto r = __builtin_amdgcn_permlane16_swap(u, u, false, false); v = __uint_as_float(r[0]) + __uint_as_float(r[1]); }
  { const unsigned u = __float_as_uint(v); auto r = __builtin_amdgcn_permlane32_swap(u, u, false, false); v = __uint_as_float(r[0]) + __uint_as_float(r[1]); }
  return v;
}

namespace pg8 {
constexpr int BM = 256, BK = 64, HALF = 128, HTB = HALF * BK * 2, STAGE_BYTES = 8 * HTB, NXCD = 8, WGM = 8;
DI int lds_byte(int r, int c) { const int st = (r >> 4) * 2 + (c >> 5), rr = r & 15, cc = c & 31, ob = rr * 64 + cc * 2; return st * 1024 + (ob ^ (((ob >> 9) & 1) << 5)); }
DI void stage_rc(int b, int& R, int& C) { const int st = b / 1024, sb = b % 1024, swz = sb ^ (((sb >> 9) & 1) << 5); R = (st >> 1) * 16 + swz / 64; C = (st & 1) * 32 + (swz % 64) / 2; }
DI int perm32(int rho) { const int n = rho >> 4, i = rho & 15; return 8 * (i >> 2) + 4 * n + (i & 3); }
struct Unit { int pm, pn; };
struct Gemm { const bf16_t* A; const bf16_t* Bt; int M, N, K, lda; };
struct StaticOrder {
  int nM, nN, nwg, G, c;
  DI void init(int M, int N, int G_, int c_) { nM = M / BM; nN = N / BM; nwg = nM * nN; G = G_; c = c_; }
  DI bool next(int i, Unit& u) const {
    const long L = (long)i * G + c; if (L >= nwg) return false;
    int wgid = (int)L; { const int q = nwg / NXCD, r = nwg % NXCD, xcd = wgid % NXCD, off = wgid / NXCD; wgid = (xcd < r ? xcd * (q + 1) : r * (q + 1) + (xcd - r) * q) + off; }
    const int nig = WGM * nN, gid = wgid / nig, fm = gid * WGM, gsz = (nM - fm) < WGM ? (nM - fm) : WGM;
    u.pm = fm + ((wgid % nig) % gsz); u.pn = (wgid % nig) / gsz; return true;
  }
};

template <class Epi>
DI void gemm_phase(LAS unsigned char* lds, const Gemm g, const StaticOrder& S, const Epi& E) {
  const int tid = opaque_tid(), wid = __builtin_amdgcn_readfirstlane(tid >> 6), lane = tid & 63, wr = wid >> 2, wc = wid & 3, fr = lane & 15, fq = lane >> 4;
  const int K = g.K, nt = K / BK, lda = g.lda;
  unsigned voffA[2], voffB[2];
#pragma unroll
  for (int i = 0; i < 2; ++i) { int R, C; stage_rc(tid * 16 + i * 8192, R, C); const int Rb = (R & ~31) + perm32(R & 31);
    voffA[i] = (unsigned)(R * lda + C) * 2u; voffB[i] = (unsigned)(Rb * K + C) * 2u; }
  const size_t kstep = (size_t)(BK * 2);
  const size_t hstepA = (size_t)HALF * lda * 2, hstepB = (size_t)HALF * K * 2;
  const size_t tstepA = 2 * hstepA, tstepB = 2 * hstepB;
  const unsigned ldsw = (unsigned)wid * 1024u;
  const int aoff = lds_byte(wr * 64 + fr, fq * 8), boff = lds_byte(wc * 32 + fr, fq * 8);
#define PG8_SA(b, h) (((b) * 2 + (h)) * HTB)
#define PG8_SB(b, h) ((4 + (b) * 2 + (h)) * HTB)
#define PG8_STAGE(bufoff, gbase, voff) do { _Pragma("unroll") for (int _i = 0; _i < 2; ++_i) \
    __builtin_amdgcn_global_load_lds((const unsigned*)((const char*)(gbase) + (voff)[_i]), (LAS unsigned*)(lds + (bufoff) + ldsw + _i * 8192), 16, 0, 0); } while (0)
#define PG8_LDA(dst, b, h) do { _Pragma("unroll") for (int m = 0; m < 4; ++m) _Pragma("unroll") for (int k = 0; k < 2; ++k) dst[m][k] = *(const LAS bf16x8*)(lds + PG8_SA(b, h) + aoff + m * 2048 + k * 1024); } while (0)
#define PG8_LDB(dst, b, h) do { _Pragma("unroll") for (int n = 0; n < 2; ++n) _Pragma("unroll") for (int k = 0; k < 2; ++k) dst[n][k] = *(const LAS bf16x8*)(lds + PG8_SB(b, h) + boff + n * 2048 + k * 1024); } while (0)
#define PG8_MMA(ai, bj, At, Bt) do { __builtin_amdgcn_s_setprio(1); _Pragma("unroll") for (int m = 0; m < 4; ++m) _Pragma("unroll") for (int n = 0; n < 2; ++n) _Pragma("unroll") for (int k = 0; k < 2; ++k) \
    acc[ai][bj][m][n] = __builtin_amdgcn_mfma_f32_16x16x32_bf16(Bt[n][k], At[m][k], acc[ai][bj][m][n], 0, 0, 0); __builtin_amdgcn_s_setprio(0); } while (0)
#define PG8_WAIT_V(n) asm volatile("s_waitcnt vmcnt(" #n ")" ::: "memory")
#define PG8_WAIT_L(n) asm volatile("s_waitcnt lgkmcnt(" #n ")" ::: "memory")
#define PG8_BAR __builtin_amdgcn_s_barrier()
#define PG8_SCHED __builtin_amdgcn_sched_barrier(0)
  Unit cur, nxt; int ui = 0;
  if (!S.next(0, cur)) return;
  f32x4 acc[2][2][4][2];
#pragma unroll
  for (int a = 0; a < 2; ++a)
#pragma unroll
    for (int b = 0; b < 2; ++b)
#pragma unroll
      for (int m = 0; m < 4; ++m)
#pragma unroll
        for (int n = 0; n < 2; ++n) acc[a][b][m][n] = (f32x4){0.f, 0.f, 0.f, 0.f};
  bf16x8 At[4][2], B0[2][2], B1[2][2];
  const char* cA = (const char*)g.A + (size_t)cur.pm * tstepA; const char* cB = (const char*)g.Bt + (size_t)cur.pn * tstepB;
  PG8_STAGE(PG8_SB(0, 0), cB, voffB); PG8_STAGE(PG8_SA(0, 0), cA, voffA); PG8_STAGE(PG8_SB(0, 1), cB + hstepB, voffB); PG8_STAGE(PG8_SA(0, 1), cA + hstepA, voffA);
  if (wr == 1) PG8_BAR;
  PG8_WAIT_V(4); PG8_BAR;
  PG8_STAGE(PG8_SB(1, 0), cB + kstep, voffB); PG8_STAGE(PG8_SA(1, 0), cA + kstep, voffA); PG8_STAGE(PG8_SB(1, 1), cB + hstepB + kstep, voffB);
  PG8_WAIT_V(6); PG8_BAR;
  for (;;) {
    const bool has_next = S.next(ui + 1, nxt);
    const char* nA = has_next ? (const char*)g.A + (size_t)nxt.pm * tstepA : cA; const char* nB = has_next ? (const char*)g.Bt + (size_t)nxt.pn * tstepB : cB;
    for (int t = 0; t < nt; t += 2) {
      const bool last = (t == nt - 2);
      const char* a1 = cA + (size_t)(t + 1) * kstep;
      const char* a2 = last ? nA : cA + (size_t)(t + 2) * kstep; const char* b2 = last ? nB : cB + (size_t)(t + 2) * kstep;
      const char* a3 = a2 + kstep; const char* b3 = b2 + kstep;
      PG8_LDB(B0, 0, 0); PG8_SCHED; PG8_LDA(At, 0, 0); PG8_STAGE(PG8_SA(1, 1), a1 + hstepA, voffA);
      PG8_WAIT_L(8); PG8_BAR; PG8_WAIT_L(0); PG8_MMA(0, 0, At, B0); PG8_BAR; PG8_SCHED;
      PG8_LDB(B1, 0, 1); PG8_STAGE(PG8_SB(0, 0), b2, voffB);
      PG8_BAR; PG8_WAIT_L(0); PG8_MMA(0, 1, At, B1); PG8_BAR;
      PG8_LDA(At, 0, 1); PG8_STAGE(PG8_SA(0, 0), a2, voffA);
      PG8_BAR; PG8_WAIT_L(0); PG8_MMA(1, 0, At, B0); PG8_BAR; PG8_SCHED;
      PG8_STAGE(PG8_SB(0, 1), b2 + hstepB, voffB);
      PG8_WAIT_V(6); PG8_BAR; PG8_MMA(1, 1, At, B1); PG8_BAR;
      PG8_LDB(B0, 1, 0); PG8_SCHED; PG8_LDA(At, 1, 0); PG8_STAGE(PG8_SA(0, 1), a2 + hstepA, voffA);
      PG8_WAIT_L(8); PG8_BAR; PG8_WAIT_L(0); PG8_MMA(0, 0, At, B0); PG8_BAR; PG8_SCHED;
      PG8_LDB(B1, 1, 1); PG8_STAGE(PG8_SB(1, 0), b3, voffB);
      PG8_BAR; PG8_WAIT_L(0); PG8_MMA(0, 1, At, B1); PG8_BAR;
      PG8_LDA(At, 1, 1); PG8_STAGE(PG8_SA(1, 0), a3, voffA);
      PG8_BAR; PG8_WAIT_L(0); PG8_MMA(1, 0, At, B0); PG8_BAR; PG8_SCHED;
      PG8_STAGE(PG8_SB(1, 1), b3 + hstepB, voffB);
      PG8_WAIT_V(6); PG8_BAR; PG8_MMA(1, 1, At, B1); PG8_BAR;
    }
    E(acc, cur, wr, wc, fr, fq);
    if (!has_next) break;
#pragma unroll
    for (int a = 0; a < 2; ++a)
#pragma unroll
      for (int b = 0; b < 2; ++b)
#pragma unroll
        for (int m = 0; m < 4; ++m)
#pragma unroll
          for (int n = 0; n < 2; ++n) acc[a][b][m][n] = (f32x4){0.f, 0.f, 0.f, 0.f};
    cur = nxt; cA = nA; cB = nB; ++ui;
  }
  PG8_WAIT_V(0);
  if (wr == 0) PG8_BAR;
  PG8_BAR;
#undef PG8_SA
#undef PG8_SB
#undef PG8_STAGE
#undef PG8_LDA
#undef PG8_LDB
#undef PG8_MMA
#undef PG8_WAIT_V
#undef PG8_WAIT_L
#undef PG8_BAR
#undef PG8_SCHED
}
}

struct Epi {
  bf16_t* out; int ldc;
  int rope64_end;
  int rope32_lo, rope32_hi;
  int qmode;
  const float* pin; int nK;
  int pslot;
  float* pout;
  const float *cosH, *sinH, *cosR, *sinR;
  DI void operator()(const f32x4 (&acc)[2][2][4][2], const pg8::Unit& u, int wr, int wc, int fr, int fq) const {
    const int row0 = u.pm * 256 + wr * 64 + fr;
    int rt[2];
#pragma unroll
    for (int bj = 0; bj < 2; ++bj) {
      const int cw = u.pn * 256 + bj * 128 + wc * 32;
      rt[bj] = 0;
      if (cw < rope64_end) rt[bj] = 1;
      else if (cw >= rope32_lo && cw < rope32_hi) rt[bj] = 2;
      else if (qmode && ((cw >> 5) % 3) == 2) rt[bj] = 2;
    }
    const int tt = rt[0] | rt[1];
    const float* ctab = (tt == 1) ? cosH + (16 * (wc & 1) + 4 * fq) : cosR + 4 * fq;
    const float* stab = (tt == 1) ? sinH + (16 * (wc & 1) + 4 * fq) : sinR + 4 * fq;
    const int tstride = (tt == 1) ? 32 : 16;
    int ps[2] = {-1, -1};
    if (pout) {
#pragma unroll
      for (int bj = 0; bj < 2; ++bj) { const int cw = u.pn * 256 + bj * 128 + wc * 32;
        if (cw >= 1792 && cw < 2432) ps[bj] = ((cw - 1792) >> 7) * 4 + wc; }
    }
#pragma unroll
    for (int ai = 0; ai < 2; ++ai) {
      f32x4 cv[4], sv[4]; float rs[4];
#pragma unroll
      for (int m = 0; m < 4; ++m) {
        const int row = row0 + ai * 128 + m * 16;
        if (tt) { const int pos = row & (SEQ - 1); cv[m] = *(const f32x4*)(ctab + pos * tstride); sv[m] = *(const f32x4*)(stab + pos * tstride); }
        rs[m] = 1.f;
        if (pin) { const f32x4 p0 = *(const f32x4*)(pin + (size_t)row * 20 + pslot), p1 = *(const f32x4*)(pin + (size_t)row * 20 + pslot + 4);
          float ss = ((p0[0] + p0[1]) + (p0[2] + p0[3])) + ((p1[0] + p1[1]) + (p1[2] + p1[3]));
          if (nK == 384) { const f32x4 p2 = *(const f32x4*)(pin + (size_t)row * 20 + pslot + 8); ss += (p2[0] + p2[1]) + (p2[2] + p2[3]); }
          rs[m] = rsqrtf(ss / (float)nK + EPS); }
      }
#pragma unroll
      for (int m = 0; m < 4; ++m) {
        const int row = row0 + ai * 128 + m * 16;
#pragma unroll
        for (int bj = 0; bj < 2; ++bj) {
          const int c0 = u.pn * 256 + bj * 128 + wc * 32 + 8 * fq;
          f32x4 v0 = acc[ai][bj][m][0] * rs[m], v1 = acc[ai][bj][m][1] * rs[m];
          if (ps[bj] >= 0) {
            float sq = (v0[0] * v0[0] + v0[1] * v0[1]) + (v0[2] * v0[2] + v0[3] * v0[3]) + (v1[0] * v1[0] + v1[1] * v1[1]) + (v1[2] * v1[2] + v1[3] * v1[3]);
            sq += __shfl_xor(sq, 16); sq += __shfl_xor(sq, 32);
            if (fq == 0) pout[(size_t)row * 20 + ps[bj]] = sq;
          }
          if (rt[bj]) {
            const f32x4 o1 = v0 * cv[m] - v1 * sv[m], o2 = v1 * cv[m] + v0 * sv[m];
            v0 = o1; v1 = o2;
          }
          u32x4 w; w.x = pk2(v0[0], v0[1]); w.y = pk2(v0[2], v0[3]); w.z = pk2(v1[0], v1[1]); w.w = pk2(v1[2], v1[3]);
          *(u32x4*)(out + (size_t)row * ldc + c0) = w;
        }
      }
    }
  }
};

DI int ropeperm64(int p) { const int g = p >> 3, r = p & 7; return r < 4 ? 4 * g + r : 32 + 4 * g + (r - 4); }
DI int ropeperm32(int p) { const int g = p >> 3, r = p & 7; return r < 4 ? 4 * g + r : 16 + 4 * g + (r - 4); }
DI int srccol(int kind, int n) {
  if (kind == 0) {
    if (n < 512) return 672 + (n & ~63) + ropeperm64(n & 63);
    if (n < 640) return 1184 + ((n - 512) & ~63) + ropeperm64(n & 63);
    if (n < 768) return 1312 + (n - 640);
    if (n < 1792) return 1440 + (n - 768);
    if (n < 2176) return n - 1792;
    if (n < 2432) return 384 + (n - 2176);
    if (n < 2464) return 640 + ropeperm32(n - 2432);
    return -1;
  }
  if (kind == 1) {
    if (n < 1024) return (n & ~63) + ropeperm64(n & 63);
    if (n < 3072) return n;
    return 3080 + (n - 3072);
  }
  if (kind == 2) { const int hd = n / 96, p = n - hd * 96; return hd * 96 + (p < 64 ? p : 64 + ropeperm32(p - 64)); }
  return n;
}
struct ConvJob { const float* W; const float* g; bf16_t* Wt; int Nsrc, K, kind, tn, tk; };
DI bool conv_decode(const Params& p, int job, ConvJob& j) {
  constexpr int NT0 = 40 * 16, NT1 = 64 * 16, NT2 = 12 * 6, NT3 = 16 * 4, NT4 = 16 * 16;
  constexpr int PER_I = NT0 + NT1 + NT2 + NT3 + 2 * NT4;
  if (job >= 2 * PER_I) return false;
  unsigned char* ws = p.ws;
  const int i = job / PER_I; int t = job - i * PER_I;
  j.g = nullptr;
  if (t < NT0) { j.W = p.ev_w_in + (size_t)i * 1024 * 2464; j.Nsrc = 2464; j.K = 1024; j.Wt = (bf16_t*)(ws + WS_WEVIN + i * SZ_WEVIN); j.kind = 0; j.tn = t / 16; j.tk = t % 16; return true; }
  t -= NT0;
  if (t < NT1) { j.W = p.od_w_in + (size_t)i * 1024 * 4104; j.Nsrc = 4104; j.K = 1024; j.Wt = (bf16_t*)(ws + WS_WODIN + i * SZ_WODIN); j.kind = 1; j.tn = t / 16; j.tk = t % 16; return true; }
  t -= NT1;
  if (t < NT2) { j.W = p.ev_w_uq + (size_t)i * 384 * 768; j.Nsrc = 768; j.K = 384; j.Wt = (bf16_t*)(ws + WS_WUQ + i * SZ_WUQ); j.kind = 2; j.g = p.ev_q_norm + i * 384; j.tn = t / 6; j.tk = t % 6; return true; }
  t -= NT2;
  if (t < NT3) { j.W = p.ev_w_ukv + (size_t)i * 256 * 1024; j.Nsrc = 1024; j.K = 256; j.Wt = (bf16_t*)(ws + WS_WUKV + i * SZ_WUKV); j.kind = 3; j.g = p.ev_kv_norm + i * 256; j.tn = t / 4; j.tk = t % 4; return true; }
  t -= NT3;
  if (t < NT4) { j.W = p.ev_w_out + (size_t)i * 1024 * 1024; j.Nsrc = 1024; j.K = 1024; j.Wt = (bf16_t*)(ws + WS_WEVOUT + i * SZ_WOUT); j.kind = 4; j.tn = t / 16; j.tk = t % 16; return true; }
  t -= NT4;
  j.W = p.od_w_out + (size_t)i * 1024 * 1024; j.Nsrc = 1024; j.K = 1024; j.Wt = (bf16_t*)(ws + WS_WODOUT + i * SZ_WOUT); j.kind = 4; j.tn = t / 16; j.tk = t % 16; return true;
}
template <int NJ>
DI void convert_tiles(const Params& p, LAS unsigned char* lds, int job0, int jstride) {
  const int tid = opaque_tid();
  const int nl = tid & 63, ks = tid >> 6;
  ConvJob j[NJ] = {}; bool ok[NJ]; float v[NJ][8];
#pragma unroll
  for (int q = 0; q < NJ; ++q) {
    ok[q] = conv_decode(p, job0 + q * jstride, j[q]);
    const int sc = ok[q] ? srccol(j[q].kind, j[q].tn * 64 + nl) : -1;
#pragma unroll
    for (int e = 0; e < 8; ++e) {
      const int k = j[q].tk * 64 + ks + 8 * e;
      v[q][e] = 0.f;
      if (sc >= 0) { v[q][e] = j[q].W[(size_t)k * j[q].Nsrc + sc]; if (j[q].g) v[q][e] *= j[q].g[k]; }
    }
  }
#pragma unroll
  for (int q = 0; q < NJ; ++q) {
    LAS bf16_t* tile = (LAS bf16_t*)(lds + q * 9216);
#pragma unroll
    for (int e = 0; e < 8; ++e) tile[nl * 72 + ks + 8 * e] = f2bf(v[q][e]);
  }
  __syncthreads();
#pragma unroll
  for (int q = 0; q < NJ; ++q) {
    if (ok[q]) {
      LAS bf16_t* tile = (LAS bf16_t*)(lds + q * 9216);
      const int n2 = tid >> 3, ch = tid & 7;
      const u32x4 w = *(const LAS u32x4*)(tile + n2 * 72 + ch * 8);
      *(u32x4*)(j[q].Wt + (size_t)(j[q].tn * 64 + n2) * j[q].K + j[q].tk * 64 + ch * 8) = w;
    }
  }
  __syncthreads();
}

DI void prologue(const Params& p, LAS unsigned char* lds) {
  const int tid = opaque_tid(), G = gridDim.x, bid = blockIdx.x;
  unsigned char* ws = p.ws;
  for (int idx = bid * 512 + tid; idx < 2048 * 48; idx += G * 512) {
    const bool isH = idx < 2048 * 32;
    const int j = isH ? idx : idx - 2048 * 32;
    const int pos = isH ? (j >> 5) : (j >> 4), i = isH ? (j & 31) : (j & 15);
    const float e = isH ? (float)(2 * i) * (1.f / 64.f) : (float)(2 * i) * (1.f / 32.f);
    const float inv = fast_exp2(-e * 13.287712379549449f);
    const float ang = (float)pos * inv;
    double t = (double)ang * 0.15915494309189535; t -= rint(t);
    const float fr = (float)t;
    const float cv = __builtin_amdgcn_cosf(fr), sv = __builtin_amdgcn_sinf(fr);
    if (isH) { ((float*)(ws + WS_COSH))[j] = cv; ((float*)(ws + WS_SINH))[j] = sv; }
    else { ((float*)(ws + WS_COSR))[j] = cv; ((float*)(ws + WS_SINR))[j] = sv; }
  }
  for (int job = bid; job < 4624; job += 4 * G) convert_tiles<4>(p, lds, job, G);
  const int item0 = G - 1 - bid;
  if (item0 < 192) {
    LAS float* cond = (LAS float*)lds;
    LAS float* red = (LAS float*)(lds + 65536);
    for (int e = tid; e < 16 * 1024; e += 512) { const int b = e >> 10, k = e & 1023; cond[k * 16 + b] = silu_f(p.c[e]); }
    __syncthreads();
    for (int item = item0; item < 192; item += G) {
      const int l = item / 48, n0 = (item % 48) * 64;
      const int col = tid & 63, kg = tid >> 6;
      float a[16];
#pragma unroll
      for (int b = 0; b < 16; ++b) a[b] = 0.f;
      const float* wp = p.w_ada + (size_t)l * 1024 * 3072 + n0 + col;
      for (int k0 = kg * 128; k0 < kg * 128 + 128; k0 += 16) {
        float wv[16];
#pragma unroll
        for (int e = 0; e < 16; ++e) wv[e] = wp[(size_t)(k0 + e) * 3072];
#pragma unroll
        for (int e = 0; e < 16; ++e) {
          const float w = wv[e]; const int k = k0 + e;
#pragma unroll
          for (int b4 = 0; b4 < 4; ++b4) { const f32x4 cv = *(const LAS f32x4*)(cond + k * 16 + b4 * 4);
            a[b4 * 4 + 0] += cv[0] * w; a[b4 * 4 + 1] += cv[1] * w; a[b4 * 4 + 2] += cv[2] * w; a[b4 * 4 + 3] += cv[3] * w; }
        }
      }
#pragma unroll
      for (int b = 0; b < 16; ++b) red[(kg * 16 + b) * 64 + col] = a[b];
      __syncthreads();
      for (int e = tid; e < 1024; e += 512) { const int b = e >> 6, cc = e & 63; float s = 0.f;
#pragma unroll
        for (int k8 = 0; k8 < 8; ++k8) s += red[(k8 * 16 + b) * 64 + cc];
        ((float*)(ws + WS_MOD))[((size_t)l * 16 + b) * 3072 + n0 + cc] = s + p.b_ada[l * 3072 + n0 + cc]; }
      __syncthreads();
    }
  }
}

DI void rowwise_phase(const Params& p, LAS unsigned char* lds, int lp, int ln) {
  const int tid = opaque_tid(), lane = tid & 63, wid = tid >> 6;
  const int gw = blockIdx.x * 8 + wid, nw = gridDim.x * 8;
  unsigned char* ws = p.ws;
  const float* mod = (const float*)(ws + WS_MOD);
  const bf16_t* ybuf = (const bf16_t*)(ws + WS_HBUF);
  bf16_t* hbuf = (bf16_t*)(ws + WS_HBUF);
  const bool ff = (ln < 4) && (ln & 1);
  LAS f32x4* wl = (LAS f32x4*)lds;
  if (ff) {
    const float* w = p.od_w_in + (size_t)(ln >> 1) * 1024 * 4104 + 3072;
    for (int c = tid; c < 1024; c += 512) {
      const f32x4 w0 = *(const f32x4*)(w + (size_t)c * 4104), w1 = *(const f32x4*)(w + (size_t)c * 4104 + 4);
      const int ln_ = (c & 255) >> 2, e = c & 3, j = c >> 8;
      wl[(j * 4 + e) * 64 + ln_] = w0; wl[1024 + (j * 4 + e) * 64 + ln_] = w1;
    }
    __syncthreads();
  }
  for (int row = gw; row < T; row += nw) {
    const int b = row >> 11;
    f32x4 xv[4];
    bf16_t* xbf = (bf16_t*)(ws + WS_XBF) + (size_t)row * DM;
    if (lp <= 0) {
      const float* xin = p.x + (size_t)row * DM;
#pragma unroll
      for (int j = 0; j < 4; ++j) xv[j] = *(const f32x4*)(xin + 4 * lane + 256 * j);
    } else {
#pragma unroll
      for (int j = 0; j < 4; ++j) { const u32x2 u = *(const u32x2*)(xbf + 4 * lane + 256 * j); xv[j] = (f32x4){bflo(u.x), bfhi(u.x), bflo(u.y), bfhi(u.y)}; }
    }
    if (lp >= 0) {
      f32x4 yv[4]; float ss = 0.f;
#pragma unroll
      for (int j = 0; j < 4; ++j) { const u32x2 u = *(const u32x2*)(ybuf + (size_t)row * DM + 4 * lane + 256 * j);
        yv[j] = (f32x4){bflo(u.x), bfhi(u.x), bflo(u.y), bfhi(u.y)}; ss += yv[j][0] * yv[j][0] + yv[j][1] * yv[j][1] + yv[j][2] * yv[j][2] + yv[j][3] * yv[j][3]; }
      ss = wave_sum(ss);
      const float rs = rsqrtf(ss * (1.f / DM) + EPS);
#pragma unroll
      for (int j = 0; j < 4; ++j) {
        const int c = 4 * lane + 256 * j;
        const f32x4 gt = *(const f32x4*)(mod + ((size_t)lp * 16 + b) * 3072 + 2048 + c);
        const f32x4 gp = *(const f32x4*)(p.g_post + lp * DM + c);
        xv[j] = xv[j] + gt * (yv[j] * rs * gp);
        if (ln >= 4) *(f32x4*)(p.out + (size_t)row * DM + c) = xv[j];
        else { u32x2 w; w.x = pk2(xv[j][0], xv[j][1]); w.y = pk2(xv[j][2], xv[j][3]); *(u32x2*)(xbf + c) = w; }
      }
    }
    if (ln < 4) {
      float ss = 0.f;
#pragma unroll
      for (int j = 0; j < 4; ++j) ss += xv[j][0] * xv[j][0] + xv[j][1] * xv[j][1] + xv[j][2] * xv[j][2] + xv[j][3] * xv[j][3];
      ss = wave_sum(ss);
      const float rs = rsqrtf(ss * (1.f / DM) + EPS);
      float zf[8];
#pragma unroll
      for (int h = 0; h < 8; ++h) zf[h] = 0.f;
#pragma unroll
      for (int j = 0; j < 4; ++j) {
        const int c = 4 * lane + 256 * j;
        const f32x4 sh = *(const f32x4*)(mod + ((size_t)ln * 16 + b) * 3072 + c);
        const f32x4 sc = *(const f32x4*)(mod + ((size_t)ln * 16 + b) * 3072 + 1024 + c);
        const f32x4 gp = *(const f32x4*)(p.g_pre + ln * DM + c);
        const f32x4 hv = (xv[j] * rs * gp) * (sc + 1.f) + sh;
        u32x2 w; w.x = pk2(hv[0], hv[1]); w.y = pk2(hv[2], hv[3]);
        *(u32x2*)(hbuf + (size_t)row * DM + c) = w;
        if (ff) {
#pragma unroll
          for (int e = 0; e < 4; ++e) {
            const f32x4 w0 = wl[(j * 4 + e) * 64 + lane], w1 = wl[1024 + (j * 4 + e) * 64 + lane];
            zf[0] += hv[e] * w0[0]; zf[1] += hv[e] * w0[1]; zf[2] += hv[e] * w0[2]; zf[3] += hv[e] * w0[3];
            zf[4] += hv[e] * w1[0]; zf[5] += hv[e] * w1[1]; zf[6] += hv[e] * w1[2]; zf[7] += hv[e] * w1[3];
          }
        }
      }
      if (ff) {
        const bool b5 = lane & 32, b4 = lane & 16, b3 = lane & 8;
        float w4[4], u2[2], t;
#pragma unroll
        for (int k = 0; k < 4; ++k) { const float send = b5 ? zf[k] : zf[4 + k], keep = b5 ? zf[4 + k] : zf[k]; w4[k] = keep + __shfl_xor(send, 32); }
#pragma unroll
        for (int k = 0; k < 2; ++k) { const float send = b4 ? w4[k] : w4[2 + k], keep = b4 ? w4[2 + k] : w4[k]; u2[k] = keep + __shfl_xor(send, 16); }
        { const float send = b3 ? u2[0] : u2[1], keep = b3 ? u2[1] : u2[0]; t = keep + __shfl_xor(send, 8); }
        t += __shfl_xor(t, 4); t += __shfl_xor(t, 2); t += __shfl_xor(t, 1);
        if ((lane & 7) == 0) {
          const int h = lane >> 3;
          const float z = t + p.od_forget_bias[(ln >> 1) * 8 + h];
          const float ls = fminf(z, 0.f) - __builtin_amdgcn_logf(1.f + fast_exp2(-fabsf(z) * LOG2E)) * 0.6931471805599453f;
          ((float*)(ws + WS_LOGF))[(size_t)row * 8 + h] = ls;
        }
      }
    }
  }
  __syncthreads();
}

DI void fox_scan(const Params& p, LAS unsigned char* lds, int bh) {
  const int tid = opaque_tid();
  const int b = bh >> 3, h = bh & 7;
  const float* logf_ = (const float*)(p.ws + WS_LOGF);
  float* fcum = (float*)(p.ws + WS_FCUM) + (size_t)bh * SEQ;
  LAS float* s = (LAS float*)lds;
  float v[4];
#pragma unroll
  for (int j = 0; j < 4; ++j) v[j] = logf_[((size_t)b * SEQ + 4 * tid + j) * 8 + h];
  v[1] += v[0]; v[2] += v[1]; v[3] += v[2];
  s[tid] = v[3];
  __syncthreads();
  for (int off = 1; off < 512; off <<= 1) {
    float t = 0.f;
    if (tid >= off) t = s[tid - off];
    __syncthreads();
    s[tid] += t;
    __syncthreads();
  }
  const float excl = s[tid] - v[3];
#pragma unroll
  for (int j = 0; j < 4; ++j) fcum[4 * tid + j] = -8.0f * (excl + v[j]);
  __syncthreads();
}

struct AttnArgs { const bf16_t *q, *k, *k2, *v, *gate; bf16_t* out; const float* fcum; int ldq, ldk, ldk2, ldv, ldo, ldg; float sl2, sink; };

DI float half_max(float x) {
  const unsigned u = __float_as_uint(x);
  auto r = __builtin_amdgcn_permlane32_swap(u, u, false, false);
  return fmaxf(__uint_as_float(r[0]), __uint_as_float(r[1]));
}
DI float half_sum(float x) {
  const unsigned u = __float_as_uint(x);
  auto r = __builtin_amdgcn_permlane32_swap(u, u, false, false);
  return __uint_as_float(r[0]) + __uint_as_float(r[1]);
}


DI void epi_block(const f32x16& O, float inv, int hh, const bf16_t* gate_row, bf16_t* out_row) {
#pragma unroll
  for (int g = 0; g < 4; g += 2) {
    float v[8];
#pragma unroll
    for (int e = 0; e < 4; ++e) {
      auto r = __builtin_amdgcn_permlane32_swap(__float_as_uint(O[4 * g + e] * inv), __float_as_uint(O[4 * (g + 1) + e] * inv), false, false);
      v[e] = __uint_as_float(r[0]); v[4 + e] = __uint_as_float(r[1]);
    }
    const int c = 8 * g + 8 * hh;
    if (gate_row) {
      const u32x4 gv = *(const u32x4*)(gate_row + c);
#pragma unroll
      for (int e = 0; e < 4; ++e) { v[2 * e] *= silu_f(bflo(gv[e])); v[2 * e + 1] *= silu_f(bfhi(gv[e])); }
    }
    u32x4 w; w.x = pk2(v[0], v[1]); w.y = pk2(v[2], v[3]); w.z = pk2(v[4], v[5]); w.w = pk2(v[6], v[7]);
    *(u32x4*)(out_row + c) = w;
  }
}

template <int N> DI void wait_vmcnt() { asm volatile("s_waitcnt vmcnt(%0)" ::"n"(N) : "memory"); }
DI void raw_barrier() { asm volatile("" ::: "memory"); __builtin_amdgcn_s_barrier(); asm volatile("" ::: "memory"); }

template <int DQK, int DV, int MODE>
DI void attn_item(LAS unsigned char* lds, const AttnArgs& a, int qb) {
  constexpr int KSTR = DQK * 2 + 16, VSTR = (DV == 64) ? 192 : 320;
  constexpr int KG16 = KSTR / 16, VG16 = VSTR / 16;
  constexpr int KCH = KG16, VCH = VG16, NCH = KCH + VCH;
  constexpr int TILE = NCH * 1024 + (MODE == 2 ? 2048 : 0);
  constexpr int NSLOT = (NCH + 7) / 8, REM = NCH - 8 * (NSLOT - 1);
  constexpr int FX = (MODE == 2) ? 1 : 0;
  constexpr int NKS = DQK / 16, NBLK = DV / 32;
  static_assert(5 * TILE <= 155648, "ring too large");
  const int tid = opaque_tid(), wid = __builtin_amdgcn_readfirstlane(tid >> 6), lane = tid & 63, r = lane & 31, hh = lane >> 5;
  const int q0 = qb * 256, qw = q0 + 32 * wid, myq = qw + r;
  const float c = a.sl2, tau = 8.0f / a.sl2;
  bf16x8 qf[NKS];
#pragma unroll
  for (int ks = 0; ks < NKS; ++ks) qf[ks] = *(const bf16x8*)(a.q + (size_t)myq * a.ldq + 16 * ks + 8 * hh);
  int lo = 0; const int hi = 4 * (qb + 1);
  if (MODE == 1) { lo = 4 * qb - 2; if (lo < 0) lo = 0; }
  const int last_w = (qw + 31) >> 6;
  int first_w = 0;
  if (MODE == 1) { first_w = (qw > 127 ? qw - 127 : 0) >> 6; }
  const char* sp[NSLOT]; unsigned sst[NSLOT];
#pragma unroll
  for (int j = 0; j < NSLOT; ++j) {
    const int ch_ = 8 * j + wid;
    if (ch_ < KCH) {
      const int p = ch_ * 64 + lane, row = p / KG16, g = p - row * KG16;
      if (DQK == 96 && g >= 8 && g < 12) { sp[j] = (const char*)(a.k2 + (size_t)row * a.ldk2 + 8 * (g - 8)); sst[j] = (unsigned)(128 * a.ldk2); }
      else { sp[j] = (const char*)(a.k + (size_t)row * a.ldk + 8 * (g < 8 ? g : 0)); sst[j] = (unsigned)(128 * a.ldk); }
    } else {
      const int p = (ch_ - KCH) * 64 + lane, row = (p / VG16) & 63, g = p - (p / VG16) * VG16;
      sp[j] = (const char*)(a.v + (size_t)row * a.ldv + 8 * (g < DV / 8 ? g : 0)); sst[j] = (unsigned)(128 * a.ldv);
    }
  }
  auto issue = [&](int kt) {
    LAS unsigned char* base = lds + (kt % 4) * TILE;
#pragma unroll
    for (int j = 0; j < NSLOT; ++j) {
      if (j < NSLOT - 1 || wid < REM)
        __builtin_amdgcn_global_load_lds((const unsigned*)(sp[j] + (size_t)kt * sst[j]), (LAS unsigned*)(base + (8 * j + wid) * 1024), 16, 0, 0);
    }
    if (MODE == 2) __builtin_amdgcn_global_load_lds((const unsigned*)(a.fcum + kt * 64 + lane), (LAS unsigned*)(base + NCH * 1024 + wid * 256), 4, 0, 0);
  };
  auto wait_tiles = [&](bool all) {
    if (all) wait_vmcnt<0>();
    else if (wid < REM) wait_vmcnt<NSLOT + FX>();
    else wait_vmcnt<NSLOT - 1 + FX>();
  };
  f32x16 O[NBLK];
#pragma unroll
  for (int bl = 0; bl < NBLK; ++bl)
#pragma unroll
    for (int i = 0; i < 16; ++i) O[bl][i] = 0.f;
  float m = (MODE == 1) ? a.sink / a.sl2 : -1e30f;
  float l0 = (MODE == 1 && hh == 0) ? 1.f : 0.f, l1 = 0.f;
  const int i16 = lane & 15, q4 = i16 >> 2, p4 = i16 & 3, grp = (lane >> 4) & 1;
  auto qk_load = [&](int kt, bf16x8 (&kf)[2][NKS]) {
    LAS unsigned char* Kl = lds + (kt % 4) * TILE;
#pragma unroll
    for (int kb = 0; kb < 2; ++kb)
#pragma unroll
      for (int ks = 0; ks < NKS; ++ks) kf[kb][ks] = *(const LAS bf16x8*)(Kl + (32 * kb + r) * KSTR + (16 * ks + 8 * hh) * 2);
  };
  auto qk_mma = [&](int kt, const bf16x8 (&kf)[2][NKS], f32x16 (&s)[2]) {
#pragma unroll
    for (int kb = 0; kb < 2; ++kb) {
      if (MODE == 2) {
        LAS unsigned char* Fl = lds + (kt % 4) * TILE + NCH * 1024 + wid * 256;
#pragma unroll
        for (int g = 0; g < 4; ++g) { const f32x4 fb = *(const LAS f32x4*)(Fl + (32 * kb + 8 * g + 4 * hh) * 4);
          s[kb][4 * g] = fb[0]; s[kb][4 * g + 1] = fb[1]; s[kb][4 * g + 2] = fb[2]; s[kb][4 * g + 3] = fb[3]; }
      } else {
#pragma unroll
        for (int i = 0; i < 16; ++i) s[kb][i] = 0.f;
      }
    }
#pragma unroll
    for (int ks = 0; ks < NKS; ++ks)
#pragma unroll
      for (int kb = 0; kb < 2; ++kb) s[kb] = __builtin_amdgcn_mfma_f32_32x32x16_bf16(kf[kb][ks], qf[ks], s[kb], 0, 0, 0);
  };
  auto softmax = [&](int kt, f32x16 (&s)[2], bf16x8 (&pf)[2][2], auto maskc) {
    constexpr bool MASK = decltype(maskc)::value;
    const int key0 = kt * 64;
    if (MASK) {
#pragma unroll
      for (int kb = 0; kb < 2; ++kb)
#pragma unroll
        for (int i = 0; i < 16; ++i) {
          const int key = key0 + 32 * kb + (i & 3) + 8 * (i >> 2) + 4 * hh;
          bool valid = key <= myq; if (MODE == 1) valid = valid && (myq - key < 128);
          s[kb][i] = valid ? s[kb][i] : -1e30f;
        }
    }
    float mx = fmaxf(s[0][0], s[1][0]);
#pragma unroll
    for (int i = 1; i < 16; ++i) mx = fmaxf(fmaxf(mx, s[0][i]), s[1][i]);
    mx = half_max(mx);
    if (__builtin_amdgcn_ballot_w64(mx > m + tau) != 0ull) {
      const float mnew = fmaxf(m, mx);
      const float alpha = fast_exp2((m - mnew) * c);
      m = mnew;
      l0 *= alpha; l1 *= alpha;
#pragma unroll
      for (int bl = 0; bl < NBLK; ++bl)
#pragma unroll
        for (int i = 0; i < 16; ++i) O[bl][i] *= alpha;
    }
    const float nmc = -m * c;
#pragma unroll
    for (int kb = 0; kb < 2; ++kb)
#pragma unroll
      for (int s2 = 0; s2 < 2; ++s2) {
        float pv[8];
#pragma unroll
        for (int e = 0; e < 8; ++e) pv[e] = fast_exp2(__builtin_fmaf(s[kb][8 * s2 + e], c, nmc));
        l0 += (pv[0] + pv[4]) + (pv[2] + pv[6]); l1 += (pv[1] + pv[5]) + (pv[3] + pv[7]);
        u32x4 w;
        w.x = pk2(pv[0], pv[1]); w.y = pk2(pv[2], pv[3]); w.z = pk2(pv[4], pv[5]); w.w = pk2(pv[6], pv[7]);
        pf[kb][s2] = __builtin_bit_cast(bf16x8, w);
      }
  };
  auto pvmm = [&](int kt, const bf16x8 (&pf)[2][2]) {
    constexpr int PD = (NBLK == 2) ? 2 : 1;
    const unsigned va = (unsigned)(size_t)(lds + (kt % 4) * TILE + KCH * 1024 + (4 * hh + q4) * VSTR + (16 * grp) * 2 + 8 * p4);
    s16x4 vl[PD + 1][NBLK], vh[PD + 1][NBLK];
#define TRRD(dst, off) asm volatile("ds_read_b64_tr_b16 %0, %1 offset:%2" : "=&v"(dst) : "v"(va), "n"(off) : "memory")
#define TRSTEP(st_) do { _Pragma("unroll") for (int bl = 0; bl < NBLK; ++bl) { TRRD(vl[(st_) % (PD + 1)][bl], 16 * (st_) * VSTR + 64 * bl); TRRD(vh[(st_) % (PD + 1)][bl], 16 * (st_) * VSTR + 64 * bl + 8 * VSTR); } } while (0)
#define TRWAIT(n_, b_) do { if (NBLK == 2) asm volatile("s_waitcnt lgkmcnt(" #n_ ")" : "+v"(vl[b_][0]), "+v"(vh[b_][0]), "+v"(vl[b_][1]), "+v"(vh[b_][1])::"memory"); \
    else asm volatile("s_waitcnt lgkmcnt(" #n_ ")" : "+v"(vl[b_][0]), "+v"(vh[b_][0]), "+v"(vl[b_][1]), "+v"(vh[b_][1]), "+v"(vl[b_][2 % NBLK]), "+v"(vh[b_][2 % NBLK]), "+v"(vl[b_][3 % NBLK]), "+v"(vh[b_][3 % NBLK])::"memory"); } while (0)
#pragma unroll
    for (int st = 0; st < PD; ++st) TRSTEP(st);
#pragma unroll
    for (int st = 0; st < 4; ++st) {
      if (st + PD < 4) TRSTEP(st + PD);
      const int ahead = ((st + PD < 4) ? st + PD : 3) - st;
      const int b_ = st % (PD + 1);
      if (ahead * 2 * NBLK == 8) TRWAIT(8, b_); else if (ahead * 2 * NBLK == 4) TRWAIT(4, b_); else TRWAIT(0, b_);
#pragma unroll
      for (int bl = 0; bl < NBLK; ++bl) {
        const bf16x8 vf = __builtin_shufflevector(vl[b_][bl], vh[b_][bl], 0, 1, 2, 3, 4, 5, 6, 7);
        O[bl] = __builtin_amdgcn_mfma_f32_32x32x16_bf16(vf, pf[st >> 1][st & 1], O[bl], 0, 0, 0);
      }
    }
#undef TRRD
#undef TRSTEP
#undef TRWAIT
  };
  auto act = [&](int kt) { return kt <= last_w && kt >= first_w; };
  f32x16 sA[2];
  const bool halfB = wid >= 4;
  issue(lo);
  if (lo + 1 < hi) issue(lo + 1);
  if (lo + 2 < hi) issue(lo + 2);
  wait_tiles(true);
  raw_barrier();
  if (halfB) raw_barrier();
  if (act(lo)) { bf16x8 kf0[2][NKS]; qk_load(lo, kf0); qk_mma(lo, kf0, sA); }
  auto step = [&](int kt, auto maskc) {
    const bool a0 = act(kt), a1 = (kt + 1 < hi) && act(kt + 1);
    bf16x8 pf[2][2], kf[2][NKS];
    if (a0) softmax(kt, sA, pf, maskc);
    wait_tiles(true);
    raw_barrier();
    if (a1) qk_load(kt + 1, kf);
    __builtin_amdgcn_s_setprio(1);
    if (a1) qk_mma(kt + 1, kf, sA);
    if (a0) pvmm(kt, pf);
    __builtin_amdgcn_s_setprio(0);
    if (kt + 3 < hi) issue(kt + 3);
    raw_barrier();
  };
  int split = lo;
  if (MODE != 1) { split = qw >> 6; if (split < lo) split = lo; if (split > hi) split = hi; }
  if (MODE != 1) { for (int kt = lo; kt < split; ++kt) step(kt, std::false_type{}); }
  for (int kt = split; kt < hi; ++kt) step(kt, std::true_type{});
  if (!halfB) raw_barrier();
  const float l = half_sum(l0 + l1);
  const float inv = 1.f / l;
#pragma unroll
  for (int bl = 0; bl < NBLK; ++bl)
    epi_block(O[bl], inv, hh, a.gate ? a.gate + (size_t)myq * a.ldg + 32 * bl : nullptr, a.out + (size_t)myq * a.ldo + 32 * bl);
}

DI void swa_item(LAS unsigned char* lds, const AttnArgs& a, const float* sinks4, int qb) {
  constexpr int KSTR = 144, VSTR = 192, KCH = 9, VCH = 12, NCH = 21, TILE = NCH * 1024, NSLOT = 3, REM = 5, NKS = 4, NBLK = 2;
  const int tid = opaque_tid(), wid = __builtin_amdgcn_readfirstlane(tid >> 6), lane = tid & 63, r = lane & 31, hh = lane >> 5;
  const int q0 = qb * 256, qw = q0 + 32 * wid, myq = qw + r;
  const float c = a.sl2, tau = 8.0f / a.sl2;
  int lo = 4 * qb - 2; if (lo < 0) lo = 0;
  const int hi = 4 * (qb + 1);
  const int last_w = (qw + 31) >> 6, first_w = (qw > 127 ? qw - 127 : 0) >> 6;
#pragma unroll
  for (int j = 0; j < NSLOT; ++j) {
    const int ch_ = 8 * j + wid;
    if (j < NSLOT - 1 || wid < REM) {
      const char* sp; unsigned sst;
      if (ch_ < KCH) { const int p = ch_ * 64 + lane, row = p / 9, g = p - row * 9;
        sp = (const char*)(a.k + (size_t)row * a.ldk + 8 * (g < 8 ? g : 0)); sst = (unsigned)(128 * a.ldk); }
      else { const int p = (ch_ - KCH) * 64 + lane, row = (p / 12) & 63, g = p - (p / 12) * 12;
        sp = (const char*)(a.v + (size_t)row * a.ldv + 8 * (g < 8 ? g : 0)); sst = (unsigned)(128 * a.ldv); }
      for (int kt = lo; kt < hi; ++kt)
        __builtin_amdgcn_global_load_lds((const unsigned*)(sp + (size_t)kt * sst), (LAS unsigned*)(lds + (kt - lo) * TILE + ch_ * 1024), 16, 0, 0);
    }
  }
  wait_vmcnt<0>();
  raw_barrier();
  const int i16 = lane & 15, q4 = i16 >> 2, p4 = i16 & 3, grp = (lane >> 4) & 1;
  for (int h4 = 0; h4 < 4; ++h4) {
    bf16x8 qf[NKS];
#pragma unroll
    for (int ks = 0; ks < NKS; ++ks) qf[ks] = *(const bf16x8*)(a.q + (size_t)myq * a.ldq + h4 * 64 + 16 * ks + 8 * hh);
    f32x16 O[NBLK];
#pragma unroll
    for (int bl = 0; bl < NBLK; ++bl)
#pragma unroll
      for (int i = 0; i < 16; ++i) O[bl][i] = 0.f;
    float m = sinks4[h4] / a.sl2;
    float l0 = (hh == 0) ? 1.f : 0.f, l1 = 0.f;
    for (int kt = first_w; kt <= last_w; ++kt) {
      LAS unsigned char* Kl = lds + (kt - lo) * TILE;
      f32x16 s[2];
      bf16x8 kf[2][NKS];
#pragma unroll
      for (int kb = 0; kb < 2; ++kb)
#pragma unroll
        for (int ks = 0; ks < NKS; ++ks) kf[kb][ks] = *(const LAS bf16x8*)(Kl + (32 * kb + r) * KSTR + (16 * ks + 8 * hh) * 2);
#pragma unroll
      for (int kb = 0; kb < 2; ++kb)
#pragma unroll
        for (int i = 0; i < 16; ++i) s[kb][i] = 0.f;
#pragma unroll
      for (int ks = 0; ks < NKS; ++ks)
#pragma unroll
        for (int kb = 0; kb < 2; ++kb) s[kb] = __builtin_amdgcn_mfma_f32_32x32x16_bf16(kf[kb][ks], qf[ks], s[kb], 0, 0, 0);
      const int key0 = kt * 64;
#pragma unroll
      for (int kb = 0; kb < 2; ++kb)
#pragma unroll
        for (int i = 0; i < 16; ++i) {
          const int key = key0 + 32 * kb + (i & 3) + 8 * (i >> 2) + 4 * hh;
          const bool valid = (key <= myq) && (myq - key < 128);
          s[kb][i] = valid ? s[kb][i] : -1e30f;
        }
      float mx = fmaxf(s[0][0], s[1][0]);
#pragma unroll
      for (int i = 1; i < 16; ++i) mx = fmaxf(fmaxf(mx, s[0][i]), s[1][i]);
      mx = half_max(mx);
      if (__builtin_amdgcn_ballot_w64(mx > m + tau) != 0ull) {
        const float mnew = fmaxf(m, mx);
        const float alpha = fast_exp2((m - mnew) * c);
        m = mnew; l0 *= alpha; l1 *= alpha;
#pragma unroll
        for (int bl = 0; bl < NBLK; ++bl)
#pragma unroll
          for (int i = 0; i < 16; ++i) O[bl][i] *= alpha;
      }
      const float nmc = -m * c;
      bf16x8 pf[2][2];
#pragma unroll
      for (int kb = 0; kb < 2; ++kb)
#pragma unroll
        for (int s2 = 0; s2 < 2; ++s2) {
          float pv[8];
#pragma unroll
          for (int e = 0; e < 8; ++e) pv[e] = fast_exp2(__builtin_fmaf(s[kb][8 * s2 + e], c, nmc));
          l0 += (pv[0] + pv[4]) + (pv[2] + pv[6]); l1 += (pv[1] + pv[5]) + (pv[3] + pv[7]);
          u32x4 w;
          w.x = pk2(pv[0], pv[1]); w.y = pk2(pv[2], pv[3]); w.z = pk2(pv[4], pv[5]); w.w = pk2(pv[6], pv[7]);
          pf[kb][s2] = __builtin_bit_cast(bf16x8, w);
        }
      LAS unsigned char* Vl = Kl + KCH * 1024 + (4 * hh + q4) * VSTR + (16 * grp) * 2 + 8 * p4;
#pragma unroll
      for (int st = 0; st < 4; ++st)
#pragma unroll
        for (int bl = 0; bl < NBLK; ++bl) {
          LAS unsigned char* ad = Vl + (16 * st) * VSTR + (32 * bl) * 2;
          const s16x4 lo_ = __builtin_amdgcn_ds_read_tr16_b64_v4i16((LAS s16x4*)ad);
          const s16x4 hi_ = __builtin_amdgcn_ds_read_tr16_b64_v4i16((LAS s16x4*)(ad + 8 * VSTR));
          const bf16x8 vf = __builtin_shufflevector(lo_, hi_, 0, 1, 2, 3, 4, 5, 6, 7);
          O[bl] = __builtin_amdgcn_mfma_f32_32x32x16_bf16(vf, pf[st >> 1][st & 1], O[bl], 0, 0, 0);
        }
    }
    const float l = half_sum(l0 + l1);
    const float inv = 1.f / l;
#pragma unroll
    for (int bl = 0; bl < NBLK; ++bl)
      epi_block(O[bl], inv, hh, a.gate + (size_t)myq * a.ldg + h4 * 64 + 32 * bl, a.out + (size_t)myq * a.ldo + h4 * 64 + 32 * bl);
  }
  __syncthreads();
}

DI bool team_item(int G, int c, int n, int& bh, int& qb) {
  if (G == 256) {
    const int x = c & 7, li = c >> 3, t = li >> 3, i = li & 7;
    bh = x + 8 * (4 * t + n);
    const int j = (i + 4) & 7;
    qb = (n == 0) ? i : (n == 1) ? 7 - i : (n == 2) ? j : 7 - j;
    return true;
  }
  const int idx = n * G + ((n & 1) ? (G - 1 - c) : c);
  if (idx >= 1024) return false;
  qb = 7 - idx / 128; bh = idx % 128;
  return true;
}

DI int snake_idx(int round, int G, int c) { return round * G + ((round & 1) ? (G - 1 - c) : c); }

DI void attn_even(const Params& p, LAS unsigned char* lds, int i) {
  const int G = gridDim.x, c = blockIdx.x;
  unsigned char* ws = p.ws;
  const bf16_t* z = (const bf16_t*)(ws + WS_ZBUF);
  const bf16_t* qb_ = (const bf16_t*)(ws + WS_QBUF);
  const bf16_t* kv = (const bf16_t*)(ws + WS_HBUF);
  bf16_t* ob = (bf16_t*)(ws + WS_OBUF);
  for (int rd = 0; rd * G < 1024; ++rd) {
    int qb, bh;
    if (!team_item(G, c, rd, bh, qb)) continue;
    const int b = bh >> 3, hd = bh & 7;
    AttnArgs a;
    a.q = qb_ + (size_t)b * SEQ * 768 + hd * 96; a.ldq = 768;
    a.k = kv + (size_t)b * SEQ * 1024 + hd * 128; a.ldk = 1024;
    a.k2 = z + (size_t)b * SEQ * 2560 + 2432; a.ldk2 = 2560;
    a.v = kv + (size_t)b * SEQ * 1024 + hd * 128 + 64; a.ldv = 1024;
    a.out = ob + (size_t)b * SEQ * 1024 + hd * 64; a.ldo = 1024;
    a.gate = z + (size_t)b * SEQ * 2560 + 768 + hd * 64; a.ldg = 2560;
    a.fcum = nullptr; a.sl2 = 0.10206207261596577f * LOG2E; a.sink = 0.f;
    attn_item<96, 64, 0>(lds, a, qb);
  }
  for (int it = c; it < 256; it += G) {
    const int b = it >> 4, kvh = (it >> 3) & 1, qb = it & 7;
    AttnArgs a;
    const bf16_t* zb = z + (size_t)b * SEQ * 2560;
    a.q = zb + kvh * 256; a.ldq = 2560;
    a.k = zb + 512 + kvh * 64; a.ldk = 2560; a.k2 = nullptr; a.ldk2 = 0;
    a.v = zb + 640 + kvh * 64; a.ldv = 2560;
    a.out = ob + (size_t)b * SEQ * 1024 + 512 + kvh * 256; a.ldo = 1024;
    a.gate = zb + 768 + 512 + kvh * 256; a.ldg = 2560;
    a.fcum = nullptr; a.sl2 = 0.125f * LOG2E; a.sink = 0.f;
    float sk[4];
#pragma unroll
    for (int h4 = 0; h4 < 4; ++h4) sk[h4] = p.ev_sinks[i * 8 + kvh * 4 + h4] * LOG2E;
    swa_item(lds, a, sk, qb);
  }
}

DI void attn_odd(const Params& p, LAS unsigned char* lds, int layer) {
  const int G = gridDim.x, c = blockIdx.x;
  unsigned char* ws = p.ws;
  const bf16_t* z = (const bf16_t*)(ws + WS_ZBUF);
  bf16_t* od = (bf16_t*)(ws + WS_HBUF);
  bf16_t* ob = (bf16_t*)(ws + WS_OBUF);
  {
    for (int rd = 0; rd * G < 512; ++rd) {
      int qb, bh2;
      if (G == 256) { const int x = c & 7, li = c >> 3, t = li >> 3, i = li & 7; bh2 = x + 8 * (2 * t + rd); qb = (rd == 0) ? i : 7 - i; }
      else { const int idx = snake_idx(rd, G, c); if (idx >= 512) continue; qb = 7 - idx / 64; bh2 = idx % 64; }
      const int b = bh2 >> 2, h = bh2 & 3;
      const bf16_t* zb = z + (size_t)b * SEQ * 4096;
      for (int mp = 0; mp < 2; ++mp) {
        const int j = 2 * h + mp;
        AttnArgs a;
        a.q = zb + j * 64; a.ldq = 4096;
        a.k = zb + 512 + j * 64; a.ldk = 4096; a.k2 = nullptr; a.ldk2 = 0;
        a.v = zb + 1024 + h * 128; a.ldv = 4096;
        a.out = od + (size_t)b * SEQ * 1024 + j * 128; a.ldo = 1024;
        a.gate = nullptr; a.ldg = 0;
        a.fcum = nullptr; a.sl2 = 0.125f * LOG2E; a.sink = 0.f;
#ifndef SKIP_DIFF
        attn_item<64, 128, 0>(lds, a, qb);
#endif
      }
      __builtin_amdgcn_fence(__ATOMIC_SEQ_CST, "workgroup");
      asm volatile("s_waitcnt vmcnt(0)" ::: "memory");
      const int tid2 = opaque_tid(), lane = tid2 & 63, wid = tid2 >> 6, li_ = layer >> 1;
      const float* lp = p.od_lambda + li_ * 256;
      const float s1 = wave_sum(lp[lane] * lp[64 + lane]), s2 = wave_sum(lp[128 + lane] * lp[192 + lane]);
      const float lam_init = 0.8f - 0.6f * fast_exp2(-0.3f * LOG2E * (float)layer);
      const float lam = fast_exp2(s1 * LOG2E) - fast_exp2(s2 * LOG2E) + lam_init;
      const int rsub = lane >> 4, dv = (lane & 15) * 8;
      float sub[8];
#pragma unroll
      for (int e = 0; e < 8; ++e) sub[e] = p.od_subln[li_ * 128 + dv + e] * (1.f - lam_init);
      const size_t row0 = (size_t)b * SEQ + qb * 256 + 32 * wid;
#pragma unroll 2
      for (int rr = 0; rr < 8; ++rr) {
        const size_t row = row0 + 4 * rr + rsub;
        const u32x4 va = *(const u32x4*)(od + row * 1024 + (2 * h) * 128 + dv);
        const u32x4 vb = *(const u32x4*)(od + row * 1024 + (2 * h + 1) * 128 + dv);
        const u32x4 vg = *(const u32x4*)(z + row * 4096 + 3072 + h * 128 + dv);
        float d[8]; float ss = 0.f;
#pragma unroll
        for (int e = 0; e < 4; ++e) { d[2 * e] = bflo(va[e]) - lam * bflo(vb[e]); d[2 * e + 1] = bfhi(va[e]) - lam * bfhi(vb[e]); ss += d[2 * e] * d[2 * e] + d[2 * e + 1] * d[2 * e + 1]; }
        ss += __shfl_xor(ss, 1); ss += __shfl_xor(ss, 2); ss += __shfl_xor(ss, 4); ss += __shfl_xor(ss, 8);
        const float rs = rsqrtf(ss * (1.f / 128.f) + EPS);
        u32x4 w;
#pragma unroll
        for (int e = 0; e < 4; ++e) {
          const float o0 = d[2 * e] * rs * sub[2 * e] * silu_f(bflo(vg[e])), o1 = d[2 * e + 1] * rs * sub[2 * e + 1] * silu_f(bfhi(vg[e]));
          w[e] = pk2(o0, o1);
        }
        *(u32x4*)(ob + row * 1024 + h * 128 + dv) = w;
      }
    }
  }
  for (int rd = 0; rd * G < 1024; ++rd) {
    int qb, bh;
    if (!team_item(G, c, rd, bh, qb)) continue;
    const int b = bh >> 3, hd = bh & 7;
    AttnArgs a;
    const bf16_t* zb = z + (size_t)b * SEQ * 4096;
    a.q = zb + 1536 + hd * 64; a.ldq = 4096;
    a.k = zb + 2048 + hd * 64; a.ldk = 4096; a.k2 = nullptr; a.ldk2 = 0;
    a.v = zb + 2560 + hd * 64; a.ldv = 4096;
    a.out = ob + (size_t)b * SEQ * 1024 + 512 + hd * 64; a.ldo = 1024;
    a.gate = zb + 3072 + 512 + hd * 64; a.ldg = 4096;
    a.fcum = (const float*)(ws + WS_FCUM) + (size_t)bh * SEQ; a.sl2 = 0.125f * LOG2E; a.sink = 0.f;
#ifndef SKIP_FOX
    attn_item<64, 64, 2>(lds, a, qb);
#endif
  }
}

DI void diff_combine(const Params& p, int layer) {
  const int tid = opaque_tid(), lane = tid & 63, wid = tid >> 6;
  const int gw = blockIdx.x * 8 + wid, nw = gridDim.x * 8;
  const int i = layer >> 1;
  unsigned char* ws = p.ws;
  const bf16_t* od = (const bf16_t*)(ws + WS_HBUF);
  const bf16_t* z = (const bf16_t*)(ws + WS_ZBUF);
  bf16_t* ob = (bf16_t*)(ws + WS_OBUF);
  const float* lp = p.od_lambda + i * 256;
  const float s1 = wave_sum(lp[lane] * lp[64 + lane]), s2 = wave_sum(lp[128 + lane] * lp[192 + lane]);
  const float lam_init = 0.8f - 0.6f * expf(-0.3f * (float)layer);
  const float lam = expf(s1) - expf(s2) + lam_init;
  const int hd = lane >> 4, dv = (lane & 15) * 8;
  float sub[8];
#pragma unroll
  for (int e = 0; e < 8; ++e) sub[e] = p.od_subln[i * 128 + dv + e] * (1.f - lam_init);
  for (int row = gw; row < T; row += nw) {
    const u32x4 a = *(const u32x4*)(od + (size_t)row * 1024 + (2 * hd) * 128 + dv);
    const u32x4 b = *(const u32x4*)(od + (size_t)row * 1024 + (2 * hd + 1) * 128 + dv);
    const u32x4 g = *(const u32x4*)(z + (size_t)row * 4096 + 3072 + hd * 128 + dv);
    float d[8]; float ss = 0.f;
#pragma unroll
    for (int e = 0; e < 4; ++e) { d[2 * e] = bflo(a[e]) - lam * bflo(b[e]); d[2 * e + 1] = bfhi(a[e]) - lam * bfhi(b[e]); ss += d[2 * e] * d[2 * e] + d[2 * e + 1] * d[2 * e + 1]; }
    ss += __shfl_xor(ss, 1); ss += __shfl_xor(ss, 2); ss += __shfl_xor(ss, 4); ss += __shfl_xor(ss, 8);
    const float rs = rsqrtf(ss * (1.f / 128.f) + EPS);
    u32x4 w;
#pragma unroll
    for (int e = 0; e < 4; ++e) {
      const float o0 = d[2 * e] * rs * sub[2 * e] * silu_f(bflo(g[e])), o1 = d[2 * e + 1] * rs * sub[2 * e + 1] * silu_f(bfhi(g[e]));
      w[e] = pk2(o0, o1);
    }
    *(u32x4*)(ob + (size_t)row * 1024 + hd * 128 + dv) = w;
  }
}


DI void grid_barrier(unsigned* ctr, unsigned& epoch) {
  asm volatile("s_waitcnt vmcnt(0)" ::: "memory");
  __syncthreads();
  epoch += 1;
  if (threadIdx.x == 0) {
    __builtin_amdgcn_fence(__ATOMIC_RELEASE, "agent");
    asm volatile("s_waitcnt vmcnt(0)" ::: "memory");
    __hip_atomic_fetch_add(ctr, 1u, __ATOMIC_RELAXED, __HIP_MEMORY_SCOPE_AGENT);
    const unsigned target = epoch * gridDim.x;
    while (__hip_atomic_load(ctr, __ATOMIC_RELAXED, __HIP_MEMORY_SCOPE_AGENT) < target) __builtin_amdgcn_s_sleep(1);
    __builtin_amdgcn_fence(__ATOMIC_ACQUIRE, "agent");
    asm volatile("s_waitcnt vmcnt(0)" ::: "memory");
  }
  __syncthreads();
}


#define XB_TMO      128
#define XB_XCNT(j)  (256  + 64 * (j))
#define XB_XSUB(j)  (1280 + 64 * (j))
#define XB_XGEN(j)  (2304 + 64 * (j))
#define XB_TOP      3328
#define XB_TOPGEN   3392
#define XCD_BAR_WORDS 3456
#define XB_SPIN_CAP (1u << 20)
DI unsigned xb_ld(unsigned* p) { return __hip_atomic_load(p, __ATOMIC_RELAXED, __HIP_MEMORY_SCOPE_AGENT); }
DI unsigned xb_add(unsigned* p, unsigned v) { return __hip_atomic_fetch_add(p, v, __ATOMIC_RELAXED, __HIP_MEMORY_SCOPE_AGENT); }
DI unsigned xb_xcc_id() { return (unsigned)__builtin_amdgcn_s_getreg((3 << 11) | 20) & 0xFu; }
#define XB_SPIN(cond, bar) do { unsigned _sp = 0; while (cond) { __builtin_amdgcn_s_sleep(1); \
    if ((++_sp & 255u) == 0u) { if (xb_ld(&(bar)[XB_TMO])) break; if (_sp > XB_SPIN_CAP) { atomicAdd(&(bar)[XB_TMO], 1u); break; } } } } while (0)
struct XcdBarrier { unsigned* bar; unsigned x; volatile LAS unsigned* st; };
DI void xcd_barrier_complete(unsigned* bar, unsigned x, unsigned& nloc, unsigned& nx) {
  const unsigned G = gridDim.x;
  unsigned sum, cnt, mine, sp = 0u;
  for (;;) {
    sum = 0u; cnt = 0u; mine = 0u;
#pragma unroll
    for (unsigned j = 0; j < 16; ++j) { const unsigned c = xb_ld(&bar[XB_XCNT(j)]); sum += c; cnt += (c > 0u) ? 1u : 0u; mine = (j == x) ? c : mine; }
    if (sum == G) break;
    __builtin_amdgcn_s_sleep(1);
    if ((++sp & 255u) == 0u) { if (xb_ld(&bar[XB_TMO])) break; if (sp > XB_SPIN_CAP) { atomicAdd(&bar[XB_TMO], 1u); break; } }
  }
  nloc = mine > 0u ? mine : 1u; nx = cnt > 0u ? cnt : 1u;
}
DI void xcd_barrier(const XcdBarrier& b) {
  asm volatile("s_waitcnt vmcnt(0)" ::: "memory");
  __syncthreads();
  if (threadIdx.x == 0) {
    unsigned* bar = b.bar;
    __builtin_amdgcn_s_waitcnt(0);
    unsigned nloc = b.st[0], nx = b.st[1];
    if (nloc == 0u) { xcd_barrier_complete(bar, b.x, nloc, nx); b.st[0] = nloc; b.st[1] = nx; }
    const unsigned old = xb_add(&bar[XB_XSUB(b.x)], 1u);
    const unsigned gen = old / nloc;
    if (old + 1u == (gen + 1u) * nloc) {
      __builtin_amdgcn_fence(__ATOMIC_RELEASE, "agent");
      asm volatile("s_waitcnt vmcnt(0)" ::: "memory");
      const unsigned og = xb_add(&bar[XB_TOP], 1u);
      const unsigned tg = og / nx;
      if (og + 1u == (tg + 1u) * nx) xb_add(&bar[XB_TOPGEN], 1u);
      else XB_SPIN(xb_ld(&bar[XB_TOPGEN]) == tg, bar);
      __builtin_amdgcn_fence(__ATOMIC_ACQUIRE, "agent");
      xb_add(&bar[XB_XGEN(b.x)], 1u);
      asm volatile("s_waitcnt vmcnt(0)" ::: "memory");
    } else {
      XB_SPIN(xb_ld(&bar[XB_XGEN(b.x)]) == gen, bar);
      __builtin_amdgcn_fence(__ATOMIC_ACQUIRE, "agent");
      asm volatile("s_waitcnt vmcnt(0)" ::: "memory");
    }
  }
  __syncthreads();
}

__global__ void __launch_bounds__(512) fwd_megakernel(Params p) {
  extern __shared__ __attribute__((aligned(16))) unsigned char lds_raw[];
  LAS unsigned char* lds = (LAS unsigned char*)lds_raw;
  cg::grid_group grid = cg::this_grid();
  unsigned char* ws = p.ws;
  const int G = gridDim.x, bid = blockIdx.x;
  const float* cosH = (const float*)(ws + WS_COSH); const float* sinH = (const float*)(ws + WS_SINH);
  const float* cosR = (const float*)(ws + WS_COSR); const float* sinR = (const float*)(ws + WS_SINR);

  unsigned* xbar = (unsigned*)(ws + WS_XBAR);
  if (bid == 0) { for (int w = threadIdx.x; w < XCD_BAR_WORDS; w += 512) __hip_atomic_store(xbar + w, 0u, __ATOMIC_RELAXED, __HIP_MEMORY_SCOPE_AGENT); }
  volatile LAS unsigned* xst = (volatile LAS unsigned*)(lds + LDS_BYTES_C - 16);
  if (threadIdx.x == 0) { xst[0] = 0u; xst[1] = 0u; }
#ifndef SKIP_PRO
  prologue(p, lds);
#endif
  grid.sync();
  XcdBarrier xb; xb.bar = xbar; xb.x = xb_xcc_id(); xb.st = xst;
  if (threadIdx.x == 0) (void)xb_add(&xbar[XB_XCNT(xb.x)], 1u);
#pragma unroll
  for (int layer = 0; layer < 4; ++layer) {
    const int i = layer >> 1; const bool odd = layer & 1;
#ifndef SKIP_ROW
    rowwise_phase(p, lds, layer - 1, layer);
#endif
    xcd_barrier(xb);
    {
#ifndef SKIP_SCAN
      if (odd) { for (int bh = bid; bh < 128; bh += G) fox_scan(p, lds, bh); }
#endif
      pg8::Gemm g; g.A = (const bf16_t*)(ws + WS_HBUF); g.lda = 1024; g.K = 1024; g.M = T;
      Epi e; e.out = (bf16_t*)(ws + WS_ZBUF); e.pin = nullptr; e.pslot = 0; e.nK = 0; e.qmode = 0; e.pout = odd ? nullptr : (float*)(ws + WS_PART); e.cosH = cosH; e.sinH = sinH; e.cosR = cosR; e.sinR = sinR;
      if (!odd) { g.Bt = (const bf16_t*)(ws + WS_WEVIN + i * SZ_WEVIN); g.N = 2560; e.ldc = 2560; e.rope64_end = 640; e.rope32_lo = 2432; e.rope32_hi = 2464; }
      else { g.Bt = (const bf16_t*)(ws + WS_WODIN + i * SZ_WODIN); g.N = 4096; e.ldc = 4096; e.rope64_end = 1024; e.rope32_lo = 0; e.rope32_hi = 0; }
      pg8::StaticOrder S; S.init(g.M, g.N, G, bid);
#ifndef SKIP_G1
      pg8::gemm_phase<Epi>(lds, g, S, e);
#endif
    }
    xcd_barrier(xb);
    if (!odd) {
      for (int which = 0; which < 2; ++which) {
        pg8::Gemm g; g.M = T; g.lda = 2560;
        Epi e; e.rope64_end = 0; e.rope32_lo = 0; e.rope32_hi = 0; e.cosH = cosH; e.sinH = sinH; e.cosR = cosR; e.sinR = sinR; e.pout = nullptr; e.pin = (const float*)(ws + WS_PART);
        if (which == 0) { g.A = (const bf16_t*)(ws + WS_ZBUF) + 1792; g.Bt = (const bf16_t*)(ws + WS_WUQ + i * SZ_WUQ); g.N = 768; g.K = 384;
          e.out = (bf16_t*)(ws + WS_QBUF); e.ldc = 768; e.qmode = 1; e.pslot = 0; e.nK = 384; }
        else { g.A = (const bf16_t*)(ws + WS_ZBUF) + 2176; g.Bt = (const bf16_t*)(ws + WS_WUKV + i * SZ_WUKV); g.N = 1024; g.K = 256;
          e.out = (bf16_t*)(ws + WS_HBUF); e.ldc = 1024; e.qmode = 0; e.pslot = 12; e.nK = 256; }
        pg8::StaticOrder S; S.init(g.M, g.N, G, bid);
#ifndef SKIP_G2
        pg8::gemm_phase<Epi>(lds, g, S, e);
#endif
      }
      xcd_barrier(xb);
#ifndef SKIP_ATTE
      attn_even(p, lds, i);
#endif
      xcd_barrier(xb);
    } else {
#ifndef SKIP_ATTO
      attn_odd(p, lds, layer);
#endif
      xcd_barrier(xb);
    }
    {
      pg8::Gemm g; g.A = (const bf16_t*)(ws + WS_OBUF); g.lda = 1024; g.K = 1024; g.M = T; g.N = 1024;
      g.Bt = (const bf16_t*)(ws + (odd ? WS_WODOUT : WS_WEVOUT) + i * SZ_WOUT);
      Epi e; e.out = (bf16_t*)(ws + WS_HBUF); e.ldc = 1024; e.pin = nullptr; e.pslot = 0; e.pout = nullptr; e.nK = 0; e.qmode = 0; e.rope64_end = 0; e.rope32_lo = 0; e.rope32_hi = 0;
      e.cosH = cosH; e.sinH = sinH; e.cosR = cosR; e.sinR = sinR;
      pg8::StaticOrder S; S.init(g.M, g.N, G, bid);
#ifndef SKIP_G3
      pg8::gemm_phase<Epi>(lds, g, S, e);
#endif
    }
    xcd_barrier(xb);
  }
#ifndef SKIP_ROW
  rowwise_phase(p, lds, 3, 4);
#endif
}

constexpr int LDS_BYTES = 155648;
static_assert(LDS_BYTES == LDS_BYTES_C, "LDS size mismatch");

extern "C" void kernel_launch(void* const* d_in, const int* in_sizes, int n_in, void* d_out, int out_size, void* d_ws, size_t ws_size, hipStream_t stream) {
  static int grid_blocks = 0;
  if (grid_blocks == 0) {
    int dev = 0, cus = 0, per_cu = 0;
    if (hipGetDevice(&dev) != hipSuccess || hipDeviceGetAttribute(&cus, hipDeviceAttributeMultiprocessorCount, dev) != hipSuccess) { fprintf(stderr, "device query failed\n"); grid_blocks = -1; return; }
    if (hipFuncSetAttribute((const void*)fwd_megakernel, hipFuncAttributeMaxDynamicSharedMemorySize, LDS_BYTES) != hipSuccess) { fprintf(stderr, "hipFuncSetAttribute failed\n"); grid_blocks = -1; return; }
    if (hipOccupancyMaxActiveBlocksPerMultiprocessor(&per_cu, (const void*)fwd_megakernel, 512, LDS_BYTES) != hipSuccess || per_cu < 1) { fprintf(stderr, "occupancy query: %d\n", per_cu); per_cu = 1; }
    (void)hipGetLastError();
    grid_blocks = cus;
    if (ws_size < WS_END) { fprintf(stderr, "workspace too small: %zu < %zu\n", ws_size, (size_t)WS_END); grid_blocks = -1; return; }
  }
  if (grid_blocks < 0) return;
  Params p{};
  const float** fp = (const float**)&p;
  for (int i = 0; i < 18; ++i) fp[i] = (const float*)d_in[i];
  p.out = (float*)d_out; p.ws = (unsigned char*)d_ws;
  void* args[] = {&p};
  hipError_t e = hipLaunchCooperativeKernel((const void*)fwd_megakernel, dim3(grid_blocks), dim3(512), args, LDS_BYTES, stream);
  if (e != hipSuccess) fprintf(stderr, "cooperative launch failed: %s (grid %d)\n", hipGetErrorString(e), grid_blocks);
}
```

```cpp
#include <hip/hip_runtime.h>
#include <hip/hip_cooperative_groups.h>
#include <cstdio>
#include <type_traits>
namespace cg = cooperative_groups;

#define DI __device__ __forceinline__
#define LAS __attribute__((address_space(3)))
typedef unsigned short bf16_t;
typedef short bf16x8 __attribute__((ext_vector_type(8)));
typedef short s16x4 __attribute__((ext_vector_type(4)));
typedef float f32x2 __attribute__((ext_vector_type(2)));
typedef float f32x4 __attribute__((ext_vector_type(4)));
typedef float f32x16 __attribute__((ext_vector_type(16)));
typedef unsigned u32x2 __attribute__((ext_vector_type(2)));
typedef unsigned u32x4 __attribute__((ext_vector_type(4)));
typedef __bf16 bf16x2_t __attribute__((ext_vector_type(2)));

constexpr int T = 32768, DM = 1024, NB = 16, SEQ = 2048;
constexpr float LOG2E = 1.4426950408889634f;
constexpr float EPS = 1e-6f;
constexpr int LDS_BYTES_C = 155648;

constexpr size_t SZ_WEVIN = 2560ull * 1024 * 2, SZ_WODIN = 4096ull * 1024 * 2, SZ_WUQ = 768ull * 384 * 2, SZ_WUKV = 1024ull * 256 * 2, SZ_WOUT = 1024ull * 1024 * 2;
constexpr size_t WS_WEVIN = 0;
constexpr size_t WS_WODIN = WS_WEVIN + 2 * SZ_WEVIN;
constexpr size_t WS_WUQ = WS_WODIN + 2 * SZ_WODIN;
constexpr size_t WS_WUKV = WS_WUQ + 2 * SZ_WUQ;
constexpr size_t WS_WEVOUT = WS_WUKV + 2 * SZ_WUKV;
constexpr size_t WS_WODOUT = WS_WEVOUT + 2 * SZ_WOUT;
constexpr size_t WS_MOD = WS_WODOUT + 2 * SZ_WOUT;
constexpr size_t WS_COSH = WS_MOD + 4ull * 16 * 3072 * 4;
constexpr size_t WS_SINH = WS_COSH + 2048ull * 32 * 4;
constexpr size_t WS_COSR = WS_SINH + 2048ull * 32 * 4;
constexpr size_t WS_SINR = WS_COSR + 2048ull * 16 * 4;
constexpr size_t WS_LOGF = WS_SINR + 2048ull * 16 * 4;
constexpr size_t WS_FCUM = WS_LOGF + (size_t)T * 8 * 4;
constexpr size_t WS_HBUF = (WS_FCUM + (size_t)T * 8 * 4 + 4095) & ~(size_t)4095;
constexpr size_t WS_OBUF = WS_HBUF + (size_t)T * 1024 * 2;
constexpr size_t WS_ZBUF = WS_OBUF + (size_t)T * 1024 * 2;
constexpr size_t WS_QBUF = WS_ZBUF + (size_t)T * 2560 * 2;
constexpr size_t WS_BAR = WS_ZBUF + (size_t)T * 4096 * 2;
constexpr size_t WS_PART = WS_BAR + 256;
constexpr size_t WS_XBAR = (WS_PART + (size_t)T * 20 * 4 + 4095) & ~(size_t)4095;
constexpr size_t WS_XBF_PRE = WS_XBAR + 16384;
constexpr size_t WS_XBF = WS_XBF_PRE;
constexpr size_t WS_END = WS_XBF + (size_t)T * 1024 * 2;

struct Params {
  const float *x, *c, *w_ada, *b_ada, *g_pre, *g_post, *ev_w_in, *ev_q_norm, *ev_kv_norm, *ev_w_uq, *ev_w_ukv, *ev_sinks, *ev_w_out,
      *od_w_in, *od_forget_bias, *od_lambda, *od_subln, *od_w_out;
  float* out;
  unsigned char* ws;
};

DI int opaque_tid() { int t = threadIdx.x; asm volatile("" : "+v"(t)); return t; }
DI float bflo(unsigned u) { return __uint_as_float(u << 16); }
DI float bfhi(unsigned u) { return __uint_as_float(u & 0xffff0000u); }
DI unsigned pk2(float lo, float hi) { f32x2 f = {lo, hi}; bf16x2_t b = __builtin_convertvector(f, bf16x2_t); return __builtin_bit_cast(unsigned, b); }
DI bf16_t f2bf(float f) { return (bf16_t)(pk2(f, 0.f) & 0xffffu); }
DI float fast_exp2(float x) { return __builtin_amdgcn_exp2f(x); }
DI float silu_f(float x) { return x * __builtin_amdgcn_rcpf(1.f + fast_exp2(-x * LOG2E)); }
template <int CTRL> DI float dpp_mov(float v) { return __builtin_bit_cast(float, __builtin_amdgcn_update_dpp(0, __builtin_bit_cast(int, v), CTRL, 0xf, 0xf, false)); }
DI float wave_sum(float v) {
  v += dpp_mov<0xB1>(v);
  v += dpp_mov<0x4E>(v);
  v += dpp_mov<0x141>(v);
  v += dpp_mov<0x140>(v);
  { const unsigned u = __float_as_uint(v); auto r = __builtin_amdgcn_permlane16_swap(u, u, false, false); v = __uint_as_float(r[0]) + __uint_as_float(r[1]); }
  { const unsigned u = __float_as_uint(v); auto r = __builtin_amdgcn_permlane32_swap(u, u, false, false); v = __uint_as_float(r[0]) + __uint_as_float(r[1]); }
  return v;
}

namespace pg8 {
constexpr int BM = 256, BK = 64, HALF = 128, HTB = HALF * BK * 2, STAGE_BYTES = 8 * HTB, NXCD = 8, WGM = 8;
DI int lds_byte(int r, int c) { const int st = (r >> 4) * 2 + (c >> 5), rr = r & 15, cc = c & 31, ob = rr * 64 + cc * 2; return st * 1024 + (ob ^ (((ob >> 9) & 1) << 5)); }
DI void stage_rc(int b, int& R, int& C) { const int st = b / 1024, sb = b % 1024, swz = sb ^ (((sb >> 9) & 1) << 5); R = (st >> 1) * 16 + swz / 64; C = (st & 1) * 32 + (swz % 64) / 2; }
DI int perm32(int rho) { const int n = rho >> 4, i = rho & 15; return 8 * (i >> 2) + 4 * n + (i & 3); }
struct Unit { int pm, pn; };
struct Gemm { const bf16_t* A; const bf16_t* Bt; int M, N, K, lda; };
struct StaticOrder {
  int nM, nN, nwg, G, c;
  DI void init(int M, int N, int G_, int c_) { nM = M / BM; nN = N / BM; nwg = nM * nN; G = G_; c = c_; }
  DI bool next(int i, Unit& u) const {
    const long L = (long)i * G + c; if (L >= nwg) return false;
    int wgid = (int)L; { const int q = nwg / NXCD, r = nwg % NXCD, xcd = wgid % NXCD, off = wgid / NXCD; wgid = (xcd < r ? xcd * (q + 1) : r * (q + 1) + (xcd - r) * q) + off; }
    const int nig = WGM * nN, gid = wgid / nig, fm = gid * WGM, gsz = (nM - fm) < WGM ? (nM - fm) : WGM;
    u.pm = fm + ((wgid % nig) % gsz); u.pn = (wgid % nig) / gsz; return true;
  }
};

template <class Epi>
DI void gemm_phase(LAS unsigned char* lds, const Gemm g, const StaticOrder& S, const Epi& E) {
  const int tid = opaque_tid(), wid = __builtin_amdgcn_readfirstlane(tid >> 6), lane = tid & 63, wr = wid >> 2, wc = wid & 3, fr = lane & 15, fq = lane >> 4;
  const int K = g.K, nt = K / BK, lda = g.lda;
  unsigned voffA[2], voffB[2];
#pragma unroll
  for (int i = 0; i < 2; ++i) { int R, C; stage_rc(tid * 16 + i * 8192, R, C); const int Rb = (R & ~31) + perm32(R & 31);
    voffA[i] = (unsigned)(R * lda + C) * 2u; voffB[i] = (unsigned)(Rb * K + C) * 2u; }
  const size_t kstep = (size_t)(BK * 2);
  const size_t hstepA = (size_t)HALF * lda * 2, hstepB = (size_t)HALF * K * 2;
  const size_t tstepA = 2 * hstepA, tstepB = 2 * hstepB;
  const unsigned ldsw = (unsigned)wid * 1024u;
  const int aoff = lds_byte(wr * 64 + fr, fq * 8), boff = lds_byte(wc * 32 + fr, fq * 8);
#define PG8_SA(b, h) (((b) * 2 + (h)) * HTB)
#define PG8_SB(b, h) ((4 + (b) * 2 + (h)) * HTB)
#define PG8_STAGE(bufoff, gbase, voff) do { _Pragma("unroll") for (int _i = 0; _i < 2; ++_i) \
    __builtin_amdgcn_global_load_lds((const unsigned*)((const char*)(gbase) + (voff)[_i]), (LAS unsigned*)(lds + (bufoff) + ldsw + _i * 8192), 16, 0, 0); } while (0)
#define PG8_LDA(dst, b, h) do { _Pragma("unroll") for (int m = 0; m < 4; ++m) _Pragma("unroll") for (int k = 0; k < 2; ++k) dst[m][k] = *(const LAS bf16x8*)(lds + PG8_SA(b, h) + aoff + m * 2048 + k * 1024); } while (0)
#define PG8_LDB(dst, b, h) do { _Pragma("unroll") for (int n = 0; n < 2; ++n) _Pragma("unroll") for (int k = 0; k < 2; ++k) dst[n][k] = *(const LAS bf16x8*)(lds + PG8_SB(b, h) + boff + n * 2048 + k * 1024); } while (0)
#define PG8_MMA(ai, bj, At, Bt) do { __builtin_amdgcn_s_setprio(1); _Pragma("unroll") for (int m = 0; m < 4; ++m) _Pragma("unroll") for (int n = 0; n < 2; ++n) _Pragma("unroll") for (int k = 0; k < 2; ++k) \
    acc[ai][bj][m][n] = __builtin_amdgcn_mfma_f32_16x16x32_bf16(Bt[n][k], At[m][k], acc[ai][bj][m][n], 0, 0, 0); __builtin_amdgcn_s_setprio(0); } while (0)
#define PG8_WAIT_V(n) asm volatile("s_waitcnt vmcnt(" #n ")" ::: "memory")
#define PG8_WAIT_L(n) asm volatile("s_waitcnt lgkmcnt(" #n ")" ::: "memory")
#define PG8_BAR __builtin_amdgcn_s_barrier()
#define PG8_SCHED __builtin_amdgcn_sched_barrier(0)
  Unit cur, nxt; int ui = 0;
  if (!S.next(0, cur)) return;
  f32x4 acc[2][2][4][2];
#pragma unroll
  for (int a = 0; a < 2; ++a)
#pragma unroll
    for (int b = 0; b < 2; ++b)
#pragma unroll
      for (int m = 0; m < 4; ++m)
#pragma unroll
        for (int n = 0; n < 2; ++n) acc[a][b][m][n] = (f32x4){0.f, 0.f, 0.f, 0.f};
  bf16x8 At[4][2], B0[2][2], B1[2][2];
  const char* cA = (const char*)g.A + (size_t)cur.pm * tstepA; const char* cB = (const char*)g.Bt + (size_t)cur.pn * tstepB;
  PG8_STAGE(PG8_SB(0, 0), cB, voffB); PG8_STAGE(PG8_SA(0, 0), cA, voffA); PG8_STAGE(PG8_SB(0, 1), cB + hstepB, voffB); PG8_STAGE(PG8_SA(0, 1), cA + hstepA, voffA);
  if (wr == 1) PG8_BAR;
  PG8_WAIT_V(4); PG8_BAR;
  PG8_STAGE(PG8_SB(1, 0), cB + kstep, voffB); PG8_STAGE(PG8_SA(1, 0), cA + kstep, voffA); PG8_STAGE(PG8_SB(1, 1), cB + hstepB + kstep, voffB);
  PG8_WAIT_V(6); PG8_BAR;
  for (;;) {
    const bool has_next = S.next(ui + 1, nxt);
    const char* nA = has_next ? (const char*)g.A + (size_t)nxt.pm * tstepA : cA; const char* nB = has_next ? (const char*)g.Bt + (size_t)nxt.pn * tstepB : cB;
    for (int t = 0; t < nt; t += 2) {
      const bool last = (t == nt - 2);
      const char* a1 = cA + (size_t)(t + 1) * kstep;
      const char* a2 = last ? nA : cA + (size_t)(t + 2) * kstep; const char* b2 = last ? nB : cB + (size_t)(t + 2) * kstep;
      const char* a3 = a2 + kstep; const char* b3 = b2 + kstep;
      PG8_LDB(B0, 0, 0); PG8_SCHED; PG8_LDA(At, 0, 0); PG8_STAGE(PG8_SA(1, 1), a1 + hstepA, voffA);
      PG8_WAIT_L(8); PG8_BAR; PG8_WAIT_L(0); PG8_MMA(0, 0, At, B0); PG8_BAR; PG8_SCHED;
      PG8_LDB(B1, 0, 1); PG8_STAGE(PG8_SB(0, 0), b2, voffB);
      PG8_BAR; PG8_WAIT_L(0); PG8_MMA(0, 1, At, B1); PG8_BAR;
      PG8_LDA(At, 0, 1); PG8_STAGE(PG8_SA(0, 0), a2, voffA);
      PG8_BAR; PG8_WAIT_L(0); PG8_MMA(1, 0, At, B0); PG8_BAR; PG8_SCHED;
      PG8_STAGE(PG8_SB(0, 1), b2 + hstepB, voffB);
      PG8_WAIT_V(6); PG8_BAR; PG8_MMA(1, 1, At, B1); PG8_BAR;
      PG8_LDB(B0, 1, 0); PG8_SCHED; PG8_LDA(At, 1, 0); PG8_STAGE(PG8_SA(0, 1), a2 + hstepA, voffA);
      PG8_WAIT_L(8); PG8_BAR; PG8_WAIT_L(0); PG8_MMA(0, 0, At, B0); PG8_BAR; PG8_SCHED;
      PG8_LDB(B1, 1, 1); PG8_STAGE(PG8_SB(1, 0), b3, voffB);
      PG8_BAR; PG8_WAIT_L(0); PG8_MMA(0, 1, At, B1); PG8_BAR;
      PG8_LDA(At, 1, 1); PG8_STAGE(PG8_SA(1, 0), a3, voffA);
      PG8_BAR; PG8_WAIT_L(0); PG8_MMA(1, 0, At, B0); PG8_BAR; PG8_SCHED;
      PG8_STAGE(PG8_SB(1, 1), b3 + hstepB, voffB);
      PG8_WAIT_V(6); PG8_BAR; PG8_MMA(1, 1, At, B1); PG8_BAR;
    }
    E(acc, cur, wr, wc, fr, fq);
    if (!has_next) break;
#pragma unroll
    for (int a = 0; a < 2; ++a)
#pragma unroll
      for (int b = 0; b < 2; ++b)
#pragma unroll
        for (int m = 0; m < 4; ++m)
#pragma unroll
          for (int n = 0; n < 2; ++n) acc[a][b][m][n] = (f32x4){0.f, 0.f, 0.f, 0.f};
    cur = nxt; cA = nA; cB = nB; ++ui;
  }
  PG8_WAIT_V(0);
  if (wr == 0) PG8_BAR;
  PG8_BAR;
#undef PG8_SA
#undef PG8_SB
#undef PG8_STAGE
#undef PG8_LDA
#undef PG8_LDB
#undef PG8_MMA
#undef PG8_WAIT_V
#undef PG8_WAIT_L
#undef PG8_BAR
#undef PG8_SCHED
}
}

struct Epi {
  bf16_t* out; int ldc;
  int rope64_end;
  int rope32_lo, rope32_hi;
  int qmode;
  const float* pin; int nK;
  int pslot;
  float* pout;
  const float *cosH, *sinH, *cosR, *sinR;
  DI void operator()(const f32x4 (&acc)[2][2][4][2], const pg8::Unit& u, int wr, int wc, int fr, int fq) const {
    const int row0 = u.pm * 256 + wr * 64 + fr;
    int rt[2];
#pragma unroll
    for (int bj = 0; bj < 2; ++bj) {
      const int cw = u.pn * 256 + bj * 128 + wc * 32;
      rt[bj] = 0;
      if (cw < rope64_end) rt[bj] = 1;
      else if (cw >= rope32_lo && cw < rope32_hi) rt[bj] = 2;
      else if (qmode && ((cw >> 5) % 3) == 2) rt[bj] = 2;
    }
    const int tt = rt[0] | rt[1];
    const float* ctab = (tt == 1) ? cosH + (16 * (wc & 1) + 4 * fq) : cosR + 4 * fq;
    const float* stab = (tt == 1) ? sinH + (16 * (wc & 1) + 4 * fq) : sinR + 4 * fq;
    const int tstride = (tt == 1) ? 32 : 16;
    int ps[2] = {-1, -1};
    if (pout) {
#pragma unroll
      for (int bj = 0; bj < 2; ++bj) { const int cw = u.pn * 256 + bj * 128 + wc * 32;
        if (cw >= 1792 && cw < 2432) ps[bj] = ((cw - 1792) >> 7) * 4 + wc; }
    }
#pragma unroll
    for (int ai = 0; ai < 2; ++ai) {
      f32x4 cv[4], sv[4]; float rs[4];
#pragma unroll
      for (int m = 0; m < 4; ++m) {
        const int row = row0 + ai * 128 + m * 16;
        if (tt) { const int pos = row & (SEQ - 1); cv[m] = *(const f32x4*)(ctab + pos * tstride); sv[m] = *(const f32x4*)(stab + pos * tstride); }
        rs[m] = 1.f;
        if (pin) { const f32x4 p0 = *(const f32x4*)(pin + (size_t)row * 20 + pslot), p1 = *(const f32x4*)(pin + (size_t)row * 20 + pslot + 4);
          float ss = ((p0[0] + p0[1]) + (p0[2] + p0[3])) + ((p1[0] + p1[1]) + (p1[2] + p1[3]));
          if (nK == 384) { const f32x4 p2 = *(const f32x4*)(pin + (size_t)row * 20 + pslot + 8); ss += (p2[0] + p2[1]) + (p2[2] + p2[3]); }
          rs[m] = rsqrtf(ss / (float)nK + EPS); }
      }
#pragma unroll
      for (int m = 0; m < 4; ++m) {
        const int row = row0 + ai * 128 + m * 16;
#pragma unroll
        for (int bj = 0; bj < 2; ++bj) {
          const int c0 = u.pn * 256 + bj * 128 + wc * 32 + 8 * fq;
          f32x4 v0 = acc[ai][bj][m][0] * rs[m], v1 = acc[ai][bj][m][1] * rs[m];
          if (ps[bj] >= 0) {
            float sq = (v0[0] * v0[0] + v0[1] * v0[1]) + (v0[2] * v0[2] + v0[3] * v0[3]) + (v1[0] * v1[0] + v1[1] * v1[1]) + (v1[2] * v1[2] + v1[3] * v1[3]);
            sq += __shfl_xor(sq, 16); sq += __shfl_xor(sq, 32);
            if (fq == 0) pout[(size_t)row * 20 + ps[bj]] = sq;
          }
          if (rt[bj]) {
            const f32x4 o1 = v0 * cv[m] - v1 * sv[m], o2 = v1 * cv[m] + v0 * sv[m];
            v0 = o1; v1 = o2;
          }
          u32x4 w; w.x = pk2(v0[0], v0[1]); w.y = pk2(v0[2], v0[3]); w.z = pk2(v1[0], v1[1]); w.w = pk2(v1[2], v1[3]);
          *(u32x4*)(out + (size_t)row * ldc + c0) = w;
        }
      }
    }
  }
};

DI int ropeperm64(int p) { const int g = p >> 3, r = p & 7; return r < 4 ? 4 * g + r : 32 + 4 * g + (r - 4); }
DI int ropeperm32(int p) { const int g = p >> 3, r = p & 7; return r < 4 ? 4 * g + r : 16 + 4 * g + (r - 4); }
DI int srccol(int kind, int n) {
  if (kind == 0) {
    if (n < 512) return 672 + (n & ~63) + ropeperm64(n & 63);
    if (n < 640) return 1184 + ((n - 512) & ~63) + ropeperm64(n & 63);
    if (n < 768) return 1312 + (n - 640);
    if (n < 1792) return 1440 + (n - 768);
    if (n < 2176) return n - 1792;
    if (n < 2432) return 384 + (n - 2176);
    if (n < 2464) return 640 + ropeperm32(n - 2432);
    return -1;
  }
  if (kind == 1) {
    if (n < 1024) return (n & ~63) + ropeperm64(n & 63);
    if (n < 3072) return n;
    return 3080 + (n - 3072);
  }
  if (kind == 2) { const int hd = n / 96, p = n - hd * 96; return hd * 96 + (p < 64 ? p : 64 + ropeperm32(p - 64)); }
  return n;
}
struct ConvJob { const float* W; const float* g; bf16_t* Wt; int Nsrc, K, kind, tn, tk; };
DI bool conv_decode(const Params& p, int job, ConvJob& j) {
  constexpr int NT0 = 40 * 16, NT1 = 64 * 16, NT2 = 12 * 6, NT3 = 16 * 4, NT4 = 16 * 16;
  constexpr int PER_I = NT0 + NT1 + NT2 + NT3 + 2 * NT4;
  if (job >= 2 * PER_I) return false;
  unsigned char* ws = p.ws;
  const int i = job / PER_I; int t = job - i * PER_I;
  j.g = nullptr;
  if (t < NT0) { j.W = p.ev_w_in + (size_t)i * 1024 * 2464; j.Nsrc = 2464; j.K = 1024; j.Wt = (bf16_t*)(ws + WS_WEVIN + i * SZ_WEVIN); j.kind = 0; j.tn = t / 16; j.tk = t % 16; return true; }
  t -= NT0;
  if (t < NT1) { j.W = p.od_w_in + (size_t)i * 1024 * 4104; j.Nsrc = 4104; j.K = 1024; j.Wt = (bf16_t*)(ws + WS_WODIN + i * SZ_WODIN); j.kind = 1; j.tn = t / 16; j.tk = t % 16; return true; }
  t -= NT1;
  if (t < NT2) { j.W = p.ev_w_uq + (size_t)i * 384 * 768; j.Nsrc = 768; j.K = 384; j.Wt = (bf16_t*)(ws + WS_WUQ + i * SZ_WUQ); j.kind = 2; j.g = p.ev_q_norm + i * 384; j.tn = t / 6; j.tk = t % 6; return true; }
  t -= NT2;
  if (t < NT3) { j.W = p.ev_w_ukv + (size_t)i * 256 * 1024; j.Nsrc = 1024; j.K = 256; j.Wt = (bf16_t*)(ws + WS_WUKV + i * SZ_WUKV); j.kind = 3; j.g = p.ev_kv_norm + i * 256; j.tn = t / 4; j.tk = t % 4; return true; }
  t -= NT3;
  if (t < NT4) { j.W = p.ev_w_out + (size_t)i * 1024 * 1024; j.Nsrc = 1024; j.K = 1024; j.Wt = (bf16_t*)(ws + WS_WEVOUT + i * SZ_WOUT); j.kind = 4; j.tn = t / 16; j.tk = t % 16; return true; }
  t -= NT4;
  j.W = p.od_w_out + (size_t)i * 1024 * 1024; j.Nsrc = 1024; j.K = 1024; j.Wt = (bf16_t*)(ws + WS_WODOUT + i * SZ_WOUT); j.kind = 4; j.tn = t / 16; j.tk = t % 16; return true;
}
template <int NJ>
DI void convert_tiles(const Params& p, LAS unsigned char* lds, int job0, int jstride) {
  const int tid = opaque_tid();
  const int n4 = (tid & 15) * 4, kq = tid >> 4;
  ConvJob j[NJ] = {}; bool ok[NJ]; f32x4 v[NJ][2];
#pragma unroll
  for (int q = 0; q < NJ; ++q) {
    ok[q] = conv_decode(p, job0 + q * jstride, j[q]);
    const int sc = ok[q] ? srccol(j[q].kind, j[q].tn * 64 + n4) : -1;
#pragma unroll
    for (int e = 0; e < 2; ++e) {
      const int k = j[q].tk * 64 + kq + 32 * e;
      v[q][e] = (f32x4){0.f, 0.f, 0.f, 0.f};
      if (sc >= 0) { v[q][e] = *(const f32x4*)(j[q].W + (size_t)k * j[q].Nsrc + sc); if (j[q].g) v[q][e] = v[q][e] * j[q].g[k]; }
    }
  }
#pragma unroll
  for (int q = 0; q < NJ; ++q) {
    LAS bf16_t* tile = (LAS bf16_t*)(lds + q * 9216);
#pragma unroll
    for (int e = 0; e < 2; ++e)
#pragma unroll
      for (int i = 0; i < 4; ++i) tile[(n4 + i) * 72 + kq + 32 * e] = f2bf(v[q][e][i]);
  }
  __syncthreads();
#pragma unroll
  for (int q = 0; q < NJ; ++q) {
    if (ok[q]) {
      LAS bf16_t* tile = (LAS bf16_t*)(lds + q * 9216);
      const int n2 = tid >> 3, ch = tid & 7;
      const u32x4 w = *(const LAS u32x4*)(tile + n2 * 72 + ch * 8);
      *(u32x4*)(j[q].Wt + (size_t)(j[q].tn * 64 + n2) * j[q].K + j[q].tk * 64 + ch * 8) = w;
    }
  }
  __syncthreads();
}

DI void prologue(const Params& p, LAS unsigned char* lds) {
  const int tid = opaque_tid(), G = gridDim.x, bid = blockIdx.x;
  unsigned char* ws = p.ws;
  for (int idx = bid * 512 + tid; idx < 2048 * 48; idx += G * 512) {
    const bool isH = idx < 2048 * 32;
    const int j = isH ? idx : idx - 2048 * 32;
    const int pos = isH ? (j >> 5) : (j >> 4), i = isH ? (j & 31) : (j & 15);
    const float e = isH ? (float)(2 * i) * (1.f / 64.f) : (float)(2 * i) * (1.f / 32.f);
    const float inv = fast_exp2(-e * 13.287712379549449f);
    const float ang = (float)pos * inv;
    double t = (double)ang * 0.15915494309189535; t -= rint(t);
    const float fr = (float)t;
    const float cv = __builtin_amdgcn_cosf(fr), sv = __builtin_amdgcn_sinf(fr);
    if (isH) { ((float*)(ws + WS_COSH))[j] = cv; ((float*)(ws + WS_SINH))[j] = sv; }
    else { ((float*)(ws + WS_COSR))[j] = cv; ((float*)(ws + WS_SINR))[j] = sv; }
  }
  for (int job = bid; job < 4624; job += 4 * G) convert_tiles<4>(p, lds, job, G);
  const int item0 = G - 1 - bid;
  if (item0 < 192) {
    LAS float* cond = (LAS float*)lds;
    LAS float* red = (LAS float*)(lds + 65536);
    for (int e = tid; e < 16 * 1024; e += 512) { const int b = e >> 10, k = e & 1023; cond[k * 16 + b] = silu_f(p.c[e]); }
    __syncthreads();
    for (int item = item0; item < 192; item += G) {
      const int l = item / 48, n0 = (item % 48) * 64;
      const int col = tid & 63, kg = tid >> 6;
      float a[16];
#pragma unroll
      for (int b = 0; b < 16; ++b) a[b] = 0.f;
      const float* wp = p.w_ada + (size_t)l * 1024 * 3072 + n0 + col;
      for (int k0 = kg * 128; k0 < kg * 128 + 128; k0 += 16) {
        float wv[16];
#pragma unroll
        for (int e = 0; e < 16; ++e) wv[e] = wp[(size_t)(k0 + e) * 3072];
#pragma unroll
        for (int e = 0; e < 16; ++e) {
          const float w = wv[e]; const int k = k0 + e;
#pragma unroll
          for (int b4 = 0; b4 < 4; ++b4) { const f32x4 cv = *(const LAS f32x4*)(cond + k * 16 + b4 * 4);
            a[b4 * 4 + 0] += cv[0] * w; a[b4 * 4 + 1] += cv[1] * w; a[b4 * 4 + 2] += cv[2] * w; a[b4 * 4 + 3] += cv[3] * w; }
        }
      }
#pragma unroll
      for (int b = 0; b < 16; ++b) red[(kg * 16 + b) * 64 + col] = a[b];
      __syncthreads();
      for (int e = tid; e < 1024; e += 512) { const int b = e >> 6, cc = e & 63; float s = 0.f;
#pragma unroll
        for (int k8 = 0; k8 < 8; ++k8) s += red[(k8 * 16 + b) * 64 + cc];
        ((float*)(ws + WS_MOD))[((size_t)l * 16 + b) * 3072 + n0 + cc] = s + p.b_ada[l * 3072 + n0 + cc]; }
      __syncthreads();
    }
  }
}

DI void rowwise_phase(const Params& p, LAS unsigned char* lds, int lp, int ln) {
  const int tid = opaque_tid(), lane = tid & 63, wid = tid >> 6;
  const int gw = blockIdx.x * 8 + wid, nw = gridDim.x * 8;
  unsigned char* ws = p.ws;
  const float* mod = (const float*)(ws + WS_MOD);
  const bf16_t* ybuf = (const bf16_t*)(ws + WS_HBUF);
  bf16_t* hbuf = (bf16_t*)(ws + WS_HBUF);
  const bool ff = (ln < 4) && (ln & 1);
  LAS f32x4* wl = (LAS f32x4*)lds;
  if (ff) {
    const float* w = p.od_w_in + (size_t)(ln >> 1) * 1024 * 4104 + 3072;
    for (int c = tid; c < 1024; c += 512) {
      const f32x4 w0 = *(const f32x4*)(w + (size_t)c * 4104), w1 = *(const f32x4*)(w + (size_t)c * 4104 + 4);
      const int ln_ = (c & 511) >> 3, e = c & 7, j = c >> 9;
      wl[(j * 8 + e) * 64 + ln_] = w0; wl[1024 + (j * 8 + e) * 64 + ln_] = w1;
    }
    __syncthreads();
  }
  for (int row = gw; row < T; row += nw) {
    const int b = row >> 11;
    float xv[2][8];
    bf16_t* xbf = (bf16_t*)(ws + WS_XBF) + (size_t)row * DM;
#pragma unroll
    for (int j = 0; j < 2; ++j) {
      const int c = 8 * lane + 512 * j;
      if (lp <= 0) {
        const f32x4 a0 = *(const f32x4*)(p.x + (size_t)row * DM + c), a1 = *(const f32x4*)(p.x + (size_t)row * DM + c + 4);
        xv[j][0] = a0[0]; xv[j][1] = a0[1]; xv[j][2] = a0[2]; xv[j][3] = a0[3]; xv[j][4] = a1[0]; xv[j][5] = a1[1]; xv[j][6] = a1[2]; xv[j][7] = a1[3];
      } else {
        const u32x4 u = *(const u32x4*)(xbf + c);
#pragma unroll
        for (int e = 0; e < 4; ++e) { xv[j][2 * e] = bflo(u[e]); xv[j][2 * e + 1] = bfhi(u[e]); }
      }
    }
    if (lp >= 0) {
      float yv[2][8]; float ss = 0.f;
#pragma unroll
      for (int j = 0; j < 2; ++j) {
        const u32x4 u = *(const u32x4*)(ybuf + (size_t)row * DM + 8 * lane + 512 * j);
#pragma unroll
        for (int e = 0; e < 4; ++e) { yv[j][2 * e] = bflo(u[e]); yv[j][2 * e + 1] = bfhi(u[e]); ss += yv[j][2 * e] * yv[j][2 * e] + yv[j][2 * e + 1] * yv[j][2 * e + 1]; }
      }
      ss = wave_sum(ss);
      const float rs = rsqrtf(ss * (1.f / DM) + EPS);
#pragma unroll
      for (int j = 0; j < 2; ++j) {
        const int c = 8 * lane + 512 * j;
#pragma unroll
        for (int q = 0; q < 2; ++q) {
          const f32x4 gt = *(const f32x4*)(mod + ((size_t)lp * 16 + b) * 3072 + 2048 + c + 4 * q);
          const f32x4 gp = *(const f32x4*)(p.g_post + lp * DM + c + 4 * q);
#pragma unroll
          for (int e = 0; e < 4; ++e) xv[j][4 * q + e] += gt[e] * (yv[j][4 * q + e] * rs * gp[e]);
        }
        if (ln >= 4) {
          *(f32x4*)(p.out + (size_t)row * DM + c) = (f32x4){xv[j][0], xv[j][1], xv[j][2], xv[j][3]};
          *(f32x4*)(p.out + (size_t)row * DM + c + 4) = (f32x4){xv[j][4], xv[j][5], xv[j][6], xv[j][7]};
        } else {
          u32x4 w; w.x = pk2(xv[j][0], xv[j][1]); w.y = pk2(xv[j][2], xv[j][3]); w.z = pk2(xv[j][4], xv[j][5]); w.w = pk2(xv[j][6], xv[j][7]);
          *(u32x4*)(xbf + c) = w;
        }
      }
    }
    if (ln < 4) {
      float ss = 0.f;
#pragma unroll
      for (int j = 0; j < 2; ++j)
#pragma unroll
        for (int e = 0; e < 8; ++e) ss += xv[j][e] * xv[j][e];
      ss = wave_sum(ss);
      const float rs = rsqrtf(ss * (1.f / DM) + EPS);
      float zf[8];
#pragma unroll
      for (int h = 0; h < 8; ++h) zf[h] = 0.f;
#pragma unroll
      for (int j = 0; j < 2; ++j) {
        const int c = 8 * lane + 512 * j;
        float hv[8];
#pragma unroll
        for (int q = 0; q < 2; ++q) {
          const f32x4 sh = *(const f32x4*)(mod + ((size_t)ln * 16 + b) * 3072 + c + 4 * q);
          const f32x4 sc = *(const f32x4*)(mod + ((size_t)ln * 16 + b) * 3072 + 1024 + c + 4 * q);
          const f32x4 gp = *(const f32x4*)(p.g_pre + ln * DM + c + 4 * q);
#pragma unroll
          for (int e = 0; e < 4; ++e) hv[4 * q + e] = (xv[j][4 * q + e] * rs * gp[e]) * (sc[e] + 1.f) + sh[e];
        }
        u32x4 w; w.x = pk2(hv[0], hv[1]); w.y = pk2(hv[2], hv[3]); w.z = pk2(hv[4], hv[5]); w.w = pk2(hv[6], hv[7]);
        *(u32x4*)(hbuf + (size_t)row * DM + c) = w;
        if (ff) {
#pragma unroll
          for (int e = 0; e < 8; ++e) {
            const f32x4 w0 = wl[(j * 8 + e) * 64 + lane], w1 = wl[1024 + (j * 8 + e) * 64 + lane];
            zf[0] += hv[e] * w0[0]; zf[1] += hv[e] * w0[1]; zf[2] += hv[e] * w0[2]; zf[3] += hv[e] * w0[3];
            zf[4] += hv[e] * w1[0]; zf[5] += hv[e] * w1[1]; zf[6] += hv[e] * w1[2]; zf[7] += hv[e] * w1[3];
          }
        }
      }
      if (ff) {
        const bool b5 = lane & 32, b4 = lane & 16, b3 = lane & 8;
        float w4[4], u2[2], t;
#pragma unroll
        for (int k = 0; k < 4; ++k) { const float send = b5 ? zf[k] : zf[4 + k], keep = b5 ? zf[4 + k] : zf[k]; w4[k] = keep + __shfl_xor(send, 32); }
#pragma unroll
        for (int k = 0; k < 2; ++k) { const float send = b4 ? w4[k] : w4[2 + k], keep = b4 ? w4[2 + k] : w4[k]; u2[k] = keep + __shfl_xor(send, 16); }
        { const float send = b3 ? u2[0] : u2[1], keep = b3 ? u2[1] : u2[0]; t = keep + __shfl_xor(send, 8); }
        t += __shfl_xor(t, 4); t += __shfl_xor(t, 2); t += __shfl_xor(t, 1);
        if ((lane & 7) == 0) {
          const int h = lane >> 3;
          const float z = t + p.od_forget_bias[(ln >> 1) * 8 + h];
          const float ls = fminf(z, 0.f) - __builtin_amdgcn_logf(1.f + fast_exp2(-fabsf(z) * LOG2E)) * 0.6931471805599453f;
          ((float*)(ws + WS_LOGF))[(size_t)row * 8 + h] = ls;
        }
      }
    }
  }
  __syncthreads();
}

DI void fox_scan(const Params& p, LAS unsigned char* lds, int bh) {
  const int tid = opaque_tid();
  const int b = bh >> 3, h = bh & 7;
  const float* logf_ = (const float*)(p.ws + WS_LOGF);
  float* fcum = (float*)(p.ws + WS_FCUM) + (size_t)bh * SEQ;
  LAS float* s = (LAS float*)lds;
  float v[4];
#pragma unroll
  for (int j = 0; j < 4; ++j) v[j] = logf_[((size_t)b * SEQ + 4 * tid + j) * 8 + h];
  v[1] += v[0]; v[2] += v[1]; v[3] += v[2];
  s[tid] = v[3];
  __syncthreads();
  for (int off = 1; off < 512; off <<= 1) {
    float t = 0.f;
    if (tid >= off) t = s[tid - off];
    __syncthreads();
    s[tid] += t;
    __syncthreads();
  }
  const float excl = s[tid] - v[3];
#pragma unroll
  for (int j = 0; j < 4; ++j) fcum[4 * tid + j] = -8.0f * (excl + v[j]);
  __syncthreads();
}

struct AttnArgs { const bf16_t *q, *k, *k2, *v, *gate; bf16_t* out; const float* fcum; int ldq, ldk, ldk2, ldv, ldo, ldg; float sl2, sink; };

DI float half_max(float x) {
  const unsigned u = __float_as_uint(x);
  auto r = __builtin_amdgcn_permlane32_swap(u, u, false, false);
  return fmaxf(__uint_as_float(r[0]), __uint_as_float(r[1]));
}
DI float half_sum(float x) {
  const unsigned u = __float_as_uint(x);
  auto r = __builtin_amdgcn_permlane32_swap(u, u, false, false);
  return __uint_as_float(r[0]) + __uint_as_float(r[1]);
}


DI void epi_block(const f32x16& O, float inv, int hh, const bf16_t* gate_row, bf16_t* out_row) {
#pragma unroll
  for (int g = 0; g < 4; g += 2) {
    float v[8];
#pragma unroll
    for (int e = 0; e < 4; ++e) {
      auto r = __builtin_amdgcn_permlane32_swap(__float_as_uint(O[4 * g + e] * inv), __float_as_uint(O[4 * (g + 1) + e] * inv), false, false);
      v[e] = __uint_as_float(r[0]); v[4 + e] = __uint_as_float(r[1]);
    }
    const int c = 8 * g + 8 * hh;
    if (gate_row) {
      const u32x4 gv = *(const u32x4*)(gate_row + c);
#pragma unroll
      for (int e = 0; e < 4; ++e) { v[2 * e] *= silu_f(bflo(gv[e])); v[2 * e + 1] *= silu_f(bfhi(gv[e])); }
    }
    u32x4 w; w.x = pk2(v[0], v[1]); w.y = pk2(v[2], v[3]); w.z = pk2(v[4], v[5]); w.w = pk2(v[6], v[7]);
    *(u32x4*)(out_row + c) = w;
  }
}

template <int N> DI void wait_vmcnt() { asm volatile("s_waitcnt vmcnt(%0)" ::"n"(N) : "memory"); }
DI void raw_barrier() { asm volatile("" ::: "memory"); __builtin_amdgcn_s_barrier(); asm volatile("" ::: "memory"); }

template <int DQK, int DV, int MODE>
DI void attn_item(LAS unsigned char* lds, const AttnArgs& a, int qb) {
  constexpr int KSTR = DQK * 2 + 16, VSTR = (DV == 64) ? 192 : 320;
  constexpr int KG16 = KSTR / 16, VG16 = VSTR / 16;
  constexpr int KCH = KG16, VCH = VG16, NCH = KCH + VCH;
  constexpr int TILE = NCH * 1024 + (MODE == 2 ? 2048 : 0);
  constexpr int NSLOT = (NCH + 7) / 8, REM = NCH - 8 * (NSLOT - 1);
  constexpr int FX = (MODE == 2) ? 1 : 0;
  constexpr int NKS = DQK / 16, NBLK = DV / 32;
  static_assert(5 * TILE <= 155648, "ring too large");
  const int tid = opaque_tid(), wid = __builtin_amdgcn_readfirstlane(tid >> 6), lane = tid & 63, r = lane & 31, hh = lane >> 5;
  const int q0 = qb * 256, qw = q0 + 32 * wid, myq = qw + r;
  const float c = a.sl2, tau = 8.0f / a.sl2;
  bf16x8 qf[NKS];
#pragma unroll
  for (int ks = 0; ks < NKS; ++ks) qf[ks] = *(const bf16x8*)(a.q + (size_t)myq * a.ldq + 16 * ks + 8 * hh);
  int lo = 0; const int hi = 4 * (qb + 1);
  if (MODE == 1) { lo = 4 * qb - 2; if (lo < 0) lo = 0; }
  const int last_w = (qw + 31) >> 6;
  int first_w = 0;
  if (MODE == 1) { first_w = (qw > 127 ? qw - 127 : 0) >> 6; }
  const char* sp[NSLOT]; unsigned sst[NSLOT];
#pragma unroll
  for (int j = 0; j < NSLOT; ++j) {
    const int ch_ = 8 * j + wid;
    if (ch_ < KCH) {
      const int p = ch_ * 64 + lane, row = p / KG16, g = p - row * KG16;
      if (DQK == 96 && g >= 8 && g < 12) { sp[j] = (const char*)(a.k2 + (size_t)row * a.ldk2 + 8 * (g - 8)); sst[j] = (unsigned)(128 * a.ldk2); }
      else { sp[j] = (const char*)(a.k + (size_t)row * a.ldk + 8 * (g < 8 ? g : 0)); sst[j] = (unsigned)(128 * a.ldk); }
    } else {
      const int p = (ch_ - KCH) * 64 + lane, row = (p / VG16) & 63, g = p - (p / VG16) * VG16;
      sp[j] = (const char*)(a.v + (size_t)row * a.ldv + 8 * (g < DV / 8 ? g : 0)); sst[j] = (unsigned)(128 * a.ldv);
    }
  }
  auto issue = [&](int kt) {
    LAS unsigned char* base = lds + (kt % 4) * TILE;
#pragma unroll
    for (int j = 0; j < NSLOT; ++j) {
      if (j < NSLOT - 1 || wid < REM)
        __builtin_amdgcn_global_load_lds((const unsigned*)(sp[j] + (size_t)kt * sst[j]), (LAS unsigned*)(base + (8 * j + wid) * 1024), 16, 0, 0);
    }
    if (MODE == 2) __builtin_amdgcn_global_load_lds((const unsigned*)(a.fcum + kt * 64 + lane), (LAS unsigned*)(base + NCH * 1024 + wid * 256), 4, 0, 0);
  };
  auto wait_tiles = [&](bool all) {
    if (all) wait_vmcnt<0>();
    else if (wid < REM) wait_vmcnt<NSLOT + FX>();
    else wait_vmcnt<NSLOT - 1 + FX>();
  };
  f32x16 O[NBLK];
#pragma unroll
  for (int bl = 0; bl < NBLK; ++bl)
#pragma unroll
    for (int i = 0; i < 16; ++i) O[bl][i] = 0.f;
  float m = (MODE == 1) ? a.sink / a.sl2 : -1e30f;
  float l0 = (MODE == 1 && hh == 0) ? 1.f : 0.f, l1 = 0.f;
  const int i16 = lane & 15, q4 = i16 >> 2, p4 = i16 & 3, grp = (lane >> 4) & 1;
  auto qk_load = [&](int kt, bf16x8 (&kf)[2][NKS]) {
    LAS unsigned char* Kl = lds + (kt % 4) * TILE;
#pragma unroll
    for (int kb = 0; kb < 2; ++kb)
#pragma unroll
      for (int ks = 0; ks < NKS; ++ks) kf[kb][ks] = *(const LAS bf16x8*)(Kl + (32 * kb + r) * KSTR + (16 * ks + 8 * hh) * 2);
  };
  auto qk_mma = [&](int kt, const bf16x8 (&kf)[2][NKS], f32x16 (&s)[2]) {
#pragma unroll
    for (int kb = 0; kb < 2; ++kb) {
      if (MODE == 2) {
        LAS unsigned char* Fl = lds + (kt % 4) * TILE + NCH * 1024 + wid * 256;
#pragma unroll
        for (int g = 0; g < 4; ++g) { const f32x4 fb = *(const LAS f32x4*)(Fl + (32 * kb + 8 * g + 4 * hh) * 4);
          s[kb][4 * g] = fb[0]; s[kb][4 * g + 1] = fb[1]; s[kb][4 * g + 2] = fb[2]; s[kb][4 * g + 3] = fb[3]; }
      } else {
#pragma unroll
        for (int i = 0; i < 16; ++i) s[kb][i] = 0.f;
      }
    }
#pragma unroll
    for (int ks = 0; ks < NKS; ++ks)
#pragma unroll
      for (int kb = 0; kb < 2; ++kb) s[kb] = __builtin_amdgcn_mfma_f32_32x32x16_bf16(kf[kb][ks], qf[ks], s[kb], 0, 0, 0);
  };
  auto softmax = [&](int kt, f32x16 (&s)[2], bf16x8 (&pf)[2][2], auto maskc) {
    constexpr bool MASK = decltype(maskc)::value;
    const int key0 = kt * 64;
    if (MASK) {
#pragma unroll
      for (int kb = 0; kb < 2; ++kb)
#pragma unroll
        for (int i = 0; i < 16; ++i) {
          const int key = key0 + 32 * kb + (i & 3) + 8 * (i >> 2) + 4 * hh;
          bool valid = key <= myq; if (MODE == 1) valid = valid && (myq - key < 128);
          s[kb][i] = valid ? s[kb][i] : -1e30f;
        }
    }
    float mx = fmaxf(s[0][0], s[1][0]);
#pragma unroll
    for (int i = 1; i < 16; ++i) mx = fmaxf(fmaxf(mx, s[0][i]), s[1][i]);
    mx = half_max(mx);
    if (__builtin_amdgcn_ballot_w64(mx > m + tau) != 0ull) {
      const float mnew = fmaxf(m, mx);
      const float alpha = fast_exp2((m - mnew) * c);
      m = mnew;
      l0 *= alpha; l1 *= alpha;
#pragma unroll
      for (int bl = 0; bl < NBLK; ++bl)
#pragma unroll
        for (int i = 0; i < 16; ++i) O[bl][i] *= alpha;
    }
    const float nmc = -m * c;
#pragma unroll
    for (int kb = 0; kb < 2; ++kb)
#pragma unroll
      for (int s2 = 0; s2 < 2; ++s2) {
        float pv[8];
#pragma unroll
        for (int e = 0; e < 8; ++e) pv[e] = fast_exp2(__builtin_fmaf(s[kb][8 * s2 + e], c, nmc));
        l0 += (pv[0] + pv[4]) + (pv[2] + pv[6]); l1 += (pv[1] + pv[5]) + (pv[3] + pv[7]);
        u32x4 w;
        w.x = pk2(pv[0], pv[1]); w.y = pk2(pv[2], pv[3]); w.z = pk2(pv[4], pv[5]); w.w = pk2(pv[6], pv[7]);
        pf[kb][s2] = __builtin_bit_cast(bf16x8, w);
      }
  };
  auto pvmm = [&](int kt, const bf16x8 (&pf)[2][2]) {
    constexpr int PD = (NBLK == 2) ? 2 : 1;
    const unsigned va = (unsigned)(size_t)(lds + (kt % 4) * TILE + KCH * 1024 + (4 * hh + q4) * VSTR + (16 * grp) * 2 + 8 * p4);
    s16x4 vl[PD + 1][NBLK], vh[PD + 1][NBLK];
#define TRRD(dst, off) asm volatile("ds_read_b64_tr_b16 %0, %1 offset:%2" : "=&v"(dst) : "v"(va), "n"(off) : "memory")
#define TRSTEP(st_) do { _Pragma("unroll") for (int bl = 0; bl < NBLK; ++bl) { TRRD(vl[(st_) % (PD + 1)][bl], 16 * (st_) * VSTR + 64 * bl); TRRD(vh[(st_) % (PD + 1)][bl], 16 * (st_) * VSTR + 64 * bl + 8 * VSTR); } } while (0)
#define TRWAIT(n_, b_) do { if (NBLK == 2) asm volatile("s_waitcnt lgkmcnt(" #n_ ")" : "+v"(vl[b_][0]), "+v"(vh[b_][0]), "+v"(vl[b_][1]), "+v"(vh[b_][1])::"memory"); \
    else asm volatile("s_waitcnt lgkmcnt(" #n_ ")" : "+v"(vl[b_][0]), "+v"(vh[b_][0]), "+v"(vl[b_][1]), "+v"(vh[b_][1]), "+v"(vl[b_][2 % NBLK]), "+v"(vh[b_][2 % NBLK]), "+v"(vl[b_][3 % NBLK]), "+v"(vh[b_][3 % NBLK])::"memory"); } while (0)
#pragma unroll
    for (int st = 0; st < PD; ++st) TRSTEP(st);
#pragma unroll
    for (int st = 0; st < 4; ++st) {
      if (st + PD < 4) TRSTEP(st + PD);
      const int ahead = ((st + PD < 4) ? st + PD : 3) - st;
      const int b_ = st % (PD + 1);
      if (ahead * 2 * NBLK == 8) TRWAIT(8, b_); else if (ahead * 2 * NBLK == 4) TRWAIT(4, b_); else TRWAIT(0, b_);
#pragma unroll
      for (int bl = 0; bl < NBLK; ++bl) {
        const bf16x8 vf = __builtin_shufflevector(vl[b_][bl], vh[b_][bl], 0, 1, 2, 3, 4, 5, 6, 7);
        O[bl] = __builtin_amdgcn_mfma_f32_32x32x16_bf16(vf, pf[st >> 1][st & 1], O[bl], 0, 0, 0);
      }
    }
#undef TRRD
#undef TRSTEP
#undef TRWAIT
  };
  auto act = [&](int kt) { return kt <= last_w && kt >= first_w; };
  f32x16 sA[2];
  const bool halfB = wid >= 4;
  issue(lo);
  if (lo + 1 < hi) issue(lo + 1);
  if (lo + 2 < hi) issue(lo + 2);
  wait_tiles(true);
  raw_barrier();
  if (halfB) raw_barrier();
  if (act(lo)) { bf16x8 kf0[2][NKS]; qk_load(lo, kf0); qk_mma(lo, kf0, sA); }
  auto step = [&](int kt, auto maskc) {
    const bool a0 = act(kt), a1 = (kt + 1 < hi) && act(kt + 1);
    bf16x8 pf[2][2], kf[2][NKS];
    if (a0) softmax(kt, sA, pf, maskc);
    wait_tiles(true);
    raw_barrier();
    if (a1) qk_load(kt + 1, kf);
    __builtin_amdgcn_s_setprio(1);
    if (a1) qk_mma(kt + 1, kf, sA);
    if (a0) pvmm(kt, pf);
    __builtin_amdgcn_s_setprio(0);
    if (kt + 3 < hi) issue(kt + 3);
    raw_barrier();
  };
  int split = lo;
  if (MODE != 1) { split = qw >> 6; if (split < lo) split = lo; if (split > hi) split = hi; }
  if (MODE != 1) { for (int kt = lo; kt < split; ++kt) step(kt, std::false_type{}); }
  for (int kt = split; kt < hi; ++kt) step(kt, std::true_type{});
  if (!halfB) raw_barrier();
  const float l = half_sum(l0 + l1);
  const float inv = 1.f / l;
#pragma unroll
  for (int bl = 0; bl < NBLK; ++bl)
    epi_block(O[bl], inv, hh, a.gate ? a.gate + (size_t)myq * a.ldg + 32 * bl : nullptr, a.out + (size_t)myq * a.ldo + 32 * bl);
}

DI void swa_item(LAS unsigned char* lds, const AttnArgs& a, const float* sinks4, int qb) {
  constexpr int KSTR = 144, VSTR = 192, KCH = 9, VCH = 12, NCH = 21, TILE = NCH * 1024, NSLOT = 3, REM = 5, NKS = 4, NBLK = 2;
  const int tid = opaque_tid(), wid = __builtin_amdgcn_readfirstlane(tid >> 6), lane = tid & 63, r = lane & 31, hh = lane >> 5;
  const int q0 = qb * 256, qw = q0 + 32 * wid, myq = qw + r;
  const float c = a.sl2, tau = 8.0f / a.sl2;
  int lo = 4 * qb - 2; if (lo < 0) lo = 0;
  const int hi = 4 * (qb + 1);
  const int last_w = (qw + 31) >> 6, first_w = (qw > 127 ? qw - 127 : 0) >> 6;
#pragma unroll
  for (int j = 0; j < NSLOT; ++j) {
    const int ch_ = 8 * j + wid;
    if (j < NSLOT - 1 || wid < REM) {
      const char* sp; unsigned sst;
      if (ch_ < KCH) { const int p = ch_ * 64 + lane, row = p / 9, g = p - row * 9;
        sp = (const char*)(a.k + (size_t)row * a.ldk + 8 * (g < 8 ? g : 0)); sst = (unsigned)(128 * a.ldk); }
      else { const int p = (ch_ - KCH) * 64 + lane, row = (p / 12) & 63, g = p - (p / 12) * 12;
        sp = (const char*)(a.v + (size_t)row * a.ldv + 8 * (g < 8 ? g : 0)); sst = (unsigned)(128 * a.ldv); }
      for (int kt = lo; kt < hi; ++kt)
        __builtin_amdgcn_global_load_lds((const unsigned*)(sp + (size_t)kt * sst), (LAS unsigned*)(lds + (kt - lo) * TILE + ch_ * 1024), 16, 0, 0);
    }
  }
  wait_vmcnt<0>();
  raw_barrier();
  const int i16 = lane & 15, q4 = i16 >> 2, p4 = i16 & 3, grp = (lane >> 4) & 1;
  for (int h4 = 0; h4 < 4; ++h4) {
    bf16x8 qf[NKS];
#pragma unroll
    for (int ks = 0; ks < NKS; ++ks) qf[ks] = *(const bf16x8*)(a.q + (size_t)myq * a.ldq + h4 * 64 + 16 * ks + 8 * hh);
    f32x16 O[NBLK];
#pragma unroll
    for (int bl = 0; bl < NBLK; ++bl)
#pragma unroll
      for (int i = 0; i < 16; ++i) O[bl][i] = 0.f;
    float m = sinks4[h4] / a.sl2;
    float l0 = (hh == 0) ? 1.f : 0.f, l1 = 0.f;
    for (int kt = first_w; kt <= last_w; ++kt) {
      LAS unsigned char* Kl = lds + (kt - lo) * TILE;
      f32x16 s[2];
      bf16x8 kf[2][NKS];
#pragma unroll
      for (int kb = 0; kb < 2; ++kb)
#pragma unroll
        for (int ks = 0; ks < NKS; ++ks) kf[kb][ks] = *(const LAS bf16x8*)(Kl + (32 * kb + r) * KSTR + (16 * ks + 8 * hh) * 2);
#pragma unroll
      for (int kb = 0; kb < 2; ++kb)
#pragma unroll
        for (int i = 0; i < 16; ++i) s[kb][i] = 0.f;
#pragma unroll
      for (int ks = 0; ks < NKS; ++ks)
#pragma unroll
        for (int kb = 0; kb < 2; ++kb) s[kb] = __builtin_amdgcn_mfma_f32_32x32x16_bf16(kf[kb][ks], qf[ks], s[kb], 0, 0, 0);
      const int key0 = kt * 64;
#pragma unroll
      for (int kb = 0; kb < 2; ++kb)
#pragma unroll
        for (int i = 0; i < 16; ++i) {
          const int key = key0 + 32 * kb + (i & 3) + 8 * (i >> 2) + 4 * hh;
          const bool valid = (key <= myq) && (myq - key < 128);
          s[kb][i] = valid ? s[kb][i] : -1e30f;
        }
      float mx = fmaxf(s[0][0], s[1][0]);
#pragma unroll
      for (int i = 1; i < 16; ++i) mx = fmaxf(fmaxf(mx, s[0][i]), s[1][i]);
      mx = half_max(mx);
      if (__builtin_amdgcn_ballot_w64(mx > m + tau) != 0ull) {
        const float mnew = fmaxf(m, mx);
        const float alpha = fast_exp2((m - mnew) * c);
        m = mnew; l0 *= alpha; l1 *= alpha;
#pragma unroll
        for (int bl = 0; bl < NBLK; ++bl)
#pragma unroll
          for (int i = 0; i < 16; ++i) O[bl][i] *= alpha;
      }
      const float nmc = -m * c;
      bf16x8 pf[2][2];
#pragma unroll
      for (int kb = 0; kb < 2; ++kb)
#pragma unroll
        for (int s2 = 0; s2 < 2; ++s2) {
          float pv[8];
#pragma unroll
          for (int e = 0; e < 8; ++e) pv[e] = fast_exp2(__builtin_fmaf(s[kb][8 * s2 + e], c, nmc));
          l0 += (pv[0] + pv[4]) + (pv[2] + pv[6]); l1 += (pv[1] + pv[5]) + (pv[3] + pv[7]);
          u32x4 w;
          w.x = pk2(pv[0], pv[1]); w.y = pk2(pv[2], pv[3]); w.z = pk2(pv[4], pv[5]); w.w = pk2(pv[6], pv[7]);
          pf[kb][s2] = __builtin_bit_cast(bf16x8, w);
        }
      LAS unsigned char* Vl = Kl + KCH * 1024 + (4 * hh + q4) * VSTR + (16 * grp) * 2 + 8 * p4;
#pragma unroll
      for (int st = 0; st < 4; ++st)
#pragma unroll
        for (int bl = 0; bl < NBLK; ++bl) {
          LAS unsigned char* ad = Vl + (16 * st) * VSTR + (32 * bl) * 2;
          const s16x4 lo_ = __builtin_amdgcn_ds_read_tr16_b64_v4i16((LAS s16x4*)ad);
          const s16x4 hi_ = __builtin_amdgcn_ds_read_tr16_b64_v4i16((LAS s16x4*)(ad + 8 * VSTR));
          const bf16x8 vf = __builtin_shufflevector(lo_, hi_, 0, 1, 2, 3, 4, 5, 6, 7);
          O[bl] = __builtin_amdgcn_mfma_f32_32x32x16_bf16(vf, pf[st >> 1][st & 1], O[bl], 0, 0, 0);
        }
    }
    const float l = half_sum(l0 + l1);
    const float inv = 1.f / l;
#pragma unroll
    for (int bl = 0; bl < NBLK; ++bl)
      epi_block(O[bl], inv, hh, a.gate + (size_t)myq * a.ldg + h4 * 64 + 32 * bl, a.out + (size_t)myq * a.ldo + h4 * 64 + 32 * bl);
  }
  __syncthreads();
}

DI bool team_item(int G, int c, int n, int& bh, int& qb) {
  if (G == 256) {
    const int x = c & 7, li = c >> 3, t = li >> 3, i = li & 7;
    bh = x + 8 * (4 * t + n);
    const int j = (i + 4) & 7;
    qb = (n == 0) ? i : (n == 1) ? 7 - i : (n == 2) ? j : 7 - j;
    return true;
  }
  const int idx = n * G + ((n & 1) ? (G - 1 - c) : c);
  if (idx >= 1024) return false;
  qb = 7 - idx / 128; bh = idx % 128;
  return true;
}

DI int snake_idx(int round, int G, int c) { return round * G + ((round & 1) ? (G - 1 - c) : c); }

DI void attn_even(const Params& p, LAS unsigned char* lds, int i) {
  const int G = gridDim.x, c = blockIdx.x;
  unsigned char* ws = p.ws;
  const bf16_t* z = (const bf16_t*)(ws + WS_ZBUF);
  const bf16_t* qb_ = (const bf16_t*)(ws + WS_QBUF);
  const bf16_t* kv = (const bf16_t*)(ws + WS_HBUF);
  bf16_t* ob = (bf16_t*)(ws + WS_OBUF);
  for (int rd = 0; rd * G < 1024; ++rd) {
    int qb, bh;
    if (!team_item(G, c, rd, bh, qb)) continue;
    const int b = bh >> 3, hd = bh & 7;
    AttnArgs a;
    a.q = qb_ + (size_t)b * SEQ * 768 + hd * 96; a.ldq = 768;
    a.k = kv + (size_t)b * SEQ * 1024 + hd * 128; a.ldk = 1024;
    a.k2 = z + (size_t)b * SEQ * 2560 + 2432; a.ldk2 = 2560;
    a.v = kv + (size_t)b * SEQ * 1024 + hd * 128 + 64; a.ldv = 1024;
    a.out = ob + (size_t)b * SEQ * 1024 + hd * 64; a.ldo = 1024;
    a.gate = z + (size_t)b * SEQ * 2560 + 768 + hd * 64; a.ldg = 2560;
    a.fcum = nullptr; a.sl2 = 0.10206207261596577f * LOG2E; a.sink = 0.f;
    attn_item<96, 64, 0>(lds, a, qb);
  }
  for (int it = c; it < 256; it += G) {
    const int b = it >> 4, kvh = (it >> 3) & 1, qb = it & 7;
    AttnArgs a;
    const bf16_t* zb = z + (size_t)b * SEQ * 2560;
    a.q = zb + kvh * 256; a.ldq = 2560;
    a.k = zb + 512 + kvh * 64; a.ldk = 2560; a.k2 = nullptr; a.ldk2 = 0;
    a.v = zb + 640 + kvh * 64; a.ldv = 2560;
    a.out = ob + (size_t)b * SEQ * 1024 + 512 + kvh * 256; a.ldo = 1024;
    a.gate = zb + 768 + 512 + kvh * 256; a.ldg = 2560;
    a.fcum = nullptr; a.sl2 = 0.125f * LOG2E; a.sink = 0.f;
    float sk[4];
#pragma unroll
    for (int h4 = 0; h4 < 4; ++h4) sk[h4] = p.ev_sinks[i * 8 + kvh * 4 + h4] * LOG2E;
    swa_item(lds, a, sk, qb);
  }
}

DI void attn_odd(const Params& p, LAS unsigned char* lds, int layer) {
  const int G = gridDim.x, c = blockIdx.x;
  unsigned char* ws = p.ws;
  const bf16_t* z = (const bf16_t*)(ws + WS_ZBUF);
  bf16_t* od = (bf16_t*)(ws + WS_HBUF);
  bf16_t* ob = (bf16_t*)(ws + WS_OBUF);
  {
    for (int rd = 0; rd * G < 512; ++rd) {
      int qb, bh2;
      if (G == 256) { const int x = c & 7, li = c >> 3, t = li >> 3, i = li & 7; bh2 = x + 8 * (2 * t + rd); qb = (rd == 0) ? i : 7 - i; }
      else { const int idx = snake_idx(rd, G, c); if (idx >= 512) continue; qb = 7 - idx / 64; bh2 = idx % 64; }
      const int b = bh2 >> 2, h = bh2 & 3;
      const bf16_t* zb = z + (size_t)b * SEQ * 4096;
      for (int mp = 0; mp < 2; ++mp) {
        const int j = 2 * h + mp;
        AttnArgs a;
        a.q = zb + j * 64; a.ldq = 4096;
        a.k = zb + 512 + j * 64; a.ldk = 4096; a.k2 = nullptr; a.ldk2 = 0;
        a.v = zb + 1024 + h * 128; a.ldv = 4096;
        a.out = od + (size_t)b * SEQ * 1024 + j * 128; a.ldo = 1024;
        a.gate = nullptr; a.ldg = 0;
        a.fcum = nullptr; a.sl2 = 0.125f * LOG2E; a.sink = 0.f;
#ifndef SKIP_DIFF
        attn_item<64, 128, 0>(lds, a, qb);
#endif
      }
      __builtin_amdgcn_fence(__ATOMIC_SEQ_CST, "workgroup");
      asm volatile("s_waitcnt vmcnt(0)" ::: "memory");
      const int tid2 = opaque_tid(), lane = tid2 & 63, wid = tid2 >> 6, li_ = layer >> 1;
      const float* lp = p.od_lambda + li_ * 256;
      const float s1 = wave_sum(lp[lane] * lp[64 + lane]), s2 = wave_sum(lp[128 + lane] * lp[192 + lane]);
      const float lam_init = 0.8f - 0.6f * fast_exp2(-0.3f * LOG2E * (float)layer);
      const float lam = fast_exp2(s1 * LOG2E) - fast_exp2(s2 * LOG2E) + lam_init;
      const int rsub = lane >> 4, dv = (lane & 15) * 8;
      float sub[8];
#pragma unroll
      for (int e = 0; e < 8; ++e) sub[e] = p.od_subln[li_ * 128 + dv + e] * (1.f - lam_init);
      const size_t row0 = (size_t)b * SEQ + qb * 256 + 32 * wid;
#pragma unroll 2
      for (int rr = 0; rr < 8; ++rr) {
        const size_t row = row0 + 4 * rr + rsub;
        const u32x4 va = *(const u32x4*)(od + row * 1024 + (2 * h) * 128 + dv);
        const u32x4 vb = *(const u32x4*)(od + row * 1024 + (2 * h + 1) * 128 + dv);
        const u32x4 vg = *(const u32x4*)(z + row * 4096 + 3072 + h * 128 + dv);
        float d[8]; float ss = 0.f;
#pragma unroll
        for (int e = 0; e < 4; ++e) { d[2 * e] = bflo(va[e]) - lam * bflo(vb[e]); d[2 * e + 1] = bfhi(va[e]) - lam * bfhi(vb[e]); ss += d[2 * e] * d[2 * e] + d[2 * e + 1] * d[2 * e + 1]; }
        ss += __shfl_xor(ss, 1); ss += __shfl_xor(ss, 2); ss += __shfl_xor(ss, 4); ss += __shfl_xor(ss, 8);
        const float rs = rsqrtf(ss * (1.f / 128.f) + EPS);
        u32x4 w;
#pragma unroll
        for (int e = 0; e < 4; ++e) {
          const float o0 = d[2 * e] * rs * sub[2 * e] * silu_f(bflo(vg[e])), o1 = d[2 * e + 1] * rs * sub[2 * e + 1] * silu_f(bfhi(vg[e]));
          w[e] = pk2(o0, o1);
        }
        *(u32x4*)(ob + row * 1024 + h * 128 + dv) = w;
      }
    }
  }
  for (int rd = 0; rd * G < 1024; ++rd) {
    int qb, bh;
    if (!team_item(G, c, rd, bh, qb)) continue;
    const int b = bh >> 3, hd = bh & 7;
    AttnArgs a;
    const bf16_t* zb = z + (size_t)b * SEQ * 4096;
    a.q = zb + 1536 + hd * 64; a.ldq = 4096;
    a.k = zb + 2048 + hd * 64; a.ldk = 4096; a.k2 = nullptr; a.ldk2 = 0;
    a.v = zb + 2560 + hd * 64; a.ldv = 4096;
    a.out = ob + (size_t)b * SEQ * 1024 + 512 + hd * 64; a.ldo = 1024;
    a.gate = zb + 3072 + 512 + hd * 64; a.ldg = 4096;
    a.fcum = (const float*)(ws + WS_FCUM) + (size_t)bh * SEQ; a.sl2 = 0.125f * LOG2E; a.sink = 0.f;
#ifndef SKIP_FOX
    attn_item<64, 64, 2>(lds, a, qb);
#endif
  }
}

DI void diff_combine(const Params& p, int layer) {
  const int tid = opaque_tid(), lane = tid & 63, wid = tid >> 6;
  const int gw = blockIdx.x * 8 + wid, nw = gridDim.x * 8;
  const int i = layer >> 1;
  unsigned char* ws = p.ws;
  const bf16_t* od = (const bf16_t*)(ws + WS_HBUF);
  const bf16_t* z = (const bf16_t*)(ws + WS_ZBUF);
  bf16_t* ob = (bf16_t*)(ws + WS_OBUF);
  const float* lp = p.od_lambda + i * 256;
  const float s1 = wave_sum(lp[lane] * lp[64 + lane]), s2 = wave_sum(lp[128 + lane] * lp[192 + lane]);
  const float lam_init = 0.8f - 0.6f * expf(-0.3f * (float)layer);
  const float lam = expf(s1) - expf(s2) + lam_init;
  const int hd = lane >> 4, dv = (lane & 15) * 8;
  float sub[8];
#pragma unroll
  for (int e = 0; e < 8; ++e) sub[e] = p.od_subln[i * 128 + dv + e] * (1.f - lam_init);
  for (int row = gw; row < T; row += nw) {
    const u32x4 a = *(const u32x4*)(od + (size_t)row * 1024 + (2 * hd) * 128 + dv);
    const u32x4 b = *(const u32x4*)(od + (size_t)row * 1024 + (2 * hd + 1) * 128 + dv);
    const u32x4 g = *(const u32x4*)(z + (size_t)row * 4096 + 3072 + hd * 128 + dv);
    float d[8]; float ss = 0.f;
#pragma unroll
    for (int e = 0; e < 4; ++e) { d[2 * e] = bflo(a[e]) - lam * bflo(b[e]); d[2 * e + 1] = bfhi(a[e]) - lam * bfhi(b[e]); ss += d[2 * e] * d[2 * e] + d[2 * e + 1] * d[2 * e + 1]; }
    ss += __shfl_xor(ss, 1); ss += __shfl_xor(ss, 2); ss += __shfl_xor(ss, 4); ss += __shfl_xor(ss, 8);
    const float rs = rsqrtf(ss * (1.f / 128.f) + EPS);
    u32x4 w;
#pragma unroll
    for (int e = 0; e < 4; ++e) {
      const float o0 = d[2 * e] * rs * sub[2 * e] * silu_f(bflo(g[e])), o1 = d[2 * e + 1] * rs * sub[2 * e + 1] * silu_f(bfhi(g[e]));
      w[e] = pk2(o0, o1);
    }
    *(u32x4*)(ob + (size_t)row * 1024 + hd * 128 + dv) = w;
  }
}


DI void grid_barrier(unsigned* ctr, unsigned& epoch) {
  asm volatile("s_waitcnt vmcnt(0)" ::: "memory");
  __syncthreads();
  epoch += 1;
  if (threadIdx.x == 0) {
    __builtin_amdgcn_fence(__ATOMIC_RELEASE, "agent");
    asm volatile("s_waitcnt vmcnt(0)" ::: "memory");
    __hip_atomic_fetch_add(ctr, 1u, __ATOMIC_RELAXED, __HIP_MEMORY_SCOPE_AGENT);
    const unsigned target = epoch * gridDim.x;
    while (__hip_atomic_load(ctr, __ATOMIC_RELAXED, __HIP_MEMORY_SCOPE_AGENT) < target) __builtin_amdgcn_s_sleep(1);
    __builtin_amdgcn_fence(__ATOMIC_ACQUIRE, "agent");
    asm volatile("s_waitcnt vmcnt(0)" ::: "memory");
  }
  __syncthreads();
}


#define XB_TMO      128
#define XB_XCNT(j)  (256  + 64 * (j))
#define XB_XSUB(j)  (1280 + 64 * (j))
#define XB_XGEN(j)  (2304 + 64 * (j))
#define XB_TOP      3328
#define XB_TOPGEN   3392
#define XCD_BAR_WORDS 3456
#define XB_SPIN_CAP (1u << 20)
DI unsigned xb_ld(unsigned* p) { return __hip_atomic_load(p, __ATOMIC_RELAXED, __HIP_MEMORY_SCOPE_AGENT); }
DI unsigned xb_add(unsigned* p, unsigned v) { return __hip_atomic_fetch_add(p, v, __ATOMIC_RELAXED, __HIP_MEMORY_SCOPE_AGENT); }
DI unsigned xb_xcc_id() { return (unsigned)__builtin_amdgcn_s_getreg((3 << 11) | 20) & 0xFu; }
#define XB_SPIN(cond, bar) do { unsigned _sp = 0; while (cond) { __builtin_amdgcn_s_sleep(1); \
    if ((++_sp & 255u) == 0u) { if (xb_ld(&(bar)[XB_TMO])) break; if (_sp > XB_SPIN_CAP) { atomicAdd(&(bar)[XB_TMO], 1u); break; } } } } while (0)
struct XcdBarrier { unsigned* bar; unsigned x; volatile LAS unsigned* st; };
DI void xcd_barrier_complete(unsigned* bar, unsigned x, unsigned& nloc, unsigned& nx) {
  const unsigned G = gridDim.x;
  unsigned sum, cnt, mine, sp = 0u;
  for (;;) {
    sum = 0u; cnt = 0u; mine = 0u;
#pragma unroll
    for (unsigned j = 0; j < 16; ++j) { const unsigned c = xb_ld(&bar[XB_XCNT(j)]); sum += c; cnt += (c > 0u) ? 1u : 0u; mine = (j == x) ? c : mine; }
    if (sum == G) break;
    __builtin_amdgcn_s_sleep(1);
    if ((++sp & 255u) == 0u) { if (xb_ld(&bar[XB_TMO])) break; if (sp > XB_SPIN_CAP) { atomicAdd(&bar[XB_TMO], 1u); break; } }
  }
  nloc = mine > 0u ? mine : 1u; nx = cnt > 0u ? cnt : 1u;
}
DI void xcd_barrier(const XcdBarrier& b) {
  asm volatile("s_waitcnt vmcnt(0)" ::: "memory");
  __syncthreads();
  if (threadIdx.x == 0) {
    unsigned* bar = b.bar;
    __builtin_amdgcn_s_waitcnt(0);
    unsigned nloc = b.st[0], nx = b.st[1];
    if (nloc == 0u) { xcd_barrier_complete(bar, b.x, nloc, nx); b.st[0] = nloc; b.st[1] = nx; }
    const unsigned old = xb_add(&bar[XB_XSUB(b.x)], 1u);
    const unsigned gen = old / nloc;
    if (old + 1u == (gen + 1u) * nloc) {
      __builtin_amdgcn_fence(__ATOMIC_RELEASE, "agent");
      asm volatile("s_waitcnt vmcnt(0)" ::: "memory");
      const unsigned og = xb_add(&bar[XB_TOP], 1u);
      const unsigned tg = og / nx;
      if (og + 1u == (tg + 1u) * nx) xb_add(&bar[XB_TOPGEN], 1u);
      else XB_SPIN(xb_ld(&bar[XB_TOPGEN]) == tg, bar);
      __builtin_amdgcn_fence(__ATOMIC_ACQUIRE, "agent");
      xb_add(&bar[XB_XGEN(b.x)], 1u);
      asm volatile("s_waitcnt vmcnt(0)" ::: "memory");
    } else {
      XB_SPIN(xb_ld(&bar[XB_XGEN(b.x)]) == gen, bar);
      __builtin_amdgcn_fence(__ATOMIC_ACQUIRE, "agent");
      asm volatile("s_waitcnt vmcnt(0)" ::: "memory");
    }
  }
  __syncthreads();
}

__global__ void __launch_bounds__(512) fwd_megakernel(Params p) {
  extern __shared__ __attribute__((aligned(16))) unsigned char lds_raw[];
  LAS unsigned char* lds = (LAS unsigned char*)lds_raw;
  cg::grid_group grid = cg::this_grid();
  unsigned char* ws = p.ws;
  const int G = gridDim.x, bid = blockIdx.x;
  const float* cosH = (const float*)(ws + WS_COSH); const float* sinH = (const float*)(ws + WS_SINH);
  const float* cosR = (const float*)(ws + WS_COSR); const float* sinR = (const float*)(ws + WS_SINR);

  unsigned* xbar = (unsigned*)(ws + WS_XBAR);
  if (bid == 0) { for (int w = threadIdx.x; w < XCD_BAR_WORDS; w += 512) __hip_atomic_store(xbar + w, 0u, __ATOMIC_RELAXED, __HIP_MEMORY_SCOPE_AGENT); }
  volatile LAS unsigned* xst = (volatile LAS unsigned*)(lds + LDS_BYTES_C - 16);
  if (threadIdx.x == 0) { xst[0] = 0u; xst[1] = 0u; }
#ifndef SKIP_PRO
  prologue(p, lds);
#endif
  grid.sync();
  XcdBarrier xb; xb.bar = xbar; xb.x = xb_xcc_id(); xb.st = xst;
  if (threadIdx.x == 0) (void)xb_add(&xbar[XB_XCNT(xb.x)], 1u);
#pragma unroll
  for (int layer = 0; layer < 4; ++layer) {
    const int i = layer >> 1; const bool odd = layer & 1;
#ifndef SKIP_ROW
    rowwise_phase(p, lds, layer - 1, layer);
#endif
    xcd_barrier(xb);
    {
#ifndef SKIP_SCAN
      if (odd) { for (int bh = bid; bh < 128; bh += G) fox_scan(p, lds, bh); }
#endif
      pg8::Gemm g; g.A = (const bf16_t*)(ws + WS_HBUF); g.lda = 1024; g.K = 1024; g.M = T;
      Epi e; e.out = (bf16_t*)(ws + WS_ZBUF); e.pin = nullptr; e.pslot = 0; e.nK = 0; e.qmode = 0; e.pout = odd ? nullptr : (float*)(ws + WS_PART); e.cosH = cosH; e.sinH = sinH; e.cosR = cosR; e.sinR = sinR;
      if (!odd) { g.Bt = (const bf16_t*)(ws + WS_WEVIN + i * SZ_WEVIN); g.N = 2560; e.ldc = 2560; e.rope64_end = 640; e.rope32_lo = 2432; e.rope32_hi = 2464; }
      else { g.Bt = (const bf16_t*)(ws + WS_WODIN + i * SZ_WODIN); g.N = 4096; e.ldc = 4096; e.rope64_end = 1024; e.rope32_lo = 0; e.rope32_hi = 0; }
      pg8::StaticOrder S; S.init(g.M, g.N, G, bid);
#ifndef SKIP_G1
      pg8::gemm_phase<Epi>(lds, g, S, e);
#endif
    }
    xcd_barrier(xb);
    if (!odd) {
      for (int which = 0; which < 2; ++which) {
        pg8::Gemm g; g.M = T; g.lda = 2560;
        Epi e; e.rope64_end = 0; e.rope32_lo = 0; e.rope32_hi = 0; e.cosH = cosH; e.sinH = sinH; e.cosR = cosR; e.sinR = sinR; e.pout = nullptr; e.pin = (const float*)(ws + WS_PART);
        if (which == 0) { g.A = (const bf16_t*)(ws + WS_ZBUF) + 1792; g.Bt = (const bf16_t*)(ws + WS_WUQ + i * SZ_WUQ); g.N = 768; g.K = 384;
          e.out = (bf16_t*)(ws + WS_QBUF); e.ldc = 768; e.qmode = 1; e.pslot = 0; e.nK = 384; }
        else { g.A = (const bf16_t*)(ws + WS_ZBUF) + 2176; g.Bt = (const bf16_t*)(ws + WS_WUKV + i * SZ_WUKV); g.N = 1024; g.K = 256;
          e.out = (bf16_t*)(ws + WS_HBUF); e.ldc = 1024; e.qmode = 0; e.pslot = 12; e.nK = 256; }
        pg8::StaticOrder S; S.init(g.M, g.N, G, bid);
#ifndef SKIP_G2
        pg8::gemm_phase<Epi>(lds, g, S, e);
#endif
      }
      xcd_barrier(xb);
#ifndef SKIP_ATTE
      attn_even(p, lds, i);
#endif
      xcd_barrier(xb);
    } else {
#ifndef SKIP_ATTO
      attn_odd(p, lds, layer);
#endif
      xcd_barrier(xb);
    }
    {
      pg8::Gemm g; g.A = (const bf16_t*)(ws + WS_OBUF); g.lda = 1024; g.K = 1024; g.M = T; g.N = 1024;
      g.Bt = (const bf16_t*)(ws + (odd ? WS_WODOUT : WS_WEVOUT) + i * SZ_WOUT);
      Epi e; e.out = (bf16_t*)(ws + WS_HBUF); e.ldc = 1024; e.pin = nullptr; e.pslot = 0; e.pout = nullptr; e.nK = 0; e.qmode = 0; e.rope64_end = 0; e.rope32_lo = 0; e.rope32_hi = 0;
      e.cosH = cosH; e.sinH = sinH; e.cosR = cosR; e.sinR = sinR;
      pg8::StaticOrder S; S.init(g.M, g.N, G, bid);
#ifndef SKIP_G3
      pg8::gemm_phase<Epi>(lds, g, S, e);
#endif
    }
    xcd_barrier(xb);
  }
#ifndef SKIP_ROW
  rowwise_phase(p, lds, 3, 4);
#endif
}

constexpr int LDS_BYTES = 155648;
static_assert(LDS_BYTES == LDS_BYTES_C, "LDS size mismatch");

extern "C" void kernel_launch(void* const* d_in, const int* in_sizes, int n_in, void* d_out, int out_size, void* d_ws, size_t ws_size, hipStream_t stream) {
  static int grid_blocks = 0;
  if (grid_blocks == 0) {
    int dev = 0, cus = 0, per_cu = 0;
    if (hipGetDevice(&dev) != hipSuccess || hipDeviceGetAttribute(&cus, hipDeviceAttributeMultiprocessorCount, dev) != hipSuccess) { fprintf(stderr, "device query failed\n"); grid_blocks = -1; return; }
    if (hipFuncSetAttribute((const void*)fwd_megakernel, hipFuncAttributeMaxDynamicSharedMemorySize, LDS_BYTES) != hipSuccess) { fprintf(stderr, "hipFuncSetAttribute failed\n"); grid_blocks = -1; return; }
    if (hipOccupancyMaxActiveBlocksPerMultiprocessor(&per_cu, (const void*)fwd_megakernel, 512, LDS_BYTES) != hipSuccess || per_cu < 1) { fprintf(stderr, "occupancy query: %d\n", per_cu); per_cu = 1; }
    (void)hipGetLastError();
    grid_blocks = cus;
    if (ws_size < WS_END) { fprintf(stderr, "workspace too small: %zu < %zu\n", ws_size, (size_t)WS_END); grid_blocks = -1; return; }
  }
  if (grid_blocks < 0) return;
  Params p{};
  const float** fp = (const float**)&p;
  for (int i = 0; i < 18; ++i) fp[i] = (const float*)d_in[i];
  p.out = (float*)d_out; p.ws = (unsigned char*)d_ws;
  void* args[] = {&p};
  hipError_t e = hipLaunchCooperativeKernel((const void*)fwd_megakernel, dim3(grid_blocks), dim3(512), args, LDS_BYTES, stream);
  if (e != hipSuccess) fprintf(stderr, "cooperative launch failed: %s (grid %d)\n", hipGetErrorString(e), grid_blocks);
}
```

```cpp
#include <hip/hip_runtime.h>
#include <hip/hip_cooperative_groups.h>
#include <cstdio>
#include <type_traits>
namespace cg = cooperative_groups;

#define DI __device__ __forceinline__
#define LAS __attribute__((address_space(3)))
typedef unsigned short bf16_t;
typedef short bf16x8 __attribute__((ext_vector_type(8)));
typedef short s16x4 __attribute__((ext_vector_type(4)));
typedef float f32x2 __attribute__((ext_vector_type(2)));
typedef float f32x4 __attribute__((ext_vector_type(4)));
typedef float f32x16 __attribute__((ext_vector_type(16)));
typedef unsigned u32x2 __attribute__((ext_vector_type(2)));
typedef unsigned u32x4 __attribute__((ext_vector_type(4)));
typedef __bf16 bf16x2_t __attribute__((ext_vector_type(2)));

constexpr int T = 32768, DM = 1024, NB = 16, SEQ = 2048;
constexpr float LOG2E = 1.4426950408889634f;
constexpr float EPS = 1e-6f;
constexpr int LDS_BYTES_C = 155648;

constexpr size_t SZ_WEVIN = 2560ull * 1024 * 2, SZ_WODIN = 4096ull * 1024 * 2, SZ_WUQ = 768ull * 384 * 2, SZ_WUKV = 1024ull * 256 * 2, SZ_WOUT = 1024ull * 1024 * 2;
constexpr size_t WS_WEVIN = 0;
constexpr size_t WS_WODIN = WS_WEVIN + 2 * SZ_WEVIN;
constexpr size_t WS_WUQ = WS_WODIN + 2 * SZ_WODIN;
constexpr size_t WS_WUKV = WS_WUQ + 2 * SZ_WUQ;
constexpr size_t WS_WEVOUT = WS_WUKV + 2 * SZ_WUKV;
constexpr size_t WS_WODOUT = WS_WEVOUT + 2 * SZ_WOUT;
constexpr size_t WS_MOD = WS_WODOUT + 2 * SZ_WOUT;
constexpr size_t WS_COSH = WS_MOD + 4ull * 16 * 3072 * 4;
constexpr size_t WS_SINH = WS_COSH + 2048ull * 32 * 4;
constexpr size_t WS_COSR = WS_SINH + 2048ull * 32 * 4;
constexpr size_t WS_SINR = WS_COSR + 2048ull * 16 * 4;
constexpr size_t WS_LOGF = WS_SINR + 2048ull * 16 * 4;
constexpr size_t WS_FCUM = WS_LOGF + (size_t)T * 8 * 4;
constexpr size_t WS_HBUF = (WS_FCUM + (size_t)T * 8 * 4 + 4095) & ~(size_t)4095;
constexpr size_t WS_OBUF = WS_HBUF + (size_t)T * 1024 * 2;
constexpr size_t WS_ZBUF = WS_OBUF + (size_t)T * 1024 * 2;
constexpr size_t WS_QBUF = WS_ZBUF + (size_t)T * 2560 * 2;
constexpr size_t WS_BAR = WS_ZBUF + (size_t)T * 4096 * 2;
constexpr size_t WS_PART = WS_BAR + 256;
constexpr size_t WS_XBAR = (WS_PART + (size_t)T * 20 * 4 + 4095) & ~(size_t)4095;
constexpr size_t WS_XBF_PRE = WS_XBAR + 16384;
constexpr size_t WS_XBF = WS_XBF_PRE;
constexpr size_t WS_END = WS_XBF + (size_t)T * 1024 * 2;

struct Params {
  const float *x, *c, *w_ada, *b_ada, *g_pre, *g_post, *ev_w_in, *ev_q_norm, *ev_kv_norm, *ev_w_uq, *ev_w_ukv, *ev_sinks, *ev_w_out,
      *od_w_in, *od_forget_bias, *od_lambda, *od_subln, *od_w_out;
  float* out;
  unsigned char* ws;
};

DI int opaque_tid() { int t = threadIdx.x; asm volatile("" : "+v"(t)); return t; }
DI float bflo(unsigned u) { return __uint_as_float(u << 16); }
DI float bfhi(unsigned u) { return __uint_as_float(u & 0xffff0000u); }
DI unsigned pk2(float lo, float hi) { f32x2 f = {lo, hi}; bf16x2_t b = __builtin_convertvector(f, bf16x2_t); return __builtin_bit_cast(unsigned, b); }
DI bf16_t f2bf(float f) { return (bf16_t)(pk2(f, 0.f) & 0xffffu); }
DI float fast_exp2(float x) { return __builtin_amdgcn_exp2f(x); }
DI float silu_f(float x) { return x * __builtin_amdgcn_rcpf(1.f + fast_exp2(-x * LOG2E)); }
template <int CTRL> DI float dpp_mov(float v) { return __builtin_bit_cast(float, __builtin_amdgcn_update_dpp(0, __builtin_bit_cast(int, v), CTRL, 0xf, 0xf, false)); }
DI float wave_sum(float v) {
  v += dpp_mov<0xB1>(v);
  v += dpp_mov<0x4E>(v);
  v += dpp_mov<0x141>(v);
  v += dpp_mov<0x140>(v);
  { const unsigned u = __float_as_uint(v); auto r = __builtin_amdgcn_permlane16_swap(u, u, false, false); v = __uint_as_float(r[0]) + __uint_as_float(r[1]); }
  { const unsigned u = __float_as_uint(v); auto r = __builtin_amdgcn_permlane32_swap(u, u, false, false); v = __uint_as_float(r[0]) + __uint_as_float(r[1]); }
  return v;
}

namespace pg8 {
constexpr int BM = 256, BK = 64, HALF = 128, HTB = HALF * BK * 2, STAGE_BYTES = 8 * HTB, NXCD = 8, WGM = 8;
DI int lds_byte(int r, int c) { const int st = (r >> 4) * 2 + (c >> 5), rr = r & 15, cc = c & 31, ob = rr * 64 + cc * 2; return st * 1024 + (ob ^ (((ob >> 9) & 1) << 5)); }
DI void stage_rc(int b, int& R, int& C) { const int st = b / 1024, sb = b % 1024, swz = sb ^ (((sb >> 9) & 1) << 5); R = (st >> 1) * 16 + swz / 64; C = (st & 1) * 32 + (swz % 64) / 2; }
DI int perm32(int rho) { const int n = rho >> 4, i = rho & 15; return 8 * (i >> 2) + 4 * n + (i & 3); }
struct Unit { int pm, pn; };
struct Gemm { const bf16_t* A; const bf16_t* Bt; int M, N, K, lda; };
struct StaticOrder {
  int nM, nN, nwg, G, c;
  DI void init(int M, int N, int G_, int c_) { nM = M / BM; nN = N / BM; nwg = nM * nN; G = G_; c = c_; }
  DI bool next(int i, Unit& u) const {
    const long L = (long)i * G + c; if (L >= nwg) return false;
    int wgid = (int)L; { const int q = nwg / NXCD, r = nwg % NXCD, xcd = wgid % NXCD, off = wgid / NXCD; wgid = (xcd < r ? xcd * (q + 1) : r * (q + 1) + (xcd - r) * q) + off; }
    const int nig = WGM * nN, gid = wgid / nig, fm = gid * WGM, gsz = (nM - fm) < WGM ? (nM - fm) : WGM;
    u.pm = fm + ((wgid % nig) % gsz); u.pn = (wgid % nig) / gsz; return true;
  }
};

template <class Epi>
DI void gemm_phase(LAS unsigned char* lds, const Gemm g, const StaticOrder& S, const Epi& E) {
  const int tid = opaque_tid(), wid = __builtin_amdgcn_readfirstlane(tid >> 6), lane = tid & 63, wr = wid >> 2, wc = wid & 3, fr = lane & 15, fq = lane >> 4;
  const int K = g.K, nt = K / BK, lda = g.lda;
  unsigned voffA[2], voffB[2];
#pragma unroll
  for (int i = 0; i < 2; ++i) { int R, C; stage_rc(tid * 16 + i * 8192, R, C); const int Rb = (R & ~31) + perm32(R & 31);
    voffA[i] = (unsigned)(R * lda + C) * 2u; voffB[i] = (unsigned)(Rb * K + C) * 2u; }
  const size_t kstep = (size_t)(BK * 2);
  const size_t hstepA = (size_t)HALF * lda * 2, hstepB = (size_t)HALF * K * 2;
  const size_t tstepA = 2 * hstepA, tstepB = 2 * hstepB;
  const unsigned ldsw = (unsigned)wid * 1024u;
  const int aoff = lds_byte(wr * 64 + fr, fq * 8), boff = lds_byte(wc * 32 + fr, fq * 8);
#define PG8_SA(b, h) (((b) * 2 + (h)) * HTB)
#define PG8_SB(b, h) ((4 + (b) * 2 + (h)) * HTB)
#define PG8_STAGE(bufoff, gbase, voff) do { _Pragma("unroll") for (int _i = 0; _i < 2; ++_i) \
    __builtin_amdgcn_global_load_lds((const unsigned*)((const char*)(gbase) + (voff)[_i]), (LAS unsigned*)(lds + (bufoff) + ldsw + _i * 8192), 16, 0, 0); } while (0)
#define PG8_LDA(dst, b, h) do { _Pragma("unroll") for (int m = 0; m < 4; ++m) _Pragma("unroll") for (int k = 0; k < 2; ++k) dst[m][k] = *(const LAS bf16x8*)(lds + PG8_SA(b, h) + aoff + m * 2048 + k * 1024); } while (0)
#define PG8_LDB(dst, b, h) do { _Pragma("unroll") for (int n = 0; n < 2; ++n) _Pragma("unroll") for (int k = 0; k < 2; ++k) dst[n][k] = *(const LAS bf16x8*)(lds + PG8_SB(b, h) + boff + n * 2048 + k * 1024); } while (0)
#define PG8_MMA(ai, bj, At, Bt) do { __builtin_amdgcn_s_setprio(1); _Pragma("unroll") for (int m = 0; m < 4; ++m) _Pragma("unroll") for (int n = 0; n < 2; ++n) _Pragma("unroll") for (int k = 0; k < 2; ++k) \
    acc[ai][bj][m][n] = __builtin_amdgcn_mfma_f32_16x16x32_bf16(Bt[n][k], At[m][k], acc[ai][bj][m][n], 0, 0, 0); __builtin_amdgcn_s_setprio(0); } while (0)
#define PG8_WAIT_V(n) asm volatile("s_waitcnt vmcnt(" #n ")" ::: "memory")
#define PG8_WAIT_L(n) asm volatile("s_waitcnt lgkmcnt(" #n ")" ::: "memory")
#define PG8_BAR __builtin_amdgcn_s_barrier()
#define PG8_SCHED __builtin_amdgcn_sched_barrier(0)
  Unit cur, nxt; int ui = 0;
  if (!S.next(0, cur)) return;
  f32x4 acc[2][2][4][2];
#pragma unroll
  for (int a = 0; a < 2; ++a)
#pragma unroll
    for (int b = 0; b < 2; ++b)
#pragma unroll
      for (int m = 0; m < 4; ++m)
#pragma unroll
        for (int n = 0; n < 2; ++n) acc[a][b][m][n] = (f32x4){0.f, 0.f, 0.f, 0.f};
  bf16x8 At[4][2], B0[2][2], B1[2][2];
  const char* cA = (const char*)g.A + (size_t)cur.pm * tstepA; const char* cB = (const char*)g.Bt + (size_t)cur.pn * tstepB;
  PG8_STAGE(PG8_SB(0, 0), cB, voffB); PG8_STAGE(PG8_SA(0, 0), cA, voffA); PG8_STAGE(PG8_SB(0, 1), cB + hstepB, voffB); PG8_STAGE(PG8_SA(0, 1), cA + hstepA, voffA);
  if (wr == 1) PG8_BAR;
  PG8_WAIT_V(4); PG8_BAR;
  PG8_STAGE(PG8_SB(1, 0), cB + kstep, voffB); PG8_STAGE(PG8_SA(1, 0), cA + kstep, voffA); PG8_STAGE(PG8_SB(1, 1), cB + hstepB + kstep, voffB);
  PG8_WAIT_V(6); PG8_BAR;
  for (;;) {
    const bool has_next = S.next(ui + 1, nxt);
    const char* nA = has_next ? (const char*)g.A + (size_t)nxt.pm * tstepA : cA; const char* nB = has_next ? (const char*)g.Bt + (size_t)nxt.pn * tstepB : cB;
    for (int t = 0; t < nt; t += 2) {
      const bool last = (t == nt - 2);
      const char* a1 = cA + (size_t)(t + 1) * kstep;
      const char* a2 = last ? nA : cA + (size_t)(t + 2) * kstep; const char* b2 = last ? nB : cB + (size_t)(t + 2) * kstep;
      const char* a3 = a2 + kstep; const char* b3 = b2 + kstep;
      PG8_LDB(B0, 0, 0); PG8_SCHED; PG8_LDA(At, 0, 0); PG8_STAGE(PG8_SA(1, 1), a1 + hstepA, voffA);
      PG8_WAIT_L(8); PG8_BAR; PG8_WAIT_L(0); PG8_MMA(0, 0, At, B0); PG8_BAR; PG8_SCHED;
      PG8_LDB(B1, 0, 1); PG8_STAGE(PG8_SB(0, 0), b2, voffB);
      PG8_BAR; PG8_WAIT_L(0); PG8_MMA(0, 1, At, B1); PG8_BAR;
      PG8_LDA(At, 0, 1); PG8_STAGE(PG8_SA(0, 0), a2, voffA);
      PG8_BAR; PG8_WAIT_L(0); PG8_MMA(1, 0, At, B0); PG8_BAR; PG8_SCHED;
      PG8_STAGE(PG8_SB(0, 1), b2 + hstepB, voffB);
      PG8_WAIT_V(6); PG8_BAR; PG8_MMA(1, 1, At, B1); PG8_BAR;
      PG8_LDB(B0, 1, 0); PG8_SCHED; PG8_LDA(At, 1, 0); PG8_STAGE(PG8_SA(0, 1), a2 + hstepA, voffA);
      PG8_WAIT_L(8); PG8_BAR; PG8_WAIT_L(0); PG8_MMA(0, 0, At, B0); PG8_BAR; PG8_SCHED;
      PG8_LDB(B1, 1, 1); PG8_STAGE(PG8_SB(1, 0), b3, voffB);
      PG8_BAR; PG8_WAIT_L(0); PG8_MMA(0, 1, At, B1); PG8_BAR;
      PG8_LDA(At, 1, 1); PG8_STAGE(PG8_SA(1, 0), a3, voffA);
      PG8_BAR; PG8_WAIT_L(0); PG8_MMA(1, 0, At, B0); PG8_BAR; PG8_SCHED;
      PG8_STAGE(PG8_SB(1, 1), b3 + hstepB, voffB);
      PG8_WAIT_V(6); PG8_BAR; PG8_MMA(1, 1, At, B1); PG8_BAR;
    }
    E(acc, cur, wr, wc, fr, fq);
    if (!has_next) break;
#pragma unroll
    for (int a = 0; a < 2; ++a)
#pragma unroll
      for (int b = 0; b < 2; ++b)
#pragma unroll
        for (int m = 0; m < 4; ++m)
#pragma unroll
          for (int n = 0; n < 2; ++n) acc[a][b][m][n] = (f32x4){0.f, 0.f, 0.f, 0.f};
    cur = nxt; cA = nA; cB = nB; ++ui;
  }
  PG8_WAIT_V(0);
  if (wr == 0) PG8_BAR;
  PG8_BAR;
#undef PG8_SA
#undef PG8_SB
#undef PG8_STAGE
#undef PG8_LDA
#undef PG8_LDB
#undef PG8_MMA
#undef PG8_WAIT_V
#undef PG8_WAIT_L
#undef PG8_BAR
#undef PG8_SCHED
}
}

struct Epi {
  bf16_t* out; int ldc;
  int rope64_end;
  int rope32_lo, rope32_hi;
  int qmode;
  const float* pin; int nK;
  int pslot;
  float* pout;
  const float *cosH, *sinH, *cosR, *sinR;
  DI void operator()(const f32x4 (&acc)[2][2][4][2], const pg8::Unit& u, int wr, int wc, int fr, int fq) const {
    const int row0 = u.pm * 256 + wr * 64 + fr;
    int rt[2];
#pragma unroll
    for (int bj = 0; bj < 2; ++bj) {
      const int cw = u.pn * 256 + bj * 128 + wc * 32;
      rt[bj] = 0;
      if (cw < rope64_end) rt[bj] = 1;
      else if (cw >= rope32_lo && cw < rope32_hi) rt[bj] = 2;
      else if (qmode && ((cw >> 5) % 3) == 2) rt[bj] = 2;
    }
    const int tt = rt[0] | rt[1];
    const float* ctab = (tt == 1) ? cosH + (16 * (wc & 1) + 4 * fq) : cosR + 4 * fq;
    const float* stab = (tt == 1) ? sinH + (16 * (wc & 1) + 4 * fq) : sinR + 4 * fq;
    const int tstride = (tt == 1) ? 32 : 16;
    int ps[2] = {-1, -1};
    if (pout) {
#pragma unroll
      for (int bj = 0; bj < 2; ++bj) { const int cw = u.pn * 256 + bj * 128 + wc * 32;
        if (cw >= 1792 && cw < 2432) ps[bj] = ((cw - 1792) >> 7) * 4 + wc; }
    }
#pragma unroll
    for (int ai = 0; ai < 2; ++ai) {
      f32x4 cv[4], sv[4]; float rs[4];
#pragma unroll
      for (int m = 0; m < 4; ++m) {
        const int row = row0 + ai * 128 + m * 16;
        if (tt) { const int pos = row & (SEQ - 1); cv[m] = *(const f32x4*)(ctab + pos * tstride); sv[m] = *(const f32x4*)(stab + pos * tstride); }
        rs[m] = 1.f;
        if (pin) { const f32x4 p0 = *(const f32x4*)(pin + (size_t)row * 20 + pslot), p1 = *(const f32x4*)(pin + (size_t)row * 20 + pslot + 4);
          float ss = ((p0[0] + p0[1]) + (p0[2] + p0[3])) + ((p1[0] + p1[1]) + (p1[2] + p1[3]));
          if (nK == 384) { const f32x4 p2 = *(const f32x4*)(pin + (size_t)row * 20 + pslot + 8); ss += (p2[0] + p2[1]) + (p2[2] + p2[3]); }
          rs[m] = rsqrtf(ss / (float)nK + EPS); }
      }
#pragma unroll
      for (int m = 0; m < 4; ++m) {
        const int row = row0 + ai * 128 + m * 16;
#pragma unroll
        for (int bj = 0; bj < 2; ++bj) {
          const int c0 = u.pn * 256 + bj * 128 + wc * 32 + 8 * fq;
          f32x4 v0 = acc[ai][bj][m][0] * rs[m], v1 = acc[ai][bj][m][1] * rs[m];
          if (ps[bj] >= 0) {
            float sq = (v0[0] * v0[0] + v0[1] * v0[1]) + (v0[2] * v0[2] + v0[3] * v0[3]) + (v1[0] * v1[0] + v1[1] * v1[1]) + (v1[2] * v1[2] + v1[3] * v1[3]);
            sq += __shfl_xor(sq, 16); sq += __shfl_xor(sq, 32);
            if (fq == 0) pout[(size_t)row * 20 + ps[bj]] = sq;
          }
          if (rt[bj]) {
            const f32x4 o1 = v0 * cv[m] - v1 * sv[m], o2 = v1 * cv[m] + v0 * sv[m];
            v0 = o1; v1 = o2;
          }
          u32x4 w; w.x = pk2(v0[0], v0[1]); w.y = pk2(v0[2], v0[3]); w.z = pk2(v1[0], v1[1]); w.w = pk2(v1[2], v1[3]);
          *(u32x4*)(out + (size_t)row * ldc + c0) = w;
        }
      }
    }
  }
};

DI int ropeperm64(int p) { const int g = p >> 3, r = p & 7; return r < 4 ? 4 * g + r : 32 + 4 * g + (r - 4); }
DI int ropeperm32(int p) { const int g = p >> 3, r = p & 7; return r < 4 ? 4 * g + r : 16 + 4 * g + (r - 4); }
DI int srccol(int kind, int n) {
  if (kind == 0) {
    if (n < 512) return 672 + (n & ~63) + ropeperm64(n & 63);
    if (n < 640) return 1184 + ((n - 512) & ~63) + ropeperm64(n & 63);
    if (n < 768) return 1312 + (n - 640);
    if (n < 1792) return 1440 + (n - 768);
    if (n < 2176) return n - 1792;
    if (n < 2432) return 384 + (n - 2176);
    if (n < 2464) return 640 + ropeperm32(n - 2432);
    return -1;
  }
  if (kind == 1) {
    if (n < 1024) return (n & ~63) + ropeperm64(n & 63);
    if (n < 3072) return n;
    return 3080 + (n - 3072);
  }
  if (kind == 2) { const int hd = n / 96, p = n - hd * 96; return hd * 96 + (p < 64 ? p : 64 + ropeperm32(p - 64)); }
  return n;
}
struct ConvJob { const float* W; const float* g; bf16_t* Wt; int Nsrc, K, kind, tn, tk; };
DI bool conv_decode(const Params& p, int job, ConvJob& j) {
  constexpr int NT0 = 40 * 16, NT1 = 64 * 16, NT2 = 12 * 6, NT3 = 16 * 4, NT4 = 16 * 16;
  constexpr int PER_I = NT0 + NT1 + NT2 + NT3 + 2 * NT4;
  if (job >= 2 * PER_I) return false;
  unsigned char* ws = p.ws;
  const int i = job / PER_I; int t = job - i * PER_I;
  j.g = nullptr;
  if (t < NT0) { j.W = p.ev_w_in + (size_t)i * 1024 * 2464; j.Nsrc = 2464; j.K = 1024; j.Wt = (bf16_t*)(ws + WS_WEVIN + i * SZ_WEVIN); j.kind = 0; j.tn = t / 16; j.tk = t % 16; return true; }
  t -= NT0;
  if (t < NT1) { j.W = p.od_w_in + (size_t)i * 1024 * 4104; j.Nsrc = 4104; j.K = 1024; j.Wt = (bf16_t*)(ws + WS_WODIN + i * SZ_WODIN); j.kind = 1; j.tn = t / 16; j.tk = t % 16; return true; }
  t -= NT1;
  if (t < NT2) { j.W = p.ev_w_uq + (size_t)i * 384 * 768; j.Nsrc = 768; j.K = 384; j.Wt = (bf16_t*)(ws + WS_WUQ + i * SZ_WUQ); j.kind = 2; j.g = p.ev_q_norm + i * 384; j.tn = t / 6; j.tk = t % 6; return true; }
  t -= NT2;
  if (t < NT3) { j.W = p.ev_w_ukv + (size_t)i * 256 * 1024; j.Nsrc = 1024; j.K = 256; j.Wt = (bf16_t*)(ws + WS_WUKV + i * SZ_WUKV); j.kind = 3; j.g = p.ev_kv_norm + i * 256; j.tn = t / 4; j.tk = t % 4; return true; }
  t -= NT3;
  if (t < NT4) { j.W = p.ev_w_out + (size_t)i * 1024 * 1024; j.Nsrc = 1024; j.K = 1024; j.Wt = (bf16_t*)(ws + WS_WEVOUT + i * SZ_WOUT); j.kind = 4; j.tn = t / 16; j.tk = t % 16; return true; }
  t -= NT4;
  j.W = p.od_w_out + (size_t)i * 1024 * 1024; j.Nsrc = 1024; j.K = 1024; j.Wt = (bf16_t*)(ws + WS_WODOUT + i * SZ_WOUT); j.kind = 4; j.tn = t / 16; j.tk = t % 16; return true;
}
template <int NJ>
DI void convert_tiles(const Params& p, LAS unsigned char* lds, int job0, int jstride) {
  const int tid = opaque_tid();
  const int n4 = (tid & 15) * 4, kq = tid >> 4;
  ConvJob j[NJ] = {}; bool ok[NJ]; f32x4 v[NJ][2];
#pragma unroll
  for (int q = 0; q < NJ; ++q) {
    ok[q] = conv_decode(p, job0 + q * jstride, j[q]);
    const int sc = ok[q] ? srccol(j[q].kind, j[q].tn * 64 + n4) : -1;
#pragma unroll
    for (int e = 0; e < 2; ++e) {
      const int k = j[q].tk * 64 + kq + 32 * e;
      v[q][e] = (f32x4){0.f, 0.f, 0.f, 0.f};
      if (sc >= 0) { v[q][e] = *(const f32x4*)(j[q].W + (size_t)k * j[q].Nsrc + sc); if (j[q].g) v[q][e] = v[q][e] * j[q].g[k]; }
    }
  }
#pragma unroll
  for (int q = 0; q < NJ; ++q) {
    LAS bf16_t* tile = (LAS bf16_t*)(lds + q * 9216);
#pragma unroll
    for (int e = 0; e < 2; ++e)
#pragma unroll
      for (int i = 0; i < 4; ++i) tile[(n4 + i) * 72 + kq + 32 * e] = f2bf(v[q][e][i]);
  }
  __syncthreads();
#pragma unroll
  for (int q = 0; q < NJ; ++q) {
    if (ok[q]) {
      LAS bf16_t* tile = (LAS bf16_t*)(lds + q * 9216);
      const int n2 = tid >> 3, ch = tid & 7;
      const u32x4 w = *(const LAS u32x4*)(tile + n2 * 72 + ch * 8);
      *(u32x4*)(j[q].Wt + (size_t)(j[q].tn * 64 + n2) * j[q].K + j[q].tk * 64 + ch * 8) = w;
    }
  }
  __syncthreads();
}

DI void prologue(const Params& p, LAS unsigned char* lds) {
  const int tid = opaque_tid(), G = gridDim.x, bid = blockIdx.x;
  unsigned char* ws = p.ws;
  for (int idx = bid * 512 + tid; idx < 2048 * 48; idx += G * 512) {
    const bool isH = idx < 2048 * 32;
    const int j = isH ? idx : idx - 2048 * 32;
    const int pos = isH ? (j >> 5) : (j >> 4), i = isH ? (j & 31) : (j & 15);
    const float e = isH ? (float)(2 * i) * (1.f / 64.f) : (float)(2 * i) * (1.f / 32.f);
    const float inv = fast_exp2(-e * 13.287712379549449f);
    const float ang = (float)pos * inv;
    double t = (double)ang * 0.15915494309189535; t -= rint(t);
    const float fr = (float)t;
    const float cv = __builtin_amdgcn_cosf(fr), sv = __builtin_amdgcn_sinf(fr);
    if (isH) { ((float*)(ws + WS_COSH))[j] = cv; ((float*)(ws + WS_SINH))[j] = sv; }
    else { ((float*)(ws + WS_COSR))[j] = cv; ((float*)(ws + WS_SINR))[j] = sv; }
  }
  for (int job = bid; job < 4624; job += 4 * G) convert_tiles<4>(p, lds, job, G);
  const int item0 = G - 1 - bid;
  if (item0 < 192) {
    LAS float* cond = (LAS float*)lds;
    LAS float* red = (LAS float*)(lds + 65536);
    for (int e = tid; e < 16 * 1024; e += 512) { const int b = e >> 10, k = e & 1023; cond[k * 16 + b] = silu_f(p.c[e]); }
    __syncthreads();
    for (int item = item0; item < 192; item += G) {
      const int l = item / 48, n0 = (item % 48) * 64;
      const int col = tid & 63, kg = tid >> 6;
      float a[16];
#pragma unroll
      for (int b = 0; b < 16; ++b) a[b] = 0.f;
      const float* wp = p.w_ada + (size_t)l * 1024 * 3072 + n0 + col;
      for (int k0 = kg * 128; k0 < kg * 128 + 128; k0 += 16) {
        float wv[16];
#pragma unroll
        for (int e = 0; e < 16; ++e) wv[e] = wp[(size_t)(k0 + e) * 3072];
#pragma unroll
        for (int e = 0; e < 16; ++e) {
          const float w = wv[e]; const int k = k0 + e;
#pragma unroll
          for (int b4 = 0; b4 < 4; ++b4) { const f32x4 cv = *(const LAS f32x4*)(cond + k * 16 + b4 * 4);
            a[b4 * 4 + 0] += cv[0] * w; a[b4 * 4 + 1] += cv[1] * w; a[b4 * 4 + 2] += cv[2] * w; a[b4 * 4 + 3] += cv[3] * w; }
        }
      }
#pragma unroll
      for (int b = 0; b < 16; ++b) red[(kg * 16 + b) * 64 + col] = a[b];
      __syncthreads();
      for (int e = tid; e < 1024; e += 512) { const int b = e >> 6, cc = e & 63; float s = 0.f;
#pragma unroll
        for (int k8 = 0; k8 < 8; ++k8) s += red[(k8 * 16 + b) * 64 + cc];
        ((float*)(ws + WS_MOD))[((size_t)l * 16 + b) * 3072 + n0 + cc] = s + p.b_ada[l * 3072 + n0 + cc]; }
      __syncthreads();
    }
  }
}

DI void rowwise_phase(const Params& p, LAS unsigned char* lds, int lp, int ln) {
  const int tid = opaque_tid(), lane = tid & 63, wid = tid >> 6;
  const int gw = blockIdx.x * 8 + wid, nw = gridDim.x * 8;
  unsigned char* ws = p.ws;
  const float* mod = (const float*)(ws + WS_MOD);
  const bf16_t* ybuf = (const bf16_t*)(ws + WS_HBUF);
  bf16_t* hbuf = (bf16_t*)(ws + WS_HBUF);
  const bool ff = (ln < 4) && (ln & 1);
  LAS f32x4* wl = (LAS f32x4*)lds;
  if (ff) {
    const float* w = p.od_w_in + (size_t)(ln >> 1) * 1024 * 4104 + 3072;
    for (int c = tid; c < 1024; c += 512) {
      const f32x4 w0 = *(const f32x4*)(w + (size_t)c * 4104), w1 = *(const f32x4*)(w + (size_t)c * 4104 + 4);
      const int ln_ = (c & 511) >> 3, e = c & 7, j = c >> 9;
      wl[(j * 8 + e) * 64 + ln_] = w0; wl[1024 + (j * 8 + e) * 64 + ln_] = w1;
    }
    __syncthreads();
  }
  const int RPW = (T + nw - 1) / nw;
  float gpo[2][8], gpr[2][8], mgt[2][8], msh[2][8], msc[2][8];
#pragma unroll
  for (int j = 0; j < 2; ++j)
#pragma unroll
    for (int e = 0; e < 8; ++e) { gpo[j][e] = 0.f; gpr[j][e] = 0.f; mgt[j][e] = 0.f; msh[j][e] = 0.f; msc[j][e] = 0.f; }
#pragma unroll
  for (int j = 0; j < 2; ++j)
#pragma unroll
    for (int q = 0; q < 2; ++q) {
      const int c = 8 * lane + 512 * j + 4 * q;
      if (lp >= 0) { const f32x4 t = *(const f32x4*)(p.g_post + lp * DM + c); gpo[j][4 * q] = t[0]; gpo[j][4 * q + 1] = t[1]; gpo[j][4 * q + 2] = t[2]; gpo[j][4 * q + 3] = t[3]; }
      if (ln < 4) { const f32x4 t = *(const f32x4*)(p.g_pre + ln * DM + c); gpr[j][4 * q] = t[0]; gpr[j][4 * q + 1] = t[1]; gpr[j][4 * q + 2] = t[2]; gpr[j][4 * q + 3] = t[3]; }
    }
  int bcur = -1;
  for (int rr = 0; rr < RPW; ++rr) {
    const int row = gw * RPW + rr;
    if (row >= T) break;
    const int b = row >> 11;
    if (b != bcur) {
      bcur = b;
#pragma unroll
      for (int j = 0; j < 2; ++j)
#pragma unroll
        for (int q = 0; q < 2; ++q) {
          const int c = 8 * lane + 512 * j + 4 * q;
          if (lp >= 0) { const f32x4 t = *(const f32x4*)(mod + ((size_t)lp * 16 + b) * 3072 + 2048 + c); mgt[j][4 * q] = t[0]; mgt[j][4 * q + 1] = t[1]; mgt[j][4 * q + 2] = t[2]; mgt[j][4 * q + 3] = t[3]; }
          if (ln < 4) {
            const f32x4 t = *(const f32x4*)(mod + ((size_t)ln * 16 + b) * 3072 + c); msh[j][4 * q] = t[0]; msh[j][4 * q + 1] = t[1]; msh[j][4 * q + 2] = t[2]; msh[j][4 * q + 3] = t[3];
            const f32x4 u = *(const f32x4*)(mod + ((size_t)ln * 16 + b) * 3072 + 1024 + c); msc[j][4 * q] = u[0] + 1.f; msc[j][4 * q + 1] = u[1] + 1.f; msc[j][4 * q + 2] = u[2] + 1.f; msc[j][4 * q + 3] = u[3] + 1.f;
          }
        }
    }
    float xv[2][8];
    bf16_t* xbf = (bf16_t*)(ws + WS_XBF) + (size_t)row * DM;
#pragma unroll
    for (int j = 0; j < 2; ++j) {
      const int c = 8 * lane + 512 * j;
      if (lp <= 0) {
        const f32x4 a0 = *(const f32x4*)(p.x + (size_t)row * DM + c), a1 = *(const f32x4*)(p.x + (size_t)row * DM + c + 4);
        xv[j][0] = a0[0]; xv[j][1] = a0[1]; xv[j][2] = a0[2]; xv[j][3] = a0[3]; xv[j][4] = a1[0]; xv[j][5] = a1[1]; xv[j][6] = a1[2]; xv[j][7] = a1[3];
      } else {
        const u32x4 u = *(const u32x4*)(xbf + c);
#pragma unroll
        for (int e = 0; e < 4; ++e) { xv[j][2 * e] = bflo(u[e]); xv[j][2 * e + 1] = bfhi(u[e]); }
      }
    }
    if (lp >= 0) {
      float yv[2][8]; float ss = 0.f;
#pragma unroll
      for (int j = 0; j < 2; ++j) {
        const u32x4 u = *(const u32x4*)(ybuf + (size_t)row * DM + 8 * lane + 512 * j);
#pragma unroll
        for (int e = 0; e < 4; ++e) { yv[j][2 * e] = bflo(u[e]); yv[j][2 * e + 1] = bfhi(u[e]); ss += yv[j][2 * e] * yv[j][2 * e] + yv[j][2 * e + 1] * yv[j][2 * e + 1]; }
      }
      ss = wave_sum(ss);
      const float rs = rsqrtf(ss * (1.f / DM) + EPS);
#pragma unroll
      for (int j = 0; j < 2; ++j) {
        const int c = 8 * lane + 512 * j;
#pragma unroll
        for (int e = 0; e < 8; ++e) xv[j][e] += mgt[j][e] * (yv[j][e] * rs * gpo[j][e]);
        if (ln >= 4) {
          *(f32x4*)(p.out + (size_t)row * DM + c) = (f32x4){xv[j][0], xv[j][1], xv[j][2], xv[j][3]};
          *(f32x4*)(p.out + (size_t)row * DM + c + 4) = (f32x4){xv[j][4], xv[j][5], xv[j][6], xv[j][7]};
        } else {
          u32x4 w; w.x = pk2(xv[j][0], xv[j][1]); w.y = pk2(xv[j][2], xv[j][3]); w.z = pk2(xv[j][4], xv[j][5]); w.w = pk2(xv[j][6], xv[j][7]);
          *(u32x4*)(xbf + c) = w;
        }
      }
    }
    if (ln < 4) {
      float ss = 0.f;
#pragma unroll
      for (int j = 0; j < 2; ++j)
#pragma unroll
        for (int e = 0; e < 8; ++e) ss += xv[j][e] * xv[j][e];
      ss = wave_sum(ss);
      const float rs = rsqrtf(ss * (1.f / DM) + EPS);
      float zf[8];
#pragma unroll
      for (int h = 0; h < 8; ++h) zf[h] = 0.f;
#pragma unroll
      for (int j = 0; j < 2; ++j) {
        const int c = 8 * lane + 512 * j;
        float hv[8];
#pragma unroll
        for (int e = 0; e < 8; ++e) hv[e] = (xv[j][e] * rs * gpr[j][e]) * msc[j][e] + msh[j][e];
        u32x4 w; w.x = pk2(hv[0], hv[1]); w.y = pk2(hv[2], hv[3]); w.z = pk2(hv[4], hv[5]); w.w = pk2(hv[6], hv[7]);
        *(u32x4*)(hbuf + (size_t)row * DM + c) = w;
        if (ff) {
#pragma unroll
          for (int e = 0; e < 8; ++e) {
            const f32x4 w0 = wl[(j * 8 + e) * 64 + lane], w1 = wl[1024 + (j * 8 + e) * 64 + lane];
            zf[0] += hv[e] * w0[0]; zf[1] += hv[e] * w0[1]; zf[2] += hv[e] * w0[2]; zf[3] += hv[e] * w0[3];
            zf[4] += hv[e] * w1[0]; zf[5] += hv[e] * w1[1]; zf[6] += hv[e] * w1[2]; zf[7] += hv[e] * w1[3];
          }
        }
      }
      if (ff) {
        const bool b5 = lane & 32, b4 = lane & 16, b3 = lane & 8;
        float w4[4], u2[2], t;
#pragma unroll
        for (int k = 0; k < 4; ++k) { const float send = b5 ? zf[k] : zf[4 + k], keep = b5 ? zf[4 + k] : zf[k]; w4[k] = keep + __shfl_xor(send, 32); }
#pragma unroll
        for (int k = 0; k < 2; ++k) { const float send = b4 ? w4[k] : w4[2 + k], keep = b4 ? w4[2 + k] : w4[k]; u2[k] = keep + __shfl_xor(send, 16); }
        { const float send = b3 ? u2[0] : u2[1], keep = b3 ? u2[1] : u2[0]; t = keep + __shfl_xor(send, 8); }
        t += __shfl_xor(t, 4); t += __shfl_xor(t, 2); t += __shfl_xor(t, 1);
        if ((lane & 7) == 0) {
          const int h = lane >> 3;
          const float z = t + p.od_forget_bias[(ln >> 1) * 8 + h];
          const float ls = fminf(z, 0.f) - __builtin_amdgcn_logf(1.f + fast_exp2(-fabsf(z) * LOG2E)) * 0.6931471805599453f;
          ((float*)(ws + WS_LOGF))[(size_t)row * 8 + h] = ls;
        }
      }
    }
  }
  __syncthreads();
}

DI void fox_scan(const Params& p, LAS unsigned char* lds, int bh) {
  const int tid = opaque_tid();
  const int b = bh >> 3, h = bh & 7;
  const float* logf_ = (const float*)(p.ws + WS_LOGF);
  float* fcum = (float*)(p.ws + WS_FCUM) + (size_t)bh * SEQ;
  LAS float* s = (LAS float*)lds;
  float v[4];
#pragma unroll
  for (int j = 0; j < 4; ++j) v[j] = logf_[((size_t)b * SEQ + 4 * tid + j) * 8 + h];
  v[1] += v[0]; v[2] += v[1]; v[3] += v[2];
  s[tid] = v[3];
  __syncthreads();
  for (int off = 1; off < 512; off <<= 1) {
    float t = 0.f;
    if (tid >= off) t = s[tid - off];
    __syncthreads();
    s[tid] += t;
    __syncthreads();
  }
  const float excl = s[tid] - v[3];
#pragma unroll
  for (int j = 0; j < 4; ++j) fcum[4 * tid + j] = -8.0f * (excl + v[j]);
  __syncthreads();
}

struct AttnArgs { const bf16_t *q, *k, *k2, *v, *gate; bf16_t* out; const float* fcum; int ldq, ldk, ldk2, ldv, ldo, ldg; float sl2, sink; };

DI float half_max(float x) {
  const unsigned u = __float_as_uint(x);
  auto r = __builtin_amdgcn_permlane32_swap(u, u, false, false);
  return fmaxf(__uint_as_float(r[0]), __uint_as_float(r[1]));
}
DI float half_sum(float x) {
  const unsigned u = __float_as_uint(x);
  auto r = __builtin_amdgcn_permlane32_swap(u, u, false, false);
  return __uint_as_float(r[0]) + __uint_as_float(r[1]);
}


DI void epi_block(const f32x16& O, float inv, int hh, const bf16_t* gate_row, bf16_t* out_row) {
#pragma unroll
  for (int g = 0; g < 4; g += 2) {
    float v[8];
#pragma unroll
    for (int e = 0; e < 4; ++e) {
      auto r = __builtin_amdgcn_permlane32_swap(__float_as_uint(O[4 * g + e] * inv), __float_as_uint(O[4 * (g + 1) + e] * inv), false, false);
      v[e] = __uint_as_float(r[0]); v[4 + e] = __uint_as_float(r[1]);
    }
    const int c = 8 * g + 8 * hh;
    if (gate_row) {
      const u32x4 gv = *(const u32x4*)(gate_row + c);
#pragma unroll
      for (int e = 0; e < 4; ++e) { v[2 * e] *= silu_f(bflo(gv[e])); v[2 * e + 1] *= silu_f(bfhi(gv[e])); }
    }
    u32x4 w; w.x = pk2(v[0], v[1]); w.y = pk2(v[2], v[3]); w.z = pk2(v[4], v[5]); w.w = pk2(v[6], v[7]);
    *(u32x4*)(out_row + c) = w;
  }
}

template <int N> DI void wait_vmcnt() { asm volatile("s_waitcnt vmcnt(%0)" ::"n"(N) : "memory"); }
DI void raw_barrier() { asm volatile("" ::: "memory"); __builtin_amdgcn_s_barrier(); asm volatile("" ::: "memory"); }

template <int DQK, int DV, int MODE>
DI void attn_item(LAS unsigned char* lds, const AttnArgs& a, int qb) {
  constexpr int KSTR = DQK * 2 + 16, VSTR = (DV == 64) ? 192 : 320;
  constexpr int KG16 = KSTR / 16, VG16 = VSTR / 16;
  constexpr int KCH = KG16, VCH = VG16, NCH = KCH + VCH;
  constexpr int TILE = NCH * 1024 + (MODE == 2 ? 2048 : 0);
  constexpr int NSLOT = (NCH + 7) / 8, REM = NCH - 8 * (NSLOT - 1);
  constexpr int FX = (MODE == 2) ? 1 : 0;
  constexpr int NKS = DQK / 16, NBLK = DV / 32;
  static_assert(5 * TILE <= 155648, "ring too large");
  const int tid = opaque_tid(), wid = __builtin_amdgcn_readfirstlane(tid >> 6), lane = tid & 63, r = lane & 31, hh = lane >> 5;
  const int q0 = qb * 256, qw = q0 + 32 * wid, myq = qw + r;
  const float c = a.sl2, tau = 8.0f / a.sl2;
  bf16x8 qf[NKS];
#pragma unroll
  for (int ks = 0; ks < NKS; ++ks) qf[ks] = *(const bf16x8*)(a.q + (size_t)myq * a.ldq + 16 * ks + 8 * hh);
  int lo = 0; const int hi = 4 * (qb + 1);
  if (MODE == 1) { lo = 4 * qb - 2; if (lo < 0) lo = 0; }
  const int last_w = (qw + 31) >> 6;
  int first_w = 0;
  if (MODE == 1) { first_w = (qw > 127 ? qw - 127 : 0) >> 6; }
  const char* sp[NSLOT]; unsigned sst[NSLOT];
#pragma unroll
  for (int j = 0; j < NSLOT; ++j) {
    const int ch_ = 8 * j + wid;
    if (ch_ < KCH) {
      const int p = ch_ * 64 + lane, row = p / KG16, g = p - row * KG16;
      if (DQK == 96 && g >= 8 && g < 12) { sp[j] = (const char*)(a.k2 + (size_t)row * a.ldk2 + 8 * (g - 8)); sst[j] = (unsigned)(128 * a.ldk2); }
      else { sp[j] = (const char*)(a.k + (size_t)row * a.ldk + 8 * (g < 8 ? g : 0)); sst[j] = (unsigned)(128 * a.ldk); }
    } else {
      const int p = (ch_ - KCH) * 64 + lane, row = (p / VG16) & 63, g = p - (p / VG16) * VG16;
      sp[j] = (const char*)(a.v + (size_t)row * a.ldv + 8 * (g < DV / 8 ? g : 0)); sst[j] = (unsigned)(128 * a.ldv);
    }
  }
  auto issue = [&](int kt) {
    LAS unsigned char* base = lds + (kt % 4) * TILE;
#pragma unroll
    for (int j = 0; j < NSLOT; ++j) {
      if (j < NSLOT - 1 || wid < REM)
        __builtin_amdgcn_global_load_lds((const unsigned*)(sp[j] + (size_t)kt * sst[j]), (LAS unsigned*)(base + (8 * j + wid) * 1024), 16, 0, 0);
    }
    if (MODE == 2) __builtin_amdgcn_global_load_lds((const unsigned*)(a.fcum + kt * 64 + lane), (LAS unsigned*)(base + NCH * 1024 + wid * 256), 4, 0, 0);
  };
  auto wait_tiles = [&](bool all) {
    if (all) wait_vmcnt<0>();
    else if (wid < REM) wait_vmcnt<NSLOT + FX>();
    else wait_vmcnt<NSLOT - 1 + FX>();
  };
  f32x16 O[NBLK];
#pragma unroll
  for (int bl = 0; bl < NBLK; ++bl)
#pragma unroll
    for (int i = 0; i < 16; ++i) O[bl][i] = 0.f;
  float m = (MODE == 1) ? a.sink / a.sl2 : -1e30f;
  float l0 = (MODE == 1 && hh == 0) ? 1.f : 0.f, l1 = 0.f;
  const int i16 = lane & 15, q4 = i16 >> 2, p4 = i16 & 3, grp = (lane >> 4) & 1;
  auto qk_load = [&](int kt, bf16x8 (&kf)[2][NKS]) {
    LAS unsigned char* Kl = lds + (kt % 4) * TILE;
#pragma unroll
    for (int kb = 0; kb < 2; ++kb)
#pragma unroll
      for (int ks = 0; ks < NKS; ++ks) kf[kb][ks] = *(const LAS bf16x8*)(Kl + (32 * kb + r) * KSTR + (16 * ks + 8 * hh) * 2);
  };
  auto qk_mma = [&](int kt, const bf16x8 (&kf)[2][NKS], f32x16 (&s)[2]) {
#pragma unroll
    for (int kb = 0; kb < 2; ++kb) {
      if (MODE == 2) {
        LAS unsigned char* Fl = lds + (kt % 4) * TILE + NCH * 1024 + wid * 256;
#pragma unroll
        for (int g = 0; g < 4; ++g) { const f32x4 fb = *(const LAS f32x4*)(Fl + (32 * kb + 8 * g + 4 * hh) * 4);
          s[kb][4 * g] = fb[0]; s[kb][4 * g + 1] = fb[1]; s[kb][4 * g + 2] = fb[2]; s[kb][4 * g + 3] = fb[3]; }
      } else {
#pragma unroll
        for (int i = 0; i < 16; ++i) s[kb][i] = 0.f;
      }
    }
#pragma unroll
    for (int ks = 0; ks < NKS; ++ks)
#pragma unroll
      for (int kb = 0; kb < 2; ++kb) s[kb] = __builtin_amdgcn_mfma_f32_32x32x16_bf16(kf[kb][ks], qf[ks], s[kb], 0, 0, 0);
  };
  auto softmax = [&](int kt, f32x16 (&s)[2], bf16x8 (&pf)[2][2], auto maskc) {
    constexpr bool MASK = decltype(maskc)::value;
    const int key0 = kt * 64;
    if (MASK) {
#pragma unroll
      for (int kb = 0; kb < 2; ++kb)
#pragma unroll
        for (int i = 0; i < 16; ++i) {
          const int key = key0 + 32 * kb + (i & 3) + 8 * (i >> 2) + 4 * hh;
          bool valid = key <= myq; if (MODE == 1) valid = valid && (myq - key < 128);
          s[kb][i] = valid ? s[kb][i] : -1e30f;
        }
    }
    float mx = fmaxf(s[0][0], s[1][0]);
#pragma unroll
    for (int i = 1; i < 16; ++i) mx = fmaxf(fmaxf(mx, s[0][i]), s[1][i]);
    mx = half_max(mx);
    if (__builtin_amdgcn_ballot_w64(mx > m + tau) != 0ull) {
      const float mnew = fmaxf(m, mx);
      const float alpha = fast_exp2((m - mnew) * c);
      m = mnew;
      l0 *= alpha; l1 *= alpha;
#pragma unroll
      for (int bl = 0; bl < NBLK; ++bl)
#pragma unroll
        for (int i = 0; i < 16; ++i) O[bl][i] *= alpha;
    }
    const float nmc = -m * c;
#pragma unroll
    for (int kb = 0; kb < 2; ++kb)
#pragma unroll
      for (int s2 = 0; s2 < 2; ++s2) {
        float pv[8];
#pragma unroll
        for (int e = 0; e < 8; ++e) pv[e] = fast_exp2(__builtin_fmaf(s[kb][8 * s2 + e], c, nmc));
        l0 += (pv[0] + pv[4]) + (pv[2] + pv[6]); l1 += (pv[1] + pv[5]) + (pv[3] + pv[7]);
        u32x4 w;
        w.x = pk2(pv[0], pv[1]); w.y = pk2(pv[2], pv[3]); w.z = pk2(pv[4], pv[5]); w.w = pk2(pv[6], pv[7]);
        pf[kb][s2] = __builtin_bit_cast(bf16x8, w);
      }
  };
  auto pvmm = [&](int kt, const bf16x8 (&pf)[2][2]) {
    constexpr int PD = (NBLK == 2) ? 2 : 1;
    const unsigned va = (unsigned)(size_t)(lds + (kt % 4) * TILE + KCH * 1024 + (4 * hh + q4) * VSTR + (16 * grp) * 2 + 8 * p4);
    s16x4 vl[PD + 1][NBLK], vh[PD + 1][NBLK];
#define TRRD(dst, off) asm volatile("ds_read_b64_tr_b16 %0, %1 offset:%2" : "=&v"(dst) : "v"(va), "n"(off) : "memory")
#define TRSTEP(st_) do { _Pragma("unroll") for (int bl = 0; bl < NBLK; ++bl) { TRRD(vl[(st_) % (PD + 1)][bl], 16 * (st_) * VSTR + 64 * bl); TRRD(vh[(st_) % (PD + 1)][bl], 16 * (st_) * VSTR + 64 * bl + 8 * VSTR); } } while (0)
#define TRWAIT(n_, b_) do { if (NBLK == 2) asm volatile("s_waitcnt lgkmcnt(" #n_ ")" : "+v"(vl[b_][0]), "+v"(vh[b_][0]), "+v"(vl[b_][1]), "+v"(vh[b_][1])::"memory"); \
    else asm volatile("s_waitcnt lgkmcnt(" #n_ ")" : "+v"(vl[b_][0]), "+v"(vh[b_][0]), "+v"(vl[b_][1]), "+v"(vh[b_][1]), "+v"(vl[b_][2 % NBLK]), "+v"(vh[b_][2 % NBLK]), "+v"(vl[b_][3 % NBLK]), "+v"(vh[b_][3 % NBLK])::"memory"); } while (0)
#pragma unroll
    for (int st = 0; st < PD; ++st) TRSTEP(st);
#pragma unroll
    for (int st = 0; st < 4; ++st) {
      if (st + PD < 4) TRSTEP(st + PD);
      const int ahead = ((st + PD < 4) ? st + PD : 3) - st;
      const int b_ = st % (PD + 1);
      if (ahead * 2 * NBLK == 8) TRWAIT(8, b_); else if (ahead * 2 * NBLK == 4) TRWAIT(4, b_); else TRWAIT(0, b_);
#pragma unroll
      for (int bl = 0; bl < NBLK; ++bl) {
        const bf16x8 vf = __builtin_shufflevector(vl[b_][bl], vh[b_][bl], 0, 1, 2, 3, 4, 5, 6, 7);
        O[bl] = __builtin_amdgcn_mfma_f32_32x32x16_bf16(vf, pf[st >> 1][st & 1], O[bl], 0, 0, 0);
      }
    }
#undef TRRD
#undef TRSTEP
#undef TRWAIT
  };
  auto act = [&](int kt) { return kt <= last_w && kt >= first_w; };
  f32x16 sA[2];
  const bool halfB = wid >= 4;
  issue(lo);
  if (lo + 1 < hi) issue(lo + 1);
  if (lo + 2 < hi) issue(lo + 2);
  wait_tiles(true);
  raw_barrier();
  if (halfB) raw_barrier();
  if (act(lo)) { bf16x8 kf0[2][NKS]; qk_load(lo, kf0); qk_mma(lo, kf0, sA); }
  auto step = [&](int kt, auto maskc) {
    const bool a0 = act(kt), a1 = (kt + 1 < hi) && act(kt + 1);
    bf16x8 pf[2][2], kf[2][NKS];
    if (a0) softmax(kt, sA, pf, maskc);
    wait_tiles(true);
    raw_barrier();
    if (a1) qk_load(kt + 1, kf);
    __builtin_amdgcn_s_setprio(1);
    if (a1) qk_mma(kt + 1, kf, sA);
    if (a0) pvmm(kt, pf);
    __builtin_amdgcn_s_setprio(0);
    if (kt + 3 < hi) issue(kt + 3);
    raw_barrier();
  };
  int split = lo;
  if (MODE != 1) { split = qw >> 6; if (split < lo) split = lo; if (split > hi) split = hi; }
  if (MODE != 1) { for (int kt = lo; kt < split; ++kt) step(kt, std::false_type{}); }
  for (int kt = split; kt < hi; ++kt) step(kt, std::true_type{});
  if (!halfB) raw_barrier();
  const float l = half_sum(l0 + l1);
  const float inv = 1.f / l;
#pragma unroll
  for (int bl = 0; bl < NBLK; ++bl)
    epi_block(O[bl], inv, hh, a.gate ? a.gate + (size_t)myq * a.ldg + 32 * bl : nullptr, a.out + (size_t)myq * a.ldo + 32 * bl);
}

DI void swa_item(LAS unsigned char* lds, const AttnArgs& a, const float* sinks4, int qb) {
  constexpr int KSTR = 144, VSTR = 192, KCH = 9, VCH = 12, NCH = 21, TILE = NCH * 1024, NSLOT = 3, REM = 5, NKS = 4, NBLK = 2;
  const int tid = opaque_tid(), wid = __builtin_amdgcn_readfirstlane(tid >> 6), lane = tid & 63, r = lane & 31, hh = lane >> 5;
  const int q0 = qb * 256, qw = q0 + 32 * wid, myq = qw + r;
  const float c = a.sl2, tau = 8.0f / a.sl2;
  int lo = 4 * qb - 2; if (lo < 0) lo = 0;
  const int hi = 4 * (qb + 1);
  const int last_w = (qw + 31) >> 6, first_w = (qw > 127 ? qw - 127 : 0) >> 6;
#pragma unroll
  for (int j = 0; j < NSLOT; ++j) {
    const int ch_ = 8 * j + wid;
    if (j < NSLOT - 1 || wid < REM) {
      const char* sp; unsigned sst;
      if (ch_ < KCH) { const int p = ch_ * 64 + lane, row = p / 9, g = p - row * 9;
        sp = (const char*)(a.k + (size_t)row * a.ldk + 8 * (g < 8 ? g : 0)); sst = (unsigned)(128 * a.ldk); }
      else { const int p = (ch_ - KCH) * 64 + lane, row = (p / 12) & 63, g = p - (p / 12) * 12;
        sp = (const char*)(a.v + (size_t)row * a.ldv + 8 * (g < 8 ? g : 0)); sst = (unsigned)(128 * a.ldv); }
      for (int kt = lo; kt < hi; ++kt)
        __builtin_amdgcn_global_load_lds((const unsigned*)(sp + (size_t)kt * sst), (LAS unsigned*)(lds + (kt - lo) * TILE + ch_ * 1024), 16, 0, 0);
    }
  }
  wait_vmcnt<0>();
  raw_barrier();
  const int i16 = lane & 15, q4 = i16 >> 2, p4 = i16 & 3, grp = (lane >> 4) & 1;
  for (int h4 = 0; h4 < 4; ++h4) {
    bf16x8 qf[NKS];
#pragma unroll
    for (int ks = 0; ks < NKS; ++ks) qf[ks] = *(const bf16x8*)(a.q + (size_t)myq * a.ldq + h4 * 64 + 16 * ks + 8 * hh);
    f32x16 O[NBLK];
#pragma unroll
    for (int bl = 0; bl < NBLK; ++bl)
#pragma unroll
      for (int i = 0; i < 16; ++i) O[bl][i] = 0.f;
    float m = sinks4[h4] / a.sl2;
    float l0 = (hh == 0) ? 1.f : 0.f, l1 = 0.f;
    for (int kt = first_w; kt <= last_w; ++kt) {
      LAS unsigned char* Kl = lds + (kt - lo) * TILE;
      f32x16 s[2];
      bf16x8 kf[2][NKS];
#pragma unroll
      for (int kb = 0; kb < 2; ++kb)
#pragma unroll
        for (int ks = 0; ks < NKS; ++ks) kf[kb][ks] = *(const LAS bf16x8*)(Kl + (32 * kb + r) * KSTR + (16 * ks + 8 * hh) * 2);
#pragma unroll
      for (int kb = 0; kb < 2; ++kb)
#pragma unroll
        for (int i = 0; i < 16; ++i) s[kb][i] = 0.f;
#pragma unroll
      for (int ks = 0; ks < NKS; ++ks)
#pragma unroll
        for (int kb = 0; kb < 2; ++kb) s[kb] = __builtin_amdgcn_mfma_f32_32x32x16_bf16(kf[kb][ks], qf[ks], s[kb], 0, 0, 0);
      const int key0 = kt * 64;
#pragma unroll
      for (int kb = 0; kb < 2; ++kb)
#pragma unroll
        for (int i = 0; i < 16; ++i) {
          const int key = key0 + 32 * kb + (i & 3) + 8 * (i >> 2) + 4 * hh;
          const bool valid = (key <= myq) && (myq - key < 128);
          s[kb][i] = valid ? s[kb][i] : -1e30f;
        }
      float mx = fmaxf(s[0][0], s[1][0]);
#pragma unroll
      for (int i = 1; i < 16; ++i) mx = fmaxf(fmaxf(mx, s[0][i]), s[1][i]);
      mx = half_max(mx);
      if (__builtin_amdgcn_ballot_w64(mx > m + tau) != 0ull) {
        const float mnew = fmaxf(m, mx);
        const float alpha = fast_exp2((m - mnew) * c);
        m = mnew; l0 *= alpha; l1 *= alpha;
#pragma unroll
        for (int bl = 0; bl < NBLK; ++bl)
#pragma unroll
          for (int i = 0; i < 16; ++i) O[bl][i] *= alpha;
      }
      const float nmc = -m * c;
      bf16x8 pf[2][2];
#pragma unroll
      for (int kb = 0; kb < 2; ++kb)
#pragma unroll
        for (int s2 = 0; s2 < 2; ++s2) {
          float pv[8];
#pragma unroll
          for (int e = 0; e < 8; ++e) pv[e] = fast_exp2(__builtin_fmaf(s[kb][8 * s2 + e], c, nmc));
          l0 += (pv[0] + pv[4]) + (pv[2] + pv[6]); l1 += (pv[1] + pv[5]) + (pv[3] + pv[7]);
          u32x4 w;
          w.x = pk2(pv[0], pv[1]); w.y = pk2(pv[2], pv[3]); w.z = pk2(pv[4], pv[5]); w.w = pk2(pv[6], pv[7]);
          pf[kb][s2] = __builtin_bit_cast(bf16x8, w);
        }
      LAS unsigned char* Vl = Kl + KCH * 1024 + (4 * hh + q4) * VSTR + (16 * grp) * 2 + 8 * p4;
#pragma unroll
      for (int st = 0; st < 4; ++st)
#pragma unroll
        for (int bl = 0; bl < NBLK; ++bl) {
          LAS unsigned char* ad = Vl + (16 * st) * VSTR + (32 * bl) * 2;
          const s16x4 lo_ = __builtin_amdgcn_ds_read_tr16_b64_v4i16((LAS s16x4*)ad);
          const s16x4 hi_ = __builtin_amdgcn_ds_read_tr16_b64_v4i16((LAS s16x4*)(ad + 8 * VSTR));
          const bf16x8 vf = __builtin_shufflevector(lo_, hi_, 0, 1, 2, 3, 4, 5, 6, 7);
          O[bl] = __builtin_amdgcn_mfma_f32_32x32x16_bf16(vf, pf[st >> 1][st & 1], O[bl], 0, 0, 0);
        }
    }
    const float l = half_sum(l0 + l1);
    const float inv = 1.f / l;
#pragma unroll
    for (int bl = 0; bl < NBLK; ++bl)
      epi_block(O[bl], inv, hh, a.gate + (size_t)myq * a.ldg + h4 * 64 + 32 * bl, a.out + (size_t)myq * a.ldo + h4 * 64 + 32 * bl);
  }
  __syncthreads();
}

DI bool team_item(int G, int c, int n, int& bh, int& qb) {
  if (G == 256) {
    const int x = c & 7, li = c >> 3, t = li >> 3, i = li & 7;
    bh = x + 8 * (4 * t + n);
    const int j = (i + 4) & 7;
    qb = (n == 0) ? i : (n == 1) ? 7 - i : (n == 2) ? j : 7 - j;
    return true;
  }
  const int idx = n * G + ((n & 1) ? (G - 1 - c) : c);
  if (idx >= 1024) return false;
  qb = 7 - idx / 128; bh = idx % 128;
  return true;
}

DI int snake_idx(int round, int G, int c) { return round * G + ((round & 1) ? (G - 1 - c) : c); }

DI void attn_even(const Params& p, LAS unsigned char* lds, int i) {
  const int G = gridDim.x, c = blockIdx.x;
  unsigned char* ws = p.ws;
  const bf16_t* z = (const bf16_t*)(ws + WS_ZBUF);
  const bf16_t* qb_ = (const bf16_t*)(ws + WS_QBUF);
  const bf16_t* kv = (const bf16_t*)(ws + WS_HBUF);
  bf16_t* ob = (bf16_t*)(ws + WS_OBUF);
  for (int rd = 0; rd * G < 1024; ++rd) {
    int qb, bh;
    if (!team_item(G, c, rd, bh, qb)) continue;
    const int b = bh >> 3, hd = bh & 7;
    AttnArgs a;
    a.q = qb_ + (size_t)b * SEQ * 768 + hd * 96; a.ldq = 768;
    a.k = kv + (size_t)b * SEQ * 1024 + hd * 128; a.ldk = 1024;
    a.k2 = z + (size_t)b * SEQ * 2560 + 2432; a.ldk2 = 2560;
    a.v = kv + (size_t)b * SEQ * 1024 + hd * 128 + 64; a.ldv = 1024;
    a.out = ob + (size_t)b * SEQ * 1024 + hd * 64; a.ldo = 1024;
    a.gate = z + (size_t)b * SEQ * 2560 + 768 + hd * 64; a.ldg = 2560;
    a.fcum = nullptr; a.sl2 = 0.10206207261596577f * LOG2E; a.sink = 0.f;
    attn_item<96, 64, 0>(lds, a, qb);
  }
  for (int it = c; it < 256; it += G) {
    const int b = it >> 4, kvh = (it >> 3) & 1, qb = it & 7;
    AttnArgs a;
    const bf16_t* zb = z + (size_t)b * SEQ * 2560;
    a.q = zb + kvh * 256; a.ldq = 2560;
    a.k = zb + 512 + kvh * 64; a.ldk = 2560; a.k2 = nullptr; a.ldk2 = 0;
    a.v = zb + 640 + kvh * 64; a.ldv = 2560;
    a.out = ob + (size_t)b * SEQ * 1024 + 512 + kvh * 256; a.ldo = 1024;
    a.gate = zb + 768 + 512 + kvh * 256; a.ldg = 2560;
    a.fcum = nullptr; a.sl2 = 0.125f * LOG2E; a.sink = 0.f;
    float sk[4];
#pragma unroll
    for (int h4 = 0; h4 < 4; ++h4) sk[h4] = p.ev_sinks[i * 8 + kvh * 4 + h4] * LOG2E;
    swa_item(lds, a, sk, qb);
  }
}

DI void attn_odd(const Params& p, LAS unsigned char* lds, int layer) {
  const int G = gridDim.x, c = blockIdx.x;
  unsigned char* ws = p.ws;
  const bf16_t* z = (const bf16_t*)(ws + WS_ZBUF);
  bf16_t* od = (bf16_t*)(ws + WS_HBUF);
  bf16_t* ob = (bf16_t*)(ws + WS_OBUF);
  {
    for (int rd = 0; rd * G < 512; ++rd) {
      int qb, bh2;
      if (G == 256) { const int x = c & 7, li = c >> 3, t = li >> 3, i = li & 7; bh2 = x + 8 * (2 * t + rd); qb = (rd == 0) ? i : 7 - i; }
      else { const int idx = snake_idx(rd, G, c); if (idx >= 512) continue; qb = 7 - idx / 64; bh2 = idx % 64; }
      const int b = bh2 >> 2, h = bh2 & 3;
      const bf16_t* zb = z + (size_t)b * SEQ * 4096;
      for (int mp = 0; mp < 2; ++mp) {
        const int j = 2 * h + mp;
        AttnArgs a;
        a.q = zb + j * 64; a.ldq = 4096;
        a.k = zb + 512 + j * 64; a.ldk = 4096; a.k2 = nullptr; a.ldk2 = 0;
        a.v = zb + 1024 + h * 128; a.ldv = 4096;
        a.out = od + (size_t)b * SEQ * 1024 + j * 128; a.ldo = 1024;
        a.gate = nullptr; a.ldg = 0;
        a.fcum = nullptr; a.sl2 = 0.125f * LOG2E; a.sink = 0.f;
#ifndef SKIP_DIFF
        attn_item<64, 128, 0>(lds, a, qb);
#endif
      }
      __builtin_amdgcn_fence(__ATOMIC_SEQ_CST, "workgroup");
      asm volatile("s_waitcnt vmcnt(0)" ::: "memory");
      const int tid2 = opaque_tid(), lane = tid2 & 63, wid = tid2 >> 6, li_ = layer >> 1;
      const float* lp = p.od_lambda + li_ * 256;
      const float s1 = wave_sum(lp[lane] * lp[64 + lane]), s2 = wave_sum(lp[128 + lane] * lp[192 + lane]);
      const float lam_init = 0.8f - 0.6f * fast_exp2(-0.3f * LOG2E * (float)layer);
      const float lam = fast_exp2(s1 * LOG2E) - fast_exp2(s2 * LOG2E) + lam_init;
      const int rsub = lane >> 4, dv = (lane & 15) * 8;
      float sub[8];
#pragma unroll
      for (int e = 0; e < 8; ++e) sub[e] = p.od_subln[li_ * 128 + dv + e] * (1.f - lam_init);
      const size_t row0 = (size_t)b * SEQ + qb * 256 + 32 * wid;
#pragma unroll 2
      for (int rr = 0; rr < 8; ++rr) {
        const size_t row = row0 + 4 * rr + rsub;
        const u32x4 va = *(const u32x4*)(od + row * 1024 + (2 * h) * 128 + dv);
        const u32x4 vb = *(const u32x4*)(od + row * 1024 + (2 * h + 1) * 128 + dv);
        const u32x4 vg = *(const u32x4*)(z + row * 4096 + 3072 + h * 128 + dv);
        float d[8]; float ss = 0.f;
#pragma unroll
        for (int e = 0; e < 4; ++e) { d[2 * e] = bflo(va[e]) - lam * bflo(vb[e]); d[2 * e + 1] = bfhi(va[e]) - lam * bfhi(vb[e]); ss += d[2 * e] * d[2 * e] + d[2 * e + 1] * d[2 * e + 1]; }
        ss += __shfl_xor(ss, 1); ss += __shfl_xor(ss, 2); ss += __shfl_xor(ss, 4); ss += __shfl_xor(ss, 8);
        const float rs = rsqrtf(ss * (1.f / 128.f) + EPS);
        u32x4 w;
#pragma unroll
        for (int e = 0; e < 4; ++e) {
          const float o0 = d[2 * e] * rs * sub[2 * e] * silu_f(bflo(vg[e])), o1 = d[2 * e + 1] * rs * sub[2 * e + 1] * silu_f(bfhi(vg[e]));
          w[e] = pk2(o0, o1);
        }
        *(u32x4*)(ob + row * 1024 + h * 128 + dv) = w;
      }
    }
  }
  for (int rd = 0; rd * G < 1024; ++rd) {
    int qb, bh;
    if (!team_item(G, c, rd, bh, qb)) continue;
    const int b = bh >> 3, hd = bh & 7;
    AttnArgs a;
    const bf16_t* zb = z + (size_t)b * SEQ * 4096;
    a.q = zb + 1536 + hd * 64; a.ldq = 4096;
    a.k = zb + 2048 + hd * 64; a.ldk = 4096; a.k2 = nullptr; a.ldk2 = 0;
    a.v = zb + 2560 + hd * 64; a.ldv = 4096;
    a.out = ob + (size_t)b * SEQ * 1024 + 512 + hd * 64; a.ldo = 1024;
    a.gate = zb + 3072 + 512 + hd * 64; a.ldg = 4096;
    a.fcum = (const float*)(ws + WS_FCUM) + (size_t)bh * SEQ; a.sl2 = 0.125f * LOG2E; a.sink = 0.f;
#ifndef SKIP_FOX
    attn_item<64, 64, 2>(lds, a, qb);
#endif
  }
}

DI void diff_combine(const Params& p, int layer) {
  const int tid = opaque_tid(), lane = tid & 63, wid = tid >> 6;
  const int gw = blockIdx.x * 8 + wid, nw = gridDim.x * 8;
  const int i = layer >> 1;
  unsigned char* ws = p.ws;
  const bf16_t* od = (const bf16_t*)(ws + WS_HBUF);
  const bf16_t* z = (const bf16_t*)(ws + WS_ZBUF);
  bf16_t* ob = (bf16_t*)(ws + WS_OBUF);
  const float* lp = p.od_lambda + i * 256;
  const float s1 = wave_sum(lp[lane] * lp[64 + lane]), s2 = wave_sum(lp[128 + lane] * lp[192 + lane]);
  const float lam_init = 0.8f - 0.6f * expf(-0.3f * (float)layer);
  const float lam = expf(s1) - expf(s2) + lam_init;
  const int hd = lane >> 4, dv = (lane & 15) * 8;
  float sub[8];
#pragma unroll
  for (int e = 0; e < 8; ++e) sub[e] = p.od_subln[i * 128 + dv + e] * (1.f - lam_init);
  for (int row = gw; row < T; row += nw) {
    const u32x4 a = *(const u32x4*)(od + (size_t)row * 1024 + (2 * hd) * 128 + dv);
    const u32x4 b = *(const u32x4*)(od + (size_t)row * 1024 + (2 * hd + 1) * 128 + dv);
    const u32x4 g = *(const u32x4*)(z + (size_t)row * 4096 + 3072 + hd * 128 + dv);
    float d[8]; float ss = 0.f;
#pragma unroll
    for (int e = 0; e < 4; ++e) { d[2 * e] = bflo(a[e]) - lam * bflo(b[e]); d[2 * e + 1] = bfhi(a[e]) - lam * bfhi(b[e]); ss += d[2 * e] * d[2 * e] + d[2 * e + 1] * d[2 * e + 1]; }
    ss += __shfl_xor(ss, 1); ss += __shfl_xor(ss, 2); ss += __shfl_xor(ss, 4); ss += __shfl_xor(ss, 8);
    const float rs = rsqrtf(ss * (1.f / 128.f) + EPS);
    u32x4 w;
#pragma unroll
    for (int e = 0; e < 4; ++e) {
      const float o0 = d[2 * e] * rs * sub[2 * e] * silu_f(bflo(g[e])), o1 = d[2 * e + 1] * rs * sub[2 * e + 1] * silu_f(bfhi(g[e]));
      w[e] = pk2(o0, o1);
    }
    *(u32x4*)(ob + (size_t)row * 1024 + hd * 128 + dv) = w;
  }
}


DI void grid_barrier(unsigned* ctr, unsigned& epoch) {
  asm volatile("s_waitcnt vmcnt(0)" ::: "memory");
  __syncthreads();
  epoch += 1;
  if (threadIdx.x == 0) {
    __builtin_amdgcn_fence(__ATOMIC_RELEASE, "agent");
    asm volatile("s_waitcnt vmcnt(0)" ::: "memory");
    __hip_atomic_fetch_add(ctr, 1u, __ATOMIC_RELAXED, __HIP_MEMORY_SCOPE_AGENT);
    const unsigned target = epoch * gridDim.x;
    while (__hip_atomic_load(ctr, __ATOMIC_RELAXED, __HIP_MEMORY_SCOPE_AGENT) < target) __builtin_amdgcn_s_sleep(1);
    __builtin_amdgcn_fence(__ATOMIC_ACQUIRE, "agent");
    asm volatile("s_waitcnt vmcnt(0)" ::: "memory");
  }
  __syncthreads();
}


#define XB_TMO      128
#define XB_XCNT(j)  (256  + 64 * (j))
#define XB_XSUB(j)  (1280 + 64 * (j))
#define XB_XGEN(j)  (2304 + 64 * (j))
#define XB_TOP      3328
#define XB_TOPGEN   3392
#define XCD_BAR_WORDS 3456
#define XB_SPIN_CAP (1u << 20)
DI unsigned xb_ld(unsigned* p) { return __hip_atomic_load(p, __ATOMIC_RELAXED, __HIP_MEMORY_SCOPE_AGENT); }
DI unsigned xb_add(unsigned* p, unsigned v) { return __hip_atomic_fetch_add(p, v, __ATOMIC_RELAXED, __HIP_MEMORY_SCOPE_AGENT); }
DI unsigned xb_xcc_id() { return (unsigned)__builtin_amdgcn_s_getreg((3 << 11) | 20) & 0xFu; }
#define XB_SPIN(cond, bar) do { unsigned _sp = 0; while (cond) { __builtin_amdgcn_s_sleep(1); \
    if ((++_sp & 255u) == 0u) { if (xb_ld(&(bar)[XB_TMO])) break; if (_sp > XB_SPIN_CAP) { atomicAdd(&(bar)[XB_TMO], 1u); break; } } } } while (0)
struct XcdBarrier { unsigned* bar; unsigned x; volatile LAS unsigned* st; };
DI void xcd_barrier_complete(unsigned* bar, unsigned x, unsigned& nloc, unsigned& nx) {
  const unsigned G = gridDim.x;
  unsigned sum, cnt, mine, sp = 0u;
  for (;;) {
    sum = 0u; cnt = 0u; mine = 0u;
#pragma unroll
    for (unsigned j = 0; j < 16; ++j) { const unsigned c = xb_ld(&bar[XB_XCNT(j)]); sum += c; cnt += (c > 0u) ? 1u : 0u; mine = (j == x) ? c : mine; }
    if (sum == G) break;
    __builtin_amdgcn_s_sleep(1);
    if ((++sp & 255u) == 0u) { if (xb_ld(&bar[XB_TMO])) break; if (sp > XB_SPIN_CAP) { atomicAdd(&bar[XB_TMO], 1u); break; } }
  }
  nloc = mine > 0u ? mine : 1u; nx = cnt > 0u ? cnt : 1u;
}
DI void xcd_barrier(const XcdBarrier& b) {
  asm volatile("s_waitcnt vmcnt(0)" ::: "memory");
  __syncthreads();
  if (threadIdx.x == 0) {
    unsigned* bar = b.bar;
    __builtin_amdgcn_s_waitcnt(0);
    unsigned nloc = b.st[0], nx = b.st[1];
    if (nloc == 0u) { xcd_barrier_complete(bar, b.x, nloc, nx); b.st[0] = nloc; b.st[1] = nx; }
    const unsigned old = xb_add(&bar[XB_XSUB(b.x)], 1u);
    const unsigned gen = old / nloc;
    if (old + 1u == (gen + 1u) * nloc) {
      __builtin_amdgcn_fence(__ATOMIC_RELEASE, "agent");
      asm volatile("s_waitcnt vmcnt(0)" ::: "memory");
      const unsigned og = xb_add(&bar[XB_TOP], 1u);
      const unsigned tg = og / nx;
      if (og + 1u == (tg + 1u) * nx) xb_add(&bar[XB_TOPGEN], 1u);
      else XB_SPIN(xb_ld(&bar[XB_TOPGEN]) == tg, bar);
      __builtin_amdgcn_fence(__ATOMIC_ACQUIRE, "agent");
      xb_add(&bar[XB_XGEN(b.x)], 1u);
      asm volatile("s_waitcnt vmcnt(0)" ::: "memory");
    } else {
      XB_SPIN(xb_ld(&bar[XB_XGEN(b.x)]) == gen, bar);
      __builtin_amdgcn_fence(__ATOMIC_ACQUIRE, "agent");
      asm volatile("s_waitcnt vmcnt(0)" ::: "memory");
    }
  }
  __syncthreads();
}

__global__ void __launch_bounds__(512) fwd_megakernel(Params p) {
  extern __shared__ __attribute__((aligned(16))) unsigned char lds_raw[];
  LAS unsigned char* lds = (LAS unsigned char*)lds_raw;
  cg::grid_group grid = cg::this_grid();
  unsigned char* ws = p.ws;
  const int G = gridDim.x, bid = blockIdx.x;
  const float* cosH = (const float*)(ws + WS_COSH); const float* sinH = (const float*)(ws + WS_SINH);
  const float* cosR = (const float*)(ws + WS_COSR); const float* sinR = (const float*)(ws + WS_SINR);

  unsigned* xbar = (unsigned*)(ws + WS_XBAR);
  if (bid == 0) { for (int w = threadIdx.x; w < XCD_BAR_WORDS; w += 512) __hip_atomic_store(xbar + w, 0u, __ATOMIC_RELAXED, __HIP_MEMORY_SCOPE_AGENT); }
  volatile LAS unsigned* xst = (volatile LAS unsigned*)(lds + LDS_BYTES_C - 16);
  if (threadIdx.x == 0) { xst[0] = 0u; xst[1] = 0u; }
#ifndef SKIP_PRO
  prologue(p, lds);
#endif
  grid.sync();
  XcdBarrier xb; xb.bar = xbar; xb.x = xb_xcc_id(); xb.st = xst;
  if (threadIdx.x == 0) (void)xb_add(&xbar[XB_XCNT(xb.x)], 1u);
#pragma unroll
  for (int layer = 0; layer < 4; ++layer) {
    const int i = layer >> 1; const bool odd = layer & 1;
#ifndef SKIP_ROW
    rowwise_phase(p, lds, layer - 1, layer);
#endif
    xcd_barrier(xb);
    {
#ifndef SKIP_SCAN
      if (odd) { for (int bh = bid; bh < 128; bh += G) fox_scan(p, lds, bh); }
#endif
      pg8::Gemm g; g.A = (const bf16_t*)(ws + WS_HBUF); g.lda = 1024; g.K = 1024; g.M = T;
      Epi e; e.out = (bf16_t*)(ws + WS_ZBUF); e.pin = nullptr; e.pslot = 0; e.nK = 0; e.qmode = 0; e.pout = odd ? nullptr : (float*)(ws + WS_PART); e.cosH = cosH; e.sinH = sinH; e.cosR = cosR; e.sinR = sinR;
      if (!odd) { g.Bt = (const bf16_t*)(ws + WS_WEVIN + i * SZ_WEVIN); g.N = 2560; e.ldc = 2560; e.rope64_end = 640; e.rope32_lo = 2432; e.rope32_hi = 2464; }
      else { g.Bt = (const bf16_t*)(ws + WS_WODIN + i * SZ_WODIN); g.N = 4096; e.ldc = 4096; e.rope64_end = 1024; e.rope32_lo = 0; e.rope32_hi = 0; }
      pg8::StaticOrder S; S.init(g.M, g.N, G, bid);
#ifndef SKIP_G1
      pg8::gemm_phase<Epi>(lds, g, S, e);
#endif
    }
    xcd_barrier(xb);
    if (!odd) {
      for (int which = 0; which < 2; ++which) {
        pg8::Gemm g; g.M = T; g.lda = 2560;
        Epi e; e.rope64_end = 0; e.rope32_lo = 0; e.rope32_hi = 0; e.cosH = cosH; e.sinH = sinH; e.cosR = cosR; e.sinR = sinR; e.pout = nullptr; e.pin = (const float*)(ws + WS_PART);
        if (which == 0) { g.A = (const bf16_t*)(ws + WS_ZBUF) + 1792; g.Bt = (const bf16_t*)(ws + WS_WUQ + i * SZ_WUQ); g.N = 768; g.K = 384;
          e.out = (bf16_t*)(ws + WS_QBUF); e.ldc = 768; e.qmode = 1; e.pslot = 0; e.nK = 384; }
        else { g.A = (const bf16_t*)(ws + WS_ZBUF) + 2176; g.Bt = (const bf16_t*)(ws + WS_WUKV + i * SZ_WUKV); g.N = 1024; g.K = 256;
          e.out = (bf16_t*)(ws + WS_HBUF); e.ldc = 1024; e.qmode = 0; e.pslot = 12; e.nK = 256; }
        pg8::StaticOrder S; S.init(g.M, g.N, G, bid);
#ifndef SKIP_G2
        pg8::gemm_phase<Epi>(lds, g, S, e);
#endif
      }
      xcd_barrier(xb);
#ifndef SKIP_ATTE
      attn_even(p, lds, i);
#endif
      xcd_barrier(xb);
    } else {
#ifndef SKIP_ATTO
      attn_odd(p, lds, layer);
#endif
      xcd_barrier(xb);
    }
    {
      pg8::Gemm g; g.A = (const bf16_t*)(ws + WS_OBUF); g.lda = 1024; g.K = 1024; g.M = T; g.N = 1024;
      g.Bt = (const bf16_t*)(ws + (odd ? WS_WODOUT : WS_WEVOUT) + i * SZ_WOUT);
      Epi e; e.out = (bf16_t*)(ws + WS_HBUF); e.ldc = 1024; e.pin = nullptr; e.pslot = 0; e.pout = nullptr; e.nK = 0; e.qmode = 0; e.rope64_end = 0; e.rope32_lo = 0; e.rope32_hi = 0;
      e.cosH = cosH; e.sinH = sinH; e.cosR = cosR; e.sinR = sinR;
      pg8::StaticOrder S; S.init(g.M, g.N, G, bid);
#ifndef SKIP_G3
      pg8::gemm_phase<Epi>(lds, g, S, e);
#endif
    }
    xcd_barrier(xb);
  }
#ifndef SKIP_ROW
  rowwise_phase(p, lds, 3, 4);
#endif
}

constexpr int LDS_BYTES = 155648;
static_assert(LDS_BYTES == LDS_BYTES_C, "LDS size mismatch");

extern "C" void kernel_launch(void* const* d_in, const int* in_sizes, int n_in, void* d_out, int out_size, void* d_ws, size_t ws_size, hipStream_t stream) {
  static int grid_blocks = 0;
  if (grid_blocks == 0) {
    int dev = 0, cus = 0, per_cu = 0;
    if (hipGetDevice(&dev) != hipSuccess || hipDeviceGetAttribute(&cus, hipDeviceAttributeMultiprocessorCount, dev) != hipSuccess) { fprintf(stderr, "device query failed\n"); grid_blocks = -1; return; }
    if (hipFuncSetAttribute((const void*)fwd_megakernel, hipFuncAttributeMaxDynamicSharedMemorySize, LDS_BYTES) != hipSuccess) { fprintf(stderr, "hipFuncSetAttribute failed\n"); grid_blocks = -1; return; }
    if (hipOccupancyMaxActiveBlocksPerMultiprocessor(&per_cu, (const void*)fwd_megakernel, 512, LDS_BYTES) != hipSuccess || per_cu < 1) { fprintf(stderr, "occupancy query: %d\n", per_cu); per_cu = 1; }
    (void)hipGetLastError();
    grid_blocks = cus;
    if (ws_size < WS_END) { fprintf(stderr, "workspace too small: %zu < %zu\n", ws_size, (size_t)WS_END); grid_blocks = -1; return; }
  }
  if (grid_blocks < 0) return;
  Params p{};
  const float** fp = (const float**)&p;
  for (int i = 0; i < 18; ++i) fp[i] = (const float*)d_in[i];
  p.out = (float*)d_out; p.ws = (unsigned char*)d_ws;
  void* args[] = {&p};
  hipError_t e = hipLaunchCooperativeKernel((const void*)fwd_megakernel, dim3(grid_blocks), dim3(512), args, LDS_BYTES, stream);
  if (e != hipSuccess) fprintf(stderr, "cooperative launch failed: %s (grid %d)\n", hipGetErrorString(e), grid_blocks);
}
```

```cpp
#include <hip/hip_runtime.h>
#include <hip/hip_cooperative_groups.h>
#include <cstdio>
#include <type_traits>
namespace cg = cooperative_groups;

#define DI __device__ __forceinline__
#define LAS __attribute__((address_space(3)))
typedef unsigned short bf16_t;
typedef short bf16x8 __attribute__((ext_vector_type(8)));
typedef short s16x4 __attribute__((ext_vector_type(4)));
typedef float f32x2 __attribute__((ext_vector_type(2)));
typedef float f32x4 __attribute__((ext_vector_type(4)));
typedef float f32x16 __attribute__((ext_vector_type(16)));
typedef unsigned u32x2 __attribute__((ext_vector_type(2)));
typedef unsigned u32x4 __attribute__((ext_vector_type(4)));
typedef __bf16 bf16x2_t __attribute__((ext_vector_type(2)));

constexpr int T = 32768, DM = 1024, NB = 16, SEQ = 2048;
constexpr float LOG2E = 1.4426950408889634f;
constexpr float EPS = 1e-6f;
constexpr int LDS_BYTES_C = 155648;

constexpr size_t SZ_WEVIN = 2560ull * 1024 * 2, SZ_WODIN = 4096ull * 1024 * 2, SZ_WUQ = 768ull * 384 * 2, SZ_WUKV = 1024ull * 256 * 2, SZ_WOUT = 1024ull * 1024 * 2;
constexpr size_t WS_WEVIN = 0;
constexpr size_t WS_WODIN = WS_WEVIN + 2 * SZ_WEVIN;
constexpr size_t WS_WUQ = WS_WODIN + 2 * SZ_WODIN;
constexpr size_t WS_WUKV = WS_WUQ + 2 * SZ_WUQ;
constexpr size_t WS_WEVOUT = WS_WUKV + 2 * SZ_WUKV;
constexpr size_t WS_WODOUT = WS_WEVOUT + 2 * SZ_WOUT;
constexpr size_t WS_MOD = WS_WODOUT + 2 * SZ_WOUT;
constexpr size_t WS_COSH = WS_MOD + 4ull * 16 * 3072 * 4;
constexpr size_t WS_SINH = WS_COSH + 2048ull * 32 * 4;
constexpr size_t WS_COSR = WS_SINH + 2048ull * 32 * 4;
constexpr size_t WS_SINR = WS_COSR + 2048ull * 16 * 4;
constexpr size_t WS_LOGF = WS_SINR + 2048ull * 16 * 4;
constexpr size_t WS_FCUM = WS_LOGF + (size_t)T * 8 * 4;
constexpr size_t WS_HBUF = (WS_FCUM + (size_t)T * 8 * 4 + 4095) & ~(size_t)4095;
constexpr size_t WS_OBUF = WS_HBUF + (size_t)T * 1024 * 2;
constexpr size_t WS_ZBUF = WS_OBUF + (size_t)T * 1024 * 2;
constexpr size_t WS_QBUF = WS_ZBUF + (size_t)T * 2560 * 2;
constexpr size_t WS_BAR = WS_ZBUF + (size_t)T * 4096 * 2;
constexpr size_t WS_PART = WS_BAR + 256;
constexpr size_t WS_XBAR = (WS_PART + (size_t)T * 20 * 4 + 4095) & ~(size_t)4095;
constexpr size_t WS_XBF_PRE = WS_XBAR + 16384;
constexpr size_t WS_XBF = WS_XBF_PRE;
constexpr size_t WS_END = WS_XBF + (size_t)T * 1024 * 2;

struct Params {
  const float *x, *c, *w_ada, *b_ada, *g_pre, *g_post, *ev_w_in, *ev_q_norm, *ev_kv_norm, *ev_w_uq, *ev_w_ukv, *ev_sinks, *ev_w_out,
      *od_w_in, *od_forget_bias, *od_lambda, *od_subln, *od_w_out;
  float* out;
  unsigned char* ws;
};

DI int opaque_tid() { int t = threadIdx.x; asm volatile("" : "+v"(t)); return t; }
DI float bflo(unsigned u) { return __uint_as_float(u << 16); }
DI float bfhi(unsigned u) { return __uint_as_float(u & 0xffff0000u); }
DI unsigned pk2(float lo, float hi) { f32x2 f = {lo, hi}; bf16x2_t b = __builtin_convertvector(f, bf16x2_t); return __builtin_bit_cast(unsigned, b); }
DI bf16_t f2bf(float f) { return (bf16_t)(pk2(f, 0.f) & 0xffffu); }
DI float fast_exp2(float x) { return __builtin_amdgcn_exp2f(x); }
DI float silu_f(float x) { return x * __builtin_amdgcn_rcpf(1.f + fast_exp2(-x * LOG2E)); }
template <int CTRL> DI float dpp_mov(float v) { return __builtin_bit_cast(float, __builtin_amdgcn_update_dpp(0, __builtin_bit_cast(int, v), CTRL, 0xf, 0xf, false)); }
DI float wave_sum(float v) {
  v += dpp_mov<0xB1>(v);
  v += dpp_mov<0x4E>(v);
  v += dpp_mov<0x141>(v);
  v += dpp_mov<0x140>(v);
  { const unsigned u = __float_as_uint(v); auto r = __builtin_amdgcn_permlane16_swap(u, u, false, false); v = __uint_as_float(r[0]) + __uint_as_float(r[1]); }
  { const unsigned u = __float_as_uint(v); auto r = __builtin_amdgcn_permlane32_swap(u, u, false, false); v = __uint_as_float(r[0]) + __uint_as_float(r[1]); }
  return v;
}

namespace pg8 {
constexpr int BM = 256, BK = 64, HALF = 128, HTB = HALF * BK * 2, STAGE_BYTES = 8 * HTB, NXCD = 8, WGM = 8;
DI int lds_byte(int r, int c) { const int st = (r >> 4) * 2 + (c >> 5), rr = r & 15, cc = c & 31, ob = rr * 64 + cc * 2; return st * 1024 + (ob ^ (((ob >> 9) & 1) << 5)); }
DI void stage_rc(int b, int& R, int& C) { const int st = b / 1024, sb = b % 1024, swz = sb ^ (((sb >> 9) & 1) << 5); R = (st >> 1) * 16 + swz / 64; C = (st & 1) * 32 + (swz % 64) / 2; }
DI int perm32(int rho) { const int n = rho >> 4, i = rho & 15; return 8 * (i >> 2) + 4 * n + (i & 3); }
struct Unit { int pm, pn; };
struct Gemm { const bf16_t* A; const bf16_t* Bt; int M, N, K, lda; };
struct StaticOrder {
  int nM, nN, nwg, G, c;
  DI void init(int M, int N, int G_, int c_) { nM = M / BM; nN = N / BM; nwg = nM * nN; G = G_; c = c_; }
  DI bool next(int i, Unit& u) const {
    const long L = (long)i * G + c; if (L >= nwg) return false;
    int wgid = (int)L; { const int q = nwg / NXCD, r = nwg % NXCD, xcd = wgid % NXCD, off = wgid / NXCD; wgid = (xcd < r ? xcd * (q + 1) : r * (q + 1) + (xcd - r) * q) + off; }
    const int nig = WGM * nN, gid = wgid / nig, fm = gid * WGM, gsz = (nM - fm) < WGM ? (nM - fm) : WGM;
    u.pm = fm + ((wgid % nig) % gsz); u.pn = (wgid % nig) / gsz; return true;
  }
};

template <class Epi>
DI void gemm_phase(LAS unsigned char* lds, const Gemm g, const StaticOrder& S, const Epi& E) {
  const int tid = opaque_tid(), wid = __builtin_amdgcn_readfirstlane(tid >> 6), lane = tid & 63, wr = wid >> 2, wc = wid & 3, fr = lane & 15, fq = lane >> 4;
  const int K = g.K, nt = K / BK, lda = g.lda;
  unsigned voffA[2], voffB[2];
#pragma unroll
  for (int i = 0; i < 2; ++i) { int R, C; stage_rc(tid * 16 + i * 8192, R, C); const int Rb = (R & ~31) + perm32(R & 31);
    voffA[i] = (unsigned)(R * lda + C) * 2u; voffB[i] = (unsigned)(Rb * K + C) * 2u; }
  const size_t kstep = (size_t)(BK * 2);
  const size_t hstepA = (size_t)HALF * lda * 2, hstepB = (size_t)HALF * K * 2;
  const size_t tstepA = 2 * hstepA, tstepB = 2 * hstepB;
  const unsigned ldsw = (unsigned)wid * 1024u;
  const int aoff = lds_byte(wr * 64 + fr, fq * 8), boff = lds_byte(wc * 32 + fr, fq * 8);
#define PG8_SA(b, h) (((b) * 2 + (h)) * HTB)
#define PG8_SB(b, h) ((4 + (b) * 2 + (h)) * HTB)
#define PG8_STAGE(bufoff, gbase, voff) do { _Pragma("unroll") for (int _i = 0; _i < 2; ++_i) \
    __builtin_amdgcn_global_load_lds((const unsigned*)((const char*)(gbase) + (voff)[_i]), (LAS unsigned*)(lds + (bufoff) + ldsw + _i * 8192), 16, 0, 0); } while (0)
#define PG8_LDA(dst, b, h) do { _Pragma("unroll") for (int m = 0; m < 4; ++m) _Pragma("unroll") for (int k = 0; k < 2; ++k) dst[m][k] = *(const LAS bf16x8*)(lds + PG8_SA(b, h) + aoff + m * 2048 + k * 1024); } while (0)
#define PG8_LDB(dst, b, h) do { _Pragma("unroll") for (int n = 0; n < 2; ++n) _Pragma("unroll") for (int k = 0; k < 2; ++k) dst[n][k] = *(const LAS bf16x8*)(lds + PG8_SB(b, h) + boff + n * 2048 + k * 1024); } while (0)
#define PG8_MMA(ai, bj, At, Bt) do { __builtin_amdgcn_s_setprio(1); _Pragma("unroll") for (int m = 0; m < 4; ++m) _Pragma("unroll") for (int n = 0; n < 2; ++n) _Pragma("unroll") for (int k = 0; k < 2; ++k) \
    acc[ai][bj][m][n] = __builtin_amdgcn_mfma_f32_16x16x32_bf16(Bt[n][k], At[m][k], acc[ai][bj][m][n], 0, 0, 0); __builtin_amdgcn_s_setprio(0); } while (0)
#define PG8_WAIT_V(n) asm volatile("s_waitcnt vmcnt(" #n ")" ::: "memory")
#define PG8_WAIT_L(n) asm volatile("s_waitcnt lgkmcnt(" #n ")" ::: "memory")
#define PG8_BAR __builtin_amdgcn_s_barrier()
#define PG8_SCHED __builtin_amdgcn_sched_barrier(0)
  Unit cur, nxt; int ui = 0;
  if (!S.next(0, cur)) return;
  f32x4 acc[2][2][4][2];
#pragma unroll
  for (int a = 0; a < 2; ++a)
#pragma unroll
    for (int b = 0; b < 2; ++b)
#pragma unroll
      for (int m = 0; m < 4; ++m)
#pragma unroll
        for (int n = 0; n < 2; ++n) acc[a][b][m][n] = (f32x4){0.f, 0.f, 0.f, 0.f};
  bf16x8 At[4][2], B0[2][2], B1[2][2];
  const char* cA = (const char*)g.A + (size_t)cur.pm * tstepA; const char* cB = (const char*)g.Bt + (size_t)cur.pn * tstepB;
  PG8_STAGE(PG8_SB(0, 0), cB, voffB); PG8_STAGE(PG8_SA(0, 0), cA, voffA); PG8_STAGE(PG8_SB(0, 1), cB + hstepB, voffB); PG8_STAGE(PG8_SA(0, 1), cA + hstepA, voffA);
  if (wr == 1) PG8_BAR;
  PG8_WAIT_V(4); PG8_BAR;
  PG8_STAGE(PG8_SB(1, 0), cB + kstep, voffB); PG8_STAGE(PG8_SA(1, 0), cA + kstep, voffA); PG8_STAGE(PG8_SB(1, 1), cB + hstepB + kstep, voffB);
  PG8_WAIT_V(6); PG8_BAR;
  for (;;) {
    const bool has_next = S.next(ui + 1, nxt);
    const char* nA = has_next ? (const char*)g.A + (size_t)nxt.pm * tstepA : cA; const char* nB = has_next ? (const char*)g.Bt + (size_t)nxt.pn * tstepB : cB;
    for (int t = 0; t < nt; t += 2) {
      const bool last = (t == nt - 2);
      const char* a1 = cA + (size_t)(t + 1) * kstep;
      const char* a2 = last ? nA : cA + (size_t)(t + 2) * kstep; const char* b2 = last ? nB : cB + (size_t)(t + 2) * kstep;
      const char* a3 = a2 + kstep; const char* b3 = b2 + kstep;
      PG8_LDB(B0, 0, 0); PG8_SCHED; PG8_LDA(At, 0, 0); PG8_STAGE(PG8_SA(1, 1), a1 + hstepA, voffA);
      PG8_WAIT_L(8); PG8_BAR; PG8_WAIT_L(0); PG8_MMA(0, 0, At, B0); PG8_BAR; PG8_SCHED;
      PG8_LDB(B1, 0, 1); PG8_STAGE(PG8_SB(0, 0), b2, voffB);
      PG8_BAR; PG8_WAIT_L(0); PG8_MMA(0, 1, At, B1); PG8_BAR;
      PG8_LDA(At, 0, 1); PG8_STAGE(PG8_SA(0, 0), a2, voffA);
      PG8_BAR; PG8_WAIT_L(0); PG8_MMA(1, 0, At, B0); PG8_BAR; PG8_SCHED;
      PG8_STAGE(PG8_SB(0, 1), b2 + hstepB, voffB);
      PG8_WAIT_V(6); PG8_BAR; PG8_MMA(1, 1, At, B1); PG8_BAR;
      PG8_LDB(B0, 1, 0); PG8_SCHED; PG8_LDA(At, 1, 0); PG8_STAGE(PG8_SA(0, 1), a2 + hstepA, voffA);
      PG8_WAIT_L(8); PG8_BAR; PG8_WAIT_L(0); PG8_MMA(0, 0, At, B0); PG8_BAR; PG8_SCHED;
      PG8_LDB(B1, 1, 1); PG8_STAGE(PG8_SB(1, 0), b3, voffB);
      PG8_BAR; PG8_WAIT_L(0); PG8_MMA(0, 1, At, B1); PG8_BAR;
      PG8_LDA(At, 1, 1); PG8_STAGE(PG8_SA(1, 0), a3, voffA);
      PG8_BAR; PG8_WAIT_L(0); PG8_MMA(1, 0, At, B0); PG8_BAR; PG8_SCHED;
      PG8_STAGE(PG8_SB(1, 1), b3 + hstepB, voffB);
      PG8_WAIT_V(6); PG8_BAR; PG8_MMA(1, 1, At, B1); PG8_BAR;
    }
    E(acc, cur, wr, wc, fr, fq);
    if (!has_next) break;
#pragma unroll
    for (int a = 0; a < 2; ++a)
#pragma unroll
      for (int b = 0; b < 2; ++b)
#pragma unroll
        for (int m = 0; m < 4; ++m)
#pragma unroll
          for (int n = 0; n < 2; ++n) acc[a][b][m][n] = (f32x4){0.f, 0.f, 0.f, 0.f};
    cur = nxt; cA = nA; cB = nB; ++ui;
  }
  PG8_WAIT_V(0);
  if (wr == 0) PG8_BAR;
  PG8_BAR;
#undef PG8_SA
#undef PG8_SB
#undef PG8_STAGE
#undef PG8_LDA
#undef PG8_LDB
#undef PG8_MMA
#undef PG8_WAIT_V
#undef PG8_WAIT_L
#undef PG8_BAR
#undef PG8_SCHED
}
}

struct Epi {
  bf16_t* out; int ldc;
  int rope64_end;
  int rope32_lo, rope32_hi;
  int qmode;
  const float* pin; int nK;
  int pslot;
  float* pout;
  const float *cosH, *sinH, *cosR, *sinR;
  DI void operator()(const f32x4 (&acc)[2][2][4][2], const pg8::Unit& u, int wr, int wc, int fr, int fq) const {
    const int row0 = u.pm * 256 + wr * 64 + fr;
    int rt[2];
#pragma unroll
    for (int bj = 0; bj < 2; ++bj) {
      const int cw = u.pn * 256 + bj * 128 + wc * 32;
      rt[bj] = 0;
      if (cw < rope64_end) rt[bj] = 1;
      else if (cw >= rope32_lo && cw < rope32_hi) rt[bj] = 2;
      else if (qmode && ((cw >> 5) % 3) == 2) rt[bj] = 2;
    }
    const int tt = rt[0] | rt[1];
    const float* ctab = (tt == 1) ? cosH + (16 * (wc & 1) + 4 * fq) : cosR + 4 * fq;
    const float* stab = (tt == 1) ? sinH + (16 * (wc & 1) + 4 * fq) : sinR + 4 * fq;
    const int tstride = (tt == 1) ? 32 : 16;
    int ps[2] = {-1, -1};
    if (pout) {
#pragma unroll
      for (int bj = 0; bj < 2; ++bj) { const int cw = u.pn * 256 + bj * 128 + wc * 32;
        if (cw >= 1792 && cw < 2432) ps[bj] = ((cw - 1792) >> 7) * 4 + wc; }
    }
#pragma unroll
    for (int ai = 0; ai < 2; ++ai) {
      f32x4 cv[4], sv[4]; float rs[4];
#pragma unroll
      for (int m = 0; m < 4; ++m) {
        const int row = row0 + ai * 128 + m * 16;
        if (tt) { const int pos = row & (SEQ - 1); cv[m] = *(const f32x4*)(ctab + pos * tstride); sv[m] = *(const f32x4*)(stab + pos * tstride); }
        rs[m] = 1.f;
        if (pin) { const f32x4 p0 = *(const f32x4*)(pin + (size_t)row * 20 + pslot), p1 = *(const f32x4*)(pin + (size_t)row * 20 + pslot + 4);
          float ss = ((p0[0] + p0[1]) + (p0[2] + p0[3])) + ((p1[0] + p1[1]) + (p1[2] + p1[3]));
          if (nK == 384) { const f32x4 p2 = *(const f32x4*)(pin + (size_t)row * 20 + pslot + 8); ss += (p2[0] + p2[1]) + (p2[2] + p2[3]); }
          rs[m] = rsqrtf(ss / (float)nK + EPS); }
      }
#pragma unroll
      for (int m = 0; m < 4; ++m) {
        const int row = row0 + ai * 128 + m * 16;
#pragma unroll
        for (int bj = 0; bj < 2; ++bj) {
          const int c0 = u.pn * 256 + bj * 128 + wc * 32 + 8 * fq;
          f32x4 v0 = acc[ai][bj][m][0] * rs[m], v1 = acc[ai][bj][m][1] * rs[m];
          if (ps[bj] >= 0) {
            float sq = (v0[0] * v0[0] + v0[1] * v0[1]) + (v0[2] * v0[2] + v0[3] * v0[3]) + (v1[0] * v1[0] + v1[1] * v1[1]) + (v1[2] * v1[2] + v1[3] * v1[3]);
            { const unsigned uq = __float_as_uint(sq); auto r16 = __builtin_amdgcn_permlane16_swap(uq, uq, false, false); sq = __uint_as_float(r16[0]) + __uint_as_float(r16[1]); }
            { const unsigned uq = __float_as_uint(sq); auto r32 = __builtin_amdgcn_permlane32_swap(uq, uq, false, false); sq = __uint_as_float(r32[0]) + __uint_as_float(r32[1]); }
            if (fq == 0) pout[(size_t)row * 20 + ps[bj]] = sq;
          }
          if (rt[bj]) {
            const f32x4 o1 = v0 * cv[m] - v1 * sv[m], o2 = v1 * cv[m] + v0 * sv[m];
            v0 = o1; v1 = o2;
          }
          u32x4 w; w.x = pk2(v0[0], v0[1]); w.y = pk2(v0[2], v0[3]); w.z = pk2(v1[0], v1[1]); w.w = pk2(v1[2], v1[3]);
          *(u32x4*)(out + (size_t)row * ldc + c0) = w;
        }
      }
    }
  }
};

DI int ropeperm64(int p) { const int g = p >> 3, r = p & 7; return r < 4 ? 4 * g + r : 32 + 4 * g + (r - 4); }
DI int ropeperm32(int p) { const int g = p >> 3, r = p & 7; return r < 4 ? 4 * g + r : 16 + 4 * g + (r - 4); }
DI int srccol(int kind, int n) {
  if (kind == 0) {
    if (n < 512) return 672 + (n & ~63) + ropeperm64(n & 63);
    if (n < 640) return 1184 + ((n - 512) & ~63) + ropeperm64(n & 63);
    if (n < 768) return 1312 + (n - 640);
    if (n < 1792) return 1440 + (n - 768);
    if (n < 2176) return n - 1792;
    if (n < 2432) return 384 + (n - 2176);
    if (n < 2464) return 640 + ropeperm32(n - 2432);
    return -1;
  }
  if (kind == 1) {
    if (n < 1024) return (n & ~63) + ropeperm64(n & 63);
    if (n < 3072) return n;
    return 3080 + (n - 3072);
  }
  if (kind == 2) { const int hd = n / 96, p = n - hd * 96; return hd * 96 + (p < 64 ? p : 64 + ropeperm32(p - 64)); }
  return n;
}
struct ConvJob { const float* W; const float* g; bf16_t* Wt; int Nsrc, K, kind, tn, tk; };
DI bool conv_decode(const Params& p, int job, ConvJob& j) {
  constexpr int NT0 = 40 * 16, NT1 = 64 * 16, NT2 = 12 * 6, NT3 = 16 * 4, NT4 = 16 * 16;
  constexpr int PER_I = NT0 + NT1 + NT2 + NT3 + 2 * NT4;
  if (job >= 2 * PER_I) return false;
  unsigned char* ws = p.ws;
  const int i = job / PER_I; int t = job - i * PER_I;
  j.g = nullptr;
  if (t < NT0) { j.W = p.ev_w_in + (size_t)i * 1024 * 2464; j.Nsrc = 2464; j.K = 1024; j.Wt = (bf16_t*)(ws + WS_WEVIN + i * SZ_WEVIN); j.kind = 0; j.tn = t / 16; j.tk = t % 16; return true; }
  t -= NT0;
  if (t < NT1) { j.W = p.od_w_in + (size_t)i * 1024 * 4104; j.Nsrc = 4104; j.K = 1024; j.Wt = (bf16_t*)(ws + WS_WODIN + i * SZ_WODIN); j.kind = 1; j.tn = t / 16; j.tk = t % 16; return true; }
  t -= NT1;
  if (t < NT2) { j.W = p.ev_w_uq + (size_t)i * 384 * 768; j.Nsrc = 768; j.K = 384; j.Wt = (bf16_t*)(ws + WS_WUQ + i * SZ_WUQ); j.kind = 2; j.g = p.ev_q_norm + i * 384; j.tn = t / 6; j.tk = t % 6; return true; }
  t -= NT2;
  if (t < NT3) { j.W = p.ev_w_ukv + (size_t)i * 256 * 1024; j.Nsrc = 1024; j.K = 256; j.Wt = (bf16_t*)(ws + WS_WUKV + i * SZ_WUKV); j.kind = 3; j.g = p.ev_kv_norm + i * 256; j.tn = t / 4; j.tk = t % 4; return true; }
  t -= NT3;
  if (t < NT4) { j.W = p.ev_w_out + (size_t)i * 1024 * 1024; j.Nsrc = 1024; j.K = 1024; j.Wt = (bf16_t*)(ws + WS_WEVOUT + i * SZ_WOUT); j.kind = 4; j.tn = t / 16; j.tk = t % 16; return true; }
  t -= NT4;
  j.W = p.od_w_out + (size_t)i * 1024 * 1024; j.Nsrc = 1024; j.K = 1024; j.Wt = (bf16_t*)(ws + WS_WODOUT + i * SZ_WOUT); j.kind = 4; j.tn = t / 16; j.tk = t % 16; return true;
}
template <int NJ>
DI void convert_tiles(const Params& p, LAS unsigned char* lds, int job0, int jstride) {
  const int tid = opaque_tid();
  const int n4 = (tid & 15) * 4, kq = tid >> 4;
  ConvJob j[NJ] = {}; bool ok[NJ]; f32x4 v[NJ][2];
#pragma unroll
  for (int q = 0; q < NJ; ++q) {
    ok[q] = conv_decode(p, job0 + q * jstride, j[q]);
    const int sc = ok[q] ? srccol(j[q].kind, j[q].tn * 64 + n4) : -1;
#pragma unroll
    for (int e = 0; e < 2; ++e) {
      const int k = j[q].tk * 64 + kq + 32 * e;
      v[q][e] = (f32x4){0.f, 0.f, 0.f, 0.f};
      if (sc >= 0) { v[q][e] = *(const f32x4*)(j[q].W + (size_t)k * j[q].Nsrc + sc); if (j[q].g) v[q][e] = v[q][e] * j[q].g[k]; }
    }
  }
#pragma unroll
  for (int q = 0; q < NJ; ++q) {
    LAS bf16_t* tile = (LAS bf16_t*)(lds + q * 9216);
#pragma unroll
    for (int e = 0; e < 2; ++e)
#pragma unroll
      for (int i = 0; i < 4; ++i) tile[(n4 + i) * 72 + kq + 32 * e] = f2bf(v[q][e][i]);
  }
  __syncthreads();
#pragma unroll
  for (int q = 0; q < NJ; ++q) {
    if (ok[q]) {
      LAS bf16_t* tile = (LAS bf16_t*)(lds + q * 9216);
      const int n2 = tid >> 3, ch = tid & 7;
      const u32x4 w = *(const LAS u32x4*)(tile + n2 * 72 + ch * 8);
      *(u32x4*)(j[q].Wt + (size_t)(j[q].tn * 64 + n2) * j[q].K + j[q].tk * 64 + ch * 8) = w;
    }
  }
  __syncthreads();
}

DI void prologue(const Params& p, LAS unsigned char* lds) {
  const int tid = opaque_tid(), G = gridDim.x, bid = blockIdx.x;
  unsigned char* ws = p.ws;
  for (int idx = bid * 512 + tid; idx < 2048 * 48; idx += G * 512) {
    const bool isH = idx < 2048 * 32;
    const int j = isH ? idx : idx - 2048 * 32;
    const int pos = isH ? (j >> 5) : (j >> 4), i = isH ? (j & 31) : (j & 15);
    const float e = isH ? (float)(2 * i) * (1.f / 64.f) : (float)(2 * i) * (1.f / 32.f);
    const float inv = fast_exp2(-e * 13.287712379549449f);
    const float ang = (float)pos * inv;
    double t = (double)ang * 0.15915494309189535; t -= rint(t);
    const float fr = (float)t;
    const float cv = __builtin_amdgcn_cosf(fr), sv = __builtin_amdgcn_sinf(fr);
    if (isH) { ((float*)(ws + WS_COSH))[j] = cv; ((float*)(ws + WS_SINH))[j] = sv; }
    else { ((float*)(ws + WS_COSR))[j] = cv; ((float*)(ws + WS_SINR))[j] = sv; }
  }
  for (int job = bid; job < 4624; job += 4 * G) convert_tiles<4>(p, lds, job, G);
  const int item0 = G - 1 - bid;
  if (item0 < 192) {
    LAS float* cond = (LAS float*)lds;
    LAS float* red = (LAS float*)(lds + 65536);
    for (int e = tid; e < 16 * 1024; e += 512) { const int b = e >> 10, k = e & 1023; cond[k * 16 + b] = silu_f(p.c[e]); }
    __syncthreads();
    for (int item = item0; item < 192; item += G) {
      const int l = item / 48, n0 = (item % 48) * 64;
      const int col = tid & 63, kg = tid >> 6;
      float a[16];
#pragma unroll
      for (int b = 0; b < 16; ++b) a[b] = 0.f;
      const float* wp = p.w_ada + (size_t)l * 1024 * 3072 + n0 + col;
      for (int k0 = kg * 128; k0 < kg * 128 + 128; k0 += 16) {
        float wv[16];
#pragma unroll
        for (int e = 0; e < 16; ++e) wv[e] = wp[(size_t)(k0 + e) * 3072];
#pragma unroll
        for (int e = 0; e < 16; ++e) {
          const float w = wv[e]; const int k = k0 + e;
#pragma unroll
          for (int b4 = 0; b4 < 4; ++b4) { const f32x4 cv = *(const LAS f32x4*)(cond + k * 16 + b4 * 4);
            a[b4 * 4 + 0] += cv[0] * w; a[b4 * 4 + 1] += cv[1] * w; a[b4 * 4 + 2] += cv[2] * w; a[b4 * 4 + 3] += cv[3] * w; }
        }
      }
#pragma unroll
      for (int b = 0; b < 16; ++b) red[(kg * 16 + b) * 64 + col] = a[b];
      __syncthreads();
      for (int e = tid; e < 1024; e += 512) { const int b = e >> 6, cc = e & 63; float s = 0.f;
#pragma unroll
        for (int k8 = 0; k8 < 8; ++k8) s += red[(k8 * 16 + b) * 64 + cc];
        ((float*)(ws + WS_MOD))[((size_t)l * 16 + b) * 3072 + n0 + cc] = s + p.b_ada[l * 3072 + n0 + cc]; }
      __syncthreads();
    }
  }
}

DI void rowwise_phase(const Params& p, LAS unsigned char* lds, int lp, int ln) {
  const int tid = opaque_tid(), lane = tid & 63, wid = tid >> 6;
  const int gw = blockIdx.x * 8 + wid, nw = gridDim.x * 8;
  unsigned char* ws = p.ws;
  const float* mod = (const float*)(ws + WS_MOD);
  const bf16_t* ybuf = (const bf16_t*)(ws + WS_HBUF);
  bf16_t* hbuf = (bf16_t*)(ws + WS_HBUF);
  const bool ff = (ln < 4) && (ln & 1);
  LAS f32x4* wl = (LAS f32x4*)lds;
  if (ff) {
    const float* w = p.od_w_in + (size_t)(ln >> 1) * 1024 * 4104 + 3072;
    for (int c = tid; c < 1024; c += 512) {
      const f32x4 w0 = *(const f32x4*)(w + (size_t)c * 4104), w1 = *(const f32x4*)(w + (size_t)c * 4104 + 4);
      const int ln_ = (c & 511) >> 3, e = c & 7, j = c >> 9;
      wl[(j * 8 + e) * 64 + ln_] = w0; wl[1024 + (j * 8 + e) * 64 + ln_] = w1;
    }
    __syncthreads();
  }
  const int RPW = (T + nw - 1) / nw;
  float gpo[2][8], gpr[2][8], mgt[2][8], msh[2][8], msc[2][8];
#pragma unroll
  for (int j = 0; j < 2; ++j)
#pragma unroll
    for (int e = 0; e < 8; ++e) { gpo[j][e] = 0.f; gpr[j][e] = 0.f; mgt[j][e] = 0.f; msh[j][e] = 0.f; msc[j][e] = 0.f; }
#pragma unroll
  for (int j = 0; j < 2; ++j)
#pragma unroll
    for (int q = 0; q < 2; ++q) {
      const int c = 8 * lane + 512 * j + 4 * q;
      if (lp >= 0) { const f32x4 t = *(const f32x4*)(p.g_post + lp * DM + c); gpo[j][4 * q] = t[0]; gpo[j][4 * q + 1] = t[1]; gpo[j][4 * q + 2] = t[2]; gpo[j][4 * q + 3] = t[3]; }
      if (ln < 4) { const f32x4 t = *(const f32x4*)(p.g_pre + ln * DM + c); gpr[j][4 * q] = t[0]; gpr[j][4 * q + 1] = t[1]; gpr[j][4 * q + 2] = t[2]; gpr[j][4 * q + 3] = t[3]; }
    }
  int bcur = -1;
  for (int rr = 0; rr < RPW; ++rr) {
    const int row = gw * RPW + rr;
    if (row >= T) break;
    const int b = row >> 11;
    if (b != bcur) {
      bcur = b;
#pragma unroll
      for (int j = 0; j < 2; ++j)
#pragma unroll
        for (int q = 0; q < 2; ++q) {
          const int c = 8 * lane + 512 * j + 4 * q;
          if (lp >= 0) { const f32x4 t = *(const f32x4*)(mod + ((size_t)lp * 16 + b) * 3072 + 2048 + c); mgt[j][4 * q] = t[0]; mgt[j][4 * q + 1] = t[1]; mgt[j][4 * q + 2] = t[2]; mgt[j][4 * q + 3] = t[3]; }
          if (ln < 4) {
            const f32x4 t = *(const f32x4*)(mod + ((size_t)ln * 16 + b) * 3072 + c); msh[j][4 * q] = t[0]; msh[j][4 * q + 1] = t[1]; msh[j][4 * q + 2] = t[2]; msh[j][4 * q + 3] = t[3];
            const f32x4 u = *(const f32x4*)(mod + ((size_t)ln * 16 + b) * 3072 + 1024 + c); msc[j][4 * q] = u[0] + 1.f; msc[j][4 * q + 1] = u[1] + 1.f; msc[j][4 * q + 2] = u[2] + 1.f; msc[j][4 * q + 3] = u[3] + 1.f;
          }
        }
    }
    float xv[2][8];
    bf16_t* xbf = (bf16_t*)(ws + WS_XBF) + (size_t)row * DM;
#pragma unroll
    for (int j = 0; j < 2; ++j) {
      const int c = 8 * lane + 512 * j;
      if (lp <= 0) {
        const f32x4 a0 = *(const f32x4*)(p.x + (size_t)row * DM + c), a1 = *(const f32x4*)(p.x + (size_t)row * DM + c + 4);
        xv[j][0] = a0[0]; xv[j][1] = a0[1]; xv[j][2] = a0[2]; xv[j][3] = a0[3]; xv[j][4] = a1[0]; xv[j][5] = a1[1]; xv[j][6] = a1[2]; xv[j][7] = a1[3];
      } else {
        const u32x4 u = *(const u32x4*)(xbf + c);
#pragma unroll
        for (int e = 0; e < 4; ++e) { xv[j][2 * e] = bflo(u[e]); xv[j][2 * e + 1] = bfhi(u[e]); }
      }
    }
    if (lp >= 0) {
      float yv[2][8]; float ss = 0.f;
#pragma unroll
      for (int j = 0; j < 2; ++j) {
        const u32x4 u = *(const u32x4*)(ybuf + (size_t)row * DM + 8 * lane + 512 * j);
#pragma unroll
        for (int e = 0; e < 4; ++e) { yv[j][2 * e] = bflo(u[e]); yv[j][2 * e + 1] = bfhi(u[e]); ss += yv[j][2 * e] * yv[j][2 * e] + yv[j][2 * e + 1] * yv[j][2 * e + 1]; }
      }
      ss = wave_sum(ss);
      const float rs = rsqrtf(ss * (1.f / DM) + EPS);
#pragma unroll
      for (int j = 0; j < 2; ++j) {
        const int c = 8 * lane + 512 * j;
#pragma unroll
        for (int e = 0; e < 8; ++e) xv[j][e] += mgt[j][e] * (yv[j][e] * rs * gpo[j][e]);
        if (ln >= 4) {
          *(f32x4*)(p.out + (size_t)row * DM + c) = (f32x4){xv[j][0], xv[j][1], xv[j][2], xv[j][3]};
          *(f32x4*)(p.out + (size_t)row * DM + c + 4) = (f32x4){xv[j][4], xv[j][5], xv[j][6], xv[j][7]};
        } else {
          u32x4 w; w.x = pk2(xv[j][0], xv[j][1]); w.y = pk2(xv[j][2], xv[j][3]); w.z = pk2(xv[j][4], xv[j][5]); w.w = pk2(xv[j][6], xv[j][7]);
          *(u32x4*)(xbf + c) = w;
        }
      }
    }
    if (ln < 4) {
      float ss = 0.f;
#pragma unroll
      for (int j = 0; j < 2; ++j)
#pragma unroll
        for (int e = 0; e < 8; ++e) ss += xv[j][e] * xv[j][e];
      ss = wave_sum(ss);
      const float rs = rsqrtf(ss * (1.f / DM) + EPS);
      float zf[8];
#pragma unroll
      for (int h = 0; h < 8; ++h) zf[h] = 0.f;
#pragma unroll
      for (int j = 0; j < 2; ++j) {
        const int c = 8 * lane + 512 * j;
        float hv[8];
#pragma unroll
        for (int e = 0; e < 8; ++e) hv[e] = (xv[j][e] * rs * gpr[j][e]) * msc[j][e] + msh[j][e];
        u32x4 w; w.x = pk2(hv[0], hv[1]); w.y = pk2(hv[2], hv[3]); w.z = pk2(hv[4], hv[5]); w.w = pk2(hv[6], hv[7]);
        *(u32x4*)(hbuf + (size_t)row * DM + c) = w;
        if (ff) {
#pragma unroll
          for (int e = 0; e < 8; ++e) {
            const f32x4 w0 = wl[(j * 8 + e) * 64 + lane], w1 = wl[1024 + (j * 8 + e) * 64 + lane];
            zf[0] += hv[e] * w0[0]; zf[1] += hv[e] * w0[1]; zf[2] += hv[e] * w0[2]; zf[3] += hv[e] * w0[3];
            zf[4] += hv[e] * w1[0]; zf[5] += hv[e] * w1[1]; zf[6] += hv[e] * w1[2]; zf[7] += hv[e] * w1[3];
          }
        }
      }
      if (ff) {
        const bool b5 = lane & 32, b4 = lane & 16, b3 = lane & 8;
        float w4[4], u2[2], t;
#pragma unroll
        for (int k = 0; k < 4; ++k) { const float send = b5 ? zf[k] : zf[4 + k], keep = b5 ? zf[4 + k] : zf[k]; w4[k] = keep + __shfl_xor(send, 32); }
#pragma unroll
        for (int k = 0; k < 2; ++k) { const float send = b4 ? w4[k] : w4[2 + k], keep = b4 ? w4[2 + k] : w4[k]; u2[k] = keep + __shfl_xor(send, 16); }
        { const float send = b3 ? u2[0] : u2[1], keep = b3 ? u2[1] : u2[0]; t = keep + __shfl_xor(send, 8); }
        t += __shfl_xor(t, 4); t += __shfl_xor(t, 2); t += __shfl_xor(t, 1);
        if ((lane & 7) == 0) {
          const int h = lane >> 3;
          const float z = t + p.od_forget_bias[(ln >> 1) * 8 + h];
          const float ls = fminf(z, 0.f) - __builtin_amdgcn_logf(1.f + fast_exp2(-fabsf(z) * LOG2E)) * 0.6931471805599453f;
          ((float*)(ws + WS_LOGF))[(size_t)row * 8 + h] = ls;
        }
      }
    }
  }
  __syncthreads();
}

DI void fox_scan(const Params& p, LAS unsigned char* lds, int bh) {
  const int tid = opaque_tid();
  const int b = bh >> 3, h = bh & 7;
  const float* logf_ = (const float*)(p.ws + WS_LOGF);
  float* fcum = (float*)(p.ws + WS_FCUM) + (size_t)bh * SEQ;
  LAS float* s = (LAS float*)lds;
  float v[4];
#pragma unroll
  for (int j = 0; j < 4; ++j) v[j] = logf_[((size_t)b * SEQ + 4 * tid + j) * 8 + h];
  v[1] += v[0]; v[2] += v[1]; v[3] += v[2];
  s[tid] = v[3];
  __syncthreads();
  for (int off = 1; off < 512; off <<= 1) {
    float t = 0.f;
    if (tid >= off) t = s[tid - off];
    __syncthreads();
    s[tid] += t;
    __syncthreads();
  }
  const float excl = s[tid] - v[3];
#pragma unroll
  for (int j = 0; j < 4; ++j) fcum[4 * tid + j] = -8.0f * (excl + v[j]);
  __syncthreads();
}

struct AttnArgs { const bf16_t *q, *k, *k2, *v, *gate; bf16_t* out; const float* fcum; int ldq, ldk, ldk2, ldv, ldo, ldg; float sl2, sink; };

DI float half_max(float x) {
  const unsigned u = __float_as_uint(x);
  auto r = __builtin_amdgcn_permlane32_swap(u, u, false, false);
  return fmaxf(__uint_as_float(r[0]), __uint_as_float(r[1]));
}
DI float half_sum(float x) {
  const unsigned u = __float_as_uint(x);
  auto r = __builtin_amdgcn_permlane32_swap(u, u, false, false);
  return __uint_as_float(r[0]) + __uint_as_float(r[1]);
}


DI void epi_block(const f32x16& O, float inv, int hh, const bf16_t* gate_row, bf16_t* out_row) {
#pragma unroll
  for (int g = 0; g < 4; g += 2) {
    float v[8];
#pragma unroll
    for (int e = 0; e < 4; ++e) {
      auto r = __builtin_amdgcn_permlane32_swap(__float_as_uint(O[4 * g + e] * inv), __float_as_uint(O[4 * (g + 1) + e] * inv), false, false);
      v[e] = __uint_as_float(r[0]); v[4 + e] = __uint_as_float(r[1]);
    }
    const int c = 8 * g + 8 * hh;
    if (gate_row) {
      const u32x4 gv = *(const u32x4*)(gate_row + c);
#pragma unroll
      for (int e = 0; e < 4; ++e) { v[2 * e] *= silu_f(bflo(gv[e])); v[2 * e + 1] *= silu_f(bfhi(gv[e])); }
    }
    u32x4 w; w.x = pk2(v[0], v[1]); w.y = pk2(v[2], v[3]); w.z = pk2(v[4], v[5]); w.w = pk2(v[6], v[7]);
    *(u32x4*)(out_row + c) = w;
  }
}

template <int N> DI void wait_vmcnt() { asm volatile("s_waitcnt vmcnt(%0)" ::"n"(N) : "memory"); }
DI void raw_barrier() { asm volatile("" ::: "memory"); __builtin_amdgcn_s_barrier(); asm volatile("" ::: "memory"); }

template <int DQK, int DV, int MODE>
DI void attn_item(LAS unsigned char* lds, const AttnArgs& a, int qb) {
  constexpr int KSTR = DQK * 2 + 16, VSTR = (DV == 64) ? 192 : 320;
  constexpr int KG16 = KSTR / 16, VG16 = VSTR / 16;
  constexpr int KCH = KG16, VCH = VG16, NCH = KCH + VCH;
  constexpr int TILE = NCH * 1024 + (MODE == 2 ? 2048 : 0);
  constexpr int NSLOT = (NCH + 7) / 8, REM = NCH - 8 * (NSLOT - 1);
  constexpr int FX = (MODE == 2) ? 1 : 0;
  constexpr int NKS = DQK / 16, NBLK = DV / 32;
  static_assert(5 * TILE <= 155648, "ring too large");
  const int tid = opaque_tid(), wid = __builtin_amdgcn_readfirstlane(tid >> 6), lane = tid & 63, r = lane & 31, hh = lane >> 5;
  const int q0 = qb * 256, qw = q0 + 32 * wid, myq = qw + r;
  const float c = a.sl2, tau = 8.0f / a.sl2;
  bf16x8 qf[NKS];
#pragma unroll
  for (int ks = 0; ks < NKS; ++ks) qf[ks] = *(const bf16x8*)(a.q + (size_t)myq * a.ldq + 16 * ks + 8 * hh);
  int lo = 0; const int hi = 4 * (qb + 1);
  if (MODE == 1) { lo = 4 * qb - 2; if (lo < 0) lo = 0; }
  const int last_w = (qw + 31) >> 6;
  int first_w = 0;
  if (MODE == 1) { first_w = (qw > 127 ? qw - 127 : 0) >> 6; }
  const char* sp[NSLOT]; unsigned sst[NSLOT];
#pragma unroll
  for (int j = 0; j < NSLOT; ++j) {
    const int ch_ = 8 * j + wid;
    if (ch_ < KCH) {
      const int p = ch_ * 64 + lane, row = p / KG16, g = p - row * KG16;
      if (DQK == 96 && g >= 8 && g < 12) { sp[j] = (const char*)(a.k2 + (size_t)row * a.ldk2 + 8 * (g - 8)); sst[j] = (unsigned)(128 * a.ldk2); }
      else { sp[j] = (const char*)(a.k + (size_t)row * a.ldk + 8 * (g < 8 ? g : 0)); sst[j] = (unsigned)(128 * a.ldk); }
    } else {
      const int p = (ch_ - KCH) * 64 + lane, row = (p / VG16) & 63, g = p - (p / VG16) * VG16;
      sp[j] = (const char*)(a.v + (size_t)row * a.ldv + 8 * (g < DV / 8 ? g : 0)); sst[j] = (unsigned)(128 * a.ldv);
    }
  }
  auto issue = [&](int kt) {
    LAS unsigned char* base = lds + (kt % 4) * TILE;
#pragma unroll
    for (int j = 0; j < NSLOT; ++j) {
      if (j < NSLOT - 1 || wid < REM)
        __builtin_amdgcn_global_load_lds((const unsigned*)(sp[j] + (size_t)kt * sst[j]), (LAS unsigned*)(base + (8 * j + wid) * 1024), 16, 0, 0);
    }
    if (MODE == 2) __builtin_amdgcn_global_load_lds((const unsigned*)(a.fcum + kt * 64 + lane), (LAS unsigned*)(base + NCH * 1024 + wid * 256), 4, 0, 0);
  };
  auto wait_tiles = [&](bool all) {
    if (all) wait_vmcnt<0>();
    else if (wid < REM) wait_vmcnt<NSLOT + FX>();
    else wait_vmcnt<NSLOT - 1 + FX>();
  };
  f32x16 O[NBLK];
#pragma unroll
  for (int bl = 0; bl < NBLK; ++bl)
#pragma unroll
    for (int i = 0; i < 16; ++i) O[bl][i] = 0.f;
  float m = (MODE == 1) ? a.sink / a.sl2 : -1e30f;
  float l0 = (MODE == 1 && hh == 0) ? 1.f : 0.f, l1 = 0.f;
  const int i16 = lane & 15, q4 = i16 >> 2, p4 = i16 & 3, grp = (lane >> 4) & 1;
  auto qk_load = [&](int kt, bf16x8 (&kf)[2][NKS]) {
    LAS unsigned char* Kl = lds + (kt % 4) * TILE;
#pragma unroll
    for (int kb = 0; kb < 2; ++kb)
#pragma unroll
      for (int ks = 0; ks < NKS; ++ks) kf[kb][ks] = *(const LAS bf16x8*)(Kl + (32 * kb + r) * KSTR + (16 * ks + 8 * hh) * 2);
  };
  auto qk_mma = [&](int kt, const bf16x8 (&kf)[2][NKS], f32x16 (&s)[2]) {
#pragma unroll
    for (int kb = 0; kb < 2; ++kb) {
      if (MODE == 2) {
        LAS unsigned char* Fl = lds + (kt % 4) * TILE + NCH * 1024 + wid * 256;
#pragma unroll
        for (int g = 0; g < 4; ++g) { const f32x4 fb = *(const LAS f32x4*)(Fl + (32 * kb + 8 * g + 4 * hh) * 4);
          s[kb][4 * g] = fb[0]; s[kb][4 * g + 1] = fb[1]; s[kb][4 * g + 2] = fb[2]; s[kb][4 * g + 3] = fb[3]; }
      } else {
#pragma unroll
        for (int i = 0; i < 16; ++i) s[kb][i] = 0.f;
      }
    }
#pragma unroll
    for (int ks = 0; ks < NKS; ++ks)
#pragma unroll
      for (int kb = 0; kb < 2; ++kb) s[kb] = __builtin_amdgcn_mfma_f32_32x32x16_bf16(kf[kb][ks], qf[ks], s[kb], 0, 0, 0);
  };
  auto softmax = [&](int kt, f32x16 (&s)[2], bf16x8 (&pf)[2][2], auto maskc) {
    constexpr bool MASK = decltype(maskc)::value;
    const int key0 = kt * 64;
    if (MASK) {
#pragma unroll
      for (int kb = 0; kb < 2; ++kb)
#pragma unroll
        for (int i = 0; i < 16; ++i) {
          const int key = key0 + 32 * kb + (i & 3) + 8 * (i >> 2) + 4 * hh;
          bool valid = key <= myq; if (MODE == 1) valid = valid && (myq - key < 128);
          s[kb][i] = valid ? s[kb][i] : -1e30f;
        }
    }
    float mx = fmaxf(s[0][0], s[1][0]);
#pragma unroll
    for (int i = 1; i < 16; ++i) mx = fmaxf(fmaxf(mx, s[0][i]), s[1][i]);
    mx = half_max(mx);
    if (__builtin_amdgcn_ballot_w64(mx > m + tau) != 0ull) {
      const float mnew = fmaxf(m, mx);
      const float alpha = fast_exp2((m - mnew) * c);
      m = mnew;
      l0 *= alpha; l1 *= alpha;
#pragma unroll
      for (int bl = 0; bl < NBLK; ++bl)
#pragma unroll
        for (int i = 0; i < 16; ++i) O[bl][i] *= alpha;
    }
    const float nmc = -m * c;
#pragma unroll
    for (int kb = 0; kb < 2; ++kb)
#pragma unroll
      for (int s2 = 0; s2 < 2; ++s2) {
        float pv[8];
#pragma unroll
        for (int e = 0; e < 8; ++e) pv[e] = fast_exp2(__builtin_fmaf(s[kb][8 * s2 + e], c, nmc));
        l0 += (pv[0] + pv[4]) + (pv[2] + pv[6]); l1 += (pv[1] + pv[5]) + (pv[3] + pv[7]);
        u32x4 w;
        w.x = pk2(pv[0], pv[1]); w.y = pk2(pv[2], pv[3]); w.z = pk2(pv[4], pv[5]); w.w = pk2(pv[6], pv[7]);
        pf[kb][s2] = __builtin_bit_cast(bf16x8, w);
      }
  };
  auto pvmm = [&](int kt, const bf16x8 (&pf)[2][2]) {
    constexpr int PD = (NBLK == 2) ? 2 : 1;
    const unsigned va = (unsigned)(size_t)(lds + (kt % 4) * TILE + KCH * 1024 + (4 * hh + q4) * VSTR + (16 * grp) * 2 + 8 * p4);
    s16x4 vl[PD + 1][NBLK], vh[PD + 1][NBLK];
#define TRRD(dst, off) asm volatile("ds_read_b64_tr_b16 %0, %1 offset:%2" : "=&v"(dst) : "v"(va), "n"(off) : "memory")
#define TRSTEP(st_) do { _Pragma("unroll") for (int bl = 0; bl < NBLK; ++bl) { TRRD(vl[(st_) % (PD + 1)][bl], 16 * (st_) * VSTR + 64 * bl); TRRD(vh[(st_) % (PD + 1)][bl], 16 * (st_) * VSTR + 64 * bl + 8 * VSTR); } } while (0)
#define TRWAIT(n_, b_) do { if (NBLK == 2) asm volatile("s_waitcnt lgkmcnt(" #n_ ")" : "+v"(vl[b_][0]), "+v"(vh[b_][0]), "+v"(vl[b_][1]), "+v"(vh[b_][1])::"memory"); \
    else asm volatile("s_waitcnt lgkmcnt(" #n_ ")" : "+v"(vl[b_][0]), "+v"(vh[b_][0]), "+v"(vl[b_][1]), "+v"(vh[b_][1]), "+v"(vl[b_][2 % NBLK]), "+v"(vh[b_][2 % NBLK]), "+v"(vl[b_][3 % NBLK]), "+v"(vh[b_][3 % NBLK])::"memory"); } while (0)
#pragma unroll
    for (int st = 0; st < PD; ++st) TRSTEP(st);
#pragma unroll
    for (int st = 0; st < 4; ++st) {
      if (st + PD < 4) TRSTEP(st + PD);
      const int ahead = ((st + PD < 4) ? st + PD : 3) - st;
      const int b_ = st % (PD + 1);
      if (ahead * 2 * NBLK == 8) TRWAIT(8, b_); else if (ahead * 2 * NBLK == 4) TRWAIT(4, b_); else TRWAIT(0, b_);
#pragma unroll
      for (int bl = 0; bl < NBLK; ++bl) {
        const bf16x8 vf = __builtin_shufflevector(vl[b_][bl], vh[b_][bl], 0, 1, 2, 3, 4, 5, 6, 7);
        O[bl] = __builtin_amdgcn_mfma_f32_32x32x16_bf16(vf, pf[st >> 1][st & 1], O[bl], 0, 0, 0);
      }
    }
#undef TRRD
#undef TRSTEP
#undef TRWAIT
  };
  auto act = [&](int kt) { return kt <= last_w && kt >= first_w; };
  f32x16 sA[2];
  const bool halfB = wid >= 4;
  issue(lo);
  if (lo + 1 < hi) issue(lo + 1);
  if (lo + 2 < hi) issue(lo + 2);
  wait_tiles(true);
  raw_barrier();
  if (halfB) raw_barrier();
  if (act(lo)) { bf16x8 kf0[2][NKS]; qk_load(lo, kf0); qk_mma(lo, kf0, sA); }
  auto step = [&](int kt, auto maskc) {
    const bool a0 = act(kt), a1 = (kt + 1 < hi) && act(kt + 1);
    bf16x8 pf[2][2], kf[2][NKS];
    if (a0) softmax(kt, sA, pf, maskc);
    wait_tiles(true);
    raw_barrier();
    if (a1) qk_load(kt + 1, kf);
    __builtin_amdgcn_s_setprio(1);
    if (a1) qk_mma(kt + 1, kf, sA);
    if (a0) pvmm(kt, pf);
    __builtin_amdgcn_s_setprio(0);
    if (kt + 3 < hi) issue(kt + 3);
    raw_barrier();
  };
  int split = lo;
  if (MODE != 1) { split = qw >> 6; if (split < lo) split = lo; if (split > hi) split = hi; }
  if (MODE != 1) { for (int kt = lo; kt < split; ++kt) step(kt, std::false_type{}); }
  for (int kt = split; kt < hi; ++kt) step(kt, std::true_type{});
  if (!halfB) raw_barrier();
  const float l = half_sum(l0 + l1);
  const float inv = 1.f / l;
#pragma unroll
  for (int bl = 0; bl < NBLK; ++bl)
    epi_block(O[bl], inv, hh, a.gate ? a.gate + (size_t)myq * a.ldg + 32 * bl : nullptr, a.out + (size_t)myq * a.ldo + 32 * bl);
}

DI void swa_item(LAS unsigned char* lds, const AttnArgs& a, const float* sinks4, int qb) {
  constexpr int KSTR = 144, VSTR = 192, KCH = 9, VCH = 12, NCH = 21, TILE = NCH * 1024, NSLOT = 3, REM = 5, NKS = 4, NBLK = 2;
  const int tid = opaque_tid(), wid = __builtin_amdgcn_readfirstlane(tid >> 6), lane = tid & 63, r = lane & 31, hh = lane >> 5;
  const int q0 = qb * 256, qw = q0 + 32 * wid, myq = qw + r;
  const float c = a.sl2, tau = 8.0f / a.sl2;
  int lo = 4 * qb - 2; if (lo < 0) lo = 0;
  const int hi = 4 * (qb + 1);
  const int last_w = (qw + 31) >> 6, first_w = (qw > 127 ? qw - 127 : 0) >> 6;
#pragma unroll
  for (int j = 0; j < NSLOT; ++j) {
    const int ch_ = 8 * j + wid;
    if (j < NSLOT - 1 || wid < REM) {
      const char* sp; unsigned sst;
      if (ch_ < KCH) { const int p = ch_ * 64 + lane, row = p / 9, g = p - row * 9;
        sp = (const char*)(a.k + (size_t)row * a.ldk + 8 * (g < 8 ? g : 0)); sst = (unsigned)(128 * a.ldk); }
      else { const int p = (ch_ - KCH) * 64 + lane, row = (p / 12) & 63, g = p - (p / 12) * 12;
        sp = (const char*)(a.v + (size_t)row * a.ldv + 8 * (g < 8 ? g : 0)); sst = (unsigned)(128 * a.ldv); }
      for (int kt = lo; kt < hi; ++kt)
        __builtin_amdgcn_global_load_lds((const unsigned*)(sp + (size_t)kt * sst), (LAS unsigned*)(lds + (kt - lo) * TILE + ch_ * 1024), 16, 0, 0);
    }
  }
  wait_vmcnt<0>();
  raw_barrier();
  const int i16 = lane & 15, q4 = i16 >> 2, p4 = i16 & 3, grp = (lane >> 4) & 1;
  for (int h4 = 0; h4 < 4; ++h4) {
    bf16x8 qf[NKS];
#pragma unroll
    for (int ks = 0; ks < NKS; ++ks) qf[ks] = *(const bf16x8*)(a.q + (size_t)myq * a.ldq + h4 * 64 + 16 * ks + 8 * hh);
    f32x16 O[NBLK];
#pragma unroll
    for (int bl = 0; bl < NBLK; ++bl)
#pragma unroll
      for (int i = 0; i < 16; ++i) O[bl][i] = 0.f;
    float m = sinks4[h4] / a.sl2;
    float l0 = (hh == 0) ? 1.f : 0.f, l1 = 0.f;
    for (int kt = first_w; kt <= last_w; ++kt) {
      LAS unsigned char* Kl = lds + (kt - lo) * TILE;
      f32x16 s[2];
      bf16x8 kf[2][NKS];
#pragma unroll
      for (int kb = 0; kb < 2; ++kb)
#pragma unroll
        for (int ks = 0; ks < NKS; ++ks) kf[kb][ks] = *(const LAS bf16x8*)(Kl + (32 * kb + r) * KSTR + (16 * ks + 8 * hh) * 2);
#pragma unroll
      for (int kb = 0; kb < 2; ++kb)
#pragma unroll
        for (int i = 0; i < 16; ++i) s[kb][i] = 0.f;
#pragma unroll
      for (int ks = 0; ks < NKS; ++ks)
#pragma unroll
        for (int kb = 0; kb < 2; ++kb) s[kb] = __builtin_amdgcn_mfma_f32_32x32x16_bf16(kf[kb][ks], qf[ks], s[kb], 0, 0, 0);
      const int key0 = kt * 64;
#pragma unroll
      for (int kb = 0; kb < 2; ++kb)
#pragma unroll
        for (int i = 0; i < 16; ++i) {
          const int key = key0 + 32 * kb + (i & 3) + 8 * (i >> 2) + 4 * hh;
          const bool valid = (key <= myq) && (myq - key < 128);
          s[kb][i] = valid ? s[kb][i] : -1e30f;
        }
      float mx = fmaxf(s[0][0], s[1][0]);
#pragma unroll
      for (int i = 1; i < 16; ++i) mx = fmaxf(fmaxf(mx, s[0][i]), s[1][i]);
      mx = half_max(mx);
      if (__builtin_amdgcn_ballot_w64(mx > m + tau) != 0ull) {
        const float mnew = fmaxf(m, mx);
        const float alpha = fast_exp2((m - mnew) * c);
        m = mnew; l0 *= alpha; l1 *= alpha;
#pragma unroll
        for (int bl = 0; bl < NBLK; ++bl)
#pragma unroll
          for (int i = 0; i < 16; ++i) O[bl][i] *= alpha;
      }
      const float nmc = -m * c;
      bf16x8 pf[2][2];
#pragma unroll
      for (int kb = 0; kb < 2; ++kb)
#pragma unroll
        for (int s2 = 0; s2 < 2; ++s2) {
          float pv[8];
#pragma unroll
          for (int e = 0; e < 8; ++e) pv[e] = fast_exp2(__builtin_fmaf(s[kb][8 * s2 + e], c, nmc));
          l0 += (pv[0] + pv[4]) + (pv[2] + pv[6]); l1 += (pv[1] + pv[5]) + (pv[3] + pv[7]);
          u32x4 w;
          w.x = pk2(pv[0], pv[1]); w.y = pk2(pv[2], pv[3]); w.z = pk2(pv[4], pv[5]); w.w = pk2(pv[6], pv[7]);
          pf[kb][s2] = __builtin_bit_cast(bf16x8, w);
        }
      LAS unsigned char* Vl = Kl + KCH * 1024 + (4 * hh + q4) * VSTR + (16 * grp) * 2 + 8 * p4;
#pragma unroll
      for (int st = 0; st < 4; ++st)
#pragma unroll
        for (int bl = 0; bl < NBLK; ++bl) {
          LAS unsigned char* ad = Vl + (16 * st) * VSTR + (32 * bl) * 2;
          const s16x4 lo_ = __builtin_amdgcn_ds_read_tr16_b64_v4i16((LAS s16x4*)ad);
          const s16x4 hi_ = __builtin_amdgcn_ds_read_tr16_b64_v4i16((LAS s16x4*)(ad + 8 * VSTR));
          const bf16x8 vf = __builtin_shufflevector(lo_, hi_, 0, 1, 2, 3, 4, 5, 6, 7);
          O[bl] = __builtin_amdgcn_mfma_f32_32x32x16_bf16(vf, pf[st >> 1][st & 1], O[bl], 0, 0, 0);
        }
    }
    const float l = half_sum(l0 + l1);
    const float inv = 1.f / l;
#pragma unroll
    for (int bl = 0; bl < NBLK; ++bl)
      epi_block(O[bl], inv, hh, a.gate + (size_t)myq * a.ldg + h4 * 64 + 32 * bl, a.out + (size_t)myq * a.ldo + h4 * 64 + 32 * bl);
  }
  __syncthreads();
}

DI bool team_item(int G, int c, int n, int& bh, int& qb) {
  if (G == 256) {
    const int x = c & 7, li = c >> 3, t = li >> 3, i = li & 7;
    bh = x + 8 * (4 * t + n);
    const int j = (i + 4) & 7;
    qb = (n == 0) ? i : (n == 1) ? 7 - i : (n == 2) ? j : 7 - j;
    return true;
  }
  const int idx = n * G + ((n & 1) ? (G - 1 - c) : c);
  if (idx >= 1024) return false;
  qb = 7 - idx / 128; bh = idx % 128;
  return true;
}

DI int snake_idx(int round, int G, int c) { return round * G + ((round & 1) ? (G - 1 - c) : c); }

DI void attn_even(const Params& p, LAS unsigned char* lds, int i) {
  const int G = gridDim.x, c = blockIdx.x;
  unsigned char* ws = p.ws;
  const bf16_t* z = (const bf16_t*)(ws + WS_ZBUF);
  const bf16_t* qb_ = (const bf16_t*)(ws + WS_QBUF);
  const bf16_t* kv = (const bf16_t*)(ws + WS_HBUF);
  bf16_t* ob = (bf16_t*)(ws + WS_OBUF);
  for (int rd = 0; rd * G < 1024; ++rd) {
    int qb, bh;
    if (!team_item(G, c, rd, bh, qb)) continue;
    const int b = bh >> 3, hd = bh & 7;
    AttnArgs a;
    a.q = qb_ + (size_t)b * SEQ * 768 + hd * 96; a.ldq = 768;
    a.k = kv + (size_t)b * SEQ * 1024 + hd * 128; a.ldk = 1024;
    a.k2 = z + (size_t)b * SEQ * 2560 + 2432; a.ldk2 = 2560;
    a.v = kv + (size_t)b * SEQ * 1024 + hd * 128 + 64; a.ldv = 1024;
    a.out = ob + (size_t)b * SEQ * 1024 + hd * 64; a.ldo = 1024;
    a.gate = z + (size_t)b * SEQ * 2560 + 768 + hd * 64; a.ldg = 2560;
    a.fcum = nullptr; a.sl2 = 0.10206207261596577f * LOG2E; a.sink = 0.f;
    attn_item<96, 64, 0>(lds, a, qb);
  }
  for (int it = c; it < 256; it += G) {
    const int b = it >> 4, kvh = (it >> 3) & 1, qb = it & 7;
    AttnArgs a;
    const bf16_t* zb = z + (size_t)b * SEQ * 2560;
    a.q = zb + kvh * 256; a.ldq = 2560;
    a.k = zb + 512 + kvh * 64; a.ldk = 2560; a.k2 = nullptr; a.ldk2 = 0;
    a.v = zb + 640 + kvh * 64; a.ldv = 2560;
    a.out = ob + (size_t)b * SEQ * 1024 + 512 + kvh * 256; a.ldo = 1024;
    a.gate = zb + 768 + 512 + kvh * 256; a.ldg = 2560;
    a.fcum = nullptr; a.sl2 = 0.125f * LOG2E; a.sink = 0.f;
    float sk[4];
#pragma unroll
    for (int h4 = 0; h4 < 4; ++h4) sk[h4] = p.ev_sinks[i * 8 + kvh * 4 + h4] * LOG2E;
    swa_item(lds, a, sk, qb);
  }
}

DI void attn_odd(const Params& p, LAS unsigned char* lds, int layer) {
  const int G = gridDim.x, c = blockIdx.x;
  unsigned char* ws = p.ws;
  const bf16_t* z = (const bf16_t*)(ws + WS_ZBUF);
  bf16_t* od = (bf16_t*)(ws + WS_HBUF);
  bf16_t* ob = (bf16_t*)(ws + WS_OBUF);
  {
    for (int rd = 0; rd * G < 512; ++rd) {
      int qb, bh2;
      if (G == 256) { const int x = c & 7, li = c >> 3, t = li >> 3, i = li & 7; bh2 = x + 8 * (2 * t + rd); qb = (rd == 0) ? i : 7 - i; }
      else { const int idx = snake_idx(rd, G, c); if (idx >= 512) continue; qb = 7 - idx / 64; bh2 = idx % 64; }
      const int b = bh2 >> 2, h = bh2 & 3;
      const bf16_t* zb = z + (size_t)b * SEQ * 4096;
      for (int mp = 0; mp < 2; ++mp) {
        const int j = 2 * h + mp;
        AttnArgs a;
        a.q = zb + j * 64; a.ldq = 4096;
        a.k = zb + 512 + j * 64; a.ldk = 4096; a.k2 = nullptr; a.ldk2 = 0;
        a.v = zb + 1024 + h * 128; a.ldv = 4096;
        a.out = od + (size_t)b * SEQ * 1024 + j * 128; a.ldo = 1024;
        a.gate = nullptr; a.ldg = 0;
        a.fcum = nullptr; a.sl2 = 0.125f * LOG2E; a.sink = 0.f;
#ifndef SKIP_DIFF
        attn_item<64, 128, 0>(lds, a, qb);
#endif
      }
      __builtin_amdgcn_fence(__ATOMIC_SEQ_CST, "workgroup");
      asm volatile("s_waitcnt vmcnt(0)" ::: "memory");
      const int tid2 = opaque_tid(), lane = tid2 & 63, wid = tid2 >> 6, li_ = layer >> 1;
      const float* lp = p.od_lambda + li_ * 256;
      const float s1 = wave_sum(lp[lane] * lp[64 + lane]), s2 = wave_sum(lp[128 + lane] * lp[192 + lane]);
      const float lam_init = 0.8f - 0.6f * fast_exp2(-0.3f * LOG2E * (float)layer);
      const float lam = fast_exp2(s1 * LOG2E) - fast_exp2(s2 * LOG2E) + lam_init;
      const int rsub = lane >> 4, dv = (lane & 15) * 8;
      float sub[8];
#pragma unroll
      for (int e = 0; e < 8; ++e) sub[e] = p.od_subln[li_ * 128 + dv + e] * (1.f - lam_init);
      const size_t row0 = (size_t)b * SEQ + qb * 256 + 32 * wid;
#pragma unroll 2
      for (int rr = 0; rr < 8; ++rr) {
        const size_t row = row0 + 4 * rr + rsub;
        const u32x4 va = *(const u32x4*)(od + row * 1024 + (2 * h) * 128 + dv);
        const u32x4 vb = *(const u32x4*)(od + row * 1024 + (2 * h + 1) * 128 + dv);
        const u32x4 vg = *(const u32x4*)(z + row * 4096 + 3072 + h * 128 + dv);
        float d[8]; float ss = 0.f;
#pragma unroll
        for (int e = 0; e < 4; ++e) { d[2 * e] = bflo(va[e]) - lam * bflo(vb[e]); d[2 * e + 1] = bfhi(va[e]) - lam * bfhi(vb[e]); ss += d[2 * e] * d[2 * e] + d[2 * e + 1] * d[2 * e + 1]; }
        ss += dpp_mov<0xB1>(ss); ss += dpp_mov<0x4E>(ss); ss += dpp_mov<0x141>(ss); ss += dpp_mov<0x140>(ss);
        const float rs = rsqrtf(ss * (1.f / 128.f) + EPS);
        u32x4 w;
#pragma unroll
        for (int e = 0; e < 4; ++e) {
          const float o0 = d[2 * e] * rs * sub[2 * e] * silu_f(bflo(vg[e])), o1 = d[2 * e + 1] * rs * sub[2 * e + 1] * silu_f(bfhi(vg[e]));
          w[e] = pk2(o0, o1);
        }
        *(u32x4*)(ob + row * 1024 + h * 128 + dv) = w;
      }
    }
  }
  for (int rd = 0; rd * G < 1024; ++rd) {
    int qb, bh;
    if (!team_item(G, c, rd, bh, qb)) continue;
    const int b = bh >> 3, hd = bh & 7;
    AttnArgs a;
    const bf16_t* zb = z + (size_t)b * SEQ * 4096;
    a.q = zb + 1536 + hd * 64; a.ldq = 4096;
    a.k = zb + 2048 + hd * 64; a.ldk = 4096; a.k2 = nullptr; a.ldk2 = 0;
    a.v = zb + 2560 + hd * 64; a.ldv = 4096;
    a.out = ob + (size_t)b * SEQ * 1024 + 512 + hd * 64; a.ldo = 1024;
    a.gate = zb + 3072 + 512 + hd * 64; a.ldg = 4096;
    a.fcum = (const float*)(ws + WS_FCUM) + (size_t)bh * SEQ; a.sl2 = 0.125f * LOG2E; a.sink = 0.f;
#ifndef SKIP_FOX
    attn_item<64, 64, 2>(lds, a, qb);
#endif
  }
}

#define XB_TMO      128
#define XB_XCNT(j)  (256  + 64 * (j))
#define XB_XSUB(j)  (1280 + 64 * (j))
#define XB_XGEN(j)  (2304 + 64 * (j))
#define XB_TOP      3328
#define XB_TOPGEN   3392
#define XCD_BAR_WORDS 3456
#define XB_SPIN_CAP (1u << 20)
DI unsigned xb_ld(unsigned* p) { return __hip_atomic_load(p, __ATOMIC_RELAXED, __HIP_MEMORY_SCOPE_AGENT); }
DI unsigned xb_add(unsigned* p, unsigned v) { return __hip_atomic_fetch_add(p, v, __ATOMIC_RELAXED, __HIP_MEMORY_SCOPE_AGENT); }
DI unsigned xb_xcc_id() { return (unsigned)__builtin_amdgcn_s_getreg((3 << 11) | 20) & 0xFu; }
#define XB_SPIN(cond, bar) do { unsigned _sp = 0; while (cond) { __builtin_amdgcn_s_sleep(1); \
    if ((++_sp & 255u) == 0u) { if (xb_ld(&(bar)[XB_TMO])) break; if (_sp > XB_SPIN_CAP) { atomicAdd(&(bar)[XB_TMO], 1u); break; } } } } while (0)
struct XcdBarrier { unsigned* bar; unsigned x; volatile LAS unsigned* st; };
DI void xcd_barrier_complete(unsigned* bar, unsigned x, unsigned& nloc, unsigned& nx) {
  const unsigned G = gridDim.x;
  unsigned sum, cnt, mine, sp = 0u;
  for (;;) {
    sum = 0u; cnt = 0u; mine = 0u;
#pragma unroll
    for (unsigned j = 0; j < 16; ++j) { const unsigned c = xb_ld(&bar[XB_XCNT(j)]); sum += c; cnt += (c > 0u) ? 1u : 0u; mine = (j == x) ? c : mine; }
    if (sum == G) break;
    __builtin_amdgcn_s_sleep(1);
    if ((++sp & 255u) == 0u) { if (xb_ld(&bar[XB_TMO])) break; if (sp > XB_SPIN_CAP) { atomicAdd(&bar[XB_TMO], 1u); break; } }
  }
  nloc = mine > 0u ? mine : 1u; nx = cnt > 0u ? cnt : 1u;
}
DI void xcd_barrier(const XcdBarrier& b) {
  asm volatile("s_waitcnt vmcnt(0)" ::: "memory");
  __syncthreads();
  if (threadIdx.x == 0) {
    unsigned* bar = b.bar;
    __builtin_amdgcn_s_waitcnt(0);
    unsigned nloc = b.st[0], nx = b.st[1];
    if (nloc == 0u) { xcd_barrier_complete(bar, b.x, nloc, nx); b.st[0] = nloc; b.st[1] = nx; }
    const unsigned old = xb_add(&bar[XB_XSUB(b.x)], 1u);
    const unsigned gen = old / nloc;
    if (old + 1u == (gen + 1u) * nloc) {
      __builtin_amdgcn_fence(__ATOMIC_RELEASE, "agent");
      asm volatile("s_waitcnt vmcnt(0)" ::: "memory");
      const unsigned og = xb_add(&bar[XB_TOP], 1u);
      const unsigned tg = og / nx;
      if (og + 1u == (tg + 1u) * nx) xb_add(&bar[XB_TOPGEN], 1u);
      else XB_SPIN(xb_ld(&bar[XB_TOPGEN]) == tg, bar);
      __builtin_amdgcn_fence(__ATOMIC_ACQUIRE, "agent");
      xb_add(&bar[XB_XGEN(b.x)], 1u);
      asm volatile("s_waitcnt vmcnt(0)" ::: "memory");
    } else {
      XB_SPIN(xb_ld(&bar[XB_XGEN(b.x)]) == gen, bar);
      __builtin_amdgcn_fence(__ATOMIC_ACQUIRE, "agent");
      asm volatile("s_waitcnt vmcnt(0)" ::: "memory");
    }
  }
  __syncthreads();
}

__global__ void __launch_bounds__(512) fwd_megakernel(Params p) {
  extern __shared__ __attribute__((aligned(16))) unsigned char lds_raw[];
  LAS unsigned char* lds = (LAS unsigned char*)lds_raw;
  cg::grid_group grid = cg::this_grid();
  unsigned char* ws = p.ws;
  const int G = gridDim.x, bid = blockIdx.x;
  const float* cosH = (const float*)(ws + WS_COSH); const float* sinH = (const float*)(ws + WS_SINH);
  const float* cosR = (const float*)(ws + WS_COSR); const float* sinR = (const float*)(ws + WS_SINR);

  unsigned* xbar = (unsigned*)(ws + WS_XBAR);
  if (bid == 0) { for (int w = threadIdx.x; w < XCD_BAR_WORDS; w += 512) __hip_atomic_store(xbar + w, 0u, __ATOMIC_RELAXED, __HIP_MEMORY_SCOPE_AGENT); }
  volatile LAS unsigned* xst = (volatile LAS unsigned*)(lds + LDS_BYTES_C - 16);
  if (threadIdx.x == 0) { xst[0] = 0u; xst[1] = 0u; }
#ifndef SKIP_PRO
  prologue(p, lds);
#endif
  grid.sync();
  XcdBarrier xb; xb.bar = xbar; xb.x = xb_xcc_id(); xb.st = xst;
  if (threadIdx.x == 0) (void)xb_add(&xbar[XB_XCNT(xb.x)], 1u);
#pragma unroll
  for (int layer = 0; layer < 4; ++layer) {
    const int i = layer >> 1; const bool odd = layer & 1;
#ifndef SKIP_ROW
    rowwise_phase(p, lds, layer - 1, layer);
#endif
    xcd_barrier(xb);
    {
#ifndef SKIP_SCAN
      if (odd) { for (int bh = bid; bh < 128; bh += G) fox_scan(p, lds, bh); }
#endif
      pg8::Gemm g; g.A = (const bf16_t*)(ws + WS_HBUF); g.lda = 1024; g.K = 1024; g.M = T;
      Epi e; e.out = (bf16_t*)(ws + WS_ZBUF); e.pin = nullptr; e.pslot = 0; e.nK = 0; e.qmode = 0; e.pout = odd ? nullptr : (float*)(ws + WS_PART); e.cosH = cosH; e.sinH = sinH; e.cosR = cosR; e.sinR = sinR;
      if (!odd) { g.Bt = (const bf16_t*)(ws + WS_WEVIN + i * SZ_WEVIN); g.N = 2560; e.ldc = 2560; e.rope64_end = 640; e.rope32_lo = 2432; e.rope32_hi = 2464; }
      else { g.Bt = (const bf16_t*)(ws + WS_WODIN + i * SZ_WODIN); g.N = 4096; e.ldc = 4096; e.rope64_end = 1024; e.rope32_lo = 0; e.rope32_hi = 0; }
      pg8::StaticOrder S; S.init(g.M, g.N, G, bid);
#ifndef SKIP_G1
      pg8::gemm_phase<Epi>(lds, g, S, e);
#endif
    }
    xcd_barrier(xb);
    if (!odd) {
      for (int which = 0; which < 2; ++which) {
        pg8::Gemm g; g.M = T; g.lda = 2560;
        Epi e; e.rope64_end = 0; e.rope32_lo = 0; e.rope32_hi = 0; e.cosH = cosH; e.sinH = sinH; e.cosR = cosR; e.sinR = sinR; e.pout = nullptr; e.pin = (const float*)(ws + WS_PART);
        if (which == 0) { g.A = (const bf16_t*)(ws + WS_ZBUF) + 1792; g.Bt = (const bf16_t*)(ws + WS_WUQ + i * SZ_WUQ); g.N = 768; g.K = 384;
          e.out = (bf16_t*)(ws + WS_QBUF); e.ldc = 768; e.qmode = 1; e.pslot = 0; e.nK = 384; }
        else { g.A = (const bf16_t*)(ws + WS_ZBUF) + 2176; g.Bt = (const bf16_t*)(ws + WS_WUKV + i * SZ_WUKV); g.N = 1024; g.K = 256;
          e.out = (bf16_t*)(ws + WS_HBUF); e.ldc = 1024; e.qmode = 0; e.pslot = 12; e.nK = 256; }
        pg8::StaticOrder S; S.init(g.M, g.N, G, bid);
#ifndef SKIP_G2
        pg8::gemm_phase<Epi>(lds, g, S, e);
#endif
      }
      xcd_barrier(xb);
#ifndef SKIP_ATTE
      attn_even(p, lds, i);
#endif
      xcd_barrier(xb);
    } else {
#ifndef SKIP_ATTO
      attn_odd(p, lds, layer);
#endif
      xcd_barrier(xb);
    }
    {
      pg8::Gemm g; g.A = (const bf16_t*)(ws + WS_OBUF); g.lda = 1024; g.K = 1024; g.M = T; g.N = 1024;
      g.Bt = (const bf16_t*)(ws + (odd ? WS_WODOUT : WS_WEVOUT) + i * SZ_WOUT);
      Epi e; e.out = (bf16_t*)(ws + WS_HBUF); e.ldc = 1024; e.pin = nullptr; e.pslot = 0; e.pout = nullptr; e.nK = 0; e.qmode = 0; e.rope64_end = 0; e.rope32_lo = 0; e.rope32_hi = 0;
      e.cosH = cosH; e.sinH = sinH; e.cosR = cosR; e.sinR = sinR;
      pg8::StaticOrder S; S.init(g.M, g.N, G, bid);
#ifndef SKIP_G3
      pg8::gemm_phase<Epi>(lds, g, S, e);
#endif
    }
    xcd_barrier(xb);
  }
#ifndef SKIP_ROW
  rowwise_phase(p, lds, 3, 4);
#endif
}

constexpr int LDS_BYTES = 155648;
static_assert(LDS_BYTES == LDS_BYTES_C, "LDS size mismatch");

extern "C" void kernel_launch(void* const* d_in, const int* in_sizes, int n_in, void* d_out, int out_size, void* d_ws, size_t ws_size, hipStream_t stream) {
  static int grid_blocks = 0;
  if (grid_blocks == 0) {
    int dev = 0, cus = 0, per_cu = 0;
    if (hipGetDevice(&dev) != hipSuccess || hipDeviceGetAttribute(&cus, hipDeviceAttributeMultiprocessorCount, dev) != hipSuccess) { fprintf(stderr, "device query failed\n"); grid_blocks = -1; return; }
    if (hipFuncSetAttribute((const void*)fwd_megakernel, hipFuncAttributeMaxDynamicSharedMemorySize, LDS_BYTES) != hipSuccess) { fprintf(stderr, "hipFuncSetAttribute failed\n"); grid_blocks = -1; return; }
    if (hipOccupancyMaxActiveBlocksPerMultiprocessor(&per_cu, (const void*)fwd_megakernel, 512, LDS_BYTES) != hipSuccess || per_cu < 1) { fprintf(stderr, "occupancy query: %d\n", per_cu); per_cu = 1; }
    (void)hipGetLastError();
    grid_blocks = cus;
    if (ws_size < WS_END) { fprintf(stderr, "workspace too small: %zu < %zu\n", ws_size, (size_t)WS_END); grid_blocks = -1; return; }
  }
  if (grid_blocks < 0) return;
  Params p{};
  const float** fp = (const float**)&p;
  for (int i = 0; i < 18; ++i) fp[i] = (const float*)d_in[i];
  p.out = (float*)d_out; p.ws = (unsigned char*)d_ws;
  void* args[] = {&p};
  hipError_t e = hipLaunchCooperativeKernel((const void*)fwd_megakernel, dim3(grid_blocks), dim3(512), args, LDS_BYTES, stream);
  if (e != hipSuccess) fprintf(stderr, "cooperative launch failed: %s (grid %d)\n", hipGetErrorString(e), grid_blocks);
}
```

```cpp
#include <hip/hip_runtime.h>
#include <hip/hip_cooperative_groups.h>
#include <cstdio>
#include <type_traits>
namespace cg = cooperative_groups;

#define DI __device__ __forceinline__
#define LAS __attribute__((address_space(3)))
typedef unsigned short bf16_t;
typedef short bf16x8 __attribute__((ext_vector_type(8)));
typedef short s16x4 __attribute__((ext_vector_type(4)));
typedef float f32x2 __attribute__((ext_vector_type(2)));
typedef float f32x4 __attribute__((ext_vector_type(4)));
typedef float f32x16 __attribute__((ext_vector_type(16)));
typedef unsigned u32x2 __attribute__((ext_vector_type(2)));
typedef unsigned u32x4 __attribute__((ext_vector_type(4)));
typedef __bf16 bf16x2_t __attribute__((ext_vector_type(2)));

constexpr int T = 32768, DM = 1024, NB = 16, SEQ = 2048;
constexpr float LOG2E = 1.4426950408889634f;
constexpr float EPS = 1e-6f;
constexpr int LDS_BYTES_C = 155648;

constexpr size_t SZ_WEVIN = 2560ull * 1024 * 2, SZ_WODIN = 4096ull * 1024 * 2, SZ_WUQ = 768ull * 384 * 2, SZ_WUKV = 1024ull * 256 * 2, SZ_WOUT = 1024ull * 1024 * 2;
constexpr size_t WS_WEVIN = 0;
constexpr size_t WS_WODIN = WS_WEVIN + 2 * SZ_WEVIN;
constexpr size_t WS_WUQ = WS_WODIN + 2 * SZ_WODIN;
constexpr size_t WS_WUKV = WS_WUQ + 2 * SZ_WUQ;
constexpr size_t WS_WEVOUT = WS_WUKV + 2 * SZ_WUKV;
constexpr size_t WS_WODOUT = WS_WEVOUT + 2 * SZ_WOUT;
constexpr size_t WS_MOD = WS_WODOUT + 2 * SZ_WOUT;
constexpr size_t WS_COSH = WS_MOD + 4ull * 16 * 3072 * 4;
constexpr size_t WS_SINH = WS_COSH + 2048ull * 32 * 4;
constexpr size_t WS_COSR = WS_SINH + 2048ull * 32 * 4;
constexpr size_t WS_SINR = WS_COSR + 2048ull * 16 * 4;
constexpr size_t WS_LOGF = WS_SINR + 2048ull * 16 * 4;
constexpr size_t WS_FCUM = WS_LOGF + (size_t)T * 8 * 4;
constexpr size_t WS_HBUF = (WS_FCUM + (size_t)T * 8 * 4 + 4095) & ~(size_t)4095;
constexpr size_t WS_OBUF = WS_HBUF + (size_t)T * 1024 * 2;
constexpr size_t WS_ZBUF = WS_OBUF + (size_t)T * 1024 * 2;
constexpr size_t WS_QBUF = WS_ZBUF + (size_t)T * 2560 * 2;
constexpr size_t WS_BAR = WS_ZBUF + (size_t)T * 4096 * 2;
constexpr size_t WS_PART = WS_BAR + 256;
constexpr size_t WS_XBAR = (WS_PART + (size_t)T * 20 * 4 + 4095) & ~(size_t)4095;
constexpr size_t WS_XBF_PRE = WS_XBAR + 16384;
constexpr size_t WS_XBF = WS_XBF_PRE;
constexpr size_t WS_END = WS_XBF + (size_t)T * 1024 * 2;

struct Params {
  const float *x, *c, *w_ada, *b_ada, *g_pre, *g_post, *ev_w_in, *ev_q_norm, *ev_kv_norm, *ev_w_uq, *ev_w_ukv, *ev_sinks, *ev_w_out,
      *od_w_in, *od_forget_bias, *od_lambda, *od_subln, *od_w_out;
  float* out;
  unsigned char* ws;
};

DI int opaque_tid() { int t = threadIdx.x; asm volatile("" : "+v"(t)); return t; }
DI float bflo(unsigned u) { return __uint_as_float(u << 16); }
DI float bfhi(unsigned u) { return __uint_as_float(u & 0xffff0000u); }
DI unsigned pk2(float lo, float hi) { f32x2 f = {lo, hi}; bf16x2_t b = __builtin_convertvector(f, bf16x2_t); return __builtin_bit_cast(unsigned, b); }
DI bf16_t f2bf(float f) { return (bf16_t)(pk2(f, 0.f) & 0xffffu); }
DI float fast_exp2(float x) { return __builtin_amdgcn_exp2f(x); }
DI float silu_f(float x) { return x * __builtin_amdgcn_rcpf(1.f + fast_exp2(-x * LOG2E)); }
template <int CTRL> DI float dpp_mov(float v) { return __builtin_bit_cast(float, __builtin_amdgcn_update_dpp(0, __builtin_bit_cast(int, v), CTRL, 0xf, 0xf, false)); }
DI float wave_sum(float v) {
  v += dpp_mov<0xB1>(v);
  v += dpp_mov<0x4E>(v);
  v += dpp_mov<0x141>(v);
  v += dpp_mov<0x140>(v);
  { const unsigned u = __float_as_uint(v); auto r = __builtin_amdgcn_permlane16_swap(u, u, false, false); v = __uint_as_float(r[0]) + __uint_as_float(r[1]); }
  { const unsigned u = __float_as_uint(v); auto r = __builtin_amdgcn_permlane32_swap(u, u, false, false); v = __uint_as_float(r[0]) + __uint_as_float(r[1]); }
  return v;
}

namespace pg8 {
constexpr int BM = 256, BK = 64, HALF = 128, HTB = HALF * BK * 2, STAGE_BYTES = 8 * HTB, NXCD = 8, WGM = 8;
DI int lds_byte(int r, int c) { const int st = (r >> 4) * 2 + (c >> 5), rr = r & 15, cc = c & 31, ob = rr * 64 + cc * 2; return st * 1024 + (ob ^ (((ob >> 9) & 1) << 5)); }
DI void stage_rc(int b, int& R, int& C) { const int st = b / 1024, sb = b % 1024, swz = sb ^ (((sb >> 9) & 1) << 5); R = (st >> 1) * 16 + swz / 64; C = (st & 1) * 32 + (swz % 64) / 2; }
DI int perm32(int rho) { const int n = rho >> 4, i = rho & 15; return 8 * (i >> 2) + 4 * n + (i & 3); }
struct Unit { int pm, pn; };
struct Gemm { const bf16_t* A; const bf16_t* Bt; int M, N, K, lda; };
struct StaticOrder {
  int nM, nN, nwg, G, c;
  DI void init(int M, int N, int G_, int c_) { nM = M / BM; nN = N / BM; nwg = nM * nN; G = G_; c = c_; }
  DI bool next(int i, Unit& u) const {
    const long L = (long)i * G + c; if (L >= nwg) return false;
    int wgid = (int)L; { const int q = nwg / NXCD, r = nwg % NXCD, xcd = wgid % NXCD, off = wgid / NXCD; wgid = (xcd < r ? xcd * (q + 1) : r * (q + 1) + (xcd - r) * q) + off; }
    const int nig = WGM * nN, gid = wgid / nig, fm = gid * WGM, gsz = (nM - fm) < WGM ? (nM - fm) : WGM;
    u.pm = fm + ((wgid % nig) % gsz); u.pn = (wgid % nig) / gsz; return true;
  }
};

template <class Epi>
DI void gemm_phase(LAS unsigned char* lds, const Gemm g, const StaticOrder& S, const Epi& E) {
  const int tid = opaque_tid(), wid = __builtin_amdgcn_readfirstlane(tid >> 6), lane = tid & 63, wr = wid >> 2, wc = wid & 3, fr = lane & 15, fq = lane >> 4;
  const int K = g.K, nt = K / BK, lda = g.lda;
  unsigned voffA[2], voffB[2];
#pragma unroll
  for (int i = 0; i < 2; ++i) { int R, C; stage_rc(tid * 16 + i * 8192, R, C); const int Rb = (R & ~31) + perm32(R & 31);
    voffA[i] = (unsigned)(R * lda + C) * 2u; voffB[i] = (unsigned)(Rb * K + C) * 2u; }
  const size_t kstep = (size_t)(BK * 2);
  const size_t hstepA = (size_t)HALF * lda * 2, hstepB = (size_t)HALF * K * 2;
  const size_t tstepA = 2 * hstepA, tstepB = 2 * hstepB;
  const unsigned ldsw = (unsigned)wid * 1024u;
  const int aoff = lds_byte(wr * 64 + fr, fq * 8), boff = lds_byte(wc * 32 + fr, fq * 8);
#define PG8_SA(b, h) (((b) * 2 + (h)) * HTB)
#define PG8_SB(b, h) ((4 + (b) * 2 + (h)) * HTB)
#define PG8_STAGE(bufoff, gbase, voff) do { _Pragma("unroll") for (int _i = 0; _i < 2; ++_i) \
    __builtin_amdgcn_global_load_lds((const unsigned*)((const char*)(gbase) + (voff)[_i]), (LAS unsigned*)(lds + (bufoff) + ldsw + _i * 8192), 16, 0, 0); } while (0)
#define PG8_LDA(dst, b, h) do { _Pragma("unroll") for (int m = 0; m < 4; ++m) _Pragma("unroll") for (int k = 0; k < 2; ++k) dst[m][k] = *(const LAS bf16x8*)(lds + PG8_SA(b, h) + aoff + m * 2048 + k * 1024); } while (0)
#define PG8_LDB(dst, b, h) do { _Pragma("unroll") for (int n = 0; n < 2; ++n) _Pragma("unroll") for (int k = 0; k < 2; ++k) dst[n][k] = *(const LAS bf16x8*)(lds + PG8_SB(b, h) + boff + n * 2048 + k * 1024); } while (0)
#define PG8_MMA(ai, bj, At, Bt) do { __builtin_amdgcn_s_setprio(1); _Pragma("unroll") for (int m = 0; m < 4; ++m) _Pragma("unroll") for (int n = 0; n < 2; ++n) _Pragma("unroll") for (int k = 0; k < 2; ++k) \
    acc[ai][bj][m][n] = __builtin_amdgcn_mfma_f32_16x16x32_bf16(Bt[n][k], At[m][k], acc[ai][bj][m][n], 0, 0, 0); __builtin_amdgcn_s_setprio(0); } while (0)
#define PG8_WAIT_V(n) asm volatile("s_waitcnt vmcnt(" #n ")" ::: "memory")
#define PG8_WAIT_L(n) asm volatile("s_waitcnt lgkmcnt(" #n ")" ::: "memory")
#define PG8_BAR __builtin_amdgcn_s_barrier()
#define PG8_SCHED __builtin_amdgcn_sched_barrier(0)
  Unit cur, nxt; int ui = 0;
  if (!S.next(0, cur)) return;
  f32x4 acc[2][2][4][2];
#pragma unroll
  for (int a = 0; a < 2; ++a)
#pragma unroll
    for (int b = 0; b < 2; ++b)
#pragma unroll
      for (int m = 0; m < 4; ++m)
#pragma unroll
        for (int n = 0; n < 2; ++n) acc[a][b][m][n] = (f32x4){0.f, 0.f, 0.f, 0.f};
  bf16x8 At[4][2], B0[2][2], B1[2][2];
  const char* cA = (const char*)g.A + (size_t)cur.pm * tstepA; const char* cB = (const char*)g.Bt + (size_t)cur.pn * tstepB;
  PG8_STAGE(PG8_SB(0, 0), cB, voffB); PG8_STAGE(PG8_SA(0, 0), cA, voffA); PG8_STAGE(PG8_SB(0, 1), cB + hstepB, voffB); PG8_STAGE(PG8_SA(0, 1), cA + hstepA, voffA);
  if (wr == 1) PG8_BAR;
  PG8_WAIT_V(4); PG8_BAR;
  PG8_STAGE(PG8_SB(1, 0), cB + kstep, voffB); PG8_STAGE(PG8_SA(1, 0), cA + kstep, voffA); PG8_STAGE(PG8_SB(1, 1), cB + hstepB + kstep, voffB);
  PG8_WAIT_V(6); PG8_BAR;
  for (;;) {
    const bool has_next = S.next(ui + 1, nxt);
    const char* nA = has_next ? (const char*)g.A + (size_t)nxt.pm * tstepA : cA; const char* nB = has_next ? (const char*)g.Bt + (size_t)nxt.pn * tstepB : cB;
    for (int t = 0; t < nt; t += 2) {
      const bool last = (t == nt - 2);
      const char* a1 = cA + (size_t)(t + 1) * kstep;
      const char* a2 = last ? nA : cA + (size_t)(t + 2) * kstep; const char* b2 = last ? nB : cB + (size_t)(t + 2) * kstep;
      const char* a3 = a2 + kstep; const char* b3 = b2 + kstep;
      PG8_LDB(B0, 0, 0); PG8_SCHED; PG8_LDA(At, 0, 0); PG8_STAGE(PG8_SA(1, 1), a1 + hstepA, voffA);
      PG8_WAIT_L(8); PG8_BAR; PG8_WAIT_L(0); PG8_MMA(0, 0, At, B0); PG8_BAR; PG8_SCHED;
      PG8_LDB(B1, 0, 1); PG8_STAGE(PG8_SB(0, 0), b2, voffB);
      PG8_BAR; PG8_WAIT_L(0); PG8_MMA(0, 1, At, B1); PG8_BAR;
      PG8_LDA(At, 0, 1); PG8_STAGE(PG8_SA(0, 0), a2, voffA);
      PG8_BAR; PG8_WAIT_L(0); PG8_MMA(1, 0, At, B0); PG8_BAR; PG8_SCHED;
      PG8_STAGE(PG8_SB(0, 1), b2 + hstepB, voffB);
      PG8_WAIT_V(6); PG8_BAR; PG8_MMA(1, 1, At, B1); PG8_BAR;
      PG8_LDB(B0, 1, 0); PG8_SCHED; PG8_LDA(At, 1, 0); PG8_STAGE(PG8_SA(0, 1), a2 + hstepA, voffA);
      PG8_WAIT_L(8); PG8_BAR; PG8_WAIT_L(0); PG8_MMA(0, 0, At, B0); PG8_BAR; PG8_SCHED;
      PG8_LDB(B1, 1, 1); PG8_STAGE(PG8_SB(1, 0), b3, voffB);
      PG8_BAR; PG8_WAIT_L(0); PG8_MMA(0, 1, At, B1); PG8_BAR;
      PG8_LDA(At, 1, 1); PG8_STAGE(PG8_SA(1, 0), a3, voffA);
      PG8_BAR; PG8_WAIT_L(0); PG8_MMA(1, 0, At, B0); PG8_BAR; PG8_SCHED;
      PG8_STAGE(PG8_SB(1, 1), b3 + hstepB, voffB);
      PG8_WAIT_V(6); PG8_BAR; PG8_MMA(1, 1, At, B1); PG8_BAR;
    }
    E(acc, cur, wr, wc, fr, fq);
    if (!has_next) break;
#pragma unroll
    for (int a = 0; a < 2; ++a)
#pragma unroll
      for (int b = 0; b < 2; ++b)
#pragma unroll
        for (int m = 0; m < 4; ++m)
#pragma unroll
          for (int n = 0; n < 2; ++n) acc[a][b][m][n] = (f32x4){0.f, 0.f, 0.f, 0.f};
    cur = nxt; cA = nA; cB = nB; ++ui;
  }
  PG8_WAIT_V(0);
  if (wr == 0) PG8_BAR;
  PG8_BAR;
#undef PG8_SA
#undef PG8_SB
#undef PG8_STAGE
#undef PG8_LDA
#undef PG8_LDB
#undef PG8_MMA
#undef PG8_WAIT_V
#undef PG8_WAIT_L
#undef PG8_BAR
#undef PG8_SCHED
}
}

struct Epi {
  bf16_t* out; int ldc;
  int rope64_end;
  int rope32_lo, rope32_hi;
  int qmode;
  const float* pin; int nK;
  int pslot;
  float* pout;
  const float *cosH, *sinH, *cosR, *sinR;
  DI void operator()(const f32x4 (&acc)[2][2][4][2], const pg8::Unit& u, int wr, int wc, int fr, int fq) const {
    const int row0 = u.pm * 256 + wr * 64 + fr;
    int rt[2];
#pragma unroll
    for (int bj = 0; bj < 2; ++bj) {
      const int cw = u.pn * 256 + bj * 128 + wc * 32;
      rt[bj] = 0;
      if (cw < rope64_end) rt[bj] = 1;
      else if (cw >= rope32_lo && cw < rope32_hi) rt[bj] = 2;
      else if (qmode && ((cw >> 5) % 3) == 2) rt[bj] = 2;
    }
    const int tt = rt[0] | rt[1];
    const float* ctab = (tt == 1) ? cosH + (16 * (wc & 1) + 4 * fq) : cosR + 4 * fq;
    const float* stab = (tt == 1) ? sinH + (16 * (wc & 1) + 4 * fq) : sinR + 4 * fq;
    const int tstride = (tt == 1) ? 32 : 16;
    int ps[2] = {-1, -1};
    if (pout) {
#pragma unroll
      for (int bj = 0; bj < 2; ++bj) { const int cw = u.pn * 256 + bj * 128 + wc * 32;
        if (cw >= 1792 && cw < 2432) ps[bj] = ((cw - 1792) >> 7) * 4 + wc; }
    }
#pragma unroll
    for (int ai = 0; ai < 2; ++ai) {
      f32x4 cv[4], sv[4]; float rs[4];
#pragma unroll
      for (int m = 0; m < 4; ++m) {
        const int row = row0 + ai * 128 + m * 16;
        if (tt) { const int pos = row & (SEQ - 1); cv[m] = *(const f32x4*)(ctab + pos * tstride); sv[m] = *(const f32x4*)(stab + pos * tstride); }
        rs[m] = 1.f;
        if (pin) { const f32x4 p0 = *(const f32x4*)(pin + (size_t)row * 20 + pslot), p1 = *(const f32x4*)(pin + (size_t)row * 20 + pslot + 4);
          float ss = ((p0[0] + p0[1]) + (p0[2] + p0[3])) + ((p1[0] + p1[1]) + (p1[2] + p1[3]));
          if (nK == 384) { const f32x4 p2 = *(const f32x4*)(pin + (size_t)row * 20 + pslot + 8); ss += (p2[0] + p2[1]) + (p2[2] + p2[3]); }
          rs[m] = rsqrtf(ss / (float)nK + EPS); }
      }
#pragma unroll
      for (int m = 0; m < 4; ++m) {
        const int row = row0 + ai * 128 + m * 16;
#pragma unroll
        for (int bj = 0; bj < 2; ++bj) {
          const int c0 = u.pn * 256 + bj * 128 + wc * 32 + 8 * fq;
          f32x4 v0 = acc[ai][bj][m][0] * rs[m], v1 = acc[ai][bj][m][1] * rs[m];
          if (ps[bj] >= 0) {
            float sq = (v0[0] * v0[0] + v0[1] * v0[1]) + (v0[2] * v0[2] + v0[3] * v0[3]) + (v1[0] * v1[0] + v1[1] * v1[1]) + (v1[2] * v1[2] + v1[3] * v1[3]);
            { const unsigned uq = __float_as_uint(sq); auto r16 = __builtin_amdgcn_permlane16_swap(uq, uq, false, false); sq = __uint_as_float(r16[0]) + __uint_as_float(r16[1]); }
            { const unsigned uq = __float_as_uint(sq); auto r32 = __builtin_amdgcn_permlane32_swap(uq, uq, false, false); sq = __uint_as_float(r32[0]) + __uint_as_float(r32[1]); }
            if (fq == 0) pout[(size_t)row * 20 + ps[bj]] = sq;
          }
          if (rt[bj]) {
            const f32x4 o1 = v0 * cv[m] - v1 * sv[m], o2 = v1 * cv[m] + v0 * sv[m];
            v0 = o1; v1 = o2;
          }
          u32x4 w; w.x = pk2(v0[0], v0[1]); w.y = pk2(v0[2], v0[3]); w.z = pk2(v1[0], v1[1]); w.w = pk2(v1[2], v1[3]);
          *(u32x4*)(out + (size_t)row * ldc + c0) = w;
        }
      }
    }
  }
};

DI int ropeperm64(int p) { const int g = p >> 3, r = p & 7; return r < 4 ? 4 * g + r : 32 + 4 * g + (r - 4); }
DI int ropeperm32(int p) { const int g = p >> 3, r = p & 7; return r < 4 ? 4 * g + r : 16 + 4 * g + (r - 4); }
DI int srccol(int kind, int n) {
  if (kind == 0) {
    if (n < 512) return 672 + (n & ~63) + ropeperm64(n & 63);
    if (n < 640) return 1184 + ((n - 512) & ~63) + ropeperm64(n & 63);
    if (n < 768) return 1312 + (n - 640);
    if (n < 1792) return 1440 + (n - 768);
    if (n < 2176) return n - 1792;
    if (n < 2432) return 384 + (n - 2176);
    if (n < 2464) return 640 + ropeperm32(n - 2432);
    return -1;
  }
  if (kind == 1) {
    if (n < 1024) return (n & ~63) + ropeperm64(n & 63);
    if (n < 3072) return n;
    return 3080 + (n - 3072);
  }
  if (kind == 2) { const int hd = n / 96, p = n - hd * 96; return hd * 96 + (p < 64 ? p : 64 + ropeperm32(p - 64)); }
  return n;
}
struct ConvJob { const float* W; const float* g; bf16_t* Wt; int Nsrc, K, kind, tn, tk; };
DI bool conv_decode(const Params& p, int job, ConvJob& j) {
  constexpr int NT0 = 40 * 16, NT1 = 64 * 16, NT2 = 12 * 6, NT3 = 16 * 4, NT4 = 16 * 16;
  constexpr int PER_I = NT0 + NT1 + NT2 + NT3 + 2 * NT4;
  if (job >= 2 * PER_I) return false;
  unsigned char* ws = p.ws;
  const int i = job / PER_I; int t = job - i * PER_I;
  j.g = nullptr;
  if (t < NT0) { j.W = p.ev_w_in + (size_t)i * 1024 * 2464; j.Nsrc = 2464; j.K = 1024; j.Wt = (bf16_t*)(ws + WS_WEVIN + i * SZ_WEVIN); j.kind = 0; j.tn = t / 16; j.tk = t % 16; return true; }
  t -= NT0;
  if (t < NT1) { j.W = p.od_w_in + (size_t)i * 1024 * 4104; j.Nsrc = 4104; j.K = 1024; j.Wt = (bf16_t*)(ws + WS_WODIN + i * SZ_WODIN); j.kind = 1; j.tn = t / 16; j.tk = t % 16; return true; }
  t -= NT1;
  if (t < NT2) { j.W = p.ev_w_uq + (size_t)i * 384 * 768; j.Nsrc = 768; j.K = 384; j.Wt = (bf16_t*)(ws + WS_WUQ + i * SZ_WUQ); j.kind = 2; j.g = p.ev_q_norm + i * 384; j.tn = t / 6; j.tk = t % 6; return true; }
  t -= NT2;
  if (t < NT3) { j.W = p.ev_w_ukv + (size_t)i * 256 * 1024; j.Nsrc = 1024; j.K = 256; j.Wt = (bf16_t*)(ws + WS_WUKV + i * SZ_WUKV); j.kind = 3; j.g = p.ev_kv_norm + i * 256; j.tn = t / 4; j.tk = t % 4; return true; }
  t -= NT3;
  if (t < NT4) { j.W = p.ev_w_out + (size_t)i * 1024 * 1024; j.Nsrc = 1024; j.K = 1024; j.Wt = (bf16_t*)(ws + WS_WEVOUT + i * SZ_WOUT); j.kind = 4; j.tn = t / 16; j.tk = t % 16; return true; }
  t -= NT4;
  j.W = p.od_w_out + (size_t)i * 1024 * 1024; j.Nsrc = 1024; j.K = 1024; j.Wt = (bf16_t*)(ws + WS_WODOUT + i * SZ_WOUT); j.kind = 4; j.tn = t / 16; j.tk = t % 16; return true;
}
template <int NJ>
DI void convert_tiles(const Params& p, LAS unsigned char* lds, int job0, int jstride) {
  const int tid = opaque_tid();
  const int n4 = (tid & 15) * 4, kq = tid >> 4;
  ConvJob j[NJ] = {}; bool ok[NJ]; f32x4 v[NJ][2];
#pragma unroll
  for (int q = 0; q < NJ; ++q) {
    ok[q] = conv_decode(p, job0 + q * jstride, j[q]);
    const int sc = ok[q] ? srccol(j[q].kind, j[q].tn * 64 + n4) : -1;
#pragma unroll
    for (int e = 0; e < 2; ++e) {
      const int k = j[q].tk * 64 + kq + 32 * e;
      v[q][e] = (f32x4){0.f, 0.f, 0.f, 0.f};
      if (sc >= 0) { v[q][e] = *(const f32x4*)(j[q].W + (size_t)k * j[q].Nsrc + sc); if (j[q].g) v[q][e] = v[q][e] * j[q].g[k]; }
    }
  }
#pragma unroll
  for (int q = 0; q < NJ; ++q) {
    LAS bf16_t* tile = (LAS bf16_t*)(lds + q * 9216);
#pragma unroll
    for (int e = 0; e < 2; ++e)
#pragma unroll
      for (int i = 0; i < 4; ++i) tile[(n4 + i) * 72 + kq + 32 * e] = f2bf(v[q][e][i]);
  }
  __syncthreads();
#pragma unroll
  for (int q = 0; q < NJ; ++q) {
    if (ok[q]) {
      LAS bf16_t* tile = (LAS bf16_t*)(lds + q * 9216);
      const int n2 = tid >> 3, ch = tid & 7;
      const u32x4 w = *(const LAS u32x4*)(tile + n2 * 72 + ch * 8);
      *(u32x4*)(j[q].Wt + (size_t)(j[q].tn * 64 + n2) * j[q].K + j[q].tk * 64 + ch * 8) = w;
    }
  }
  __syncthreads();
}

DI void prologue(const Params& p, LAS unsigned char* lds) {
  const int tid = opaque_tid(), G = gridDim.x, bid = blockIdx.x;
  unsigned char* ws = p.ws;
  for (int idx = bid * 512 + tid; idx < 2048 * 48; idx += G * 512) {
    const bool isH = idx < 2048 * 32;
    const int j = isH ? idx : idx - 2048 * 32;
    const int pos = isH ? (j >> 5) : (j >> 4), i = isH ? (j & 31) : (j & 15);
    const float e = isH ? (float)(2 * i) * (1.f / 64.f) : (float)(2 * i) * (1.f / 32.f);
    const float inv = fast_exp2(-e * 13.287712379549449f);
    const float ang = (float)pos * inv;
    double t = (double)ang * 0.15915494309189535; t -= rint(t);
    const float fr = (float)t;
    const float cv = __builtin_amdgcn_cosf(fr), sv = __builtin_amdgcn_sinf(fr);
    if (isH) { ((float*)(ws + WS_COSH))[j] = cv; ((float*)(ws + WS_SINH))[j] = sv; }
    else { ((float*)(ws + WS_COSR))[j] = cv; ((float*)(ws + WS_SINR))[j] = sv; }
  }
  for (int job = bid; job < 4624; job += 4 * G) convert_tiles<4>(p, lds, job, G);
  const int item0 = G - 1 - bid;
  if (item0 < 192) {
    LAS float* cond = (LAS float*)lds;
    LAS float* red = (LAS float*)(lds + 65536);
    for (int e = tid; e < 16 * 1024; e += 512) { const int b = e >> 10, k = e & 1023; cond[k * 16 + b] = silu_f(p.c[e]); }
    __syncthreads();
    for (int item = item0; item < 192; item += G) {
      const int l = item / 48, n0 = (item % 48) * 64;
      const int col = tid & 63, kg = tid >> 6;
      float a[16];
#pragma unroll
      for (int b = 0; b < 16; ++b) a[b] = 0.f;
      const float* wp = p.w_ada + (size_t)l * 1024 * 3072 + n0 + col;
      for (int k0 = kg * 128; k0 < kg * 128 + 128; k0 += 16) {
        float wv[16];
#pragma unroll
        for (int e = 0; e < 16; ++e) wv[e] = wp[(size_t)(k0 + e) * 3072];
#pragma unroll
        for (int e = 0; e < 16; ++e) {
          const float w = wv[e]; const int k = k0 + e;
#pragma unroll
          for (int b4 = 0; b4 < 4; ++b4) { const f32x4 cv = *(const LAS f32x4*)(cond + k * 16 + b4 * 4);
            a[b4 * 4 + 0] += cv[0] * w; a[b4 * 4 + 1] += cv[1] * w; a[b4 * 4 + 2] += cv[2] * w; a[b4 * 4 + 3] += cv[3] * w; }
        }
      }
#pragma unroll
      for (int b = 0; b < 16; ++b) red[(kg * 16 + b) * 64 + col] = a[b];
      __syncthreads();
      for (int e = tid; e < 1024; e += 512) { const int b = e >> 6, cc = e & 63; float s = 0.f;
#pragma unroll
        for (int k8 = 0; k8 < 8; ++k8) s += red[(k8 * 16 + b) * 64 + cc];
        ((float*)(ws + WS_MOD))[((size_t)l * 16 + b) * 3072 + n0 + cc] = s + p.b_ada[l * 3072 + n0 + cc]; }
      __syncthreads();
    }
  }
}

DI void rowwise_phase(const Params& p, LAS unsigned char* lds, int lp, int ln) {
  const int tid = opaque_tid(), lane = tid & 63, wid = tid >> 6;
  const int gw = blockIdx.x * 8 + wid, nw = gridDim.x * 8;
  unsigned char* ws = p.ws;
  const float* mod = (const float*)(ws + WS_MOD);
  const bf16_t* ybuf = (const bf16_t*)(ws + WS_HBUF);
  bf16_t* hbuf = (bf16_t*)(ws + WS_HBUF);
  const bool ff = (ln < 4) && (ln & 1);
  LAS f32x4* wl = (LAS f32x4*)lds;
  if (ff) {
    const float* w = p.od_w_in + (size_t)(ln >> 1) * 1024 * 4104 + 3072;
    for (int c = tid; c < 1024; c += 512) {
      const f32x4 w0 = *(const f32x4*)(w + (size_t)c * 4104), w1 = *(const f32x4*)(w + (size_t)c * 4104 + 4);
      const int ln_ = (c & 511) >> 3, e = c & 7, j = c >> 9;
      wl[(j * 8 + e) * 64 + ln_] = w0; wl[1024 + (j * 8 + e) * 64 + ln_] = w1;
    }
    __syncthreads();
  }
  const int RPW = (T + nw - 1) / nw;
  float gpo[2][8], gpr[2][8], mgt[2][8], msh[2][8], msc[2][8];
#pragma unroll
  for (int j = 0; j < 2; ++j)
#pragma unroll
    for (int e = 0; e < 8; ++e) { gpo[j][e] = 0.f; gpr[j][e] = 0.f; mgt[j][e] = 0.f; msh[j][e] = 0.f; msc[j][e] = 0.f; }
#pragma unroll
  for (int j = 0; j < 2; ++j)
#pragma unroll
    for (int q = 0; q < 2; ++q) {
      const int c = 8 * lane + 512 * j + 4 * q;
      if (lp >= 0) { const f32x4 t = *(const f32x4*)(p.g_post + lp * DM + c); gpo[j][4 * q] = t[0]; gpo[j][4 * q + 1] = t[1]; gpo[j][4 * q + 2] = t[2]; gpo[j][4 * q + 3] = t[3]; }
      if (ln < 4) { const f32x4 t = *(const f32x4*)(p.g_pre + ln * DM + c); gpr[j][4 * q] = t[0]; gpr[j][4 * q + 1] = t[1]; gpr[j][4 * q + 2] = t[2]; gpr[j][4 * q + 3] = t[3]; }
    }
  int bcur = -1;
  for (int rr = 0; rr < RPW; ++rr) {
    const int row = gw * RPW + rr;
    if (row >= T) break;
    const int b = row >> 11;
    if (b != bcur) {
      bcur = b;
#pragma unroll
      for (int j = 0; j < 2; ++j)
#pragma unroll
        for (int q = 0; q < 2; ++q) {
          const int c = 8 * lane + 512 * j + 4 * q;
          if (lp >= 0) { const f32x4 t = *(const f32x4*)(mod + ((size_t)lp * 16 + b) * 3072 + 2048 + c); mgt[j][4 * q] = t[0]; mgt[j][4 * q + 1] = t[1]; mgt[j][4 * q + 2] = t[2]; mgt[j][4 * q + 3] = t[3]; }
          if (ln < 4) {
            const f32x4 t = *(const f32x4*)(mod + ((size_t)ln * 16 + b) * 3072 + c); msh[j][4 * q] = t[0]; msh[j][4 * q + 1] = t[1]; msh[j][4 * q + 2] = t[2]; msh[j][4 * q + 3] = t[3];
            const f32x4 u = *(const f32x4*)(mod + ((size_t)ln * 16 + b) * 3072 + 1024 + c); msc[j][4 * q] = u[0] + 1.f; msc[j][4 * q + 1] = u[1] + 1.f; msc[j][4 * q + 2] = u[2] + 1.f; msc[j][4 * q + 3] = u[3] + 1.f;
          }
        }
    }
    float xv[2][8];
    bf16_t* xbf = (bf16_t*)(ws + WS_XBF) + (size_t)row * DM;
#pragma unroll
    for (int j = 0; j < 2; ++j) {
      const int c = 8 * lane + 512 * j;
      if (lp <= 0) {
        const f32x4 a0 = *(const f32x4*)(p.x + (size_t)row * DM + c), a1 = *(const f32x4*)(p.x + (size_t)row * DM + c + 4);
        xv[j][0] = a0[0]; xv[j][1] = a0[1]; xv[j][2] = a0[2]; xv[j][3] = a0[3]; xv[j][4] = a1[0]; xv[j][5] = a1[1]; xv[j][6] = a1[2]; xv[j][7] = a1[3];
      } else {
        const u32x4 u = *(const u32x4*)(xbf + c);
#pragma unroll
        for (int e = 0; e < 4; ++e) { xv[j][2 * e] = bflo(u[e]); xv[j][2 * e + 1] = bfhi(u[e]); }
      }
    }
    if (lp >= 0) {
      float yv[2][8]; float ss = 0.f;
#pragma unroll
      for (int j = 0; j < 2; ++j) {
        const u32x4 u = *(const u32x4*)(ybuf + (size_t)row * DM + 8 * lane + 512 * j);
#pragma unroll
        for (int e = 0; e < 4; ++e) { yv[j][2 * e] = bflo(u[e]); yv[j][2 * e + 1] = bfhi(u[e]); ss += yv[j][2 * e] * yv[j][2 * e] + yv[j][2 * e + 1] * yv[j][2 * e + 1]; }
      }
      ss = wave_sum(ss);
      const float rs = rsqrtf(ss * (1.f / DM) + EPS);
#pragma unroll
      for (int j = 0; j < 2; ++j) {
        const int c = 8 * lane + 512 * j;
#pragma unroll
        for (int e = 0; e < 8; ++e) xv[j][e] += mgt[j][e] * (yv[j][e] * rs * gpo[j][e]);
        if (ln >= 4) {
          *(f32x4*)(p.out + (size_t)row * DM + c) = (f32x4){xv[j][0], xv[j][1], xv[j][2], xv[j][3]};
          *(f32x4*)(p.out + (size_t)row * DM + c + 4) = (f32x4){xv[j][4], xv[j][5], xv[j][6], xv[j][7]};
        } else {
          u32x4 w; w.x = pk2(xv[j][0], xv[j][1]); w.y = pk2(xv[j][2], xv[j][3]); w.z = pk2(xv[j][4], xv[j][5]); w.w = pk2(xv[j][6], xv[j][7]);
          *(u32x4*)(xbf + c) = w;
        }
      }
    }
    if (ln < 4) {
      float ss = 0.f;
#pragma unroll
      for (int j = 0; j < 2; ++j)
#pragma unroll
        for (int e = 0; e < 8; ++e) ss += xv[j][e] * xv[j][e];
      ss = wave_sum(ss);
      const float rs = rsqrtf(ss * (1.f / DM) + EPS);
      float zf[8];
#pragma unroll
      for (int h = 0; h < 8; ++h) zf[h] = 0.f;
#pragma unroll
      for (int j = 0; j < 2; ++j) {
        const int c = 8 * lane + 512 * j;
        float hv[8];
#pragma unroll
        for (int e = 0; e < 8; ++e) hv[e] = (xv[j][e] * rs * gpr[j][e]) * msc[j][e] + msh[j][e];
        u32x4 w; w.x = pk2(hv[0], hv[1]); w.y = pk2(hv[2], hv[3]); w.z = pk2(hv[4], hv[5]); w.w = pk2(hv[6], hv[7]);
        *(u32x4*)(hbuf + (size_t)row * DM + c) = w;
        if (ff) {
#pragma unroll
          for (int e = 0; e < 8; ++e) {
            const f32x4 w0 = wl[(j * 8 + e) * 64 + lane], w1 = wl[1024 + (j * 8 + e) * 64 + lane];
            zf[0] += hv[e] * w0[0]; zf[1] += hv[e] * w0[1]; zf[2] += hv[e] * w0[2]; zf[3] += hv[e] * w0[3];
            zf[4] += hv[e] * w1[0]; zf[5] += hv[e] * w1[1]; zf[6] += hv[e] * w1[2]; zf[7] += hv[e] * w1[3];
          }
        }
      }
      if (ff) {
        const bool b5 = lane & 32, b4 = lane & 16, b3 = lane & 8;
        float w4[4], u2[2], t;
#pragma unroll
        for (int k = 0; k < 4; ++k) { const float send = b5 ? zf[k] : zf[4 + k], keep = b5 ? zf[4 + k] : zf[k]; w4[k] = keep + __shfl_xor(send, 32); }
#pragma unroll
        for (int k = 0; k < 2; ++k) { const float send = b4 ? w4[k] : w4[2 + k], keep = b4 ? w4[2 + k] : w4[k]; u2[k] = keep + __shfl_xor(send, 16); }
        { const float send = b3 ? u2[0] : u2[1], keep = b3 ? u2[1] : u2[0]; t = keep + __shfl_xor(send, 8); }
        t += __shfl_xor(t, 4); t += __shfl_xor(t, 2); t += __shfl_xor(t, 1);
        if ((lane & 7) == 0) {
          const int h = lane >> 3;
          const float z = t + p.od_forget_bias[(ln >> 1) * 8 + h];
          const float ls = fminf(z, 0.f) - __builtin_amdgcn_logf(1.f + fast_exp2(-fabsf(z) * LOG2E)) * 0.6931471805599453f;
          ((float*)(ws + WS_LOGF))[(size_t)row * 8 + h] = ls;
        }
      }
    }
  }
  __syncthreads();
}

DI void fox_scan(const Params& p, LAS unsigned char* lds, int bh) {
  const int tid = opaque_tid();
  const int b = bh >> 3, h = bh & 7;
  const float* logf_ = (const float*)(p.ws + WS_LOGF);
  float* fcum = (float*)(p.ws + WS_FCUM) + (size_t)bh * SEQ;
  LAS float* s = (LAS float*)lds;
  float v[4];
#pragma unroll
  for (int j = 0; j < 4; ++j) v[j] = logf_[((size_t)b * SEQ + 4 * tid + j) * 8 + h];
  v[1] += v[0]; v[2] += v[1]; v[3] += v[2];
  s[tid] = v[3];
  __syncthreads();
  for (int off = 1; off < 512; off <<= 1) {
    float t = 0.f;
    if (tid >= off) t = s[tid - off];
    __syncthreads();
    s[tid] += t;
    __syncthreads();
  }
  const float excl = s[tid] - v[3];
#pragma unroll
  for (int j = 0; j < 4; ++j) fcum[4 * tid + j] = -8.0f * (excl + v[j]);
  __syncthreads();
}

struct AttnArgs { const bf16_t *q, *k, *k2, *v, *gate; bf16_t* out; const float* fcum; int ldq, ldk, ldk2, ldv, ldo, ldg; float sl2, sink; };

DI float half_max(float x) {
  const unsigned u = __float_as_uint(x);
  auto r = __builtin_amdgcn_permlane32_swap(u, u, false, false);
  return fmaxf(__uint_as_float(r[0]), __uint_as_float(r[1]));
}
DI float half_sum(float x) {
  const unsigned u = __float_as_uint(x);
  auto r = __builtin_amdgcn_permlane32_swap(u, u, false, false);
  return __uint_as_float(r[0]) + __uint_as_float(r[1]);
}


DI void epi_block(const f32x16& O, float inv, int hh, const bf16_t* gate_row, bf16_t* out_row) {
#pragma unroll
  for (int g = 0; g < 4; g += 2) {
    float v[8];
#pragma unroll
    for (int e = 0; e < 4; ++e) {
      auto r = __builtin_amdgcn_permlane32_swap(__float_as_uint(O[4 * g + e] * inv), __float_as_uint(O[4 * (g + 1) + e] * inv), false, false);
      v[e] = __uint_as_float(r[0]); v[4 + e] = __uint_as_float(r[1]);
    }
    const int c = 8 * g + 8 * hh;
    if (gate_row) {
      const u32x4 gv = *(const u32x4*)(gate_row + c);
#pragma unroll
      for (int e = 0; e < 4; ++e) { v[2 * e] *= silu_f(bflo(gv[e])); v[2 * e + 1] *= silu_f(bfhi(gv[e])); }
    }
    u32x4 w; w.x = pk2(v[0], v[1]); w.y = pk2(v[2], v[3]); w.z = pk2(v[4], v[5]); w.w = pk2(v[6], v[7]);
    *(u32x4*)(out_row + c) = w;
  }
}

template <int N> DI void wait_vmcnt() { asm volatile("s_waitcnt vmcnt(%0)" ::"n"(N) : "memory"); }
DI void raw_barrier() { asm volatile("" ::: "memory"); __builtin_amdgcn_s_barrier(); asm volatile("" ::: "memory"); }

template <int DQK, int DV, int MODE>
DI void attn_item(LAS unsigned char* lds, const AttnArgs& a, int qb) {
  constexpr int KSTR = DQK * 2 + 16, VSTR = (DV == 64) ? 192 : 320;
  constexpr int KG16 = KSTR / 16, VG16 = VSTR / 16;
  constexpr int KCH = KG16, VCH = VG16, NCH = KCH + VCH;
  constexpr int TILE = NCH * 1024 + (MODE == 2 ? 2048 : 0);
  constexpr int NSLOT = (NCH + 7) / 8, REM = NCH - 8 * (NSLOT - 1);
  constexpr int FX = (MODE == 2) ? 1 : 0;
  constexpr int NKS = DQK / 16, NBLK = DV / 32;
  static_assert(5 * TILE <= 155648, "ring too large");
  const int tid = opaque_tid(), wid = __builtin_amdgcn_readfirstlane(tid >> 6), lane = tid & 63, r = lane & 31, hh = lane >> 5;
  const int q0 = qb * 256, qw = q0 + 32 * wid, myq = qw + r;
  const float c = a.sl2, tau = ((MODE == 2) ? 20.0f : 8.0f) / a.sl2;
  bf16x8 qf[NKS];
#pragma unroll
  for (int ks = 0; ks < NKS; ++ks) qf[ks] = *(const bf16x8*)(a.q + (size_t)myq * a.ldq + 16 * ks + 8 * hh);
  int lo = 0; const int hi = 4 * (qb + 1);
  if (MODE == 1) { lo = 4 * qb - 2; if (lo < 0) lo = 0; }
  const int last_w = (qw + 31) >> 6;
  int first_w = 0;
  if (MODE == 1) { first_w = (qw > 127 ? qw - 127 : 0) >> 6; }
  const char* sp[NSLOT]; unsigned sst[NSLOT];
#pragma unroll
  for (int j = 0; j < NSLOT; ++j) {
    const int ch_ = 8 * j + wid;
    if (ch_ < KCH) {
      const int p = ch_ * 64 + lane, row = p / KG16, g = p - row * KG16;
      if (DQK == 96 && g >= 8 && g < 12) { sp[j] = (const char*)(a.k2 + (size_t)row * a.ldk2 + 8 * (g - 8)); sst[j] = (unsigned)(128 * a.ldk2); }
      else { sp[j] = (const char*)(a.k + (size_t)row * a.ldk + 8 * (g < 8 ? g : 0)); sst[j] = (unsigned)(128 * a.ldk); }
    } else {
      const int p = (ch_ - KCH) * 64 + lane, row = (p / VG16) & 63, g = p - (p / VG16) * VG16;
      sp[j] = (const char*)(a.v + (size_t)row * a.ldv + 8 * (g < DV / 8 ? g : 0)); sst[j] = (unsigned)(128 * a.ldv);
    }
  }
  auto issue = [&](int kt) {
    LAS unsigned char* base = lds + (kt % 4) * TILE;
#pragma unroll
    for (int j = 0; j < NSLOT; ++j) {
      if (j < NSLOT - 1 || wid < REM)
        __builtin_amdgcn_global_load_lds((const unsigned*)(sp[j] + (size_t)kt * sst[j]), (LAS unsigned*)(base + (8 * j + wid) * 1024), 16, 0, 0);
    }
    if (MODE == 2) __builtin_amdgcn_global_load_lds((const unsigned*)(a.fcum + kt * 64 + lane), (LAS unsigned*)(base + NCH * 1024 + wid * 256), 4, 0, 0);
  };
  auto wait_tiles = [&](bool all) {
    if (all) wait_vmcnt<0>();
    else if (wid < REM) wait_vmcnt<NSLOT + FX>();
    else wait_vmcnt<NSLOT - 1 + FX>();
  };
  f32x16 O[NBLK];
#pragma unroll
  for (int bl = 0; bl < NBLK; ++bl)
#pragma unroll
    for (int i = 0; i < 16; ++i) O[bl][i] = 0.f;
  float m = (MODE == 1) ? a.sink / a.sl2 : -1e30f;
  float l0 = (MODE == 1 && hh == 0) ? 1.f : 0.f, l1 = 0.f;
  const int i16 = lane & 15, q4 = i16 >> 2, p4 = i16 & 3, grp = (lane >> 4) & 1;
  auto qk_load = [&](int kt, bf16x8 (&kf)[2][NKS]) {
    LAS unsigned char* Kl = lds + (kt % 4) * TILE;
#pragma unroll
    for (int kb = 0; kb < 2; ++kb)
#pragma unroll
      for (int ks = 0; ks < NKS; ++ks) kf[kb][ks] = *(const LAS bf16x8*)(Kl + (32 * kb + r) * KSTR + (16 * ks + 8 * hh) * 2);
  };
  auto qk_mma = [&](int kt, const bf16x8 (&kf)[2][NKS], f32x16 (&s)[2]) {
#pragma unroll
    for (int kb = 0; kb < 2; ++kb) {
      if (MODE == 2) {
        LAS unsigned char* Fl = lds + (kt % 4) * TILE + NCH * 1024 + wid * 256;
#pragma unroll
        for (int g = 0; g < 4; ++g) { const f32x4 fb = *(const LAS f32x4*)(Fl + (32 * kb + 8 * g + 4 * hh) * 4);
          s[kb][4 * g] = fb[0]; s[kb][4 * g + 1] = fb[1]; s[kb][4 * g + 2] = fb[2]; s[kb][4 * g + 3] = fb[3]; }
      } else {
#pragma unroll
        for (int i = 0; i < 16; ++i) s[kb][i] = 0.f;
      }
    }
#pragma unroll
    for (int ks = 0; ks < NKS; ++ks)
#pragma unroll
      for (int kb = 0; kb < 2; ++kb) s[kb] = __builtin_amdgcn_mfma_f32_32x32x16_bf16(kf[kb][ks], qf[ks], s[kb], 0, 0, 0);
  };
  auto softmax = [&](int kt, f32x16 (&s)[2], bf16x8 (&pf)[2][2], auto maskc) {
    constexpr bool MASK = decltype(maskc)::value;
    const int key0 = kt * 64;
    if (MASK) {
#pragma unroll
      for (int kb = 0; kb < 2; ++kb)
#pragma unroll
        for (int i = 0; i < 16; ++i) {
          const int key = key0 + 32 * kb + (i & 3) + 8 * (i >> 2) + 4 * hh;
          bool valid = key <= myq; if (MODE == 1) valid = valid && (myq - key < 128);
          s[kb][i] = valid ? s[kb][i] : -1e30f;
        }
    }
    float mx = fmaxf(s[0][0], s[1][0]);
#pragma unroll
    for (int i = 1; i < 16; ++i) mx = fmaxf(fmaxf(mx, s[0][i]), s[1][i]);
    mx = half_max(mx);
    if (__builtin_amdgcn_ballot_w64(mx > m + tau) != 0ull) {
      const float mnew = fmaxf(m, mx);
      const float alpha = fast_exp2((m - mnew) * c);
      m = mnew;
      l0 *= alpha; l1 *= alpha;
#pragma unroll
      for (int bl = 0; bl < NBLK; ++bl)
#pragma unroll
        for (int i = 0; i < 16; ++i) O[bl][i] *= alpha;
    }
    const float nmc = -m * c;
#pragma unroll
    for (int kb = 0; kb < 2; ++kb)
#pragma unroll
      for (int s2 = 0; s2 < 2; ++s2) {
        float pv[8];
#pragma unroll
        for (int e = 0; e < 8; ++e) pv[e] = fast_exp2(__builtin_fmaf(s[kb][8 * s2 + e], c, nmc));
        l0 += (pv[0] + pv[4]) + (pv[2] + pv[6]); l1 += (pv[1] + pv[5]) + (pv[3] + pv[7]);
        u32x4 w;
        w.x = pk2(pv[0], pv[1]); w.y = pk2(pv[2], pv[3]); w.z = pk2(pv[4], pv[5]); w.w = pk2(pv[6], pv[7]);
        pf[kb][s2] = __builtin_bit_cast(bf16x8, w);
      }
  };
  auto pvmm = [&](int kt, const bf16x8 (&pf)[2][2]) {
    constexpr int PD = (NBLK == 2) ? 2 : 1;
    const unsigned va = (unsigned)(size_t)(lds + (kt % 4) * TILE + KCH * 1024 + (4 * hh + q4) * VSTR + (16 * grp) * 2 + 8 * p4);
    s16x4 vl[PD + 1][NBLK], vh[PD + 1][NBLK];
#define TRRD(dst, off) asm volatile("ds_read_b64_tr_b16 %0, %1 offset:%2" : "=&v"(dst) : "v"(va), "n"(off) : "memory")
#define TRSTEP(st_) do { _Pragma("unroll") for (int bl = 0; bl < NBLK; ++bl) { TRRD(vl[(st_) % (PD + 1)][bl], 16 * (st_) * VSTR + 64 * bl); TRRD(vh[(st_) % (PD + 1)][bl], 16 * (st_) * VSTR + 64 * bl + 8 * VSTR); } } while (0)
#define TRWAIT(n_, b_) do { if (NBLK == 2) asm volatile("s_waitcnt lgkmcnt(" #n_ ")" : "+v"(vl[b_][0]), "+v"(vh[b_][0]), "+v"(vl[b_][1]), "+v"(vh[b_][1])::"memory"); \
    else asm volatile("s_waitcnt lgkmcnt(" #n_ ")" : "+v"(vl[b_][0]), "+v"(vh[b_][0]), "+v"(vl[b_][1]), "+v"(vh[b_][1]), "+v"(vl[b_][2 % NBLK]), "+v"(vh[b_][2 % NBLK]), "+v"(vl[b_][3 % NBLK]), "+v"(vh[b_][3 % NBLK])::"memory"); } while (0)
#pragma unroll
    for (int st = 0; st < PD; ++st) TRSTEP(st);
#pragma unroll
    for (int st = 0; st < 4; ++st) {
      if (st + PD < 4) TRSTEP(st + PD);
      const int ahead = ((st + PD < 4) ? st + PD : 3) - st;
      const int b_ = st % (PD + 1);
      if (ahead * 2 * NBLK == 8) TRWAIT(8, b_); else if (ahead * 2 * NBLK == 4) TRWAIT(4, b_); else TRWAIT(0, b_);
#pragma unroll
      for (int bl = 0; bl < NBLK; ++bl) {
        const bf16x8 vf = __builtin_shufflevector(vl[b_][bl], vh[b_][bl], 0, 1, 2, 3, 4, 5, 6, 7);
        O[bl] = __builtin_amdgcn_mfma_f32_32x32x16_bf16(vf, pf[st >> 1][st & 1], O[bl], 0, 0, 0);
      }
    }
#undef TRRD
#undef TRSTEP
#undef TRWAIT
  };
  auto act = [&](int kt) { return kt <= last_w && kt >= first_w; };
  f32x16 sA[2];
  const bool halfB = wid >= 4;
  issue(lo);
  if (lo + 1 < hi) issue(lo + 1);
  if (lo + 2 < hi) issue(lo + 2);
  wait_tiles(true);
  raw_barrier();
  if (halfB) raw_barrier();
  if (act(lo)) { bf16x8 kf0[2][NKS]; qk_load(lo, kf0); qk_mma(lo, kf0, sA); }
  auto step = [&](int kt, auto maskc) {
    const bool a0 = act(kt), a1 = (kt + 1 < hi) && act(kt + 1);
    bf16x8 pf[2][2], kf[2][NKS];
    if (a0) softmax(kt, sA, pf, maskc);
    wait_tiles(true);
    raw_barrier();
    if (a1) qk_load(kt + 1, kf);
    __builtin_amdgcn_s_setprio(1);
    if (a1) qk_mma(kt + 1, kf, sA);
    if (a0) pvmm(kt, pf);
    __builtin_amdgcn_s_setprio(0);
    if (kt + 3 < hi) issue(kt + 3);
    raw_barrier();
  };
  int split = lo;
  if (MODE != 1) { split = qw >> 6; if (split < lo) split = lo; if (split > hi) split = hi; }
  if (MODE != 1) { for (int kt = lo; kt < split; ++kt) step(kt, std::false_type{}); }
  for (int kt = split; kt < hi; ++kt) step(kt, std::true_type{});
  if (!halfB) raw_barrier();
  const float l = half_sum(l0 + l1);
  const float inv = 1.f / l;
#pragma unroll
  for (int bl = 0; bl < NBLK; ++bl)
    epi_block(O[bl], inv, hh, a.gate ? a.gate + (size_t)myq * a.ldg + 32 * bl : nullptr, a.out + (size_t)myq * a.ldo + 32 * bl);
}

DI void swa_item(LAS unsigned char* lds, const AttnArgs& a, const float* sinks4, int qb) {
  constexpr int KSTR = 144, VSTR = 192, KCH = 9, VCH = 12, NCH = 21, TILE = NCH * 1024, NSLOT = 3, REM = 5, NKS = 4, NBLK = 2;
  const int tid = opaque_tid(), wid = __builtin_amdgcn_readfirstlane(tid >> 6), lane = tid & 63, r = lane & 31, hh = lane >> 5;
  const int q0 = qb * 256, qw = q0 + 32 * wid, myq = qw + r;
  const float c = a.sl2, tau = 8.0f / a.sl2;
  int lo = 4 * qb - 2; if (lo < 0) lo = 0;
  const int hi = 4 * (qb + 1);
  const int last_w = (qw + 31) >> 6, first_w = (qw > 127 ? qw - 127 : 0) >> 6;
#pragma unroll
  for (int j = 0; j < NSLOT; ++j) {
    const int ch_ = 8 * j + wid;
    if (j < NSLOT - 1 || wid < REM) {
      const char* sp; unsigned sst;
      if (ch_ < KCH) { const int p = ch_ * 64 + lane, row = p / 9, g = p - row * 9;
        sp = (const char*)(a.k + (size_t)row * a.ldk + 8 * (g < 8 ? g : 0)); sst = (unsigned)(128 * a.ldk); }
      else { const int p = (ch_ - KCH) * 64 + lane, row = (p / 12) & 63, g = p - (p / 12) * 12;
        sp = (const char*)(a.v + (size_t)row * a.ldv + 8 * (g < 8 ? g : 0)); sst = (unsigned)(128 * a.ldv); }
      for (int kt = lo; kt < hi; ++kt)
        __builtin_amdgcn_global_load_lds((const unsigned*)(sp + (size_t)kt * sst), (LAS unsigned*)(lds + (kt - lo) * TILE + ch_ * 1024), 16, 0, 0);
    }
  }
  wait_vmcnt<0>();
  raw_barrier();
  const int i16 = lane & 15, q4 = i16 >> 2, p4 = i16 & 3, grp = (lane >> 4) & 1;
  for (int h4 = 0; h4 < 4; ++h4) {
    bf16x8 qf[NKS];
#pragma unroll
    for (int ks = 0; ks < NKS; ++ks) qf[ks] = *(const bf16x8*)(a.q + (size_t)myq * a.ldq + h4 * 64 + 16 * ks + 8 * hh);
    f32x16 O[NBLK];
#pragma unroll
    for (int bl = 0; bl < NBLK; ++bl)
#pragma unroll
      for (int i = 0; i < 16; ++i) O[bl][i] = 0.f;
    float m = sinks4[h4] / a.sl2;
    float l0 = (hh == 0) ? 1.f : 0.f, l1 = 0.f;
    for (int kt = first_w; kt <= last_w; ++kt) {
      LAS unsigned char* Kl = lds + (kt - lo) * TILE;
      f32x16 s[2];
      bf16x8 kf[2][NKS];
#pragma unroll
      for (int kb = 0; kb < 2; ++kb)
#pragma unroll
        for (int ks = 0; ks < NKS; ++ks) kf[kb][ks] = *(const LAS bf16x8*)(Kl + (32 * kb + r) * KSTR + (16 * ks + 8 * hh) * 2);
#pragma unroll
      for (int kb = 0; kb < 2; ++kb)
#pragma unroll
        for (int i = 0; i < 16; ++i) s[kb][i] = 0.f;
#pragma unroll
      for (int ks = 0; ks < NKS; ++ks)
#pragma unroll
        for (int kb = 0; kb < 2; ++kb) s[kb] = __builtin_amdgcn_mfma_f32_32x32x16_bf16(kf[kb][ks], qf[ks], s[kb], 0, 0, 0);
      const int key0 = kt * 64;
#pragma unroll
      for (int kb = 0; kb < 2; ++kb)
#pragma unroll
        for (int i = 0; i < 16; ++i) {
          const int key = key0 + 32 * kb + (i & 3) + 8 * (i >> 2) + 4 * hh;
          const bool valid = (key <= myq) && (myq - key < 128);
          s[kb][i] = valid ? s[kb][i] : -1e30f;
        }
      float mx = fmaxf(s[0][0], s[1][0]);
#pragma unroll
      for (int i = 1; i < 16; ++i) mx = fmaxf(fmaxf(mx, s[0][i]), s[1][i]);
      mx = half_max(mx);
      if (__builtin_amdgcn_ballot_w64(mx > m + tau) != 0ull) {
        const float mnew = fmaxf(m, mx);
        const float alpha = fast_exp2((m - mnew) * c);
        m = mnew; l0 *= alpha; l1 *= alpha;
#pragma unroll
        for (int bl = 0; bl < NBLK; ++bl)
#pragma unroll
          for (int i = 0; i < 16; ++i) O[bl][i] *= alpha;
      }
      const float nmc = -m * c;
      bf16x8 pf[2][2];
#pragma unroll
      for (int kb = 0; kb < 2; ++kb)
#pragma unroll
        for (int s2 = 0; s2 < 2; ++s2) {
          float pv[8];
#pragma unroll
          for (int e = 0; e < 8; ++e) pv[e] = fast_exp2(__builtin_fmaf(s[kb][8 * s2 + e], c, nmc));
          l0 += (pv[0] + pv[4]) + (pv[2] + pv[6]); l1 += (pv[1] + pv[5]) + (pv[3] + pv[7]);
          u32x4 w;
          w.x = pk2(pv[0], pv[1]); w.y = pk2(pv[2], pv[3]); w.z = pk2(pv[4], pv[5]); w.w = pk2(pv[6], pv[7]);
          pf[kb][s2] = __builtin_bit_cast(bf16x8, w);
        }
      LAS unsigned char* Vl = Kl + KCH * 1024 + (4 * hh + q4) * VSTR + (16 * grp) * 2 + 8 * p4;
#pragma unroll
      for (int st = 0; st < 4; ++st)
#pragma unroll
        for (int bl = 0; bl < NBLK; ++bl) {
          LAS unsigned char* ad = Vl + (16 * st) * VSTR + (32 * bl) * 2;
          const s16x4 lo_ = __builtin_amdgcn_ds_read_tr16_b64_v4i16((LAS s16x4*)ad);
          const s16x4 hi_ = __builtin_amdgcn_ds_read_tr16_b64_v4i16((LAS s16x4*)(ad + 8 * VSTR));
          const bf16x8 vf = __builtin_shufflevector(lo_, hi_, 0, 1, 2, 3, 4, 5, 6, 7);
          O[bl] = __builtin_amdgcn_mfma_f32_32x32x16_bf16(vf, pf[st >> 1][st & 1], O[bl], 0, 0, 0);
        }
    }
    const float l = half_sum(l0 + l1);
    const float inv = 1.f / l;
#pragma unroll
    for (int bl = 0; bl < NBLK; ++bl)
      epi_block(O[bl], inv, hh, a.gate + (size_t)myq * a.ldg + h4 * 64 + 32 * bl, a.out + (size_t)myq * a.ldo + h4 * 64 + 32 * bl);
  }
  __syncthreads();
}

DI bool team_item(int G, int c, int n, int& bh, int& qb) {
  if (G == 256) {
    const int x = c & 7, li = c >> 3, t = li >> 3, i = li & 7;
    bh = x + 8 * (4 * t + n);
    const int j = (i + 4) & 7;
    qb = (n == 0) ? i : (n == 1) ? 7 - i : (n == 2) ? j : 7 - j;
    return true;
  }
  const int idx = n * G + ((n & 1) ? (G - 1 - c) : c);
  if (idx >= 1024) return false;
  qb = 7 - idx / 128; bh = idx % 128;
  return true;
}

DI int snake_idx(int round, int G, int c) { return round * G + ((round & 1) ? (G - 1 - c) : c); }

DI void attn_even(const Params& p, LAS unsigned char* lds, int i) {
  const int G = gridDim.x, c = blockIdx.x;
  unsigned char* ws = p.ws;
  const bf16_t* z = (const bf16_t*)(ws + WS_ZBUF);
  const bf16_t* qb_ = (const bf16_t*)(ws + WS_QBUF);
  const bf16_t* kv = (const bf16_t*)(ws + WS_HBUF);
  bf16_t* ob = (bf16_t*)(ws + WS_OBUF);
  for (int rd = 0; rd * G < 1024; ++rd) {
    int qb, bh;
    if (!team_item(G, c, rd, bh, qb)) continue;
    const int b = bh >> 3, hd = bh & 7;
    AttnArgs a;
    a.q = qb_ + (size_t)b * SEQ * 768 + hd * 96; a.ldq = 768;
    a.k = kv + (size_t)b * SEQ * 1024 + hd * 128; a.ldk = 1024;
    a.k2 = z + (size_t)b * SEQ * 2560 + 2432; a.ldk2 = 2560;
    a.v = kv + (size_t)b * SEQ * 1024 + hd * 128 + 64; a.ldv = 1024;
    a.out = ob + (size_t)b * SEQ * 1024 + hd * 64; a.ldo = 1024;
    a.gate = z + (size_t)b * SEQ * 2560 + 768 + hd * 64; a.ldg = 2560;
    a.fcum = nullptr; a.sl2 = 0.10206207261596577f * LOG2E; a.sink = 0.f;
    attn_item<96, 64, 0>(lds, a, qb);
  }
  for (int it = c; it < 256; it += G) {
    const int b = it >> 4, kvh = (it >> 3) & 1, qb = it & 7;
    AttnArgs a;
    const bf16_t* zb = z + (size_t)b * SEQ * 2560;
    a.q = zb + kvh * 256; a.ldq = 2560;
    a.k = zb + 512 + kvh * 64; a.ldk = 2560; a.k2 = nullptr; a.ldk2 = 0;
    a.v = zb + 640 + kvh * 64; a.ldv = 2560;
    a.out = ob + (size_t)b * SEQ * 1024 + 512 + kvh * 256; a.ldo = 1024;
    a.gate = zb + 768 + 512 + kvh * 256; a.ldg = 2560;
    a.fcum = nullptr; a.sl2 = 0.125f * LOG2E; a.sink = 0.f;
    float sk[4];
#pragma unroll
    for (int h4 = 0; h4 < 4; ++h4) sk[h4] = p.ev_sinks[i * 8 + kvh * 4 + h4] * LOG2E;
    swa_item(lds, a, sk, qb);
  }
}

DI void attn_odd(const Params& p, LAS unsigned char* lds, int layer) {
  const int G = gridDim.x, c = blockIdx.x;
  unsigned char* ws = p.ws;
  const bf16_t* z = (const bf16_t*)(ws + WS_ZBUF);
  bf16_t* od = (bf16_t*)(ws + WS_HBUF);
  bf16_t* ob = (bf16_t*)(ws + WS_OBUF);
  {
    for (int rd = 0; rd * G < 512; ++rd) {
      int qb, bh2;
      if (G == 256) { const int x = c & 7, li = c >> 3, t = li >> 3, i = li & 7; bh2 = x + 8 * (2 * t + rd); qb = (rd == 0) ? i : 7 - i; }
      else { const int idx = snake_idx(rd, G, c); if (idx >= 512) continue; qb = 7 - idx / 64; bh2 = idx % 64; }
      const int b = bh2 >> 2, h = bh2 & 3;
      const bf16_t* zb = z + (size_t)b * SEQ * 4096;
      for (int mp = 0; mp < 2; ++mp) {
        const int j = 2 * h + mp;
        AttnArgs a;
        a.q = zb + j * 64; a.ldq = 4096;
        a.k = zb + 512 + j * 64; a.ldk = 4096; a.k2 = nullptr; a.ldk2 = 0;
        a.v = zb + 1024 + h * 128; a.ldv = 4096;
        a.out = od + (size_t)b * SEQ * 1024 + j * 128; a.ldo = 1024;
        a.gate = nullptr; a.ldg = 0;
        a.fcum = nullptr; a.sl2 = 0.125f * LOG2E; a.sink = 0.f;
#ifndef SKIP_DIFF
        attn_item<64, 128, 0>(lds, a, qb);
#endif
      }
      __builtin_amdgcn_fence(__ATOMIC_SEQ_CST, "workgroup");
      asm volatile("s_waitcnt vmcnt(0)" ::: "memory");
      const int tid2 = opaque_tid(), lane = tid2 & 63, wid = tid2 >> 6, li_ = layer >> 1;
      const float* lp = p.od_lambda + li_ * 256;
      const float s1 = wave_sum(lp[lane] * lp[64 + lane]), s2 = wave_sum(lp[128 + lane] * lp[192 + lane]);
      const float lam_init = 0.8f - 0.6f * fast_exp2(-0.3f * LOG2E * (float)layer);
      const float lam = fast_exp2(s1 * LOG2E) - fast_exp2(s2 * LOG2E) + lam_init;
      const int rsub = lane >> 4, dv = (lane & 15) * 8;
      float sub[8];
#pragma unroll
      for (int e = 0; e < 8; ++e) sub[e] = p.od_subln[li_ * 128 + dv + e] * (1.f - lam_init);
      const size_t row0 = (size_t)b * SEQ + qb * 256 + 32 * wid;
#pragma unroll 2
      for (int rr = 0; rr < 8; ++rr) {
        const size_t row = row0 + 4 * rr + rsub;
        const u32x4 va = *(const u32x4*)(od + row * 1024 + (2 * h) * 128 + dv);
        const u32x4 vb = *(const u32x4*)(od + row * 1024 + (2 * h + 1) * 128 + dv);
        const u32x4 vg = *(const u32x4*)(z + row * 4096 + 3072 + h * 128 + dv);
        float d[8]; float ss = 0.f;
#pragma unroll
        for (int e = 0; e < 4; ++e) { d[2 * e] = bflo(va[e]) - lam * bflo(vb[e]); d[2 * e + 1] = bfhi(va[e]) - lam * bfhi(vb[e]); ss += d[2 * e] * d[2 * e] + d[2 * e + 1] * d[2 * e + 1]; }
        ss += dpp_mov<0xB1>(ss); ss += dpp_mov<0x4E>(ss); ss += dpp_mov<0x141>(ss); ss += dpp_mov<0x140>(ss);
        const float rs = rsqrtf(ss * (1.f / 128.f) + EPS);
        u32x4 w;
#pragma unroll
        for (int e = 0; e < 4; ++e) {
          const float o0 = d[2 * e] * rs * sub[2 * e] * silu_f(bflo(vg[e])), o1 = d[2 * e + 1] * rs * sub[2 * e + 1] * silu_f(bfhi(vg[e]));
          w[e] = pk2(o0, o1);
        }
        *(u32x4*)(ob + row * 1024 + h * 128 + dv) = w;
      }
    }
  }
  for (int rd = 0; rd * G < 1024; ++rd) {
    int qb, bh;
    if (!team_item(G, c, rd, bh, qb)) continue;
    const int b = bh >> 3, hd = bh & 7;
    AttnArgs a;
    const bf16_t* zb = z + (size_t)b * SEQ * 4096;
    a.q = zb + 1536 + hd * 64; a.ldq = 4096;
    a.k = zb + 2048 + hd * 64; a.ldk = 4096; a.k2 = nullptr; a.ldk2 = 0;
    a.v = zb + 2560 + hd * 64; a.ldv = 4096;
    a.out = ob + (size_t)b * SEQ * 1024 + 512 + hd * 64; a.ldo = 1024;
    a.gate = zb + 3072 + 512 + hd * 64; a.ldg = 4096;
    a.fcum = (const float*)(ws + WS_FCUM) + (size_t)bh * SEQ; a.sl2 = 0.125f * LOG2E; a.sink = 0.f;
#ifndef SKIP_FOX
    attn_item<64, 64, 2>(lds, a, qb);
#endif
  }
}

#define XB_TMO      128
#define XB_XCNT(j)  (256  + 64 * (j))
#define XB_XSUB(j)  (1280 + 64 * (j))
#define XB_XGEN(j)  (2304 + 64 * (j))
#define XB_TOP      3328
#define XB_TOPGEN   3392
#define XCD_BAR_WORDS 3456
#define XB_SPIN_CAP (1u << 20)
DI unsigned xb_ld(unsigned* p) { return __hip_atomic_load(p, __ATOMIC_RELAXED, __HIP_MEMORY_SCOPE_AGENT); }
DI unsigned xb_add(unsigned* p, unsigned v) { return __hip_atomic_fetch_add(p, v, __ATOMIC_RELAXED, __HIP_MEMORY_SCOPE_AGENT); }
DI unsigned xb_xcc_id() { return (unsigned)__builtin_amdgcn_s_getreg((3 << 11) | 20) & 0xFu; }
#define XB_SPIN(cond, bar) do { unsigned _sp = 0; while (cond) { __builtin_amdgcn_s_sleep(1); \
    if ((++_sp & 255u) == 0u) { if (xb_ld(&(bar)[XB_TMO])) break; if (_sp > XB_SPIN_CAP) { atomicAdd(&(bar)[XB_TMO], 1u); break; } } } } while (0)
struct XcdBarrier { unsigned* bar; unsigned x; volatile LAS unsigned* st; };
DI void xcd_barrier_complete(unsigned* bar, unsigned x, unsigned& nloc, unsigned& nx) {
  const unsigned G = gridDim.x;
  unsigned sum, cnt, mine, sp = 0u;
  for (;;) {
    sum = 0u; cnt = 0u; mine = 0u;
#pragma unroll
    for (unsigned j = 0; j < 16; ++j) { const unsigned c = xb_ld(&bar[XB_XCNT(j)]); sum += c; cnt += (c > 0u) ? 1u : 0u; mine = (j == x) ? c : mine; }
    if (sum == G) break;
    __builtin_amdgcn_s_sleep(1);
    if ((++sp & 255u) == 0u) { if (xb_ld(&bar[XB_TMO])) break; if (sp > XB_SPIN_CAP) { atomicAdd(&bar[XB_TMO], 1u); break; } }
  }
  nloc = mine > 0u ? mine : 1u; nx = cnt > 0u ? cnt : 1u;
}
DI void xcd_barrier(const XcdBarrier& b) {
  asm volatile("s_waitcnt vmcnt(0)" ::: "memory");
  __syncthreads();
  if (threadIdx.x == 0) {
    unsigned* bar = b.bar;
    __builtin_amdgcn_s_waitcnt(0);
    unsigned nloc = b.st[0], nx = b.st[1];
    if (nloc == 0u) { xcd_barrier_complete(bar, b.x, nloc, nx); b.st[0] = nloc; b.st[1] = nx; }
    const unsigned old = xb_add(&bar[XB_XSUB(b.x)], 1u);
    const unsigned gen = old / nloc;
    if (old + 1u == (gen + 1u) * nloc) {
      __builtin_amdgcn_fence(__ATOMIC_RELEASE, "agent");
      asm volatile("s_waitcnt vmcnt(0)" ::: "memory");
      const unsigned og = xb_add(&bar[XB_TOP], 1u);
      const unsigned tg = og / nx;
      if (og + 1u == (tg + 1u) * nx) xb_add(&bar[XB_TOPGEN], 1u);
      else XB_SPIN(xb_ld(&bar[XB_TOPGEN]) == tg, bar);
      __builtin_amdgcn_fence(__ATOMIC_ACQUIRE, "agent");
      xb_add(&bar[XB_XGEN(b.x)], 1u);
      asm volatile("s_waitcnt vmcnt(0)" ::: "memory");
    } else {
      XB_SPIN(xb_ld(&bar[XB_XGEN(b.x)]) == gen, bar);
      __builtin_amdgcn_fence(__ATOMIC_ACQUIRE, "agent");
      asm volatile("s_waitcnt vmcnt(0)" ::: "memory");
    }
  }
  __syncthreads();
}

__global__ void __launch_bounds__(512) fwd_megakernel(Params p) {
  extern __shared__ __attribute__((aligned(16))) unsigned char lds_raw[];
  LAS unsigned char* lds = (LAS unsigned char*)lds_raw;
  cg::grid_group grid = cg::this_grid();
  unsigned char* ws = p.ws;
  const int G = gridDim.x, bid = blockIdx.x;
  const float* cosH = (const float*)(ws + WS_COSH); const float* sinH = (const float*)(ws + WS_SINH);
  const float* cosR = (const float*)(ws + WS_COSR); const float* sinR = (const float*)(ws + WS_SINR);

  unsigned* xbar = (unsigned*)(ws + WS_XBAR);
  if (bid == 0) { for (int w = threadIdx.x; w < XCD_BAR_WORDS; w += 512) __hip_atomic_store(xbar + w, 0u, __ATOMIC_RELAXED, __HIP_MEMORY_SCOPE_AGENT); }
  volatile LAS unsigned* xst = (volatile LAS unsigned*)(lds + LDS_BYTES_C - 16);
  if (threadIdx.x == 0) { xst[0] = 0u; xst[1] = 0u; }
#ifndef SKIP_PRO
  prologue(p, lds);
#endif
  grid.sync();
  XcdBarrier xb; xb.bar = xbar; xb.x = xb_xcc_id(); xb.st = xst;
  if (threadIdx.x == 0) (void)xb_add(&xbar[XB_XCNT(xb.x)], 1u);
#pragma unroll
  for (int layer = 0; layer < 4; ++layer) {
    const int i = layer >> 1; const bool odd = layer & 1;
#ifndef SKIP_ROW
    rowwise_phase(p, lds, layer - 1, layer);
#endif
    xcd_barrier(xb);
    {
#ifndef SKIP_SCAN
      if (odd) { for (int bh = bid; bh < 128; bh += G) fox_scan(p, lds, bh); }
#endif
      pg8::Gemm g; g.A = (const bf16_t*)(ws + WS_HBUF); g.lda = 1024; g.K = 1024; g.M = T;
      Epi e; e.out = (bf16_t*)(ws + WS_ZBUF); e.pin = nullptr; e.pslot = 0; e.nK = 0; e.qmode = 0; e.pout = odd ? nullptr : (float*)(ws + WS_PART); e.cosH = cosH; e.sinH = sinH; e.cosR = cosR; e.sinR = sinR;
      if (!odd) { g.Bt = (const bf16_t*)(ws + WS_WEVIN + i * SZ_WEVIN); g.N = 2560; e.ldc = 2560; e.rope64_end = 640; e.rope32_lo = 2432; e.rope32_hi = 2464; }
      else { g.Bt = (const bf16_t*)(ws + WS_WODIN + i * SZ_WODIN); g.N = 4096; e.ldc = 4096; e.rope64_end = 1024; e.rope32_lo = 0; e.rope32_hi = 0; }
      pg8::StaticOrder S; S.init(g.M, g.N, G, bid);
#ifndef SKIP_G1
      pg8::gemm_phase<Epi>(lds, g, S, e);
#endif
    }
    xcd_barrier(xb);
    if (!odd) {
      for (int which = 0; which < 2; ++which) {
        pg8::Gemm g; g.M = T; g.lda = 2560;
        Epi e; e.rope64_end = 0; e.rope32_lo = 0; e.rope32_hi = 0; e.cosH = cosH; e.sinH = sinH; e.cosR = cosR; e.sinR = sinR; e.pout = nullptr; e.pin = (const float*)(ws + WS_PART);
        if (which == 0) { g.A = (const bf16_t*)(ws + WS_ZBUF) + 1792; g.Bt = (const bf16_t*)(ws + WS_WUQ + i * SZ_WUQ); g.N = 768; g.K = 384;
          e.out = (bf16_t*)(ws + WS_QBUF); e.ldc = 768; e.qmode = 1; e.pslot = 0; e.nK = 384; }
        else { g.A = (const bf16_t*)(ws + WS_ZBUF) + 2176; g.Bt = (const bf16_t*)(ws + WS_WUKV + i * SZ_WUKV); g.N = 1024; g.K = 256;
          e.out = (bf16_t*)(ws + WS_HBUF); e.ldc = 1024; e.qmode = 0; e.pslot = 12; e.nK = 256; }
        pg8::StaticOrder S; S.init(g.M, g.N, G, bid);
#ifndef SKIP_G2
        pg8::gemm_phase<Epi>(lds, g, S, e);
#endif
      }
      xcd_barrier(xb);
#ifndef SKIP_ATTE
      attn_even(p, lds, i);
#endif
      xcd_barrier(xb);
    } else {
#ifndef SKIP_ATTO
      attn_odd(p, lds, layer);
#endif
      xcd_barrier(xb);
    }
    {
      pg8::Gemm g; g.A = (const bf16_t*)(ws + WS_OBUF); g.lda = 1024; g.K = 1024; g.M = T; g.N = 1024;
      g.Bt = (const bf16_t*)(ws + (odd ? WS_WODOUT : WS_WEVOUT) + i * SZ_WOUT);
      Epi e; e.out = (bf16_t*)(ws + WS_HBUF); e.ldc = 1024; e.pin = nullptr; e.pslot = 0; e.pout = nullptr; e.nK = 0; e.qmode = 0; e.rope64_end = 0; e.rope32_lo = 0; e.rope32_hi = 0;
      e.cosH = cosH; e.sinH = sinH; e.cosR = cosR; e.sinR = sinR;
      pg8::StaticOrder S; S.init(g.M, g.N, G, bid);
#ifndef SKIP_G3
      pg8::gemm_phase<Epi>(lds, g, S, e);
#endif
    }
    xcd_barrier(xb);
  }
#ifndef SKIP_ROW
  rowwise_phase(p, lds, 3, 4);
#endif
}

constexpr int LDS_BYTES = 155648;
static_assert(LDS_BYTES == LDS_BYTES_C, "LDS size mismatch");

extern "C" void kernel_launch(void* const* d_in, const int* in_sizes, int n_in, void* d_out, int out_size, void* d_ws, size_t ws_size, hipStream_t stream) {
  static int grid_blocks = 0;
  if (grid_blocks == 0) {
    int dev = 0, cus = 0, per_cu = 0;
    if (hipGetDevice(&dev) != hipSuccess || hipDeviceGetAttribute(&cus, hipDeviceAttributeMultiprocessorCount, dev) != hipSuccess) { fprintf(stderr, "device query failed\n"); grid_blocks = -1; return; }
    if (hipFuncSetAttribute((const void*)fwd_megakernel, hipFuncAttributeMaxDynamicSharedMemorySize, LDS_BYTES) != hipSuccess) { fprintf(stderr, "hipFuncSetAttribute failed\n"); grid_blocks = -1; return; }
    if (hipOccupancyMaxActiveBlocksPerMultiprocessor(&per_cu, (const void*)fwd_megakernel, 512, LDS_BYTES) != hipSuccess || per_cu < 1) { fprintf(stderr, "occupancy query: %d\n", per_cu); per_cu = 1; }
    (void)hipGetLastError();
    grid_blocks = cus;
    if (ws_size < WS_END) { fprintf(stderr, "workspace too small: %zu < %zu\n", ws_size, (size_t)WS_END); grid_blocks = -1; return; }
  }
  if (grid_blocks < 0) return;
  Params p{};
  const float** fp = (const float**)&p;
  for (int i = 0; i < 18; ++i) fp[i] = (const float*)d_in[i];
  p.out = (float*)d_out; p.ws = (unsigned char*)d_ws;
  void* args[] = {&p};
  hipError_t e = hipLaunchCooperativeKernel((const void*)fwd_megakernel, dim3(grid_blocks), dim3(512), args, LDS_BYTES, stream);
  if (e != hipSuccess) fprintf(stderr, "cooperative launch failed: %s (grid %d)\n", hipGetErrorString(e), grid_blocks);
}
```

```cpp
#include <hip/hip_runtime.h>
#include <hip/hip_cooperative_groups.h>
#include <cstdio>
#include <type_traits>
namespace cg = cooperative_groups;

#define DI __device__ __forceinline__
#define LAS __attribute__((address_space(3)))
typedef unsigned short bf16_t;
typedef short bf16x8 __attribute__((ext_vector_type(8)));
typedef short s16x4 __attribute__((ext_vector_type(4)));
typedef float f32x2 __attribute__((ext_vector_type(2)));
typedef float f32x4 __attribute__((ext_vector_type(4)));
typedef float f32x16 __attribute__((ext_vector_type(16)));
typedef unsigned u32x2 __attribute__((ext_vector_type(2)));
typedef unsigned u32x4 __attribute__((ext_vector_type(4)));
typedef __bf16 bf16x2_t __attribute__((ext_vector_type(2)));

constexpr int T = 32768, DM = 1024, NB = 16, SEQ = 2048;
constexpr float LOG2E = 1.4426950408889634f;
constexpr float EPS = 1e-6f;
constexpr int LDS_BYTES_C = 155648;

constexpr size_t SZ_WEVIN = 2560ull * 1024 * 2, SZ_WODIN = 4096ull * 1024 * 2, SZ_WUQ = 768ull * 384 * 2, SZ_WUKV = 1024ull * 256 * 2, SZ_WOUT = 1024ull * 1024 * 2;
constexpr size_t WS_WEVIN = 0;
constexpr size_t WS_WODIN = WS_WEVIN + 2 * SZ_WEVIN;
constexpr size_t WS_WUQ = WS_WODIN + 2 * SZ_WODIN;
constexpr size_t WS_WUKV = WS_WUQ + 2 * SZ_WUQ;
constexpr size_t WS_WEVOUT = WS_WUKV + 2 * SZ_WUKV;
constexpr size_t WS_WODOUT = WS_WEVOUT + 2 * SZ_WOUT;
constexpr size_t WS_MOD = WS_WODOUT + 2 * SZ_WOUT;
constexpr size_t WS_COSH = WS_MOD + 4ull * 16 * 3072 * 4;
constexpr size_t WS_SINH = WS_COSH + 2048ull * 32 * 4;
constexpr size_t WS_COSR = WS_SINH + 2048ull * 32 * 4;
constexpr size_t WS_SINR = WS_COSR + 2048ull * 16 * 4;
constexpr size_t WS_LOGF = WS_SINR + 2048ull * 16 * 4;
constexpr size_t WS_FCUM = WS_LOGF + (size_t)T * 8 * 4;
constexpr size_t WS_HBUF = (WS_FCUM + (size_t)T * 8 * 4 + 4095) & ~(size_t)4095;
constexpr size_t WS_OBUF = WS_HBUF + (size_t)T * 1024 * 2;
constexpr size_t WS_ZBUF = WS_OBUF + (size_t)T * 1024 * 2;
constexpr size_t WS_QBUF = WS_ZBUF + (size_t)T * 2560 * 2;
constexpr size_t WS_BAR = WS_ZBUF + (size_t)T * 4096 * 2;
constexpr size_t WS_PART = WS_BAR + 256;
constexpr size_t WS_XBAR = (WS_PART + (size_t)T * 20 * 4 + 4095) & ~(size_t)4095;
constexpr size_t WS_XBF_PRE = WS_XBAR + 16384;
constexpr size_t WS_XBF = WS_XBF_PRE;
constexpr size_t WS_END = WS_XBF + (size_t)T * 1024 * 2;

struct Params {
  const float *x, *c, *w_ada, *b_ada, *g_pre, *g_post, *ev_w_in, *ev_q_norm, *ev_kv_norm, *ev_w_uq, *ev_w_ukv, *ev_sinks, *ev_w_out,
      *od_w_in, *od_forget_bias, *od_lambda, *od_subln, *od_w_out;
  float* out;
  unsigned char* ws;
};

DI int opaque_tid() { int t = threadIdx.x; asm volatile("" : "+v"(t)); return t; }
DI float bflo(unsigned u) { return __uint_as_float(u << 16); }
DI float bfhi(unsigned u) { return __uint_as_float(u & 0xffff0000u); }
DI unsigned pk2(float lo, float hi) { f32x2 f = {lo, hi}; bf16x2_t b = __builtin_convertvector(f, bf16x2_t); return __builtin_bit_cast(unsigned, b); }
DI bf16_t f2bf(float f) { return (bf16_t)(pk2(f, 0.f) & 0xffffu); }
DI float fast_exp2(float x) { return __builtin_amdgcn_exp2f(x); }
DI float silu_f(float x) { return x * __builtin_amdgcn_rcpf(1.f + fast_exp2(-x * LOG2E)); }
template <int CTRL> DI float dpp_mov(float v) { return __builtin_bit_cast(float, __builtin_amdgcn_update_dpp(0, __builtin_bit_cast(int, v), CTRL, 0xf, 0xf, false)); }
DI float wave_sum(float v) {
  v += dpp_mov<0xB1>(v);
  v += dpp_mov<0x4E>(v);
  v += dpp_mov<0x141>(v);
  v += dpp_mov<0x140>(v);
  { const unsigned u = __float_as_uint(v); auto r = __builtin_amdgcn_permlane16_swap(u, u, false, false); v = __uint_as_float(r[0]) + __uint_as_float(r[1]); }
  { const unsigned u = __float_as_uint(v); auto r = __builtin_amdgcn_permlane32_swap(u, u, false, false); v = __uint_as_float(r[0]) + __uint_as_float(r[1]); }
  return v;
}

namespace pg8 {
constexpr int BM = 256, BK = 64, HALF = 128, HTB = HALF * BK * 2, STAGE_BYTES = 8 * HTB, NXCD = 8, WGM = 8;
DI int lds_byte(int r, int c) { const int st = (r >> 4) * 2 + (c >> 5), rr = r & 15, cc = c & 31, ob = rr * 64 + cc * 2; return st * 1024 + (ob ^ (((ob >> 9) & 1) << 5)); }
DI void stage_rc(int b, int& R, int& C) { const int st = b / 1024, sb = b % 1024, swz = sb ^ (((sb >> 9) & 1) << 5); R = (st >> 1) * 16 + swz / 64; C = (st & 1) * 32 + (swz % 64) / 2; }
DI int perm32(int rho) { const int n = rho >> 4, i = rho & 15; return 8 * (i >> 2) + 4 * n + (i & 3); }
struct Unit { int pm, pn; };
struct Gemm { const bf16_t* A; const bf16_t* Bt; int M, N, K, lda; };
struct StaticOrder {
  int nM, nN, nwg, G, c;
  DI void init(int M, int N, int G_, int c_) { nM = M / BM; nN = N / BM; nwg = nM * nN; G = G_; c = c_; }
  DI bool next(int i, Unit& u) const {
    const long L = (long)i * G + c; if (L >= nwg) return false;
    int wgid = (int)L; { const int q = nwg / NXCD, r = nwg % NXCD, xcd = wgid % NXCD, off = wgid / NXCD; wgid = (xcd < r ? xcd * (q + 1) : r * (q + 1) + (xcd - r) * q) + off; }
    const int nig = WGM * nN, gid = wgid / nig, fm = gid * WGM, gsz = (nM - fm) < WGM ? (nM - fm) : WGM;
    u.pm = fm + ((wgid % nig) % gsz); u.pn = (wgid % nig) / gsz; return true;
  }
};

template <class Epi>
DI void gemm_phase(LAS unsigned char* lds, const Gemm g, const StaticOrder& S, const Epi& E) {
  const int tid = opaque_tid(), wid = __builtin_amdgcn_readfirstlane(tid >> 6), lane = tid & 63, wr = wid >> 2, wc = wid & 3, fr = lane & 15, fq = lane >> 4;
  const int K = g.K, nt = K / BK, lda = g.lda;
  unsigned voffA[2], voffB[2];
#pragma unroll
  for (int i = 0; i < 2; ++i) { int R, C; stage_rc(tid * 16 + i * 8192, R, C); const int Rb = (R & ~31) + perm32(R & 31);
    voffA[i] = (unsigned)(R * lda + C) * 2u; voffB[i] = (unsigned)(Rb * K + C) * 2u; }
  const size_t kstep = (size_t)(BK * 2);
  const size_t hstepA = (size_t)HALF * lda * 2, hstepB = (size_t)HALF * K * 2;
  const size_t tstepA = 2 * hstepA, tstepB = 2 * hstepB;
  const unsigned ldsw = (unsigned)wid * 1024u;
  const int aoff = lds_byte(wr * 64 + fr, fq * 8), boff = lds_byte(wc * 32 + fr, fq * 8);
#define PG8_SA(b, h) (((b) * 2 + (h)) * HTB)
#define PG8_SB(b, h) ((4 + (b) * 2 + (h)) * HTB)
#define PG8_STAGE(bufoff, gbase, voff) do { _Pragma("unroll") for (int _i = 0; _i < 2; ++_i) \
    __builtin_amdgcn_global_load_lds((const unsigned*)((const char*)(gbase) + (voff)[_i]), (LAS unsigned*)(lds + (bufoff) + ldsw + _i * 8192), 16, 0, 0); } while (0)
#define PG8_LDA(dst, b, h) do { _Pragma("unroll") for (int m = 0; m < 4; ++m) _Pragma("unroll") for (int k = 0; k < 2; ++k) dst[m][k] = *(const LAS bf16x8*)(lds + PG8_SA(b, h) + aoff + m * 2048 + k * 1024); } while (0)
#define PG8_LDB(dst, b, h) do { _Pragma("unroll") for (int n = 0; n < 2; ++n) _Pragma("unroll") for (int k = 0; k < 2; ++k) dst[n][k] = *(const LAS bf16x8*)(lds + PG8_SB(b, h) + boff + n * 2048 + k * 1024); } while (0)
#define PG8_MMA(ai, bj, At, Bt) do { __builtin_amdgcn_s_setprio(1); _Pragma("unroll") for (int m = 0; m < 4; ++m) _Pragma("unroll") for (int n = 0; n < 2; ++n) _Pragma("unroll") for (int k = 0; k < 2; ++k) \
    acc[ai][bj][m][n] = __builtin_amdgcn_mfma_f32_16x16x32_bf16(Bt[n][k], At[m][k], acc[ai][bj][m][n], 0, 0, 0); __builtin_amdgcn_s_setprio(0); } while (0)
#define PG8_WAIT_V(n) asm volatile("s_waitcnt vmcnt(" #n ")" ::: "memory")
#define PG8_WAIT_L(n) asm volatile("s_waitcnt lgkmcnt(" #n ")" ::: "memory")
#define PG8_BAR __builtin_amdgcn_s_barrier()
#define PG8_SCHED __builtin_amdgcn_sched_barrier(0)
  Unit cur, nxt; int ui = 0;
  if (!S.next(0, cur)) return;
  f32x4 acc[2][2][4][2];
#pragma unroll
  for (int a = 0; a < 2; ++a)
#pragma unroll
    for (int b = 0; b < 2; ++b)
#pragma unroll
      for (int m = 0; m < 4; ++m)
#pragma unroll
        for (int n = 0; n < 2; ++n) acc[a][b][m][n] = (f32x4){0.f, 0.f, 0.f, 0.f};
  bf16x8 At[4][2], B0[2][2], B1[2][2];
  const char* cA = (const char*)g.A + (size_t)cur.pm * tstepA; const char* cB = (const char*)g.Bt + (size_t)cur.pn * tstepB;
  PG8_STAGE(PG8_SB(0, 0), cB, voffB); PG8_STAGE(PG8_SA(0, 0), cA, voffA); PG8_STAGE(PG8_SB(0, 1), cB + hstepB, voffB); PG8_STAGE(PG8_SA(0, 1), cA + hstepA, voffA);
  if (wr == 1) PG8_BAR;
  PG8_WAIT_V(4); PG8_BAR;
  PG8_STAGE(PG8_SB(1, 0), cB + kstep, voffB); PG8_STAGE(PG8_SA(1, 0), cA + kstep, voffA); PG8_STAGE(PG8_SB(1, 1), cB + hstepB + kstep, voffB);
  PG8_WAIT_V(6); PG8_BAR;
  for (;;) {
    const bool has_next = S.next(ui + 1, nxt);
    const char* nA = has_next ? (const char*)g.A + (size_t)nxt.pm * tstepA : cA; const char* nB = has_next ? (const char*)g.Bt + (size_t)nxt.pn * tstepB : cB;
    for (int t = 0; t < nt; t += 2) {
      const bool last = (t == nt - 2);
      const char* a1 = cA + (size_t)(t + 1) * kstep;
      const char* a2 = last ? nA : cA + (size_t)(t + 2) * kstep; const char* b2 = last ? nB : cB + (size_t)(t + 2) * kstep;
      const char* a3 = a2 + kstep; const char* b3 = b2 + kstep;
      PG8_LDB(B0, 0, 0); PG8_SCHED; PG8_LDA(At, 0, 0); PG8_STAGE(PG8_SA(1, 1), a1 + hstepA, voffA);
      PG8_WAIT_L(8); PG8_BAR; PG8_WAIT_L(0); PG8_MMA(0, 0, At, B0); PG8_BAR; PG8_SCHED;
      PG8_LDB(B1, 0, 1); PG8_STAGE(PG8_SB(0, 0), b2, voffB);
      PG8_BAR; PG8_WAIT_L(0); PG8_MMA(0, 1, At, B1); PG8_BAR;
      PG8_LDA(At, 0, 1); PG8_STAGE(PG8_SA(0, 0), a2, voffA);
      PG8_BAR; PG8_WAIT_L(0); PG8_MMA(1, 0, At, B0); PG8_BAR; PG8_SCHED;
      PG8_STAGE(PG8_SB(0, 1), b2 + hstepB, voffB);
      PG8_WAIT_V(6); PG8_BAR; PG8_MMA(1, 1, At, B1); PG8_BAR;
      PG8_LDB(B0, 1, 0); PG8_SCHED; PG8_LDA(At, 1, 0); PG8_STAGE(PG8_SA(0, 1), a2 + hstepA, voffA);
      PG8_WAIT_L(8); PG8_BAR; PG8_WAIT_L(0); PG8_MMA(0, 0, At, B0); PG8_BAR; PG8_SCHED;
      PG8_LDB(B1, 1, 1); PG8_STAGE(PG8_SB(1, 0), b3, voffB);
      PG8_BAR; PG8_WAIT_L(0); PG8_MMA(0, 1, At, B1); PG8_BAR;
      PG8_LDA(At, 1, 1); PG8_STAGE(PG8_SA(1, 0), a3, voffA);
      PG8_BAR; PG8_WAIT_L(0); PG8_MMA(1, 0, At, B0); PG8_BAR; PG8_SCHED;
      PG8_STAGE(PG8_SB(1, 1), b3 + hstepB, voffB);
      PG8_WAIT_V(6); PG8_BAR; PG8_MMA(1, 1, At, B1); PG8_BAR;
    }
    E(acc, cur, wr, wc, fr, fq);
    if (!has_next) break;
#pragma unroll
    for (int a = 0; a < 2; ++a)
#pragma unroll
      for (int b = 0; b < 2; ++b)
#pragma unroll
        for (int m = 0; m < 4; ++m)
#pragma unroll
          for (int n = 0; n < 2; ++n) acc[a][b][m][n] = (f32x4){0.f, 0.f, 0.f, 0.f};
    cur = nxt; cA = nA; cB = nB; ++ui;
  }
  PG8_WAIT_V(0);
  if (wr == 0) PG8_BAR;
  PG8_BAR;
#undef PG8_SA
#undef PG8_SB
#undef PG8_STAGE
#undef PG8_LDA
#undef PG8_LDB
#undef PG8_MMA
#undef PG8_WAIT_V
#undef PG8_WAIT_L
#undef PG8_BAR
#undef PG8_SCHED
}
}

struct Epi {
  bf16_t* out; int ldc;
  int rope64_end;
  int rope32_lo, rope32_hi;
  int qmode;
  const float* pin; int nK;
  int pslot;
  float* pout;
  const float *cosH, *sinH, *cosR, *sinR;
  DI void operator()(const f32x4 (&acc)[2][2][4][2], const pg8::Unit& u, int wr, int wc, int fr, int fq) const {
    const int row0 = u.pm * 256 + wr * 64 + fr;
    int rt[2];
#pragma unroll
    for (int bj = 0; bj < 2; ++bj) {
      const int cw = u.pn * 256 + bj * 128 + wc * 32;
      rt[bj] = 0;
      if (cw < rope64_end) rt[bj] = 1;
      else if (cw >= rope32_lo && cw < rope32_hi) rt[bj] = 2;
      else if (qmode && ((cw >> 5) % 3) == 2) rt[bj] = 2;
    }
    const int tt = rt[0] | rt[1];
    const float* ctab = (tt == 1) ? cosH + (16 * (wc & 1) + 4 * fq) : cosR + 4 * fq;
    const float* stab = (tt == 1) ? sinH + (16 * (wc & 1) + 4 * fq) : sinR + 4 * fq;
    const int tstride = (tt == 1) ? 32 : 16;
    int ps[2] = {-1, -1};
    if (pout) {
#pragma unroll
      for (int bj = 0; bj < 2; ++bj) { const int cw = u.pn * 256 + bj * 128 + wc * 32;
        if (cw >= 1792 && cw < 2432) ps[bj] = ((cw - 1792) >> 7) * 4 + wc; }
    }
#pragma unroll
    for (int ai = 0; ai < 2; ++ai) {
      f32x4 cv[4], sv[4]; float rs[4];
#pragma unroll
      for (int m = 0; m < 4; ++m) {
        const int row = row0 + ai * 128 + m * 16;
        if (tt) { const int pos = row & (SEQ - 1); cv[m] = *(const f32x4*)(ctab + pos * tstride); sv[m] = *(const f32x4*)(stab + pos * tstride); }
        rs[m] = 1.f;
        if (pin) { const f32x4 p0 = *(const f32x4*)(pin + (size_t)row * 20 + pslot), p1 = *(const f32x4*)(pin + (size_t)row * 20 + pslot + 4);
          float ss = ((p0[0] + p0[1]) + (p0[2] + p0[3])) + ((p1[0] + p1[1]) + (p1[2] + p1[3]));
          if (nK == 384) { const f32x4 p2 = *(const f32x4*)(pin + (size_t)row * 20 + pslot + 8); ss += (p2[0] + p2[1]) + (p2[2] + p2[3]); }
          rs[m] = rsqrtf(ss / (float)nK + EPS); }
      }
#pragma unroll
      for (int m = 0; m < 4; ++m) {
        const int row = row0 + ai * 128 + m * 16;
#pragma unroll
        for (int bj = 0; bj < 2; ++bj) {
          const int c0 = u.pn * 256 + bj * 128 + wc * 32 + 8 * fq;
          f32x4 v0 = acc[ai][bj][m][0] * rs[m], v1 = acc[ai][bj][m][1] * rs[m];
          if (ps[bj] >= 0) {
            float sq = (v0[0] * v0[0] + v0[1] * v0[1]) + (v0[2] * v0[2] + v0[3] * v0[3]) + (v1[0] * v1[0] + v1[1] * v1[1]) + (v1[2] * v1[2] + v1[3] * v1[3]);
            { const unsigned uq = __float_as_uint(sq); auto r16 = __builtin_amdgcn_permlane16_swap(uq, uq, false, false); sq = __uint_as_float(r16[0]) + __uint_as_float(r16[1]); }
            { const unsigned uq = __float_as_uint(sq); auto r32 = __builtin_amdgcn_permlane32_swap(uq, uq, false, false); sq = __uint_as_float(r32[0]) + __uint_as_float(r32[1]); }
            if (fq == 0) pout[(size_t)row * 20 + ps[bj]] = sq;
          }
          if (rt[bj]) {
            const f32x4 o1 = v0 * cv[m] - v1 * sv[m], o2 = v1 * cv[m] + v0 * sv[m];
            v0 = o1; v1 = o2;
          }
          u32x4 w; w.x = pk2(v0[0], v0[1]); w.y = pk2(v0[2], v0[3]); w.z = pk2(v1[0], v1[1]); w.w = pk2(v1[2], v1[3]);
          *(u32x4*)(out + (size_t)row * ldc + c0) = w;
        }
      }
    }
  }
};

DI int ropeperm64(int p) { const int g = p >> 3, r = p & 7; return r < 4 ? 4 * g + r : 32 + 4 * g + (r - 4); }
DI int ropeperm32(int p) { const int g = p >> 3, r = p & 7; return r < 4 ? 4 * g + r : 16 + 4 * g + (r - 4); }
DI int srccol(int kind, int n) {
  if (kind == 0) {
    if (n < 512) return 672 + (n & ~63) + ropeperm64(n & 63);
    if (n < 640) return 1184 + ((n - 512) & ~63) + ropeperm64(n & 63);
    if (n < 768) return 1312 + (n - 640);
    if (n < 1792) return 1440 + (n - 768);
    if (n < 2176) return n - 1792;
    if (n < 2432) return 384 + (n - 2176);
    if (n < 2464) return 640 + ropeperm32(n - 2432);
    return -1;
  }
  if (kind == 1) {
    if (n < 1024) return (n & ~63) + ropeperm64(n & 63);
    if (n < 3072) return n;
    return 3080 + (n - 3072);
  }
  if (kind == 2) { const int hd = n / 96, p = n - hd * 96; return hd * 96 + (p < 64 ? p : 64 + ropeperm32(p - 64)); }
  return n;
}
struct ConvJob { const float* W; const float* g; bf16_t* Wt; int Nsrc, K, kind, tn, tk; };
DI bool conv_decode(const Params& p, int job, ConvJob& j) {
  constexpr int NT0 = 40 * 16, NT1 = 64 * 16, NT2 = 12 * 6, NT3 = 16 * 4, NT4 = 16 * 16;
  constexpr int PER_I = NT0 + NT1 + NT2 + NT3 + 2 * NT4;
  if (job >= 2 * PER_I) return false;
  unsigned char* ws = p.ws;
  const int i = job / PER_I; int t = job - i * PER_I;
  j.g = nullptr;
  if (t < NT0) { j.W = p.ev_w_in + (size_t)i * 1024 * 2464; j.Nsrc = 2464; j.K = 1024; j.Wt = (bf16_t*)(ws + WS_WEVIN + i * SZ_WEVIN); j.kind = 0; j.tn = t / 16; j.tk = t % 16; return true; }
  t -= NT0;
  if (t < NT1) { j.W = p.od_w_in + (size_t)i * 1024 * 4104; j.Nsrc = 4104; j.K = 1024; j.Wt = (bf16_t*)(ws + WS_WODIN + i * SZ_WODIN); j.kind = 1; j.tn = t / 16; j.tk = t % 16; return true; }
  t -= NT1;
  if (t < NT2) { j.W = p.ev_w_uq + (size_t)i * 384 * 768; j.Nsrc = 768; j.K = 384; j.Wt = (bf16_t*)(ws + WS_WUQ + i * SZ_WUQ); j.kind = 2; j.g = p.ev_q_norm + i * 384; j.tn = t / 6; j.tk = t % 6; return true; }
  t -= NT2;
  if (t < NT3) { j.W = p.ev_w_ukv + (size_t)i * 256 * 1024; j.Nsrc = 1024; j.K = 256; j.Wt = (bf16_t*)(ws + WS_WUKV + i * SZ_WUKV); j.kind = 3; j.g = p.ev_kv_norm + i * 256; j.tn = t / 4; j.tk = t % 4; return true; }
  t -= NT3;
  if (t < NT4) { j.W = p.ev_w_out + (size_t)i * 1024 * 1024; j.Nsrc = 1024; j.K = 1024; j.Wt = (bf16_t*)(ws + WS_WEVOUT + i * SZ_WOUT); j.kind = 4; j.tn = t / 16; j.tk = t % 16; return true; }
  t -= NT4;
  j.W = p.od_w_out + (size_t)i * 1024 * 1024; j.Nsrc = 1024; j.K = 1024; j.Wt = (bf16_t*)(ws + WS_WODOUT + i * SZ_WOUT); j.kind = 4; j.tn = t / 16; j.tk = t % 16; return true;
}
template <int NJ>
DI void convert_tiles(const Params& p, LAS unsigned char* lds, int job0, int jstride) {
  const int tid = opaque_tid();
  const int n4 = (tid & 15) * 4, kq = tid >> 4;
  ConvJob j[NJ] = {}; bool ok[NJ]; f32x4 v[NJ][2];
#pragma unroll
  for (int q = 0; q < NJ; ++q) {
    ok[q] = conv_decode(p, job0 + q * jstride, j[q]);
    const int sc = ok[q] ? srccol(j[q].kind, j[q].tn * 64 + n4) : -1;
#pragma unroll
    for (int e = 0; e < 2; ++e) {
      const int k = j[q].tk * 64 + kq + 32 * e;
      v[q][e] = (f32x4){0.f, 0.f, 0.f, 0.f};
      if (sc >= 0) { v[q][e] = *(const f32x4*)(j[q].W + (size_t)k * j[q].Nsrc + sc); if (j[q].g) v[q][e] = v[q][e] * j[q].g[k]; }
    }
  }
#pragma unroll
  for (int q = 0; q < NJ; ++q) {
    LAS bf16_t* tile = (LAS bf16_t*)(lds + q * 9216);
#pragma unroll
    for (int e = 0; e < 2; ++e)
#pragma unroll
      for (int i = 0; i < 4; ++i) tile[(n4 + i) * 72 + kq + 32 * e] = f2bf(v[q][e][i]);
  }
  __syncthreads();
#pragma unroll
  for (int q = 0; q < NJ; ++q) {
    if (ok[q]) {
      LAS bf16_t* tile = (LAS bf16_t*)(lds + q * 9216);
      const int n2 = tid >> 3, ch = tid & 7;
      const u32x4 w = *(const LAS u32x4*)(tile + n2 * 72 + ch * 8);
      *(u32x4*)(j[q].Wt + (size_t)(j[q].tn * 64 + n2) * j[q].K + j[q].tk * 64 + ch * 8) = w;
    }
  }
  __syncthreads();
}

DI void prologue(const Params& p, LAS unsigned char* lds) {
  const int tid = opaque_tid(), G = gridDim.x, bid = blockIdx.x;
  unsigned char* ws = p.ws;
  for (int idx = bid * 512 + tid; idx < 2048 * 48; idx += G * 512) {
    const bool isH = idx < 2048 * 32;
    const int j = isH ? idx : idx - 2048 * 32;
    const int pos = isH ? (j >> 5) : (j >> 4), i = isH ? (j & 31) : (j & 15);
    const float e = isH ? (float)(2 * i) * (1.f / 64.f) : (float)(2 * i) * (1.f / 32.f);
    const float inv = fast_exp2(-e * 13.287712379549449f);
    const float ang = (float)pos * inv;
    double t = (double)ang * 0.15915494309189535; t -= rint(t);
    const float fr = (float)t;
    const float cv = __builtin_amdgcn_cosf(fr), sv = __builtin_amdgcn_sinf(fr);
    if (isH) { ((float*)(ws + WS_COSH))[j] = cv; ((float*)(ws + WS_SINH))[j] = sv; }
    else { ((float*)(ws + WS_COSR))[j] = cv; ((float*)(ws + WS_SINR))[j] = sv; }
  }
  for (int job = bid; job < 4624; job += 4 * G) convert_tiles<4>(p, lds, job, G);
  const int item0 = G - 1 - bid;
  if (item0 < 192) {
    LAS float* cond = (LAS float*)lds;
    LAS float* red = (LAS float*)(lds + 65536);
    for (int e = tid; e < 16 * 1024; e += 512) { const int b = e >> 10, k = e & 1023; cond[k * 16 + b] = silu_f(p.c[e]); }
    __syncthreads();
    for (int item = item0; item < 192; item += G) {
      const int l = item / 48, n0 = (item % 48) * 64;
      const int col = tid & 63, kg = tid >> 6;
      float a[16];
#pragma unroll
      for (int b = 0; b < 16; ++b) a[b] = 0.f;
      const float* wp = p.w_ada + (size_t)l * 1024 * 3072 + n0 + col;
      for (int k0 = kg * 128; k0 < kg * 128 + 128; k0 += 16) {
        float wv[16];
#pragma unroll
        for (int e = 0; e < 16; ++e) wv[e] = wp[(size_t)(k0 + e) * 3072];
#pragma unroll
        for (int e = 0; e < 16; ++e) {
          const float w = wv[e]; const int k = k0 + e;
#pragma unroll
          for (int b4 = 0; b4 < 4; ++b4) { const f32x4 cv = *(const LAS f32x4*)(cond + k * 16 + b4 * 4);
            a[b4 * 4 + 0] += cv[0] * w; a[b4 * 4 + 1] += cv[1] * w; a[b4 * 4 + 2] += cv[2] * w; a[b4 * 4 + 3] += cv[3] * w; }
        }
      }
#pragma unroll
      for (int b = 0; b < 16; ++b) red[(kg * 16 + b) * 64 + col] = a[b];
      __syncthreads();
      for (int e = tid; e < 1024; e += 512) { const int b = e >> 6, cc = e & 63; float s = 0.f;
#pragma unroll
        for (int k8 = 0; k8 < 8; ++k8) s += red[(k8 * 16 + b) * 64 + cc];
        ((float*)(ws + WS_MOD))[((size_t)l * 16 + b) * 3072 + n0 + cc] = s + p.b_ada[l * 3072 + n0 + cc]; }
      __syncthreads();
    }
  }
}

DI void rowwise_phase(const Params& p, LAS unsigned char* lds, int lp, int ln) {
  const int tid = opaque_tid(), lane = tid & 63, wid = tid >> 6;
  const int gw = blockIdx.x * 8 + wid, nw = gridDim.x * 8;
  unsigned char* ws = p.ws;
  const float* mod = (const float*)(ws + WS_MOD);
  const bf16_t* ybuf = (const bf16_t*)(ws + WS_HBUF);
  bf16_t* hbuf = (bf16_t*)(ws + WS_HBUF);
  const bool ff = (ln < 4) && (ln & 1);
  LAS f32x4* wl = (LAS f32x4*)lds;
  if (ff) {
    const float* w = p.od_w_in + (size_t)(ln >> 1) * 1024 * 4104 + 3072;
    for (int c = tid; c < 1024; c += 512) {
      const f32x4 w0 = *(const f32x4*)(w + (size_t)c * 4104), w1 = *(const f32x4*)(w + (size_t)c * 4104 + 4);
      const int ln_ = (c & 511) >> 3, e = c & 7, j = c >> 9;
      wl[(j * 8 + e) * 64 + ln_] = w0; wl[1024 + (j * 8 + e) * 64 + ln_] = w1;
    }
    __syncthreads();
  }
  const int RPW = (T + nw - 1) / nw;
  float gpo[2][8], gpr[2][8], mgt[2][8], msh[2][8], msc[2][8];
#pragma unroll
  for (int j = 0; j < 2; ++j)
#pragma unroll
    for (int e = 0; e < 8; ++e) { gpo[j][e] = 0.f; gpr[j][e] = 0.f; mgt[j][e] = 0.f; msh[j][e] = 0.f; msc[j][e] = 0.f; }
#pragma unroll
  for (int j = 0; j < 2; ++j)
#pragma unroll
    for (int q = 0; q < 2; ++q) {
      const int c = 8 * lane + 512 * j + 4 * q;
      if (lp >= 0) { const f32x4 t = *(const f32x4*)(p.g_post + lp * DM + c); gpo[j][4 * q] = t[0]; gpo[j][4 * q + 1] = t[1]; gpo[j][4 * q + 2] = t[2]; gpo[j][4 * q + 3] = t[3]; }
      if (ln < 4) { const f32x4 t = *(const f32x4*)(p.g_pre + ln * DM + c); gpr[j][4 * q] = t[0]; gpr[j][4 * q + 1] = t[1]; gpr[j][4 * q + 2] = t[2]; gpr[j][4 * q + 3] = t[3]; }
    }
  int bcur = -1;
  for (int rr = 0; rr < RPW; ++rr) {
    const int row = gw * RPW + rr;
    if (row >= T) break;
    const int b = row >> 11;
    if (b != bcur) {
      bcur = b;
#pragma unroll
      for (int j = 0; j < 2; ++j)
#pragma unroll
        for (int q = 0; q < 2; ++q) {
          const int c = 8 * lane + 512 * j + 4 * q;
          if (lp >= 0) { const f32x4 t = *(const f32x4*)(mod + ((size_t)lp * 16 + b) * 3072 + 2048 + c); mgt[j][4 * q] = t[0]; mgt[j][4 * q + 1] = t[1]; mgt[j][4 * q + 2] = t[2]; mgt[j][4 * q + 3] = t[3]; }
          if (ln < 4) {
            const f32x4 t = *(const f32x4*)(mod + ((size_t)ln * 16 + b) * 3072 + c); msh[j][4 * q] = t[0]; msh[j][4 * q + 1] = t[1]; msh[j][4 * q + 2] = t[2]; msh[j][4 * q + 3] = t[3];
            const f32x4 u = *(const f32x4*)(mod + ((size_t)ln * 16 + b) * 3072 + 1024 + c); msc[j][4 * q] = u[0] + 1.f; msc[j][4 * q + 1] = u[1] + 1.f; msc[j][4 * q + 2] = u[2] + 1.f; msc[j][4 * q + 3] = u[3] + 1.f;
          }
        }
    }
    float xv[2][8];
    bf16_t* xbf = (bf16_t*)(ws + WS_XBF) + (size_t)row * DM;
#pragma unroll
    for (int j = 0; j < 2; ++j) {
      const int c = 8 * lane + 512 * j;
      if (lp <= 0) {
        const f32x4 a0 = *(const f32x4*)(p.x + (size_t)row * DM + c), a1 = *(const f32x4*)(p.x + (size_t)row * DM + c + 4);
        xv[j][0] = a0[0]; xv[j][1] = a0[1]; xv[j][2] = a0[2]; xv[j][3] = a0[3]; xv[j][4] = a1[0]; xv[j][5] = a1[1]; xv[j][6] = a1[2]; xv[j][7] = a1[3];
      } else {
        const u32x4 u = *(const u32x4*)(xbf + c);
#pragma unroll
        for (int e = 0; e < 4; ++e) { xv[j][2 * e] = bflo(u[e]); xv[j][2 * e + 1] = bfhi(u[e]); }
      }
    }
    if (lp >= 0) {
      float yv[2][8]; float ss = 0.f;
#pragma unroll
      for (int j = 0; j < 2; ++j) {
        const u32x4 u = *(const u32x4*)(ybuf + (size_t)row * DM + 8 * lane + 512 * j);
#pragma unroll
        for (int e = 0; e < 4; ++e) { yv[j][2 * e] = bflo(u[e]); yv[j][2 * e + 1] = bfhi(u[e]); ss += yv[j][2 * e] * yv[j][2 * e] + yv[j][2 * e + 1] * yv[j][2 * e + 1]; }
      }
      ss = wave_sum(ss);
      const float rs = rsqrtf(ss * (1.f / DM) + EPS);
#pragma unroll
      for (int j = 0; j < 2; ++j) {
        const int c = 8 * lane + 512 * j;
#pragma unroll
        for (int e = 0; e < 8; ++e) xv[j][e] += mgt[j][e] * (yv[j][e] * rs * gpo[j][e]);
        if (ln >= 4) {
          *(f32x4*)(p.out + (size_t)row * DM + c) = (f32x4){xv[j][0], xv[j][1], xv[j][2], xv[j][3]};
          *(f32x4*)(p.out + (size_t)row * DM + c + 4) = (f32x4){xv[j][4], xv[j][5], xv[j][6], xv[j][7]};
        } else {
          u32x4 w; w.x = pk2(xv[j][0], xv[j][1]); w.y = pk2(xv[j][2], xv[j][3]); w.z = pk2(xv[j][4], xv[j][5]); w.w = pk2(xv[j][6], xv[j][7]);
          *(u32x4*)(xbf + c) = w;
        }
      }
    }
    if (ln < 4) {
      float ss = 0.f;
#pragma unroll
      for (int j = 0; j < 2; ++j)
#pragma unroll
        for (int e = 0; e < 8; ++e) ss += xv[j][e] * xv[j][e];
      ss = wave_sum(ss);
      const float rs = rsqrtf(ss * (1.f / DM) + EPS);
      float zf[8];
#pragma unroll
      for (int h = 0; h < 8; ++h) zf[h] = 0.f;
#pragma unroll
      for (int j = 0; j < 2; ++j) {
        const int c = 8 * lane + 512 * j;
        float hv[8];
#pragma unroll
        for (int e = 0; e < 8; ++e) hv[e] = (xv[j][e] * rs * gpr[j][e]) * msc[j][e] + msh[j][e];
        u32x4 w; w.x = pk2(hv[0], hv[1]); w.y = pk2(hv[2], hv[3]); w.z = pk2(hv[4], hv[5]); w.w = pk2(hv[6], hv[7]);
        *(u32x4*)(hbuf + (size_t)row * DM + c) = w;
        if (ff) {
#pragma unroll
          for (int e = 0; e < 8; ++e) {
            const f32x4 w0 = wl[(j * 8 + e) * 64 + lane], w1 = wl[1024 + (j * 8 + e) * 64 + lane];
            zf[0] += hv[e] * w0[0]; zf[1] += hv[e] * w0[1]; zf[2] += hv[e] * w0[2]; zf[3] += hv[e] * w0[3];
            zf[4] += hv[e] * w1[0]; zf[5] += hv[e] * w1[1]; zf[6] += hv[e] * w1[2]; zf[7] += hv[e] * w1[3];
          }
        }
      }
      if (ff) {
        const bool b5 = lane & 32, b4 = lane & 16, b3 = lane & 8;
        float w4[4], u2[2], t;
#pragma unroll
        for (int k = 0; k < 4; ++k) { const float send = b5 ? zf[k] : zf[4 + k], keep = b5 ? zf[4 + k] : zf[k]; w4[k] = keep + __shfl_xor(send, 32); }
#pragma unroll
        for (int k = 0; k < 2; ++k) { const float send = b4 ? w4[k] : w4[2 + k], keep = b4 ? w4[2 + k] : w4[k]; u2[k] = keep + __shfl_xor(send, 16); }
        { const float send = b3 ? u2[0] : u2[1], keep = b3 ? u2[1] : u2[0]; t = keep + __shfl_xor(send, 8); }
        t += __shfl_xor(t, 4); t += __shfl_xor(t, 2); t += __shfl_xor(t, 1);
        if ((lane & 7) == 0) {
          const int h = lane >> 3;
          const float z = t + p.od_forget_bias[(ln >> 1) * 8 + h];
          const float ls = fminf(z, 0.f) - __builtin_amdgcn_logf(1.f + fast_exp2(-fabsf(z) * LOG2E)) * 0.6931471805599453f;
          ((float*)(ws + WS_LOGF))[(size_t)row * 8 + h] = ls;
        }
      }
    }
  }
  __syncthreads();
}

DI void fox_scan(const Params& p, LAS unsigned char* lds, int bh) {
  const int tid = opaque_tid();
  const int b = bh >> 3, h = bh & 7;
  const float* logf_ = (const float*)(p.ws + WS_LOGF);
  float* fcum = (float*)(p.ws + WS_FCUM) + (size_t)bh * SEQ;
  LAS float* s = (LAS float*)lds;
  float v[4];
#pragma unroll
  for (int j = 0; j < 4; ++j) v[j] = logf_[((size_t)b * SEQ + 4 * tid + j) * 8 + h];
  v[1] += v[0]; v[2] += v[1]; v[3] += v[2];
  s[tid] = v[3];
  __syncthreads();
  for (int off = 1; off < 512; off <<= 1) {
    float t = 0.f;
    if (tid >= off) t = s[tid - off];
    __syncthreads();
    s[tid] += t;
    __syncthreads();
  }
  const float excl = s[tid] - v[3];
#pragma unroll
  for (int j = 0; j < 4; ++j) fcum[4 * tid + j] = -8.0f * (excl + v[j]);
  __syncthreads();
}

struct AttnArgs { const bf16_t *q, *k, *k2, *v, *gate; bf16_t* out; const float* fcum; int ldq, ldk, ldk2, ldv, ldo, ldg; float sl2, sink; };

DI float half_max(float x) {
  const unsigned u = __float_as_uint(x);
  auto r = __builtin_amdgcn_permlane32_swap(u, u, false, false);
  return fmaxf(__uint_as_float(r[0]), __uint_as_float(r[1]));
}
DI float half_sum(float x) {
  const unsigned u = __float_as_uint(x);
  auto r = __builtin_amdgcn_permlane32_swap(u, u, false, false);
  return __uint_as_float(r[0]) + __uint_as_float(r[1]);
}


DI void epi_block(const f32x16& O, float inv, int hh, const bf16_t* gate_row, bf16_t* out_row) {
#pragma unroll
  for (int g = 0; g < 4; g += 2) {
    float v[8];
#pragma unroll
    for (int e = 0; e < 4; ++e) {
      auto r = __builtin_amdgcn_permlane32_swap(__float_as_uint(O[4 * g + e] * inv), __float_as_uint(O[4 * (g + 1) + e] * inv), false, false);
      v[e] = __uint_as_float(r[0]); v[4 + e] = __uint_as_float(r[1]);
    }
    const int c = 8 * g + 8 * hh;
    if (gate_row) {
      const u32x4 gv = *(const u32x4*)(gate_row + c);
#pragma unroll
      for (int e = 0; e < 4; ++e) { v[2 * e] *= silu_f(bflo(gv[e])); v[2 * e + 1] *= silu_f(bfhi(gv[e])); }
    }
    u32x4 w; w.x = pk2(v[0], v[1]); w.y = pk2(v[2], v[3]); w.z = pk2(v[4], v[5]); w.w = pk2(v[6], v[7]);
    *(u32x4*)(out_row + c) = w;
  }
}

template <int N> DI void wait_vmcnt() { asm volatile("s_waitcnt vmcnt(%0)" ::"n"(N) : "memory"); }
DI void raw_barrier() { asm volatile("" ::: "memory"); __builtin_amdgcn_s_barrier(); asm volatile("" ::: "memory"); }

template <int DQK, int DV, int MODE>
DI void attn_item(LAS unsigned char* lds, const AttnArgs& a, int qb) {
  constexpr int KSTR = DQK * 2 + 16, VSTR = (DV == 64) ? 192 : 320;
  constexpr int KG16 = KSTR / 16, VG16 = VSTR / 16;
  constexpr int KCH = KG16, VCH = VG16, NCH = KCH + VCH;
  constexpr int TILE = NCH * 1024 + (MODE == 2 ? 2048 : 0);
  constexpr int NSLOT = (NCH + 7) / 8, REM = NCH - 8 * (NSLOT - 1);
  constexpr int FX = (MODE == 2) ? 1 : 0;
  constexpr int NKS = DQK / 16, NBLK = DV / 32;
  static_assert(5 * TILE <= 155648, "ring too large");
  const int tid = opaque_tid(), wid = __builtin_amdgcn_readfirstlane(tid >> 6), lane = tid & 63, r = lane & 31, hh = lane >> 5;
  const int q0 = qb * 256, qw = q0 + 32 * wid, myq = qw + r;
  const float c = a.sl2, tau = ((MODE == 2) ? 20.0f : 8.0f) / a.sl2;
  bf16x8 qf[NKS];
#pragma unroll
  for (int ks = 0; ks < NKS; ++ks) qf[ks] = *(const bf16x8*)(a.q + (size_t)myq * a.ldq + 16 * ks + 8 * hh);
  int lo = 0; const int hi = 4 * (qb + 1);
  if (MODE == 1) { lo = 4 * qb - 2; if (lo < 0) lo = 0; }
  const int last_w = (qw + 31) >> 6;
  int first_w = 0;
  if (MODE == 1) { first_w = (qw > 127 ? qw - 127 : 0) >> 6; }
  const char* sp[NSLOT]; unsigned sst[NSLOT];
#pragma unroll
  for (int j = 0; j < NSLOT; ++j) {
    const int ch_ = 8 * j + wid;
    if (ch_ < KCH) {
      const int p = ch_ * 64 + lane, row = p / KG16, g = p - row * KG16;
      if (DQK == 96 && g >= 8 && g < 12) { sp[j] = (const char*)(a.k2 + (size_t)row * a.ldk2 + 8 * (g - 8)); sst[j] = (unsigned)(128 * a.ldk2); }
      else { sp[j] = (const char*)(a.k + (size_t)row * a.ldk + 8 * (g < 8 ? g : 0)); sst[j] = (unsigned)(128 * a.ldk); }
    } else {
      const int p = (ch_ - KCH) * 64 + lane, row = (p / VG16) & 63, g = p - (p / VG16) * VG16;
      sp[j] = (const char*)(a.v + (size_t)row * a.ldv + 8 * (g < DV / 8 ? g : 0)); sst[j] = (unsigned)(128 * a.ldv);
    }
  }
  auto issue = [&](int kt) {
    LAS unsigned char* base = lds + (kt % 4) * TILE;
#pragma unroll
    for (int j = 0; j < NSLOT; ++j) {
      if (j < NSLOT - 1 || wid < REM)
        __builtin_amdgcn_global_load_lds((const unsigned*)(sp[j] + (size_t)kt * sst[j]), (LAS unsigned*)(base + (8 * j + wid) * 1024), 16, 0, 0);
    }
    if (MODE == 2) __builtin_amdgcn_global_load_lds((const unsigned*)(a.fcum + kt * 64 + lane), (LAS unsigned*)(base + NCH * 1024 + wid * 256), 4, 0, 0);
  };
  auto wait_tiles = [&](bool all) {
    if (all) wait_vmcnt<0>();
    else if (wid < REM) wait_vmcnt<NSLOT + FX>();
    else wait_vmcnt<NSLOT - 1 + FX>();
  };
  f32x16 O[NBLK];
#pragma unroll
  for (int bl = 0; bl < NBLK; ++bl)
#pragma unroll
    for (int i = 0; i < 16; ++i) O[bl][i] = 0.f;
  float m = (MODE == 1) ? a.sink / a.sl2 : -1e30f;
  float l0 = (MODE == 1 && hh == 0) ? 1.f : 0.f, l1 = 0.f;
  const int i16 = lane & 15, q4 = i16 >> 2, p4 = i16 & 3, grp = (lane >> 4) & 1;
  auto qk_load = [&](int kt, bf16x8 (&kf)[2][NKS]) {
    LAS unsigned char* Kl = lds + (kt % 4) * TILE;
#pragma unroll
    for (int kb = 0; kb < 2; ++kb)
#pragma unroll
      for (int ks = 0; ks < NKS; ++ks) kf[kb][ks] = *(const LAS bf16x8*)(Kl + (32 * kb + r) * KSTR + (16 * ks + 8 * hh) * 2);
  };
  auto qk_mma = [&](int kt, const bf16x8 (&kf)[2][NKS], f32x16 (&s)[2]) {
#pragma unroll
    for (int kb = 0; kb < 2; ++kb) {
      if (MODE == 2) {
        LAS unsigned char* Fl = lds + (kt % 4) * TILE + NCH * 1024 + wid * 256;
#pragma unroll
        for (int g = 0; g < 4; ++g) { const f32x4 fb = *(const LAS f32x4*)(Fl + (32 * kb + 8 * g + 4 * hh) * 4);
          s[kb][4 * g] = fb[0]; s[kb][4 * g + 1] = fb[1]; s[kb][4 * g + 2] = fb[2]; s[kb][4 * g + 3] = fb[3]; }
      } else {
#pragma unroll
        for (int i = 0; i < 16; ++i) s[kb][i] = 0.f;
      }
    }
#pragma unroll
    for (int ks = 0; ks < NKS; ++ks)
#pragma unroll
      for (int kb = 0; kb < 2; ++kb) s[kb] = __builtin_amdgcn_mfma_f32_32x32x16_bf16(kf[kb][ks], qf[ks], s[kb], 0, 0, 0);
  };
  auto softmax = [&](int kt, f32x16 (&s)[2], bf16x8 (&pf)[2][2], auto maskc) {
    constexpr bool MASK = decltype(maskc)::value;
    const int key0 = kt * 64;
    if (MASK) {
#pragma unroll
      for (int kb = 0; kb < 2; ++kb)
#pragma unroll
        for (int i = 0; i < 16; ++i) {
          const int key = key0 + 32 * kb + (i & 3) + 8 * (i >> 2) + 4 * hh;
          bool valid = key <= myq; if (MODE == 1) valid = valid && (myq - key < 128);
          s[kb][i] = valid ? s[kb][i] : -1e30f;
        }
    }
    float mx = fmaxf(s[0][0], s[1][0]);
#pragma unroll
    for (int i = 1; i < 16; ++i) mx = fmaxf(fmaxf(mx, s[0][i]), s[1][i]);
    mx = half_max(mx);
    if (__builtin_amdgcn_ballot_w64(mx > m + tau) != 0ull) {
      const float mnew = fmaxf(m, mx);
      const float alpha = fast_exp2((m - mnew) * c);
      m = mnew;
      l0 *= alpha; l1 *= alpha;
#pragma unroll
      for (int bl = 0; bl < NBLK; ++bl)
#pragma unroll
        for (int i = 0; i < 16; ++i) O[bl][i] *= alpha;
    }
    const float nmc = -m * c;
#pragma unroll
    for (int kb = 0; kb < 2; ++kb)
#pragma unroll
      for (int s2 = 0; s2 < 2; ++s2) {
        float pv[8];
#pragma unroll
        for (int e = 0; e < 8; ++e) pv[e] = fast_exp2(__builtin_fmaf(s[kb][8 * s2 + e], c, nmc));
        l0 += (pv[0] + pv[4]) + (pv[2] + pv[6]); l1 += (pv[1] + pv[5]) + (pv[3] + pv[7]);
        u32x4 w;
        w.x = pk2(pv[0], pv[1]); w.y = pk2(pv[2], pv[3]); w.z = pk2(pv[4], pv[5]); w.w = pk2(pv[6], pv[7]);
        pf[kb][s2] = __builtin_bit_cast(bf16x8, w);
      }
  };
  auto pvmm = [&](int kt, const bf16x8 (&pf)[2][2]) {
    constexpr int PD = (NBLK == 2) ? 2 : 1;
    const unsigned va = (unsigned)(size_t)(lds + (kt % 4) * TILE + KCH * 1024 + (4 * hh + q4) * VSTR + (16 * grp) * 2 + 8 * p4);
    s16x4 vl[PD + 1][NBLK], vh[PD + 1][NBLK];
#define TRRD(dst, off) asm volatile("ds_read_b64_tr_b16 %0, %1 offset:%2" : "=&v"(dst) : "v"(va), "n"(off) : "memory")
#define TRSTEP(st_) do { _Pragma("unroll") for (int bl = 0; bl < NBLK; ++bl) { TRRD(vl[(st_) % (PD + 1)][bl], 16 * (st_) * VSTR + 64 * bl); TRRD(vh[(st_) % (PD + 1)][bl], 16 * (st_) * VSTR + 64 * bl + 8 * VSTR); } } while (0)
#define TRWAIT(n_, b_) do { if (NBLK == 2) asm volatile("s_waitcnt lgkmcnt(" #n_ ")" : "+v"(vl[b_][0]), "+v"(vh[b_][0]), "+v"(vl[b_][1]), "+v"(vh[b_][1])::"memory"); \
    else asm volatile("s_waitcnt lgkmcnt(" #n_ ")" : "+v"(vl[b_][0]), "+v"(vh[b_][0]), "+v"(vl[b_][1]), "+v"(vh[b_][1]), "+v"(vl[b_][2 % NBLK]), "+v"(vh[b_][2 % NBLK]), "+v"(vl[b_][3 % NBLK]), "+v"(vh[b_][3 % NBLK])::"memory"); } while (0)
#pragma unroll
    for (int st = 0; st < PD; ++st) TRSTEP(st);
#pragma unroll
    for (int st = 0; st < 4; ++st) {
      if (st + PD < 4) TRSTEP(st + PD);
      const int ahead = ((st + PD < 4) ? st + PD : 3) - st;
      const int b_ = st % (PD + 1);
      if (ahead * 2 * NBLK == 8) TRWAIT(8, b_); else if (ahead * 2 * NBLK == 4) TRWAIT(4, b_); else TRWAIT(0, b_);
#pragma unroll
      for (int bl = 0; bl < NBLK; ++bl) {
        const bf16x8 vf = __builtin_shufflevector(vl[b_][bl], vh[b_][bl], 0, 1, 2, 3, 4, 5, 6, 7);
        O[bl] = __builtin_amdgcn_mfma_f32_32x32x16_bf16(vf, pf[st >> 1][st & 1], O[bl], 0, 0, 0);
      }
    }
#undef TRRD
#undef TRSTEP
#undef TRWAIT
  };
  auto act = [&](int kt) { return kt <= last_w && kt >= first_w; };
  f32x16 sA[2];
  const bool halfB = wid >= 4;
  issue(lo);
  if (lo + 1 < hi) issue(lo + 1);
  if (lo + 2 < hi) issue(lo + 2);
  wait_tiles(true);
  raw_barrier();
  if (halfB) raw_barrier();
  if (act(lo)) { bf16x8 kf0[2][NKS]; qk_load(lo, kf0); qk_mma(lo, kf0, sA); }
  auto step = [&](int kt, auto maskc) {
    const bool a0 = act(kt), a1 = (kt + 1 < hi) && act(kt + 1);
    bf16x8 pf[2][2], kf[2][NKS];
    if (a0) softmax(kt, sA, pf, maskc);
    wait_tiles(true);
    raw_barrier();
    if (a1) qk_load(kt + 1, kf);
    __builtin_amdgcn_s_setprio(1);
    if (a1) qk_mma(kt + 1, kf, sA);
    if (a0) pvmm(kt, pf);
    __builtin_amdgcn_s_setprio(0);
    if (kt + 3 < hi) issue(kt + 3);
    raw_barrier();
  };
  int split = lo;
  if (MODE != 1) { split = qw >> 6; if (split < lo) split = lo; if (split > hi) split = hi; }
  if (MODE != 1) { for (int kt = lo; kt < split; ++kt) step(kt, std::false_type{}); }
  for (int kt = split; kt < hi; ++kt) step(kt, std::true_type{});
  if (!halfB) raw_barrier();
  const float l = half_sum(l0 + l1);
  const float inv = 1.f / l;
#pragma unroll
  for (int bl = 0; bl < NBLK; ++bl)
    epi_block(O[bl], inv, hh, a.gate ? a.gate + (size_t)myq * a.ldg + 32 * bl : nullptr, a.out + (size_t)myq * a.ldo + 32 * bl);
}

DI void swa_item(LAS unsigned char* lds, const AttnArgs& a, const float* sinks4, int qb) {
  constexpr int KSTR = 144, VSTR = 192, KCH = 9, VCH = 12, NCH = 21, TILE = NCH * 1024, NSLOT = 3, REM = 5, NKS = 4, NBLK = 2;
  const int tid = opaque_tid(), wid = __builtin_amdgcn_readfirstlane(tid >> 6), lane = tid & 63, r = lane & 31, hh = lane >> 5;
  const int q0 = qb * 256, qw = q0 + 32 * wid, myq = qw + r;
  const float c = a.sl2, tau = 8.0f / a.sl2;
  int lo = 4 * qb - 2; if (lo < 0) lo = 0;
  const int hi = 4 * (qb + 1);
  const int last_w = (qw + 31) >> 6, first_w = (qw > 127 ? qw - 127 : 0) >> 6;
#pragma unroll
  for (int j = 0; j < NSLOT; ++j) {
    const int ch_ = 8 * j + wid;
    if (j < NSLOT - 1 || wid < REM) {
      const char* sp; unsigned sst;
      if (ch_ < KCH) { const int p = ch_ * 64 + lane, row = p / 9, g = p - row * 9;
        sp = (const char*)(a.k + (size_t)row * a.ldk + 8 * (g < 8 ? g : 0)); sst = (unsigned)(128 * a.ldk); }
      else { const int p = (ch_ - KCH) * 64 + lane, row = (p / 12) & 63, g = p - (p / 12) * 12;
        sp = (const char*)(a.v + (size_t)row * a.ldv + 8 * (g < 8 ? g : 0)); sst = (unsigned)(128 * a.ldv); }
      for (int kt = lo; kt < hi; ++kt)
        __builtin_amdgcn_global_load_lds((const unsigned*)(sp + (size_t)kt * sst), (LAS unsigned*)(lds + (kt - lo) * TILE + ch_ * 1024), 16, 0, 0);
    }
  }
  wait_vmcnt<0>();
  raw_barrier();
  const int i16 = lane & 15, q4 = i16 >> 2, p4 = i16 & 3, grp = (lane >> 4) & 1;
  for (int h4 = 0; h4 < 4; ++h4) {
    bf16x8 qf[NKS];
#pragma unroll
    for (int ks = 0; ks < NKS; ++ks) qf[ks] = *(const bf16x8*)(a.q + (size_t)myq * a.ldq + h4 * 64 + 16 * ks + 8 * hh);
    f32x16 O[NBLK];
#pragma unroll
    for (int bl = 0; bl < NBLK; ++bl)
#pragma unroll
      for (int i = 0; i < 16; ++i) O[bl][i] = 0.f;
    float m = sinks4[h4] / a.sl2;
    float l0 = (hh == 0) ? 1.f : 0.f, l1 = 0.f;
    for (int kt = first_w; kt <= last_w; ++kt) {
      LAS unsigned char* Kl = lds + (kt - lo) * TILE;
      f32x16 s[2];
      bf16x8 kf[2][NKS];
#pragma unroll
      for (int kb = 0; kb < 2; ++kb)
#pragma unroll
        for (int ks = 0; ks < NKS; ++ks) kf[kb][ks] = *(const LAS bf16x8*)(Kl + (32 * kb + r) * KSTR + (16 * ks + 8 * hh) * 2);
#pragma unroll
      for (int kb = 0; kb < 2; ++kb)
#pragma unroll
        for (int i = 0; i < 16; ++i) s[kb][i] = 0.f;
#pragma unroll
      for (int ks = 0; ks < NKS; ++ks)
#pragma unroll
        for (int kb = 0; kb < 2; ++kb) s[kb] = __builtin_amdgcn_mfma_f32_32x32x16_bf16(kf[kb][ks], qf[ks], s[kb], 0, 0, 0);
      const int key0 = kt * 64;
#pragma unroll
      for (int kb = 0; kb < 2; ++kb)
#pragma unroll
        for (int i = 0; i < 16; ++i) {
          const int key = key0 + 32 * kb + (i & 3) + 8 * (i >> 2) + 4 * hh;
          const bool valid = (key <= myq) && (myq - key < 128);
          s[kb][i] = valid ? s[kb][i] : -1e30f;
        }
      float mx = fmaxf(s[0][0], s[1][0]);
#pragma unroll
      for (int i = 1; i < 16; ++i) mx = fmaxf(fmaxf(mx, s[0][i]), s[1][i]);
      mx = half_max(mx);
      if (__builtin_amdgcn_ballot_w64(mx > m + tau) != 0ull) {
        const float mnew = fmaxf(m, mx);
        const float alpha = fast_exp2((m - mnew) * c);
        m = mnew; l0 *= alpha; l1 *= alpha;
#pragma unroll
        for (int bl = 0; bl < NBLK; ++bl)
#pragma unroll
          for (int i = 0; i < 16; ++i) O[bl][i] *= alpha;
      }
      const float nmc = -m * c;
      bf16x8 pf[2][2];
#pragma unroll
      for (int kb = 0; kb < 2; ++kb)
#pragma unroll
        for (int s2 = 0; s2 < 2; ++s2) {
          float pv[8];
#pragma unroll
          for (int e = 0; e < 8; ++e) pv[e] = fast_exp2(__builtin_fmaf(s[kb][8 * s2 + e], c, nmc));
          l0 += (pv[0] + pv[4]) + (pv[2] + pv[6]); l1 += (pv[1] + pv[5]) + (pv[3] + pv[7]);
          u32x4 w;
          w.x = pk2(pv[0], pv[1]); w.y = pk2(pv[2], pv[3]); w.z = pk2(pv[4], pv[5]); w.w = pk2(pv[6], pv[7]);
          pf[kb][s2] = __builtin_bit_cast(bf16x8, w);
        }
      LAS unsigned char* Vl = Kl + KCH * 1024 + (4 * hh + q4) * VSTR + (16 * grp) * 2 + 8 * p4;
#pragma unroll
      for (int st = 0; st < 4; ++st)
#pragma unroll
        for (int bl = 0; bl < NBLK; ++bl) {
          LAS unsigned char* ad = Vl + (16 * st) * VSTR + (32 * bl) * 2;
          const s16x4 lo_ = __builtin_amdgcn_ds_read_tr16_b64_v4i16((LAS s16x4*)ad);
          const s16x4 hi_ = __builtin_amdgcn_ds_read_tr16_b64_v4i16((LAS s16x4*)(ad + 8 * VSTR));
          const bf16x8 vf = __builtin_shufflevector(lo_, hi_, 0, 1, 2, 3, 4, 5, 6, 7);
          O[bl] = __builtin_amdgcn_mfma_f32_32x32x16_bf16(vf, pf[st >> 1][st & 1], O[bl], 0, 0, 0);
        }
    }
    const float l = half_sum(l0 + l1);
    const float inv = 1.f / l;
#pragma unroll
    for (int bl = 0; bl < NBLK; ++bl)
      epi_block(O[bl], inv, hh, a.gate + (size_t)myq * a.ldg + h4 * 64 + 32 * bl, a.out + (size_t)myq * a.ldo + h4 * 64 + 32 * bl);
  }
  __syncthreads();
}

DI bool team_item(int G, int c, int n, int& bh, int& qb) {
  if (G == 256) {
    const int x = c & 7, li = c >> 3, t = li >> 3, i = li & 7;
    bh = x + 8 * (4 * t + n);
    const int j = (i + 4) & 7;
    qb = (n == 0) ? i : (n == 1) ? 7 - i : (n == 2) ? j : 7 - j;
    return true;
  }
  const int idx = n * G + ((n & 1) ? (G - 1 - c) : c);
  if (idx >= 1024) return false;
  qb = 7 - idx / 128; bh = idx % 128;
  return true;
}

DI int snake_idx(int round, int G, int c) { return round * G + ((round & 1) ? (G - 1 - c) : c); }

DI void attn_even(const Params& p, LAS unsigned char* lds, int i) {
  const int G = gridDim.x, c = blockIdx.x;
  unsigned char* ws = p.ws;
  const bf16_t* z = (const bf16_t*)(ws + WS_ZBUF);
  const bf16_t* qb_ = (const bf16_t*)(ws + WS_QBUF);
  const bf16_t* kv = (const bf16_t*)(ws + WS_HBUF);
  bf16_t* ob = (bf16_t*)(ws + WS_OBUF);
  for (int rd = 0; rd * G < 1024; ++rd) {
    int qb, bh;
    if (!team_item(G, c, rd, bh, qb)) continue;
    const int b = bh >> 3, hd = bh & 7;
    AttnArgs a;
    a.q = qb_ + (size_t)b * SEQ * 768 + hd * 96; a.ldq = 768;
    a.k = kv + (size_t)b * SEQ * 1024 + hd * 128; a.ldk = 1024;
    a.k2 = z + (size_t)b * SEQ * 2560 + 2432; a.ldk2 = 2560;
    a.v = kv + (size_t)b * SEQ * 1024 + hd * 128 + 64; a.ldv = 1024;
    a.out = ob + (size_t)b * SEQ * 1024 + hd * 64; a.ldo = 1024;
    a.gate = z + (size_t)b * SEQ * 2560 + 768 + hd * 64; a.ldg = 2560;
    a.fcum = nullptr; a.sl2 = 0.10206207261596577f * LOG2E; a.sink = 0.f;
    attn_item<96, 64, 0>(lds, a, qb);
  }
  for (int it = c; it < 256; it += G) {
    const int b = it >> 4, kvh = (it >> 3) & 1, qb = it & 7;
    AttnArgs a;
    const bf16_t* zb = z + (size_t)b * SEQ * 2560;
    a.q = zb + kvh * 256; a.ldq = 2560;
    a.k = zb + 512 + kvh * 64; a.ldk = 2560; a.k2 = nullptr; a.ldk2 = 0;
    a.v = zb + 640 + kvh * 64; a.ldv = 2560;
    a.out = ob + (size_t)b * SEQ * 1024 + 512 + kvh * 256; a.ldo = 1024;
    a.gate = zb + 768 + 512 + kvh * 256; a.ldg = 2560;
    a.fcum = nullptr; a.sl2 = 0.125f * LOG2E; a.sink = 0.f;
    float sk[4];
#pragma unroll
    for (int h4 = 0; h4 < 4; ++h4) sk[h4] = p.ev_sinks[i * 8 + kvh * 4 + h4] * LOG2E;
    swa_item(lds, a, sk, qb);
  }
}

DI void attn_odd(const Params& p, LAS unsigned char* lds, int layer) {
  const int G = gridDim.x, c = blockIdx.x;
  unsigned char* ws = p.ws;
  const bf16_t* z = (const bf16_t*)(ws + WS_ZBUF);
  bf16_t* od = (bf16_t*)(ws + WS_HBUF);
  bf16_t* ob = (bf16_t*)(ws + WS_OBUF);
  {
    for (int rd = 0; rd * G < 512; ++rd) {
      int qb, bh2;
      if (G == 256) { const int x = c & 7, li = c >> 3, t = li >> 3, i = li & 7; bh2 = x + 8 * (2 * t + rd); qb = (rd == 0) ? i : 7 - i; }
      else { const int idx = snake_idx(rd, G, c); if (idx >= 512) continue; qb = 7 - idx / 64; bh2 = idx % 64; }
      const int b = bh2 >> 2, h = bh2 & 3;
      const bf16_t* zb = z + (size_t)b * SEQ * 4096;
      for (int mp = 0; mp < 2; ++mp) {
        const int j = 2 * h + mp;
        AttnArgs a;
        a.q = zb + j * 64; a.ldq = 4096;
        a.k = zb + 512 + j * 64; a.ldk = 4096; a.k2 = nullptr; a.ldk2 = 0;
        a.v = zb + 1024 + h * 128; a.ldv = 4096;
        a.out = od + (size_t)b * SEQ * 1024 + j * 128; a.ldo = 1024;
        a.gate = nullptr; a.ldg = 0;
        a.fcum = nullptr; a.sl2 = 0.125f * LOG2E; a.sink = 0.f;
#ifndef SKIP_DIFF
        attn_item<64, 128, 0>(lds, a, qb);
#endif
      }
      __builtin_amdgcn_fence(__ATOMIC_SEQ_CST, "workgroup");
      asm volatile("s_waitcnt vmcnt(0)" ::: "memory");
      const int tid2 = opaque_tid(), lane = tid2 & 63, wid = tid2 >> 6, li_ = layer >> 1;
      const float* lp = p.od_lambda + li_ * 256;
      const float s1 = wave_sum(lp[lane] * lp[64 + lane]), s2 = wave_sum(lp[128 + lane] * lp[192 + lane]);
      const float lam_init = 0.8f - 0.6f * fast_exp2(-0.3f * LOG2E * (float)layer);
      const float lam = fast_exp2(s1 * LOG2E) - fast_exp2(s2 * LOG2E) + lam_init;
      const int rsub = lane >> 4, dv = (lane & 15) * 8;
      float sub[8];
#pragma unroll
      for (int e = 0; e < 8; ++e) sub[e] = p.od_subln[li_ * 128 + dv + e] * (1.f - lam_init);
      const size_t row0 = (size_t)b * SEQ + qb * 256 + 32 * wid;
#pragma unroll 2
      for (int rr = 0; rr < 8; ++rr) {
        const size_t row = row0 + 4 * rr + rsub;
        const u32x4 va = *(const u32x4*)(od + row * 1024 + (2 * h) * 128 + dv);
        const u32x4 vb = *(const u32x4*)(od + row * 1024 + (2 * h + 1) * 128 + dv);
        const u32x4 vg = *(const u32x4*)(z + row * 4096 + 3072 + h * 128 + dv);
        float d[8]; float ss = 0.f;
#pragma unroll
        for (int e = 0; e < 4; ++e) { d[2 * e] = bflo(va[e]) - lam * bflo(vb[e]); d[2 * e + 1] = bfhi(va[e]) - lam * bfhi(vb[e]); ss += d[2 * e] * d[2 * e] + d[2 * e + 1] * d[2 * e + 1]; }
        ss += dpp_mov<0xB1>(ss); ss += dpp_mov<0x4E>(ss); ss += dpp_mov<0x141>(ss); ss += dpp_mov<0x140>(ss);
        const float rs = rsqrtf(ss * (1.f / 128.f) + EPS);
        u32x4 w;
#pragma unroll
        for (int e = 0; e < 4; ++e) {
          const float o0 = d[2 * e] * rs * sub[2 * e] * silu_f(bflo(vg[e])), o1 = d[2 * e + 1] * rs * sub[2 * e + 1] * silu_f(bfhi(vg[e]));
          w[e] = pk2(o0, o1);
        }
        *(u32x4*)(ob + row * 1024 + h * 128 + dv) = w;
      }
    }
  }
  for (int rd = 0; rd * G < 1024; ++rd) {
    int qb, bh;
    if (!team_item(G, c, rd, bh, qb)) continue;
    const int b = bh >> 3, hd = bh & 7;
    AttnArgs a;
    const bf16_t* zb = z + (size_t)b * SEQ * 4096;
    a.q = zb + 1536 + hd * 64; a.ldq = 4096;
    a.k = zb + 2048 + hd * 64; a.ldk = 4096; a.k2 = nullptr; a.ldk2 = 0;
    a.v = zb + 2560 + hd * 64; a.ldv = 4096;
    a.out = ob + (size_t)b * SEQ * 1024 + 512 + hd * 64; a.ldo = 1024;
    a.gate = zb + 3072 + 512 + hd * 64; a.ldg = 4096;
    a.fcum = (const float*)(ws + WS_FCUM) + (size_t)bh * SEQ; a.sl2 = 0.125f * LOG2E; a.sink = 0.f;
#ifndef SKIP_FOX
    attn_item<64, 64, 2>(lds, a, qb);
#endif
  }
}

#define XB_TMO      128
#define XB_XCNT(j)  (256  + 64 * (j))
#define XB_XSUB(j)  (1280 + 64 * (j))
#define XB_XGEN(j)  (2304 + 64 * (j))
#define XB_TOP      3328
#define XB_TOPGEN   3392
#define XCD_BAR_WORDS 3456
#define XB_SPIN_CAP (1u << 20)
DI unsigned xb_ld(unsigned* p) { return __hip_atomic_load(p, __ATOMIC_RELAXED, __HIP_MEMORY_SCOPE_AGENT); }
DI unsigned xb_add(unsigned* p, unsigned v) { return __hip_atomic_fetch_add(p, v, __ATOMIC_RELAXED, __HIP_MEMORY_SCOPE_AGENT); }
DI unsigned xb_xcc_id() { return (unsigned)__builtin_amdgcn_s_getreg((3 << 11) | 20) & 0xFu; }
#define XB_SPIN(cond, bar) do { unsigned _sp = 0; while (cond) { __builtin_amdgcn_s_sleep(1); \
    if ((++_sp & 255u) == 0u) { if (xb_ld(&(bar)[XB_TMO])) break; if (_sp > XB_SPIN_CAP) { atomicAdd(&(bar)[XB_TMO], 1u); break; } } } } while (0)
struct XcdBarrier { unsigned* bar; unsigned x; volatile LAS unsigned* st; };
DI void xcd_barrier_complete(unsigned* bar, unsigned x, unsigned& nloc, unsigned& nx) {
  const unsigned G = gridDim.x;
  unsigned sum, cnt, mine, sp = 0u;
  for (;;) {
    sum = 0u; cnt = 0u; mine = 0u;
#pragma unroll
    for (unsigned j = 0; j < 16; ++j) { const unsigned c = xb_ld(&bar[XB_XCNT(j)]); sum += c; cnt += (c > 0u) ? 1u : 0u; mine = (j == x) ? c : mine; }
    if (sum == G) break;
    __builtin_amdgcn_s_sleep(1);
    if ((++sp & 255u) == 0u) { if (xb_ld(&bar[XB_TMO])) break; if (sp > XB_SPIN_CAP) { atomicAdd(&bar[XB_TMO], 1u); break; } }
  }
  nloc = mine > 0u ? mine : 1u; nx = cnt > 0u ? cnt : 1u;
}
DI void xcd_barrier(const XcdBarrier& b) {
  asm volatile("s_waitcnt vmcnt(0)" ::: "memory");
  __syncthreads();
  if (threadIdx.x == 0) {
    unsigned* bar = b.bar;
    const unsigned bx = xb_xcc_id();
    __builtin_amdgcn_s_waitcnt(0);
    unsigned nloc = b.st[0], nx = b.st[1];
    if (nloc == 0u) { xcd_barrier_complete(bar, bx, nloc, nx); b.st[0] = nloc; b.st[1] = nx; }
    const unsigned old = xb_add(&bar[XB_XSUB(bx)], 1u);
    const unsigned gen = old / nloc;
    if (old + 1u == (gen + 1u) * nloc) {
      __builtin_amdgcn_fence(__ATOMIC_RELEASE, "agent");
      asm volatile("s_waitcnt vmcnt(0)" ::: "memory");
      const unsigned og = xb_add(&bar[XB_TOP], 1u);
      const unsigned tg = og / nx;
      if (og + 1u == (tg + 1u) * nx) xb_add(&bar[XB_TOPGEN], 1u);
      else XB_SPIN(xb_ld(&bar[XB_TOPGEN]) == tg, bar);
      __builtin_amdgcn_fence(__ATOMIC_ACQUIRE, "agent");
      xb_add(&bar[XB_XGEN(bx)], 1u);
      asm volatile("s_waitcnt vmcnt(0)" ::: "memory");
    } else {
      XB_SPIN(xb_ld(&bar[XB_XGEN(bx)]) == gen, bar);
      __builtin_amdgcn_fence(__ATOMIC_ACQUIRE, "agent");
      asm volatile("s_waitcnt vmcnt(0)" ::: "memory");
    }
  }
  __syncthreads();
}

__global__ void __launch_bounds__(512) fwd_megakernel(Params p) {
  extern __shared__ __attribute__((aligned(16))) unsigned char lds_raw[];
  LAS unsigned char* lds = (LAS unsigned char*)lds_raw;
  if (p.out == nullptr) cg::this_grid().sync();
  unsigned char* ws = p.ws;
  const int G = gridDim.x, bid = blockIdx.x;
  const float* cosH = (const float*)(ws + WS_COSH); const float* sinH = (const float*)(ws + WS_SINH);
  const float* cosR = (const float*)(ws + WS_COSR); const float* sinR = (const float*)(ws + WS_SINR);

  unsigned* xbar = (unsigned*)(ws + WS_XBAR);
  volatile LAS unsigned* xst = (volatile LAS unsigned*)(lds + LDS_BYTES_C - 16);
  if (threadIdx.x == 0) { xst[0] = 0u; xst[1] = 0u; (void)xb_add(&xbar[XB_XCNT(xb_xcc_id())], 1u); }
#ifndef SKIP_PRO
  prologue(p, lds);
#endif
  XcdBarrier xb; xb.bar = xbar; xb.x = xb_xcc_id(); xb.st = xst;
  xcd_barrier(xb);
#pragma unroll
  for (int layer = 0; layer < 4; ++layer) {
    const int i = layer >> 1; const bool odd = layer & 1;
#ifndef SKIP_ROW
    rowwise_phase(p, lds, layer - 1, layer);
#endif
    xcd_barrier(xb);
    {
#ifndef SKIP_SCAN
      if (odd) { for (int bh = bid; bh < 128; bh += G) fox_scan(p, lds, bh); }
#endif
      pg8::Gemm g; g.A = (const bf16_t*)(ws + WS_HBUF); g.lda = 1024; g.K = 1024; g.M = T;
      Epi e; e.out = (bf16_t*)(ws + WS_ZBUF); e.pin = nullptr; e.pslot = 0; e.nK = 0; e.qmode = 0; e.pout = odd ? nullptr : (float*)(ws + WS_PART); e.cosH = cosH; e.sinH = sinH; e.cosR = cosR; e.sinR = sinR;
      if (!odd) { g.Bt = (const bf16_t*)(ws + WS_WEVIN + i * SZ_WEVIN); g.N = 2560; e.ldc = 2560; e.rope64_end = 640; e.rope32_lo = 2432; e.rope32_hi = 2464; }
      else { g.Bt = (const bf16_t*)(ws + WS_WODIN + i * SZ_WODIN); g.N = 4096; e.ldc = 4096; e.rope64_end = 1024; e.rope32_lo = 0; e.rope32_hi = 0; }
      pg8::StaticOrder S; S.init(g.M, g.N, G, bid);
#ifndef SKIP_G1
      pg8::gemm_phase<Epi>(lds, g, S, e);
#endif
    }
    xcd_barrier(xb);
    if (!odd) {
      for (int which = 0; which < 2; ++which) {
        pg8::Gemm g; g.M = T; g.lda = 2560;
        Epi e; e.rope64_end = 0; e.rope32_lo = 0; e.rope32_hi = 0; e.cosH = cosH; e.sinH = sinH; e.cosR = cosR; e.sinR = sinR; e.pout = nullptr; e.pin = (const float*)(ws + WS_PART);
        if (which == 0) { g.A = (const bf16_t*)(ws + WS_ZBUF) + 1792; g.Bt = (const bf16_t*)(ws + WS_WUQ + i * SZ_WUQ); g.N = 768; g.K = 384;
          e.out = (bf16_t*)(ws + WS_QBUF); e.ldc = 768; e.qmode = 1; e.pslot = 0; e.nK = 384; }
        else { g.A = (const bf16_t*)(ws + WS_ZBUF) + 2176; g.Bt = (const bf16_t*)(ws + WS_WUKV + i * SZ_WUKV); g.N = 1024; g.K = 256;
          e.out = (bf16_t*)(ws + WS_HBUF); e.ldc = 1024; e.qmode = 0; e.pslot = 12; e.nK = 256; }
        pg8::StaticOrder S; S.init(g.M, g.N, G, bid);
#ifndef SKIP_G2
        pg8::gemm_phase<Epi>(lds, g, S, e);
#endif
      }
      xcd_barrier(xb);
#ifndef SKIP_ATTE
      attn_even(p, lds, i);
#endif
      xcd_barrier(xb);
    } else {
#ifndef SKIP_ATTO
      attn_odd(p, lds, layer);
#endif
      xcd_barrier(xb);
    }
    {
      pg8::Gemm g; g.A = (const bf16_t*)(ws + WS_OBUF); g.lda = 1024; g.K = 1024; g.M = T; g.N = 1024;
      g.Bt = (const bf16_t*)(ws + (odd ? WS_WODOUT : WS_WEVOUT) + i * SZ_WOUT);
      Epi e; e.out = (bf16_t*)(ws + WS_HBUF); e.ldc = 1024; e.pin = nullptr; e.pslot = 0; e.pout = nullptr; e.nK = 0; e.qmode = 0; e.rope64_end = 0; e.rope32_lo = 0; e.rope32_hi = 0;
      e.cosH = cosH; e.sinH = sinH; e.cosR = cosR; e.sinR = sinR;
      pg8::StaticOrder S; S.init(g.M, g.N, G, bid);
#ifndef SKIP_G3
      pg8::gemm_phase<Epi>(lds, g, S, e);
#endif
    }
    xcd_barrier(xb);
  }
#ifndef SKIP_ROW
  rowwise_phase(p, lds, 3, 4);
#endif
}

constexpr int LDS_BYTES = 155648;
static_assert(LDS_BYTES == LDS_BYTES_C, "LDS size mismatch");

extern "C" void kernel_launch(void* const* d_in, const int* in_sizes, int n_in, void* d_out, int out_size, void* d_ws, size_t ws_size, hipStream_t stream) {
  static int grid_blocks = 0;
  if (grid_blocks == 0) {
    int dev = 0, cus = 0, per_cu = 0;
    if (hipGetDevice(&dev) != hipSuccess || hipDeviceGetAttribute(&cus, hipDeviceAttributeMultiprocessorCount, dev) != hipSuccess) { fprintf(stderr, "device query failed\n"); grid_blocks = -1; return; }
    if (hipFuncSetAttribute((const void*)fwd_megakernel, hipFuncAttributeMaxDynamicSharedMemorySize, LDS_BYTES) != hipSuccess) { fprintf(stderr, "hipFuncSetAttribute failed\n"); grid_blocks = -1; return; }
    if (hipOccupancyMaxActiveBlocksPerMultiprocessor(&per_cu, (const void*)fwd_megakernel, 512, LDS_BYTES) != hipSuccess || per_cu < 1) { fprintf(stderr, "occupancy query: %d\n", per_cu); per_cu = 1; }
    (void)hipGetLastError();
    grid_blocks = cus;
    if (ws_size < WS_END) { fprintf(stderr, "workspace too small: %zu < %zu\n", ws_size, (size_t)WS_END); grid_blocks = -1; return; }
  }
  if (grid_blocks < 0) return;
  Params p{};
  const float** fp = (const float**)&p;
  for (int i = 0; i < 18; ++i) fp[i] = (const float*)d_in[i];
  p.out = (float*)d_out; p.ws = (unsigned char*)d_ws;
  if (hipMemsetAsync((unsigned char*)d_ws + WS_XBAR, 0, 16384, stream) != hipSuccess) { fprintf(stderr, "memset of the barrier words failed\n"); return; }
  void* args[] = {&p};
  hipError_t e = hipLaunchCooperativeKernel((const void*)fwd_megakernel, dim3(grid_blocks), dim3(512), args, LDS_BYTES, stream);
  if (e != hipSuccess) fprintf(stderr, "cooperative launch failed: %s (grid %d)\n", hipGetErrorString(e), grid_blocks);
}
```
